# Optimizing an MI355X kernel written in HIP

```python
import math
import jax, jax.numpy as jnp
from jax import lax
import numpy as np

D_MODEL = 1024
BATCH = 2
SEQ = 8192
DEPTH = 2

GRID_W = 64
CTX_LEN = 256
EPS = 1e-6
ROPE_BASE = 10000.0
HEAD_DIM = 64

SWA_HEADS = 6
SWA_KV_HEADS = 2
SWA_WINDOW = 128
SWA_BLOCK = 128
GDN_HEADS = 6
GDN_DK = 64
GDN_DV = 64
GDN_CONV = 5
GDN_CHUNK = 64
MLA_HEADS = 4
MLA_Q_RANK = 192
MLA_KV_RANK = 128
MLA_NOPE = 64
MLA_ROPE = 32
MLA_V = 64
MLA_BLOCK = 128

D_MIX = SWA_HEADS * HEAD_DIM + GDN_HEADS * GDN_DV + MLA_HEADS * MLA_V
GDN_QKV = 2 * GDN_HEADS * GDN_DK + GDN_HEADS * GDN_DV
PROJ_SPLITS = (SWA_HEADS * HEAD_DIM, SWA_KV_HEADS * HEAD_DIM, SWA_KV_HEADS * HEAD_DIM,
               GDN_QKV, GDN_HEADS * GDN_DV, 4 * GDN_HEADS,
               MLA_Q_RANK, MLA_KV_RANK, MLA_ROPE)
D_PROJ = sum(PROJ_SPLITS)

N_EXPERTS = 64
MOE_TOP_K = 8
MOE_GROUPS = 8
MOE_TOPK_GROUPS = 4
D_EXPERT = 256
D_SHARED = 256
ROUTED_SCALE = 2.5
MOE_BLOCK = 128

kernel_name = "hybrid_dit_hymba_swa_gdn_mla_moe"


def rms_norm(x, gain=None):
    xf = x.astype(jnp.float32)
    y = xf * lax.rsqrt(jnp.mean(xf * xf, axis=-1, keepdims=True) + EPS)
    if gain is not None:
        y = y * gain.astype(jnp.float32)
    return y.astype(x.dtype)


def l2_normalize(t):
    tf = t.astype(jnp.float32)
    return (tf * lax.rsqrt(jnp.sum(tf * tf, axis=-1, keepdims=True) + EPS)).astype(t.dtype)


def grid_positions(n_tokens):
    rows = n_tokens // GRID_W
    row = jnp.repeat(jnp.arange(rows, dtype=jnp.int32), GRID_W)
    col = jnp.tile(jnp.arange(GRID_W, dtype=jnp.int32), rows)
    return row, col


def rope_2d(x, row, col):
    half = x.shape[-1] // 2

    def rot(xh, pos):
        n = xh.shape[-1] // 2
        inv = ROPE_BASE ** (-jnp.arange(n, dtype=jnp.float32) / n)
        ang = pos.astype(jnp.float32)[:, None] * inv[None, :]
        cos, sin = jnp.cos(ang)[:, None, :], jnp.sin(ang)[:, None, :]
        x1, x2 = xh[..., :n], xh[..., n:]
        return jnp.concatenate([x1 * cos - x2 * sin, x1 * sin + x2 * cos], axis=-1)

    return jnp.concatenate([rot(x[..., :half], row), rot(x[..., half:], col)], axis=-1).astype(x.dtype)


def split_proj(p):
    offsets = np.cumsum(PROJ_SPLITS)[:-1].tolist()
    return jnp.split(p, offsets, axis=-1)


def modulation(cvec, w_ada, b_ada):
    return jnp.split(jax.nn.silu(cvec) @ w_ada + b_ada, 6, axis=-1)


def swa_latent(q, k, v, kc, vc, sink):
    B, S, H, d = q.shape
    Bk = SWA_BLOCK
    nb = S // Bk
    G = H // SWA_KV_HEADS
    qb = q.reshape(B, nb, Bk, SWA_KV_HEADS, G, d)

    def neighbours(t):
        tp = jnp.pad(t, ((0, 0), (Bk, Bk), (0, 0), (0, 0))).reshape(B, nb + 2, Bk, SWA_KV_HEADS, d)
        return jnp.concatenate([tp[:, :-2], tp[:, 1:-1], tp[:, 2:]], axis=2)

    kb, vb = neighbours(k), neighbours(v)
    blk = jnp.arange(nb)[:, None, None]
    qpos = blk * Bk + jnp.arange(Bk)[None, :, None]
    kpos = (blk - 1) * Bk + jnp.arange(3 * Bk)[None, None, :]
    valid = (jnp.abs(qpos - kpos) <= SWA_WINDOW) & (kpos >= 0) & (kpos < S)
    scale = d ** -0.5
    s_loc = jnp.einsum('bnqkgd,bnpkd->bnkgqp', qb, kb).astype(jnp.float32) * scale
    s_loc = jnp.where(valid[None, :, None, None], s_loc, -jnp.inf)
    s_ctx = jnp.einsum('bnqkgd,bpkd->bnkgqp', qb, kc).astype(jnp.float32) * scale
    s_sink = jnp.broadcast_to(sink.reshape(SWA_KV_HEADS, G, 1, 1).astype(jnp.float32), s_loc.shape[:-1] + (1,))
    p = jax.nn.softmax(jnp.concatenate([s_loc, s_ctx, s_sink], axis=-1), axis=-1).astype(v.dtype)
    o = (jnp.einsum('bnkgqp,bnpkd->bnqkgd', p[..., :3 * Bk], vb)
         + jnp.einsum('bnkgqp,bpkd->bnqkgd', p[..., 3 * Bk:-1], vc))
    return o.reshape(B, S, H * d)


def swa_context(qc, kc, vc, sink):
    B, L, H, d = qc.shape
    G = H // SWA_KV_HEADS
    qg = qc.reshape(B, L, SWA_KV_HEADS, G, d)
    s = jnp.einsum('bqkgd,bpkd->bkgqp', qg, kc).astype(jnp.float32) * d ** -0.5
    s_sink = jnp.broadcast_to(sink.reshape(SWA_KV_HEADS, G, 1, 1).astype(jnp.float32), s.shape[:-1] + (1,))
    p = jax.nn.softmax(jnp.concatenate([s, s_sink], axis=-1), axis=-1).astype(vc.dtype)
    return jnp.einsum('bkgqp,bpkd->bqkgd', p[..., :-1], vc).reshape(B, L, H * d)


def short_conv(x, w):
    return lax.conv_general_dilated(x, w[:, None, :].astype(x.dtype), window_strides=(1,), padding='SAME',
                                    dimension_numbers=('NWC', 'WIO', 'NWC'), feature_group_count=x.shape[-1])


def gdn_features(qkv, ba, conv_w, a_log, dt_bias):
    B, T, _ = qkv.shape
    qkv = jax.nn.silu(short_conv(qkv, conv_w))
    q, k, v = jnp.split(qkv, [GDN_HEADS * GDN_DK, 2 * GDN_HEADS * GDN_DK], axis=-1)
    q = l2_normalize(q.reshape(B, T, GDN_HEADS, GDN_DK))
    k = l2_normalize(k.reshape(B, T, GDN_HEADS, GDN_DK))
    v = v.reshape(B, T, GDN_HEADS, GDN_DV)
    baf = ba.astype(jnp.float32)
    beta = jax.nn.sigmoid(baf[..., :2 * GDN_HEADS]).reshape(B, T, 2, GDN_HEADS)
    a = baf[..., 2 * GDN_HEADS:].reshape(B, T, 2, GDN_HEADS)
    g = -jnp.exp(a_log.astype(jnp.float32)) * jax.nn.softplus(a + dt_bias.astype(jnp.float32))
    return q, k, v, beta, g


def gated_delta_chunked(q, k, v, g, beta, state0, with_output):
    B, T, H, dk = q.shape
    dv = v.shape[-1]
    out_dtype = v.dtype
    C = GDN_CHUNK
    n = T // C
    f32 = jnp.float32

    def to_chunks(t):
        return jnp.moveaxis(t.astype(f32).reshape((B, n, C, H) + t.shape[3:]), 3, 1)

    q, k, v, g, beta = map(to_chunks, (q, k, v, g, beta))
    gc = jnp.cumsum(g, axis=-1)
    incl = jnp.tril(jnp.ones((C, C), dtype=bool))
    strict = jnp.tril(jnp.ones((C, C), dtype=bool), -1)
    decay = jnp.exp(jnp.where(incl, gc[..., :, None] - gc[..., None, :], -jnp.inf))
    k_beta = k * beta[..., None]
    lower = jnp.where(strict, jnp.einsum('bhnid,bhnjd->bhnij', k_beta, k) * decay, 0.0)
    rhs = jnp.concatenate([v * beta[..., None], k_beta * jnp.exp(gc)[..., None]], axis=-1)
    sol = lax.linalg.triangular_solve(jnp.eye(C, dtype=f32) + lower, rhs,
                                      left_side=True, lower=True, unit_diagonal=True)
    u, w = sol[..., :dv], sol[..., dv:]
    k_out = k * jnp.exp(gc[..., -1:] - gc)[..., None]
    g_tot = jnp.exp(gc[..., -1])
    chunk_major = lambda t: jnp.moveaxis(t, 2, 0)
    if with_output:
        qs = q * dk ** -0.5
        intra = jnp.where(incl, jnp.einsum('bhnid,bhnjd->bhnij', qs, k) * decay, 0.0)
        xs = tuple(map(chunk_major, (u, w, k_out, g_tot, qs * jnp.exp(gc)[..., None], intra)))
    else:
        xs = tuple(map(chunk_major, (u, w, k_out, g_tot)))

    def step(S, inp):
        u_i, w_i, k_i, gt_i = inp[:4]
        v_new = u_i - jnp.einsum('bhcd,bhde->bhce', w_i, S)
        S_next = S * gt_i[..., None, None] + jnp.einsum('bhcd,bhce->bhde', k_i, v_new)
        if not with_output:
            return S_next, None
        q_i, a_i = inp[4:]
        o_i = jnp.einsum('bhcd,bhde->bhce', q_i, S) + jnp.einsum('bhij,bhje->bhie', a_i, v_new)
        return S_next, o_i

    S_final, o = lax.scan(step, state0.astype(f32), xs)
    if not with_output:
        return None, S_final
    o = jnp.moveaxis(jnp.moveaxis(o, 0, 2), 1, 3).reshape(B, T, H, dv)
    return o.astype(out_dtype), S_final


def gdn_bidirectional(lat, ctx, ctx_out):
    qL, kL, vL, bL, gL = lat
    qC, kC, vC, bC, gC = ctx
    rev = lambda t: jnp.flip(t, axis=1)
    S0 = jnp.zeros((qL.shape[0], GDN_HEADS, GDN_DK, GDN_DV), jnp.float32)
    oCf, SCf = gated_delta_chunked(qC, kC, vC, gC[:, :, 0], bC[:, :, 0], S0, ctx_out)
    oLf, _ = gated_delta_chunked(qL, kL, vL, gL[:, :, 0], bL[:, :, 0], SCf, True)
    oCb, SCb = gated_delta_chunked(rev(qC), rev(kC), rev(vC), rev(gC[:, :, 1]), rev(bC[:, :, 1]), S0, ctx_out)
    oLb, _ = gated_delta_chunked(rev(qL), rev(kL), rev(vL), rev(gL[:, :, 1]), rev(bL[:, :, 1]), SCb, True)
    o_lat = oLf + rev(oLb)
    o_ctx = oCf + rev(oCb) if ctx_out else None
    return o_lat, o_ctx


def gdn_output(o, z, norm_w):
    B, T = o.shape[:2]
    z = z.reshape(B, T, GDN_HEADS, GDN_DV)
    return (rms_norm(o, norm_w) * jax.nn.silu(z)).reshape(B, T, GDN_HEADS * GDN_DV)


def mla_queries(cq, q_norm, w_uq, row, col):
    B, T = cq.shape[:2]
    q = (rms_norm(cq, q_norm) @ w_uq).reshape(B, T, MLA_HEADS, MLA_NOPE + MLA_ROPE)
    qn, qr = q[..., :MLA_NOPE], q[..., MLA_NOPE:]
    if row is not None:
        qr = rope_2d(qr, row, col)
    return qn, qr


def mla_keys(ckv, kr, kv_norm, w_ukv, row, col):
    B, T = ckv.shape[:2]
    kv = (rms_norm(ckv, kv_norm) @ w_ukv).reshape(B, T, MLA_HEADS, MLA_NOPE + MLA_V)
    kn, v = kv[..., :MLA_NOPE], kv[..., MLA_NOPE:]
    if row is not None:
        kr = rope_2d(kr[:, :, None, :], row, col)[:, :, 0]
    return kn, kr, v


def mla_attend(qn, qr, kn, kr, v):
    s = jnp.einsum('bqhd,bkhd->bhqk', qn, kn) + jnp.einsum('bqhr,bkr->bhqk', qr, kr)
    p = jax.nn.softmax(s.astype(jnp.float32) * (MLA_NOPE + MLA_ROPE) ** -0.5, axis=-1).astype(v.dtype)
    return jnp.einsum('bhqk,bkhd->bqhd', p, v)


def mla_latent(qn, qr, kn, kr, v):
    B, S = qn.shape[:2]
    nb = S // MLA_BLOCK

    def blocks(t):
        return jnp.moveaxis(t.reshape((B, nb, MLA_BLOCK) + t.shape[2:]), 1, 0)

    o = lax.map(lambda qs: mla_attend(qs[0], qs[1], kn, kr, v), (blocks(qn), blocks(qr)))
    return jnp.moveaxis(o, 0, 1).reshape(B, S, MLA_HEADS * MLA_V)


def token_mixer(h, hc, w_in, w_out, swa_sink, conv_w, a_log, dt_bias, gdn_norm_w,
                q_norm, w_uq, kv_norm, w_ukv, row, col, ctx_out):
    B, S, _ = h.shape
    L = hc.shape[1]
    pl = split_proj(h @ w_in)
    pc = split_proj(hc @ w_in)
    qa = rope_2d(pl[0].reshape(B, S, SWA_HEADS, HEAD_DIM), row, col)
    ka = rope_2d(pl[1].reshape(B, S, SWA_KV_HEADS, HEAD_DIM), row, col)
    va = pl[2].reshape(B, S, SWA_KV_HEADS, HEAD_DIM)
    kca = pc[1].reshape(B, L, SWA_KV_HEADS, HEAD_DIM)
    vca = pc[2].reshape(B, L, SWA_KV_HEADS, HEAD_DIM)
    oa = swa_latent(qa, ka, va, kca, vca, swa_sink)
    featL = gdn_features(pl[3], pl[5], conv_w, a_log, dt_bias)
    featC = gdn_features(pc[3], pc[5], conv_w, a_log, dt_bias)
    obL, obC = gdn_bidirectional(featL, featC, ctx_out)
    ob = gdn_output(obL, pl[4], gdn_norm_w)
    qnL, qrL = mla_queries(pl[6], q_norm, w_uq, row, col)
    knL, krL, vL = mla_keys(pl[7], pl[8], kv_norm, w_ukv, row, col)
    knC, krC, vC = mla_keys(pc[7], pc[8], kv_norm, w_ukv, None, None)
    oc = mla_latent(qnL, qrL, jnp.concatenate([knL, knC], axis=1), jnp.concatenate([krL, krC], axis=1),
                    jnp.concatenate([vL, vC], axis=1))
    y = jnp.concatenate([oa, ob, oc], axis=-1) @ w_out
    if not ctx_out:
        return y, None
    oca = swa_context(pc[0].reshape(B, L, SWA_HEADS, HEAD_DIM), kca, vca, swa_sink)
    obc = gdn_output(obC, pc[4], gdn_norm_w)
    qnC, qrC = mla_queries(pc[6], q_norm, w_uq, None, None)
    occ = mla_attend(qnC, qrC, knC, krC, vC).reshape(B, L, MLA_HEADS * MLA_V)
    yc = jnp.concatenate([oca, obc, occ], axis=-1) @ w_out
    return y, yc


def swiglu(t, wg, wu, wd):
    return (jax.nn.silu(t @ wg) * (t @ wu)) @ wd


def route(h, router_w, router_bias):
    N = h.shape[0]
    scores = jax.nn.sigmoid((h @ router_w).astype(jnp.float32))
    sel = scores + router_bias.astype(jnp.float32)
    grouped = sel.reshape(N, MOE_GROUPS, N_EXPERTS // MOE_GROUPS)
    group_score = lax.top_k(grouped, 2)[0].sum(-1)
    _, top_groups = lax.top_k(group_score, MOE_TOPK_GROUPS)
    group_mask = jnp.any(top_groups[:, :, None] == jnp.arange(MOE_GROUPS)[None, None, :], axis=1)
    masked = jnp.where(jnp.repeat(group_mask, N_EXPERTS // MOE_GROUPS, axis=1), sel, -jnp.inf)
    _, top_idx = lax.top_k(masked, MOE_TOP_K)
    w = jnp.take_along_axis(scores, top_idx, axis=1)
    return top_idx, w / jnp.sum(w, axis=-1, keepdims=True) * ROUTED_SCALE


def moe_ffn(h, router_w, router_bias, w_gate, w_up, w_down, s_gate, s_up, s_down):
    N, D = h.shape
    top_idx, top_w = route(h, router_w, router_bias)
    NK = N * MOE_TOP_K
    e = top_idx.reshape(-1)
    tok = jnp.arange(NK, dtype=jnp.int32) // MOE_TOP_K
    wts = top_w.reshape(-1).astype(h.dtype)
    order = jnp.argsort(e)
    e_s = e[order]
    counts = jnp.bincount(e, length=N_EXPERTS)
    starts = jnp.cumsum(counts) - counts
    pcounts = (counts + MOE_BLOCK - 1) // MOE_BLOCK * MOE_BLOCK
    pends = jnp.cumsum(pcounts)
    dest = (pends - pcounts)[e_s] + jnp.arange(NK, dtype=jnp.int32) - starts[e_s]
    n_blocks = -(-NK // MOE_BLOCK) + N_EXPERTS
    P = n_blocks * MOE_BLOCK
    buf_tok = jnp.full((P,), N, jnp.int32).at[dest].set(tok[order])
    buf_w = jnp.zeros((P,), h.dtype).at[dest].set(wts[order])
    blk_exp = jnp.minimum(jnp.searchsorted(pends, jnp.arange(n_blocks) * MOE_BLOCK, side='right'), N_EXPERTS - 1)
    xb = jnp.concatenate([h, jnp.zeros((1, D), h.dtype)], axis=0)[buf_tok].reshape(n_blocks, MOE_BLOCK, D)
    yb = lax.map(lambda a: swiglu(a[0], w_gate[a[1]], w_up[a[1]], w_down[a[1]]), (xb, blk_exp))
    yb = yb.reshape(P, D) * buf_w[:, None]
    routed = jnp.zeros((N + 1, D), yb.dtype).at[buf_tok].add(yb)[:N]
    return swiglu(h, s_gate, s_up, s_down) + routed


def setup_inputs(seed: int = 0) -> dict:
    key = jax.random.key(seed)
    ks = iter(jax.random.split(key, 40))
    nrm = lambda shape, scale: scale * jax.random.normal(next(ks), shape, jnp.float32)
    gain = lambda shape: 1.0 + nrm(shape, 0.02)
    dt = jnp.exp(jax.random.uniform(next(ks), (DEPTH, 2, GDN_HEADS), jnp.float32,
                                    minval=math.log(1e-3), maxval=math.log(1e-1)))
    return {
        "x": nrm((BATCH, SEQ, D_MODEL), 1.0),
        "c": nrm((BATCH, D_MODEL), 1.0),
        "ctx": nrm((BATCH, CTX_LEN, D_MODEL), 1.0),
        "c_ctx": nrm((D_MODEL,), 1.0),
        "ada_w": nrm((DEPTH, D_MODEL, 6 * D_MODEL), 0.5 * D_MODEL ** -0.5),
        "ada_b": nrm((DEPTH, 6 * D_MODEL), 0.02),
        "mix_norm_pre": gain((DEPTH, D_MODEL)),
        "mix_norm_post": gain((DEPTH, D_MODEL)),
        "ffn_norm_pre": gain((DEPTH, D_MODEL)),
        "ffn_norm_post": gain((DEPTH, D_MODEL)),
        "w_in": nrm((DEPTH, D_MODEL, D_PROJ), D_MODEL ** -0.5),
        "w_out": nrm((DEPTH, D_MIX, D_MODEL), D_MIX ** -0.5),
        "swa_sink": nrm((DEPTH, SWA_HEADS), 0.5),
        "gdn_conv_w": nrm((DEPTH, GDN_CONV, GDN_QKV), GDN_CONV ** -0.5),
        "gdn_a_log": jnp.log(jax.random.uniform(next(ks), (DEPTH, 2, GDN_HEADS), jnp.float32, minval=1.0, maxval=16.0)),
        "gdn_dt_bias": dt + jnp.log(-jnp.expm1(-dt)),
        "gdn_norm_w": gain((DEPTH, GDN_DV)),
        "mla_q_norm": gain((DEPTH, MLA_Q_RANK)),
        "mla_w_uq": nrm((DEPTH, MLA_Q_RANK, MLA_HEADS * (MLA_NOPE + MLA_ROPE)), MLA_Q_RANK ** -0.5),
        "mla_kv_norm": gain((DEPTH, MLA_KV_RANK)),
        "mla_w_ukv": nrm((DEPTH, MLA_KV_RANK, MLA_HEADS * (MLA_NOPE + MLA_V)), MLA_KV_RANK ** -0.5),
        "router_w": nrm((DEPTH, D_MODEL, N_EXPERTS), D_MODEL ** -0.5),
        "router_bias": nrm((DEPTH, N_EXPERTS), 0.01),
        "expert_w_gate": nrm((DEPTH, N_EXPERTS, D_MODEL, D_EXPERT), D_MODEL ** -0.5),
        "expert_w_up": nrm((DEPTH, N_EXPERTS, D_MODEL, D_EXPERT), D_MODEL ** -0.5),
        "expert_w_down": nrm((DEPTH, N_EXPERTS, D_EXPERT, D_MODEL), D_EXPERT ** -0.5),
        "shared_w_gate": nrm((DEPTH, D_MODEL, D_SHARED), D_MODEL ** -0.5),
        "shared_w_up": nrm((DEPTH, D_MODEL, D_SHARED), D_MODEL ** -0.5),
        "shared_w_down": nrm((DEPTH, D_SHARED, D_MODEL), D_SHARED ** -0.5),
    }


def reference(x, c, ctx, c_ctx, ada_w, ada_b, mix_norm_pre, mix_norm_post, ffn_norm_pre, ffn_norm_post,
              w_in, w_out, swa_sink, gdn_conv_w, gdn_a_log, gdn_dt_bias, gdn_norm_w,
              mla_q_norm, mla_w_uq, mla_kv_norm, mla_w_ukv, router_w, router_bias,
              expert_w_gate, expert_w_up, expert_w_down, shared_w_gate, shared_w_up, shared_w_down):
    B, S, D = x.shape
    L = ctx.shape[1]
    row, col = grid_positions(S)
    for layer in range(DEPTH):
        last = layer == DEPTH - 1
        sh1, sc1, g1, sh2, sc2, g2 = [t[:, None, :] for t in modulation(c, ada_w[layer], ada_b[layer])]
        csh1, csc1, cg1, csh2, csc2, cg2 = modulation(c_ctx, ada_w[layer], ada_b[layer])
        h = rms_norm(x, mix_norm_pre[layer]) * (1.0 + sc1) + sh1
        hc = rms_norm(ctx, mix_norm_pre[layer]) * (1.0 + csc1) + csh1
        y, yc = token_mixer(h, hc, w_in[layer], w_out[layer], swa_sink[layer], gdn_conv_w[layer],
                            gdn_a_log[layer], gdn_dt_bias[layer], gdn_norm_w[layer], mla_q_norm[layer],
                            mla_w_uq[layer], mla_kv_norm[layer], mla_w_ukv[layer], row, col, not last)
        x = x + g1 * rms_norm(y, mix_norm_post[layer])
        moe_args = (router_w[layer], router_bias[layer], expert_w_gate[layer], expert_w_up[layer],
                    expert_w_down[layer], shared_w_gate[layer], shared_w_up[layer], shared_w_down[layer])
        h2 = rms_norm(x, ffn_norm_pre[layer]) * (1.0 + sc2) + sh2
        if last:
            f = moe_ffn(h2.reshape(B * S, D), *moe_args).reshape(B, S, D)
        else:
            ctx = ctx + cg1 * rms_norm(yc, mix_norm_post[layer])
            h2c = rms_norm(ctx, ffn_norm_pre[layer]) * (1.0 + csc2) + csh2
            f_all = moe_ffn(jnp.concatenate([h2.reshape(B * S, D), h2c.reshape(B * L, D)], axis=0), *moe_args)
            f, fc = f_all[:B * S].reshape(B, S, D), f_all[B * S:].reshape(B, L, D)
            ctx = ctx + cg2 * rms_norm(fc, ffn_norm_post[layer])
        x = x + g2 * rms_norm(f, ffn_norm_post[layer])
    return x
```

```cpp
#ifndef HOST_EMU
#include <hip/hip_runtime.h>
#include <hip/hip_cooperative_groups.h>
#include <cstdio>
#define HD __host__ __device__ __forceinline__
#else
#include <cmath>
#include <cstdio>
#include <cstring>
#define HD inline
#endif
#include <cstdint>
#include <utility>

#ifndef CFG_D
#define CFG_D 1024
#endif
#ifndef CFG_S
#define CFG_S 8192
#endif
#ifndef CFG_L
#define CFG_L 256
#endif
#ifndef CFG_DE
#define CFG_DE 256
#endif
#ifndef CFG_DS
#define CFG_DS 256
#endif
#ifndef PROBE_MASK
#define PROBE_MASK 0
#endif
#ifndef USE_KMOD
#define USE_KMOD 1
#endif
#ifndef USE_RNORM1
#define USE_RNORM1 1
#endif
#ifndef USE_RPOST1
#define USE_RPOST1 1
#endif
#ifndef USE_RPOST2
#define USE_RPOST2 1
#endif

namespace cfg {
constexpr int D = CFG_D, B = 2, S = CFG_S, L = CFG_L, DEPTH = 2, GRID_W = 64;
constexpr int T = B * S, TC = B * L, TA = T + TC;
constexpr int SWA_H = 6, SWA_KVH = 2, SWA_G = 3, SWA_W = 128;
constexpr int GH = 6, GDK = 64, GDV = 64, GCONV = 5;
constexpr int MH = 4, MQR = 192, MKVR = 128, MNOPE = 64, MROPE = 32, MV = 64, MQD = MNOPE + MROPE, MKVD = MNOPE + MV;
constexpr int DMIX = 1024, GQKV = 1152;
constexpr int PO_QA = 0, PO_KA = 384, PO_VA = 512, PO_GQKV = 640, PO_Z = 1792, PO_BA = 2176, PO_CQ = 2200, PO_CKV = 2392, PO_KR = 2520, DPROJ = 2552, DPROJP = 2560;
constexpr int NE = 64, TOPK = 8, NGRP = 8, TOPG = 4, DE = CFG_DE, DS = CFG_DS;
constexpr float EPS = 1e-6f, ROUTED_SCALE = 2.5f;
constexpr int NSLOT = TA * TOPK, NK = S + L, NCHAIN = B * GH * 2, NCH = (S + L) / 64;
static_assert(D % 128 == 0 && DE % 64 == 0 && DS % 64 == 0 && TA % 128 == 0 && T % 128 == 0, "tile divisibility");
}
using namespace cfg;

#ifdef HOST_EMU
typedef float st_t;
HD float ldf(const st_t* p) { return *p; }
HD void stf(st_t* p, float v) { *p = v; }
HD void st4(st_t* p, float a, float b, float c, float d) { p[0] = a; p[1] = b; p[2] = c; p[3] = d; }
#else
typedef unsigned short st_t;
typedef short bf16x8 __attribute__((ext_vector_type(8)));
typedef float f32x4 __attribute__((ext_vector_type(4)));
typedef float f32x2 __attribute__((ext_vector_type(2)));
typedef __bf16 bf16x2_t __attribute__((ext_vector_type(2)));
#define LAS __attribute__((address_space(3)))
HD float ldf(const st_t* p) { unsigned u = ((unsigned)*p) << 16; float f; __builtin_memcpy(&f, &u, 4); return f; }
HD unsigned short f2bf(float v) { unsigned u; __builtin_memcpy(&u, &v, 4); u = (u + 0x7fffu + ((u >> 16) & 1u)) >> 16; return (unsigned short)u; }
HD void stf(st_t* p, float v) { *p = f2bf(v); }
HD float ldf(const float* p) { return *p; }
HD void stf(float* p, float v) { *p = v; }
__device__ __forceinline__ unsigned pk_bf16(float lo, float hi) { f32x2 v = {lo, hi}; return __builtin_bit_cast(unsigned, __builtin_convertvector(v, bf16x2_t)); }
HD void st4(st_t* p, float a, float b, float c, float d) {
#if defined(__HIP_DEVICE_COMPILE__)
    uint2 w; w.x = pk_bf16(a, b); w.y = pk_bf16(c, d); *(uint2*)p = w;
#else
    p[0] = f2bf(a); p[1] = f2bf(b); p[2] = f2bf(c); p[3] = f2bf(d);
#endif
}
#endif

HD float silu_f(float x) { return x / (1.0f + expf(-x)); }
HD float sigmoid_f(float x) { return 1.0f / (1.0f + expf(-x)); }
HD float softplus_f(float x) { return x > 20.f ? x : log1pf(expf(x)); }

struct TJob { const float* src; st_t* dst; int K, N, npad, grp, off, ldt; };
constexpr int NJOBS = 14;

struct Params {
    const float *x, *c, *ctx, *c_ctx, *ada_w, *ada_b, *mix_norm_pre, *mix_norm_post, *ffn_norm_pre, *ffn_norm_post,
        *w_in, *w_out, *swa_sink, *gdn_conv_w, *gdn_a_log, *gdn_dt_bias, *gdn_norm_w, *mla_q_norm, *mla_w_uq, *mla_kv_norm, *mla_w_ukv,
        *router_w, *router_bias, *e_gate, *e_up, *e_down, *s_gate, *s_up, *s_down;
    float* out;
    float *MOD, *XC, *BG, *LOGITS, *EW, *WLIST, *GAM;
    int *EIDX, *EPOS, *CNT, *TOKLIST, *CTR;
    st_t *H, *P, *G, *CQN, *CKVN, *MQ, *MKV, *O, *Y, *SACT, *ACT, *YB, *SH, *VtM, *VtA, *OF, *OB, *CH;
    st_t *Wt_in, *Wt_out, *Wt_uq, *Wt_ukv, *Wt_sgu, *Wt_sd, *Wt_egu, *Wt_ed;
    TJob jobs[NJOBS];
};

HD size_t align256(size_t v) { return (v + 255) & ~(size_t)255; }
inline size_t carve(Params& p, char* ws) {
    size_t off = 0;
    auto take = [&](size_t bytes) { size_t o = off; off = align256(off + bytes); return ws ? ws + o : (char*)nullptr; };
    const size_t E = sizeof(st_t);
    p.MOD = (float*)take((size_t)DEPTH * 3 * 6 * D * 4);
    p.XC = (float*)take((size_t)TC * D * 4);
    p.BG = (float*)take((size_t)TA * 24 * 4);
    p.LOGITS = (float*)take((size_t)TA * NE * 4);
    p.EW = (float*)take((size_t)TA * TOPK * 4);
    p.EIDX = (int*)take((size_t)TA * TOPK * 4);
    p.EPOS = (int*)take((size_t)TA * TOPK * 4);
    p.CNT = (int*)take((size_t)DEPTH * NE * 4);
    p.CTR = (int*)take((size_t)DEPTH * 16 * 4);
    p.GAM = (float*)take((size_t)NCHAIN * NCH * 4);
    p.TOKLIST = (int*)take((size_t)NE * TA * 4);
    p.WLIST = (float*)take((size_t)NE * TA * 4);
    p.H = (st_t*)take((size_t)TA * D * E);
    p.SH = p.H;
    p.Wt_in = (st_t*)take((size_t)DEPTH * DPROJP * D * E);
    p.Wt_out = (st_t*)take((size_t)DEPTH * D * DMIX * E);
    p.Wt_uq = (st_t*)take((size_t)DEPTH * MH * MQD * MQR * E);
    p.Wt_ukv = (st_t*)take((size_t)DEPTH * MH * MKVD * MKVR * E);
    p.Wt_sgu = (st_t*)take((size_t)DEPTH * 2 * DS * D * E);
    p.Wt_sd = (st_t*)take((size_t)DEPTH * D * DS * E);
    const size_t q0 = off;
    p.SACT = (st_t*)take((size_t)TA * DS * E);
    p.ACT = (st_t*)take((size_t)NSLOT * DE * E > (size_t)TA * D * E ? (size_t)NSLOT * DE * E : (size_t)TA * D * E);
    p.Y = p.ACT;
    p.Wt_egu = (st_t*)take((size_t)NE * 2 * DE * D * E);
    p.Wt_ed = (st_t*)take((size_t)NE * D * DE * E);
    p.CH = (st_t*)(ws ? ws + q0 : nullptr);
    { const size_t chb = align256((size_t)NCHAIN * NCH * 5 * 4096 * E); if (q0 + chb > off) off = q0 + chb; }
    const size_t r0 = off;
    p.P = (st_t*)take((size_t)TA * DPROJP * E);
    p.G = (st_t*)take((size_t)TA * GQKV * E);
    p.CQN = (st_t*)take((size_t)TA * MQR * E);
    p.CKVN = (st_t*)take((size_t)TA * MKVR * E);
    p.MQ = (st_t*)take((size_t)TA * MH * MQD * E);
    p.MKV = (st_t*)take((size_t)TA * MH * MKVD * E);
    p.O = (st_t*)take((size_t)TA * DMIX * E);
    p.VtM = (st_t*)take((size_t)B * MH * MV * NK * E);
    p.VtA = (st_t*)take((size_t)B * SWA_KVH * 64 * NK * E);
    p.OF = (st_t*)take((size_t)TA * GH * GDV * E);
    p.OB = (st_t*)take((size_t)TA * GH * GDV * E);
    const size_t r1 = off;
    p.YB = (st_t*)(ws ? ws + r0 : nullptr);
    const size_t ybytes = align256((size_t)NSLOT * D * E);
    if (r0 + ybytes > r1) off = r0 + ybytes;
    return off;
}
inline void build_jobs(Params& p) {
    int n = 0;
    for (int l = 0; l < DEPTH; ++l) {
        p.jobs[n++] = {p.w_in + (size_t)l * D * DPROJ, p.Wt_in + (size_t)l * DPROJP * D, D, DPROJ, DPROJP, 16, 0, D};
        p.jobs[n++] = {p.w_out + (size_t)l * DMIX * D, p.Wt_out + (size_t)l * D * DMIX, DMIX, D, D, 16, 0, DMIX};
        p.jobs[n++] = {p.mla_w_uq + (size_t)l * MQR * MH * MQD, p.Wt_uq + (size_t)l * MH * MQD * MQR, MQR, MH * MQD, MH * MQD, 16, 0, MQR};
        p.jobs[n++] = {p.mla_w_ukv + (size_t)l * MKVR * MH * MKVD, p.Wt_ukv + (size_t)l * MH * MKVD * MKVR, MKVR, MH * MKVD, MH * MKVD, 16, 0, MKVR};
        p.jobs[n++] = {p.s_gate + (size_t)l * D * DS, p.Wt_sgu + (size_t)l * 2 * DS * D, D, DS, DS, 32, 0, D};
        p.jobs[n++] = {p.s_up + (size_t)l * D * DS, p.Wt_sgu + (size_t)l * 2 * DS * D, D, DS, DS, 32, 16, D};
        p.jobs[n++] = {p.s_down + (size_t)l * DS * D, p.Wt_sd + (size_t)l * D * DS, DS, D, D, 16, 0, DS};
    }
}

HD int mod_which(int r) { return r < T ? r / S : 2; }
HD const float* mod_vec(const Params& p, int layer, int r, int chunk) { return p.MOD + ((size_t)(layer * 3 + mod_which(r)) * 6 + chunk) * D; }
HD void seq_bounds(int r, int& lo, int& hi) { if (r < T) { lo = (r / S) * S; hi = lo + S; } else { lo = T + ((r - T) / L) * L; hi = lo + L; } }
HD float* xrow(const Params& p, int r) { return r < T ? p.out + (size_t)r * D : p.XC + (size_t)(r - T) * D; }
HD const float* xin_row(const Params& p, int layer, int r) { if (layer > 0) return xrow(p, r); return r < T ? p.x + (size_t)r * D : p.ctx + (size_t)(r - T) * D; }
HD int rows_out(int layer) { return layer == DEPTH - 1 ? T : TA; }
HD int expert_base(const int* cnt, int e) { int b = 0; for (int i = 0; i < e; ++i) b += cnt[i]; return b; }

#ifdef HOST_EMU
inline int atomic_inc(int* p) { int v;
#pragma omp atomic capture
    { v = *p; *p += 1; }
    return v; }
#else
__device__ __forceinline__ int atomic_inc(int* p) { return atomicAdd(p, 1); }
#endif

enum Stage { ST_MOD = 0, ST_ZERO, ST_NORM1, ST_ROPE_SWA, ST_GDN_CONV, ST_GDN_L2, ST_GDN_GATE, ST_MLA_NORM, ST_ROPE_MLA,
             ST_SWA, ST_GDN_SCAN, ST_GDN_OUT, ST_MLA, ST_POST1, ST_ROUTER, ST_ROUTE, ST_POST2, ST_VT, ST_COUNT };

HD long long n_items(int st, int layer) {
    switch (st) {
    case ST_MOD: return (long long)DEPTH * 3 * 6 * D;
    case ST_ZERO: return DEPTH * NE + DEPTH * 16;
    case ST_VT: return (long long)(B * MH + B * SWA_KVH) * (NK / 8) * 64;
    case ST_NORM1: return TA;
    case ST_ROPE_SWA: return (long long)T * 8 * 32;
    case ST_GDN_CONV: return (long long)TA * GQKV;
    case ST_GDN_L2: return (long long)TA * 12;
    case ST_GDN_GATE: return (long long)TA * 12;
    case ST_MLA_NORM: return (long long)TA * 2;
    case ST_ROPE_MLA: return (long long)T * 5 * 16;
    case ST_SWA: return (long long)rows_out(layer) * SWA_H;
    case ST_GDN_SCAN: return (long long)B * GH * 2 * GDV;
    case ST_GDN_OUT: return (long long)rows_out(layer) * GH;
    case ST_MLA: return (long long)rows_out(layer) * MH;
    case ST_POST1: return rows_out(layer);
    case ST_ROUTER: return (long long)rows_out(layer) * NE;
    case ST_ROUTE: return rows_out(layer);
    case ST_POST2: return rows_out(layer);
    }
    return 0;
}

HD float rope_inv(int i, int n) { return powf(10000.0f, -(float)i / (float)n); }

HD void run_item(const Params& p, int st, int layer, long long i) {
    switch (st) {
    case ST_MOD: {
        const int j = (int)(i % (6 * D)); const int w = (int)((i / (6 * D)) % 3); const int ly = (int)(i / (6 * D * 3));
        const float* cv = w < 2 ? p.c + (size_t)w * D : p.c_ctx;
        const float* W = p.ada_w + (size_t)ly * D * 6 * D;
        float acc = p.ada_b[(size_t)ly * 6 * D + j];
        for (int k = 0; k < D; ++k) acc += silu_f(cv[k]) * W[(size_t)k * 6 * D + j];
        p.MOD[i] = acc;
    } break;
    case ST_ZERO: if (i < DEPTH * NE) p.CNT[i] = 0; else p.CTR[i - DEPTH * NE] = 0; break;
    case ST_VT: {
        const int dv = (int)(i % 64); long long r = i / 64; const int kc = (int)(r % (NK / 8)); const int bh = (int)(r / (NK / 8));
        const bool mla = bh < B * MH; const int b = mla ? bh / MH : (bh - B * MH) / SWA_KVH, hd = mla ? bh % MH : (bh - B * MH) % SWA_KVH;
        st_t* dst = (mla ? p.VtM + ((size_t)(b * MH + hd) * 64 + dv) * NK : p.VtA + ((size_t)(b * SWA_KVH + hd) * 64 + dv) * NK) + kc * 8;
        for (int j = 0; j < 8; ++j) { const int kidx = kc * 8 + j; const int row = kidx < S ? b * S + kidx : T + b * L + (kidx - S);
            dst[j] = mla ? p.MKV[(size_t)row * MH * MKVD + hd * MKVD + MNOPE + dv] : p.P[(size_t)row * DPROJP + PO_VA + hd * 64 + dv]; }
    } break;
    case ST_NORM1: {
        const int r = (int)i; const float* xr = xin_row(p, layer, r); float ss = 0.f;
        for (int d = 0; d < D; ++d) ss += xr[d] * xr[d];
        const float rstd = 1.0f / sqrtf(ss / D + EPS);
        const float* gain = p.mix_norm_pre + (size_t)layer * D; const float* sh = mod_vec(p, layer, r, 0); const float* sc = mod_vec(p, layer, r, 1);
        st_t* hr = p.H + (size_t)r * D;
        for (int d = 0; d < D; ++d) stf(hr + d, xr[d] * rstd * gain[d] * (1.0f + sc[d]) + sh[d]);
    } break;
    case ST_ROPE_SWA: {
        const int j = (int)(i % 32), hh = (int)((i / 32) % 8), r = (int)(i / 256);
        const int s = r % S, rp = s / GRID_W, cp = s % GRID_W;
        const int base = hh < 6 ? PO_QA + hh * 64 : PO_KA + (hh - 6) * 64;
        const int half = j / 16, ii = j % 16; const int i1 = base + half * 32 + ii, i2 = i1 + 16;
        const float ang = (float)(half == 0 ? rp : cp) * rope_inv(ii, 16); const float cs = cosf(ang), sn = sinf(ang);
        st_t* pr = p.P + (size_t)r * DPROJP; const float x1 = ldf(pr + i1), x2 = ldf(pr + i2);
        stf(pr + i1, x1 * cs - x2 * sn); stf(pr + i2, x1 * sn + x2 * cs);
    } break;
    case ST_GDN_CONV: {
        const int cc = (int)(i % GQKV), r = (int)(i / GQKV); int lo, hi; seq_bounds(r, lo, hi);
        const float* w = p.gdn_conv_w + (size_t)layer * GCONV * GQKV; float acc = 0.f;
        for (int j = 0; j < GCONV; ++j) { const int rr = r + j - 2; if (rr >= lo && rr < hi) acc += w[j * GQKV + cc] * ldf(p.P + (size_t)rr * DPROJP + PO_GQKV + cc); }
        stf(p.G + (size_t)r * GQKV + cc, silu_f(acc));
    } break;
    case ST_GDN_L2: {
        const int hh = (int)(i % 12), r = (int)(i / 12); st_t* g = p.G + (size_t)r * GQKV + hh * 64; float ss = 0.f;
        for (int d = 0; d < 64; ++d) { const float v = ldf(g + d); ss += v * v; }
        const float rn = 1.0f / sqrtf(ss + EPS);
        for (int d = 0; d < 64; ++d) stf(g + d, ldf(g + d) * rn);
    } break;
    case ST_GDN_GATE: {
        const int j = (int)(i % 12), r = (int)(i / 12); const st_t* pr = p.P + (size_t)r * DPROJP + PO_BA;
        const float beta = sigmoid_f(ldf(pr + j)); const float a = ldf(pr + 12 + j);
        const float g = -expf(p.gdn_a_log[layer * 12 + j]) * softplus_f(a + p.gdn_dt_bias[layer * 12 + j]);
        p.BG[(size_t)r * 24 + j] = beta; p.BG[(size_t)r * 24 + 12 + j] = g;
    } break;
    case ST_MLA_NORM: {
        const int w = (int)(i % 2), r = (int)(i / 2);
        const int n = w == 0 ? MQR : MKVR; const st_t* src = p.P + (size_t)r * DPROJP + (w == 0 ? PO_CQ : PO_CKV);
        const float* gain = w == 0 ? p.mla_q_norm + (size_t)layer * MQR : p.mla_kv_norm + (size_t)layer * MKVR;
        st_t* dst = w == 0 ? p.CQN + (size_t)r * MQR : p.CKVN + (size_t)r * MKVR; float ss = 0.f;
        for (int d = 0; d < n; ++d) { const float v = ldf(src + d); ss += v * v; }
        const float rstd = 1.0f / sqrtf(ss / n + EPS);
        for (int d = 0; d < n; ++d) stf(dst + d, ldf(src + d) * rstd * gain[d]);
    } break;
    case ST_ROPE_MLA: {
        const int j = (int)(i % 16), w = (int)((i / 16) % 5), r = (int)(i / 80);
        const int s = r % S, rp = s / GRID_W, cp = s % GRID_W;
        const int half = j / 8, ii = j % 8; const float ang = (float)(half == 0 ? rp : cp) * rope_inv(ii, 8); const float cs = cosf(ang), sn = sinf(ang);
        st_t* q = w < 4 ? p.MQ + (size_t)r * MH * MQD + w * MQD + MNOPE + half * 16 + ii : p.P + (size_t)r * DPROJP + PO_KR + half * 16 + ii;
        const float x1 = ldf(q), x2 = ldf(q + 8); stf(q, x1 * cs - x2 * sn); stf(q + 8, x1 * sn + x2 * cs);
    } break;
    case ST_SWA: {
        const int h = (int)(i % SWA_H), r = (int)(i / SWA_H); const int kvh = h / SWA_G;
        float q[64], acc[64]; const st_t* qp = p.P + (size_t)r * DPROJP + PO_QA + h * 64;
        _Pragma("unroll") for (int d = 0; d < 64; ++d) { q[d] = ldf(qp + d) * 0.125f; acc[d] = 0.f; }
        float m = p.swa_sink[layer * SWA_H + h], den = 1.0f;
        int b, klo = 0, khi = 0;
        if (r < T) { b = r / S; const int s = r % S; klo = s - SWA_W < 0 ? 0 : s - SWA_W; khi = s + SWA_W > S - 1 ? S - 1 : s + SWA_W; } else { b = (r - T) / L; khi = -1; }
        const int nloc = khi - klo + 1;
        for (int t = 0; t < nloc + L; ++t) {
            const int kr = t < nloc ? b * S + klo + t : T + b * L + (t - nloc);
            const st_t* kp = p.P + (size_t)kr * DPROJP + PO_KA + kvh * 64; const st_t* vp = p.P + (size_t)kr * DPROJP + PO_VA + kvh * 64;
            float sc = 0.f; _Pragma("unroll") for (int d = 0; d < 64; ++d) sc += q[d] * ldf(kp + d);
            if (sc > m) { const float f = expf(m - sc); den *= f; _Pragma("unroll") for (int d = 0; d < 64; ++d) acc[d] *= f; m = sc; }
            const float pe = expf(sc - m); den += pe;
            _Pragma("unroll") for (int d = 0; d < 64; ++d) acc[d] += pe * ldf(vp + d);
        }
        const float inv = 1.0f / den; st_t* o = p.O + (size_t)r * DMIX + h * 64;
        _Pragma("unroll") for (int d = 0; d < 64; ++d) stf(o + d, acc[d] * inv);
    } break;
    case ST_GDN_SCAN: {
        const int e = (int)(i % GDV), dir = (int)((i / GDV) % 2), h = (int)((i / (GDV * 2)) % GH), b = (int)(i / (GDV * 2 * GH));
        float s[64]; _Pragma("unroll") for (int d = 0; d < 64; ++d) s[d] = 0.f;
        st_t* dst = dir == 0 ? p.OF : p.OB;
        for (int t = 0; t < L + S; ++t) {
            int r; if (t < L) r = T + b * L + (dir == 0 ? t : L - 1 - t); else { const int u = t - L; r = b * S + (dir == 0 ? u : S - 1 - u); }
            const st_t* g = p.G + (size_t)r * GQKV; const st_t* qv = g + h * 64; const st_t* kv = g + 384 + h * 64; const float v = ldf(g + 768 + h * 64 + e);
            const float beta = p.BG[(size_t)r * 24 + dir * 6 + h], alpha = expf(p.BG[(size_t)r * 24 + 12 + dir * 6 + h]);
            float ks = 0.f; _Pragma("unroll") for (int d = 0; d < 64; ++d) { s[d] *= alpha; ks += ldf(kv + d) * s[d]; }
            const float vn = beta * (v - ks); float o = 0.f;
            _Pragma("unroll") for (int d = 0; d < 64; ++d) { s[d] += ldf(kv + d) * vn; o += ldf(qv + d) * s[d]; }
            stf(dst + (size_t)r * (GH * GDV) + h * 64 + e, o * 0.125f);
        }
    } break;
    case ST_GDN_OUT: {
        const int h = (int)(i % GH), r = (int)(i / GH); const st_t* of = p.OF + (size_t)r * 384 + h * 64; const st_t* ob = p.OB + (size_t)r * 384 + h * 64;
        float ss = 0.f; for (int d = 0; d < 64; ++d) { const float o = ldf(of + d) + ldf(ob + d); ss += o * o; }
        const float rstd = 1.0f / sqrtf(ss / 64 + EPS); const float* nw = p.gdn_norm_w + layer * 64; const st_t* z = p.P + (size_t)r * DPROJP + PO_Z + h * 64;
        st_t* o = p.O + (size_t)r * DMIX + 384 + h * 64;
        for (int d = 0; d < 64; ++d) stf(o + d, (ldf(of + d) + ldf(ob + d)) * rstd * nw[d] * silu_f(ldf(z + d)));
    } break;
    case ST_MLA: {
        const int h = (int)(i % MH), r = (int)(i / MH); const float scale = 1.0f / sqrtf((float)MQD);
        float acc[64]; const st_t* qp = p.MQ + (size_t)r * MH * MQD + h * MQD;
        _Pragma("unroll") for (int d = 0; d < 64; ++d) acc[d] = 0.f;
        float m = -1e30f, den = 0.f; int b, nlat;
        if (r < T) { b = r / S; nlat = S; } else { b = (r - T) / L; nlat = 0; }
        for (int t = 0; t < nlat + L; ++t) {
            const int kr = t < nlat ? b * S + t : T + b * L + (t - nlat);
            const st_t* kn = p.MKV + (size_t)kr * MH * MKVD + h * MKVD; const st_t* krp = p.P + (size_t)kr * DPROJP + PO_KR;
            float sc = 0.f; for (int d = 0; d < 64; ++d) sc += ldf(qp + d) * ldf(kn + d);
            for (int d = 0; d < 32; ++d) sc += ldf(qp + 64 + d) * ldf(krp + d);
            sc *= scale;
            if (sc > m) { const float f = expf(m - sc); den *= f; _Pragma("unroll") for (int d = 0; d < 64; ++d) acc[d] *= f; m = sc; }
            const float pe = expf(sc - m); den += pe;
            _Pragma("unroll") for (int d = 0; d < 64; ++d) acc[d] += pe * ldf(kn + 64 + d);
        }
        const float inv = 1.0f / den; st_t* o = p.O + (size_t)r * DMIX + 768 + h * 64;
        _Pragma("unroll") for (int d = 0; d < 64; ++d) stf(o + d, acc[d] * inv);
    } break;
    case ST_POST1: {
        const int r = (int)i; const st_t* y = p.Y + (size_t)r * D; const float* xi = xin_row(p, layer, r); float* xr = xrow(p, r); float ss = 0.f;
        for (int d = 0; d < D; ++d) { const float v = ldf(y + d); ss += v * v; }
        const float rstd = 1.0f / sqrtf(ss / D + EPS); const float* gp = p.mix_norm_post + (size_t)layer * D; const float* g1 = mod_vec(p, layer, r, 2);
        float s2 = 0.f;
        for (int d = 0; d < D; ++d) { const float v = xi[d] + g1[d] * ldf(y + d) * rstd * gp[d]; xr[d] = v; s2 += v * v; }
        const float r2 = 1.0f / sqrtf(s2 / D + EPS); const float* gf = p.ffn_norm_pre + (size_t)layer * D; const float* sh = mod_vec(p, layer, r, 3); const float* sc = mod_vec(p, layer, r, 4);
        st_t* hr = p.H + (size_t)r * D;
        for (int d = 0; d < D; ++d) stf(hr + d, xr[d] * r2 * gf[d] * (1.0f + sc[d]) + sh[d]);
    } break;
    case ST_ROUTER: {
        const int n = (int)(i % NE), r = (int)(i / NE); const st_t* a = p.H + (size_t)r * D; const float* b = p.router_w + (size_t)layer * D * NE + n; float acc = 0.f;
        for (int k = 0; k < D; ++k) acc += ldf(a + k) * b[(size_t)k * NE];
        p.LOGITS[(size_t)r * NE + n] = acc;
    } break;
    case ST_ROUTE: {
        const int r = (int)i; const float* lg = p.LOGITS + (size_t)r * NE; const float* bias = p.router_bias + (size_t)layer * NE;
        float gs[NGRP];
        _Pragma("unroll") for (int g = 0; g < NGRP; ++g) { float m1 = -1e30f, m2 = -1e30f; for (int j = 0; j < 8; ++j) { const float v = sigmoid_f(lg[g * 8 + j]) + bias[g * 8 + j]; if (v > m1) { m2 = m1; m1 = v; } else if (v > m2) m2 = v; } gs[g] = m1 + m2; }
        unsigned gmask = 0;
        _Pragma("unroll") for (int k = 0; k < TOPG; ++k) { int best = 0; float bv = -1e30f; _Pragma("unroll") for (int g = 0; g < NGRP; ++g) if (!((gmask >> g) & 1u) && gs[g] > bv) { bv = gs[g]; best = g; } gmask |= 1u << best; }
        unsigned long long used = 0ull; float wsum = 0.f; float wv[TOPK]; int wi[TOPK];
        _Pragma("unroll") for (int k = 0; k < TOPK; ++k) { int best = 0; float bv = -1e30f;
            for (int e = 0; e < NE; ++e) if (((gmask >> (e / 8)) & 1u) && !((used >> e) & 1ull)) { const float v = sigmoid_f(lg[e]) + bias[e]; if (v > bv) { bv = v; best = e; } }
            used |= 1ull << best; wi[k] = best; wv[k] = sigmoid_f(lg[best]); wsum += wv[k]; }
        int* cnt = p.CNT + layer * NE;
        _Pragma("unroll") for (int k = 0; k < TOPK; ++k) { const float w = wv[k] / wsum * ROUTED_SCALE; const int e = wi[k]; const int pos = atomic_inc(cnt + e);
            p.EIDX[(size_t)r * TOPK + k] = e; p.EW[(size_t)r * TOPK + k] = w; p.EPOS[(size_t)r * TOPK + k] = pos; p.TOKLIST[(size_t)e * TA + pos] = r; p.WLIST[(size_t)e * TA + pos] = w; }
    } break;
    case ST_POST2: {
        const int r = (int)i; float* xr = xrow(p, r); const int* cnt = p.CNT + layer * NE; const st_t* f[TOPK + 1]; f[0] = p.SH + (size_t)r * D;
        _Pragma("unroll") for (int k = 0; k < TOPK; ++k) { const int e = p.EIDX[(size_t)r * TOPK + k]; f[k + 1] = p.YB + (size_t)(expert_base(cnt, e) + p.EPOS[(size_t)r * TOPK + k]) * D; }
        float ss = 0.f;
        for (int d = 0; d < D; ++d) { float v = 0.f; _Pragma("unroll") for (int k = 0; k <= TOPK; ++k) v += ldf(f[k] + d); ss += v * v; }
        const float rstd = 1.0f / sqrtf(ss / D + EPS); const float* gp = p.ffn_norm_post + (size_t)layer * D; const float* g2 = mod_vec(p, layer, r, 5);
        for (int d = 0; d < D; ++d) { float v = 0.f; _Pragma("unroll") for (int k = 0; k <= TOPK; ++k) v += ldf(f[k] + d); xr[d] = xr[d] + g2[d] * v * rstd * gp[d]; }
    } break;
    }
}

enum { WT_STATIC = 0, WT_EXPERT = 1 };
HD long long wt_items(const Params& p, int kind) {
    if (kind == WT_STATIC) { long long n = 0; for (int j = 0; j < NJOBS; ++j) n += (long long)(p.jobs[j].K / 64) * ((p.jobs[j].npad + 31) / 32); return n; }
    return (long long)NE * ((D / 64) * (DE / 32) * 2 + (DE / 64) * (D / 32));
}
HD bool wt_job(const Params& p, int kind, int layer, long long item, TJob& jb, int& kb, int& nb) {
    if (kind == WT_STATIC) {
        for (int j = 0; j < NJOBS; ++j) { const long long n = (long long)(p.jobs[j].K / 64) * ((p.jobs[j].npad + 31) / 32); if (item < n) { jb = p.jobs[j]; const int nblk = (jb.npad + 31) / 32; kb = (int)(item / nblk); nb = (int)(item % nblk); return true; } item -= n; }
        return false;
    }
    const int per_gu = (D / 64) * (DE / 32), per_d = (DE / 64) * (D / 32), per_e = 2 * per_gu + per_d;
    const int e = (int)(item / per_e); int r = (int)(item % per_e);
    if (r < 2 * per_gu) { const int w = r / per_gu; r %= per_gu; const float* src = (w == 0 ? p.e_gate : p.e_up) + ((size_t)layer * NE + e) * D * DE;
        jb = {src, p.Wt_egu + (size_t)e * 2 * DE * D, D, DE, DE, 32, w * 16, D}; kb = r / (DE / 32); nb = r % (DE / 32); }
    else { r -= 2 * per_gu; jb = {p.e_down + ((size_t)layer * NE + e) * DE * D, p.Wt_ed + (size_t)e * D * DE, DE, D, D, 16, 0, DE}; kb = r / (D / 32); nb = r % (D / 32); }
    return true;
}
HD size_t wt_dst_row(const TJob& jb, int n) { return (size_t)(n / 16) * jb.grp + (n % 16) + jb.off; }
#ifdef HOST_EMU
inline void wt_item_host(const Params& p, int kind, int layer, long long item) {
    TJob jb; int kb, nb; if (!wt_job(p, kind, layer, item, jb, kb, nb)) return;
    for (int n = nb * 32; n < nb * 32 + 32 && n < jb.npad; ++n) for (int k = kb * 64; k < kb * 64 + 64; ++k)
        jb.dst[wt_dst_row(jb, n) * jb.ldt + k] = n < jb.N ? jb.src[(size_t)k * jb.N + n] : 0.f;
}
#else
__device__ __forceinline__ void wt_item_dev(const Params& p, int kind, int layer, long long item, LAS float* scr, int lane) {
    TJob jb; int kb, nb; if (!wt_job(p, kind, layer, item, jb, kb, nb)) return;
    const int k0 = kb * 64, n0 = nb * 32;
#pragma unroll 8
    for (int i = 0; i < 32; ++i) { const int kk = 2 * i + (lane >> 5), n = n0 + (lane & 31); scr[kk * 33 + (lane & 31)] = n < jb.N ? jb.src[(size_t)(k0 + kk) * jb.N + n] : 0.f; }
    asm volatile("s_waitcnt lgkmcnt(0)" ::: "memory");
    const int c = lane & 7;
#pragma unroll
    for (int j = 0; j < 4; ++j) { const int nl = (lane >> 3) + 8 * j, n = n0 + nl; const LAS float* s = scr + (8 * c) * 33 + nl;
        if (n < jb.npad) { uint4 o; o.x = pk_bf16(s[0 * 33], s[1 * 33]); o.y = pk_bf16(s[2 * 33], s[3 * 33]); o.z = pk_bf16(s[4 * 33], s[5 * 33]); o.w = pk_bf16(s[6 * 33], s[7 * 33]);
            *(uint4*)(jb.dst + wt_dst_row(jb, n) * jb.ldt + k0 + 8 * c) = o; } }
    asm volatile("s_waitcnt lgkmcnt(0)" ::: "memory");
}
#endif

enum { EPI_BF16 = 0, EPI_SWIGLU = 1, EPI_SCALE = 2 };
enum GStage { G_PROJ = 0, G_UQ, G_UKV, G_WOUT, G_SGU, G_SDOWN, G_EGU, G_EDOWN };
struct GemmDesc {
    const st_t* A; int lda; const int* rowidx; int a_row0, nrows;
    const st_t* Bt; int ldb, K, n0;
    int epi; st_t* out; int ldc; long long out_row0; const float* rowscale;
};
HD int cdiv(int a, int b) { return (a + b - 1) / b; }
HD int gemm_ntiles(const Params& p, int gs, int layer) {
    const int mt = rows_out(layer) / 128;
    switch (gs) {
    case G_PROJ: return (TA / 128) * (DPROJP / 128);
    case G_UQ: return (TA / 128) * (MH * MQD / 128);
    case G_UKV: return (TA / 128) * (MH * MKVD / 128);
    case G_WOUT: return mt * (D / 128);
    case G_SGU: return mt * (2 * DS / 128);
    case G_SDOWN: return mt * (D / 128);
    case G_EGU: { int t = 0; for (int e = 0; e < NE; ++e) t += cdiv(p.CNT[layer * NE + e], 128); return t * (2 * DE / 128); }
    case G_EDOWN: { int t = 0; for (int e = 0; e < NE; ++e) t += cdiv(p.CNT[layer * NE + e], 128); return t * (D / 128); }
    }
    return 0;
}
HD void gemm_desc(const Params& p, int gs, int layer, int item, GemmDesc& g) {
    g.rowidx = nullptr; g.rowscale = nullptr; g.nrows = 128; g.epi = EPI_BF16;
    auto plain = [&](const st_t* A, int lda, const st_t* Bt, int K, int ntn, st_t* out, int ldc) {
        const int mt = item / ntn, nt = item % ntn; g.A = A; g.lda = lda; g.a_row0 = mt * 128; g.Bt = Bt; g.ldb = K; g.K = K; g.n0 = nt * 128; g.out = out; g.ldc = ldc; g.out_row0 = mt * 128; };
    switch (gs) {
    case G_PROJ: plain(p.H, D, p.Wt_in + (size_t)layer * DPROJP * D, D, DPROJP / 128, p.P, DPROJP); break;
    case G_UQ: plain(p.CQN, MQR, p.Wt_uq + (size_t)layer * MH * MQD * MQR, MQR, MH * MQD / 128, p.MQ, MH * MQD); break;
    case G_UKV: plain(p.CKVN, MKVR, p.Wt_ukv + (size_t)layer * MH * MKVD * MKVR, MKVR, MH * MKVD / 128, p.MKV, MH * MKVD); break;
    case G_WOUT: plain(p.O, DMIX, p.Wt_out + (size_t)layer * D * DMIX, DMIX, D / 128, p.Y, D); break;
    case G_SGU: plain(p.H, D, p.Wt_sgu + (size_t)layer * 2 * DS * D, D, 2 * DS / 128, p.SACT, DS); g.epi = EPI_SWIGLU; break;
    case G_SDOWN: plain(p.SACT, DS, p.Wt_sd + (size_t)layer * D * DS, DS, D / 128, p.SH, D); break;
    case G_EGU: case G_EDOWN: {
        const int ntn = gs == G_EGU ? 2 * DE / 128 : D / 128; int mt = item / ntn; const int nt = item % ntn; const int* cnt = p.CNT + layer * NE;
        int e = 0, base = 0; for (; e < NE; ++e) { const int te = cdiv(cnt[e], 128); if (mt < te) break; mt -= te; base += cnt[e]; }
        g.a_row0 = mt * 128; g.nrows = cnt[e] - mt * 128 < 128 ? cnt[e] - mt * 128 : 128; g.n0 = nt * 128; g.out_row0 = base + mt * 128;
        if (gs == G_EGU) { g.A = p.H; g.lda = D; g.rowidx = p.TOKLIST + (size_t)e * TA; g.Bt = p.Wt_egu + (size_t)e * 2 * DE * D; g.ldb = D; g.K = D; g.epi = EPI_SWIGLU; g.out = p.ACT; g.ldc = DE; }
        else { g.A = p.ACT + (size_t)base * DE; g.lda = DE; g.Bt = p.Wt_ed + (size_t)e * D * DE; g.ldb = DE; g.K = DE; g.epi = EPI_SCALE; g.out = p.YB; g.ldc = D; g.rowscale = p.WLIST + (size_t)e * TA - base; }
    } break;
    }
}
HD void gemm_epi(const GemmDesc& g, int rl, int cb, int q, const float (&v)[4][4]) {
    if (rl >= g.nrows) return;
    const long long orow = g.out_row0 + rl;
    if (g.epi == EPI_SWIGLU) {
        for (int jj = 0; jj < 2; ++jj) { float a[4]; for (int r = 0; r < 4; ++r) a[r] = silu_f(v[2 * jj][r]) * v[2 * jj + 1][r];
            st4(g.out + (size_t)orow * g.ldc + (g.n0 + cb) / 2 + jj * 16 + q * 4, a[0], a[1], a[2], a[3]); }
    } else {
        const float w = g.epi == EPI_SCALE ? g.rowscale[orow] : 1.0f;
        for (int j = 0; j < 4; ++j) st4(g.out + (size_t)orow * g.ldc + g.n0 + cb + j * 16 + q * 4, v[j][0] * w, v[j][1] * w, v[j][2] * w, v[j][3] * w);
    }
}
#ifdef HOST_EMU
inline void gemm_tile_host(const GemmDesc& g) {
    for (int rl = 0; rl < g.nrows; ++rl) {
        const long long ar = g.rowidx ? g.rowidx[g.a_row0 + rl] : g.a_row0 + rl; const st_t* a = g.A + (size_t)ar * g.lda;
        for (int cb = 0; cb < 128; cb += 64) for (int q = 0; q < 4; ++q) { float v[4][4];
            for (int j = 0; j < 4; ++j) for (int r = 0; r < 4; ++r) { const st_t* b = g.Bt + (size_t)(g.n0 + cb + j * 16 + q * 4 + r) * g.ldb; float acc = 0.f; for (int k = 0; k < g.K; ++k) acc += a[k] * b[k]; v[j][r] = acc; }
            gemm_epi(g, rl, cb, q, v); }
    }
}
#else
__device__ __forceinline__ void gemm_tile_dev(const GemmDesc& g, LAS unsigned char* lds, const int tid) {
    const int lane = tid & 63, wave = __builtin_amdgcn_readfirstlane(tid >> 6), wr = wave >> 1, wc = wave & 1;
    const int lrow = lane >> 3, slot = lane & 7;
    const st_t* asrc[4]; const st_t* bsrc[4];
#pragma unroll
    for (int i = 0; i < 4; ++i) {
        const int row = i * 32 + wave * 8 + lrow, chunk = slot ^ ((row >> 1) & 7);
        int rl = row < g.nrows ? row : g.nrows - 1;
        const long long ar = g.rowidx ? (long long)g.rowidx[g.a_row0 + rl] : (long long)(g.a_row0 + rl);
        asrc[i] = g.A + (size_t)ar * g.lda + chunk * 8;
        bsrc[i] = g.Bt + (size_t)(g.n0 + row) * g.ldb + chunk * 8;
    }
    const int nt = g.K / 64;
    auto stage = [&](int buf, int t) {
#pragma unroll
        for (int i = 0; i < 4; ++i) {
            __builtin_amdgcn_global_load_lds((const unsigned*)(asrc[i] + t * 64), (LAS unsigned*)(lds + buf * 32768 + (i * 32 + wave * 8) * 128), 16, 0, 0);
            __builtin_amdgcn_global_load_lds((const unsigned*)(bsrc[i] + t * 64), (LAS unsigned*)(lds + buf * 32768 + 16384 + (i * 32 + wave * 8) * 128), 16, 0, 0);
        }
    };
    f32x4 acc[4][4];
#pragma unroll
    for (int i = 0; i < 4; ++i)
#pragma unroll
        for (int j = 0; j < 4; ++j) acc[i][j] = (f32x4){0.f, 0.f, 0.f, 0.f};
    const int fr = lane & 15, fq = lane >> 4;
    __syncthreads();
    stage(0, 0);
    __syncthreads();
    for (int t = 0; t < nt; ++t) {
        const int cur = t & 1;
        if (t + 1 < nt) stage(cur ^ 1, t + 1);
        const LAS unsigned char* As = lds + cur * 32768; const LAS unsigned char* Bs = As + 16384;
#pragma unroll
        for (int kk = 0; kk < 2; ++kk) {
            bf16x8 af[4], bfr[4];
#pragma unroll
            for (int i = 0; i < 4; ++i) { const int row = wr * 64 + i * 16 + fr; af[i] = *(const LAS bf16x8*)(As + row * 128 + (((kk * 4 + fq) ^ ((row >> 1) & 7)) << 4)); }
#pragma unroll
            for (int j = 0; j < 4; ++j) { const int row = wc * 64 + j * 16 + fr; bfr[j] = *(const LAS bf16x8*)(Bs + row * 128 + (((kk * 4 + fq) ^ ((row >> 1) & 7)) << 4)); }
#pragma unroll
            for (int i = 0; i < 4; ++i)
#pragma unroll
                for (int j = 0; j < 4; ++j) acc[i][j] = __builtin_amdgcn_mfma_f32_16x16x32_bf16(bfr[j], af[i], acc[i][j], 0, 0, 0);
        }
        __syncthreads();
    }
#pragma unroll
    for (int i = 0; i < 4; ++i) { float v[4][4];
#pragma unroll
        for (int j = 0; j < 4; ++j)
#pragma unroll
            for (int r = 0; r < 4; ++r) v[j][r] = acc[i][j][r];
        gemm_epi(g, wr * 64 + i * 16 + fr, wc * 64, fq, v); }
}
#endif


struct AttnDesc {
    int dqk;
    const st_t* Q; int ldq, q_row0;
    const st_t* K1; int ldk1; const st_t* K2; int ldk2;
    int lat_row0, ctx_row0;
    const st_t* Vt;
    int kt_lo, kt_hi, nctx;
    int mask, qpos0;
    float m_init, l_init, c;
    st_t* O; int o_col;
};
HD int attn_nitems(int layer) { const int lat = B * MH * (S / 128) + B * SWA_H * (S / 128); return layer == DEPTH - 1 ? lat : lat + B * MH * (L / 128) + B * SWA_H * (L / 128); }
HD void attn_desc(const Params& p, int layer, int item, AttnDesc& a) {
    const float LOG2E = 1.4426950408889634f;
    const int n_mla = B * MH * (S / 128), n_swa = B * SWA_H * (S / 128), n_mlac = B * MH * (L / 128);
    bool mla, ctxq; int b, h, qb;
    if (item < n_mla) { mla = true; ctxq = false; qb = item % (S / 128); h = (item / (S / 128)) % MH; b = item / (S / 128) / MH; }
    else if (item < n_mla + n_swa) { item -= n_mla; mla = false; ctxq = false; qb = item % (S / 128); h = (item / (S / 128)) % SWA_H; b = item / (S / 128) / SWA_H; }
    else if (item < n_mla + n_swa + n_mlac) { item -= n_mla + n_swa; mla = true; ctxq = true; qb = item % (L / 128); h = (item / (L / 128)) % MH; b = item / (L / 128) / MH; }
    else { item -= n_mla + n_swa + n_mlac; mla = false; ctxq = true; qb = item % (L / 128); h = (item / (L / 128)) % SWA_H; b = item / (L / 128) / SWA_H; }
    a.q_row0 = ctxq ? T + b * L + qb * 128 : b * S + qb * 128; a.lat_row0 = b * S; a.ctx_row0 = T + b * L; a.nctx = L / 64; a.qpos0 = qb * 128; a.O = p.O;
    if (mla) {
        a.dqk = 96; a.Q = p.MQ + h * MQD; a.ldq = MH * MQD; a.K1 = p.MKV + h * MKVD; a.ldk1 = MH * MKVD; a.K2 = p.P + PO_KR; a.ldk2 = DPROJP;
        a.Vt = p.VtM + (size_t)(b * MH + h) * 64 * NK; a.kt_lo = 0; a.kt_hi = ctxq ? 0 : S / 64; a.mask = 0; a.m_init = -1e30f; a.l_init = 0.f; a.c = LOG2E / sqrtf((float)MQD); a.o_col = 768 + h * 64;
    } else {
        const int kvh = h / SWA_G;
        a.dqk = 64; a.Q = p.P + PO_QA + h * 64; a.ldq = DPROJP; a.K1 = p.P + PO_KA + kvh * 64; a.ldk1 = DPROJP; a.K2 = nullptr; a.ldk2 = 0;
        a.Vt = p.VtA + (size_t)(b * SWA_KVH + kvh) * 64 * NK; a.mask = ctxq ? 0 : 1;
        if (ctxq) { a.kt_lo = 0; a.kt_hi = 0; } else { a.kt_lo = (a.qpos0 - SWA_W) / 64; if (a.kt_lo < 0) a.kt_lo = 0; a.kt_hi = (a.qpos0 + 128 + SWA_W) / 64; if (a.kt_hi > S / 64) a.kt_hi = S / 64; }
        a.m_init = p.swa_sink[layer * SWA_H + h] * LOG2E; a.l_init = 1.f; a.c = LOG2E * 0.125f; a.o_col = h * 64;
    }
}
#ifdef HOST_EMU
inline void attn_tile_host(const AttnDesc& a) {
    const int nl = a.kt_hi - a.kt_lo, ntile = nl + a.nctx;
    for (int q = 0; q < 128; ++q) {
        const st_t* qr = a.Q + (size_t)(a.q_row0 + q) * a.ldq; float m = a.m_init, l = a.l_init, acc[64]; for (int d = 0; d < 64; ++d) acc[d] = 0.f;
        for (int t = 0; t < ntile; ++t) for (int kk = 0; kk < 64; ++kk) {
            const int kidx = t < nl ? (a.kt_lo + t) * 64 + kk : S + (t - nl) * 64 + kk; const int row = kidx < S ? a.lat_row0 + kidx : a.ctx_row0 + kidx - S;
            if (a.mask && t < nl) { const int dq = a.qpos0 + q - kidx; if (dq > SWA_W || dq < -SWA_W) continue; }
            float sc = 0.f; for (int d = 0; d < 64; ++d) sc += qr[d] * a.K1[(size_t)row * a.ldk1 + d];
            if (a.dqk > 64) for (int d = 64; d < a.dqk; ++d) sc += qr[d] * a.K2[(size_t)row * a.ldk2 + d - 64];
            sc *= a.c; if (sc > m) { const float f = exp2f(m - sc); l *= f; for (int d = 0; d < 64; ++d) acc[d] *= f; m = sc; }
            const float pe = exp2f(sc - m); l += pe; for (int d = 0; d < 64; ++d) acc[d] += pe * a.Vt[(size_t)d * NK + kidx];
        }
        for (int d = 0; d < 64; ++d) a.O[(size_t)(a.q_row0 + q) * DMIX + a.o_col + d] = acc[d] / l;
    }
}
#else
typedef float f32x16 __attribute__((ext_vector_type(16)));
typedef unsigned u32x4 __attribute__((ext_vector_type(4)));
typedef unsigned u32x2 __attribute__((ext_vector_type(2)));
__device__ __forceinline__ int crow16(int reg, int h) { return (reg & 3) + 8 * (reg >> 2) + 4 * h; }
template <int DQK>
__device__ __forceinline__ void attn_tile_dev(const AttnDesc& a, LAS unsigned char* lds, const int tid) {
    constexpr int KSTR = DQK * 2 + 16, VSTR = 136, KBYTES = 64 * KSTR, BUF = KBYTES + 64 * VSTR, CPR = DQK / 8, KCH = 64 * CPR / 256, NKS = DQK / 16;
    const int lane = tid & 63, wave = __builtin_amdgcn_readfirstlane(tid >> 6), l31 = lane & 31, hh = lane >> 5;
    bf16x8 qf[NKS];
    { const st_t* qrow = a.Q + (size_t)(a.q_row0 + wave * 32 + l31) * a.ldq;
#pragma unroll
      for (int ks = 0; ks < NKS; ++ks) qf[ks] = *(const bf16x8*)(qrow + 16 * ks + 8 * hh); }
    f32x16 ot[2];
#pragma unroll
    for (int r = 0; r < 16; ++r) { ot[0][r] = 0.f; ot[1][r] = 0.f; }
    float m = a.m_init, lsum = hh == 0 ? a.l_init : 0.f;
    const int nl = a.kt_hi - a.kt_lo, ntile = nl + a.nctx; const float c = a.c;
    u32x4 kreg[KCH], vreg[2];
    auto gload = [&](int t) {
        const int kidx0 = t < nl ? (a.kt_lo + t) * 64 : S + (t - nl) * 64; const int rowbase = t < nl ? a.lat_row0 + kidx0 : a.ctx_row0 + kidx0 - S;
#pragma unroll
        for (int u = 0; u < KCH; ++u) { const int ci = tid + 256 * u, row = ci / CPR, cc = ci % CPR;
            const st_t* src = (DQK == 64 || cc < 8) ? a.K1 + (size_t)(rowbase + row) * a.ldk1 + cc * 8 : a.K2 + (size_t)(rowbase + row) * a.ldk2 + (cc - 8) * 8;
            kreg[u] = *(const u32x4*)src; }
#pragma unroll
        for (int u = 0; u < 2; ++u) { const int ci = tid + 256 * u, dv = ci >> 3, cc = ci & 7; vreg[u] = *(const u32x4*)(a.Vt + (size_t)dv * NK + kidx0 + cc * 8); }
    };
    auto lstore = [&](int buf) {
#pragma unroll
        for (int u = 0; u < KCH; ++u) { const int ci = tid + 256 * u, row = ci / CPR, cc = ci % CPR; *(LAS u32x4*)(lds + buf * BUF + row * KSTR + cc * 16) = kreg[u]; }
#pragma unroll
        for (int u = 0; u < 2; ++u) { const int ci = tid + 256 * u, dv = ci >> 3, cc = ci & 7; LAS u32x2* d = (LAS u32x2*)(lds + buf * BUF + KBYTES + dv * VSTR + cc * 16);
            d[0] = (u32x2){vreg[u].x, vreg[u].y}; d[1] = (u32x2){vreg[u].z, vreg[u].w}; }
    };
    __syncthreads();
    gload(0); lstore(0);
    __syncthreads();
    for (int t = 0; t < ntile; ++t) {
        const int cur = t & 1;
        if (t + 1 < ntile) gload(t + 1);
        const LAS unsigned char* Ks = lds + cur * BUF; const LAS unsigned char* Vs = Ks + KBYTES;
        f32x16 st[2];
#pragma unroll
        for (int kb = 0; kb < 2; ++kb) {
#pragma unroll
            for (int r = 0; r < 16; ++r) st[kb][r] = 0.f;
#pragma unroll
            for (int ks = 0; ks < NKS; ++ks) { const bf16x8 af = *(const LAS bf16x8*)(Ks + (kb * 32 + l31) * KSTR + (16 * ks + 8 * hh) * 2);
                st[kb] = __builtin_amdgcn_mfma_f32_32x32x16_bf16(af, qf[ks], st[kb], 0, 0, 0); }
        }
        if (a.mask && t < nl) {
            const int d0 = a.qpos0 + wave * 32 + l31 - (a.kt_lo + t) * 64;
#pragma unroll
            for (int kb = 0; kb < 2; ++kb)
#pragma unroll
                for (int r = 0; r < 16; ++r) { const int dq = d0 - (kb * 32 + crow16(r, hh)); if (dq > SWA_W || dq < -SWA_W) st[kb][r] = -1e30f; }
        }
        float mx = st[0][0];
#pragma unroll
        for (int r = 1; r < 16; ++r) mx = fmaxf(mx, st[0][r]);
#pragma unroll
        for (int r = 0; r < 16; ++r) mx = fmaxf(mx, st[1][r]);
        mx = fmaxf(mx, __shfl_xor(mx, 32));
        const float m_new = fmaxf(m, mx * c), alpha = __builtin_amdgcn_exp2f(m - m_new);
        float rs = 0.f;
#pragma unroll
        for (int kb = 0; kb < 2; ++kb)
#pragma unroll
            for (int r = 0; r < 16; ++r) { const float pe = __builtin_amdgcn_exp2f(__builtin_fmaf(st[kb][r], c, -m_new)); st[kb][r] = pe; rs += pe; }
        lsum = lsum * alpha + rs; m = m_new;
#pragma unroll
        for (int r = 0; r < 16; ++r) { ot[0][r] *= alpha; ot[1][r] *= alpha; }
#pragma unroll
        for (int kb = 0; kb < 2; ++kb)
#pragma unroll
            for (int s2 = 0; s2 < 2; ++s2) {
                u32x4 pw; pw.x = pk_bf16(st[kb][8 * s2 + 0], st[kb][8 * s2 + 1]); pw.y = pk_bf16(st[kb][8 * s2 + 2], st[kb][8 * s2 + 3]);
                pw.z = pk_bf16(st[kb][8 * s2 + 4], st[kb][8 * s2 + 5]); pw.w = pk_bf16(st[kb][8 * s2 + 6], st[kb][8 * s2 + 7]);
                const bf16x8 pb = __builtin_bit_cast(bf16x8, pw);
#pragma unroll
                for (int db = 0; db < 2; ++db) { const LAS unsigned char* vp = Vs + (db * 32 + l31) * VSTR + (kb * 32 + 16 * s2 + 4 * hh) * 2;
                    const u32x2 lo = *(const LAS u32x2*)vp, hi = *(const LAS u32x2*)(vp + 16); u32x4 vw; vw.x = lo.x; vw.y = lo.y; vw.z = hi.x; vw.w = hi.y;
                    ot[db] = __builtin_amdgcn_mfma_f32_32x32x16_bf16(__builtin_bit_cast(bf16x8, vw), pb, ot[db], 0, 0, 0); }
            }
        if (t + 1 < ntile) lstore(cur ^ 1);
        __syncthreads();
    }
    const float inv = 1.0f / (lsum + __shfl_xor(lsum, 32));
    st_t* orow = a.O + (size_t)(a.q_row0 + wave * 32 + l31) * DMIX + a.o_col;
#pragma unroll
    for (int db = 0; db < 2; ++db)
#pragma unroll
        for (int g = 0; g < 4; ++g) st4(orow + db * 32 + 8 * g + 4 * hh, ot[db][4 * g] * inv, ot[db][4 * g + 1] * inv, ot[db][4 * g + 2] * inv, ot[db][4 * g + 3] * inv);
}
#endif


HD int gdn_row(int b, int dir, int n, int i) {
    if (n < L / 64) { const int pos = n * 64 + i; return T + b * L + (dir == 0 ? pos : L - 1 - pos); }
    const int pos = (n - L / 64) * 64 + i; return b * S + (dir == 0 ? pos : S - 1 - pos);
}
#ifdef HOST_EMU
inline void gdn_pre_host(const Params& p, int item) {
    const int c = item / NCH, n = item % NCH, dir = c & 1, h = (c >> 1) % GH, b = (c >> 1) / GH;
    float gc[64], beta[64]; const st_t* kk[64]; const st_t* qq[64]; const st_t* vv[64]; float acc = 0.f;
    for (int i = 0; i < 64; ++i) { const int r = gdn_row(b, dir, n, i); acc += p.BG[(size_t)r * 24 + 12 + dir * 6 + h]; gc[i] = acc; beta[i] = p.BG[(size_t)r * 24 + dir * 6 + h];
        qq[i] = p.G + (size_t)r * GQKV + h * 64; kk[i] = qq[i] + 384; vv[i] = qq[i] + 768; }
    static thread_local float A[64][64], XU[64][64], XW[64][64];
    for (int i = 0; i < 64; ++i) for (int j = 0; j < 64; ++j) { float d = 0.f; for (int e = 0; e < 64; ++e) d += kk[i][e] * kk[j][e]; A[i][j] = j < i ? beta[i] * d * expf(gc[i] - gc[j]) : 0.f; }
    for (int i = 0; i < 64; ++i) for (int e = 0; e < 64; ++e) { float u = beta[i] * vv[i][e], w = beta[i] * expf(gc[i]) * kk[i][e];
        for (int j = 0; j < i; ++j) { u -= A[i][j] * XU[j][e]; w -= A[i][j] * XW[j][e]; } XU[i][e] = u; XW[i][e] = w; }
    st_t* ch = p.CH + (size_t)item * 5 * 4096;
    for (int i = 0; i < 64; ++i) for (int e = 0; e < 64; ++e) {
        ch[0 * 4096 + e * 64 + i] = XU[i][e]; ch[1 * 4096 + i * 64 + e] = XW[i][e]; ch[2 * 4096 + i * 64 + e] = qq[i][e] * 0.125f * expf(gc[i]);
        float d = 0.f; for (int x = 0; x < 64; ++x) d += qq[i][x] * kk[e][x]; ch[3 * 4096 + i * 64 + e] = e <= i ? d * 0.125f * expf(gc[i] - gc[e]) : 0.f;
        ch[4 * 4096 + e * 64 + i] = kk[i][e] * expf(gc[63] - gc[i]); }
    p.GAM[item] = expf(gc[63]);
}
inline void gdn_scan_host(const Params& p, int c) {
    const int dir = c & 1, h = (c >> 1) % GH, b = (c >> 1) / GH; st_t* dst = dir == 0 ? p.OF : p.OB;
    static thread_local float Sm[64][64], Vn[64][64]; for (int d = 0; d < 64; ++d) for (int e = 0; e < 64; ++e) Sm[d][e] = 0.f;
    for (int n = 0; n < NCH; ++n) { const st_t* ch = p.CH + (size_t)(c * NCH + n) * 5 * 4096; const float gam = p.GAM[c * NCH + n];
        for (int i = 0; i < 64; ++i) for (int e = 0; e < 64; ++e) { float v = ch[0 * 4096 + e * 64 + i]; for (int d = 0; d < 64; ++d) v -= ch[1 * 4096 + i * 64 + d] * Sm[d][e]; Vn[i][e] = v; }
        for (int i = 0; i < 64; ++i) for (int e = 0; e < 64; ++e) { float o = 0.f; for (int d = 0; d < 64; ++d) o += ch[2 * 4096 + i * 64 + d] * Sm[d][e]; for (int j = 0; j < 64; ++j) o += ch[3 * 4096 + i * 64 + j] * Vn[j][e];
            dst[(size_t)gdn_row(b, dir, n, i) * (GH * GDV) + h * 64 + e] = o; }
        for (int d = 0; d < 64; ++d) for (int e = 0; e < 64; ++e) { float sn = gam * Sm[d][e]; for (int i = 0; i < 64; ++i) sn += ch[4 * 4096 + d * 64 + i] * Vn[i][e]; Sm[d][e] = sn; }
    }
}
#else
template <int... Is, class F> __device__ __forceinline__ void static_for_impl(std::integer_sequence<int, Is...>, F&& f) { (f(std::integral_constant<int, Is>{}), ...); }
template <int N, class F> __device__ __forceinline__ void static_for(F&& f) { static_for_impl(std::make_integer_sequence<int, N>{}, f); }
__device__ __forceinline__ float bf_lo(unsigned u) { return __builtin_bit_cast(float, u << 16); }
__device__ __forceinline__ float bf_hi(unsigned u) { return __builtin_bit_cast(float, u & 0xffff0000u); }
template <int ROLE>
__device__ __forceinline__ void gdn_pre_role(const Params& p, int pair, LAS unsigned char* lds, const int lane, const int wave) {
    constexpr int AST = 68;
    const int l31 = lane & 31, hh = lane >> 5;
    const int item = pair * 2 + (wave >> 1);
    const int c = item / NCH, n = item % NCH, dir = c & 1, h = (c >> 1) % GH, b = (c >> 1) / GH;
    LAS float* At = (LAS float*)(lds + (wave >> 1) * 18432); LAS float* gcs = At + 64 * AST; LAS float* bts = gcs + 64; LAS float* ebt = bts + 64;
    st_t* ch = p.CH + (size_t)item * 5 * 4096;
    const int row0 = gdn_row(b, dir, n, 0); const int sgn = dir == 0 ? 1 : -1;
    const int myrow = row0 + sgn * lane;
    float gc = p.BG[(size_t)myrow * 24 + 12 + dir * 6 + h]; const float beta = p.BG[(size_t)myrow * 24 + dir * 6 + h];
#pragma unroll
    for (int o = 1; o < 64; o <<= 1) { const float t = __shfl_up(gc, o); if (lane >= o) gc += t; }
    const float gc63 = __shfl(gc, 63);
    __syncthreads();
    if (ROLE == 0) { gcs[lane] = gc; bts[lane] = beta; ebt[lane] = beta * __expf(gc); }
    const st_t* gbase = p.G + h * 64;
    f32x16 d00, d10, d11;
#pragma unroll
    for (int r = 0; r < 16; ++r) { d00[r] = 0.f; d10[r] = 0.f; d11[r] = 0.f; }
    { const size_t r0 = (size_t)(row0 + sgn * l31) * GQKV, r1 = (size_t)(row0 + sgn * (32 + l31)) * GQKV; constexpr int xo = ROLE == 0 ? 384 : 0;
#pragma unroll
      for (int ks = 0; ks < 4; ++ks) {
          const bf16x8 a0 = *(const bf16x8*)(gbase + r0 + xo + 16 * ks + 8 * hh), a1 = *(const bf16x8*)(gbase + r1 + xo + 16 * ks + 8 * hh);
          const bf16x8 b0 = *(const bf16x8*)(gbase + r0 + 384 + 16 * ks + 8 * hh), b1 = *(const bf16x8*)(gbase + r1 + 384 + 16 * ks + 8 * hh);
          d00 = __builtin_amdgcn_mfma_f32_32x32x16_bf16(a0, b0, d00, 0, 0, 0); d10 = __builtin_amdgcn_mfma_f32_32x32x16_bf16(a1, b0, d10, 0, 0, 0); d11 = __builtin_amdgcn_mfma_f32_32x32x16_bf16(a1, b1, d11, 0, 0, 0); } }
    __syncthreads();
    auto post = [&](const f32x16& d, int ib, int jb) __attribute__((always_inline)) {
        const int j = 32 * jb + l31; const float gcj = gcs[j];
#pragma unroll
        for (int g = 0; g < 4; ++g) { const int i0 = 32 * ib + 8 * g + 4 * hh; const f32x4 gci = *(const LAS f32x4*)(gcs + i0);
            if (ROLE == 0) { const f32x4 bi = *(const LAS f32x4*)(bts + i0); f32x4 o;
#pragma unroll
                for (int u = 0; u < 4; ++u) o[u] = (j < i0 + u) ? bi[u] * d[4 * g + u] * __expf(gci[u] - gcj) : 0.f;
                *(LAS f32x4*)(At + j * AST + i0) = o; }
            else {
#pragma unroll
                for (int u = 0; u < 4; ++u) { const float v = (j <= i0 + u) ? 0.125f * d[4 * g + u] * __expf(gci[u] - gcj) : 0.f; stf(ch + 3 * 4096 + (i0 + u) * 64 + j, v); } } }
    };
    post(d00, 0, 0); post(d10, 1, 0); post(d11, 1, 1);
    if (ROLE == 1) {
#pragma unroll
        for (int r = 0; r < 16; ++r) stf(ch + 3 * 4096 + crow16(r, hh) * 64 + 32 + l31, 0.f); }
    __syncthreads();
    float acc[64];
#pragma unroll
    for (int i = 0; i < 64; ++i) acc[i] = 0.f;
    { const long long stp = (long long)sgn * GQKV;
      const st_t* sp = gbase + (ROLE == 0 ? 768 : 384) + lane + (size_t)row0 * GQKV;
      const LAS float* sc = ROLE == 0 ? bts : ebt;
      float cur[8], pre[8];
#pragma unroll
      for (int u = 0; u < 8; ++u) { cur[u] = ldf(sp + u * stp); pre[u] = ldf(sp + (8 + u) * stp); }
      unsigned pk[4]; f32x4 s4 = (f32x4){0.f, 0.f, 0.f, 0.f}; float xprev = 0.f;
      static_for<64>([&](auto jc) __attribute__((always_inline)) {
          constexpr int j = decltype(jc)::value;
          if constexpr ((j & 7) == 0 && j > 0) {
#pragma unroll
              for (int u = 0; u < 8; ++u) cur[u] = pre[u];
              if constexpr (j + 8 < 64) { const st_t* gp = sp + (j + 8) * stp; asm volatile("" : "+v"(gp));
#pragma unroll
                  for (int u = 0; u < 8; ++u) pre[u] = ldf(gp + u * stp); }
          }
          if constexpr ((j & 3) == 0) s4 = *(const LAS f32x4*)(sc + j);
          const float x = s4[j & 3] * cur[j & 7] - acc[j];
          if constexpr (ROLE == 0) {
              if constexpr ((j & 1) == 1) pk[(j >> 1) & 3] = pk_bf16(xprev, x);
              if constexpr ((j & 7) == 7) { u32x4 w; w.x = pk[0]; w.y = pk[1]; w.z = pk[2]; w.w = pk[3]; *(u32x4*)(ch + 0 * 4096 + lane * 64 + (j - 7)) = w; }
          } else stf(ch + 1 * 4096 + j * 64 + lane, x);
          xprev = x;
          constexpr int I0 = ((j + 1) >> 2) << 2;
#pragma unroll
          for (int i4 = I0; i4 < 64; i4 += 4) { const f32x4 av = *(const LAS f32x4*)(At + j * AST + i4);
#pragma unroll
              for (int u = 0; u < 4; ++u) if (i4 + u > j) acc[i4 + u] += av[u] * x;
              asm volatile("" : "+v"(acc[i4]), "+v"(acc[i4 + 1]), "+v"(acc[i4 + 2]), "+v"(acc[i4 + 3])); }
          __builtin_amdgcn_sched_barrier(0);
      }); }
    { const st_t* src = gbase + (size_t)myrow * GQKV + (ROLE == 0 ? 384 : 0); const float sc = ROLE == 0 ? __expf(gc63 - gc) : 0.125f * __expf(gc);
#pragma unroll
      for (int c8 = 0; c8 < 8; ++c8) { const u32x4 w = *(const u32x4*)(src + 8 * c8);
          const float f0 = bf_lo(w.x) * sc, f1 = bf_hi(w.x) * sc, f2 = bf_lo(w.y) * sc, f3 = bf_hi(w.y) * sc, f4 = bf_lo(w.z) * sc, f5 = bf_hi(w.z) * sc, f6 = bf_lo(w.w) * sc, f7 = bf_hi(w.w) * sc;
          if (ROLE == 0) { st_t* kt = ch + 4 * 4096 + (8 * c8) * 64 + lane; stf(kt, f0); stf(kt + 64, f1); stf(kt + 128, f2); stf(kt + 192, f3); stf(kt + 256, f4); stf(kt + 320, f5); stf(kt + 384, f6); stf(kt + 448, f7); }
          else { u32x4 o; o.x = pk_bf16(f0, f1); o.y = pk_bf16(f2, f3); o.z = pk_bf16(f4, f5); o.w = pk_bf16(f6, f7); *(u32x4*)(ch + 2 * 4096 + lane * 64 + 8 * c8) = o; } } }
    if (ROLE == 0 && lane == 0) p.GAM[item] = __expf(gc63);
}
static_assert((NCHAIN * NCH) % 2 == 0, "chunk items come in pairs");
__device__ __forceinline__ void gdn_pre_dev(const Params& p, int pair, LAS unsigned char* lds, const int tid) {
    const int lane = tid & 63, wave = __builtin_amdgcn_readfirstlane(tid >> 6);
    if ((wave & 1) == 0) gdn_pre_role<0>(p, pair, lds, lane, wave); else gdn_pre_role<1>(p, pair, lds, lane, wave);
}
__device__ __forceinline__ void gdn_scan_dev(const Params& p, int c, LAS unsigned char* lds, const int tid) {
    constexpr int RS = 136, MB = 64 * RS;
    const int lane = tid & 63, wave = __builtin_amdgcn_readfirstlane(tid >> 6), r16 = lane & 15, q = lane >> 4;
    const int dir = c & 1, h = (c >> 1) % GH, b = (c >> 1) / GH; st_t* dst = (dir == 0 ? p.OF : p.OB) + h * 64 + 16 * wave + r16;
    f32x4 Sb[4];
#pragma unroll
    for (int i = 0; i < 4; ++i) Sb[i] = (f32x4){0.f, 0.f, 0.f, 0.f};
    u32x4 stg[10]; float gam_next = 0.f;
    auto gload = [&](int n) { const u32x4* src = (const u32x4*)(p.CH + (size_t)(c * NCH + n) * 5 * 4096);
#pragma unroll
        for (int u = 0; u < 10; ++u) stg[u] = src[tid + 256 * u];
        gam_next = p.GAM[c * NCH + n]; };
    auto lstore = [&]() {
#pragma unroll
        for (int u = 0; u < 10; ++u) { const int ci = tid + 256 * u, mat = ci >> 9, row = (ci >> 3) & 63, cc = ci & 7; LAS u32x2* d = (LAS u32x2*)(lds + mat * MB + row * RS + cc * 16);
            d[0] = (u32x2){stg[u].x, stg[u].y}; d[1] = (u32x2){stg[u].z, stg[u].w}; } };
    auto afrag = [&](int mat, int row, int a2) -> bf16x8 { const LAS unsigned char* bp = lds + mat * MB + row * RS + (32 * a2 + 4 * q) * 2;
        const u32x2 lo = *(const LAS u32x2*)bp, hi = *(const LAS u32x2*)(bp + 32); u32x4 w; w.x = lo.x; w.y = lo.y; w.z = hi.x; w.w = hi.y; return __builtin_bit_cast(bf16x8, w); };
    auto pack2 = [&](const f32x4& x, const f32x4& y) -> bf16x8 { u32x4 w; w.x = pk_bf16(x[0], x[1]); w.y = pk_bf16(x[2], x[3]); w.z = pk_bf16(y[0], y[1]); w.w = pk_bf16(y[2], y[3]); return __builtin_bit_cast(bf16x8, w); };
    __syncthreads();
    gload(0); lstore(); float gam = gam_next;
    __syncthreads();
    for (int n = 0; n < NCH; ++n) {
        if (n + 1 < NCH) gload(n + 1);
        const bf16x8 sb0 = pack2(Sb[0], Sb[1]), sb1 = pack2(Sb[2], Sb[3]);
        f32x4 vn[4], oc[4];
#pragma unroll
        for (int tb = 0; tb < 4; ++tb) {
            f32x4 acc = (f32x4){0.f, 0.f, 0.f, 0.f};
            acc = __builtin_amdgcn_mfma_f32_16x16x32_bf16(afrag(1, 16 * tb + r16, 0), sb0, acc, 0, 0, 0);
            acc = __builtin_amdgcn_mfma_f32_16x16x32_bf16(afrag(1, 16 * tb + r16, 1), sb1, acc, 0, 0, 0);
            const u32x2 uu = *(const LAS u32x2*)(lds + 0 * MB + (16 * wave + r16) * RS + (16 * tb + 4 * q) * 2);
            vn[tb][0] = bf_lo(uu.x) - acc[0]; vn[tb][1] = bf_hi(uu.x) - acc[1]; vn[tb][2] = bf_lo(uu.y) - acc[2]; vn[tb][3] = bf_hi(uu.y) - acc[3];
            f32x4 o = (f32x4){0.f, 0.f, 0.f, 0.f};
            o = __builtin_amdgcn_mfma_f32_16x16x32_bf16(afrag(2, 16 * tb + r16, 0), sb0, o, 0, 0, 0);
            o = __builtin_amdgcn_mfma_f32_16x16x32_bf16(afrag(2, 16 * tb + r16, 1), sb1, o, 0, 0, 0);
            oc[tb] = o;
        }
        const bf16x8 vb0 = pack2(vn[0], vn[1]), vb1 = pack2(vn[2], vn[3]);
#pragma unroll
        for (int tb = 0; tb < 4; ++tb) {
            f32x4 o = oc[tb];
            o = __builtin_amdgcn_mfma_f32_16x16x32_bf16(afrag(3, 16 * tb + r16, 0), vb0, o, 0, 0, 0);
            o = __builtin_amdgcn_mfma_f32_16x16x32_bf16(afrag(3, 16 * tb + r16, 1), vb1, o, 0, 0, 0);
#pragma unroll
            for (int u = 0; u < 4; ++u) stf(dst + (size_t)gdn_row(b, dir, n, 16 * tb + 4 * q + u) * (GH * GDV), o[u]);
        }
#pragma unroll
        for (int db = 0; db < 4; ++db) {
            f32x4 sn = Sb[db] * gam;
            sn = __builtin_amdgcn_mfma_f32_16x16x32_bf16(afrag(4, 16 * db + r16, 0), vb0, sn, 0, 0, 0);
            sn = __builtin_amdgcn_mfma_f32_16x16x32_bf16(afrag(4, 16 * db + r16, 1), vb1, sn, 0, 0, 0);
            Sb[db] = sn;
        }
        __syncthreads();
        if (n + 1 < NCH) { lstore(); gam = gam_next; }
        __syncthreads();
    }
}
#endif


#ifndef HOST_EMU
enum { R_NORM1 = 0, R_POST1 = 1, R_POST2 = 2 };
__device__ __forceinline__ float wave_sum(float v) {
#pragma unroll
    for (int o = 32; o > 0; o >>= 1) v += __shfl_xor(v, o);
    return v;
}
__device__ __forceinline__ void ld_row_f32(const float* p, int lane, f32x4 (&v)[D / 256]) {
#pragma unroll
    for (int j = 0; j < D / 256; ++j) v[j] = *(const f32x4*)(p + 4 * lane + 256 * j); }
__device__ __forceinline__ void ld_row_bf16(const st_t* p, int lane, f32x4 (&v)[D / 256]) {
#pragma unroll
    for (int j = 0; j < D / 256; ++j) { const u32x2 w = *(const u32x2*)(p + 4 * lane + 256 * j); v[j] = (f32x4){bf_lo(w.x), bf_hi(w.x), bf_lo(w.y), bf_hi(w.y)}; } }
__device__ __forceinline__ void st_row_bf16(st_t* p, int lane, const f32x4 (&v)[D / 256]) {
#pragma unroll
    for (int j = 0; j < D / 256; ++j) st4(p + 4 * lane + 256 * j, v[j][0], v[j][1], v[j][2], v[j][3]); }
__device__ __forceinline__ float sumsq(const f32x4 (&v)[D / 256]) { float s = 0.f;
#pragma unroll
    for (int j = 0; j < D / 256; ++j) s += (v[j][0] * v[j][0] + v[j][1] * v[j][1]) + (v[j][2] * v[j][2] + v[j][3] * v[j][3]);
    return wave_sum(s); }
template <bool TO_LDS>
__device__ __forceinline__ void modulate_store(const f32x4 (&x)[D / 256], float rstd, const float* gain, const float* sc, const float* sh, st_t* hrow, int lane, LAS float* hl) {
    f32x4 g[D / 256], a[D / 256], b[D / 256], h[D / 256]; ld_row_f32(gain, lane, g); ld_row_f32(sc, lane, a); ld_row_f32(sh, lane, b);
#pragma unroll
    for (int j = 0; j < D / 256; ++j) h[j] = x[j] * rstd * g[j] * (a[j] + 1.0f) + b[j];
    st_row_bf16(hrow, lane, h);
    if constexpr (TO_LDS) {
#pragma unroll
        for (int j = 0; j < D / 256; ++j) *(LAS f32x4*)(hl + 4 * lane + 256 * j) = h[j]; }
}
__device__ __forceinline__ void row_norm1(const Params& p, int layer, int r, int lane) {
    f32x4 x[D / 256]; ld_row_f32(xin_row(p, layer, r), lane, x);
    const float rstd = 1.0f / sqrtf(sumsq(x) / D + EPS);
    modulate_store<false>(x, rstd, p.mix_norm_pre + (size_t)layer * D, mod_vec(p, layer, r, 1), mod_vec(p, layer, r, 0), p.H + (size_t)r * D, lane, (LAS float*)0);
}
__device__ __forceinline__ void row_post1_pair(const Params& p, int layer, int pair, int lane, LAS float* hl) {
#pragma unroll
    for (int rr = 0; rr < 2; ++rr) { const int r = 2 * pair + rr;
        f32x4 y[D / 256], x[D / 256], g1[D / 256], gp[D / 256]; ld_row_bf16(p.Y + (size_t)r * D, lane, y); ld_row_f32(xin_row(p, layer, r), lane, x);
        ld_row_f32(mod_vec(p, layer, r, 2), lane, g1); ld_row_f32(p.mix_norm_post + (size_t)layer * D, lane, gp);
        const float rstd = 1.0f / sqrtf(sumsq(y) / D + EPS);
#pragma unroll
        for (int j = 0; j < D / 256; ++j) x[j] = x[j] + g1[j] * y[j] * rstd * gp[j];
        float* xr = xrow(p, r);
#pragma unroll
        for (int j = 0; j < D / 256; ++j) *(f32x4*)(xr + 4 * lane + 256 * j) = x[j];
        const float r2 = 1.0f / sqrtf(sumsq(x) / D + EPS);
        modulate_store<true>(x, r2, p.ffn_norm_pre + (size_t)layer * D, mod_vec(p, layer, r, 4), mod_vec(p, layer, r, 3), p.H + (size_t)r * D, lane, hl + rr * D);
    }
    asm volatile("s_waitcnt lgkmcnt(0)" ::: "memory");
    const float* wr = p.router_w + (size_t)layer * D * NE + lane; float a0 = 0.f, a1 = 0.f;
#pragma unroll 4
    for (int d4 = 0; d4 < D / 4; ++d4) { const f32x4 h0 = *(const LAS f32x4*)(hl + 4 * d4), h1 = *(const LAS f32x4*)(hl + D + 4 * d4);
#pragma unroll
        for (int u = 0; u < 4; ++u) { const float w = wr[(size_t)(4 * d4 + u) * NE]; a0 += h0[u] * w; a1 += h1[u] * w; } }
    p.LOGITS[(size_t)(2 * pair) * NE + lane] = a0; p.LOGITS[(size_t)(2 * pair + 1) * NE + lane] = a1;
    asm volatile("s_waitcnt lgkmcnt(0)" ::: "memory");
}
__device__ __forceinline__ void row_post2(const Params& p, int layer, int r, int lane) {
    const int* cnt = p.CNT + layer * NE; int slot = 0;
    if (lane < TOPK) { const int e = p.EIDX[(size_t)r * TOPK + lane]; slot = expert_base(cnt, e) + p.EPOS[(size_t)r * TOPK + lane]; }
    f32x4 f[D / 256]; ld_row_bf16(p.SH + (size_t)r * D, lane, f);
#pragma unroll
    for (int k = 0; k < TOPK; ++k) { const int sk = __shfl(slot, k); f32x4 t[D / 256]; ld_row_bf16(p.YB + (size_t)sk * D, lane, t);
#pragma unroll
        for (int j = 0; j < D / 256; ++j) f[j] += t[j]; }
    const float rstd = 1.0f / sqrtf(sumsq(f) / D + EPS);
    float* xr = xrow(p, r); f32x4 x[D / 256], g2[D / 256], gp[D / 256]; ld_row_f32(xr, lane, x); ld_row_f32(mod_vec(p, layer, r, 5), lane, g2); ld_row_f32(p.ffn_norm_post + (size_t)layer * D, lane, gp);
#pragma unroll
    for (int j = 0; j < D / 256; ++j) { x[j] = x[j] + g2[j] * f[j] * rstd * gp[j]; *(f32x4*)(xr + 4 * lane + 256 * j) = x[j]; }
    if (layer + 1 < DEPTH) { const float r2 = 1.0f / sqrtf(sumsq(x) / D + EPS);
        modulate_store<false>(x, r2, p.mix_norm_pre + (size_t)(layer + 1) * D, mod_vec(p, layer + 1, r, 1), mod_vec(p, layer + 1, r, 0), p.H + (size_t)r * D, lane, (LAS float*)0); }
}
__device__ __forceinline__ void mod_block(const Params& p, int item, LAS unsigned char* lds, int tid) {
    const int lane = tid & 63, wave = __builtin_amdgcn_readfirstlane(tid >> 6); const int ly = item / (6 * D / 64), jb = item % (6 * D / 64);
    LAS float* sl = (LAS float*)lds; LAS float* red = sl + 3 * D;
    __syncthreads();
    for (int i = tid; i < 3 * D; i += 256) { const int w = i / D, k = i % D; sl[i] = silu_f(w < 2 ? p.c[(size_t)w * D + k] : p.c_ctx[k]); }
    __syncthreads();
    const float* W = p.ada_w + (size_t)ly * D * 6 * D + jb * 64 + lane; float a0 = 0.f, a1 = 0.f, a2 = 0.f;
#pragma unroll 8
    for (int k = wave * (D / 4); k < (wave + 1) * (D / 4); ++k) { const float w = W[(size_t)k * 6 * D]; a0 += sl[k] * w; a1 += sl[D + k] * w; a2 += sl[2 * D + k] * w; }
    red[(wave * 3 + 0) * 64 + lane] = a0; red[(wave * 3 + 1) * 64 + lane] = a1; red[(wave * 3 + 2) * 64 + lane] = a2;
    __syncthreads();
    if (wave < 3) { const float v = red[(0 * 3 + wave) * 64 + lane] + red[(1 * 3 + wave) * 64 + lane] + red[(2 * 3 + wave) * 64 + lane] + red[(3 * 3 + wave) * 64 + lane];
        p.MOD[((size_t)(ly * 3 + wave) * 6 * D) + jb * 64 + lane] = v + p.ada_b[(size_t)ly * 6 * D + jb * 64 + lane]; }
}
#endif

enum { K_ITEM = 0, K_WT = 1, K_GEMM = 2, K_ATTN = 3, K_GPRE = 4, K_ROW = 5, K_MOD = 6 };
struct Step { int kind, st, layer, sync_before; };
inline int build_program(Step* prog) {
    int n = 0;
    prog[n++] = {K_ITEM, ST_ZERO, 0, 0}; prog[n++] = {USE_KMOD ? K_MOD : K_ITEM, USE_KMOD ? 0 : ST_MOD, 0, 0}; prog[n++] = {K_WT, WT_STATIC, 0, 0};
    for (int l = 0; l < DEPTH; ++l) {
        if (l == 0 || !USE_RPOST2) { if (USE_RNORM1) prog[n++] = {K_ROW, 0  , l, 1}; else prog[n++] = {K_ITEM, ST_NORM1, l, 1}; }
        prog[n++] = {K_GEMM, G_PROJ, l, 1};
        prog[n++] = {K_ITEM, ST_ROPE_SWA, l, 1}; prog[n++] = {K_ITEM, ST_GDN_CONV, l, 0}; prog[n++] = {K_ITEM, ST_GDN_GATE, l, 0}; prog[n++] = {K_ITEM, ST_MLA_NORM, l, 0};
        prog[n++] = {K_ITEM, ST_GDN_L2, l, 1}; prog[n++] = {K_GEMM, G_UQ, l, 0}; prog[n++] = {K_GEMM, G_UKV, l, 0};
        prog[n++] = {K_ITEM, ST_ROPE_MLA, l, 1}; prog[n++] = {K_ITEM, ST_VT, l, 0}; prog[n++] = {K_GPRE, 0, l, 0};
        prog[n++] = {K_ATTN, 0, l, 1};
        prog[n++] = {K_ITEM, ST_GDN_OUT, l, 1}; prog[n++] = {K_WT, WT_EXPERT, l, 0};
        prog[n++] = {K_GEMM, G_WOUT, l, 1};
        if (USE_RPOST1) prog[n++] = {K_ROW, 1  , l, 1}; else { prog[n++] = {K_ITEM, ST_POST1, l, 1}; prog[n++] = {K_ITEM, ST_ROUTER, l, 1}; }
        prog[n++] = {K_ITEM, ST_ROUTE, l, 1};
        prog[n++] = {K_GEMM, G_SGU, l, 1}; prog[n++] = {K_GEMM, G_EGU, l, 0};
        prog[n++] = {K_GEMM, G_SDOWN, l, 1}; prog[n++] = {K_GEMM, G_EDOWN, l, 0};
        if (USE_RPOST2) prog[n++] = {K_ROW, 2  , l, 1}; else prog[n++] = {K_ITEM, ST_POST2, l, 1};
    }
    return n;
}
constexpr int MAX_STEPS = 64;

#ifndef HOST_EMU
namespace cg = cooperative_groups;
struct Prog { Step s[MAX_STEPS]; int n; int pad[3]; };

__global__ void __launch_bounds__(256, 2) k_mega(Params p, Prog pr) {
    extern __shared__ __attribute__((aligned(16))) unsigned char smem[];
    LAS unsigned char* lds = (LAS unsigned char*)smem;
    cg::grid_group grid = cg::this_grid();
    const long long gthreads = (long long)gridDim.x * 256;
    for (int s = 0; s < pr.n; ++s) {
        const int kind = pr.s[s].kind, st = pr.s[s].st, layer = pr.s[s].layer;
        if (pr.s[s].sync_before) grid.sync();
        int reps = 1;
        if (PROBE_MASK) { const int grp = kind == K_GEMM ? 0 : kind == K_ATTN ? 1 : kind == K_GPRE ? 2 : kind == K_WT ? 3 : (kind == K_ITEM && (st == ST_GDN_CONV || st == ST_GDN_GATE || st == ST_MLA_NORM || st == ST_VT || st == ST_GDN_OUT || st == ST_GDN_L2)) ? 4 : 7;
            if ((PROBE_MASK >> grp) & 1) reps = 2; if (((PROBE_MASK >> 5) & 1) && pr.s[s].sync_before) grid.sync(); }
        for (int rep = 0; rep < reps; ++rep) {
        int tid = threadIdx.x; asm volatile("" : "+v"(tid));
        const int lane = tid & 63, wave = __builtin_amdgcn_readfirstlane(tid >> 6);
        const long long gtid = (long long)blockIdx.x * 256 + tid;
        if (kind == K_ITEM) {
            const long long n = n_items(st, layer);
#define RUN_ST(ST) case ST: for (long long i = gtid; i < n; i += gthreads) run_item(p, ST, layer, i); break;
            switch (st) {
#if !USE_KMOD
                RUN_ST(ST_MOD)
#endif
#if !USE_RNORM1
                RUN_ST(ST_NORM1)
#endif
#if !USE_RPOST1
                RUN_ST(ST_POST1) RUN_ST(ST_ROUTER)
#endif
#if !USE_RPOST2
                RUN_ST(ST_POST2)
#endif
                RUN_ST(ST_ZERO) RUN_ST(ST_ROPE_SWA) RUN_ST(ST_GDN_CONV) RUN_ST(ST_GDN_L2) RUN_ST(ST_GDN_GATE) RUN_ST(ST_MLA_NORM) RUN_ST(ST_ROPE_MLA)
                          RUN_ST(ST_GDN_OUT) RUN_ST(ST_ROUTE) RUN_ST(ST_VT) default: break; }
#undef RUN_ST
        } else if (kind == K_WT) {
            const long long n = wt_items(p, st); LAS float* scr = (LAS float*)(lds + wave * (64 * 33 * 4));
            for (long long i = (long long)blockIdx.x * 4 + wave; i < n; i += (long long)gridDim.x * 4) wt_item_dev(p, st, layer, i, scr, lane);
        } else if (kind == K_GEMM) {
            const int n = gemm_ntiles(p, st, layer);
            for (int i = blockIdx.x; i < n; i += gridDim.x) { GemmDesc g; gemm_desc(p, st, layer, i, g); gemm_tile_dev(g, lds, tid); }
        } else if (kind == K_ROW) {
            const int gw = blockIdx.x * 4 + wave, nw = gridDim.x * 4;
            if (st == R_NORM1) { for (int r = gw; r < TA; r += nw) row_norm1(p, layer, r, lane); }
            else if (st == R_POST1) { __syncthreads(); LAS float* hl = (LAS float*)(lds + wave * (2 * D * 4)); for (int i = gw; i < rows_out(layer) / 2; i += nw) row_post1_pair(p, layer, i, lane, hl); }
            else { for (int r = gw; r < rows_out(layer); r += nw) row_post2(p, layer, r, lane); }
        } else if (kind == K_MOD) {
            for (int i = blockIdx.x; i < DEPTH * (6 * D / 64); i += gridDim.x) mod_block(p, i, lds, tid);
        } else if (kind == K_GPRE) {
            const int n = NCHAIN * NCH / 2;
            for (int i = blockIdx.x; i < n; i += gridDim.x) gdn_pre_dev(p, i, lds, tid);
        } else {
            const int n = attn_nitems(layer) + NCHAIN; LAS int* slot = (LAS int*)(lds + 65536 - 16);
            for (;;) {
                __syncthreads(); if (tid == 0) *slot = atomicAdd(p.CTR + layer * 16 + rep, 1); __syncthreads();
                const int item = *slot; if (item >= n) break;
                if (item < NCHAIN) { gdn_scan_dev(p, item, lds, tid); continue; }
                AttnDesc a; attn_desc(p, layer, item - NCHAIN, a);
                if (a.dqk == 96) attn_tile_dev<96>(a, lds, tid); else attn_tile_dev<64>(a, lds, tid);
            }
        }
        }
    }
}

extern "C" void kernel_launch(void* const* d_in, const int* in_sizes, int n_in, void* d_out, int out_size, void* d_ws, size_t ws_size, hipStream_t stream) {
    Params p{};
    const float** pin = (const float**)&p;
    for (int i = 0; i < 29 && i < n_in; ++i) pin[i] = (const float*)d_in[i];
    p.out = (float*)d_out;
    const size_t need = carve(p, (char*)d_ws);
    if (need > ws_size) { fprintf(stderr, "kernel_launch: workspace too small: need %zu have %zu\n", need, ws_size); return; }
    build_jobs(p);
    Prog pr{}; pr.n = build_program(pr.s);
    constexpr int LDS_BYTES = 65536;
    static int grid_blocks = 0;
    if (!grid_blocks) {
        int dev = 0, cus = 0, per_cu = 0;
        (void)hipGetDevice(&dev);
        (void)hipDeviceGetAttribute(&cus, hipDeviceAttributeMultiprocessorCount, dev);
        (void)hipFuncSetAttribute((const void*)k_mega, hipFuncAttributeMaxDynamicSharedMemorySize, LDS_BYTES);
        (void)hipOccupancyMaxActiveBlocksPerMultiprocessor(&per_cu, k_mega, 256, LDS_BYTES);
        if (per_cu > 2) per_cu = 2;
        if (per_cu < 1) per_cu = 1;
        grid_blocks = cus * per_cu;
    }
    void* args[] = {&p, &pr};
    hipError_t e = hipLaunchCooperativeKernel((void*)k_mega, dim3(grid_blocks), dim3(256), args, LDS_BYTES, stream);
    if (e != hipSuccess) fprintf(stderr, "cooperative launch failed: %s (grid %d)\n", hipGetErrorString(e), grid_blocks);
}
#endif
```

```cpp
#ifndef HOST_EMU
#include <hip/hip_runtime.h>
#include <hip/hip_cooperative_groups.h>
#include <cstdio>
#define HD __host__ __device__ __forceinline__
#else
#include <cmath>
#include <cstdio>
#include <cstring>
#define HD inline
#endif
#include <cstdint>
#include <utility>

#ifndef CFG_D
#define CFG_D 1024
#endif
#ifndef CFG_S
#define CFG_S 8192
#endif
#ifndef CFG_L
#define CFG_L 256
#endif
#ifndef CFG_DE
#define CFG_DE 256
#endif
#ifndef CFG_DS
#define CFG_DS 256
#endif
#ifndef PROBE_MASK
#define PROBE_MASK 0
#endif
#ifndef USE_KMOD
#define USE_KMOD 1
#endif
#ifndef USE_RNORM1
#define USE_RNORM1 1
#endif
#ifndef USE_RPOST1
#define USE_RPOST1 1
#endif
#ifndef USE_RPOST2
#define USE_RPOST2 1
#endif

namespace cfg {
constexpr int D = CFG_D, B = 2, S = CFG_S, L = CFG_L, DEPTH = 2, GRID_W = 64;
constexpr int T = B * S, TC = B * L, TA = T + TC;
constexpr int SWA_H = 6, SWA_KVH = 2, SWA_G = 3, SWA_W = 128;
constexpr int GH = 6, GDK = 64, GDV = 64, GCONV = 5;
constexpr int MH = 4, MQR = 192, MKVR = 128, MNOPE = 64, MROPE = 32, MV = 64, MQD = MNOPE + MROPE, MKVD = MNOPE + MV;
constexpr int DMIX = 1024, GQKV = 1152;
constexpr int PO_QA = 0, PO_KA = 384, PO_VA = 512, PO_GQKV = 640, PO_Z = 1792, PO_BA = 2176, PO_CQ = 2200, PO_CKV = 2392, PO_KR = 2528  , PO_KR_SRC = 2520, DPROJ = 2552, DPROJP = 2560;
constexpr int NE = 64, TOPK = 8, NGRP = 8, TOPG = 4, DE = CFG_DE, DS = CFG_DS;
constexpr float EPS = 1e-6f, ROUTED_SCALE = 2.5f;
constexpr int NSLOT = TA * TOPK, NK = S + L, NCHAIN = B * GH * 2, NCH = (S + L) / 64;
static_assert(D % 128 == 0 && DE % 64 == 0 && DS % 64 == 0 && TA % 128 == 0 && T % 128 == 0, "tile divisibility");
}
using namespace cfg;

#ifdef HOST_EMU
typedef float st_t;
HD float ldf(const st_t* p) { return *p; }
HD void stf(st_t* p, float v) { *p = v; }
HD void st4(st_t* p, float a, float b, float c, float d) { p[0] = a; p[1] = b; p[2] = c; p[3] = d; }
#else
typedef unsigned short st_t;
typedef short bf16x8 __attribute__((ext_vector_type(8)));
typedef float f32x4 __attribute__((ext_vector_type(4)));
typedef float f32x2 __attribute__((ext_vector_type(2)));
typedef __bf16 bf16x2_t __attribute__((ext_vector_type(2)));
#define LAS __attribute__((address_space(3)))
HD float ldf(const st_t* p) { unsigned u = ((unsigned)*p) << 16; float f; __builtin_memcpy(&f, &u, 4); return f; }
HD unsigned short f2bf(float v) { unsigned u; __builtin_memcpy(&u, &v, 4); u = (u + 0x7fffu + ((u >> 16) & 1u)) >> 16; return (unsigned short)u; }
HD void stf(st_t* p, float v) { *p = f2bf(v); }
HD float ldf(const float* p) { return *p; }
HD void stf(float* p, float v) { *p = v; }
__device__ __forceinline__ unsigned pk_bf16(float lo, float hi) { f32x2 v = {lo, hi}; return __builtin_bit_cast(unsigned, __builtin_convertvector(v, bf16x2_t)); }
HD void st4(st_t* p, float a, float b, float c, float d) {
#if defined(__HIP_DEVICE_COMPILE__)
    uint2 w; w.x = pk_bf16(a, b); w.y = pk_bf16(c, d); *(uint2*)p = w;
#else
    p[0] = f2bf(a); p[1] = f2bf(b); p[2] = f2bf(c); p[3] = f2bf(d);
#endif
}
#endif

#if defined(__HIP_DEVICE_COMPILE__)
__device__ __forceinline__ float fast_exp(float x) { return __builtin_amdgcn_exp2f(x * 1.4426950408889634f); }
__device__ __forceinline__ float silu_f(float x) { return x * __builtin_amdgcn_rcpf(1.0f + fast_exp(-x)); }
__device__ __forceinline__ float sigmoid_f(float x) { return __builtin_amdgcn_rcpf(1.0f + fast_exp(-x)); }
__device__ __forceinline__ float softplus_f(float x) { return x > 20.f ? x : 0.6931471805599453f * __builtin_amdgcn_logf(1.0f + fast_exp(x)); }
__device__ __forceinline__ float rsqrt_f(float x) { return __builtin_amdgcn_rsqf(x); }
#else
HD float silu_f(float x) { return x / (1.0f + expf(-x)); }
HD float sigmoid_f(float x) { return 1.0f / (1.0f + expf(-x)); }
HD float softplus_f(float x) { return x > 20.f ? x : log1pf(expf(x)); }
HD float rsqrt_f(float x) { return 1.0f / sqrtf(x); }
#endif

struct TJob { const float* src; st_t* dst; int K, N, npad, grp, off, ldt, ldsrc, pad_; };
constexpr int NJOBS = 16;

struct Params {
    const float *x, *c, *ctx, *c_ctx, *ada_w, *ada_b, *mix_norm_pre, *mix_norm_post, *ffn_norm_pre, *ffn_norm_post,
        *w_in, *w_out, *swa_sink, *gdn_conv_w, *gdn_a_log, *gdn_dt_bias, *gdn_norm_w, *mla_q_norm, *mla_w_uq, *mla_kv_norm, *mla_w_ukv,
        *router_w, *router_bias, *e_gate, *e_up, *e_down, *s_gate, *s_up, *s_down;
    float* out;
    float *MOD, *XC, *BG, *LOGITS, *EW, *WLIST, *GAM, *TABA, *TABM;
    int *EIDX, *EPOS, *CNT, *TOKLIST, *CTR;
    unsigned* BAR;
    st_t *H, *P, *G, *CQN, *CKVN, *MQ, *MKV, *O, *Y, *SACT, *ACT, *YB, *SH, *VtM, *VtA, *OF, *OB, *CH;
    st_t *Wt_in, *Wt_out, *Wt_uq, *Wt_ukv, *Wt_sgu, *Wt_sd, *Wt_egu, *Wt_ed;
    TJob jobs[NJOBS];
};

HD size_t align256(size_t v) { return (v + 255) & ~(size_t)255; }
inline size_t carve(Params& p, char* ws) {
    size_t off = 0;
    auto take = [&](size_t bytes) { size_t o = off; off = align256(off + bytes); return ws ? ws + o : (char*)nullptr; };
    const size_t E = sizeof(st_t);
    p.BAR = (unsigned*)take((size_t)4096 * 4);
    p.MOD = (float*)take((size_t)DEPTH * 3 * 6 * D * 4);
    p.TABA = (float*)take((size_t)128 * 16 * 2 * 4);
    p.TABM = (float*)take((size_t)128 * 8 * 2 * 4);
    p.XC = (float*)take((size_t)TC * D * 4);
    p.BG = (float*)take((size_t)TA * 24 * 4);
    p.LOGITS = (float*)take((size_t)TA * NE * 4);
    p.EW = (float*)take((size_t)TA * TOPK * 4);
    p.EIDX = (int*)take((size_t)TA * TOPK * 4);
    p.EPOS = (int*)take((size_t)TA * TOPK * 4);
    p.CNT = (int*)take((size_t)DEPTH * NE * 4);
    p.CTR = (int*)take((size_t)DEPTH * 16 * 4);
    p.GAM = (float*)take((size_t)NCHAIN * NCH * 4);
    p.TOKLIST = (int*)take((size_t)NE * TA * 4);
    p.WLIST = (float*)take((size_t)NE * TA * 4);
    p.H = (st_t*)take((size_t)TA * D * E);
    p.SH = p.H;
    p.Wt_in = (st_t*)take((size_t)DEPTH * DPROJP * D * E);
    p.Wt_out = (st_t*)take((size_t)DEPTH * D * DMIX * E);
    p.Wt_uq = (st_t*)take((size_t)DEPTH * MH * MQD * MQR * E);
    p.Wt_ukv = (st_t*)take((size_t)DEPTH * MH * MKVD * MKVR * E);
    p.Wt_sgu = (st_t*)take((size_t)DEPTH * 2 * DS * D * E);
    p.Wt_sd = (st_t*)take((size_t)DEPTH * D * DS * E);
    const size_t q0 = off;
    p.SACT = (st_t*)take((size_t)TA * DS * E);
    p.ACT = (st_t*)take((size_t)NSLOT * DE * E > (size_t)TA * D * E ? (size_t)NSLOT * DE * E : (size_t)TA * D * E);
    p.Y = p.ACT;
    p.Wt_egu = (st_t*)take((size_t)NE * 2 * DE * D * E);
    p.Wt_ed = (st_t*)take((size_t)NE * D * DE * E);
    p.CH = (st_t*)(ws ? ws + q0 : nullptr);
    { const size_t chb = align256((size_t)NCHAIN * NCH * 5 * 4096 * E); if (q0 + chb > off) off = q0 + chb; }
    const size_t r0 = off;
    p.P = (st_t*)take((size_t)TA * DPROJP * E);
    p.G = (st_t*)take((size_t)TA * GQKV * E);
    p.CQN = (st_t*)take((size_t)TA * MQR * E);
    p.CKVN = (st_t*)take((size_t)TA * MKVR * E);
    p.MQ = (st_t*)take((size_t)TA * MH * MQD * E);
    p.MKV = (st_t*)take((size_t)TA * MH * MKVD * E);
    p.O = (st_t*)take((size_t)TA * DMIX * E);
    p.VtM = (st_t*)take((size_t)B * MH * MV * NK * E);
    p.VtA = (st_t*)take((size_t)B * SWA_KVH * 64 * NK * E);
    p.OF = (st_t*)take((size_t)TA * GH * GDV * E);
    p.OB = (st_t*)take((size_t)TA * GH * GDV * E);
    const size_t r1 = off;
    p.YB = (st_t*)(ws ? ws + r0 : nullptr);
    const size_t ybytes = align256((size_t)NSLOT * D * E);
    if (r0 + ybytes > r1) off = r0 + ybytes;
    return off;
}
inline void build_jobs(Params& p) {
    int n = 0;
    for (int l = 0; l < DEPTH; ++l) {
        p.jobs[n++] = {p.w_in + (size_t)l * D * DPROJ, p.Wt_in + (size_t)l * DPROJP * D, D, PO_KR_SRC, PO_KR, 16, 0, D, DPROJ, 0};
        p.jobs[n++] = {p.w_in + (size_t)l * D * DPROJ + PO_KR_SRC, p.Wt_in + (size_t)l * DPROJP * D + (size_t)PO_KR * D, D, MROPE, MROPE, 16, 0, D, DPROJ, 0};
        p.jobs[n++] = {p.w_out + (size_t)l * DMIX * D, p.Wt_out + (size_t)l * D * DMIX, DMIX, D, D, 16, 0, DMIX, D, 0};
        p.jobs[n++] = {p.mla_w_uq + (size_t)l * MQR * MH * MQD, p.Wt_uq + (size_t)l * MH * MQD * MQR, MQR, MH * MQD, MH * MQD, 16, 0, MQR, MH * MQD, 0};
        p.jobs[n++] = {p.mla_w_ukv + (size_t)l * MKVR * MH * MKVD, p.Wt_ukv + (size_t)l * MH * MKVD * MKVR, MKVR, MH * MKVD, MH * MKVD, 16, 0, MKVR, MH * MKVD, 0};
        p.jobs[n++] = {p.s_gate + (size_t)l * D * DS, p.Wt_sgu + (size_t)l * 2 * DS * D, D, DS, DS, 32, 0, D, DS, 0};
        p.jobs[n++] = {p.s_up + (size_t)l * D * DS, p.Wt_sgu + (size_t)l * 2 * DS * D, D, DS, DS, 32, 16, D, DS, 0};
        p.jobs[n++] = {p.s_down + (size_t)l * DS * D, p.Wt_sd + (size_t)l * D * DS, DS, D, D, 16, 0, DS, D, 0};
    }
}

HD int mod_which(int r) { return r < T ? r / S : 2; }
HD const float* mod_vec(const Params& p, int layer, int r, int chunk) { return p.MOD + ((size_t)(layer * 3 + mod_which(r)) * 6 + chunk) * D; }
HD void seq_bounds(int r, int& lo, int& hi) { if (r < T) { lo = (r / S) * S; hi = lo + S; } else { lo = T + ((r - T) / L) * L; hi = lo + L; } }
HD float* xrow(const Params& p, int r) { return r < T ? p.out + (size_t)r * D : p.XC + (size_t)(r - T) * D; }
HD const float* xin_row(const Params& p, int layer, int r) { if (layer > 0) return xrow(p, r); return r < T ? p.x + (size_t)r * D : p.ctx + (size_t)(r - T) * D; }
HD int rows_out(int layer) { return layer == DEPTH - 1 ? T : TA; }
HD int expert_base(const int* cnt, int e) { int b = 0; for (int i = 0; i < e; ++i) b += cnt[i]; return b; }

#ifdef HOST_EMU
inline int atomic_inc(int* p) { int v;
#pragma omp atomic capture
    { v = *p; *p += 1; }
    return v; }
#else
__device__ __forceinline__ int atomic_inc(int* p) { return atomicAdd(p, 1); }
#endif

enum Stage { ST_MOD = 0, ST_ZERO, ST_NORM1, ST_ROPE_SWA, ST_GDN_CONV, ST_GDN_L2, ST_GDN_GATE, ST_MLA_NORM, ST_ROPE_MLA,
             ST_SWA, ST_GDN_SCAN, ST_GDN_OUT, ST_MLA, ST_POST1, ST_ROUTER, ST_ROUTE, ST_POST2, ST_VT, ST_TAB, ST_COUNT };

HD long long n_items(int st, int layer) {
    switch (st) {
    case ST_MOD: return (long long)DEPTH * 3 * 6 * D;
    case ST_ZERO: return DEPTH * NE + DEPTH * 16;
    case ST_VT: return (long long)(B * MH + B * SWA_KVH) * (NK / 8) * 64;
    case ST_TAB: return 128 * 16 + 128 * 8;
    case ST_NORM1: return TA;
    case ST_ROPE_SWA: return (long long)T * 8 * 32;
    case ST_GDN_CONV: return (long long)TA * GQKV;
    case ST_GDN_L2: return (long long)TA * 12;
    case ST_GDN_GATE: return (long long)TA * 12;
    case ST_MLA_NORM: return (long long)TA * 2;
    case ST_ROPE_MLA: return (long long)T * 5 * 16;
    case ST_SWA: return (long long)rows_out(layer) * SWA_H;
    case ST_GDN_SCAN: return (long long)B * GH * 2 * GDV;
    case ST_GDN_OUT: return (long long)rows_out(layer) * GH;
    case ST_MLA: return (long long)rows_out(layer) * MH;
    case ST_POST1: return rows_out(layer);
    case ST_ROUTER: return (long long)rows_out(layer) * NE;
    case ST_ROUTE: return rows_out(layer);
    case ST_POST2: return rows_out(layer);
    }
    return 0;
}

HD float rope_inv(int i, int n) { return exp2f(-(float)i / (float)n * 13.287712379549449f); }

HD void run_item(const Params& p, int st, int layer, long long i) {
    switch (st) {
    case ST_MOD: {
        const int j = (int)(i % (6 * D)); const int w = (int)((i / (6 * D)) % 3); const int ly = (int)(i / (6 * D * 3));
        const float* cv = w < 2 ? p.c + (size_t)w * D : p.c_ctx;
        const float* W = p.ada_w + (size_t)ly * D * 6 * D;
        float acc = p.ada_b[(size_t)ly * 6 * D + j];
        for (int k = 0; k < D; ++k) acc += silu_f(cv[k]) * W[(size_t)k * 6 * D + j];
        p.MOD[i] = acc;
    } break;
    case ST_ZERO: if (i < DEPTH * NE) p.CNT[i] = 0; else p.CTR[i - DEPTH * NE] = 0; break;
    case ST_TAB: {
        if (i < 128 * 16) { const int pos = (int)(i / 16), ii = (int)(i % 16); const float ang = (float)pos * rope_inv(ii, 16); p.TABA[2 * i] = cosf(ang); p.TABA[2 * i + 1] = sinf(ang); }
        else { const long long k = i - 128 * 16; const int pos = (int)(k / 8), ii = (int)(k % 8); const float ang = (float)pos * rope_inv(ii, 8); p.TABM[2 * k] = cosf(ang); p.TABM[2 * k + 1] = sinf(ang); }
    } break;
    case ST_VT: {
        const int dv = (int)(i % 64); long long r = i / 64; const int kc = (int)(r % (NK / 8)); const int bh = (int)(r / (NK / 8));
        const bool mla = bh < B * MH; const int b = mla ? bh / MH : (bh - B * MH) / SWA_KVH, hd = mla ? bh % MH : (bh - B * MH) % SWA_KVH;
        st_t* dst = (mla ? p.VtM + ((size_t)(b * MH + hd) * 64 + dv) * NK : p.VtA + ((size_t)(b * SWA_KVH + hd) * 64 + dv) * NK) + kc * 8;
        for (int j = 0; j < 8; ++j) { const int kidx = kc * 8 + j; const int row = kidx < S ? b * S + kidx : T + b * L + (kidx - S);
            dst[j] = mla ? p.MKV[(size_t)row * MH * MKVD + hd * MKVD + MNOPE + dv] : p.P[(size_t)row * DPROJP + PO_VA + hd * 64 + dv]; }
    } break;
    case ST_NORM1: {
        const int r = (int)i; const float* xr = xin_row(p, layer, r); float ss = 0.f;
        for (int d = 0; d < D; ++d) ss += xr[d] * xr[d];
        const float rstd = 1.0f / sqrtf(ss / D + EPS);
        const float* gain = p.mix_norm_pre + (size_t)layer * D; const float* sh = mod_vec(p, layer, r, 0); const float* sc = mod_vec(p, layer, r, 1);
        st_t* hr = p.H + (size_t)r * D;
        for (int d = 0; d < D; ++d) stf(hr + d, xr[d] * rstd * gain[d] * (1.0f + sc[d]) + sh[d]);
    } break;
    case ST_ROPE_SWA: {
        const int j = (int)(i % 32), hh = (int)((i / 32) % 8), r = (int)(i / 256);
        const int s = r % S, rp = s / GRID_W, cp = s % GRID_W;
        const int base = hh < 6 ? PO_QA + hh * 64 : PO_KA + (hh - 6) * 64;
        const int half = j / 16, ii = j % 16; const int i1 = base + half * 32 + ii, i2 = i1 + 16;
        const float ang = (float)(half == 0 ? rp : cp) * rope_inv(ii, 16); const float cs = cosf(ang), sn = sinf(ang);
        st_t* pr = p.P + (size_t)r * DPROJP; const float x1 = ldf(pr + i1), x2 = ldf(pr + i2);
        stf(pr + i1, x1 * cs - x2 * sn); stf(pr + i2, x1 * sn + x2 * cs);
    } break;
    case ST_GDN_CONV: {
        const int cc = (int)(i % GQKV), r = (int)(i / GQKV); int lo, hi; seq_bounds(r, lo, hi);
        const float* w = p.gdn_conv_w + (size_t)layer * GCONV * GQKV; float acc = 0.f;
        for (int j = 0; j < GCONV; ++j) { const int rr = r + j - 2; if (rr >= lo && rr < hi) acc += w[j * GQKV + cc] * ldf(p.P + (size_t)rr * DPROJP + PO_GQKV + cc); }
        stf(p.G + (size_t)r * GQKV + cc, silu_f(acc));
    } break;
    case ST_GDN_L2: {
        const int hh = (int)(i % 12), r = (int)(i / 12); st_t* g = p.G + (size_t)r * GQKV + hh * 64; float ss = 0.f;
        for (int d = 0; d < 64; ++d) { const float v = ldf(g + d); ss += v * v; }
        const float rn = 1.0f / sqrtf(ss + EPS);
        for (int d = 0; d < 64; ++d) stf(g + d, ldf(g + d) * rn);
    } break;
    case ST_GDN_GATE: {
        const int j = (int)(i % 12), r = (int)(i / 12); const st_t* pr = p.P + (size_t)r * DPROJP + PO_BA;
        const float beta = sigmoid_f(ldf(pr + j)); const float a = ldf(pr + 12 + j);
        const float g = -expf(p.gdn_a_log[layer * 12 + j]) * softplus_f(a + p.gdn_dt_bias[layer * 12 + j]);
        p.BG[(size_t)r * 24 + j] = beta; p.BG[(size_t)r * 24 + 12 + j] = g;
    } break;
    case ST_MLA_NORM: {
        const int w = (int)(i % 2), r = (int)(i / 2);
        const int n = w == 0 ? MQR : MKVR; const st_t* src = p.P + (size_t)r * DPROJP + (w == 0 ? PO_CQ : PO_CKV);
        const float* gain = w == 0 ? p.mla_q_norm + (size_t)layer * MQR : p.mla_kv_norm + (size_t)layer * MKVR;
        st_t* dst = w == 0 ? p.CQN + (size_t)r * MQR : p.CKVN + (size_t)r * MKVR; float ss = 0.f;
        for (int d = 0; d < n; ++d) { const float v = ldf(src + d); ss += v * v; }
        const float rstd = 1.0f / sqrtf(ss / n + EPS);
        for (int d = 0; d < n; ++d) stf(dst + d, ldf(src + d) * rstd * gain[d]);
    } break;
    case ST_ROPE_MLA: {
        const int j = (int)(i % 16), w = (int)((i / 16) % 5), r = (int)(i / 80);
        const int s = r % S, rp = s / GRID_W, cp = s % GRID_W;
        const int half = j / 8, ii = j % 8; const float ang = (float)(half == 0 ? rp : cp) * rope_inv(ii, 8); const float cs = cosf(ang), sn = sinf(ang);
        st_t* q = w < 4 ? p.MQ + (size_t)r * MH * MQD + w * MQD + MNOPE + half * 16 + ii : p.P + (size_t)r * DPROJP + PO_KR + half * 16 + ii;
        const float x1 = ldf(q), x2 = ldf(q + 8); stf(q, x1 * cs - x2 * sn); stf(q + 8, x1 * sn + x2 * cs);
    } break;
    case ST_SWA: {
        const int h = (int)(i % SWA_H), r = (int)(i / SWA_H); const int kvh = h / SWA_G;
        float q[64], acc[64]; const st_t* qp = p.P + (size_t)r * DPROJP + PO_QA + h * 64;
        _Pragma("unroll") for (int d = 0; d < 64; ++d) { q[d] = ldf(qp + d) * 0.125f; acc[d] = 0.f; }
        float m = p.swa_sink[layer * SWA_H + h], den = 1.0f;
        int b, klo = 0, khi = 0;
        if (r < T) { b = r / S; const int s = r % S; klo = s - SWA_W < 0 ? 0 : s - SWA_W; khi = s + SWA_W > S - 1 ? S - 1 : s + SWA_W; } else { b = (r - T) / L; khi = -1; }
        const int nloc = khi - klo + 1;
        for (int t = 0; t < nloc + L; ++t) {
            const int kr = t < nloc ? b * S + klo + t : T + b * L + (t - nloc);
            const st_t* kp = p.P + (size_t)kr * DPROJP + PO_KA + kvh * 64; const st_t* vp = p.P + (size_t)kr * DPROJP + PO_VA + kvh * 64;
            float sc = 0.f; _Pragma("unroll") for (int d = 0; d < 64; ++d) sc += q[d] * ldf(kp + d);
            if (sc > m) { const float f = expf(m - sc); den *= f; _Pragma("unroll") for (int d = 0; d < 64; ++d) acc[d] *= f; m = sc; }
            const float pe = expf(sc - m); den += pe;
            _Pragma("unroll") for (int d = 0; d < 64; ++d) acc[d] += pe * ldf(vp + d);
        }
        const float inv = 1.0f / den; st_t* o = p.O + (size_t)r * DMIX + h * 64;
        _Pragma("unroll") for (int d = 0; d < 64; ++d) stf(o + d, acc[d] * inv);
    } break;
    case ST_GDN_SCAN: {
        const int e = (int)(i % GDV), dir = (int)((i / GDV) % 2), h = (int)((i / (GDV * 2)) % GH), b = (int)(i / (GDV * 2 * GH));
        float s[64]; _Pragma("unroll") for (int d = 0; d < 64; ++d) s[d] = 0.f;
        st_t* dst = dir == 0 ? p.OF : p.OB;
        for (int t = 0; t < L + S; ++t) {
            int r; if (t < L) r = T + b * L + (dir == 0 ? t : L - 1 - t); else { const int u = t - L; r = b * S + (dir == 0 ? u : S - 1 - u); }
            const st_t* g = p.G + (size_t)r * GQKV; const st_t* qv = g + h * 64; const st_t* kv = g + 384 + h * 64; const float v = ldf(g + 768 + h * 64 + e);
            const float beta = p.BG[(size_t)r * 24 + dir * 6 + h], alpha = expf(p.BG[(size_t)r * 24 + 12 + dir * 6 + h]);
            float ks = 0.f; _Pragma("unroll") for (int d = 0; d < 64; ++d) { s[d] *= alpha; ks += ldf(kv + d) * s[d]; }
            const float vn = beta * (v - ks); float o = 0.f;
            _Pragma("unroll") for (int d = 0; d < 64; ++d) { s[d] += ldf(kv + d) * vn; o += ldf(qv + d) * s[d]; }
            stf(dst + (size_t)r * (GH * GDV) + h * 64 + e, o * 0.125f);
        }
    } break;
    case ST_GDN_OUT: {
        const int h = (int)(i % GH), r = (int)(i / GH); const st_t* of = p.OF + (size_t)r * 384 + h * 64; const st_t* ob = p.OB + (size_t)r * 384 + h * 64;
        float ss = 0.f; for (int d = 0; d < 64; ++d) { const float o = ldf(of + d) + ldf(ob + d); ss += o * o; }
        const float rstd = 1.0f / sqrtf(ss / 64 + EPS); const float* nw = p.gdn_norm_w + layer * 64; const st_t* z = p.P + (size_t)r * DPROJP + PO_Z + h * 64;
        st_t* o = p.O + (size_t)r * DMIX + 384 + h * 64;
        for (int d = 0; d < 64; ++d) stf(o + d, (ldf(of + d) + ldf(ob + d)) * rstd * nw[d] * silu_f(ldf(z + d)));
    } break;
    case ST_MLA: {
        const int h = (int)(i % MH), r = (int)(i / MH); const float scale = 1.0f / sqrtf((float)MQD);
        float acc[64]; const st_t* qp = p.MQ + (size_t)r * MH * MQD + h * MQD;
        _Pragma("unroll") for (int d = 0; d < 64; ++d) acc[d] = 0.f;
        float m = -1e30f, den = 0.f; int b, nlat;
        if (r < T) { b = r / S; nlat = S; } else { b = (r - T) / L; nlat = 0; }
        for (int t = 0; t < nlat + L; ++t) {
            const int kr = t < nlat ? b * S + t : T + b * L + (t - nlat);
            const st_t* kn = p.MKV + (size_t)kr * MH * MKVD + h * MKVD; const st_t* krp = p.P + (size_t)kr * DPROJP + PO_KR;
            float sc = 0.f; for (int d = 0; d < 64; ++d) sc += ldf(qp + d) * ldf(kn + d);
            for (int d = 0; d < 32; ++d) sc += ldf(qp + 64 + d) * ldf(krp + d);
            sc *= scale;
            if (sc > m) { const float f = expf(m - sc); den *= f; _Pragma("unroll") for (int d = 0; d < 64; ++d) acc[d] *= f; m = sc; }
            const float pe = expf(sc - m); den += pe;
            _Pragma("unroll") for (int d = 0; d < 64; ++d) acc[d] += pe * ldf(kn + 64 + d);
        }
        const float inv = 1.0f / den; st_t* o = p.O + (size_t)r * DMIX + 768 + h * 64;
        _Pragma("unroll") for (int d = 0; d < 64; ++d) stf(o + d, acc[d] * inv);
    } break;
    case ST_POST1: {
        const int r = (int)i; const st_t* y = p.Y + (size_t)r * D; const float* xi = xin_row(p, layer, r); float* xr = xrow(p, r); float ss = 0.f;
        for (int d = 0; d < D; ++d) { const float v = ldf(y + d); ss += v * v; }
        const float rstd = 1.0f / sqrtf(ss / D + EPS); const float* gp = p.mix_norm_post + (size_t)layer * D; const float* g1 = mod_vec(p, layer, r, 2);
        float s2 = 0.f;
        for (int d = 0; d < D; ++d) { const float v = xi[d] + g1[d] * ldf(y + d) * rstd * gp[d]; xr[d] = v; s2 += v * v; }
        const float r2 = 1.0f / sqrtf(s2 / D + EPS); const float* gf = p.ffn_norm_pre + (size_t)layer * D; const float* sh = mod_vec(p, layer, r, 3); const float* sc = mod_vec(p, layer, r, 4);
        st_t* hr = p.H + (size_t)r * D;
        for (int d = 0; d < D; ++d) stf(hr + d, xr[d] * r2 * gf[d] * (1.0f + sc[d]) + sh[d]);
    } break;
    case ST_ROUTER: {
        const int n = (int)(i % NE), r = (int)(i / NE); const st_t* a = p.H + (size_t)r * D; const float* b = p.router_w + (size_t)layer * D * NE + n; float acc = 0.f;
        for (int k = 0; k < D; ++k) acc += ldf(a + k) * b[(size_t)k * NE];
        p.LOGITS[(size_t)r * NE + n] = acc;
    } break;
    case ST_ROUTE: {
        const int r = (int)i; const float* lg = p.LOGITS + (size_t)r * NE; const float* bias = p.router_bias + (size_t)layer * NE;
        float gs[NGRP];
        _Pragma("unroll") for (int g = 0; g < NGRP; ++g) { float m1 = -1e30f, m2 = -1e30f; for (int j = 0; j < 8; ++j) { const float v = sigmoid_f(lg[g * 8 + j]) + bias[g * 8 + j]; if (v > m1) { m2 = m1; m1 = v; } else if (v > m2) m2 = v; } gs[g] = m1 + m2; }
        unsigned gmask = 0;
        _Pragma("unroll") for (int k = 0; k < TOPG; ++k) { int best = 0; float bv = -1e30f; _Pragma("unroll") for (int g = 0; g < NGRP; ++g) if (!((gmask >> g) & 1u) && gs[g] > bv) { bv = gs[g]; best = g; } gmask |= 1u << best; }
        unsigned long long used = 0ull; float wsum = 0.f; float wv[TOPK]; int wi[TOPK];
        _Pragma("unroll") for (int k = 0; k < TOPK; ++k) { int best = 0; float bv = -1e30f;
            for (int e = 0; e < NE; ++e) if (((gmask >> (e / 8)) & 1u) && !((used >> e) & 1ull)) { const float v = sigmoid_f(lg[e]) + bias[e]; if (v > bv) { bv = v; best = e; } }
            used |= 1ull << best; wi[k] = best; wv[k] = sigmoid_f(lg[best]); wsum += wv[k]; }
        int* cnt = p.CNT + layer * NE;
        _Pragma("unroll") for (int k = 0; k < TOPK; ++k) { const float w = wv[k] / wsum * ROUTED_SCALE; const int e = wi[k]; const int pos = atomic_inc(cnt + e);
            p.EIDX[(size_t)r * TOPK + k] = e; p.EW[(size_t)r * TOPK + k] = w; p.EPOS[(size_t)r * TOPK + k] = pos; p.TOKLIST[(size_t)e * TA + pos] = r; p.WLIST[(size_t)e * TA + pos] = w; }
    } break;
    case ST_POST2: {
        const int r = (int)i; float* xr = xrow(p, r); const int* cnt = p.CNT + layer * NE; const st_t* f[TOPK + 1]; f[0] = p.SH + (size_t)r * D;
        _Pragma("unroll") for (int k = 0; k < TOPK; ++k) { const int e = p.EIDX[(size_t)r * TOPK + k]; f[k + 1] = p.YB + (size_t)(expert_base(cnt, e) + p.EPOS[(size_t)r * TOPK + k]) * D; }
        float ss = 0.f;
        for (int d = 0; d < D; ++d) { float v = 0.f; _Pragma("unroll") for (int k = 0; k <= TOPK; ++k) v += ldf(f[k] + d); ss += v * v; }
        const float rstd = 1.0f / sqrtf(ss / D + EPS); const float* gp = p.ffn_norm_post + (size_t)layer * D; const float* g2 = mod_vec(p, layer, r, 5);
        for (int d = 0; d < D; ++d) { float v = 0.f; _Pragma("unroll") for (int k = 0; k <= TOPK; ++k) v += ldf(f[k] + d); xr[d] = xr[d] + g2[d] * v * rstd * gp[d]; }
    } break;
    }
}

enum { WT_STATIC = 0, WT_EXPERT = 1 };
HD long long wt_items(const Params& p, int kind) {
    if (kind == WT_STATIC) { long long n = 0; for (int j = 0; j < NJOBS; ++j) n += (long long)(p.jobs[j].K / 64) * ((p.jobs[j].npad + 31) / 32); return n; }
    return (long long)NE * ((D / 64) * (DE / 32) * 2 + (DE / 64) * (D / 32));
}
HD bool wt_job(const Params& p, int kind, int layer, long long item, TJob& jb, int& kb, int& nb) {
    if (kind == WT_STATIC) {
        for (int j = 0; j < NJOBS; ++j) { const long long n = (long long)(p.jobs[j].K / 64) * ((p.jobs[j].npad + 31) / 32); if (item < n) { jb = p.jobs[j]; const int nblk = (jb.npad + 31) / 32; kb = (int)(item / nblk); nb = (int)(item % nblk); return true; } item -= n; }
        return false;
    }
    const int per_gu = (D / 64) * (DE / 32), per_d = (DE / 64) * (D / 32), per_e = 2 * per_gu + per_d;
    const int e = (int)(item / per_e); int r = (int)(item % per_e);
    if (r < 2 * per_gu) { const int w = r / per_gu; r %= per_gu; const float* src = (w == 0 ? p.e_gate : p.e_up) + ((size_t)layer * NE + e) * D * DE;
        jb = {src, p.Wt_egu + (size_t)e * 2 * DE * D, D, DE, DE, 32, w * 16, D, DE, 0}; kb = r / (DE / 32); nb = r % (DE / 32); }
    else { r -= 2 * per_gu; jb = {p.e_down + ((size_t)layer * NE + e) * DE * D, p.Wt_ed + (size_t)e * D * DE, DE, D, D, 16, 0, DE, D, 0}; kb = r / (D / 32); nb = r % (D / 32); }
    return true;
}
HD size_t wt_dst_row(const TJob& jb, int n) { return (size_t)(n / 16) * jb.grp + (n % 16) + jb.off; }
#ifdef HOST_EMU
inline void wt_item_host(const Params& p, int kind, int layer, long long item) {
    TJob jb; int kb, nb; if (!wt_job(p, kind, layer, item, jb, kb, nb)) return;
    for (int n = nb * 32; n < nb * 32 + 32 && n < jb.npad; ++n) for (int k = kb * 64; k < kb * 64 + 64; ++k)
        jb.dst[wt_dst_row(jb, n) * jb.ldt + k] = n < jb.N ? jb.src[(size_t)k * jb.ldsrc + n] : 0.f;
}
#else
__device__ __forceinline__ void wt_item_dev(const Params& p, int kind, int layer, long long item, LAS float* scr, int lane) {
    TJob jb; int kb, nb; if (!wt_job(p, kind, layer, item, jb, kb, nb)) return;
    const int k0 = kb * 64, n0 = nb * 32;
#pragma unroll 8
    for (int i = 0; i < 32; ++i) { const int kk = 2 * i + (lane >> 5), n = n0 + (lane & 31); scr[kk * 33 + (lane & 31)] = n < jb.N ? jb.src[(size_t)(k0 + kk) * jb.ldsrc + n] : 0.f; }
    asm volatile("s_waitcnt lgkmcnt(0)" ::: "memory");
    const int c = lane & 7;
#pragma unroll
    for (int j = 0; j < 4; ++j) { const int nl = (lane >> 3) + 8 * j, n = n0 + nl; const LAS float* s = scr + (8 * c) * 33 + nl;
        if (n < jb.npad) { uint4 o; o.x = pk_bf16(s[0 * 33], s[1 * 33]); o.y = pk_bf16(s[2 * 33], s[3 * 33]); o.z = pk_bf16(s[4 * 33], s[5 * 33]); o.w = pk_bf16(s[6 * 33], s[7 * 33]);
            *(uint4*)(jb.dst + wt_dst_row(jb, n) * jb.ldt + k0 + 8 * c) = o; } }
    asm volatile("s_waitcnt lgkmcnt(0)" ::: "memory");
}
#endif

enum { EPI_BF16 = 0, EPI_SWIGLU = 1, EPI_SCALE = 2, EPI_PROJ = 3, EPI_UQ = 4, EPI_UKV = 5 };
enum GStage { G_PROJ = 0, G_UQ, G_UKV, G_WOUT, G_SGU, G_SDOWN, G_EGU, G_EDOWN };
struct GemmDesc {
    const st_t* A; int lda; const int* rowidx; int a_row0, nrows;
    const st_t* Bt; int ldb, K, n0;
    int epi; st_t* out; int ldc; long long out_row0; const float* rowscale;
    const float* tab; st_t* vt;
};
HD int cdiv(int a, int b) { return (a + b - 1) / b; }
HD int gemm_ntiles(const Params& p, int gs, int layer) {
    const int mt = rows_out(layer) / 128;
    switch (gs) {
    case G_PROJ: return (TA / 128) * (DPROJP / 128);
    case G_UQ: return (TA / 128) * (MH * MQD / 128);
    case G_UKV: return (TA / 128) * (MH * MKVD / 128);
    case G_WOUT: return mt * (D / 128);
    case G_SGU: return mt * (2 * DS / 128);
    case G_SDOWN: return mt * (D / 128);
    case G_EGU: { int t = 0; for (int e = 0; e < NE; ++e) t += cdiv(p.CNT[layer * NE + e], 128); return t * (2 * DE / 128); }
    case G_EDOWN: { int t = 0; for (int e = 0; e < NE; ++e) t += cdiv(p.CNT[layer * NE + e], 128); return t * (D / 128); }
    }
    return 0;
}
HD void gemm_desc(const Params& p, int gs, int layer, int item, GemmDesc& g) {
    g.rowidx = nullptr; g.rowscale = nullptr; g.nrows = 128; g.epi = EPI_BF16; g.tab = nullptr; g.vt = nullptr;
    auto plain = [&](const st_t* A, int lda, const st_t* Bt, int K, int ntn, st_t* out, int ldc) {
        const int mt = item / ntn, nt = item % ntn; g.A = A; g.lda = lda; g.a_row0 = mt * 128; g.Bt = Bt; g.ldb = K; g.K = K; g.n0 = nt * 128; g.out = out; g.ldc = ldc; g.out_row0 = mt * 128; };
    switch (gs) {
    case G_PROJ: plain(p.H, D, p.Wt_in + (size_t)layer * DPROJP * D, D, DPROJP / 128, p.P, DPROJP); g.epi = EPI_PROJ; g.tab = g.n0 + 128 > PO_KR ? p.TABM : p.TABA; g.vt = p.VtA; break;
    case G_UQ: plain(p.CQN, MQR, p.Wt_uq + (size_t)layer * MH * MQD * MQR, MQR, MH * MQD / 128, p.MQ, MH * MQD); g.epi = EPI_UQ; g.tab = p.TABM; break;
    case G_UKV: plain(p.CKVN, MKVR, p.Wt_ukv + (size_t)layer * MH * MKVD * MKVR, MKVR, MH * MKVD / 128, p.MKV, MH * MKVD); g.epi = EPI_UKV; g.vt = p.VtM; break;
    case G_WOUT: plain(p.O, DMIX, p.Wt_out + (size_t)layer * D * DMIX, DMIX, D / 128, p.Y, D); break;
    case G_SGU: plain(p.H, D, p.Wt_sgu + (size_t)layer * 2 * DS * D, D, 2 * DS / 128, p.SACT, DS); g.epi = EPI_SWIGLU; break;
    case G_SDOWN: plain(p.SACT, DS, p.Wt_sd + (size_t)layer * D * DS, DS, D / 128, p.SH, D); break;
    case G_EGU: case G_EDOWN: {
        const int ntn = gs == G_EGU ? 2 * DE / 128 : D / 128; int mt = item / ntn; const int nt = item % ntn; const int* cnt = p.CNT + layer * NE;
        int e = 0, base = 0; for (; e < NE; ++e) { const int te = cdiv(cnt[e], 128); if (mt < te) break; mt -= te; base += cnt[e]; }
        g.a_row0 = mt * 128; g.nrows = cnt[e] - mt * 128 < 128 ? cnt[e] - mt * 128 : 128; g.n0 = nt * 128; g.out_row0 = base + mt * 128;
        if (gs == G_EGU) { g.A = p.H; g.lda = D; g.rowidx = p.TOKLIST + (size_t)e * TA; g.Bt = p.Wt_egu + (size_t)e * 2 * DE * D; g.ldb = D; g.K = D; g.epi = EPI_SWIGLU; g.out = p.ACT; g.ldc = DE; }
        else { g.A = p.ACT + (size_t)base * DE; g.lda = DE; g.Bt = p.Wt_ed + (size_t)e * D * DE; g.ldb = DE; g.K = DE; g.epi = EPI_SCALE; g.out = p.YB; g.ldc = D; g.rowscale = p.WLIST + (size_t)e * TA - base; }
    } break;
    }
}
HD bool epi_needs_partner(const GemmDesc& g, int cb) { return g.epi == EPI_UQ || (g.epi == EPI_PROJ && g.n0 + cb + 64 > PO_KR); }
HD void rope8(float (&v)[4], const float (&pv)[4], int q, const float* tab, int pos) {
    for (int r = 0; r < 4; ++r) { const int c16 = q * 4 + r, i = c16 & 7; const float cs = tab[(pos * 8 + i) * 2], sn = tab[(pos * 8 + i) * 2 + 1];
        v[r] = c16 < 8 ? v[r] * cs - pv[r] * sn : pv[r] * sn + v[r] * cs; }
}
HD void gemm_epi(const GemmDesc& g, int rl, int cb, int q, float (&v)[4][4], const float (&pv)[4][4]) {
    if (rl >= g.nrows) return;
    const long long orow = g.out_row0 + rl;
    if (g.epi == EPI_SWIGLU) {
        for (int jj = 0; jj < 2; ++jj) { float a[4]; for (int r = 0; r < 4; ++r) a[r] = silu_f(v[2 * jj][r]) * v[2 * jj + 1][r];
            st4(g.out + (size_t)orow * g.ldc + (g.n0 + cb) / 2 + jj * 16 + q * 4, a[0], a[1], a[2], a[3]); }
        return;
    }
    if (g.epi >= EPI_PROJ) {
        const int row = (int)orow; const bool lat = row < T; const int bb = lat ? row / S : (row - T) / L, kidx = lat ? row % S : S + (row - T) % L;
        const int rp = lat ? (row % S) / GRID_W : 0, cp = lat ? (row % S) % GRID_W : 0, span = (g.n0 + cb) / 64;
        if (g.epi == EPI_PROJ) {
            if (span < 8) { if (lat) for (int hp = 0; hp < 2; ++hp) for (int r = 0; r < 4; ++r) { const int i = q * 4 + r, pos = hp ? cp : rp; const float cs = g.tab[(pos * 16 + i) * 2], sn = g.tab[(pos * 16 + i) * 2 + 1];
                    const float x1 = v[2 * hp][r], x2 = v[2 * hp + 1][r]; v[2 * hp][r] = x1 * cs - x2 * sn; v[2 * hp + 1][r] = x1 * sn + x2 * cs; } }
            else if (span < 10) { for (int j = 0; j < 4; ++j) for (int r = 0; r < 4; ++r) stf(g.vt + ((size_t)(bb * SWA_KVH + span - 8) * 64 + j * 16 + q * 4 + r) * NK + kidx, v[j][r]); return; }
            else if (g.n0 + cb + 64 > PO_KR && lat) { rope8(v[2], pv[2], q, g.tab, rp); rope8(v[3], pv[3], q, g.tab, cp); }
        } else if (g.epi == EPI_UQ) {
            if (lat) for (int j = 0; j < 4; ++j) { const int k6 = ((g.n0 + cb) / 16 + j) % 6; if (k6 >= 4) rope8(v[j], pv[j], q, g.tab, k6 == 4 ? rp : cp); }
        } else {
            if (span & 1) { for (int j = 0; j < 4; ++j) for (int r = 0; r < 4; ++r) stf(g.vt + ((size_t)(bb * MH + span / 2) * 64 + j * 16 + q * 4 + r) * NK + kidx, v[j][r]); return; }
        }
    }
    const float w = g.epi == EPI_SCALE ? g.rowscale[orow] : 1.0f;
    for (int j = 0; j < 4; ++j) st4(g.out + (size_t)orow * g.ldc + g.n0 + cb + j * 16 + q * 4, v[j][0] * w, v[j][1] * w, v[j][2] * w, v[j][3] * w);
}
#ifdef HOST_EMU
inline void gemm_tile_host(const GemmDesc& g) {
    for (int rl = 0; rl < g.nrows; ++rl) {
        const long long ar = g.rowidx ? g.rowidx[g.a_row0 + rl] : g.a_row0 + rl; const st_t* a = g.A + (size_t)ar * g.lda;
        for (int cb = 0; cb < 128; cb += 64) for (int q = 0; q < 4; ++q) { float v[4][4], pv[4][4];
            for (int j = 0; j < 4; ++j) for (int r = 0; r < 4; ++r) { const st_t* b = g.Bt + (size_t)(g.n0 + cb + j * 16 + q * 4 + r) * g.ldb; float acc = 0.f; for (int k = 0; k < g.K; ++k) acc += a[k] * b[k]; v[j][r] = acc;
                const st_t* b2 = g.Bt + (size_t)(g.n0 + cb + j * 16 + (q ^ 2) * 4 + r) * g.ldb; float acc2 = 0.f; for (int k = 0; k < g.K; ++k) acc2 += a[k] * b2[k]; pv[j][r] = acc2; }
            gemm_epi(g, rl, cb, q, v, pv); }
    }
}
#else
__device__ __forceinline__ void gemm_tile_dev(const GemmDesc& g, LAS unsigned char* lds, const int tid) {
    const int lane = tid & 63, wave = __builtin_amdgcn_readfirstlane(tid >> 6), wr = wave >> 1, wc = wave & 1;
    const int lrow = lane >> 3, slot = lane & 7;
    const st_t* asrc[4]; const st_t* bsrc[4];
#pragma unroll
    for (int i = 0; i < 4; ++i) {
        const int row = i * 32 + wave * 8 + lrow, chunk = slot ^ ((row >> 1) & 7);
        int rl = row < g.nrows ? row : g.nrows - 1;
        const long long ar = g.rowidx ? (long long)g.rowidx[g.a_row0 + rl] : (long long)(g.a_row0 + rl);
        asrc[i] = g.A + (size_t)ar * g.lda + chunk * 8;
        bsrc[i] = g.Bt + (size_t)(g.n0 + row) * g.ldb + chunk * 8;
    }
    const int nt = g.K / 64;
    auto stage = [&](int buf, int t) {
#pragma unroll
        for (int i = 0; i < 4; ++i) {
            __builtin_amdgcn_global_load_lds((const unsigned*)(asrc[i] + t * 64), (LAS unsigned*)(lds + buf * 32768 + (i * 32 + wave * 8) * 128), 16, 0, 0);
            __builtin_amdgcn_global_load_lds((const unsigned*)(bsrc[i] + t * 64), (LAS unsigned*)(lds + buf * 32768 + 16384 + (i * 32 + wave * 8) * 128), 16, 0, 0);
        }
    };
    f32x4 acc[4][4];
#pragma unroll
    for (int i = 0; i < 4; ++i)
#pragma unroll
        for (int j = 0; j < 4; ++j) acc[i][j] = (f32x4){0.f, 0.f, 0.f, 0.f};
    const int fr = lane & 15, fq = lane >> 4;
    __syncthreads();
    stage(0, 0);
    __syncthreads();
    for (int t = 0; t < nt; ++t) {
        const int cur = t & 1;
        if (t + 1 < nt) stage(cur ^ 1, t + 1);
        const LAS unsigned char* As = lds + cur * 32768; const LAS unsigned char* Bs = As + 16384;
#pragma unroll
        for (int kk = 0; kk < 2; ++kk) {
            bf16x8 af[4], bfr[4];
#pragma unroll
            for (int i = 0; i < 4; ++i) { const int row = wr * 64 + i * 16 + fr; af[i] = *(const LAS bf16x8*)(As + row * 128 + (((kk * 4 + fq) ^ ((row >> 1) & 7)) << 4)); }
#pragma unroll
            for (int j = 0; j < 4; ++j) { const int row = wc * 64 + j * 16 + fr; bfr[j] = *(const LAS bf16x8*)(Bs + row * 128 + (((kk * 4 + fq) ^ ((row >> 1) & 7)) << 4)); }
#pragma unroll
            for (int i = 0; i < 4; ++i)
#pragma unroll
                for (int j = 0; j < 4; ++j) acc[i][j] = __builtin_amdgcn_mfma_f32_16x16x32_bf16(bfr[j], af[i], acc[i][j], 0, 0, 0);
        }
        __syncthreads();
    }
    const bool need_pv = epi_needs_partner(g, wc * 64);
#pragma unroll
    for (int i = 0; i < 4; ++i) { float v[4][4], pv[4][4];
#pragma unroll
        for (int j = 0; j < 4; ++j)
#pragma unroll
            for (int r = 0; r < 4; ++r) { v[j][r] = acc[i][j][r]; pv[j][r] = 0.f; }
        if (need_pv) {
#pragma unroll
            for (int j = 0; j < 4; ++j)
#pragma unroll
                for (int r = 0; r < 4; ++r) pv[j][r] = __shfl_xor(v[j][r], 32); }
        gemm_epi(g, wr * 64 + i * 16 + fr, wc * 64, fq, v, pv); }
}
#endif


struct AttnDesc {
    int dqk;
    const st_t* Q; int ldq, q_row0;
    const st_t* K1; int ldk1; const st_t* K2; int ldk2;
    int lat_row0, ctx_row0;
    const st_t* Vt;
    int kt_lo, kt_hi, nctx;
    int mask, qpos0;
    float m_init, l_init, c;
    st_t* O; int o_col;
};
HD int attn_nitems(int layer) { const int lat = B * MH * (S / 128) + B * SWA_H * (S / 128); return layer == DEPTH - 1 ? lat : lat + B * MH * (L / 128) + B * SWA_H * (L / 128); }
HD void attn_desc(const Params& p, int layer, int item, AttnDesc& a) {
    const float LOG2E = 1.4426950408889634f;
    const int n_mla = B * MH * (S / 128), n_swa = B * SWA_H * (S / 128), n_mlac = B * MH * (L / 128);
    bool mla, ctxq; int b, h, qb;
    if (item < n_mla) { mla = true; ctxq = false; qb = item % (S / 128); h = (item / (S / 128)) % MH; b = item / (S / 128) / MH; }
    else if (item < n_mla + n_swa) { item -= n_mla; mla = false; ctxq = false; qb = item % (S / 128); h = (item / (S / 128)) % SWA_H; b = item / (S / 128) / SWA_H; }
    else if (item < n_mla + n_swa + n_mlac) { item -= n_mla + n_swa; mla = true; ctxq = true; qb = item % (L / 128); h = (item / (L / 128)) % MH; b = item / (L / 128) / MH; }
    else { item -= n_mla + n_swa + n_mlac; mla = false; ctxq = true; qb = item % (L / 128); h = (item / (L / 128)) % SWA_H; b = item / (L / 128) / SWA_H; }
    a.q_row0 = ctxq ? T + b * L + qb * 128 : b * S + qb * 128; a.lat_row0 = b * S; a.ctx_row0 = T + b * L; a.nctx = L / 64; a.qpos0 = qb * 128; a.O = p.O;
    if (mla) {
        a.dqk = 96; a.Q = p.MQ + h * MQD; a.ldq = MH * MQD; a.K1 = p.MKV + h * MKVD; a.ldk1 = MH * MKVD; a.K2 = p.P + PO_KR; a.ldk2 = DPROJP;
        a.Vt = p.VtM + (size_t)(b * MH + h) * 64 * NK; a.kt_lo = 0; a.kt_hi = ctxq ? 0 : S / 64; a.mask = 0; a.m_init = -1e30f; a.l_init = 0.f; a.c = LOG2E / sqrtf((float)MQD); a.o_col = 768 + h * 64;
    } else {
        const int kvh = h / SWA_G;
        a.dqk = 64; a.Q = p.P + PO_QA + h * 64; a.ldq = DPROJP; a.K1 = p.P + PO_KA + kvh * 64; a.ldk1 = DPROJP; a.K2 = nullptr; a.ldk2 = 0;
        a.Vt = p.VtA + (size_t)(b * SWA_KVH + kvh) * 64 * NK; a.mask = ctxq ? 0 : 1;
        if (ctxq) { a.kt_lo = 0; a.kt_hi = 0; } else { a.kt_lo = (a.qpos0 - SWA_W) / 64; if (a.kt_lo < 0) a.kt_lo = 0; a.kt_hi = (a.qpos0 + 128 + SWA_W) / 64; if (a.kt_hi > S / 64) a.kt_hi = S / 64; }
        a.m_init = p.swa_sink[layer * SWA_H + h] * LOG2E; a.l_init = 1.f; a.c = LOG2E * 0.125f; a.o_col = h * 64;
    }
}
#ifdef HOST_EMU
inline void attn_tile_host(const AttnDesc& a) {
    const int nl = a.kt_hi - a.kt_lo, ntile = nl + a.nctx;
    for (int q = 0; q < 128; ++q) {
        const st_t* qr = a.Q + (size_t)(a.q_row0 + q) * a.ldq; float m = a.m_init, l = a.l_init, acc[64]; for (int d = 0; d < 64; ++d) acc[d] = 0.f;
        for (int t = 0; t < ntile; ++t) for (int kk = 0; kk < 64; ++kk) {
            const int kidx = t < nl ? (a.kt_lo + t) * 64 + kk : S + (t - nl) * 64 + kk; const int row = kidx < S ? a.lat_row0 + kidx : a.ctx_row0 + kidx - S;
            if (a.mask && t < nl) { const int dq = a.qpos0 + q - kidx; if (dq > SWA_W || dq < -SWA_W) continue; }
            float sc = 0.f; for (int d = 0; d < 64; ++d) sc += qr[d] * a.K1[(size_t)row * a.ldk1 + d];
            if (a.dqk > 64) for (int d = 64; d < a.dqk; ++d) sc += qr[d] * a.K2[(size_t)row * a.ldk2 + d - 64];
            sc *= a.c; if (sc > m) { const float f = exp2f(m - sc); l *= f; for (int d = 0; d < 64; ++d) acc[d] *= f; m = sc; }
            const float pe = exp2f(sc - m); l += pe; for (int d = 0; d < 64; ++d) acc[d] += pe * a.Vt[(size_t)d * NK + kidx];
        }
        for (int d = 0; d < 64; ++d) a.O[(size_t)(a.q_row0 + q) * DMIX + a.o_col + d] = acc[d] / l;
    }
}
#else
typedef float f32x16 __attribute__((ext_vector_type(16)));
typedef unsigned u32x4 __attribute__((ext_vector_type(4)));
typedef unsigned u32x2 __attribute__((ext_vector_type(2)));
__device__ __forceinline__ int crow16(int reg, int h) { return (reg & 3) + 8 * (reg >> 2) + 4 * h; }
template <int DQK>
__device__ __forceinline__ void attn_tile_dev(const AttnDesc& a, LAS unsigned char* lds, const int tid) {
    constexpr int KSTR = DQK * 2 + 16, VSTR = 136, KBYTES = 64 * KSTR, BUF = KBYTES + 64 * VSTR, CPR = DQK / 8, KCH = 64 * CPR / 256, NKS = DQK / 16;
    const int lane = tid & 63, wave = __builtin_amdgcn_readfirstlane(tid >> 6), l31 = lane & 31, hh = lane >> 5;
    bf16x8 qf[NKS];
    { const st_t* qrow = a.Q + (size_t)(a.q_row0 + wave * 32 + l31) * a.ldq;
#pragma unroll
      for (int ks = 0; ks < NKS; ++ks) qf[ks] = *(const bf16x8*)(qrow + 16 * ks + 8 * hh); }
    f32x16 ot[2];
#pragma unroll
    for (int r = 0; r < 16; ++r) { ot[0][r] = 0.f; ot[1][r] = 0.f; }
    float m = a.m_init, lsum = hh == 0 ? a.l_init : 0.f;
    const int nl = a.kt_hi - a.kt_lo, ntile = nl + a.nctx; const float c = a.c;
    u32x4 kreg[KCH], vreg[2];
    auto gload = [&](int t) {
        const int kidx0 = t < nl ? (a.kt_lo + t) * 64 : S + (t - nl) * 64; const int rowbase = t < nl ? a.lat_row0 + kidx0 : a.ctx_row0 + kidx0 - S;
#pragma unroll
        for (int u = 0; u < KCH; ++u) { const int ci = tid + 256 * u, row = ci / CPR, cc = ci % CPR;
            const st_t* src = (DQK == 64 || cc < 8) ? a.K1 + (size_t)(rowbase + row) * a.ldk1 + cc * 8 : a.K2 + (size_t)(rowbase + row) * a.ldk2 + (cc - 8) * 8;
            kreg[u] = *(const u32x4*)src; }
#pragma unroll
        for (int u = 0; u < 2; ++u) { const int ci = tid + 256 * u, dv = ci >> 3, cc = ci & 7; vreg[u] = *(const u32x4*)(a.Vt + (size_t)dv * NK + kidx0 + cc * 8); }
    };
    auto lstore = [&](int buf) {
#pragma unroll
        for (int u = 0; u < KCH; ++u) { const int ci = tid + 256 * u, row = ci / CPR, cc = ci % CPR; *(LAS u32x4*)(lds + buf * BUF + row * KSTR + cc * 16) = kreg[u]; }
#pragma unroll
        for (int u = 0; u < 2; ++u) { const int ci = tid + 256 * u, dv = ci >> 3, cc = ci & 7; LAS u32x2* d = (LAS u32x2*)(lds + buf * BUF + KBYTES + dv * VSTR + cc * 16);
            d[0] = (u32x2){vreg[u].x, vreg[u].y}; d[1] = (u32x2){vreg[u].z, vreg[u].w}; }
    };
    __syncthreads();
    gload(0); lstore(0);
    __syncthreads();
    for (int t = 0; t < ntile; ++t) {
        const int cur = t & 1;
        if (t + 1 < ntile) gload(t + 1);
        const LAS unsigned char* Ks = lds + cur * BUF; const LAS unsigned char* Vs = Ks + KBYTES;
        f32x16 st[2];
#pragma unroll
        for (int kb = 0; kb < 2; ++kb) {
#pragma unroll
            for (int r = 0; r < 16; ++r) st[kb][r] = 0.f;
#pragma unroll
            for (int ks = 0; ks < NKS; ++ks) { const bf16x8 af = *(const LAS bf16x8*)(Ks + (kb * 32 + l31) * KSTR + (16 * ks + 8 * hh) * 2);
                st[kb] = __builtin_amdgcn_mfma_f32_32x32x16_bf16(af, qf[ks], st[kb], 0, 0, 0); }
        }
        if (a.mask && t < nl) {
            const int d0 = a.qpos0 + wave * 32 + l31 - (a.kt_lo + t) * 64;
#pragma unroll
            for (int kb = 0; kb < 2; ++kb)
#pragma unroll
                for (int r = 0; r < 16; ++r) { const int dq = d0 - (kb * 32 + crow16(r, hh)); if (dq > SWA_W || dq < -SWA_W) st[kb][r] = -1e30f; }
        }
        float mx = st[0][0];
#pragma unroll
        for (int r = 1; r < 16; ++r) mx = fmaxf(mx, st[0][r]);
#pragma unroll
        for (int r = 0; r < 16; ++r) mx = fmaxf(mx, st[1][r]);
        mx = fmaxf(mx, __shfl_xor(mx, 32));
        const float m_new = fmaxf(m, mx * c), alpha = __builtin_amdgcn_exp2f(m - m_new);
        float rs = 0.f;
#pragma unroll
        for (int kb = 0; kb < 2; ++kb)
#pragma unroll
            for (int r = 0; r < 16; ++r) { const float pe = __builtin_amdgcn_exp2f(__builtin_fmaf(st[kb][r], c, -m_new)); st[kb][r] = pe; rs += pe; }
        lsum = lsum * alpha + rs; m = m_new;
#pragma unroll
        for (int r = 0; r < 16; ++r) { ot[0][r] *= alpha; ot[1][r] *= alpha; }
#pragma unroll
        for (int kb = 0; kb < 2; ++kb)
#pragma unroll
            for (int s2 = 0; s2 < 2; ++s2) {
                u32x4 pw; pw.x = pk_bf16(st[kb][8 * s2 + 0], st[kb][8 * s2 + 1]); pw.y = pk_bf16(st[kb][8 * s2 + 2], st[kb][8 * s2 + 3]);
                pw.z = pk_bf16(st[kb][8 * s2 + 4], st[kb][8 * s2 + 5]); pw.w = pk_bf16(st[kb][8 * s2 + 6], st[kb][8 * s2 + 7]);
                const bf16x8 pb = __builtin_bit_cast(bf16x8, pw);
#pragma unroll
                for (int db = 0; db < 2; ++db) { const LAS unsigned char* vp = Vs + (db * 32 + l31) * VSTR + (kb * 32 + 16 * s2 + 4 * hh) * 2;
                    const u32x2 lo = *(const LAS u32x2*)vp, hi = *(const LAS u32x2*)(vp + 16); u32x4 vw; vw.x = lo.x; vw.y = lo.y; vw.z = hi.x; vw.w = hi.y;
                    ot[db] = __builtin_amdgcn_mfma_f32_32x32x16_bf16(__builtin_bit_cast(bf16x8, vw), pb, ot[db], 0, 0, 0); }
            }
        if (t + 1 < ntile) lstore(cur ^ 1);
        __syncthreads();
    }
    const float inv = 1.0f / (lsum + __shfl_xor(lsum, 32));
    st_t* orow = a.O + (size_t)(a.q_row0 + wave * 32 + l31) * DMIX + a.o_col;
#pragma unroll
    for (int db = 0; db < 2; ++db)
#pragma unroll
        for (int g = 0; g < 4; ++g) st4(orow + db * 32 + 8 * g + 4 * hh, ot[db][4 * g] * inv, ot[db][4 * g + 1] * inv, ot[db][4 * g + 2] * inv, ot[db][4 * g + 3] * inv);
}
#endif


HD int gdn_row(int b, int dir, int n, int i) {
    if (n < L / 64) { const int pos = n * 64 + i; return T + b * L + (dir == 0 ? pos : L - 1 - pos); }
    const int pos = (n - L / 64) * 64 + i; return b * S + (dir == 0 ? pos : S - 1 - pos);
}
#ifdef HOST_EMU
inline void gdn_pre_host(const Params& p, int item) {
    const int c = item / NCH, n = item % NCH, dir = c & 1, h = (c >> 1) % GH, b = (c >> 1) / GH;
    float gc[64], beta[64]; const st_t* kk[64]; const st_t* qq[64]; const st_t* vv[64]; float acc = 0.f;
    for (int i = 0; i < 64; ++i) { const int r = gdn_row(b, dir, n, i); acc += p.BG[(size_t)r * 24 + 12 + dir * 6 + h]; gc[i] = acc; beta[i] = p.BG[(size_t)r * 24 + dir * 6 + h];
        qq[i] = p.G + (size_t)r * GQKV + h * 64; kk[i] = qq[i] + 384; vv[i] = qq[i] + 768; }
    static thread_local float A[64][64], XU[64][64], XW[64][64];
    for (int i = 0; i < 64; ++i) for (int j = 0; j < 64; ++j) { float d = 0.f; for (int e = 0; e < 64; ++e) d += kk[i][e] * kk[j][e]; A[i][j] = j < i ? beta[i] * d * expf(gc[i] - gc[j]) : 0.f; }
    for (int i = 0; i < 64; ++i) for (int e = 0; e < 64; ++e) { float u = beta[i] * vv[i][e], w = beta[i] * expf(gc[i]) * kk[i][e];
        for (int j = 0; j < i; ++j) { u -= A[i][j] * XU[j][e]; w -= A[i][j] * XW[j][e]; } XU[i][e] = u; XW[i][e] = w; }
    st_t* ch = p.CH + (size_t)item * 5 * 4096;
    for (int i = 0; i < 64; ++i) for (int e = 0; e < 64; ++e) {
        ch[0 * 4096 + e * 64 + i] = XU[i][e]; ch[1 * 4096 + i * 64 + e] = XW[i][e]; ch[2 * 4096 + i * 64 + e] = qq[i][e] * 0.125f * expf(gc[i]);
        float d = 0.f; for (int x = 0; x < 64; ++x) d += qq[i][x] * kk[e][x]; ch[3 * 4096 + i * 64 + e] = e <= i ? d * 0.125f * expf(gc[i] - gc[e]) : 0.f;
        ch[4 * 4096 + e * 64 + i] = kk[i][e] * expf(gc[63] - gc[i]); }
    p.GAM[item] = expf(gc[63]);
}
inline void gdn_scan_host(const Params& p, int c) {
    const int dir = c & 1, h = (c >> 1) % GH, b = (c >> 1) / GH; st_t* dst = dir == 0 ? p.OF : p.OB;
    static thread_local float Sm[64][64], Vn[64][64]; for (int d = 0; d < 64; ++d) for (int e = 0; e < 64; ++e) Sm[d][e] = 0.f;
    for (int n = 0; n < NCH; ++n) { const st_t* ch = p.CH + (size_t)(c * NCH + n) * 5 * 4096; const float gam = p.GAM[c * NCH + n];
        for (int i = 0; i < 64; ++i) for (int e = 0; e < 64; ++e) { float v = ch[0 * 4096 + e * 64 + i]; for (int d = 0; d < 64; ++d) v -= ch[1 * 4096 + i * 64 + d] * Sm[d][e]; Vn[i][e] = v; }
        for (int i = 0; i < 64; ++i) for (int e = 0; e < 64; ++e) { float o = 0.f; for (int d = 0; d < 64; ++d) o += ch[2 * 4096 + i * 64 + d] * Sm[d][e]; for (int j = 0; j < 64; ++j) o += ch[3 * 4096 + i * 64 + j] * Vn[j][e];
            dst[(size_t)gdn_row(b, dir, n, i) * (GH * GDV) + h * 64 + e] = o; }
        for (int d = 0; d < 64; ++d) for (int e = 0; e < 64; ++e) { float sn = gam * Sm[d][e]; for (int i = 0; i < 64; ++i) sn += ch[4 * 4096 + d * 64 + i] * Vn[i][e]; Sm[d][e] = sn; }
    }
}
#else
template <int... Is, class F> __device__ __forceinline__ void static_for_impl(std::integer_sequence<int, Is...>, F&& f) { (f(std::integral_constant<int, Is>{}), ...); }
template <int N, class F> __device__ __forceinline__ void static_for(F&& f) { static_for_impl(std::make_integer_sequence<int, N>{}, f); }
__device__ __forceinline__ float bf_lo(unsigned u) { return __builtin_bit_cast(float, u << 16); }
__device__ __forceinline__ float bf_hi(unsigned u) { return __builtin_bit_cast(float, u & 0xffff0000u); }
template <int ROLE>
__device__ __forceinline__ void gdn_pre_role(const Params& p, int pair, LAS unsigned char* lds, const int lane, const int wave) {
    constexpr int AST = 68;
    const int l31 = lane & 31, hh = lane >> 5;
    const int item = pair * 2 + (wave >> 1);
    const int c = item / NCH, n = item % NCH, dir = c & 1, h = (c >> 1) % GH, b = (c >> 1) / GH;
    LAS float* At = (LAS float*)(lds + (wave >> 1) * 18432); LAS float* gcs = At + 64 * AST; LAS float* bts = gcs + 64; LAS float* ebt = bts + 64;
    st_t* ch = p.CH + (size_t)item * 5 * 4096;
    const int row0 = gdn_row(b, dir, n, 0); const int sgn = dir == 0 ? 1 : -1;
    const int myrow = row0 + sgn * lane;
    float gc = p.BG[(size_t)myrow * 24 + 12 + dir * 6 + h]; const float beta = p.BG[(size_t)myrow * 24 + dir * 6 + h];
#pragma unroll
    for (int o = 1; o < 64; o <<= 1) { const float t = __shfl_up(gc, o); if (lane >= o) gc += t; }
    const float gc63 = __shfl(gc, 63);
    __syncthreads();
    if (ROLE == 0) { gcs[lane] = gc; bts[lane] = beta; ebt[lane] = beta * __expf(gc); }
    const st_t* gbase = p.G + h * 64;
    f32x16 d00, d10, d11;
#pragma unroll
    for (int r = 0; r < 16; ++r) { d00[r] = 0.f; d10[r] = 0.f; d11[r] = 0.f; }
    { const size_t r0 = (size_t)(row0 + sgn * l31) * GQKV, r1 = (size_t)(row0 + sgn * (32 + l31)) * GQKV; constexpr int xo = ROLE == 0 ? 384 : 0;
#pragma unroll
      for (int ks = 0; ks < 4; ++ks) {
          const bf16x8 a0 = *(const bf16x8*)(gbase + r0 + xo + 16 * ks + 8 * hh), a1 = *(const bf16x8*)(gbase + r1 + xo + 16 * ks + 8 * hh);
          const bf16x8 b0 = *(const bf16x8*)(gbase + r0 + 384 + 16 * ks + 8 * hh), b1 = *(const bf16x8*)(gbase + r1 + 384 + 16 * ks + 8 * hh);
          d00 = __builtin_amdgcn_mfma_f32_32x32x16_bf16(a0, b0, d00, 0, 0, 0); d10 = __builtin_amdgcn_mfma_f32_32x32x16_bf16(a1, b0, d10, 0, 0, 0); d11 = __builtin_amdgcn_mfma_f32_32x32x16_bf16(a1, b1, d11, 0, 0, 0); } }
    __syncthreads();
    auto post = [&](const f32x16& d, int ib, int jb) __attribute__((always_inline)) {
        const int j = 32 * jb + l31; const float gcj = gcs[j];
#pragma unroll
        for (int g = 0; g < 4; ++g) { const int i0 = 32 * ib + 8 * g + 4 * hh; const f32x4 gci = *(const LAS f32x4*)(gcs + i0);
            if (ROLE == 0) { const f32x4 bi = *(const LAS f32x4*)(bts + i0); f32x4 o;
#pragma unroll
                for (int u = 0; u < 4; ++u) o[u] = (j < i0 + u) ? bi[u] * d[4 * g + u] * __expf(gci[u] - gcj) : 0.f;
                *(LAS f32x4*)(At + j * AST + i0) = o; }
            else {
#pragma unroll
                for (int u = 0; u < 4; ++u) { const float v = (j <= i0 + u) ? 0.125f * d[4 * g + u] * __expf(gci[u] - gcj) : 0.f; stf(ch + 3 * 4096 + (i0 + u) * 64 + j, v); } } }
    };
    post(d00, 0, 0); post(d10, 1, 0); post(d11, 1, 1);
    if (ROLE == 1) {
#pragma unroll
        for (int r = 0; r < 16; ++r) stf(ch + 3 * 4096 + crow16(r, hh) * 64 + 32 + l31, 0.f); }
    __syncthreads();
    float acc[64];
#pragma unroll
    for (int i = 0; i < 64; ++i) acc[i] = 0.f;
    { const long long stp = (long long)sgn * GQKV;
      const st_t* sp = gbase + (ROLE == 0 ? 768 : 384) + lane + (size_t)row0 * GQKV;
      const LAS float* sc = ROLE == 0 ? bts : ebt;
      float cur[8], pre[8];
#pragma unroll
      for (int u = 0; u < 8; ++u) { cur[u] = ldf(sp + u * stp); pre[u] = ldf(sp + (8 + u) * stp); }
      unsigned pk[4]; f32x4 s4 = (f32x4){0.f, 0.f, 0.f, 0.f}; float xprev = 0.f;
      static_for<64>([&](auto jc) __attribute__((always_inline)) {
          constexpr int j = decltype(jc)::value;
          if constexpr ((j & 7) == 0 && j > 0) {
#pragma unroll
              for (int u = 0; u < 8; ++u) cur[u] = pre[u];
              if constexpr (j + 8 < 64) { const st_t* gp = sp + (j + 8) * stp; asm volatile("" : "+v"(gp));
#pragma unroll
                  for (int u = 0; u < 8; ++u) pre[u] = ldf(gp + u * stp); }
          }
          if constexpr ((j & 3) == 0) s4 = *(const LAS f32x4*)(sc + j);
          const float x = s4[j & 3] * cur[j & 7] - acc[j];
          if constexpr (ROLE == 0) {
              if constexpr ((j & 1) == 1) pk[(j >> 1) & 3] = pk_bf16(xprev, x);
              if constexpr ((j & 7) == 7) { u32x4 w; w.x = pk[0]; w.y = pk[1]; w.z = pk[2]; w.w = pk[3]; *(u32x4*)(ch + 0 * 4096 + lane * 64 + (j - 7)) = w; }
          } else stf(ch + 1 * 4096 + j * 64 + lane, x);
          xprev = x;
          constexpr int I0 = ((j + 1) >> 2) << 2;
#pragma unroll
          for (int i4 = I0; i4 < 64; i4 += 4) { const f32x4 av = *(const LAS f32x4*)(At + j * AST + i4);
#pragma unroll
              for (int u = 0; u < 4; ++u) if (i4 + u > j) acc[i4 + u] += av[u] * x;
              asm volatile("" : "+v"(acc[i4]), "+v"(acc[i4 + 1]), "+v"(acc[i4 + 2]), "+v"(acc[i4 + 3])); }
          __builtin_amdgcn_sched_barrier(0);
      }); }
    { const st_t* src = gbase + (size_t)myrow * GQKV + (ROLE == 0 ? 384 : 0); const float sc = ROLE == 0 ? __expf(gc63 - gc) : 0.125f * __expf(gc);
#pragma unroll
      for (int c8 = 0; c8 < 8; ++c8) { const u32x4 w = *(const u32x4*)(src + 8 * c8);
          const float f0 = bf_lo(w.x) * sc, f1 = bf_hi(w.x) * sc, f2 = bf_lo(w.y) * sc, f3 = bf_hi(w.y) * sc, f4 = bf_lo(w.z) * sc, f5 = bf_hi(w.z) * sc, f6 = bf_lo(w.w) * sc, f7 = bf_hi(w.w) * sc;
          if (ROLE == 0) { st_t* kt = ch + 4 * 4096 + (8 * c8) * 64 + lane; stf(kt, f0); stf(kt + 64, f1); stf(kt + 128, f2); stf(kt + 192, f3); stf(kt + 256, f4); stf(kt + 320, f5); stf(kt + 384, f6); stf(kt + 448, f7); }
          else { u32x4 o; o.x = pk_bf16(f0, f1); o.y = pk_bf16(f2, f3); o.z = pk_bf16(f4, f5); o.w = pk_bf16(f6, f7); *(u32x4*)(ch + 2 * 4096 + lane * 64 + 8 * c8) = o; } } }
    if (ROLE == 0 && lane == 0) p.GAM[item] = __expf(gc63);
}
static_assert((NCHAIN * NCH) % 2 == 0, "chunk items come in pairs");
__device__ __forceinline__ void gdn_pre_dev(const Params& p, int pair, LAS unsigned char* lds, const int tid) {
    const int lane = tid & 63, wave = __builtin_amdgcn_readfirstlane(tid >> 6);
    if ((wave & 1) == 0) gdn_pre_role<0>(p, pair, lds, lane, wave); else gdn_pre_role<1>(p, pair, lds, lane, wave);
}
__device__ __forceinline__ void gdn_scan_dev(const Params& p, int c, LAS unsigned char* lds, const int tid) {
    constexpr int RS = 136, MB = 64 * RS;
    const int lane = tid & 63, wave = __builtin_amdgcn_readfirstlane(tid >> 6), r16 = lane & 15, q = lane >> 4;
    const int dir = c & 1, h = (c >> 1) % GH, b = (c >> 1) / GH; st_t* dst = (dir == 0 ? p.OF : p.OB) + h * 64 + 16 * wave + r16;
    f32x4 Sb[4];
#pragma unroll
    for (int i = 0; i < 4; ++i) Sb[i] = (f32x4){0.f, 0.f, 0.f, 0.f};
    u32x4 stg[10]; float gam_next = 0.f;
    auto gload = [&](int n) { const u32x4* src = (const u32x4*)(p.CH + (size_t)(c * NCH + n) * 5 * 4096);
#pragma unroll
        for (int u = 0; u < 10; ++u) stg[u] = src[tid + 256 * u];
        gam_next = p.GAM[c * NCH + n]; };
    auto lstore = [&]() {
#pragma unroll
        for (int u = 0; u < 10; ++u) { const int ci = tid + 256 * u, mat = ci >> 9, row = (ci >> 3) & 63, cc = ci & 7; LAS u32x2* d = (LAS u32x2*)(lds + mat * MB + row * RS + cc * 16);
            d[0] = (u32x2){stg[u].x, stg[u].y}; d[1] = (u32x2){stg[u].z, stg[u].w}; } };
    auto afrag = [&](int mat, int row, int a2) -> bf16x8 { const LAS unsigned char* bp = lds + mat * MB + row * RS + (32 * a2 + 4 * q) * 2;
        const u32x2 lo = *(const LAS u32x2*)bp, hi = *(const LAS u32x2*)(bp + 32); u32x4 w; w.x = lo.x; w.y = lo.y; w.z = hi.x; w.w = hi.y; return __builtin_bit_cast(bf16x8, w); };
    auto pack2 = [&](const f32x4& x, const f32x4& y) -> bf16x8 { u32x4 w; w.x = pk_bf16(x[0], x[1]); w.y = pk_bf16(x[2], x[3]); w.z = pk_bf16(y[0], y[1]); w.w = pk_bf16(y[2], y[3]); return __builtin_bit_cast(bf16x8, w); };
    __syncthreads();
    gload(0); lstore(); float gam = gam_next;
    __syncthreads();
    for (int n = 0; n < NCH; ++n) {
        if (n + 1 < NCH) gload(n + 1);
        const bf16x8 sb0 = pack2(Sb[0], Sb[1]), sb1 = pack2(Sb[2], Sb[3]);
        f32x4 vn[4], oc[4];
#pragma unroll
        for (int tb = 0; tb < 4; ++tb) {
            f32x4 acc = (f32x4){0.f, 0.f, 0.f, 0.f};
            acc = __builtin_amdgcn_mfma_f32_16x16x32_bf16(afrag(1, 16 * tb + r16, 0), sb0, acc, 0, 0, 0);
            acc = __builtin_amdgcn_mfma_f32_16x16x32_bf16(afrag(1, 16 * tb + r16, 1), sb1, acc, 0, 0, 0);
            const u32x2 uu = *(const LAS u32x2*)(lds + 0 * MB + (16 * wave + r16) * RS + (16 * tb + 4 * q) * 2);
            vn[tb][0] = bf_lo(uu.x) - acc[0]; vn[tb][1] = bf_hi(uu.x) - acc[1]; vn[tb][2] = bf_lo(uu.y) - acc[2]; vn[tb][3] = bf_hi(uu.y) - acc[3];
            f32x4 o = (f32x4){0.f, 0.f, 0.f, 0.f};
            o = __builtin_amdgcn_mfma_f32_16x16x32_bf16(afrag(2, 16 * tb + r16, 0), sb0, o, 0, 0, 0);
            o = __builtin_amdgcn_mfma_f32_16x16x32_bf16(afrag(2, 16 * tb + r16, 1), sb1, o, 0, 0, 0);
            oc[tb] = o;
        }
        const bf16x8 vb0 = pack2(vn[0], vn[1]), vb1 = pack2(vn[2], vn[3]);
#pragma unroll
        for (int tb = 0; tb < 4; ++tb) {
            f32x4 o = oc[tb];
            o = __builtin_amdgcn_mfma_f32_16x16x32_bf16(afrag(3, 16 * tb + r16, 0), vb0, o, 0, 0, 0);
            o = __builtin_amdgcn_mfma_f32_16x16x32_bf16(afrag(3, 16 * tb + r16, 1), vb1, o, 0, 0, 0);
#pragma unroll
            for (int u = 0; u < 4; ++u) stf(dst + (size_t)gdn_row(b, dir, n, 16 * tb + 4 * q + u) * (GH * GDV), o[u]);
        }
#pragma unroll
        for (int db = 0; db < 4; ++db) {
            f32x4 sn = Sb[db] * gam;
            sn = __builtin_amdgcn_mfma_f32_16x16x32_bf16(afrag(4, 16 * db + r16, 0), vb0, sn, 0, 0, 0);
            sn = __builtin_amdgcn_mfma_f32_16x16x32_bf16(afrag(4, 16 * db + r16, 1), vb1, sn, 0, 0, 0);
            Sb[db] = sn;
        }
        __syncthreads();
        if (n + 1 < NCH) { lstore(); gam = gam_next; }
        __syncthreads();
    }
}
#endif


#ifndef HOST_EMU
enum { R_NORM1 = 0, R_POST1 = 1, R_POST2 = 2, R_XFORM = 3, R_GOUT = 4 };
__device__ __forceinline__ float wave_sum(float v) {
#pragma unroll
    for (int o = 32; o > 0; o >>= 1) v += __shfl_xor(v, o);
    return v;
}
__device__ __forceinline__ void ld_row_f32(const float* p, int lane, f32x4 (&v)[D / 256]) {
#pragma unroll
    for (int j = 0; j < D / 256; ++j) v[j] = *(const f32x4*)(p + 4 * lane + 256 * j); }
__device__ __forceinline__ void ld_row_bf16(const st_t* p, int lane, f32x4 (&v)[D / 256]) {
#pragma unroll
    for (int j = 0; j < D / 256; ++j) { const u32x2 w = *(const u32x2*)(p + 4 * lane + 256 * j); v[j] = (f32x4){bf_lo(w.x), bf_hi(w.x), bf_lo(w.y), bf_hi(w.y)}; } }
__device__ __forceinline__ void st_row_bf16(st_t* p, int lane, const f32x4 (&v)[D / 256]) {
#pragma unroll
    for (int j = 0; j < D / 256; ++j) st4(p + 4 * lane + 256 * j, v[j][0], v[j][1], v[j][2], v[j][3]); }
__device__ __forceinline__ float sumsq(const f32x4 (&v)[D / 256]) { float s = 0.f;
#pragma unroll
    for (int j = 0; j < D / 256; ++j) s += (v[j][0] * v[j][0] + v[j][1] * v[j][1]) + (v[j][2] * v[j][2] + v[j][3] * v[j][3]);
    return wave_sum(s); }
template <bool TO_LDS>
__device__ __forceinline__ void modulate_store(const f32x4 (&x)[D / 256], float rstd, const float* gain, const float* sc, const float* sh, st_t* hrow, int lane, LAS float* hl) {
    f32x4 g[D / 256], a[D / 256], b[D / 256], h[D / 256]; ld_row_f32(gain, lane, g); ld_row_f32(sc, lane, a); ld_row_f32(sh, lane, b);
#pragma unroll
    for (int j = 0; j < D / 256; ++j) h[j] = x[j] * rstd * g[j] * (a[j] + 1.0f) + b[j];
    st_row_bf16(hrow, lane, h);
    if constexpr (TO_LDS) {
#pragma unroll
        for (int j = 0; j < D / 256; ++j) *(LAS f32x4*)(hl + 4 * lane + 256 * j) = h[j]; }
}
__device__ __forceinline__ void row_norm1(const Params& p, int layer, int r, int lane) {
    f32x4 x[D / 256]; ld_row_f32(xin_row(p, layer, r), lane, x);
    const float rstd = rsqrt_f(sumsq(x) / D + EPS);
    modulate_store<false>(x, rstd, p.mix_norm_pre + (size_t)layer * D, mod_vec(p, layer, r, 1), mod_vec(p, layer, r, 0), p.H + (size_t)r * D, lane, (LAS float*)0);
}
__device__ __forceinline__ void row_post1_pair(const Params& p, int layer, int pair, int lane, LAS float* hl) {
#pragma unroll
    for (int rr = 0; rr < 2; ++rr) { const int r = 2 * pair + rr;
        f32x4 y[D / 256], x[D / 256], g1[D / 256], gp[D / 256]; ld_row_bf16(p.Y + (size_t)r * D, lane, y); ld_row_f32(xin_row(p, layer, r), lane, x);
        ld_row_f32(mod_vec(p, layer, r, 2), lane, g1); ld_row_f32(p.mix_norm_post + (size_t)layer * D, lane, gp);
        const float rstd = rsqrt_f(sumsq(y) / D + EPS);
#pragma unroll
        for (int j = 0; j < D / 256; ++j) x[j] = x[j] + g1[j] * y[j] * rstd * gp[j];
        float* xr = xrow(p, r);
#pragma unroll
        for (int j = 0; j < D / 256; ++j) *(f32x4*)(xr + 4 * lane + 256 * j) = x[j];
        const float r2 = rsqrt_f(sumsq(x) / D + EPS);
        modulate_store<true>(x, r2, p.ffn_norm_pre + (size_t)layer * D, mod_vec(p, layer, r, 4), mod_vec(p, layer, r, 3), p.H + (size_t)r * D, lane, hl + rr * D);
    }
    asm volatile("s_waitcnt lgkmcnt(0)" ::: "memory");
    const float* wr = p.router_w + (size_t)layer * D * NE + lane; float a0 = 0.f, a1 = 0.f;
#pragma unroll 4
    for (int d4 = 0; d4 < D / 4; ++d4) { const f32x4 h0 = *(const LAS f32x4*)(hl + 4 * d4), h1 = *(const LAS f32x4*)(hl + D + 4 * d4);
#pragma unroll
        for (int u = 0; u < 4; ++u) { const float w = wr[(size_t)(4 * d4 + u) * NE]; a0 += h0[u] * w; a1 += h1[u] * w; } }
    p.LOGITS[(size_t)(2 * pair) * NE + lane] = a0; p.LOGITS[(size_t)(2 * pair + 1) * NE + lane] = a1;
    asm volatile("s_waitcnt lgkmcnt(0)" ::: "memory");
}
__device__ __forceinline__ void row_post2(const Params& p, int layer, int r, int lane) {
    const int* cnt = p.CNT + layer * NE; int slot = 0;
    if (lane < TOPK) { const int e = p.EIDX[(size_t)r * TOPK + lane]; slot = expert_base(cnt, e) + p.EPOS[(size_t)r * TOPK + lane]; }
    f32x4 f[D / 256]; ld_row_bf16(p.SH + (size_t)r * D, lane, f);
#pragma unroll
    for (int k = 0; k < TOPK; ++k) { const int sk = __shfl(slot, k); f32x4 t[D / 256]; ld_row_bf16(p.YB + (size_t)sk * D, lane, t);
#pragma unroll
        for (int j = 0; j < D / 256; ++j) f[j] += t[j]; }
    const float rstd = rsqrt_f(sumsq(f) / D + EPS);
    float* xr = xrow(p, r); f32x4 x[D / 256], g2[D / 256], gp[D / 256]; ld_row_f32(xr, lane, x); ld_row_f32(mod_vec(p, layer, r, 5), lane, g2); ld_row_f32(p.ffn_norm_post + (size_t)layer * D, lane, gp);
#pragma unroll
    for (int j = 0; j < D / 256; ++j) { x[j] = x[j] + g2[j] * f[j] * rstd * gp[j]; *(f32x4*)(xr + 4 * lane + 256 * j) = x[j]; }
    if (layer + 1 < DEPTH) { const float r2 = rsqrt_f(sumsq(x) / D + EPS);
        modulate_store<false>(x, r2, p.mix_norm_pre + (size_t)(layer + 1) * D, mod_vec(p, layer + 1, r, 1), mod_vec(p, layer + 1, r, 0), p.H + (size_t)r * D, lane, (LAS float*)0); }
}
__device__ __forceinline__ void unpack8(const u32x4 w, float (&x)[8]) { x[0] = bf_lo(w.x); x[1] = bf_hi(w.x); x[2] = bf_lo(w.y); x[3] = bf_hi(w.y); x[4] = bf_lo(w.z); x[5] = bf_hi(w.z); x[6] = bf_lo(w.w); x[7] = bf_hi(w.w); }
__device__ __forceinline__ u32x4 pack8(const float (&x)[8]) { u32x4 o; o.x = pk_bf16(x[0], x[1]); o.y = pk_bf16(x[2], x[3]); o.z = pk_bf16(x[4], x[5]); o.w = pk_bf16(x[6], x[7]); return o; }
__device__ __forceinline__ void row_xform(const Params& p, int layer, int r, int lane, const LAS float* cw) {
    int lo, hi; seq_bounds(r, lo, hi);
    const st_t* prow = p.P + (size_t)r * DPROJP;
#pragma unroll
    for (int gi = 0; gi < 3; ++gi) {
        if (gi < 2 || lane < 16) {
            const int c0 = 8 * (lane + 64 * gi); float acc[8];
#pragma unroll
            for (int e = 0; e < 8; ++e) acc[e] = 0.f;
#pragma unroll
            for (int j = 0; j < GCONV; ++j) { const int rr = r + j - 2;
                if (rr >= lo && rr < hi) { float x[8]; unpack8(*(const u32x4*)(p.P + (size_t)rr * DPROJP + PO_GQKV + c0), x);
                    const f32x4 w0 = *(const LAS f32x4*)(cw + j * GQKV + c0), w1 = *(const LAS f32x4*)(cw + j * GQKV + c0 + 4);
#pragma unroll
                    for (int e = 0; e < 4; ++e) { acc[e] += w0[e] * x[e]; acc[4 + e] += w1[e] * x[4 + e]; } } }
            float ss = 0.f;
#pragma unroll
            for (int e = 0; e < 8; ++e) { acc[e] = silu_f(acc[e]); ss += acc[e] * acc[e]; }
            if (gi < 2) {
                ss += __shfl_xor(ss, 1); ss += __shfl_xor(ss, 2); ss += __shfl_xor(ss, 4);
                const float rn = c0 < 2 * GH * GDK ? rsqrt_f(ss + EPS) : 1.0f;
#pragma unroll
                for (int e = 0; e < 8; ++e) acc[e] *= rn; }
            *(u32x4*)(p.G + (size_t)r * GQKV + c0) = pack8(acc);
        }
    }
    if (lane < 12) { const float beta = sigmoid_f(ldf(prow + PO_BA + lane)), a = ldf(prow + PO_BA + 12 + lane);
        p.BG[(size_t)r * 24 + lane] = beta; p.BG[(size_t)r * 24 + 12 + lane] = -expf(p.gdn_a_log[layer * 12 + lane]) * softplus_f(a + p.gdn_dt_bias[layer * 12 + lane]); }
    { float x[8]; float ss = 0.f;
      if (lane < MQR / 8) { unpack8(*(const u32x4*)(prow + PO_CQ + 8 * lane), x);
#pragma unroll
          for (int e = 0; e < 8; ++e) ss += x[e] * x[e]; }
      const float rstd = rsqrt_f(wave_sum(ss) / MQR + EPS);
      if (lane < MQR / 8) { const float* gn = p.mla_q_norm + (size_t)layer * MQR + 8 * lane;
#pragma unroll
          for (int e = 0; e < 8; ++e) x[e] = x[e] * rstd * gn[e];
          *(u32x4*)(p.CQN + (size_t)r * MQR + 8 * lane) = pack8(x); } }
    { float x[8]; float ss = 0.f;
      if (lane < MKVR / 8) { unpack8(*(const u32x4*)(prow + PO_CKV + 8 * lane), x);
#pragma unroll
          for (int e = 0; e < 8; ++e) ss += x[e] * x[e]; }
      const float rstd = rsqrt_f(wave_sum(ss) / MKVR + EPS);
      if (lane < MKVR / 8) { const float* gn = p.mla_kv_norm + (size_t)layer * MKVR + 8 * lane;
#pragma unroll
          for (int e = 0; e < 8; ++e) x[e] = x[e] * rstd * gn[e];
          *(u32x4*)(p.CKVN + (size_t)r * MKVR + 8 * lane) = pack8(x); } }
}
__device__ __forceinline__ void row_gout(const Params& p, int layer, int r, int lane) {
    float o[8]; float ss = 0.f; const bool act = lane < GH * GDV / 8;
    if (act) { float a[8], b[8]; unpack8(*(const u32x4*)(p.OF + (size_t)r * (GH * GDV) + 8 * lane), a); unpack8(*(const u32x4*)(p.OB + (size_t)r * (GH * GDV) + 8 * lane), b);
#pragma unroll
        for (int e = 0; e < 8; ++e) { o[e] = a[e] + b[e]; ss += o[e] * o[e]; } }
    ss += __shfl_xor(ss, 1); ss += __shfl_xor(ss, 2); ss += __shfl_xor(ss, 4);
    if (act) { const float rstd = rsqrt_f(ss / GDV + EPS); float z[8]; unpack8(*(const u32x4*)(p.P + (size_t)r * DPROJP + PO_Z + 8 * lane), z);
        const float* nw = p.gdn_norm_w + layer * GDV + (8 * lane) % GDV;
#pragma unroll
        for (int e = 0; e < 8; ++e) o[e] = o[e] * rstd * nw[e] * silu_f(z[e]);
        *(u32x4*)(p.O + (size_t)r * DMIX + GH * GDV + 8 * lane) = pack8(o); }
}
__device__ __forceinline__ void mod_block(const Params& p, int item, LAS unsigned char* lds, int tid) {
    const int lane = tid & 63, wave = __builtin_amdgcn_readfirstlane(tid >> 6); const int ly = item / (6 * D / 64), jb = item % (6 * D / 64);
    LAS float* sl = (LAS float*)lds; LAS float* red = sl + 3 * D;
    __syncthreads();
    for (int i = tid; i < 3 * D; i += 256) { const int w = i / D, k = i % D; sl[i] = silu_f(w < 2 ? p.c[(size_t)w * D + k] : p.c_ctx[k]); }
    __syncthreads();
    const float* W = p.ada_w + (size_t)ly * D * 6 * D + jb * 64 + lane; float a0 = 0.f, a1 = 0.f, a2 = 0.f;
#pragma unroll 8
    for (int k = wave * (D / 4); k < (wave + 1) * (D / 4); ++k) { const float w = W[(size_t)k * 6 * D]; a0 += sl[k] * w; a1 += sl[D + k] * w; a2 += sl[2 * D + k] * w; }
    red[(wave * 3 + 0) * 64 + lane] = a0; red[(wave * 3 + 1) * 64 + lane] = a1; red[(wave * 3 + 2) * 64 + lane] = a2;
    __syncthreads();
    if (wave < 3) { const float v = red[(0 * 3 + wave) * 64 + lane] + red[(1 * 3 + wave) * 64 + lane] + red[(2 * 3 + wave) * 64 + lane] + red[(3 * 3 + wave) * 64 + lane];
        p.MOD[((size_t)(ly * 3 + wave) * 6 * D) + jb * 64 + lane] = v + p.ada_b[(size_t)ly * 6 * D + jb * 64 + lane]; }
}
#endif


#ifndef HOST_EMU
#define XB_TMO      128
#define XB_XCNT(j)  (256  + 64 * (j))
#define XB_XSUB(j)  (1280 + 64 * (j))
#define XB_XGEN(j)  (2304 + 64 * (j))
#define XB_TOP      3328
#define XB_TOPGEN   3392
#define XCD_BAR_WORDS 3456
#define XB_SPIN_CAP (1u << 18)

__device__ __forceinline__ unsigned xb_ld(unsigned* p)              { return __hip_atomic_load(p, __ATOMIC_RELAXED, __HIP_MEMORY_SCOPE_AGENT); }
__device__ __forceinline__ unsigned xb_add(unsigned* p, unsigned v) { return __hip_atomic_fetch_add(p, v, __ATOMIC_RELAXED, __HIP_MEMORY_SCOPE_AGENT); }
__device__ __forceinline__ unsigned xb_xcc_id() { return (unsigned)__builtin_amdgcn_s_getreg((3 << 11) | 20) & 0xFu; }
#define XB_SPIN(cond, bar) do { unsigned _sp = 0; while (cond) { __builtin_amdgcn_s_sleep(1); \
    if ((++_sp & 255u) == 0u) { if (xb_ld(&(bar)[XB_TMO])) break; if (_sp > XB_SPIN_CAP) { atomicAdd(&(bar)[XB_TMO], 1u); break; } } } } while (0)

struct XcdBarrier {
    unsigned* bar; unsigned x;
    volatile LAS unsigned* st;
};

__device__ __forceinline__ XcdBarrier xcd_barrier_post(unsigned* bar, volatile LAS unsigned* st) {
    XcdBarrier b; b.bar = bar; b.x = xb_xcc_id(); b.st = st;
    if (threadIdx.x == 0) (void)xb_add(&bar[XB_XCNT(b.x)], 1u);
    return b;
}
__device__ __forceinline__ void xcd_barrier_complete(unsigned* bar, unsigned x, unsigned& nloc, unsigned& nx) {
    const unsigned G = gridDim.x * gridDim.y * gridDim.z;
    unsigned sum, cnt, mine, sp = 0u;
    for (;;) {
        sum = 0u; cnt = 0u; mine = 0u;
#pragma unroll
        for (unsigned j = 0; j < 16; ++j) { const unsigned c = xb_ld(&bar[XB_XCNT(j)]); sum += c; cnt += (c > 0u) ? 1u : 0u; mine = (j == x) ? c : mine; }
        if (sum == G) break;
        __builtin_amdgcn_s_sleep(1);
        if ((++sp & 255u) == 0u) { if (xb_ld(&bar[XB_TMO])) break; if (sp > XB_SPIN_CAP) { atomicAdd(&bar[XB_TMO], 1u); break; } }
    }
    nloc = mine > 0u ? mine : 1u; nx = cnt > 0u ? cnt : 1u;
}

__device__ __forceinline__ void xcd_barrier(const XcdBarrier& b) {
    asm volatile("s_waitcnt vmcnt(0)" ::: "memory");
    __syncthreads();
    if (threadIdx.x == 0) {
        unsigned* bar = b.bar;
        __builtin_amdgcn_s_waitcnt(0);
        unsigned nloc = b.st[0], nx = b.st[1];
        if (nloc == 0u) { xcd_barrier_complete(bar, b.x, nloc, nx); b.st[0] = nloc; b.st[1] = nx; }
        const unsigned old = xb_add(&bar[XB_XSUB(b.x)], 1u);
        const unsigned gen = old / nloc;
        if (old + 1u == (gen + 1u) * nloc) {
            __builtin_amdgcn_fence(__ATOMIC_RELEASE, "agent");
            asm volatile("s_waitcnt vmcnt(0)" ::: "memory");
            const unsigned og = xb_add(&bar[XB_TOP], 1u);
            const unsigned tg = og / nx;
            if (og + 1u == (tg + 1u) * nx) xb_add(&bar[XB_TOPGEN], 1u);
            else XB_SPIN(xb_ld(&bar[XB_TOPGEN]) == tg, bar);
            __builtin_amdgcn_fence(__ATOMIC_ACQUIRE, "agent");
            xb_add(&bar[XB_XGEN(b.x)], 1u);
            asm volatile("s_waitcnt vmcnt(0)" ::: "memory");
        } else {
            XB_SPIN(xb_ld(&bar[XB_XGEN(b.x)]) == gen, bar);
            __builtin_amdgcn_fence(__ATOMIC_ACQUIRE, "agent");
            asm volatile("s_waitcnt vmcnt(0)" ::: "memory");
        }
    }
    __syncthreads();
}

#endif

enum { K_ITEM = 0, K_WT = 1, K_GEMM = 2, K_ATTN = 3, K_GPRE = 4, K_ROW = 5, K_MOD = 6 };
struct Step { int kind, st, layer, sync_before; };
inline int build_program(Step* prog) {
    int n = 0;
    prog[n++] = {K_ITEM, ST_ZERO, 0, 0}; prog[n++] = {K_ITEM, ST_TAB, 0, 0}; prog[n++] = {USE_KMOD ? K_MOD : K_ITEM, USE_KMOD ? 0 : ST_MOD, 0, 0}; prog[n++] = {K_WT, WT_STATIC, 0, 0};
    for (int l = 0; l < DEPTH; ++l) {
        if (l == 0 || !USE_RPOST2) { if (USE_RNORM1) prog[n++] = {K_ROW, 0  , l, 1}; else prog[n++] = {K_ITEM, ST_NORM1, l, 1}; }
        prog[n++] = {K_GEMM, G_PROJ, l, 1};
        prog[n++] = {K_ROW, 3  , l, 1};
        prog[n++] = {K_GEMM, G_UQ, l, 1}; prog[n++] = {K_GEMM, G_UKV, l, 0}; prog[n++] = {K_GPRE, 0, l, 0};
        prog[n++] = {K_ATTN, 0, l, 1};
        prog[n++] = {K_ROW, 4  , l, 1}; prog[n++] = {K_WT, WT_EXPERT, l, 0};
        prog[n++] = {K_GEMM, G_WOUT, l, 1};
        if (USE_RPOST1) prog[n++] = {K_ROW, 1  , l, 1}; else { prog[n++] = {K_ITEM, ST_POST1, l, 1}; prog[n++] = {K_ITEM, ST_ROUTER, l, 1}; }
        prog[n++] = {K_ITEM, ST_ROUTE, l, 1};
        prog[n++] = {K_GEMM, G_SGU, l, 1}; prog[n++] = {K_GEMM, G_EGU, l, 0};
        prog[n++] = {K_GEMM, G_SDOWN, l, 1}; prog[n++] = {K_GEMM, G_EDOWN, l, 0};
        if (USE_RPOST2) prog[n++] = {K_ROW, 2  , l, 1}; else prog[n++] = {K_ITEM, ST_POST2, l, 1};
    }
    return n;
}
constexpr int MAX_STEPS = 64;

#ifndef HOST_EMU
namespace cg = cooperative_groups;
struct Prog { Step s[MAX_STEPS]; int n; int pad[3]; };

__global__ void __launch_bounds__(256, 2) k_mega(Params p, Prog pr) {
    extern __shared__ __attribute__((aligned(16))) unsigned char smem[];
    LAS unsigned char* lds = (LAS unsigned char*)smem;
    cg::grid_group grid = cg::this_grid();
    { volatile LAS unsigned* bst = (volatile LAS unsigned*)(lds + 65536); if (threadIdx.x < 2) bst[threadIdx.x] = 0u; }
    __syncthreads();
    (void)xcd_barrier_post(p.BAR, (volatile LAS unsigned*)(lds + 65536));
#define XBAR_NOW() do { XcdBarrier xb_; xb_.bar = p.BAR; xb_.x = xb_xcc_id(); xb_.st = (volatile LAS unsigned*)(lds + 65536); xcd_barrier(xb_); } while (0)
    bool first_sync = true;
    const long long gthreads = (long long)gridDim.x * 256;
    for (int s = 0; s < pr.n; ++s) {
        const int kind = pr.s[s].kind, st = pr.s[s].st, layer = pr.s[s].layer;
        if (pr.s[s].sync_before) { if (first_sync) { grid.sync(); first_sync = false; } else XBAR_NOW(); }
        int reps = 1;
        if (PROBE_MASK) { const int grp = kind == K_GEMM ? 0 : kind == K_ATTN ? 1 : kind == K_GPRE ? 2 : kind == K_WT ? 3 : (kind == K_ROW && (st == R_XFORM || st == R_GOUT || st == R_NORM1)) ? 4 : 7;
            if ((PROBE_MASK >> grp) & 1) reps = 2; if (((PROBE_MASK >> 5) & 1) && pr.s[s].sync_before) XBAR_NOW(); }
        for (int rep = 0; rep < reps; ++rep) {
        int tid = threadIdx.x; asm volatile("" : "+v"(tid));
        const int lane = tid & 63, wave = __builtin_amdgcn_readfirstlane(tid >> 6);
        const long long gtid = (long long)blockIdx.x * 256 + tid;
        if (kind == K_ITEM) {
            const long long n = n_items(st, layer);
#define RUN_ST(ST) case ST: for (long long i = gtid; i < n; i += gthreads) run_item(p, ST, layer, i); break;
            switch (st) {
#if !USE_KMOD
                RUN_ST(ST_MOD)
#endif
#if !USE_RNORM1
                RUN_ST(ST_NORM1)
#endif
#if !USE_RPOST1
                RUN_ST(ST_POST1) RUN_ST(ST_ROUTER)
#endif
#if !USE_RPOST2
                RUN_ST(ST_POST2)
#endif
                RUN_ST(ST_ZERO) RUN_ST(ST_TAB) RUN_ST(ST_ROUTE) default: break; }
#undef RUN_ST
        } else if (kind == K_WT) {
            const long long n = wt_items(p, st); LAS float* scr = (LAS float*)(lds + wave * (64 * 33 * 4));
            for (long long i = (long long)blockIdx.x * 4 + wave; i < n; i += (long long)gridDim.x * 4) wt_item_dev(p, st, layer, i, scr, lane);
        } else if (kind == K_GEMM) {
            const int n = gemm_ntiles(p, st, layer);
            for (int i = blockIdx.x; i < n; i += gridDim.x) { GemmDesc g; gemm_desc(p, st, layer, i, g); gemm_tile_dev(g, lds, tid); }
        } else if (kind == K_ROW) {
            const int gw = blockIdx.x * 4 + wave, nw = gridDim.x * 4;
            if (st == R_NORM1) { for (int r = gw; r < TA; r += nw) row_norm1(p, layer, r, lane); }
            else if (st == R_POST1) { __syncthreads(); LAS float* hl = (LAS float*)(lds + wave * (2 * D * 4)); for (int i = gw; i < rows_out(layer) / 2; i += nw) row_post1_pair(p, layer, i, lane, hl); }
            else if (st == R_POST2) { for (int r = gw; r < rows_out(layer); r += nw) row_post2(p, layer, r, lane); }
            else if (st == R_XFORM) { __syncthreads(); LAS float* cw = (LAS float*)lds; for (int i = tid; i < GCONV * GQKV; i += 256) cw[i] = p.gdn_conv_w[(size_t)layer * GCONV * GQKV + i]; __syncthreads();
                for (int r = gw; r < TA; r += nw) row_xform(p, layer, r, lane, cw); }
            else { for (int r = gw; r < rows_out(layer); r += nw) row_gout(p, layer, r, lane); }
        } else if (kind == K_MOD) {
            for (int i = blockIdx.x; i < DEPTH * (6 * D / 64); i += gridDim.x) mod_block(p, i, lds, tid);
        } else if (kind == K_GPRE) {
            const int n = NCHAIN * NCH / 2;
            for (int i = blockIdx.x; i < n; i += gridDim.x) gdn_pre_dev(p, i, lds, tid);
        } else {
            const int n = attn_nitems(layer) + NCHAIN; LAS int* slot = (LAS int*)(lds + 65536 + 16);
            for (;;) {
                __syncthreads(); if (tid == 0) *slot = atomicAdd(p.CTR + layer * 16 + rep, 1); __syncthreads();
                const int item = *slot; if (item >= n) break;
                if (item < NCHAIN) { gdn_scan_dev(p, item, lds, tid); continue; }
                AttnDesc a; attn_desc(p, layer, item - NCHAIN, a);
                if (a.dqk == 96) attn_tile_dev<96>(a, lds, tid); else attn_tile_dev<64>(a, lds, tid);
            }
        }
        }
    }
}

extern "C" void kernel_launch(void* const* d_in, const int* in_sizes, int n_in, void* d_out, int out_size, void* d_ws, size_t ws_size, hipStream_t stream) {
    Params p{};
    const float** pin = (const float**)&p;
    for (int i = 0; i < 29 && i < n_in; ++i) pin[i] = (const float*)d_in[i];
    p.out = (float*)d_out;
    const size_t need = carve(p, (char*)d_ws);
    if (need > ws_size) { fprintf(stderr, "kernel_launch: workspace too small: need %zu have %zu\n", need, ws_size); return; }
    build_jobs(p);
    Prog pr{}; pr.n = build_program(pr.s);
    constexpr int LDS_BYTES = 65536 + 256;
    static int grid_blocks = 0;
    if (!grid_blocks) {
        int dev = 0, cus = 0, per_cu = 0;
        (void)hipGetDevice(&dev);
        (void)hipDeviceGetAttribute(&cus, hipDeviceAttributeMultiprocessorCount, dev);
        (void)hipFuncSetAttribute((const void*)k_mega, hipFuncAttributeMaxDynamicSharedMemorySize, LDS_BYTES);
        (void)hipOccupancyMaxActiveBlocksPerMultiprocessor(&per_cu, k_mega, 256, LDS_BYTES);
        if (per_cu > 2) per_cu = 2;
        if (per_cu < 1) per_cu = 1;
        grid_blocks = cus * per_cu;
    }
    (void)hipMemsetAsync(p.BAR, 0, 4096 * 4, stream);
    void* args[] = {&p, &pr};
    hipError_t e = hipLaunchCooperativeKernel((void*)k_mega, dim3(grid_blocks), dim3(256), args, LDS_BYTES, stream);
    if (e != hipSuccess) fprintf(stderr, "cooperative launch failed: %s (grid %d)\n", hipGetErrorString(e), grid_blocks);
}
#endif
```

```cpp
#ifndef HOST_EMU
#include <hip/hip_runtime.h>
#include <hip/hip_cooperative_groups.h>
#include <cstdio>
#define HD __host__ __device__ __forceinline__
#else
#include <cmath>
#include <cstdio>
#include <cstring>
#define HD inline
#endif
#include <cstdint>
#include <utility>

#ifndef CFG_D
#define CFG_D 1024
#endif
#ifndef CFG_S
#define CFG_S 8192
#endif
#ifndef CFG_L
#define CFG_L 256
#endif
#ifndef CFG_DE
#define CFG_DE 256
#endif
#ifndef CFG_DS
#define CFG_DS 256
#endif
#ifndef PROBE_MASK
#define PROBE_MASK 0
#endif
#ifndef FUSE_ROUTE
#define FUSE_ROUTE 0
#endif
#ifndef USE_KMOD
#define USE_KMOD 1
#endif
#ifndef USE_RNORM1
#define USE_RNORM1 1
#endif
#ifndef USE_RPOST1
#define USE_RPOST1 1
#endif
#ifndef USE_RPOST2
#define USE_RPOST2 1
#endif

namespace cfg {
constexpr int D = CFG_D, B = 2, S = CFG_S, L = CFG_L, DEPTH = 2, GRID_W = 64;
constexpr int T = B * S, TC = B * L, TA = T + TC;
constexpr int SWA_H = 6, SWA_KVH = 2, SWA_G = 3, SWA_W = 128;
constexpr int GH = 6, GDK = 64, GDV = 64, GCONV = 5;
constexpr int MH = 4, MQR = 192, MKVR = 128, MNOPE = 64, MROPE = 32, MV = 64, MQD = MNOPE + MROPE, MKVD = MNOPE + MV;
constexpr int DMIX = 1024, GQKV = 1152;
constexpr int PO_QA = 0, PO_KA = 384, PO_VA = 512, PO_GQKV = 640, PO_Z = 1792, PO_BA = 2176, PO_CQ = 2200, PO_CKV = 2392, PO_KR = 2528  , PO_KR_SRC = 2520, DPROJ = 2552, DPROJP = 2560;
constexpr int NE = 64, TOPK = 8, NGRP = 8, TOPG = 4, DE = CFG_DE, DS = CFG_DS;
constexpr float EPS = 1e-6f, ROUTED_SCALE = 2.5f;
constexpr int NSLOT = TA * TOPK, NK = S + L, NCHAIN = B * GH * 2, NCH = (S + L) / 64;
static_assert(D % 128 == 0 && DE % 64 == 0 && DS % 64 == 0 && TA % 128 == 0 && T % 128 == 0, "tile divisibility");
}
using namespace cfg;

#ifdef HOST_EMU
typedef float st_t;
HD float ldf(const st_t* p) { return *p; }
HD void stf(st_t* p, float v) { *p = v; }
HD void st4(st_t* p, float a, float b, float c, float d) { p[0] = a; p[1] = b; p[2] = c; p[3] = d; }
#else
typedef unsigned short st_t;
typedef short bf16x8 __attribute__((ext_vector_type(8)));
typedef float f32x4 __attribute__((ext_vector_type(4)));
typedef float f32x2 __attribute__((ext_vector_type(2)));
typedef __bf16 bf16x2_t __attribute__((ext_vector_type(2)));
#define LAS __attribute__((address_space(3)))
HD float ldf(const st_t* p) { unsigned u = ((unsigned)*p) << 16; float f; __builtin_memcpy(&f, &u, 4); return f; }
HD unsigned short f2bf(float v) { unsigned u; __builtin_memcpy(&u, &v, 4); u = (u + 0x7fffu + ((u >> 16) & 1u)) >> 16; return (unsigned short)u; }
HD void stf(st_t* p, float v) { *p = f2bf(v); }
HD float ldf(const float* p) { return *p; }
HD void stf(float* p, float v) { *p = v; }
__device__ __forceinline__ unsigned pk_bf16(float lo, float hi) { f32x2 v = {lo, hi}; return __builtin_bit_cast(unsigned, __builtin_convertvector(v, bf16x2_t)); }
HD void st4(st_t* p, float a, float b, float c, float d) {
#if defined(__HIP_DEVICE_COMPILE__)
    uint2 w; w.x = pk_bf16(a, b); w.y = pk_bf16(c, d); *(uint2*)p = w;
#else
    p[0] = f2bf(a); p[1] = f2bf(b); p[2] = f2bf(c); p[3] = f2bf(d);
#endif
}
#endif

#if defined(__HIP_DEVICE_COMPILE__)
__device__ __forceinline__ float fast_exp(float x) { return __builtin_amdgcn_exp2f(x * 1.4426950408889634f); }
__device__ __forceinline__ float silu_f(float x) { return x * __builtin_amdgcn_rcpf(1.0f + fast_exp(-x)); }
__device__ __forceinline__ float sigmoid_f(float x) { return __builtin_amdgcn_rcpf(1.0f + fast_exp(-x)); }
__device__ __forceinline__ float softplus_f(float x) { return x > 20.f ? x : 0.6931471805599453f * __builtin_amdgcn_logf(1.0f + fast_exp(x)); }
__device__ __forceinline__ float rsqrt_f(float x) { return __builtin_amdgcn_rsqf(x); }
#else
HD float silu_f(float x) { return x / (1.0f + expf(-x)); }
HD float sigmoid_f(float x) { return 1.0f / (1.0f + expf(-x)); }
HD float softplus_f(float x) { return x > 20.f ? x : log1pf(expf(x)); }
HD float rsqrt_f(float x) { return 1.0f / sqrtf(x); }
#endif

struct TJob { const float* src; st_t* dst; int K, N, npad, grp, off, ldt, ldsrc, pad_; };
constexpr int NJOBS = 16;

struct WsOff { size_t BAR, MOD, TABA, TABM, XC, BG, LOGITS, EW, EIDX, EPOS, CNT, CNTP, CTR, GAM, TOKLIST, WLIST, H, Wt_in, Wt_out, Wt_uq, Wt_ukv, Wt_sgu, Wt_sd, SACT, ACT, Wt_egu, Wt_ed, CH,
               P, G, CQN, CKVN, MQ, MKV, O, VtM, VtA, OF, OB, YB, total; };
constexpr size_t align256(size_t v) { return (v + 255) & ~(size_t)255; }
constexpr WsOff make_ws() {
    WsOff w{}; size_t off = 0; const size_t E = sizeof(st_t);
#define TAKE(name, bytes) w.name = off; off = align256(off + (size_t)(bytes));
    TAKE(BAR, 4096 * 4)
    TAKE(MOD, (size_t)DEPTH * 3 * 6 * D * 4) TAKE(TABA, 128 * 16 * 2 * 4) TAKE(TABM, 128 * 8 * 2 * 4) TAKE(XC, (size_t)TC * D * 4) TAKE(BG, (size_t)TA * 24 * 4)
    TAKE(LOGITS, (size_t)TA * NE * 4) TAKE(EW, (size_t)TA * TOPK * 4) TAKE(EIDX, (size_t)TA * TOPK * 4) TAKE(EPOS, (size_t)TA * TOPK * 4)
    TAKE(CNT, DEPTH * NE * 4) TAKE(CNTP, DEPTH * NE * 32 * 4) TAKE(CTR, DEPTH * 16 * 4) TAKE(GAM, (size_t)NCHAIN * NCH * 4) TAKE(TOKLIST, (size_t)NE * TA * 4) TAKE(WLIST, (size_t)NE * TA * 4)
    TAKE(H, (size_t)TA * D * E)
    TAKE(Wt_in, (size_t)DEPTH * DPROJP * D * E) TAKE(Wt_out, (size_t)DEPTH * D * DMIX * E) TAKE(Wt_uq, (size_t)DEPTH * MH * MQD * MQR * E) TAKE(Wt_ukv, (size_t)DEPTH * MH * MKVD * MKVR * E)
    TAKE(Wt_sgu, (size_t)DEPTH * 2 * DS * D * E) TAKE(Wt_sd, (size_t)DEPTH * D * DS * E)
    const size_t q0 = off;
    TAKE(SACT, (size_t)TA * DS * E) TAKE(ACT, ((size_t)NSLOT * DE * E > (size_t)TA * D * E ? (size_t)NSLOT * DE * E : (size_t)TA * D * E))
    TAKE(Wt_egu, (size_t)NE * 2 * DE * D * E) TAKE(Wt_ed, (size_t)NE * D * DE * E)
    w.CH = q0; { const size_t chb = align256((size_t)NCHAIN * NCH * 5 * 4096 * E); if (q0 + chb > off) off = q0 + chb; }
    const size_t r0 = off;
    TAKE(P, (size_t)TA * DPROJP * E) TAKE(G, (size_t)TA * GQKV * E) TAKE(CQN, (size_t)TA * MQR * E) TAKE(CKVN, (size_t)TA * MKVR * E) TAKE(MQ, (size_t)TA * MH * MQD * E) TAKE(MKV, (size_t)TA * MH * MKVD * E)
    TAKE(O, (size_t)TA * DMIX * E) TAKE(VtM, (size_t)B * MH * MV * NK * E) TAKE(VtA, (size_t)B * SWA_KVH * 64 * NK * E) TAKE(OF, (size_t)TA * GH * GDV * E) TAKE(OB, (size_t)TA * GH * GDV * E)
#undef TAKE
    w.YB = r0; { const size_t yb = align256((size_t)NSLOT * D * E); if (r0 + yb > off) off = r0 + yb; }
    w.total = off; return w;
}
constexpr WsOff WS = make_ws();

struct Params {
    const float *x, *c, *ctx, *c_ctx, *ada_w, *ada_b, *mix_norm_pre, *mix_norm_post, *ffn_norm_pre, *ffn_norm_post,
        *w_in, *w_out, *swa_sink, *gdn_conv_w, *gdn_a_log, *gdn_dt_bias, *gdn_norm_w, *mla_q_norm, *mla_w_uq, *mla_kv_norm, *mla_w_ukv,
        *router_w, *router_bias, *e_gate, *e_up, *e_down, *s_gate, *s_up, *s_down;
    float* out;
    char* ws;
#define WSF(T, name, field) HD T* name() const { return (T*)(ws + WS.field); }
    WSF(unsigned, BAR, BAR) WSF(float, MOD, MOD) WSF(float, TABA, TABA) WSF(float, TABM, TABM) WSF(float, XC, XC) WSF(float, BG, BG) WSF(float, LOGITS, LOGITS) WSF(float, EW, EW)
    WSF(int, EIDX, EIDX) WSF(int, EPOS, EPOS) WSF(int, CNT, CNT) WSF(int, CNTP, CNTP) WSF(int, CTR, CTR) WSF(float, GAM, GAM) WSF(int, TOKLIST, TOKLIST) WSF(float, WLIST, WLIST)
    WSF(st_t, H, H) WSF(st_t, SH, H) WSF(st_t, Wt_in, Wt_in) WSF(st_t, Wt_out, Wt_out) WSF(st_t, Wt_uq, Wt_uq) WSF(st_t, Wt_ukv, Wt_ukv) WSF(st_t, Wt_sgu, Wt_sgu) WSF(st_t, Wt_sd, Wt_sd)
    WSF(st_t, SACT, SACT) WSF(st_t, ACT, ACT) WSF(st_t, Y, ACT) WSF(st_t, Wt_egu, Wt_egu) WSF(st_t, Wt_ed, Wt_ed) WSF(st_t, CH, CH)
    WSF(st_t, P, P) WSF(st_t, G, G) WSF(st_t, CQN, CQN) WSF(st_t, CKVN, CKVN) WSF(st_t, MQ, MQ) WSF(st_t, MKV, MKV) WSF(st_t, O, O) WSF(st_t, VtM, VtM) WSF(st_t, VtA, VtA)
    WSF(st_t, OF, OF) WSF(st_t, OB, OB) WSF(st_t, YB, YB)
#undef WSF
};
inline size_t carve(Params& p, char* ws) { p.ws = ws; return WS.total; }

HD TJob static_job(const Params& p, int j) {
    const int l = j / (NJOBS / DEPTH), k = j % (NJOBS / DEPTH);
    switch (k) {
    case 0: return TJob{p.w_in + (size_t)l * D * DPROJ, p.Wt_in() + (size_t)l * DPROJP * D, D, PO_KR_SRC, PO_KR, 16, 0, D, DPROJ, 0};
    case 1: return TJob{p.w_in + (size_t)l * D * DPROJ + PO_KR_SRC, p.Wt_in() + (size_t)l * DPROJP * D + (size_t)PO_KR * D, D, MROPE, MROPE, 16, 0, D, DPROJ, 0};
    case 2: return TJob{p.w_out + (size_t)l * DMIX * D, p.Wt_out() + (size_t)l * D * DMIX, DMIX, D, D, 16, 0, DMIX, D, 0};
    case 3: return TJob{p.mla_w_uq + (size_t)l * MQR * MH * MQD, p.Wt_uq() + (size_t)l * MH * MQD * MQR, MQR, MH * MQD, MH * MQD, 16, 0, MQR, MH * MQD, 0};
    case 4: return TJob{p.mla_w_ukv + (size_t)l * MKVR * MH * MKVD, p.Wt_ukv() + (size_t)l * MH * MKVD * MKVR, MKVR, MH * MKVD, MH * MKVD, 16, 0, MKVR, MH * MKVD, 0};
    case 5: return TJob{p.s_gate + (size_t)l * D * DS, p.Wt_sgu() + (size_t)l * 2 * DS * D, D, DS, DS, 32, 0, D, DS, 0};
    case 6: return TJob{p.s_up + (size_t)l * D * DS, p.Wt_sgu() + (size_t)l * 2 * DS * D, D, DS, DS, 32, 16, D, DS, 0};
    default: return TJob{p.s_down + (size_t)l * DS * D, p.Wt_sd() + (size_t)l * D * DS, DS, D, D, 16, 0, DS, D, 0};
    }
}
HD long long static_job_items(int j) {
    const int k = j % (NJOBS / DEPTH);
    const int K = k == 2 ? DMIX : k == 3 ? MQR : k == 4 ? MKVR : k == 7 ? DS : D;
    const int npad = k == 0 ? PO_KR : k == 1 ? MROPE : k == 2 ? D : k == 3 ? MH * MQD : k == 4 ? MH * MKVD : k == 7 ? D : DS;
    return (long long)(K / 64) * ((npad + 31) / 32);
}

HD int mod_which(int r) { return r < T ? r / S : 2; }
HD const float* mod_vec(const Params& p, int layer, int r, int chunk) { return p.MOD() + ((size_t)(layer * 3 + mod_which(r)) * 6 + chunk) * D; }
HD void seq_bounds(int r, int& lo, int& hi) { if (r < T) { lo = (r / S) * S; hi = lo + S; } else { lo = T + ((r - T) / L) * L; hi = lo + L; } }
HD float* xrow(const Params& p, int r) { return r < T ? p.out + (size_t)r * D : p.XC() + (size_t)(r - T) * D; }
HD const float* xin_row(const Params& p, int layer, int r) { if (layer > 0) return xrow(p, r); return r < T ? p.x + (size_t)r * D : p.ctx + (size_t)(r - T) * D; }
HD int rows_out(int layer) { return layer == DEPTH - 1 ? T : TA; }
HD int expert_base(const int* cnt, int e) { int b = 0; for (int i = 0; i < e; ++i) b += cnt[i]; return b; }

#ifdef HOST_EMU
inline int atomic_inc(int* p) { int v;
#pragma omp atomic capture
    { v = *p; *p += 1; }
    return v; }
#else
__device__ __forceinline__ int atomic_inc(int* p) { return atomicAdd(p, 1); }
#endif

enum Stage { ST_MOD = 0, ST_ZERO, ST_NORM1, ST_ROPE_SWA, ST_GDN_CONV, ST_GDN_L2, ST_GDN_GATE, ST_MLA_NORM, ST_ROPE_MLA,
             ST_SWA, ST_GDN_SCAN, ST_GDN_OUT, ST_MLA, ST_POST1, ST_ROUTER, ST_ROUTE, ST_POST2, ST_VT, ST_TAB, ST_COUNT };

HD long long n_items(int st, int layer) {
    switch (st) {
    case ST_MOD: return (long long)DEPTH * 3 * 6 * D;
    case ST_ZERO: return DEPTH * NE + DEPTH * 16 + DEPTH * NE * 32;
    case ST_VT: return (long long)(B * MH + B * SWA_KVH) * (NK / 8) * 64;
    case ST_TAB: return 128 * 16 + 128 * 8;
    case ST_NORM1: return TA;
    case ST_ROPE_SWA: return (long long)T * 8 * 32;
    case ST_GDN_CONV: return (long long)TA * GQKV;
    case ST_GDN_L2: return (long long)TA * 12;
    case ST_GDN_GATE: return (long long)TA * 12;
    case ST_MLA_NORM: return (long long)TA * 2;
    case ST_ROPE_MLA: return (long long)T * 5 * 16;
    case ST_SWA: return (long long)rows_out(layer) * SWA_H;
    case ST_GDN_SCAN: return (long long)B * GH * 2 * GDV;
    case ST_GDN_OUT: return (long long)rows_out(layer) * GH;
    case ST_MLA: return (long long)rows_out(layer) * MH;
    case ST_POST1: return rows_out(layer);
    case ST_ROUTER: return (long long)rows_out(layer) * NE;
    case ST_ROUTE: return rows_out(layer);
    case ST_POST2: return rows_out(layer);
    }
    return 0;
}

HD float rope_inv(int i, int n) { return exp2f(-(float)i / (float)n * 13.287712379549449f); }

HD void run_item(const Params& p, int st, int layer, long long i) {
    switch (st) {
    case ST_MOD: {
        const int j = (int)(i % (6 * D)); const int w = (int)((i / (6 * D)) % 3); const int ly = (int)(i / (6 * D * 3));
        const float* cv = w < 2 ? p.c + (size_t)w * D : p.c_ctx;
        const float* W = p.ada_w + (size_t)ly * D * 6 * D;
        float acc = p.ada_b[(size_t)ly * 6 * D + j];
        for (int k = 0; k < D; ++k) acc += silu_f(cv[k]) * W[(size_t)k * 6 * D + j];
        p.MOD()[i] = acc;
    } break;
    case ST_ZERO: if (i < DEPTH * NE) p.CNT()[i] = 0; else if (i < DEPTH * NE + DEPTH * 16) p.CTR()[i - DEPTH * NE] = 0; else p.CNTP()[i - DEPTH * NE - DEPTH * 16] = 0; break;
    case ST_TAB: {
        if (i < 128 * 16) { const int pos = (int)(i / 16), ii = (int)(i % 16); const float ang = (float)pos * rope_inv(ii, 16); p.TABA()[2 * i] = cosf(ang); p.TABA()[2 * i + 1] = sinf(ang); }
        else { const long long k = i - 128 * 16; const int pos = (int)(k / 8), ii = (int)(k % 8); const float ang = (float)pos * rope_inv(ii, 8); p.TABM()[2 * k] = cosf(ang); p.TABM()[2 * k + 1] = sinf(ang); }
    } break;
    case ST_VT: {
        const int dv = (int)(i % 64); long long r = i / 64; const int kc = (int)(r % (NK / 8)); const int bh = (int)(r / (NK / 8));
        const bool mla = bh < B * MH; const int b = mla ? bh / MH : (bh - B * MH) / SWA_KVH, hd = mla ? bh % MH : (bh - B * MH) % SWA_KVH;
        st_t* dst = (mla ? p.VtM() + ((size_t)(b * MH + hd) * 64 + dv) * NK : p.VtA() + ((size_t)(b * SWA_KVH + hd) * 64 + dv) * NK) + kc * 8;
        for (int j = 0; j < 8; ++j) { const int kidx = kc * 8 + j; const int row = kidx < S ? b * S + kidx : T + b * L + (kidx - S);
            dst[j] = mla ? p.MKV()[(size_t)row * MH * MKVD + hd * MKVD + MNOPE + dv] : p.P()[(size_t)row * DPROJP + PO_VA + hd * 64 + dv]; }
    } break;
    case ST_NORM1: {
        const int r = (int)i; const float* xr = xin_row(p, layer, r); float ss = 0.f;
        for (int d = 0; d < D; ++d) ss += xr[d] * xr[d];
        const float rstd = 1.0f / sqrtf(ss / D + EPS);
        const float* gain = p.mix_norm_pre + (size_t)layer * D; const float* sh = mod_vec(p, layer, r, 0); const float* sc = mod_vec(p, layer, r, 1);
        st_t* hr = p.H() + (size_t)r * D;
        for (int d = 0; d < D; ++d) stf(hr + d, xr[d] * rstd * gain[d] * (1.0f + sc[d]) + sh[d]);
    } break;
    case ST_ROPE_SWA: {
        const int j = (int)(i % 32), hh = (int)((i / 32) % 8), r = (int)(i / 256);
        const int s = r % S, rp = s / GRID_W, cp = s % GRID_W;
        const int base = hh < 6 ? PO_QA + hh * 64 : PO_KA + (hh - 6) * 64;
        const int half = j / 16, ii = j % 16; const int i1 = base + half * 32 + ii, i2 = i1 + 16;
        const float ang = (float)(half == 0 ? rp : cp) * rope_inv(ii, 16); const float cs = cosf(ang), sn = sinf(ang);
        st_t* pr = p.P() + (size_t)r * DPROJP; const float x1 = ldf(pr + i1), x2 = ldf(pr + i2);
        stf(pr + i1, x1 * cs - x2 * sn); stf(pr + i2, x1 * sn + x2 * cs);
    } break;
    case ST_GDN_CONV: {
        const int cc = (int)(i % GQKV), r = (int)(i / GQKV); int lo, hi; seq_bounds(r, lo, hi);
        const float* w = p.gdn_conv_w + (size_t)layer * GCONV * GQKV; float acc = 0.f;
        for (int j = 0; j < GCONV; ++j) { const int rr = r + j - 2; if (rr >= lo && rr < hi) acc += w[j * GQKV + cc] * ldf(p.P() + (size_t)rr * DPROJP + PO_GQKV + cc); }
        stf(p.G() + (size_t)r * GQKV + cc, silu_f(acc));
    } break;
    case ST_GDN_L2: {
        const int hh = (int)(i % 12), r = (int)(i / 12); st_t* g = p.G() + (size_t)r * GQKV + hh * 64; float ss = 0.f;
        for (int d = 0; d < 64; ++d) { const float v = ldf(g + d); ss += v * v; }
        const float rn = 1.0f / sqrtf(ss + EPS);
        for (int d = 0; d < 64; ++d) stf(g + d, ldf(g + d) * rn);
    } break;
    case ST_GDN_GATE: {
        const int j = (int)(i % 12), r = (int)(i / 12); const st_t* pr = p.P() + (size_t)r * DPROJP + PO_BA;
        const float beta = sigmoid_f(ldf(pr + j)); const float a = ldf(pr + 12 + j);
        const float g = -expf(p.gdn_a_log[layer * 12 + j]) * softplus_f(a + p.gdn_dt_bias[layer * 12 + j]);
        p.BG()[(size_t)r * 24 + j] = beta; p.BG()[(size_t)r * 24 + 12 + j] = g;
    } break;
    case ST_MLA_NORM: {
        const int w = (int)(i % 2), r = (int)(i / 2);
        const int n = w == 0 ? MQR : MKVR; const st_t* src = p.P() + (size_t)r * DPROJP + (w == 0 ? PO_CQ : PO_CKV);
        const float* gain = w == 0 ? p.mla_q_norm + (size_t)layer * MQR : p.mla_kv_norm + (size_t)layer * MKVR;
        st_t* dst = w == 0 ? p.CQN() + (size_t)r * MQR : p.CKVN() + (size_t)r * MKVR; float ss = 0.f;
        for (int d = 0; d < n; ++d) { const float v = ldf(src + d); ss += v * v; }
        const float rstd = 1.0f / sqrtf(ss / n + EPS);
        for (int d = 0; d < n; ++d) stf(dst + d, ldf(src + d) * rstd * gain[d]);
    } break;
    case ST_ROPE_MLA: {
        const int j = (int)(i % 16), w = (int)((i / 16) % 5), r = (int)(i / 80);
        const int s = r % S, rp = s / GRID_W, cp = s % GRID_W;
        const int half = j / 8, ii = j % 8; const float ang = (float)(half == 0 ? rp : cp) * rope_inv(ii, 8); const float cs = cosf(ang), sn = sinf(ang);
        st_t* q = w < 4 ? p.MQ() + (size_t)r * MH * MQD + w * MQD + MNOPE + half * 16 + ii : p.P() + (size_t)r * DPROJP + PO_KR + half * 16 + ii;
        const float x1 = ldf(q), x2 = ldf(q + 8); stf(q, x1 * cs - x2 * sn); stf(q + 8, x1 * sn + x2 * cs);
    } break;
    case ST_SWA: {
        const int h = (int)(i % SWA_H), r = (int)(i / SWA_H); const int kvh = h / SWA_G;
        float q[64], acc[64]; const st_t* qp = p.P() + (size_t)r * DPROJP + PO_QA + h * 64;
        _Pragma("unroll") for (int d = 0; d < 64; ++d) { q[d] = ldf(qp + d) * 0.125f; acc[d] = 0.f; }
        float m = p.swa_sink[layer * SWA_H + h], den = 1.0f;
        int b, klo = 0, khi = 0;
        if (r < T) { b = r / S; const int s = r % S; klo = s - SWA_W < 0 ? 0 : s - SWA_W; khi = s + SWA_W > S - 1 ? S - 1 : s + SWA_W; } else { b = (r - T) / L; khi = -1; }
        const int nloc = khi - klo + 1;
        for (int t = 0; t < nloc + L; ++t) {
            const int kr = t < nloc ? b * S + klo + t : T + b * L + (t - nloc);
            const st_t* kp = p.P() + (size_t)kr * DPROJP + PO_KA + kvh * 64; const st_t* vp = p.P() + (size_t)kr * DPROJP + PO_VA + kvh * 64;
            float sc = 0.f; _Pragma("unroll") for (int d = 0; d < 64; ++d) sc += q[d] * ldf(kp + d);
            if (sc > m) { const float f = expf(m - sc); den *= f; _Pragma("unroll") for (int d = 0; d < 64; ++d) acc[d] *= f; m = sc; }
            const float pe = expf(sc - m); den += pe;
            _Pragma("unroll") for (int d = 0; d < 64; ++d) acc[d] += pe * ldf(vp + d);
        }
        const float inv = 1.0f / den; st_t* o = p.O() + (size_t)r * DMIX + h * 64;
        _Pragma("unroll") for (int d = 0; d < 64; ++d) stf(o + d, acc[d] * inv);
    } break;
    case ST_GDN_SCAN: {
        const int e = (int)(i % GDV), dir = (int)((i / GDV) % 2), h = (int)((i / (GDV * 2)) % GH), b = (int)(i / (GDV * 2 * GH));
        float s[64]; _Pragma("unroll") for (int d = 0; d < 64; ++d) s[d] = 0.f;
        st_t* dst = dir == 0 ? p.OF() : p.OB();
        for (int t = 0; t < L + S; ++t) {
            int r; if (t < L) r = T + b * L + (dir == 0 ? t : L - 1 - t); else { const int u = t - L; r = b * S + (dir == 0 ? u : S - 1 - u); }
            const st_t* g = p.G() + (size_t)r * GQKV; const st_t* qv = g + h * 64; const st_t* kv = g + 384 + h * 64; const float v = ldf(g + 768 + h * 64 + e);
            const float beta = p.BG()[(size_t)r * 24 + dir * 6 + h], alpha = expf(p.BG()[(size_t)r * 24 + 12 + dir * 6 + h]);
            float ks = 0.f; _Pragma("unroll") for (int d = 0; d < 64; ++d) { s[d] *= alpha; ks += ldf(kv + d) * s[d]; }
            const float vn = beta * (v - ks); float o = 0.f;
            _Pragma("unroll") for (int d = 0; d < 64; ++d) { s[d] += ldf(kv + d) * vn; o += ldf(qv + d) * s[d]; }
            stf(dst + (size_t)r * (GH * GDV) + h * 64 + e, o * 0.125f);
        }
    } break;
    case ST_GDN_OUT: {
        const int h = (int)(i % GH), r = (int)(i / GH); const st_t* of = p.OF() + (size_t)r * 384 + h * 64; const st_t* ob = p.OB() + (size_t)r * 384 + h * 64;
        float ss = 0.f; for (int d = 0; d < 64; ++d) { const float o = ldf(of + d) + ldf(ob + d); ss += o * o; }
        const float rstd = 1.0f / sqrtf(ss / 64 + EPS); const float* nw = p.gdn_norm_w + layer * 64; const st_t* z = p.P() + (size_t)r * DPROJP + PO_Z + h * 64;
        st_t* o = p.O() + (size_t)r * DMIX + 384 + h * 64;
        for (int d = 0; d < 64; ++d) stf(o + d, (ldf(of + d) + ldf(ob + d)) * rstd * nw[d] * silu_f(ldf(z + d)));
    } break;
    case ST_MLA: {
        const int h = (int)(i % MH), r = (int)(i / MH); const float scale = 1.0f / sqrtf((float)MQD);
        float acc[64]; const st_t* qp = p.MQ() + (size_t)r * MH * MQD + h * MQD;
        _Pragma("unroll") for (int d = 0; d < 64; ++d) acc[d] = 0.f;
        float m = -1e30f, den = 0.f; int b, nlat;
        if (r < T) { b = r / S; nlat = S; } else { b = (r - T) / L; nlat = 0; }
        for (int t = 0; t < nlat + L; ++t) {
            const int kr = t < nlat ? b * S + t : T + b * L + (t - nlat);
            const st_t* kn = p.MKV() + (size_t)kr * MH * MKVD + h * MKVD; const st_t* krp = p.P() + (size_t)kr * DPROJP + PO_KR;
            float sc = 0.f; for (int d = 0; d < 64; ++d) sc += ldf(qp + d) * ldf(kn + d);
            for (int d = 0; d < 32; ++d) sc += ldf(qp + 64 + d) * ldf(krp + d);
            sc *= scale;
            if (sc > m) { const float f = expf(m - sc); den *= f; _Pragma("unroll") for (int d = 0; d < 64; ++d) acc[d] *= f; m = sc; }
            const float pe = expf(sc - m); den += pe;
            _Pragma("unroll") for (int d = 0; d < 64; ++d) acc[d] += pe * ldf(kn + 64 + d);
        }
        const float inv = 1.0f / den; st_t* o = p.O() + (size_t)r * DMIX + 768 + h * 64;
        _Pragma("unroll") for (int d = 0; d < 64; ++d) stf(o + d, acc[d] * inv);
    } break;
    case ST_POST1: {
        const int r = (int)i; const st_t* y = p.Y() + (size_t)r * D; const float* xi = xin_row(p, layer, r); float* xr = xrow(p, r); float ss = 0.f;
        for (int d = 0; d < D; ++d) { const float v = ldf(y + d); ss += v * v; }
        const float rstd = 1.0f / sqrtf(ss / D + EPS); const float* gp = p.mix_norm_post + (size_t)layer * D; const float* g1 = mod_vec(p, layer, r, 2);
        float s2 = 0.f;
        for (int d = 0; d < D; ++d) { const float v = xi[d] + g1[d] * ldf(y + d) * rstd * gp[d]; xr[d] = v; s2 += v * v; }
        const float r2 = 1.0f / sqrtf(s2 / D + EPS); const float* gf = p.ffn_norm_pre + (size_t)layer * D; const float* sh = mod_vec(p, layer, r, 3); const float* sc = mod_vec(p, layer, r, 4);
        st_t* hr = p.H() + (size_t)r * D;
        for (int d = 0; d < D; ++d) stf(hr + d, xr[d] * r2 * gf[d] * (1.0f + sc[d]) + sh[d]);
    } break;
    case ST_ROUTER: {
        const int n = (int)(i % NE), r = (int)(i / NE); const st_t* a = p.H() + (size_t)r * D; const float* b = p.router_w + (size_t)layer * D * NE + n; float acc = 0.f;
        for (int k = 0; k < D; ++k) acc += ldf(a + k) * b[(size_t)k * NE];
        p.LOGITS()[(size_t)r * NE + n] = acc;
    } break;
    case ST_ROUTE: {
        const int r = (int)i; const float* lg = p.LOGITS() + (size_t)r * NE; const float* bias = p.router_bias + (size_t)layer * NE;
        float gs[NGRP];
        _Pragma("unroll") for (int g = 0; g < NGRP; ++g) { float m1 = -1e30f, m2 = -1e30f; for (int j = 0; j < 8; ++j) { const float v = sigmoid_f(lg[g * 8 + j]) + bias[g * 8 + j]; if (v > m1) { m2 = m1; m1 = v; } else if (v > m2) m2 = v; } gs[g] = m1 + m2; }
        unsigned gmask = 0;
        _Pragma("unroll") for (int k = 0; k < TOPG; ++k) { int best = 0; float bv = -1e30f; _Pragma("unroll") for (int g = 0; g < NGRP; ++g) if (!((gmask >> g) & 1u) && gs[g] > bv) { bv = gs[g]; best = g; } gmask |= 1u << best; }
        unsigned long long used = 0ull; float wsum = 0.f; float wv[TOPK]; int wi[TOPK];
        _Pragma("unroll") for (int k = 0; k < TOPK; ++k) { int best = 0; float bv = -1e30f;
            for (int e = 0; e < NE; ++e) if (((gmask >> (e / 8)) & 1u) && !((used >> e) & 1ull)) { const float v = sigmoid_f(lg[e]) + bias[e]; if (v > bv) { bv = v; best = e; } }
            used |= 1ull << best; wi[k] = best; wv[k] = sigmoid_f(lg[best]); wsum += wv[k]; }
        int* cnt = p.CNT() + layer * NE;
        _Pragma("unroll") for (int k = 0; k < TOPK; ++k) { const float w = wv[k] / wsum * ROUTED_SCALE; const int e = wi[k]; const int pos = atomic_inc(cnt + e);
            p.EIDX()[(size_t)r * TOPK + k] = e; p.EW()[(size_t)r * TOPK + k] = w; p.EPOS()[(size_t)r * TOPK + k] = pos; p.TOKLIST()[(size_t)e * TA + pos] = r; p.WLIST()[(size_t)e * TA + pos] = w; }
    } break;
    case ST_POST2: {
        const int r = (int)i; float* xr = xrow(p, r); const int* cnt = p.CNT() + layer * NE; const st_t* f[TOPK + 1]; f[0] = p.SH() + (size_t)r * D;
        _Pragma("unroll") for (int k = 0; k < TOPK; ++k) { const int e = p.EIDX()[(size_t)r * TOPK + k]; f[k + 1] = p.YB() + (size_t)(expert_base(cnt, e) + p.EPOS()[(size_t)r * TOPK + k]) * D; }
        float ss = 0.f;
        for (int d = 0; d < D; ++d) { float v = 0.f; _Pragma("unroll") for (int k = 0; k <= TOPK; ++k) v += ldf(f[k] + d); ss += v * v; }
        const float rstd = 1.0f / sqrtf(ss / D + EPS); const float* gp = p.ffn_norm_post + (size_t)layer * D; const float* g2 = mod_vec(p, layer, r, 5);
        for (int d = 0; d < D; ++d) { float v = 0.f; _Pragma("unroll") for (int k = 0; k <= TOPK; ++k) v += ldf(f[k] + d); xr[d] = xr[d] + g2[d] * v * rstd * gp[d]; }
    } break;
    }
}

enum { WT_STATIC = 0, WT_EXPERT = 1 };
HD long long wt_items(const Params& p, int kind) {
    if (kind == WT_STATIC) { long long n = 0; for (int j = 0; j < NJOBS; ++j) n += static_job_items(j); return n; }
    return (long long)NE * ((D / 64) * (DE / 32) * 2 + (DE / 64) * (D / 32));
}
HD bool wt_job(const Params& p, int kind, int layer, long long item, TJob& jb, int& kb, int& nb) {
    if (kind == WT_STATIC) {
        for (int j = 0; j < NJOBS; ++j) { const long long n = static_job_items(j); if (item < n) { jb = static_job(p, j); const int nblk = (jb.npad + 31) / 32; kb = (int)(item / nblk); nb = (int)(item % nblk); return true; } item -= n; }
        return false;
    }
    const int per_gu = (D / 64) * (DE / 32), per_d = (DE / 64) * (D / 32), per_e = 2 * per_gu + per_d;
    const int e = (int)(item / per_e); int r = (int)(item % per_e);
    if (r < 2 * per_gu) { const int w = r / per_gu; r %= per_gu; const float* src = (w == 0 ? p.e_gate : p.e_up) + ((size_t)layer * NE + e) * D * DE;
        jb = {src, p.Wt_egu() + (size_t)e * 2 * DE * D, D, DE, DE, 32, w * 16, D, DE, 0}; kb = r / (DE / 32); nb = r % (DE / 32); }
    else { r -= 2 * per_gu; jb = {p.e_down + ((size_t)layer * NE + e) * DE * D, p.Wt_ed() + (size_t)e * D * DE, DE, D, D, 16, 0, DE, D, 0}; kb = r / (D / 32); nb = r % (D / 32); }
    return true;
}
HD size_t wt_dst_row(const TJob& jb, int n) { return (size_t)(n / 16) * jb.grp + (n % 16) + jb.off; }
#ifdef HOST_EMU
inline void wt_item_host(const Params& p, int kind, int layer, long long item) {
    TJob jb; int kb, nb; if (!wt_job(p, kind, layer, item, jb, kb, nb)) return;
    for (int n = nb * 32; n < nb * 32 + 32 && n < jb.npad; ++n) for (int k = kb * 64; k < kb * 64 + 64; ++k)
        jb.dst[wt_dst_row(jb, n) * jb.ldt + k] = n < jb.N ? jb.src[(size_t)k * jb.ldsrc + n] : 0.f;
}
#else
__device__ __forceinline__ void wt_item_dev(const Params& p, int kind, int layer, long long item, LAS float* scr, int lane) {
    TJob jb; int kb, nb; if (!wt_job(p, kind, layer, item, jb, kb, nb)) return;
    const int k0 = kb * 64, n0 = nb * 32;
    { float tmp[32]; const int n = n0 + (lane & 31); const float* sp = jb.src + (size_t)(k0 + (lane >> 5)) * jb.ldsrc + n;
      if (n < jb.N) {
#pragma unroll
          for (int i = 0; i < 32; ++i) tmp[i] = sp[(size_t)(2 * i) * jb.ldsrc];
      } else {
#pragma unroll
          for (int i = 0; i < 32; ++i) tmp[i] = 0.f; }
#pragma unroll
      for (int i = 0; i < 32; ++i) scr[(2 * i + (lane >> 5)) * 33 + (lane & 31)] = tmp[i]; }
    asm volatile("s_waitcnt lgkmcnt(0)" ::: "memory");
    const int c = lane & 7;
#pragma unroll
    for (int j = 0; j < 4; ++j) { const int nl = (lane >> 3) + 8 * j, n = n0 + nl; const LAS float* s = scr + (8 * c) * 33 + nl;
        if (n < jb.npad) { uint4 o; o.x = pk_bf16(s[0 * 33], s[1 * 33]); o.y = pk_bf16(s[2 * 33], s[3 * 33]); o.z = pk_bf16(s[4 * 33], s[5 * 33]); o.w = pk_bf16(s[6 * 33], s[7 * 33]);
            *(uint4*)(jb.dst + wt_dst_row(jb, n) * jb.ldt + k0 + 8 * c) = o; } }
    asm volatile("s_waitcnt lgkmcnt(0)" ::: "memory");
}
#endif

enum { EPI_BF16 = 0, EPI_SWIGLU = 1, EPI_SCALE = 2, EPI_PROJ = 3, EPI_UQ = 4, EPI_UKV = 5 };
enum GStage { G_PROJ = 0, G_UQ, G_UKV, G_WOUT, G_SGU, G_SDOWN, G_EGU, G_EDOWN };
struct GemmDesc {
    const st_t* A; int lda; const int* rowidx; int a_row0, nrows;
    const st_t* Bt; int ldb, K, n0;
    int epi; st_t* out; int ldc; long long out_row0; const float* rowscale;
    const float* tab; st_t* vt;
};
HD int cdiv(int a, int b) { return (a + b - 1) / b; }
struct ETab { const int* eb; const int* tb; };
HD int gemm_ntiles(const Params& p, int gs, int layer, ETab et = ETab{nullptr, nullptr}) {
    const int mt = rows_out(layer) / 128;
    switch (gs) {
    case G_PROJ: return (TA / 128) * (DPROJP / 128);
    case G_UQ: return (TA / 128) * (MH * MQD / 128);
    case G_UKV: return (TA / 128) * (MH * MKVD / 128);
    case G_WOUT: return mt * (D / 128);
    case G_SGU: return mt * (2 * DS / 128);
    case G_SDOWN: return mt * (D / 128);
    case G_EGU: case G_EDOWN: { int t = 0; if (et.tb) t = et.tb[NE]; else for (int e = 0; e < NE; ++e) t += cdiv(p.CNT()[layer * NE + e], 128); return t * (gs == G_EGU ? 2 * DE / 128 : D / 128); }
    }
    return 0;
}
HD void gemm_desc(const Params& p, int gs, int layer, int item, GemmDesc& g, ETab et = ETab{nullptr, nullptr}) {
    g.rowidx = nullptr; g.rowscale = nullptr; g.nrows = 128; g.epi = EPI_BF16; g.tab = nullptr; g.vt = nullptr;
    auto plain = [&](const st_t* A, int lda, const st_t* Bt, int K, int ntn, st_t* out, int ldc) {
        const int mtn = (gs == G_PROJ || gs == G_UQ || gs == G_UKV ? TA : rows_out(layer)) / 128, PW = ntn < 8 ? ntn : 8, nfull = ntn / PW;
        int mt, nt; { const int pidx = item / (mtn * PW); if (pidx < nfull) { const int w = item - pidx * mtn * PW; mt = w / PW; nt = pidx * PW + w % PW; } else { const int pw = ntn - nfull * PW, w = item - nfull * mtn * PW; mt = w / pw; nt = nfull * PW + w % pw; } }
        g.A = A; g.lda = lda; g.a_row0 = mt * 128; g.Bt = Bt; g.ldb = K; g.K = K; g.n0 = nt * 128; g.out = out; g.ldc = ldc; g.out_row0 = mt * 128; };
    switch (gs) {
    case G_PROJ: plain(p.H(), D, p.Wt_in() + (size_t)layer * DPROJP * D, D, DPROJP / 128, p.P(), DPROJP); g.epi = EPI_PROJ; g.tab = g.n0 + 128 > PO_KR ? p.TABM() : p.TABA(); g.vt = p.VtA(); break;
    case G_UQ: plain(p.CQN(), MQR, p.Wt_uq() + (size_t)layer * MH * MQD * MQR, MQR, MH * MQD / 128, p.MQ(), MH * MQD); g.epi = EPI_UQ; g.tab = p.TABM(); break;
    case G_UKV: plain(p.CKVN(), MKVR, p.Wt_ukv() + (size_t)layer * MH * MKVD * MKVR, MKVR, MH * MKVD / 128, p.MKV(), MH * MKVD); g.epi = EPI_UKV; g.vt = p.VtM(); break;
    case G_WOUT: plain(p.O(), DMIX, p.Wt_out() + (size_t)layer * D * DMIX, DMIX, D / 128, p.Y(), D); break;
    case G_SGU: plain(p.H(), D, p.Wt_sgu() + (size_t)layer * 2 * DS * D, D, 2 * DS / 128, p.SACT(), DS); g.epi = EPI_SWIGLU; break;
    case G_SDOWN: plain(p.SACT(), DS, p.Wt_sd() + (size_t)layer * D * DS, DS, D / 128, p.SH(), D); break;
    case G_EGU: case G_EDOWN: {
        const int ntn = gs == G_EGU ? 2 * DE / 128 : D / 128; int mt = item / ntn; const int nt = item % ntn; const int* cnt = p.CNT() + layer * NE;
        int e = 0, base = 0;
        if (et.tb) { int lo = 0, hi = NE - 1; while (lo < hi) { const int mid = (lo + hi + 1) >> 1; if (et.tb[mid] <= mt) lo = mid; else hi = mid - 1; } e = lo; mt -= et.tb[e]; base = et.eb[e]; }
        else for (; e < NE; ++e) { const int te = cdiv(cnt[e], 128); if (mt < te) break; mt -= te; base += cnt[e]; }
        g.a_row0 = mt * 128; g.nrows = cnt[e] - mt * 128 < 128 ? cnt[e] - mt * 128 : 128; g.n0 = nt * 128; g.out_row0 = base + mt * 128;
        if (gs == G_EGU) { g.A = p.H(); g.lda = D; g.rowidx = p.TOKLIST() + (size_t)e * TA; g.Bt = p.Wt_egu() + (size_t)e * 2 * DE * D; g.ldb = D; g.K = D; g.epi = EPI_SWIGLU; g.out = p.ACT(); g.ldc = DE; }
        else { g.A = p.ACT() + (size_t)base * DE; g.lda = DE; g.Bt = p.Wt_ed() + (size_t)e * D * DE; g.ldb = DE; g.K = DE; g.epi = EPI_SCALE; g.out = p.YB(); g.ldc = D; g.rowscale = p.WLIST() + (size_t)e * TA - base; }
    } break;
    }
}
HD bool epi_needs_partner(const GemmDesc& g, int cb) { return g.epi == EPI_UQ || (g.epi == EPI_PROJ && g.n0 + cb + 64 > PO_KR); }
HD void rope8(float (&v)[4], const float (&pv)[4], int q, const float* tab, int pos) {
    for (int r = 0; r < 4; ++r) { const int c16 = q * 4 + r, i = c16 & 7; const float cs = tab[(pos * 8 + i) * 2], sn = tab[(pos * 8 + i) * 2 + 1];
        v[r] = c16 < 8 ? v[r] * cs - pv[r] * sn : pv[r] * sn + v[r] * cs; }
}
HD void gemm_epi(const GemmDesc& g, int rl, int cb, int q, float (&v)[4][4], const float (&pv)[4][4]) {
    if (rl >= g.nrows) return;
    const long long orow = g.out_row0 + rl;
    if (g.epi == EPI_SWIGLU) {
        for (int jj = 0; jj < 2; ++jj) { float a[4]; for (int r = 0; r < 4; ++r) a[r] = silu_f(v[2 * jj][r]) * v[2 * jj + 1][r];
            st4(g.out + (size_t)orow * g.ldc + (g.n0 + cb) / 2 + jj * 16 + q * 4, a[0], a[1], a[2], a[3]); }
        return;
    }
    if (g.epi >= EPI_PROJ) {
        const int row = (int)orow; const bool lat = row < T; const int bb = lat ? row / S : (row - T) / L, kidx = lat ? row % S : S + (row - T) % L;
        const int rp = lat ? (row % S) / GRID_W : 0, cp = lat ? (row % S) % GRID_W : 0, span = (g.n0 + cb) / 64;
        if (g.epi == EPI_PROJ) {
            if (span < 8) { if (lat) for (int hp = 0; hp < 2; ++hp) for (int r = 0; r < 4; ++r) { const int i = q * 4 + r, pos = hp ? cp : rp; const float cs = g.tab[(pos * 16 + i) * 2], sn = g.tab[(pos * 16 + i) * 2 + 1];
                    const float x1 = v[2 * hp][r], x2 = v[2 * hp + 1][r]; v[2 * hp][r] = x1 * cs - x2 * sn; v[2 * hp + 1][r] = x1 * sn + x2 * cs; } }
            else if (span < 10) { for (int j = 0; j < 4; ++j) for (int r = 0; r < 4; ++r) stf(g.vt + ((size_t)(bb * SWA_KVH + span - 8) * 64 + j * 16 + q * 4 + r) * NK + kidx, v[j][r]); return; }
            else if (g.n0 + cb + 64 > PO_KR && lat) { rope8(v[2], pv[2], q, g.tab, rp); rope8(v[3], pv[3], q, g.tab, cp); }
        } else if (g.epi == EPI_UQ) {
            if (lat) for (int j = 0; j < 4; ++j) { const int k6 = ((g.n0 + cb) / 16 + j) % 6; if (k6 >= 4) rope8(v[j], pv[j], q, g.tab, k6 == 4 ? rp : cp); }
        } else {
            if (span & 1) { for (int j = 0; j < 4; ++j) for (int r = 0; r < 4; ++r) stf(g.vt + ((size_t)(bb * MH + span / 2) * 64 + j * 16 + q * 4 + r) * NK + kidx, v[j][r]); return; }
        }
    }
    const float w = g.epi == EPI_SCALE ? g.rowscale[orow] : 1.0f;
    for (int j = 0; j < 4; ++j) st4(g.out + (size_t)orow * g.ldc + g.n0 + cb + j * 16 + q * 4, v[j][0] * w, v[j][1] * w, v[j][2] * w, v[j][3] * w);
}
#ifdef HOST_EMU
inline void gemm_tile_host(const GemmDesc& g) {
    for (int rl = 0; rl < g.nrows; ++rl) {
        const long long ar = g.rowidx ? g.rowidx[g.a_row0 + rl] : g.a_row0 + rl; const st_t* a = g.A + (size_t)ar * g.lda;
        for (int cb = 0; cb < 128; cb += 64) for (int q = 0; q < 4; ++q) { float v[4][4], pv[4][4];
            for (int j = 0; j < 4; ++j) for (int r = 0; r < 4; ++r) { const st_t* b = g.Bt + (size_t)(g.n0 + cb + j * 16 + q * 4 + r) * g.ldb; float acc = 0.f; for (int k = 0; k < g.K; ++k) acc += a[k] * b[k]; v[j][r] = acc;
                const st_t* b2 = g.Bt + (size_t)(g.n0 + cb + j * 16 + (q ^ 2) * 4 + r) * g.ldb; float acc2 = 0.f; for (int k = 0; k < g.K; ++k) acc2 += a[k] * b2[k]; pv[j][r] = acc2; }
            gemm_epi(g, rl, cb, q, v, pv); }
    }
}
#else
__device__ __forceinline__ void gemm_tile_dev(const GemmDesc& g, LAS unsigned char* lds, const int tid) {
    const int lane = tid & 63, wave = __builtin_amdgcn_readfirstlane(tid >> 6), wr = wave >> 1, wc = wave & 1;
    const int lrow = lane >> 3, slot = lane & 7;
    const st_t* asrc[4]; const st_t* bsrc[4];
#pragma unroll
    for (int i = 0; i < 4; ++i) {
        const int row = i * 32 + wave * 8 + lrow, chunk = slot ^ ((row >> 1) & 7);
        int rl = row < g.nrows ? row : g.nrows - 1;
        const long long ar = g.rowidx ? (long long)g.rowidx[g.a_row0 + rl] : (long long)(g.a_row0 + rl);
        asrc[i] = g.A + (size_t)ar * g.lda + chunk * 8;
        bsrc[i] = g.Bt + (size_t)(g.n0 + row) * g.ldb + chunk * 8;
    }
    const int nt = g.K / 64;
    auto stage = [&](int buf, int t) {
#pragma unroll
        for (int i = 0; i < 4; ++i) {
            __builtin_amdgcn_global_load_lds((const unsigned*)(asrc[i] + t * 64), (LAS unsigned*)(lds + buf * 32768 + (i * 32 + wave * 8) * 128), 16, 0, 0);
            __builtin_amdgcn_global_load_lds((const unsigned*)(bsrc[i] + t * 64), (LAS unsigned*)(lds + buf * 32768 + 16384 + (i * 32 + wave * 8) * 128), 16, 0, 0);
        }
    };
    f32x4 acc[4][4];
#pragma unroll
    for (int i = 0; i < 4; ++i)
#pragma unroll
        for (int j = 0; j < 4; ++j) acc[i][j] = (f32x4){0.f, 0.f, 0.f, 0.f};
    const int fr = lane & 15, fq = lane >> 4;
    __syncthreads();
    stage(0, 0);
    __syncthreads();
    for (int t = 0; t < nt; ++t) {
        const int cur = t & 1;
        if (t + 1 < nt) stage(cur ^ 1, t + 1);
        const LAS unsigned char* As = lds + cur * 32768; const LAS unsigned char* Bs = As + 16384;
#pragma unroll
        for (int kk = 0; kk < 2; ++kk) {
            bf16x8 af[4], bfr[4];
#pragma unroll
            for (int i = 0; i < 4; ++i) { const int row = wr * 64 + i * 16 + fr; af[i] = *(const LAS bf16x8*)(As + row * 128 + (((kk * 4 + fq) ^ ((row >> 1) & 7)) << 4)); }
#pragma unroll
            for (int j = 0; j < 4; ++j) { const int row = wc * 64 + j * 16 + fr; bfr[j] = *(const LAS bf16x8*)(Bs + row * 128 + (((kk * 4 + fq) ^ ((row >> 1) & 7)) << 4)); }
#pragma unroll
            for (int i = 0; i < 4; ++i)
#pragma unroll
                for (int j = 0; j < 4; ++j) acc[i][j] = __builtin_amdgcn_mfma_f32_16x16x32_bf16(bfr[j], af[i], acc[i][j], 0, 0, 0);
        }
        __syncthreads();
    }
    const bool need_pv = epi_needs_partner(g, wc * 64);
#pragma unroll
    for (int i = 0; i < 4; ++i) { float v[4][4], pv[4][4];
#pragma unroll
        for (int j = 0; j < 4; ++j)
#pragma unroll
            for (int r = 0; r < 4; ++r) { v[j][r] = acc[i][j][r]; pv[j][r] = 0.f; }
        if (need_pv) {
#pragma unroll
            for (int j = 0; j < 4; ++j)
#pragma unroll
                for (int r = 0; r < 4; ++r) pv[j][r] = __shfl_xor(v[j][r], 32); }
        gemm_epi(g, wr * 64 + i * 16 + fr, wc * 64, fq, v, pv); }
}
#endif


struct AttnDesc {
    int dqk;
    const st_t* Q; int ldq, q_row0;
    const st_t* K1; int ldk1; const st_t* K2; int ldk2;
    int lat_row0, ctx_row0;
    const st_t* Vt;
    int kt_lo, kt_hi, nctx;
    int mask, qpos0;
    float m_init, l_init, c;
    st_t* O; int o_col;
};
HD int attn_nitems(int layer) { const int lat = B * MH * (S / 128) + B * SWA_H * (S / 128); return layer == DEPTH - 1 ? lat : lat + B * MH * (L / 128) + B * SWA_H * (L / 128); }
HD int attn_queue_size(int layer, int x) {
    const int NQ = S / 128, NQC = L / 128, half = x / 4; int n = NCHAIN / 8 + NQ + SWA_G * (NQ * (half + 1) / 2 - NQ * half / 2);
    if (layer < DEPTH - 1) n += NQC + SWA_G * (NQC * (half + 1) / 2 - NQC * half / 2);
    return n;
}
HD int attn_queue_item(int layer, int x, int k) {
    const int NQ = S / 128, NQC = L / 128, half = x / 4, n_mla = B * MH * NQ, n_swa = B * SWA_H * NQ, n_mlac = B * MH * NQC;
    if (k < NCHAIN / 8) return x * (NCHAIN / 8) + k; k -= NCHAIN / 8;
    if (k < NQ) return NCHAIN + x * NQ + k; k -= NQ;
    const int gb = (x % 4) / SWA_KVH, gk = (x % 4) % SWA_KVH;
    { const int qlo = NQ * half / 2, nq = NQ * (half + 1) / 2 - qlo; if (k < SWA_G * nq) { const int h = gk * SWA_G + k / nq; return NCHAIN + n_mla + (gb * SWA_H + h) * NQ + qlo + k % nq; } k -= SWA_G * nq; }
    if (k < NQC) return NCHAIN + n_mla + n_swa + x * NQC + k; k -= NQC;
    { const int qlo = NQC * half / 2, nq = NQC * (half + 1) / 2 - qlo; const int h = gk * SWA_G + k / (nq > 0 ? nq : 1); return NCHAIN + n_mla + n_swa + n_mlac + (gb * SWA_H + h) * NQC + qlo + k % (nq > 0 ? nq : 1); }
}
static_assert(NCHAIN % 8 == 0 && B * MH == 8 && B * SWA_KVH == 4, "queue layout");
HD void attn_desc(const Params& p, int layer, int item, AttnDesc& a) {
    const float LOG2E = 1.4426950408889634f;
    const int n_mla = B * MH * (S / 128), n_swa = B * SWA_H * (S / 128), n_mlac = B * MH * (L / 128);
    bool mla, ctxq; int b, h, qb;
    if (item < n_mla) { mla = true; ctxq = false; qb = item % (S / 128); h = (item / (S / 128)) % MH; b = item / (S / 128) / MH; }
    else if (item < n_mla + n_swa) { item -= n_mla; mla = false; ctxq = false; qb = item % (S / 128); h = (item / (S / 128)) % SWA_H; b = item / (S / 128) / SWA_H; }
    else if (item < n_mla + n_swa + n_mlac) { item -= n_mla + n_swa; mla = true; ctxq = true; qb = item % (L / 128); h = (item / (L / 128)) % MH; b = item / (L / 128) / MH; }
    else { item -= n_mla + n_swa + n_mlac; mla = false; ctxq = true; qb = item % (L / 128); h = (item / (L / 128)) % SWA_H; b = item / (L / 128) / SWA_H; }
    a.q_row0 = ctxq ? T + b * L + qb * 128 : b * S + qb * 128; a.lat_row0 = b * S; a.ctx_row0 = T + b * L; a.nctx = L / 64; a.qpos0 = qb * 128; a.O = p.O();
    if (mla) {
        a.dqk = 96; a.Q = p.MQ() + h * MQD; a.ldq = MH * MQD; a.K1 = p.MKV() + h * MKVD; a.ldk1 = MH * MKVD; a.K2 = p.P() + PO_KR; a.ldk2 = DPROJP;
        a.Vt = p.VtM() + (size_t)(b * MH + h) * 64 * NK; a.kt_lo = 0; a.kt_hi = ctxq ? 0 : S / 64; a.mask = 0; a.m_init = -1e30f; a.l_init = 0.f; a.c = LOG2E / sqrtf((float)MQD); a.o_col = 768 + h * 64;
    } else {
        const int kvh = h / SWA_G;
        a.dqk = 64; a.Q = p.P() + PO_QA + h * 64; a.ldq = DPROJP; a.K1 = p.P() + PO_KA + kvh * 64; a.ldk1 = DPROJP; a.K2 = nullptr; a.ldk2 = 0;
        a.Vt = p.VtA() + (size_t)(b * SWA_KVH + kvh) * 64 * NK; a.mask = ctxq ? 0 : 1;
        if (ctxq) { a.kt_lo = 0; a.kt_hi = 0; } else { a.kt_lo = (a.qpos0 - SWA_W) / 64; if (a.kt_lo < 0) a.kt_lo = 0; a.kt_hi = (a.qpos0 + 128 + SWA_W) / 64; if (a.kt_hi > S / 64) a.kt_hi = S / 64; }
        a.m_init = p.swa_sink[layer * SWA_H + h] * LOG2E; a.l_init = 1.f; a.c = LOG2E * 0.125f; a.o_col = h * 64;
    }
}
#ifdef HOST_EMU
inline void attn_tile_host(const AttnDesc& a) {
    const int nl = a.kt_hi - a.kt_lo, ntile = nl + a.nctx;
    for (int q = 0; q < 128; ++q) {
        const st_t* qr = a.Q + (size_t)(a.q_row0 + q) * a.ldq; float m = a.m_init, l = a.l_init, acc[64]; for (int d = 0; d < 64; ++d) acc[d] = 0.f;
        for (int t = 0; t < ntile; ++t) for (int kk = 0; kk < 64; ++kk) {
            const int kidx = t < nl ? (a.kt_lo + t) * 64 + kk : S + (t - nl) * 64 + kk; const int row = kidx < S ? a.lat_row0 + kidx : a.ctx_row0 + kidx - S;
            if (a.mask && t < nl) { const int dq = a.qpos0 + q - kidx; if (dq > SWA_W || dq < -SWA_W) continue; }
            float sc = 0.f; for (int d = 0; d < 64; ++d) sc += qr[d] * a.K1[(size_t)row * a.ldk1 + d];
            if (a.dqk > 64) for (int d = 64; d < a.dqk; ++d) sc += qr[d] * a.K2[(size_t)row * a.ldk2 + d - 64];
            sc *= a.c; if (sc > m) { const float f = exp2f(m - sc); l *= f; for (int d = 0; d < 64; ++d) acc[d] *= f; m = sc; }
            const float pe = exp2f(sc - m); l += pe; for (int d = 0; d < 64; ++d) acc[d] += pe * a.Vt[(size_t)d * NK + kidx];
        }
        for (int d = 0; d < 64; ++d) a.O[(size_t)(a.q_row0 + q) * DMIX + a.o_col + d] = acc[d] / l;
    }
}
#else
typedef float f32x16 __attribute__((ext_vector_type(16)));
typedef unsigned u32x4 __attribute__((ext_vector_type(4)));
typedef unsigned u32x2 __attribute__((ext_vector_type(2)));
__device__ __forceinline__ int crow16(int reg, int h) { return (reg & 3) + 8 * (reg >> 2) + 4 * h; }
template <int DQK>
__device__ __forceinline__ void attn_tile_dev(const AttnDesc& a, LAS unsigned char* lds, const int tid) {
    constexpr int KSTR = DQK * 2 + 16, VSTR = 136, KBYTES = 64 * KSTR, BUF = KBYTES + 64 * VSTR, CPR = DQK / 8, KCH = 64 * CPR / 256, NKS = DQK / 16;
    const int lane = tid & 63, wave = __builtin_amdgcn_readfirstlane(tid >> 6), l31 = lane & 31, hh = lane >> 5;
    bf16x8 qf[NKS];
    { const st_t* qrow = a.Q + (size_t)(a.q_row0 + wave * 32 + l31) * a.ldq;
#pragma unroll
      for (int ks = 0; ks < NKS; ++ks) qf[ks] = *(const bf16x8*)(qrow + 16 * ks + 8 * hh); }
    f32x16 ot[2];
#pragma unroll
    for (int r = 0; r < 16; ++r) { ot[0][r] = 0.f; ot[1][r] = 0.f; }
    float m = a.m_init, lsum = hh == 0 ? a.l_init : 0.f;
    const int nl = a.kt_hi - a.kt_lo, ntile = nl + a.nctx; const float c = a.c;
    u32x4 kreg[KCH], vreg[2];
    auto gload = [&](int t) {
        const int kidx0 = t < nl ? (a.kt_lo + t) * 64 : S + (t - nl) * 64; const int rowbase = t < nl ? a.lat_row0 + kidx0 : a.ctx_row0 + kidx0 - S;
#pragma unroll
        for (int u = 0; u < KCH; ++u) { const int ci = tid + 256 * u, row = ci / CPR, cc = ci % CPR;
            const st_t* src = (DQK == 64 || cc < 8) ? a.K1 + (size_t)(rowbase + row) * a.ldk1 + cc * 8 : a.K2 + (size_t)(rowbase + row) * a.ldk2 + (cc - 8) * 8;
            kreg[u] = *(const u32x4*)src; }
#pragma unroll
        for (int u = 0; u < 2; ++u) { const int ci = tid + 256 * u, dv = ci >> 3, cc = ci & 7; vreg[u] = *(const u32x4*)(a.Vt + (size_t)dv * NK + kidx0 + cc * 8); }
    };
    auto lstore = [&](int buf) {
#pragma unroll
        for (int u = 0; u < KCH; ++u) { const int ci = tid + 256 * u, row = ci / CPR, cc = ci % CPR; *(LAS u32x4*)(lds + buf * BUF + row * KSTR + cc * 16) = kreg[u]; }
#pragma unroll
        for (int u = 0; u < 2; ++u) { const int ci = tid + 256 * u, dv = ci >> 3, cc = ci & 7; LAS u32x2* d = (LAS u32x2*)(lds + buf * BUF + KBYTES + dv * VSTR + cc * 16);
            d[0] = (u32x2){vreg[u].x, vreg[u].y}; d[1] = (u32x2){vreg[u].z, vreg[u].w}; }
    };
    __syncthreads();
    gload(0); lstore(0);
    __syncthreads();
    for (int t = 0; t < ntile; ++t) {
        const int cur = t & 1;
        if (t + 1 < ntile) gload(t + 1);
        const LAS unsigned char* Ks = lds + cur * BUF; const LAS unsigned char* Vs = Ks + KBYTES;
        f32x16 st[2];
#pragma unroll
        for (int kb = 0; kb < 2; ++kb) {
#pragma unroll
            for (int r = 0; r < 16; ++r) st[kb][r] = 0.f;
#pragma unroll
            for (int ks = 0; ks < NKS; ++ks) { const bf16x8 af = *(const LAS bf16x8*)(Ks + (kb * 32 + l31) * KSTR + (16 * ks + 8 * hh) * 2);
                st[kb] = __builtin_amdgcn_mfma_f32_32x32x16_bf16(af, qf[ks], st[kb], 0, 0, 0); }
        }
        if (a.mask && t < nl) {
            const int d0 = a.qpos0 + wave * 32 + l31 - (a.kt_lo + t) * 64;
#pragma unroll
            for (int kb = 0; kb < 2; ++kb)
#pragma unroll
                for (int r = 0; r < 16; ++r) { const int dq = d0 - (kb * 32 + crow16(r, hh)); if (dq > SWA_W || dq < -SWA_W) st[kb][r] = -1e30f; }
        }
        float mx = st[0][0];
#pragma unroll
        for (int r = 1; r < 16; ++r) mx = fmaxf(mx, st[0][r]);
#pragma unroll
        for (int r = 0; r < 16; ++r) mx = fmaxf(mx, st[1][r]);
        mx = fmaxf(mx, __shfl_xor(mx, 32));
        const float m_new = fmaxf(m, mx * c), alpha = __builtin_amdgcn_exp2f(m - m_new);
        float rs = 0.f;
#pragma unroll
        for (int kb = 0; kb < 2; ++kb)
#pragma unroll
            for (int r = 0; r < 16; ++r) { const float pe = __builtin_amdgcn_exp2f(__builtin_fmaf(st[kb][r], c, -m_new)); st[kb][r] = pe; rs += pe; }
        lsum = lsum * alpha + rs; m = m_new;
#pragma unroll
        for (int r = 0; r < 16; ++r) { ot[0][r] *= alpha; ot[1][r] *= alpha; }
#pragma unroll
        for (int kb = 0; kb < 2; ++kb)
#pragma unroll
            for (int s2 = 0; s2 < 2; ++s2) {
                u32x4 pw; pw.x = pk_bf16(st[kb][8 * s2 + 0], st[kb][8 * s2 + 1]); pw.y = pk_bf16(st[kb][8 * s2 + 2], st[kb][8 * s2 + 3]);
                pw.z = pk_bf16(st[kb][8 * s2 + 4], st[kb][8 * s2 + 5]); pw.w = pk_bf16(st[kb][8 * s2 + 6], st[kb][8 * s2 + 7]);
                const bf16x8 pb = __builtin_bit_cast(bf16x8, pw);
#pragma unroll
                for (int db = 0; db < 2; ++db) { const LAS unsigned char* vp = Vs + (db * 32 + l31) * VSTR + (kb * 32 + 16 * s2 + 4 * hh) * 2;
                    const u32x2 lo = *(const LAS u32x2*)vp, hi = *(const LAS u32x2*)(vp + 16); u32x4 vw; vw.x = lo.x; vw.y = lo.y; vw.z = hi.x; vw.w = hi.y;
                    ot[db] = __builtin_amdgcn_mfma_f32_32x32x16_bf16(__builtin_bit_cast(bf16x8, vw), pb, ot[db], 0, 0, 0); }
            }
        if (t + 1 < ntile) lstore(cur ^ 1);
        __syncthreads();
    }
    const float inv = 1.0f / (lsum + __shfl_xor(lsum, 32));
    st_t* orow = a.O + (size_t)(a.q_row0 + wave * 32 + l31) * DMIX + a.o_col;
#pragma unroll
    for (int db = 0; db < 2; ++db)
#pragma unroll
        for (int g = 0; g < 4; ++g) st4(orow + db * 32 + 8 * g + 4 * hh, ot[db][4 * g] * inv, ot[db][4 * g + 1] * inv, ot[db][4 * g + 2] * inv, ot[db][4 * g + 3] * inv);
}
#endif


HD int gdn_row(int b, int dir, int n, int i) {
    if (n < L / 64) { const int pos = n * 64 + i; return T + b * L + (dir == 0 ? pos : L - 1 - pos); }
    const int pos = (n - L / 64) * 64 + i; return b * S + (dir == 0 ? pos : S - 1 - pos);
}
#ifdef HOST_EMU
inline void gdn_pre_host(const Params& p, int item) {
    const int c = item / NCH, n = item % NCH, dir = c & 1, h = (c >> 1) % GH, b = (c >> 1) / GH;
    float gc[64], beta[64]; const st_t* kk[64]; const st_t* qq[64]; const st_t* vv[64]; float acc = 0.f;
    for (int i = 0; i < 64; ++i) { const int r = gdn_row(b, dir, n, i); acc += p.BG()[(size_t)r * 24 + 12 + dir * 6 + h]; gc[i] = acc; beta[i] = p.BG()[(size_t)r * 24 + dir * 6 + h];
        qq[i] = p.G() + (size_t)r * GQKV + h * 64; kk[i] = qq[i] + 384; vv[i] = qq[i] + 768; }
    static thread_local float A[64][64], XU[64][64], XW[64][64];
    for (int i = 0; i < 64; ++i) for (int j = 0; j < 64; ++j) { float d = 0.f; for (int e = 0; e < 64; ++e) d += kk[i][e] * kk[j][e]; A[i][j] = j < i ? beta[i] * d * expf(gc[i] - gc[j]) : 0.f; }
    for (int i = 0; i < 64; ++i) for (int e = 0; e < 64; ++e) { float u = beta[i] * vv[i][e], w = beta[i] * expf(gc[i]) * kk[i][e];
        for (int j = 0; j < i; ++j) { u -= A[i][j] * XU[j][e]; w -= A[i][j] * XW[j][e]; } XU[i][e] = u; XW[i][e] = w; }
    st_t* ch = p.CH() + (size_t)item * 5 * 4096;
    for (int i = 0; i < 64; ++i) for (int e = 0; e < 64; ++e) {
        ch[0 * 4096 + e * 64 + i] = XU[i][e]; ch[1 * 4096 + i * 64 + e] = XW[i][e]; ch[2 * 4096 + i * 64 + e] = qq[i][e] * 0.125f * expf(gc[i]);
        float d = 0.f; for (int x = 0; x < 64; ++x) d += qq[i][x] * kk[e][x]; ch[3 * 4096 + i * 64 + e] = e <= i ? d * 0.125f * expf(gc[i] - gc[e]) : 0.f;
        ch[4 * 4096 + e * 64 + i] = kk[i][e] * expf(gc[63] - gc[i]); }
    p.GAM()[item] = expf(gc[63]);
}
inline void gdn_scan_host(const Params& p, int c) {
    const int dir = c & 1, h = (c >> 1) % GH, b = (c >> 1) / GH; st_t* dst = dir == 0 ? p.OF() : p.OB();
    static thread_local float Sm[64][64], Vn[64][64]; for (int d = 0; d < 64; ++d) for (int e = 0; e < 64; ++e) Sm[d][e] = 0.f;
    for (int n = 0; n < NCH; ++n) { const st_t* ch = p.CH() + (size_t)(c * NCH + n) * 5 * 4096; const float gam = p.GAM()[c * NCH + n];
        for (int i = 0; i < 64; ++i) for (int e = 0; e < 64; ++e) { float v = ch[0 * 4096 + e * 64 + i]; for (int d = 0; d < 64; ++d) v -= ch[1 * 4096 + i * 64 + d] * Sm[d][e]; Vn[i][e] = v; }
        for (int i = 0; i < 64; ++i) for (int e = 0; e < 64; ++e) { float o = 0.f; for (int d = 0; d < 64; ++d) o += ch[2 * 4096 + i * 64 + d] * Sm[d][e]; for (int j = 0; j < 64; ++j) o += ch[3 * 4096 + i * 64 + j] * Vn[j][e];
            dst[(size_t)gdn_row(b, dir, n, i) * (GH * GDV) + h * 64 + e] = o; }
        for (int d = 0; d < 64; ++d) for (int e = 0; e < 64; ++e) { float sn = gam * Sm[d][e]; for (int i = 0; i < 64; ++i) sn += ch[4 * 4096 + d * 64 + i] * Vn[i][e]; Sm[d][e] = sn; }
    }
}
#else
template <int... Is, class F> __device__ __forceinline__ void static_for_impl(std::integer_sequence<int, Is...>, F&& f) { (f(std::integral_constant<int, Is>{}), ...); }
template <int N, class F> __device__ __forceinline__ void static_for(F&& f) { static_for_impl(std::make_integer_sequence<int, N>{}, f); }
__device__ __forceinline__ float bf_lo(unsigned u) { return __builtin_bit_cast(float, u << 16); }
__device__ __forceinline__ float bf_hi(unsigned u) { return __builtin_bit_cast(float, u & 0xffff0000u); }
template <int ROLE>
__device__ __forceinline__ void gdn_pre_role(const Params& p, int pair, LAS unsigned char* lds, const int lane, const int wave) {
    constexpr int AST = 68;
    const int l31 = lane & 31, hh = lane >> 5;
    const int item = pair * 2 + (wave >> 1);
    const int c = item / NCH, n = item % NCH, dir = c & 1, h = (c >> 1) % GH, b = (c >> 1) / GH;
    LAS float* At = (LAS float*)(lds + (wave >> 1) * 18432); LAS float* gcs = At + 64 * AST; LAS float* bts = gcs + 64; LAS float* ebt = bts + 64;
    st_t* ch = p.CH() + (size_t)item * 5 * 4096;
    const int row0 = gdn_row(b, dir, n, 0); const int sgn = dir == 0 ? 1 : -1;
    const int myrow = row0 + sgn * lane;
    float gc = p.BG()[(size_t)myrow * 24 + 12 + dir * 6 + h]; const float beta = p.BG()[(size_t)myrow * 24 + dir * 6 + h];
#pragma unroll
    for (int o = 1; o < 64; o <<= 1) { const float t = __shfl_up(gc, o); if (lane >= o) gc += t; }
    const float gc63 = __shfl(gc, 63);
    __syncthreads();
    if (ROLE == 0) { gcs[lane] = gc; bts[lane] = beta; ebt[lane] = beta * __expf(gc); }
    const st_t* gbase = p.G() + h * 64;
    f32x16 d00, d10, d11;
#pragma unroll
    for (int r = 0; r < 16; ++r) { d00[r] = 0.f; d10[r] = 0.f; d11[r] = 0.f; }
    { const size_t r0 = (size_t)(row0 + sgn * l31) * GQKV, r1 = (size_t)(row0 + sgn * (32 + l31)) * GQKV; constexpr int xo = ROLE == 0 ? 384 : 0;
#pragma unroll
      for (int ks = 0; ks < 4; ++ks) {
          const bf16x8 a0 = *(const bf16x8*)(gbase + r0 + xo + 16 * ks + 8 * hh), a1 = *(const bf16x8*)(gbase + r1 + xo + 16 * ks + 8 * hh);
          const bf16x8 b0 = *(const bf16x8*)(gbase + r0 + 384 + 16 * ks + 8 * hh), b1 = *(const bf16x8*)(gbase + r1 + 384 + 16 * ks + 8 * hh);
          d00 = __builtin_amdgcn_mfma_f32_32x32x16_bf16(a0, b0, d00, 0, 0, 0); d10 = __builtin_amdgcn_mfma_f32_32x32x16_bf16(a1, b0, d10, 0, 0, 0); d11 = __builtin_amdgcn_mfma_f32_32x32x16_bf16(a1, b1, d11, 0, 0, 0); } }
    __syncthreads();
    auto post = [&](const f32x16& d, int ib, int jb) __attribute__((always_inline)) {
        const int j = 32 * jb + l31; const float gcj = gcs[j];
#pragma unroll
        for (int g = 0; g < 4; ++g) { const int i0 = 32 * ib + 8 * g + 4 * hh; const f32x4 gci = *(const LAS f32x4*)(gcs + i0);
            if (ROLE == 0) { const f32x4 bi = *(const LAS f32x4*)(bts + i0); f32x4 o;
#pragma unroll
                for (int u = 0; u < 4; ++u) o[u] = (j < i0 + u) ? bi[u] * d[4 * g + u] * __expf(gci[u] - gcj) : 0.f;
                *(LAS f32x4*)(At + j * AST + i0) = o; }
            else {
#pragma unroll
                for (int u = 0; u < 4; ++u) { const float v = (j <= i0 + u) ? 0.125f * d[4 * g + u] * __expf(gci[u] - gcj) : 0.f; stf(ch + 3 * 4096 + (i0 + u) * 64 + j, v); } } }
    };
    post(d00, 0, 0); post(d10, 1, 0); post(d11, 1, 1);
    if (ROLE == 1) {
#pragma unroll
        for (int r = 0; r < 16; ++r) stf(ch + 3 * 4096 + crow16(r, hh) * 64 + 32 + l31, 0.f); }
    __syncthreads();
    float acc[64];
#pragma unroll
    for (int i = 0; i < 64; ++i) acc[i] = 0.f;
    { const long long stp = (long long)sgn * GQKV;
      const st_t* sp = gbase + (ROLE == 0 ? 768 : 384) + lane + (size_t)row0 * GQKV;
      const LAS float* sc = ROLE == 0 ? bts : ebt;
      float cur[8], pre[8];
#pragma unroll
      for (int u = 0; u < 8; ++u) { cur[u] = ldf(sp + u * stp); pre[u] = ldf(sp + (8 + u) * stp); }
      unsigned pk[4]; f32x4 s4 = (f32x4){0.f, 0.f, 0.f, 0.f}; float xprev = 0.f;
      static_for<64>([&](auto jc) __attribute__((always_inline)) {
          constexpr int j = decltype(jc)::value;
          if constexpr ((j & 7) == 0 && j > 0) {
#pragma unroll
              for (int u = 0; u < 8; ++u) cur[u] = pre[u];
              if constexpr (j + 8 < 64) { const st_t* gp = sp + (j + 8) * stp; asm volatile("" : "+v"(gp));
#pragma unroll
                  for (int u = 0; u < 8; ++u) pre[u] = ldf(gp + u * stp); }
          }
          if constexpr ((j & 3) == 0) s4 = *(const LAS f32x4*)(sc + j);
          const float x = s4[j & 3] * cur[j & 7] - acc[j];
          if constexpr (ROLE == 0) {
              if constexpr ((j & 1) == 1) pk[(j >> 1) & 3] = pk_bf16(xprev, x);
              if constexpr ((j & 7) == 7) { u32x4 w; w.x = pk[0]; w.y = pk[1]; w.z = pk[2]; w.w = pk[3]; *(u32x4*)(ch + 0 * 4096 + lane * 64 + (j - 7)) = w; }
          } else stf(ch + 1 * 4096 + j * 64 + lane, x);
          xprev = x;
          constexpr int I0 = ((j + 1) >> 2) << 2;
#pragma unroll
          for (int i4 = I0; i4 < 64; i4 += 4) { const f32x4 av = *(const LAS f32x4*)(At + j * AST + i4);
#pragma unroll
              for (int u = 0; u < 4; ++u) if (i4 + u > j) acc[i4 + u] += av[u] * x;
              asm volatile("" : "+v"(acc[i4]), "+v"(acc[i4 + 1]), "+v"(acc[i4 + 2]), "+v"(acc[i4 + 3])); }
          __builtin_amdgcn_sched_barrier(0);
      }); }
    { const st_t* src = gbase + (size_t)myrow * GQKV + (ROLE == 0 ? 384 : 0); const float sc = ROLE == 0 ? __expf(gc63 - gc) : 0.125f * __expf(gc);
#pragma unroll
      for (int c8 = 0; c8 < 8; ++c8) { const u32x4 w = *(const u32x4*)(src + 8 * c8);
          const float f0 = bf_lo(w.x) * sc, f1 = bf_hi(w.x) * sc, f2 = bf_lo(w.y) * sc, f3 = bf_hi(w.y) * sc, f4 = bf_lo(w.z) * sc, f5 = bf_hi(w.z) * sc, f6 = bf_lo(w.w) * sc, f7 = bf_hi(w.w) * sc;
          if (ROLE == 0) { st_t* kt = ch + 4 * 4096 + (8 * c8) * 64 + lane; stf(kt, f0); stf(kt + 64, f1); stf(kt + 128, f2); stf(kt + 192, f3); stf(kt + 256, f4); stf(kt + 320, f5); stf(kt + 384, f6); stf(kt + 448, f7); }
          else { u32x4 o; o.x = pk_bf16(f0, f1); o.y = pk_bf16(f2, f3); o.z = pk_bf16(f4, f5); o.w = pk_bf16(f6, f7); *(u32x4*)(ch + 2 * 4096 + lane * 64 + 8 * c8) = o; } } }
    if (ROLE == 0 && lane == 0) p.GAM()[item] = __expf(gc63);
}
static_assert((NCHAIN * NCH) % 2 == 0, "chunk items come in pairs");
__device__ __forceinline__ void gdn_pre_dev(const Params& p, int pair, LAS unsigned char* lds, const int tid) {
    const int lane = tid & 63, wave = __builtin_amdgcn_readfirstlane(tid >> 6);
    if ((wave & 1) == 0) gdn_pre_role<0>(p, pair, lds, lane, wave); else gdn_pre_role<1>(p, pair, lds, lane, wave);
}
__device__ __forceinline__ void gdn_scan_dev(const Params& p, int c, LAS unsigned char* lds, const int tid) {
    constexpr int RS = 136, MB = 64 * RS;
    const int lane = tid & 63, wave = __builtin_amdgcn_readfirstlane(tid >> 6), r16 = lane & 15, q = lane >> 4;
    const int dir = c & 1, h = (c >> 1) % GH, b = (c >> 1) / GH; st_t* dst = (dir == 0 ? p.OF() : p.OB()) + h * 64 + 16 * wave + r16;
    f32x4 Sb[4];
#pragma unroll
    for (int i = 0; i < 4; ++i) Sb[i] = (f32x4){0.f, 0.f, 0.f, 0.f};
    u32x4 stg[10]; float gam_next = 0.f;
    auto gload = [&](int n) { const u32x4* src = (const u32x4*)(p.CH() + (size_t)(c * NCH + n) * 5 * 4096);
#pragma unroll
        for (int u = 0; u < 10; ++u) stg[u] = src[tid + 256 * u];
        gam_next = p.GAM()[c * NCH + n]; };
    auto lstore = [&]() {
#pragma unroll
        for (int u = 0; u < 10; ++u) { const int ci = tid + 256 * u, mat = ci >> 9, row = (ci >> 3) & 63, cc = ci & 7; LAS u32x2* d = (LAS u32x2*)(lds + mat * MB + row * RS + cc * 16);
            d[0] = (u32x2){stg[u].x, stg[u].y}; d[1] = (u32x2){stg[u].z, stg[u].w}; } };
    auto afrag = [&](int mat, int row, int a2) -> bf16x8 { const LAS unsigned char* bp = lds + mat * MB + row * RS + (32 * a2 + 4 * q) * 2;
        const u32x2 lo = *(const LAS u32x2*)bp, hi = *(const LAS u32x2*)(bp + 32); u32x4 w; w.x = lo.x; w.y = lo.y; w.z = hi.x; w.w = hi.y; return __builtin_bit_cast(bf16x8, w); };
    auto pack2 = [&](const f32x4& x, const f32x4& y) -> bf16x8 { u32x4 w; w.x = pk_bf16(x[0], x[1]); w.y = pk_bf16(x[2], x[3]); w.z = pk_bf16(y[0], y[1]); w.w = pk_bf16(y[2], y[3]); return __builtin_bit_cast(bf16x8, w); };
    __syncthreads();
    gload(0); lstore(); float gam = gam_next;
    __syncthreads();
    for (int n = 0; n < NCH; ++n) {
        if (n + 1 < NCH) gload(n + 1);
        const bf16x8 sb0 = pack2(Sb[0], Sb[1]), sb1 = pack2(Sb[2], Sb[3]);
        f32x4 vn[4], oc[4];
#pragma unroll
        for (int tb = 0; tb < 4; ++tb) {
            f32x4 acc = (f32x4){0.f, 0.f, 0.f, 0.f};
            acc = __builtin_amdgcn_mfma_f32_16x16x32_bf16(afrag(1, 16 * tb + r16, 0), sb0, acc, 0, 0, 0);
            acc = __builtin_amdgcn_mfma_f32_16x16x32_bf16(afrag(1, 16 * tb + r16, 1), sb1, acc, 0, 0, 0);
            const u32x2 uu = *(const LAS u32x2*)(lds + 0 * MB + (16 * wave + r16) * RS + (16 * tb + 4 * q) * 2);
            vn[tb][0] = bf_lo(uu.x) - acc[0]; vn[tb][1] = bf_hi(uu.x) - acc[1]; vn[tb][2] = bf_lo(uu.y) - acc[2]; vn[tb][3] = bf_hi(uu.y) - acc[3];
            f32x4 o = (f32x4){0.f, 0.f, 0.f, 0.f};
            o = __builtin_amdgcn_mfma_f32_16x16x32_bf16(afrag(2, 16 * tb + r16, 0), sb0, o, 0, 0, 0);
            o = __builtin_amdgcn_mfma_f32_16x16x32_bf16(afrag(2, 16 * tb + r16, 1), sb1, o, 0, 0, 0);
            oc[tb] = o;
        }
        const bf16x8 vb0 = pack2(vn[0], vn[1]), vb1 = pack2(vn[2], vn[3]);
#pragma unroll
        for (int tb = 0; tb < 4; ++tb) {
            f32x4 o = oc[tb];
            o = __builtin_amdgcn_mfma_f32_16x16x32_bf16(afrag(3, 16 * tb + r16, 0), vb0, o, 0, 0, 0);
            o = __builtin_amdgcn_mfma_f32_16x16x32_bf16(afrag(3, 16 * tb + r16, 1), vb1, o, 0, 0, 0);
#pragma unroll
            for (int u = 0; u < 4; ++u) stf(dst + (size_t)gdn_row(b, dir, n, 16 * tb + 4 * q + u) * (GH * GDV), o[u]);
        }
#pragma unroll
        for (int db = 0; db < 4; ++db) {
            f32x4 sn = Sb[db] * gam;
            sn = __builtin_amdgcn_mfma_f32_16x16x32_bf16(afrag(4, 16 * db + r16, 0), vb0, sn, 0, 0, 0);
            sn = __builtin_amdgcn_mfma_f32_16x16x32_bf16(afrag(4, 16 * db + r16, 1), vb1, sn, 0, 0, 0);
            Sb[db] = sn;
        }
        __syncthreads();
        if (n + 1 < NCH) { lstore(); gam = gam_next; }
        __syncthreads();
    }
}
#endif


#ifndef HOST_EMU
enum { R_NORM1 = 0, R_POST1 = 1, R_POST2 = 2, R_XFORM = 3, R_GOUT = 4 };
__device__ __forceinline__ float wave_sum(float v) {
#pragma unroll
    for (int o = 32; o > 0; o >>= 1) v += __shfl_xor(v, o);
    return v;
}
__device__ __forceinline__ void ld_row_f32(const float* p, int lane, f32x4 (&v)[D / 256]) {
#pragma unroll
    for (int j = 0; j < D / 256; ++j) v[j] = *(const f32x4*)(p + 4 * lane + 256 * j); }
__device__ __forceinline__ void ld_row_bf16(const st_t* p, int lane, f32x4 (&v)[D / 256]) {
#pragma unroll
    for (int j = 0; j < D / 256; ++j) { const u32x2 w = *(const u32x2*)(p + 4 * lane + 256 * j); v[j] = (f32x4){bf_lo(w.x), bf_hi(w.x), bf_lo(w.y), bf_hi(w.y)}; } }
__device__ __forceinline__ void st_row_bf16(st_t* p, int lane, const f32x4 (&v)[D / 256]) {
#pragma unroll
    for (int j = 0; j < D / 256; ++j) st4(p + 4 * lane + 256 * j, v[j][0], v[j][1], v[j][2], v[j][3]); }
__device__ __forceinline__ float sumsq(const f32x4 (&v)[D / 256]) { float s = 0.f;
#pragma unroll
    for (int j = 0; j < D / 256; ++j) s += (v[j][0] * v[j][0] + v[j][1] * v[j][1]) + (v[j][2] * v[j][2] + v[j][3] * v[j][3]);
    return wave_sum(s); }
template <bool TO_LDS>
__device__ __forceinline__ void modulate_store(const f32x4 (&x)[D / 256], float rstd, const float* gain, const float* sc, const float* sh, st_t* hrow, int lane, LAS float* hl) {
    f32x4 g[D / 256], a[D / 256], b[D / 256], h[D / 256]; ld_row_f32(gain, lane, g); ld_row_f32(sc, lane, a); ld_row_f32(sh, lane, b);
#pragma unroll
    for (int j = 0; j < D / 256; ++j) h[j] = x[j] * rstd * g[j] * (a[j] + 1.0f) + b[j];
    st_row_bf16(hrow, lane, h);
    if constexpr (TO_LDS) {
#pragma unroll
        for (int j = 0; j < D / 256; ++j) *(LAS f32x4*)(hl + 4 * lane + 256 * j) = h[j]; }
}
__device__ __forceinline__ void row_norm1(const Params& p, int layer, int r, int lane) {
    f32x4 x[D / 256]; ld_row_f32(xin_row(p, layer, r), lane, x);
    const float rstd = rsqrt_f(sumsq(x) / D + EPS);
    modulate_store<false>(x, rstd, p.mix_norm_pre + (size_t)layer * D, mod_vec(p, layer, r, 1), mod_vec(p, layer, r, 0), p.H() + (size_t)r * D, lane, (LAS float*)0);
}
__device__ __forceinline__ void row_post1_pair(const Params& p, int layer, int pair, int lane, LAS float* hl) {
#pragma unroll
    for (int rr = 0; rr < 2; ++rr) { const int r = 2 * pair + rr;
        f32x4 y[D / 256], x[D / 256], g1[D / 256], gp[D / 256]; ld_row_bf16(p.Y() + (size_t)r * D, lane, y); ld_row_f32(xin_row(p, layer, r), lane, x);
        ld_row_f32(mod_vec(p, layer, r, 2), lane, g1); ld_row_f32(p.mix_norm_post + (size_t)layer * D, lane, gp);
        const float rstd = rsqrt_f(sumsq(y) / D + EPS);
#pragma unroll
        for (int j = 0; j < D / 256; ++j) x[j] = x[j] + g1[j] * y[j] * rstd * gp[j];
        float* xr = xrow(p, r);
#pragma unroll
        for (int j = 0; j < D / 256; ++j) *(f32x4*)(xr + 4 * lane + 256 * j) = x[j];
        const float r2 = rsqrt_f(sumsq(x) / D + EPS);
        modulate_store<true>(x, r2, p.ffn_norm_pre + (size_t)layer * D, mod_vec(p, layer, r, 4), mod_vec(p, layer, r, 3), p.H() + (size_t)r * D, lane, hl + rr * D);
    }
    asm volatile("s_waitcnt lgkmcnt(0)" ::: "memory");
    const float* wr = p.router_w + (size_t)layer * D * NE + lane; float a0 = 0.f, a1 = 0.f;
#pragma unroll 4
    for (int d4 = 0; d4 < D / 4; ++d4) { const f32x4 h0 = *(const LAS f32x4*)(hl + 4 * d4), h1 = *(const LAS f32x4*)(hl + D + 4 * d4);
#pragma unroll
        for (int u = 0; u < 4; ++u) { const float w = wr[(size_t)(4 * d4 + u) * NE]; a0 += h0[u] * w; a1 += h1[u] * w; } }
    p.LOGITS()[(size_t)(2 * pair) * NE + lane] = a0; p.LOGITS()[(size_t)(2 * pair + 1) * NE + lane] = a1;
    asm volatile("s_waitcnt lgkmcnt(0)" ::: "memory");
}
__device__ __forceinline__ void route_row(const Params& p, int layer, int r, int lane, float logit) {
    const float sg = sigmoid_f(logit), v = sg + p.router_bias[(size_t)layer * NE + lane];
    float m1 = v; int i1 = lane;
#pragma unroll
    for (int o = 1; o < 8; o <<= 1) { const float ov = __shfl_xor(m1, o); const int oi = __shfl_xor(i1, o); if (ov > m1 || (ov == m1 && oi < i1)) { m1 = ov; i1 = oi; } }
    float m2 = lane == i1 ? -3.0e38f : v;
#pragma unroll
    for (int o = 1; o < 8; o <<= 1) m2 = fmaxf(m2, __shfl_xor(m2, o));
    const float gs = m1 + m2; const int grp = lane >> 3;
    int grank = 0;
#pragma unroll
    for (int j = 0; j < NGRP; ++j) { const float og = __shfl(gs, j * 8); grank += (og > gs || (og == gs && j < grp)) ? 1 : 0; }
    const float mv = grank < TOPG ? v : -3.0e38f;
    int rank = 0;
#pragma unroll
    for (int j = 0; j < NE; ++j) { const float ov = __shfl(mv, j); rank += (ov > mv || (ov == mv && j < lane)) ? 1 : 0; }
    const bool sel = rank < TOPK;
    const float wsum = wave_sum(sel ? sg : 0.f);
    if (sel) { const float w = sg / wsum * ROUTED_SCALE; const int pos = atomicAdd(p.CNT() + layer * NE + lane, 1); atomicAdd(p.CNTP() + (layer * NE + lane) * 32, 1);
        p.EIDX()[(size_t)r * TOPK + rank] = lane; p.EPOS()[(size_t)r * TOPK + rank] = pos; p.TOKLIST()[(size_t)lane * TA + pos] = r; p.WLIST()[(size_t)lane * TA + pos] = w; }
}
__device__ __forceinline__ void row_post1_quad(const Params& p, int layer, int quad, int lane, LAS float* hl) {
#pragma unroll
    for (int rr = 0; rr < 4; ++rr) { const int r = 4 * quad + rr;
        f32x4 y[D / 256], x[D / 256], g1[D / 256], gp[D / 256]; ld_row_bf16(p.Y() + (size_t)r * D, lane, y); ld_row_f32(xin_row(p, layer, r), lane, x);
        ld_row_f32(mod_vec(p, layer, r, 2), lane, g1); ld_row_f32(p.mix_norm_post + (size_t)layer * D, lane, gp);
        const float rstd = rsqrt_f(sumsq(y) / D + EPS);
#pragma unroll
        for (int j = 0; j < D / 256; ++j) x[j] = x[j] + g1[j] * y[j] * rstd * gp[j];
        float* xr = xrow(p, r);
#pragma unroll
        for (int j = 0; j < D / 256; ++j) *(f32x4*)(xr + 4 * lane + 256 * j) = x[j];
        const float r2 = rsqrt_f(sumsq(x) / D + EPS);
        modulate_store<true>(x, r2, p.ffn_norm_pre + (size_t)layer * D, mod_vec(p, layer, r, 4), mod_vec(p, layer, r, 3), p.H() + (size_t)r * D, lane, hl + rr * D);
    }
    asm volatile("s_waitcnt lgkmcnt(0)" ::: "memory");
    const float* wr = p.router_w + (size_t)layer * D * NE + lane; float a0 = 0.f, a1 = 0.f, a2 = 0.f, a3 = 0.f;
#pragma unroll 4
    for (int d4 = 0; d4 < D / 4; ++d4) { const f32x4 h0 = *(const LAS f32x4*)(hl + 4 * d4), h1 = *(const LAS f32x4*)(hl + D + 4 * d4), h2 = *(const LAS f32x4*)(hl + 2 * D + 4 * d4), h3 = *(const LAS f32x4*)(hl + 3 * D + 4 * d4);
#pragma unroll
        for (int u = 0; u < 4; ++u) { const float w = wr[(size_t)(4 * d4 + u) * NE]; a0 += h0[u] * w; a1 += h1[u] * w; a2 += h2[u] * w; a3 += h3[u] * w; } }
    route_row(p, layer, 4 * quad, lane, a0); route_row(p, layer, 4 * quad + 1, lane, a1); route_row(p, layer, 4 * quad + 2, lane, a2); route_row(p, layer, 4 * quad + 3, lane, a3);
    asm volatile("s_waitcnt lgkmcnt(0)" ::: "memory");
}
__device__ __forceinline__ void row_post2(const Params& p, int layer, int r, int lane, const int* eb) {
    int slot = 0;
    if (lane < TOPK) { const int e = p.EIDX()[(size_t)r * TOPK + lane]; slot = eb[e] + p.EPOS()[(size_t)r * TOPK + lane]; }
    f32x4 f[D / 256]; ld_row_bf16(p.SH() + (size_t)r * D, lane, f);
#pragma unroll
    for (int k = 0; k < TOPK; ++k) { const int sk = __shfl(slot, k); f32x4 t[D / 256]; ld_row_bf16(p.YB() + (size_t)sk * D, lane, t);
#pragma unroll
        for (int j = 0; j < D / 256; ++j) f[j] += t[j]; }
    const float rstd = rsqrt_f(sumsq(f) / D + EPS);
    float* xr = xrow(p, r); f32x4 x[D / 256], g2[D / 256], gp[D / 256]; ld_row_f32(xr, lane, x); ld_row_f32(mod_vec(p, layer, r, 5), lane, g2); ld_row_f32(p.ffn_norm_post + (size_t)layer * D, lane, gp);
#pragma unroll
    for (int j = 0; j < D / 256; ++j) { x[j] = x[j] + g2[j] * f[j] * rstd * gp[j]; *(f32x4*)(xr + 4 * lane + 256 * j) = x[j]; }
    if (layer + 1 < DEPTH) { const float r2 = rsqrt_f(sumsq(x) / D + EPS);
        modulate_store<false>(x, r2, p.mix_norm_pre + (size_t)(layer + 1) * D, mod_vec(p, layer + 1, r, 1), mod_vec(p, layer + 1, r, 0), p.H() + (size_t)r * D, lane, (LAS float*)0); }
}
__device__ __forceinline__ void unpack8(const u32x4 w, float (&x)[8]) { x[0] = bf_lo(w.x); x[1] = bf_hi(w.x); x[2] = bf_lo(w.y); x[3] = bf_hi(w.y); x[4] = bf_lo(w.z); x[5] = bf_hi(w.z); x[6] = bf_lo(w.w); x[7] = bf_hi(w.w); }
__device__ __forceinline__ u32x4 pack8(const float (&x)[8]) { u32x4 o; o.x = pk_bf16(x[0], x[1]); o.y = pk_bf16(x[2], x[3]); o.z = pk_bf16(x[4], x[5]); o.w = pk_bf16(x[6], x[7]); return o; }
__device__ __forceinline__ void row_xform(const Params& p, int layer, int r, int lane, const LAS float* cw) {
    int lo, hi; seq_bounds(r, lo, hi);
    const st_t* prow = p.P() + (size_t)r * DPROJP;
#pragma unroll
    for (int gi = 0; gi < 3; ++gi) {
        if (gi < 2 || lane < 16) {
            const int c0 = 8 * (lane + 64 * gi); float acc[8];
#pragma unroll
            for (int e = 0; e < 8; ++e) acc[e] = 0.f;
#pragma unroll
            for (int j = 0; j < GCONV; ++j) { const int rr = r + j - 2;
                if (rr >= lo && rr < hi) { float x[8]; unpack8(*(const u32x4*)(p.P() + (size_t)rr * DPROJP + PO_GQKV + c0), x);
                    const f32x4 w0 = *(const LAS f32x4*)(cw + j * GQKV + c0), w1 = *(const LAS f32x4*)(cw + j * GQKV + c0 + 4);
#pragma unroll
                    for (int e = 0; e < 4; ++e) { acc[e] += w0[e] * x[e]; acc[4 + e] += w1[e] * x[4 + e]; } } }
            float ss = 0.f;
#pragma unroll
            for (int e = 0; e < 8; ++e) { acc[e] = silu_f(acc[e]); ss += acc[e] * acc[e]; }
            if (gi < 2) {
                ss += __shfl_xor(ss, 1); ss += __shfl_xor(ss, 2); ss += __shfl_xor(ss, 4);
                const float rn = c0 < 2 * GH * GDK ? rsqrt_f(ss + EPS) : 1.0f;
#pragma unroll
                for (int e = 0; e < 8; ++e) acc[e] *= rn; }
            *(u32x4*)(p.G() + (size_t)r * GQKV + c0) = pack8(acc);
        }
    }
    if (lane < 12) { const float beta = sigmoid_f(ldf(prow + PO_BA + lane)), a = ldf(prow + PO_BA + 12 + lane);
        p.BG()[(size_t)r * 24 + lane] = beta; p.BG()[(size_t)r * 24 + 12 + lane] = -expf(p.gdn_a_log[layer * 12 + lane]) * softplus_f(a + p.gdn_dt_bias[layer * 12 + lane]); }
    { float x[8]; float ss = 0.f;
      if (lane < MQR / 8) { unpack8(*(const u32x4*)(prow + PO_CQ + 8 * lane), x);
#pragma unroll
          for (int e = 0; e < 8; ++e) ss += x[e] * x[e]; }
      const float rstd = rsqrt_f(wave_sum(ss) / MQR + EPS);
      if (lane < MQR / 8) { const float* gn = p.mla_q_norm + (size_t)layer * MQR + 8 * lane;
#pragma unroll
          for (int e = 0; e < 8; ++e) x[e] = x[e] * rstd * gn[e];
          *(u32x4*)(p.CQN() + (size_t)r * MQR + 8 * lane) = pack8(x); } }
    { float x[8]; float ss = 0.f;
      if (lane < MKVR / 8) { unpack8(*(const u32x4*)(prow + PO_CKV + 8 * lane), x);
#pragma unroll
          for (int e = 0; e < 8; ++e) ss += x[e] * x[e]; }
      const float rstd = rsqrt_f(wave_sum(ss) / MKVR + EPS);
      if (lane < MKVR / 8) { const float* gn = p.mla_kv_norm + (size_t)layer * MKVR + 8 * lane;
#pragma unroll
          for (int e = 0; e < 8; ++e) x[e] = x[e] * rstd * gn[e];
          *(u32x4*)(p.CKVN() + (size_t)r * MKVR + 8 * lane) = pack8(x); } }
}
__device__ __forceinline__ void row_gout(const Params& p, int layer, int r, int lane) {
    float o[8]; float ss = 0.f; const bool act = lane < GH * GDV / 8;
    if (act) { float a[8], b[8]; unpack8(*(const u32x4*)(p.OF() + (size_t)r * (GH * GDV) + 8 * lane), a); unpack8(*(const u32x4*)(p.OB() + (size_t)r * (GH * GDV) + 8 * lane), b);
#pragma unroll
        for (int e = 0; e < 8; ++e) { o[e] = a[e] + b[e]; ss += o[e] * o[e]; } }
    ss += __shfl_xor(ss, 1); ss += __shfl_xor(ss, 2); ss += __shfl_xor(ss, 4);
    if (act) { const float rstd = rsqrt_f(ss / GDV + EPS); float z[8]; unpack8(*(const u32x4*)(p.P() + (size_t)r * DPROJP + PO_Z + 8 * lane), z);
        const float* nw = p.gdn_norm_w + layer * GDV + (8 * lane) % GDV;
#pragma unroll
        for (int e = 0; e < 8; ++e) o[e] = o[e] * rstd * nw[e] * silu_f(z[e]);
        *(u32x4*)(p.O() + (size_t)r * DMIX + GH * GDV + 8 * lane) = pack8(o); }
}
__device__ __forceinline__ void mod_block(const Params& p, int item, LAS unsigned char* lds, int tid) {
    const int lane = tid & 63, wave = __builtin_amdgcn_readfirstlane(tid >> 6); const int ly = item / (6 * D / 64), jb = item % (6 * D / 64);
    LAS float* sl = (LAS float*)lds; LAS float* red = sl + 3 * D;
    __syncthreads();
    for (int i = tid; i < 3 * D; i += 256) { const int w = i / D, k = i % D; sl[i] = silu_f(w < 2 ? p.c[(size_t)w * D + k] : p.c_ctx[k]); }
    __syncthreads();
    const float* W = p.ada_w + (size_t)ly * D * 6 * D + jb * 64 + lane; float a0 = 0.f, a1 = 0.f, a2 = 0.f;
#pragma unroll 8
    for (int k = wave * (D / 4); k < (wave + 1) * (D / 4); ++k) { const float w = W[(size_t)k * 6 * D]; a0 += sl[k] * w; a1 += sl[D + k] * w; a2 += sl[2 * D + k] * w; }
    red[(wave * 3 + 0) * 64 + lane] = a0; red[(wave * 3 + 1) * 64 + lane] = a1; red[(wave * 3 + 2) * 64 + lane] = a2;
    __syncthreads();
    if (wave < 3) { const float v = red[(0 * 3 + wave) * 64 + lane] + red[(1 * 3 + wave) * 64 + lane] + red[(2 * 3 + wave) * 64 + lane] + red[(3 * 3 + wave) * 64 + lane];
        p.MOD()[((size_t)(ly * 3 + wave) * 6 * D) + jb * 64 + lane] = v + p.ada_b[(size_t)ly * 6 * D + jb * 64 + lane]; }
}
#endif


#ifndef HOST_EMU
#define XB_TMO      128
#define XB_XCNT(j)  (256  + 64 * (j))
#define XB_XSUB(j)  (1280 + 64 * (j))
#define XB_XGEN(j)  (2304 + 64 * (j))
#define XB_TOP      3328
#define XB_TOPGEN   3392
#define XCD_BAR_WORDS 3456
#define XB_SPIN_CAP (1u << 18)

__device__ __forceinline__ unsigned xb_ld(unsigned* p)              { return __hip_atomic_load(p, __ATOMIC_RELAXED, __HIP_MEMORY_SCOPE_AGENT); }
__device__ __forceinline__ unsigned xb_add(unsigned* p, unsigned v) { return __hip_atomic_fetch_add(p, v, __ATOMIC_RELAXED, __HIP_MEMORY_SCOPE_AGENT); }
__device__ __forceinline__ unsigned xb_xcc_id() { return (unsigned)__builtin_amdgcn_s_getreg((3 << 11) | 20) & 0xFu; }
#define XB_SPIN(cond, bar) do { unsigned _sp = 0; while (cond) { __builtin_amdgcn_s_sleep(1); \
    if ((++_sp & 255u) == 0u) { if (xb_ld(&(bar)[XB_TMO])) break; if (_sp > XB_SPIN_CAP) { atomicAdd(&(bar)[XB_TMO], 1u); break; } } } } while (0)

struct XcdBarrier {
    unsigned* bar; unsigned x;
    volatile LAS unsigned* st;
};

__device__ __forceinline__ XcdBarrier xcd_barrier_post(unsigned* bar, volatile LAS unsigned* st) {
    XcdBarrier b; b.bar = bar; b.x = xb_xcc_id(); b.st = st;
    if (threadIdx.x == 0) (void)xb_add(&bar[XB_XCNT(b.x)], 1u);
    return b;
}
__device__ __forceinline__ void xcd_barrier_complete(unsigned* bar, unsigned x, unsigned& nloc, unsigned& nx) {
    const unsigned G = gridDim.x * gridDim.y * gridDim.z;
    unsigned sum, cnt, mine, sp = 0u;
    for (;;) {
        sum = 0u; cnt = 0u; mine = 0u;
#pragma unroll
        for (unsigned j = 0; j < 16; ++j) { const unsigned c = xb_ld(&bar[XB_XCNT(j)]); sum += c; cnt += (c > 0u) ? 1u : 0u; mine = (j == x) ? c : mine; }
        if (sum == G) break;
        __builtin_amdgcn_s_sleep(1);
        if ((++sp & 255u) == 0u) { if (xb_ld(&bar[XB_TMO])) break; if (sp > XB_SPIN_CAP) { atomicAdd(&bar[XB_TMO], 1u); break; } }
    }
    nloc = mine > 0u ? mine : 1u; nx = cnt > 0u ? cnt : 1u;
}

__device__ __forceinline__ void xcd_barrier(const XcdBarrier& b) {
    asm volatile("s_waitcnt vmcnt(0)" ::: "memory");
    __syncthreads();
    if (threadIdx.x == 0) {
        unsigned* bar = b.bar;
        __builtin_amdgcn_s_waitcnt(0);
        unsigned nloc = b.st[0], nx = b.st[1];
        if (nloc == 0u) { xcd_barrier_complete(bar, b.x, nloc, nx); b.st[0] = nloc; b.st[1] = nx; }
        const unsigned old = xb_add(&bar[XB_XSUB(b.x)], 1u);
        const unsigned gen = old / nloc;
        if (old + 1u == (gen + 1u) * nloc) {
            __builtin_amdgcn_fence(__ATOMIC_RELEASE, "agent");
            asm volatile("s_waitcnt vmcnt(0)" ::: "memory");
            const unsigned og = xb_add(&bar[XB_TOP], 1u);
            const unsigned tg = og / nx;
            if (og + 1u == (tg + 1u) * nx) xb_add(&bar[XB_TOPGEN], 1u);
            else XB_SPIN(xb_ld(&bar[XB_TOPGEN]) == tg, bar);
            __builtin_amdgcn_fence(__ATOMIC_ACQUIRE, "agent");
            xb_add(&bar[XB_XGEN(b.x)], 1u);
            asm volatile("s_waitcnt vmcnt(0)" ::: "memory");
        } else {
            XB_SPIN(xb_ld(&bar[XB_XGEN(b.x)]) == gen, bar);
            __builtin_amdgcn_fence(__ATOMIC_ACQUIRE, "agent");
            asm volatile("s_waitcnt vmcnt(0)" ::: "memory");
        }
    }
    __syncthreads();
}

#endif

enum { K_ITEM = 0, K_WT = 1, K_GEMM = 2, K_ATTN = 3, K_GPRE = 4, K_ROW = 5, K_MOD = 6 };
struct Step { int kind, st, layer, sync_before; };
inline int build_program(Step* prog) {
    int n = 0;
    prog[n++] = {K_ITEM, ST_ZERO, 0, 0}; prog[n++] = {K_ITEM, ST_TAB, 0, 0}; prog[n++] = {USE_KMOD ? K_MOD : K_ITEM, USE_KMOD ? 0 : ST_MOD, 0, 0}; prog[n++] = {K_WT, WT_STATIC, 0, 0};
    for (int l = 0; l < DEPTH; ++l) {
        if (l == 0 || !USE_RPOST2) { if (USE_RNORM1) prog[n++] = {K_ROW, 0  , l, 1}; else prog[n++] = {K_ITEM, ST_NORM1, l, 1}; }
        prog[n++] = {K_GEMM, G_PROJ, l, 1};
        prog[n++] = {K_ROW, 3  , l, 1};
        prog[n++] = {K_GEMM, G_UQ, l, 1}; prog[n++] = {K_GEMM, G_UKV, l, 0}; prog[n++] = {K_GPRE, 0, l, 0};
        prog[n++] = {K_ATTN, 0, l, 1};
        prog[n++] = {K_ROW, 4  , l, 1}; prog[n++] = {K_WT, WT_EXPERT, l, 0};
        prog[n++] = {K_GEMM, G_WOUT, l, 1};
        if (USE_RPOST1) { prog[n++] = {K_ROW, 1  , l, 1}; if (!FUSE_ROUTE) prog[n++] = {K_ITEM, ST_ROUTE, l, 1}; } else { prog[n++] = {K_ITEM, ST_POST1, l, 1}; prog[n++] = {K_ITEM, ST_ROUTER, l, 1}; prog[n++] = {K_ITEM, ST_ROUTE, l, 1}; }
        prog[n++] = {K_GEMM, G_SGU, l, 1}; prog[n++] = {K_GEMM, G_EGU, l, 0};
        prog[n++] = {K_GEMM, G_SDOWN, l, 1}; prog[n++] = {K_GEMM, G_EDOWN, l, 0};
        if (USE_RPOST2) prog[n++] = {K_ROW, 2  , l, 1}; else prog[n++] = {K_ITEM, ST_POST2, l, 1};
    }
    return n;
}
constexpr int MAX_STEPS = 64;

#ifndef HOST_EMU
namespace cg = cooperative_groups;
struct Prog { Step s[MAX_STEPS]; int n; int pad[3]; };

__global__ void __launch_bounds__(256, 2) k_mega(Params p, Prog pr) {
    extern __shared__ __attribute__((aligned(16))) unsigned char smem[];
    LAS unsigned char* lds = (LAS unsigned char*)smem;
    cg::grid_group grid = cg::this_grid();
    { volatile LAS unsigned* bst = (volatile LAS unsigned*)(lds + 65536); if (threadIdx.x < 2) bst[threadIdx.x] = 0u; }
    __syncthreads();
    (void)xcd_barrier_post(p.BAR(), (volatile LAS unsigned*)(lds + 65536));
#define XBAR_NOW() do { XcdBarrier xb_; xb_.bar = p.BAR(); xb_.x = xb_xcc_id(); xb_.st = (volatile LAS unsigned*)(lds + 65536); xcd_barrier(xb_); } while (0)
    bool first_sync = true;
    const long long gthreads = (long long)gridDim.x * 256;
    for (int s = 0; s < pr.n; ++s) {
        const int kind = pr.s[s].kind, st = pr.s[s].st, layer = pr.s[s].layer;
        if (pr.s[s].sync_before) { if (first_sync) { grid.sync(); first_sync = false; } else XBAR_NOW(); }
        int reps = 1;
        if (PROBE_MASK) { const int grp = kind == K_GEMM ? 0 : kind == K_ATTN ? 1 : kind == K_GPRE ? 2 : kind == K_WT ? 3 : (kind == K_ROW && (st == R_XFORM || st == R_GOUT || st == R_NORM1)) ? 4 : 7;
            if ((PROBE_MASK >> grp) & 1) reps = 2; if (((PROBE_MASK >> 5) & 1) && pr.s[s].sync_before) XBAR_NOW(); }
        for (int rep = 0; rep < reps; ++rep) {
        if (rep > 0 && ((PROBE_MASK >> 6) & 1)) XBAR_NOW();
        int tid = threadIdx.x; asm volatile("" : "+v"(tid));
        const int lane = tid & 63, wave = __builtin_amdgcn_readfirstlane(tid >> 6);
        const long long gtid = (long long)blockIdx.x * 256 + tid;
        ETab et{nullptr, nullptr};
        if ((kind == K_GEMM && (st == G_EGU || st == G_EDOWN)) || (kind == K_ROW && st == R_POST2)) {
            LAS int* eb = (LAS int*)(lds + 65536 + 64); LAS int* tb = eb + 72;
            __syncthreads();
            if (wave == 0) { const int c = FUSE_ROUTE ? p.CNTP()[(layer * NE + lane) * 32] : p.CNT()[layer * NE + lane]; int a = c, t = (c + 127) >> 7;
#pragma unroll
                for (int o = 1; o < 64; o <<= 1) { const int ua = __shfl_up(a, o), ut = __shfl_up(t, o); if (lane >= o) { a += ua; t += ut; } }
                eb[lane + 1] = a; tb[lane + 1] = t; if (lane == 0) { eb[0] = 0; tb[0] = 0; } }
            __syncthreads();
            et.eb = (const int*)eb; et.tb = (const int*)tb;
        }
        if (kind == K_ITEM) {
            const long long n = n_items(st, layer);
#define RUN_ST(ST) case ST: for (long long i = gtid; i < n; i += gthreads) run_item(p, ST, layer, i); break;
            switch (st) {
#if !USE_KMOD
                RUN_ST(ST_MOD)
#endif
#if !USE_RNORM1
                RUN_ST(ST_NORM1)
#endif
#if !USE_RPOST1
                RUN_ST(ST_POST1) RUN_ST(ST_ROUTER)
#endif
#if !USE_RPOST2
                RUN_ST(ST_POST2)
#endif
                RUN_ST(ST_ZERO) RUN_ST(ST_TAB)
#if !USE_RPOST1 || !FUSE_ROUTE
                RUN_ST(ST_ROUTE)
#endif
                default: break; }
#undef RUN_ST
        } else if (kind == K_WT) {
            const long long n = wt_items(p, st); LAS float* scr = (LAS float*)(lds + wave * (64 * 33 * 4));
            for (long long i = (long long)blockIdx.x * 4 + wave; i < n; i += (long long)gridDim.x * 4) wt_item_dev(p, st, layer, i, scr, lane);
        } else if (kind == K_GEMM) {
            const int n = gemm_ntiles(p, st, layer, et);
            const int q8 = n >> 3, r8 = n & 7;
            for (int i = blockIdx.x; i < n; i += gridDim.x) {
                const int x = i & 7, tau = (x < r8 ? x * (q8 + 1) : r8 * (q8 + 1) + (x - r8) * q8) + (i >> 3);
                GemmDesc g; gemm_desc(p, st, layer, tau, g, et); gemm_tile_dev(g, lds, tid); }
        } else if (kind == K_ROW) {
            const int gw = blockIdx.x * 4 + wave, nw = gridDim.x * 4;
            if (st == R_NORM1) { for (int r = gw; r < TA; r += nw) row_norm1(p, layer, r, lane); }
            else if (st == R_POST1) { __syncthreads();
#if FUSE_ROUTE
                LAS float* hl = (LAS float*)(lds + wave * (4 * D * 4)); for (int i = gw; i < rows_out(layer) / 4; i += nw) row_post1_quad(p, layer, i, lane, hl);
#else
                LAS float* hl = (LAS float*)(lds + wave * (2 * D * 4)); for (int i = gw; i < rows_out(layer) / 2; i += nw) row_post1_pair(p, layer, i, lane, hl);
#endif
            }
            else if (st == R_POST2) { for (int r = gw; r < rows_out(layer); r += nw) row_post2(p, layer, r, lane, et.eb); }
            else if (st == R_XFORM) { __syncthreads(); LAS float* cw = (LAS float*)lds; for (int i = tid; i < GCONV * GQKV; i += 256) cw[i] = p.gdn_conv_w[(size_t)layer * GCONV * GQKV + i]; __syncthreads();
                for (int r = gw; r < TA; r += nw) row_xform(p, layer, r, lane, cw); }
            else { for (int r = gw; r < rows_out(layer); r += nw) row_gout(p, layer, r, lane); }
        } else if (kind == K_MOD) {
            for (int i = blockIdx.x; i < DEPTH * (6 * D / 64); i += gridDim.x) mod_block(p, i, lds, tid);
        } else if (kind == K_GPRE) {
            const int n = NCHAIN * NCH / 2;
            for (int i = blockIdx.x; i < n; i += gridDim.x) gdn_pre_dev(p, i, lds, tid);
        } else {
            LAS int* slot = (LAS int*)(lds + 65536 + 16); const int x0 = (int)(xb_xcc_id() & 7u);
            for (int qs = 0; qs < 8; ++qs) {
                const int x = (x0 + qs) & 7, nq = attn_queue_size(layer, x);
                for (;;) {
                    __syncthreads(); if (tid == 0) *slot = atomicAdd(p.CTR() + layer * 16 + rep * 8 + x, 1); __syncthreads();
                    const int k = *slot; if (k >= nq) break;
                    const int item = attn_queue_item(layer, x, k);
                    int t2 = tid; asm volatile("" : "+v"(t2));
                    if (item < NCHAIN) { gdn_scan_dev(p, item, lds, t2); continue; }
                    AttnDesc a; attn_desc(p, layer, item - NCHAIN, a);
                    if (a.dqk == 96) attn_tile_dev<96>(a, lds, t2); else attn_tile_dev<64>(a, lds, t2);
                }
            }
        }
        }
    }
}

extern "C" void kernel_launch(void* const* d_in, const int* in_sizes, int n_in, void* d_out, int out_size, void* d_ws, size_t ws_size, hipStream_t stream) {
    Params p{};
    const float** pin = (const float**)&p;
    for (int i = 0; i < 29 && i < n_in; ++i) pin[i] = (const float*)d_in[i];
    p.out = (float*)d_out;
    const size_t need = carve(p, (char*)d_ws);
    if (need > ws_size) { fprintf(stderr, "kernel_launch: workspace too small: need %zu have %zu\n", need, ws_size); return; }
    Prog pr{}; pr.n = build_program(pr.s);
    constexpr int LDS_BYTES = 65536 + 1024;
    static int grid_blocks = 0;
    if (!grid_blocks) {
        int dev = 0, cus = 0, per_cu = 0;
        (void)hipGetDevice(&dev);
        (void)hipDeviceGetAttribute(&cus, hipDeviceAttributeMultiprocessorCount, dev);
        (void)hipFuncSetAttribute((const void*)k_mega, hipFuncAttributeMaxDynamicSharedMemorySize, LDS_BYTES);
        (void)hipOccupancyMaxActiveBlocksPerMultiprocessor(&per_cu, k_mega, 256, LDS_BYTES);
        if (per_cu > 2) per_cu = 2;
        if (per_cu < 1) per_cu = 1;
        grid_blocks = cus * per_cu;
    }
    (void)hipMemsetAsync(p.BAR(), 0, 4096 * 4, stream);
    void* args[] = {&p, &pr};
    hipError_t e = hipLaunchCooperativeKernel((void*)k_mega, dim3(grid_blocks), dim3(256), args, LDS_BYTES, stream);
    if (e != hipSuccess) fprintf(stderr, "cooperative launch failed: %s (grid %d)\n", hipGetErrorString(e), grid_blocks);
}
#endif
```

```cpp
#ifndef HOST_EMU
#include <hip/hip_runtime.h>
#include <hip/hip_cooperative_groups.h>
#include <cstdio>
#define HD __host__ __device__ __forceinline__
#else
#include <cmath>
#include <cstdio>
#include <cstring>
#define HD inline
#endif
#include <cstdint>
#include <utility>

#ifndef CFG_D
#define CFG_D 1024
#endif
#ifndef CFG_S
#define CFG_S 8192
#endif
#ifndef CFG_L
#define CFG_L 256
#endif
#ifndef CFG_DE
#define CFG_DE 256
#endif
#ifndef CFG_DS
#define CFG_DS 256
#endif
#ifndef PROBE_SEL
#define PROBE_SEL 0
#endif
#ifndef PROBE_MASK
#define PROBE_MASK 0
#endif
#ifndef FUSE_ROUTE
#define FUSE_ROUTE 0
#endif
#ifndef USE_KMOD
#define USE_KMOD 1
#endif
#ifndef USE_RNORM1
#define USE_RNORM1 1
#endif
#ifndef USE_RPOST1
#define USE_RPOST1 1
#endif
#ifndef USE_RPOST2
#define USE_RPOST2 1
#endif

namespace cfg {
constexpr int D = CFG_D, B = 2, S = CFG_S, L = CFG_L, DEPTH = 2, GRID_W = 64;
constexpr int T = B * S, TC = B * L, TA = T + TC;
constexpr int SWA_H = 6, SWA_KVH = 2, SWA_G = 3, SWA_W = 128;
constexpr int GH = 6, GDK = 64, GDV = 64, GCONV = 5;
constexpr int MH = 4, MQR = 192, MKVR = 128, MNOPE = 64, MROPE = 32, MV = 64, MQD = MNOPE + MROPE, MKVD = MNOPE + MV;
constexpr int DMIX = 1024, GQKV = 1152;
constexpr int PO_QA = 0, PO_KA = 384, PO_VA = 512, PO_GQKV = 640, PO_Z = 1792, PO_BA = 2176, PO_CQ = 2200, PO_CKV = 2392, PO_KR = 2528  , PO_KR_SRC = 2520, DPROJ = 2552, DPROJP = 2560;
constexpr int NE = 64, TOPK = 8, NGRP = 8, TOPG = 4, DE = CFG_DE, DS = CFG_DS;
constexpr float EPS = 1e-6f, ROUTED_SCALE = 2.5f;
constexpr int NSLOT = TA * TOPK, NK = S + L, NCHAIN = B * GH * 2, NCH = (S + L) / 64;
constexpr int NSPLIT = (NK / 64) % 4 == 0 ? 4 : ((NK / 64) % 2 == 0 ? 2 : 1);
static_assert(D % 128 == 0 && DE % 64 == 0 && DS % 64 == 0 && TA % 128 == 0 && T % 128 == 0, "tile divisibility");
}
using namespace cfg;

#ifdef HOST_EMU
typedef float st_t;
HD float ldf(const st_t* p) { return *p; }
HD void stf(st_t* p, float v) { *p = v; }
HD void st4(st_t* p, float a, float b, float c, float d) { p[0] = a; p[1] = b; p[2] = c; p[3] = d; }
#else
typedef unsigned short st_t;
typedef short bf16x8 __attribute__((ext_vector_type(8)));
typedef float f32x4 __attribute__((ext_vector_type(4)));
typedef float f32x2 __attribute__((ext_vector_type(2)));
typedef __bf16 bf16x2_t __attribute__((ext_vector_type(2)));
#define LAS __attribute__((address_space(3)))
HD float ldf(const st_t* p) { unsigned u = ((unsigned)*p) << 16; float f; __builtin_memcpy(&f, &u, 4); return f; }
HD unsigned short f2bf(float v) { unsigned u; __builtin_memcpy(&u, &v, 4); u = (u + 0x7fffu + ((u >> 16) & 1u)) >> 16; return (unsigned short)u; }
HD void stf(st_t* p, float v) { *p = f2bf(v); }
HD float ldf(const float* p) { return *p; }
HD void stf(float* p, float v) { *p = v; }
__device__ __forceinline__ unsigned pk_bf16(float lo, float hi) { f32x2 v = {lo, hi}; return __builtin_bit_cast(unsigned, __builtin_convertvector(v, bf16x2_t)); }
HD void st4(st_t* p, float a, float b, float c, float d) {
#if defined(__HIP_DEVICE_COMPILE__)
    uint2 w; w.x = pk_bf16(a, b); w.y = pk_bf16(c, d); *(uint2*)p = w;
#else
    p[0] = f2bf(a); p[1] = f2bf(b); p[2] = f2bf(c); p[3] = f2bf(d);
#endif
}
#endif

#if defined(__HIP_DEVICE_COMPILE__)
__device__ __forceinline__ float fast_exp(float x) { return __builtin_amdgcn_exp2f(x * 1.4426950408889634f); }
__device__ __forceinline__ float silu_f(float x) { return x * __builtin_amdgcn_rcpf(1.0f + fast_exp(-x)); }
__device__ __forceinline__ float sigmoid_f(float x) { return __builtin_amdgcn_rcpf(1.0f + fast_exp(-x)); }
__device__ __forceinline__ float softplus_f(float x) { return x > 20.f ? x : 0.6931471805599453f * __builtin_amdgcn_logf(1.0f + fast_exp(x)); }
__device__ __forceinline__ float rsqrt_f(float x) { return __builtin_amdgcn_rsqf(x); }
#else
HD float silu_f(float x) { return x / (1.0f + expf(-x)); }
HD float sigmoid_f(float x) { return 1.0f / (1.0f + expf(-x)); }
HD float softplus_f(float x) { return x > 20.f ? x : log1pf(expf(x)); }
HD float rsqrt_f(float x) { return 1.0f / sqrtf(x); }
#endif

struct TJob { const float* src; st_t* dst; int K, N, npad, grp, off, ldt, ldsrc, pad_; };
constexpr int NJOBS = 16;

struct WsOff { size_t BAR, MOD, TABA, TABM, XC, BG, LOGITS, EW, EIDX, EPOS, CNT, CNTP, CTR, GAM, TOKLIST, WLIST, H, Wt_in, Wt_out, Wt_uq, Wt_ukv, Wt_sgu, Wt_sd, SACT, ACT, Wt_egu, Wt_ed, CH,
               P, G, CQN, CKVN, MQ, MKV, O, VtM, VtA, OF, OB, YB, OPART, MLPART, BCNT, total; };
constexpr size_t align256(size_t v) { return (v + 255) & ~(size_t)255; }
constexpr WsOff make_ws() {
    WsOff w{}; size_t off = 0; const size_t E = sizeof(st_t);
#define TAKE(name, bytes) w.name = off; off = align256(off + (size_t)(bytes));
    TAKE(BAR, 4096 * 4)
    TAKE(MOD, (size_t)DEPTH * 3 * 6 * D * 4) TAKE(TABA, 128 * 16 * 2 * 4) TAKE(TABM, 128 * 8 * 2 * 4) TAKE(XC, (size_t)TC * D * 4) TAKE(BG, (size_t)TA * 24 * 4)
    TAKE(LOGITS, (size_t)TA * NE * 4) TAKE(EW, (size_t)TA * TOPK * 4) TAKE(EIDX, (size_t)TA * TOPK * 4) TAKE(EPOS, (size_t)TA * TOPK * 4)
    TAKE(BCNT, 1024 * NE * 4)
    TAKE(CNT, DEPTH * NE * 4) TAKE(CNTP, DEPTH * NE * 32 * 4) TAKE(CTR, DEPTH * 16 * 4) TAKE(GAM, (size_t)NCHAIN * NCH * 4) TAKE(TOKLIST, (size_t)NE * TA * 4) TAKE(WLIST, (size_t)NE * TA * 4)
    TAKE(H, (size_t)TA * D * E)
    TAKE(Wt_in, (size_t)DEPTH * DPROJP * D * E) TAKE(Wt_out, (size_t)DEPTH * D * DMIX * E) TAKE(Wt_uq, (size_t)DEPTH * MH * MQD * MQR * E) TAKE(Wt_ukv, (size_t)DEPTH * MH * MKVD * MKVR * E)
    TAKE(Wt_sgu, (size_t)DEPTH * 2 * DS * D * E) TAKE(Wt_sd, (size_t)DEPTH * D * DS * E)
    const size_t q0 = off;
    TAKE(SACT, (size_t)TA * DS * E) TAKE(ACT, ((size_t)NSLOT * DE * E > (size_t)TA * D * E ? (size_t)NSLOT * DE * E : (size_t)TA * D * E))
    TAKE(Wt_egu, (size_t)NE * 2 * DE * D * E) TAKE(Wt_ed, (size_t)NE * D * DE * E)
    w.CH = q0; { const size_t chb = align256((size_t)NCHAIN * NCH * 5 * 4096 * E); if (q0 + chb > off) off = q0 + chb; }
    const size_t r0 = off;
    TAKE(P, (size_t)TA * DPROJP * E) TAKE(G, (size_t)TA * GQKV * E) TAKE(CQN, (size_t)TA * MQR * E) TAKE(CKVN, (size_t)TA * MKVR * E) TAKE(MQ, (size_t)TA * MH * MQD * E) TAKE(MKV, (size_t)TA * MH * MKVD * E)
    TAKE(O, (size_t)TA * DMIX * E) TAKE(VtM, (size_t)B * MH * MV * NK * E) TAKE(VtA, (size_t)B * SWA_KVH * 64 * NK * E) TAKE(OF, (size_t)TA * GH * GDV * E) TAKE(OB, (size_t)TA * GH * GDV * E)
#undef TAKE
    w.YB = r0; { const size_t yb = align256((size_t)NSLOT * D * E); if (r0 + yb > off) off = r0 + yb; }
    if ((size_t)NSPLIT * T * MH * MV * E <= (size_t)TA * D * E) w.OPART = w.H; else { w.OPART = off; off = align256(off + (size_t)NSPLIT * T * MH * MV * E); }
    if ((size_t)NSPLIT * T * MH * 2 * 4 <= (size_t)TA * NE * 4) w.MLPART = w.LOGITS; else { w.MLPART = off; off = align256(off + (size_t)NSPLIT * T * MH * 2 * 4); }
    w.total = off; return w;
}
constexpr WsOff WS = make_ws();

struct Params {
    const float *x, *c, *ctx, *c_ctx, *ada_w, *ada_b, *mix_norm_pre, *mix_norm_post, *ffn_norm_pre, *ffn_norm_post,
        *w_in, *w_out, *swa_sink, *gdn_conv_w, *gdn_a_log, *gdn_dt_bias, *gdn_norm_w, *mla_q_norm, *mla_w_uq, *mla_kv_norm, *mla_w_ukv,
        *router_w, *router_bias, *e_gate, *e_up, *e_down, *s_gate, *s_up, *s_down;
    float* out;
    char* ws;
#define WSF(T, name, field) HD T* name() const { return (T*)(ws + WS.field); }
    WSF(unsigned, BAR, BAR) WSF(float, MOD, MOD) WSF(float, TABA, TABA) WSF(float, TABM, TABM) WSF(float, XC, XC) WSF(float, BG, BG) WSF(float, LOGITS, LOGITS) WSF(float, EW, EW)
    WSF(int, EIDX, EIDX) WSF(int, EPOS, EPOS) WSF(int, CNT, CNT) WSF(int, CNTP, CNTP) WSF(int, CTR, CTR) WSF(float, GAM, GAM) WSF(int, TOKLIST, TOKLIST) WSF(float, WLIST, WLIST)
    WSF(st_t, H, H) WSF(st_t, SH, H) WSF(st_t, Wt_in, Wt_in) WSF(st_t, Wt_out, Wt_out) WSF(st_t, Wt_uq, Wt_uq) WSF(st_t, Wt_ukv, Wt_ukv) WSF(st_t, Wt_sgu, Wt_sgu) WSF(st_t, Wt_sd, Wt_sd)
    WSF(st_t, SACT, SACT) WSF(st_t, ACT, ACT) WSF(st_t, Y, ACT) WSF(st_t, Wt_egu, Wt_egu) WSF(st_t, Wt_ed, Wt_ed) WSF(st_t, CH, CH)
    WSF(st_t, P, P) WSF(st_t, G, G) WSF(st_t, CQN, CQN) WSF(st_t, CKVN, CKVN) WSF(st_t, MQ, MQ) WSF(st_t, MKV, MKV) WSF(st_t, O, O) WSF(st_t, VtM, VtM) WSF(st_t, VtA, VtA)
    WSF(st_t, OF, OF) WSF(st_t, OB, OB) WSF(st_t, YB, YB)
    WSF(st_t, OPART, OPART) WSF(float, MLPART, MLPART) WSF(int, BCNT, BCNT)
#undef WSF
};
inline size_t carve(Params& p, char* ws) { p.ws = ws; return WS.total; }

HD TJob static_job(const Params& p, int j) {
    const int l = j / (NJOBS / DEPTH), k = j % (NJOBS / DEPTH);
    switch (k) {
    case 0: return TJob{p.w_in + (size_t)l * D * DPROJ, p.Wt_in() + (size_t)l * DPROJP * D, D, PO_KR_SRC, PO_KR, 16, 0, D, DPROJ, 0};
    case 1: return TJob{p.w_in + (size_t)l * D * DPROJ + PO_KR_SRC, p.Wt_in() + (size_t)l * DPROJP * D + (size_t)PO_KR * D, D, MROPE, MROPE, 16, 0, D, DPROJ, 0};
    case 2: return TJob{p.w_out + (size_t)l * DMIX * D, p.Wt_out() + (size_t)l * D * DMIX, DMIX, D, D, 16, 0, DMIX, D, 0};
    case 3: return TJob{p.mla_w_uq + (size_t)l * MQR * MH * MQD, p.Wt_uq() + (size_t)l * MH * MQD * MQR, MQR, MH * MQD, MH * MQD, 16, 0, MQR, MH * MQD, 0};
    case 4: return TJob{p.mla_w_ukv + (size_t)l * MKVR * MH * MKVD, p.Wt_ukv() + (size_t)l * MH * MKVD * MKVR, MKVR, MH * MKVD, MH * MKVD, 16, 0, MKVR, MH * MKVD, 0};
    case 5: return TJob{p.s_gate + (size_t)l * D * DS, p.Wt_sgu() + (size_t)l * 2 * DS * D, D, DS, DS, 32, 0, D, DS, 0};
    case 6: return TJob{p.s_up + (size_t)l * D * DS, p.Wt_sgu() + (size_t)l * 2 * DS * D, D, DS, DS, 32, 16, D, DS, 0};
    default: return TJob{p.s_down + (size_t)l * DS * D, p.Wt_sd() + (size_t)l * D * DS, DS, D, D, 16, 0, DS, D, 0};
    }
}
HD long long static_job_items(int j) {
    const int k = j % (NJOBS / DEPTH);
    const int K = k == 2 ? DMIX : k == 3 ? MQR : k == 4 ? MKVR : k == 7 ? DS : D;
    const int npad = k == 0 ? PO_KR : k == 1 ? MROPE : k == 2 ? D : k == 3 ? MH * MQD : k == 4 ? MH * MKVD : k == 7 ? D : DS;
    return (long long)(K / 64) * ((npad + 31) / 32);
}

HD int mod_which(int r) { return r < T ? r / S : 2; }
HD const float* mod_vec(const Params& p, int layer, int r, int chunk) { return p.MOD() + ((size_t)(layer * 3 + mod_which(r)) * 6 + chunk) * D; }
HD void seq_bounds(int r, int& lo, int& hi) { if (r < T) { lo = (r / S) * S; hi = lo + S; } else { lo = T + ((r - T) / L) * L; hi = lo + L; } }
HD float* xrow(const Params& p, int r) { return r < T ? p.out + (size_t)r * D : p.XC() + (size_t)(r - T) * D; }
HD const float* xin_row(const Params& p, int layer, int r) { if (layer > 0) return xrow(p, r); return r < T ? p.x + (size_t)r * D : p.ctx + (size_t)(r - T) * D; }
HD int rows_out(int layer) { return layer == DEPTH - 1 ? T : TA; }
HD int expert_base(const int* cnt, int e) { int b = 0; for (int i = 0; i < e; ++i) b += cnt[i]; return b; }

#ifdef HOST_EMU
inline int atomic_inc(int* p) { int v;
#pragma omp atomic capture
    { v = *p; *p += 1; }
    return v; }
#else
__device__ __forceinline__ int atomic_inc(int* p) { return atomicAdd(p, 1); }
#endif

enum Stage { ST_MOD = 0, ST_ZERO, ST_NORM1, ST_ROPE_SWA, ST_GDN_CONV, ST_GDN_L2, ST_GDN_GATE, ST_MLA_NORM, ST_ROPE_MLA,
             ST_SWA, ST_GDN_SCAN, ST_GDN_OUT, ST_MLA, ST_POST1, ST_ROUTER, ST_ROUTE, ST_POST2, ST_VT, ST_TAB, ST_COUNT };

HD long long n_items(int st, int layer) {
    switch (st) {
    case ST_MOD: return (long long)DEPTH * 3 * 6 * D;
    case ST_ZERO: return DEPTH * NE + DEPTH * 16 + DEPTH * NE * 32;
    case ST_VT: return (long long)(B * MH + B * SWA_KVH) * (NK / 8) * 64;
    case ST_TAB: return 128 * 16 + 128 * 8;
    case ST_NORM1: return TA;
    case ST_ROPE_SWA: return (long long)T * 8 * 32;
    case ST_GDN_CONV: return (long long)TA * GQKV;
    case ST_GDN_L2: return (long long)TA * 12;
    case ST_GDN_GATE: return (long long)TA * 12;
    case ST_MLA_NORM: return (long long)TA * 2;
    case ST_ROPE_MLA: return (long long)T * 5 * 16;
    case ST_SWA: return (long long)rows_out(layer) * SWA_H;
    case ST_GDN_SCAN: return (long long)B * GH * 2 * GDV;
    case ST_GDN_OUT: return (long long)rows_out(layer) * GH;
    case ST_MLA: return (long long)rows_out(layer) * MH;
    case ST_POST1: return rows_out(layer);
    case ST_ROUTER: return (long long)rows_out(layer) * NE;
    case ST_ROUTE: return rows_out(layer);
    case ST_POST2: return rows_out(layer);
    }
    return 0;
}

HD float rope_inv(int i, int n) { return exp2f(-(float)i / (float)n * 13.287712379549449f); }

HD void run_item(const Params& p, int st, int layer, long long i) {
    switch (st) {
    case ST_MOD: {
        const int j = (int)(i % (6 * D)); const int w = (int)((i / (6 * D)) % 3); const int ly = (int)(i / (6 * D * 3));
        const float* cv = w < 2 ? p.c + (size_t)w * D : p.c_ctx;
        const float* W = p.ada_w + (size_t)ly * D * 6 * D;
        float acc = p.ada_b[(size_t)ly * 6 * D + j];
        for (int k = 0; k < D; ++k) acc += silu_f(cv[k]) * W[(size_t)k * 6 * D + j];
        p.MOD()[i] = acc;
    } break;
    case ST_ZERO: if (i < DEPTH * NE) p.CNT()[i] = 0; else if (i < DEPTH * NE + DEPTH * 16) p.CTR()[i - DEPTH * NE] = 0; else p.CNTP()[i - DEPTH * NE - DEPTH * 16] = 0; break;
    case ST_TAB: {
        if (i < 128 * 16) { const int pos = (int)(i / 16), ii = (int)(i % 16); const float ang = (float)pos * rope_inv(ii, 16); p.TABA()[2 * i] = cosf(ang); p.TABA()[2 * i + 1] = sinf(ang); }
        else { const long long k = i - 128 * 16; const int pos = (int)(k / 8), ii = (int)(k % 8); const float ang = (float)pos * rope_inv(ii, 8); p.TABM()[2 * k] = cosf(ang); p.TABM()[2 * k + 1] = sinf(ang); }
    } break;
    case ST_VT: {
        const int dv = (int)(i % 64); long long r = i / 64; const int kc = (int)(r % (NK / 8)); const int bh = (int)(r / (NK / 8));
        const bool mla = bh < B * MH; const int b = mla ? bh / MH : (bh - B * MH) / SWA_KVH, hd = mla ? bh % MH : (bh - B * MH) % SWA_KVH;
        st_t* dst = (mla ? p.VtM() + ((size_t)(b * MH + hd) * 64 + dv) * NK : p.VtA() + ((size_t)(b * SWA_KVH + hd) * 64 + dv) * NK) + kc * 8;
        for (int j = 0; j < 8; ++j) { const int kidx = kc * 8 + j; const int row = kidx < S ? b * S + kidx : T + b * L + (kidx - S);
            dst[j] = mla ? p.MKV()[(size_t)row * MH * MKVD + hd * MKVD + MNOPE + dv] : p.P()[(size_t)row * DPROJP + PO_VA + hd * 64 + dv]; }
    } break;
    case ST_NORM1: {
        const int r = (int)i; const float* xr = xin_row(p, layer, r); float ss = 0.f;
        for (int d = 0; d < D; ++d) ss += xr[d] * xr[d];
        const float rstd = 1.0f / sqrtf(ss / D + EPS);
        const float* gain = p.mix_norm_pre + (size_t)layer * D; const float* sh = mod_vec(p, layer, r, 0); const float* sc = mod_vec(p, layer, r, 1);
        st_t* hr = p.H() + (size_t)r * D;
        for (int d = 0; d < D; ++d) stf(hr + d, xr[d] * rstd * gain[d] * (1.0f + sc[d]) + sh[d]);
    } break;
    case ST_ROPE_SWA: {
        const int j = (int)(i % 32), hh = (int)((i / 32) % 8), r = (int)(i / 256);
        const int s = r % S, rp = s / GRID_W, cp = s % GRID_W;
        const int base = hh < 6 ? PO_QA + hh * 64 : PO_KA + (hh - 6) * 64;
        const int half = j / 16, ii = j % 16; const int i1 = base + half * 32 + ii, i2 = i1 + 16;
        const float ang = (float)(half == 0 ? rp : cp) * rope_inv(ii, 16); const float cs = cosf(ang), sn = sinf(ang);
        st_t* pr = p.P() + (size_t)r * DPROJP; const float x1 = ldf(pr + i1), x2 = ldf(pr + i2);
        stf(pr + i1, x1 * cs - x2 * sn); stf(pr + i2, x1 * sn + x2 * cs);
    } break;
    case ST_GDN_CONV: {
        const int cc = (int)(i % GQKV), r = (int)(i / GQKV); int lo, hi; seq_bounds(r, lo, hi);
        const float* w = p.gdn_conv_w + (size_t)layer * GCONV * GQKV; float acc = 0.f;
        for (int j = 0; j < GCONV; ++j) { const int rr = r + j - 2; if (rr >= lo && rr < hi) acc += w[j * GQKV + cc] * ldf(p.P() + (size_t)rr * DPROJP + PO_GQKV + cc); }
        stf(p.G() + (size_t)r * GQKV + cc, silu_f(acc));
    } break;
    case ST_GDN_L2: {
        const int hh = (int)(i % 12), r = (int)(i / 12); st_t* g = p.G() + (size_t)r * GQKV + hh * 64; float ss = 0.f;
        for (int d = 0; d < 64; ++d) { const float v = ldf(g + d); ss += v * v; }
        const float rn = 1.0f / sqrtf(ss + EPS);
        for (int d = 0; d < 64; ++d) stf(g + d, ldf(g + d) * rn);
    } break;
    case ST_GDN_GATE: {
        const int j = (int)(i % 12), r = (int)(i / 12); const st_t* pr = p.P() + (size_t)r * DPROJP + PO_BA;
        const float beta = sigmoid_f(ldf(pr + j)); const float a = ldf(pr + 12 + j);
        const float g = -expf(p.gdn_a_log[layer * 12 + j]) * softplus_f(a + p.gdn_dt_bias[layer * 12 + j]);
        p.BG()[(size_t)r * 24 + j] = beta; p.BG()[(size_t)r * 24 + 12 + j] = g;
    } break;
    case ST_MLA_NORM: {
        const int w = (int)(i % 2), r = (int)(i / 2);
        const int n = w == 0 ? MQR : MKVR; const st_t* src = p.P() + (size_t)r * DPROJP + (w == 0 ? PO_CQ : PO_CKV);
        const float* gain = w == 0 ? p.mla_q_norm + (size_t)layer * MQR : p.mla_kv_norm + (size_t)layer * MKVR;
        st_t* dst = w == 0 ? p.CQN() + (size_t)r * MQR : p.CKVN() + (size_t)r * MKVR; float ss = 0.f;
        for (int d = 0; d < n; ++d) { const float v = ldf(src + d); ss += v * v; }
        const float rstd = 1.0f / sqrtf(ss / n + EPS);
        for (int d = 0; d < n; ++d) stf(dst + d, ldf(src + d) * rstd * gain[d]);
    } break;
    case ST_ROPE_MLA: {
        const int j = (int)(i % 16), w = (int)((i / 16) % 5), r = (int)(i / 80);
        const int s = r % S, rp = s / GRID_W, cp = s % GRID_W;
        const int half = j / 8, ii = j % 8; const float ang = (float)(half == 0 ? rp : cp) * rope_inv(ii, 8); const float cs = cosf(ang), sn = sinf(ang);
        st_t* q = w < 4 ? p.MQ() + (size_t)r * MH * MQD + w * MQD + MNOPE + half * 16 + ii : p.P() + (size_t)r * DPROJP + PO_KR + half * 16 + ii;
        const float x1 = ldf(q), x2 = ldf(q + 8); stf(q, x1 * cs - x2 * sn); stf(q + 8, x1 * sn + x2 * cs);
    } break;
    case ST_SWA: {
        const int h = (int)(i % SWA_H), r = (int)(i / SWA_H); const int kvh = h / SWA_G;
        float q[64], acc[64]; const st_t* qp = p.P() + (size_t)r * DPROJP + PO_QA + h * 64;
        _Pragma("unroll") for (int d = 0; d < 64; ++d) { q[d] = ldf(qp + d) * 0.125f; acc[d] = 0.f; }
        float m = p.swa_sink[layer * SWA_H + h], den = 1.0f;
        int b, klo = 0, khi = 0;
        if (r < T) { b = r / S; const int s = r % S; klo = s - SWA_W < 0 ? 0 : s - SWA_W; khi = s + SWA_W > S - 1 ? S - 1 : s + SWA_W; } else { b = (r - T) / L; khi = -1; }
        const int nloc = khi - klo + 1;
        for (int t = 0; t < nloc + L; ++t) {
            const int kr = t < nloc ? b * S + klo + t : T + b * L + (t - nloc);
            const st_t* kp = p.P() + (size_t)kr * DPROJP + PO_KA + kvh * 64; const st_t* vp = p.P() + (size_t)kr * DPROJP + PO_VA + kvh * 64;
            float sc = 0.f; _Pragma("unroll") for (int d = 0; d < 64; ++d) sc += q[d] * ldf(kp + d);
            if (sc > m) { const float f = expf(m - sc); den *= f; _Pragma("unroll") for (int d = 0; d < 64; ++d) acc[d] *= f; m = sc; }
            const float pe = expf(sc - m); den += pe;
            _Pragma("unroll") for (int d = 0; d < 64; ++d) acc[d] += pe * ldf(vp + d);
        }
        const float inv = 1.0f / den; st_t* o = p.O() + (size_t)r * DMIX + h * 64;
        _Pragma("unroll") for (int d = 0; d < 64; ++d) stf(o + d, acc[d] * inv);
    } break;
    case ST_GDN_SCAN: {
        const int e = (int)(i % GDV), dir = (int)((i / GDV) % 2), h = (int)((i / (GDV * 2)) % GH), b = (int)(i / (GDV * 2 * GH));
        float s[64]; _Pragma("unroll") for (int d = 0; d < 64; ++d) s[d] = 0.f;
        st_t* dst = dir == 0 ? p.OF() : p.OB();
        for (int t = 0; t < L + S; ++t) {
            int r; if (t < L) r = T + b * L + (dir == 0 ? t : L - 1 - t); else { const int u = t - L; r = b * S + (dir == 0 ? u : S - 1 - u); }
            const st_t* g = p.G() + (size_t)r * GQKV; const st_t* qv = g + h * 64; const st_t* kv = g + 384 + h * 64; const float v = ldf(g + 768 + h * 64 + e);
            const float beta = p.BG()[(size_t)r * 24 + dir * 6 + h], alpha = expf(p.BG()[(size_t)r * 24 + 12 + dir * 6 + h]);
            float ks = 0.f; _Pragma("unroll") for (int d = 0; d < 64; ++d) { s[d] *= alpha; ks += ldf(kv + d) * s[d]; }
            const float vn = beta * (v - ks); float o = 0.f;
            _Pragma("unroll") for (int d = 0; d < 64; ++d) { s[d] += ldf(kv + d) * vn; o += ldf(qv + d) * s[d]; }
            stf(dst + (size_t)r * (GH * GDV) + h * 64 + e, o * 0.125f);
        }
    } break;
    case ST_GDN_OUT: {
        const int h = (int)(i % GH), r = (int)(i / GH); const st_t* of = p.OF() + (size_t)r * 384 + h * 64; const st_t* ob = p.OB() + (size_t)r * 384 + h * 64;
        float ss = 0.f; for (int d = 0; d < 64; ++d) { const float o = ldf(of + d) + ldf(ob + d); ss += o * o; }
        const float rstd = 1.0f / sqrtf(ss / 64 + EPS); const float* nw = p.gdn_norm_w + layer * 64; const st_t* z = p.P() + (size_t)r * DPROJP + PO_Z + h * 64;
        st_t* o = p.O() + (size_t)r * DMIX + 384 + h * 64;
        for (int d = 0; d < 64; ++d) stf(o + d, (ldf(of + d) + ldf(ob + d)) * rstd * nw[d] * silu_f(ldf(z + d)));
    } break;
    case ST_MLA: {
        const int h = (int)(i % MH), r = (int)(i / MH); const float scale = 1.0f / sqrtf((float)MQD);
        float acc[64]; const st_t* qp = p.MQ() + (size_t)r * MH * MQD + h * MQD;
        _Pragma("unroll") for (int d = 0; d < 64; ++d) acc[d] = 0.f;
        float m = -1e30f, den = 0.f; int b, nlat;
        if (r < T) { b = r / S; nlat = S; } else { b = (r - T) / L; nlat = 0; }
        for (int t = 0; t < nlat + L; ++t) {
            const int kr = t < nlat ? b * S + t : T + b * L + (t - nlat);
            const st_t* kn = p.MKV() + (size_t)kr * MH * MKVD + h * MKVD; const st_t* krp = p.P() + (size_t)kr * DPROJP + PO_KR;
            float sc = 0.f; for (int d = 0; d < 64; ++d) sc += ldf(qp + d) * ldf(kn + d);
            for (int d = 0; d < 32; ++d) sc += ldf(qp + 64 + d) * ldf(krp + d);
            sc *= scale;
            if (sc > m) { const float f = expf(m - sc); den *= f; _Pragma("unroll") for (int d = 0; d < 64; ++d) acc[d] *= f; m = sc; }
            const float pe = expf(sc - m); den += pe;
            _Pragma("unroll") for (int d = 0; d < 64; ++d) acc[d] += pe * ldf(kn + 64 + d);
        }
        const float inv = 1.0f / den; st_t* o = p.O() + (size_t)r * DMIX + 768 + h * 64;
        _Pragma("unroll") for (int d = 0; d < 64; ++d) stf(o + d, acc[d] * inv);
    } break;
    case ST_POST1: {
        const int r = (int)i; const st_t* y = p.Y() + (size_t)r * D; const float* xi = xin_row(p, layer, r); float* xr = xrow(p, r); float ss = 0.f;
        for (int d = 0; d < D; ++d) { const float v = ldf(y + d); ss += v * v; }
        const float rstd = 1.0f / sqrtf(ss / D + EPS); const float* gp = p.mix_norm_post + (size_t)layer * D; const float* g1 = mod_vec(p, layer, r, 2);
        float s2 = 0.f;
        for (int d = 0; d < D; ++d) { const float v = xi[d] + g1[d] * ldf(y + d) * rstd * gp[d]; xr[d] = v; s2 += v * v; }
        const float r2 = 1.0f / sqrtf(s2 / D + EPS); const float* gf = p.ffn_norm_pre + (size_t)layer * D; const float* sh = mod_vec(p, layer, r, 3); const float* sc = mod_vec(p, layer, r, 4);
        st_t* hr = p.H() + (size_t)r * D;
        for (int d = 0; d < D; ++d) stf(hr + d, xr[d] * r2 * gf[d] * (1.0f + sc[d]) + sh[d]);
    } break;
    case ST_ROUTER: {
        const int n = (int)(i % NE), r = (int)(i / NE); const st_t* a = p.H() + (size_t)r * D; const float* b = p.router_w + (size_t)layer * D * NE + n; float acc = 0.f;
        for (int k = 0; k < D; ++k) acc += ldf(a + k) * b[(size_t)k * NE];
        p.LOGITS()[(size_t)r * NE + n] = acc;
    } break;
    case ST_ROUTE: {
        const int r = (int)i; const float* lg = p.LOGITS() + (size_t)r * NE; const float* bias = p.router_bias + (size_t)layer * NE;
        float gs[NGRP];
        _Pragma("unroll") for (int g = 0; g < NGRP; ++g) { float m1 = -1e30f, m2 = -1e30f; for (int j = 0; j < 8; ++j) { const float v = sigmoid_f(lg[g * 8 + j]) + bias[g * 8 + j]; if (v > m1) { m2 = m1; m1 = v; } else if (v > m2) m2 = v; } gs[g] = m1 + m2; }
        unsigned gmask = 0;
        _Pragma("unroll") for (int k = 0; k < TOPG; ++k) { int best = 0; float bv = -1e30f; _Pragma("unroll") for (int g = 0; g < NGRP; ++g) if (!((gmask >> g) & 1u) && gs[g] > bv) { bv = gs[g]; best = g; } gmask |= 1u << best; }
        unsigned long long used = 0ull; float wsum = 0.f; float wv[TOPK]; int wi[TOPK];
        _Pragma("unroll") for (int k = 0; k < TOPK; ++k) { int best = 0; float bv = -1e30f;
            for (int e = 0; e < NE; ++e) if (((gmask >> (e / 8)) & 1u) && !((used >> e) & 1ull)) { const float v = sigmoid_f(lg[e]) + bias[e]; if (v > bv) { bv = v; best = e; } }
            used |= 1ull << best; wi[k] = best; wv[k] = sigmoid_f(lg[best]); wsum += wv[k]; }
        int* cnt = p.CNT() + layer * NE;
        _Pragma("unroll") for (int k = 0; k < TOPK; ++k) { const float w = wv[k] / wsum * ROUTED_SCALE; const int e = wi[k]; const int pos = atomic_inc(cnt + e);
            p.EIDX()[(size_t)r * TOPK + k] = e; p.EW()[(size_t)r * TOPK + k] = w; p.EPOS()[(size_t)r * TOPK + k] = pos; p.TOKLIST()[(size_t)e * TA + pos] = r; p.WLIST()[(size_t)e * TA + pos] = w; }
    } break;
    case ST_POST2: {
        const int r = (int)i; float* xr = xrow(p, r); const int* cnt = p.CNT() + layer * NE; const st_t* f[TOPK + 1]; f[0] = p.SH() + (size_t)r * D;
        _Pragma("unroll") for (int k = 0; k < TOPK; ++k) { const int e = p.EIDX()[(size_t)r * TOPK + k]; f[k + 1] = p.YB() + (size_t)(expert_base(cnt, e) + p.EPOS()[(size_t)r * TOPK + k]) * D; }
        float ss = 0.f;
        for (int d = 0; d < D; ++d) { float v = 0.f; _Pragma("unroll") for (int k = 0; k <= TOPK; ++k) v += ldf(f[k] + d); ss += v * v; }
        const float rstd = 1.0f / sqrtf(ss / D + EPS); const float* gp = p.ffn_norm_post + (size_t)layer * D; const float* g2 = mod_vec(p, layer, r, 5);
        for (int d = 0; d < D; ++d) { float v = 0.f; _Pragma("unroll") for (int k = 0; k <= TOPK; ++k) v += ldf(f[k] + d); xr[d] = xr[d] + g2[d] * v * rstd * gp[d]; }
    } break;
    }
}

enum { WT_STATIC = 0, WT_EXPERT = 1 };
HD long long wt_items(const Params& p, int kind) {
    if (kind == WT_STATIC) { long long n = 0; for (int j = 0; j < NJOBS; ++j) n += static_job_items(j); return n; }
    return (long long)NE * ((D / 64) * (DE / 32) * 2 + (DE / 64) * (D / 32));
}
HD bool wt_job(const Params& p, int kind, int layer, long long item, TJob& jb, int& kb, int& nb) {
    if (kind == WT_STATIC) {
        for (int j = 0; j < NJOBS; ++j) { const long long n = static_job_items(j); if (item < n) { jb = static_job(p, j); const int nblk = (jb.npad + 31) / 32; kb = (int)(item / nblk); nb = (int)(item % nblk); return true; } item -= n; }
        return false;
    }
    const int per_gu = (D / 64) * (DE / 32), per_d = (DE / 64) * (D / 32), per_e = 2 * per_gu + per_d;
    const int e = (int)(item / per_e); int r = (int)(item % per_e);
    if (r < 2 * per_gu) { const int w = r / per_gu; r %= per_gu; const float* src = (w == 0 ? p.e_gate : p.e_up) + ((size_t)layer * NE + e) * D * DE;
        jb = {src, p.Wt_egu() + (size_t)e * 2 * DE * D, D, DE, DE, 32, w * 16, D, DE, 0}; kb = r / (DE / 32); nb = r % (DE / 32); }
    else { r -= 2 * per_gu; jb = {p.e_down + ((size_t)layer * NE + e) * DE * D, p.Wt_ed() + (size_t)e * D * DE, DE, D, D, 16, 0, DE, D, 0}; kb = r / (D / 32); nb = r % (D / 32); }
    return true;
}
HD size_t wt_dst_row(const TJob& jb, int n) { return (size_t)(n / 16) * jb.grp + (n % 16) + jb.off; }
#ifdef HOST_EMU
inline void wt_item_host(const Params& p, int kind, int layer, long long item) {
    TJob jb; int kb, nb; if (!wt_job(p, kind, layer, item, jb, kb, nb)) return;
    for (int n = nb * 32; n < nb * 32 + 32 && n < jb.npad; ++n) for (int k = kb * 64; k < kb * 64 + 64; ++k)
        jb.dst[wt_dst_row(jb, n) * jb.ldt + k] = n < jb.N ? jb.src[(size_t)k * jb.ldsrc + n] : 0.f;
}
#else
__device__ __forceinline__ void wt_item_dev(const Params& p, int kind, int layer, long long item, LAS float* scr, int lane) {
    TJob jb; int kb, nb; if (!wt_job(p, kind, layer, item, jb, kb, nb)) return;
    const int k0 = kb * 64, n0 = nb * 32;
    { float tmp[32]; const int n = n0 + (lane & 31); const float* sp = jb.src + (size_t)(k0 + (lane >> 5)) * jb.ldsrc + n;
      if (n < jb.N) {
#pragma unroll
          for (int i = 0; i < 32; ++i) tmp[i] = sp[(size_t)(2 * i) * jb.ldsrc];
      } else {
#pragma unroll
          for (int i = 0; i < 32; ++i) tmp[i] = 0.f; }
#pragma unroll
      for (int i = 0; i < 32; ++i) scr[(2 * i + (lane >> 5)) * 33 + (lane & 31)] = tmp[i]; }
    asm volatile("s_waitcnt lgkmcnt(0)" ::: "memory");
    const int c = lane & 7;
#pragma unroll
    for (int j = 0; j < 4; ++j) { const int nl = (lane >> 3) + 8 * j, n = n0 + nl; const LAS float* s = scr + (8 * c) * 33 + nl;
        if (n < jb.npad) { uint4 o; o.x = pk_bf16(s[0 * 33], s[1 * 33]); o.y = pk_bf16(s[2 * 33], s[3 * 33]); o.z = pk_bf16(s[4 * 33], s[5 * 33]); o.w = pk_bf16(s[6 * 33], s[7 * 33]);
            *(uint4*)(jb.dst + wt_dst_row(jb, n) * jb.ldt + k0 + 8 * c) = o; } }
    asm volatile("s_waitcnt lgkmcnt(0)" ::: "memory");
}
#endif

enum { EPI_BF16 = 0, EPI_SWIGLU = 1, EPI_SCALE = 2, EPI_PROJ = 3, EPI_UQ = 4, EPI_UKV = 5 };
enum GStage { G_PROJ = 0, G_UQ, G_UKV, G_WOUT, G_SGU, G_SDOWN, G_EGU, G_EDOWN };
struct GemmDesc {
    const st_t* A; int lda; const int* rowidx; int a_row0, nrows;
    const st_t* Bt; int ldb, K, n0;
    int epi; st_t* out; int ldc; long long out_row0; const float* rowscale;
    const float* tab; st_t* vt;
};
HD int cdiv(int a, int b) { return (a + b - 1) / b; }
struct ETab { const int* eb; const int* tb; };
HD int gemm_ntiles(const Params& p, int gs, int layer, ETab et = ETab{nullptr, nullptr}) {
    const int mt = rows_out(layer) / 128;
    switch (gs) {
    case G_PROJ: return (TA / 128) * (DPROJP / 128);
    case G_UQ: return (TA / 128) * (MH * MQD / 128);
    case G_UKV: return (TA / 128) * (MH * MKVD / 128);
    case G_WOUT: return mt * (D / 128);
    case G_SGU: return mt * (2 * DS / 128);
    case G_SDOWN: return mt * (D / 128);
    case G_EGU: case G_EDOWN: { int t = 0; if (et.tb) t = et.tb[NE]; else for (int e = 0; e < NE; ++e) t += cdiv(p.CNT()[layer * NE + e], 128); return t * (gs == G_EGU ? 2 * DE / 128 : D / 128); }
    }
    return 0;
}
HD void gemm_desc(const Params& p, int gs, int layer, int item, GemmDesc& g, ETab et = ETab{nullptr, nullptr}) {
    g.rowidx = nullptr; g.rowscale = nullptr; g.nrows = 128; g.epi = EPI_BF16; g.tab = nullptr; g.vt = nullptr;
    auto plain = [&](const st_t* A, int lda, const st_t* Bt, int K, int ntn, st_t* out, int ldc) {
        const int mtn = (gs == G_PROJ || gs == G_UQ || gs == G_UKV ? TA : rows_out(layer)) / 128, PW = ntn < 8 ? ntn : 8, nfull = ntn / PW;
        int mt, nt; { const int pidx = item / (mtn * PW); if (pidx < nfull) { const int w = item - pidx * mtn * PW; mt = w / PW; nt = pidx * PW + w % PW; } else { const int pw = ntn - nfull * PW, w = item - nfull * mtn * PW; mt = w / pw; nt = nfull * PW + w % pw; } }
        g.A = A; g.lda = lda; g.a_row0 = mt * 128; g.Bt = Bt; g.ldb = K; g.K = K; g.n0 = nt * 128; g.out = out; g.ldc = ldc; g.out_row0 = mt * 128; };
    switch (gs) {
    case G_PROJ: plain(p.H(), D, p.Wt_in() + (size_t)layer * DPROJP * D, D, DPROJP / 128, p.P(), DPROJP); g.epi = EPI_PROJ; g.tab = g.n0 + 128 > PO_KR ? p.TABM() : p.TABA(); g.vt = p.VtA(); break;
    case G_UQ: plain(p.CQN(), MQR, p.Wt_uq() + (size_t)layer * MH * MQD * MQR, MQR, MH * MQD / 128, p.MQ(), MH * MQD); g.epi = EPI_UQ; g.tab = p.TABM(); break;
    case G_UKV: plain(p.CKVN(), MKVR, p.Wt_ukv() + (size_t)layer * MH * MKVD * MKVR, MKVR, MH * MKVD / 128, p.MKV(), MH * MKVD); g.epi = EPI_UKV; g.vt = p.VtM(); break;
    case G_WOUT: plain(p.O(), DMIX, p.Wt_out() + (size_t)layer * D * DMIX, DMIX, D / 128, p.Y(), D); break;
    case G_SGU: plain(p.H(), D, p.Wt_sgu() + (size_t)layer * 2 * DS * D, D, 2 * DS / 128, p.SACT(), DS); g.epi = EPI_SWIGLU; break;
    case G_SDOWN: plain(p.SACT(), DS, p.Wt_sd() + (size_t)layer * D * DS, DS, D / 128, p.SH(), D); break;
    case G_EGU: case G_EDOWN: {
        const int ntn = gs == G_EGU ? 2 * DE / 128 : D / 128; int mt = item / ntn; const int nt = item % ntn; const int* cnt = p.CNT() + layer * NE;
        int e = 0, base = 0;
        if (et.tb) { int lo = 0, hi = NE - 1; while (lo < hi) { const int mid = (lo + hi + 1) >> 1; if (et.tb[mid] <= mt) lo = mid; else hi = mid - 1; } e = lo; mt -= et.tb[e]; base = et.eb[e]; }
        else for (; e < NE; ++e) { const int te = cdiv(cnt[e], 128); if (mt < te) break; mt -= te; base += cnt[e]; }
        g.a_row0 = mt * 128; g.nrows = cnt[e] - mt * 128 < 128 ? cnt[e] - mt * 128 : 128; g.n0 = nt * 128; g.out_row0 = base + mt * 128;
        if (gs == G_EGU) { g.A = p.H(); g.lda = D; g.rowidx = p.TOKLIST() + (size_t)e * TA; g.Bt = p.Wt_egu() + (size_t)e * 2 * DE * D; g.ldb = D; g.K = D; g.epi = EPI_SWIGLU; g.out = p.ACT(); g.ldc = DE; }
        else { g.A = p.ACT() + (size_t)base * DE; g.lda = DE; g.Bt = p.Wt_ed() + (size_t)e * D * DE; g.ldb = DE; g.K = DE; g.epi = EPI_SCALE; g.out = p.YB(); g.ldc = D; g.rowscale = p.WLIST() + (size_t)e * TA - base; }
    } break;
    }
}
HD bool epi_needs_partner(const GemmDesc& g, int cb) { return g.epi == EPI_UQ || (g.epi == EPI_PROJ && g.n0 + cb + 64 > PO_KR); }
HD void rope8(float (&v)[4], const float (&pv)[4], int q, const float* tab, int pos) {
    for (int r = 0; r < 4; ++r) { const int c16 = q * 4 + r, i = c16 & 7; const float cs = tab[(pos * 8 + i) * 2], sn = tab[(pos * 8 + i) * 2 + 1];
        v[r] = c16 < 8 ? v[r] * cs - pv[r] * sn : pv[r] * sn + v[r] * cs; }
}
HD void gemm_epi(const GemmDesc& g, int rl, int cb, int q, float (&v)[4][4], const float (&pv)[4][4]) {
    if (rl >= g.nrows) return;
    const long long orow = g.out_row0 + rl;
    if (g.epi == EPI_SWIGLU) {
        for (int jj = 0; jj < 2; ++jj) { float a[4]; for (int r = 0; r < 4; ++r) a[r] = silu_f(v[2 * jj][r]) * v[2 * jj + 1][r];
            st4(g.out + (size_t)orow * g.ldc + (g.n0 + cb) / 2 + jj * 16 + q * 4, a[0], a[1], a[2], a[3]); }
        return;
    }
    if (g.epi >= EPI_PROJ) {
        const int row = (int)orow; const bool lat = row < T; const int bb = lat ? row / S : (row - T) / L, kidx = lat ? row % S : S + (row - T) % L;
        const int rp = lat ? (row % S) / GRID_W : 0, cp = lat ? (row % S) % GRID_W : 0, span = (g.n0 + cb) / 64;
        if (g.epi == EPI_PROJ) {
            if (span < 8) { if (lat) for (int hp = 0; hp < 2; ++hp) for (int r = 0; r < 4; ++r) { const int i = q * 4 + r, pos = hp ? cp : rp; const float cs = g.tab[(pos * 16 + i) * 2], sn = g.tab[(pos * 16 + i) * 2 + 1];
                    const float x1 = v[2 * hp][r], x2 = v[2 * hp + 1][r]; v[2 * hp][r] = x1 * cs - x2 * sn; v[2 * hp + 1][r] = x1 * sn + x2 * cs; } }
            else if (span < 10) { for (int j = 0; j < 4; ++j) for (int r = 0; r < 4; ++r) stf(g.vt + ((size_t)(bb * SWA_KVH + span - 8) * 64 + j * 16 + q * 4 + r) * NK + kidx, v[j][r]); return; }
            else if (g.n0 + cb + 64 > PO_KR && lat) { rope8(v[2], pv[2], q, g.tab, rp); rope8(v[3], pv[3], q, g.tab, cp); }
        } else if (g.epi == EPI_UQ) {
            if (lat) for (int j = 0; j < 4; ++j) { const int k6 = ((g.n0 + cb) / 16 + j) % 6; if (k6 >= 4) rope8(v[j], pv[j], q, g.tab, k6 == 4 ? rp : cp); }
        } else {
            if (span & 1) { for (int j = 0; j < 4; ++j) for (int r = 0; r < 4; ++r) stf(g.vt + ((size_t)(bb * MH + span / 2) * 64 + j * 16 + q * 4 + r) * NK + kidx, v[j][r]); return; }
        }
    }
    const float w = g.epi == EPI_SCALE ? g.rowscale[orow] : 1.0f;
    for (int j = 0; j < 4; ++j) st4(g.out + (size_t)orow * g.ldc + g.n0 + cb + j * 16 + q * 4, v[j][0] * w, v[j][1] * w, v[j][2] * w, v[j][3] * w);
}
#ifdef HOST_EMU
inline void gemm_tile_host(const GemmDesc& g) {
    for (int rl = 0; rl < g.nrows; ++rl) {
        const long long ar = g.rowidx ? g.rowidx[g.a_row0 + rl] : g.a_row0 + rl; const st_t* a = g.A + (size_t)ar * g.lda;
        for (int cb = 0; cb < 128; cb += 64) for (int q = 0; q < 4; ++q) { float v[4][4], pv[4][4];
            for (int j = 0; j < 4; ++j) for (int r = 0; r < 4; ++r) { const st_t* b = g.Bt + (size_t)(g.n0 + cb + j * 16 + q * 4 + r) * g.ldb; float acc = 0.f; for (int k = 0; k < g.K; ++k) acc += a[k] * b[k]; v[j][r] = acc;
                const st_t* b2 = g.Bt + (size_t)(g.n0 + cb + j * 16 + (q ^ 2) * 4 + r) * g.ldb; float acc2 = 0.f; for (int k = 0; k < g.K; ++k) acc2 += a[k] * b2[k]; pv[j][r] = acc2; }
            gemm_epi(g, rl, cb, q, v, pv); }
    }
}
#else
__device__ __forceinline__ void gemm_tile_dev(const GemmDesc& g, LAS unsigned char* lds, const int tid) {
    const int lane = tid & 63, wave = __builtin_amdgcn_readfirstlane(tid >> 6), wr = wave >> 1, wc = wave & 1;
    const int lrow = lane >> 3, slot = lane & 7;
    const st_t* asrc[4]; const st_t* bsrc[4];
#pragma unroll
    for (int i = 0; i < 4; ++i) {
        const int row = i * 32 + wave * 8 + lrow, chunk = slot ^ ((row >> 1) & 7);
        int rl = row < g.nrows ? row : g.nrows - 1;
        const long long ar = g.rowidx ? (long long)g.rowidx[g.a_row0 + rl] : (long long)(g.a_row0 + rl);
        asrc[i] = g.A + (size_t)ar * g.lda + chunk * 8;
        bsrc[i] = g.Bt + (size_t)(g.n0 + row) * g.ldb + chunk * 8;
    }
    const int nt = g.K / 64;
    auto stage = [&](int buf, int t) {
#pragma unroll
        for (int i = 0; i < 4; ++i) {
            __builtin_amdgcn_global_load_lds((const unsigned*)(asrc[i] + t * 64), (LAS unsigned*)(lds + buf * 32768 + (i * 32 + wave * 8) * 128), 16, 0, 0);
            __builtin_amdgcn_global_load_lds((const unsigned*)(bsrc[i] + t * 64), (LAS unsigned*)(lds + buf * 32768 + 16384 + (i * 32 + wave * 8) * 128), 16, 0, 0);
        }
    };
    f32x4 acc[4][4];
#pragma unroll
    for (int i = 0; i < 4; ++i)
#pragma unroll
        for (int j = 0; j < 4; ++j) acc[i][j] = (f32x4){0.f, 0.f, 0.f, 0.f};
    const int fr = lane & 15, fq = lane >> 4;
    __syncthreads();
    stage(0, 0);
    __syncthreads();
    for (int t = 0; t < nt; ++t) {
        const int cur = t & 1;
        if (t + 1 < nt) stage(cur ^ 1, t + 1);
        const LAS unsigned char* As = lds + cur * 32768; const LAS unsigned char* Bs = As + 16384;
#pragma unroll
        for (int kk = 0; kk < 2; ++kk) {
            bf16x8 af[4], bfr[4];
#pragma unroll
            for (int i = 0; i < 4; ++i) { const int row = wr * 64 + i * 16 + fr; af[i] = *(const LAS bf16x8*)(As + row * 128 + (((kk * 4 + fq) ^ ((row >> 1) & 7)) << 4)); }
#pragma unroll
            for (int j = 0; j < 4; ++j) { const int row = wc * 64 + j * 16 + fr; bfr[j] = *(const LAS bf16x8*)(Bs + row * 128 + (((kk * 4 + fq) ^ ((row >> 1) & 7)) << 4)); }
#pragma unroll
            for (int i = 0; i < 4; ++i)
#pragma unroll
                for (int j = 0; j < 4; ++j) acc[i][j] = __builtin_amdgcn_mfma_f32_16x16x32_bf16(bfr[j], af[i], acc[i][j], 0, 0, 0);
        }
        __syncthreads();
    }
    const bool need_pv = epi_needs_partner(g, wc * 64);
#pragma unroll
    for (int i = 0; i < 4; ++i) { float v[4][4], pv[4][4];
#pragma unroll
        for (int j = 0; j < 4; ++j)
#pragma unroll
            for (int r = 0; r < 4; ++r) { v[j][r] = acc[i][j][r]; pv[j][r] = 0.f; }
        if (need_pv) {
#pragma unroll
            for (int j = 0; j < 4; ++j)
#pragma unroll
                for (int r = 0; r < 4; ++r) pv[j][r] = __shfl_xor(v[j][r], 32); }
        gemm_epi(g, wr * 64 + i * 16 + fr, wc * 64, fq, v, pv); }
}
#endif


struct AttnDesc {
    int dqk;
    const st_t* Q; int ldq, q_row0;
    const st_t* K1; int ldk1; const st_t* K2; int ldk2;
    int lat_row0, ctx_row0;
    const st_t* Vt;
    int kt_lo, kt_hi, nctx, ctx_t0;
    int mask, qpos0;
    float m_init, l_init, c;
    st_t* O; int o_col;
    int part; st_t* opart; float* mlpart;
};
HD int attn_nitems(int layer) { const int lat = B * MH * (S / 128) * NSPLIT + B * SWA_H * (S / 128); return layer == DEPTH - 1 ? lat : lat + B * MH * (L / 128) + B * SWA_H * (L / 128); }
HD int attn_queue_size(int layer, int x) {
    const int NQ = S / 128, NQC = L / 128, half = x / 4; int n = NCHAIN / 8 + NQ * NSPLIT + SWA_G * (NQ * (half + 1) / 2 - NQ * half / 2);
    if (layer < DEPTH - 1) n += NQC + SWA_G * (NQC * (half + 1) / 2 - NQC * half / 2);
    return n;
}
HD int attn_queue_item(int layer, int x, int k) {
    const int NQ = S / 128, NQC = L / 128, half = x / 4, n_mla = B * MH * NQ * NSPLIT, n_swa = B * SWA_H * NQ, n_mlac = B * MH * NQC;
    if (k < NCHAIN / 8) return x * (NCHAIN / 8) + k; k -= NCHAIN / 8;
    if (k < NQ * NSPLIT) return NCHAIN + x * NQ * NSPLIT + k; k -= NQ * NSPLIT;
    const int gb = (x % 4) / SWA_KVH, gk = (x % 4) % SWA_KVH;
    { const int qlo = NQ * half / 2, nq = NQ * (half + 1) / 2 - qlo; if (k < SWA_G * nq) { const int h = gk * SWA_G + k / nq; return NCHAIN + n_mla + (gb * SWA_H + h) * NQ + qlo + k % nq; } k -= SWA_G * nq; }
    if (k < NQC) return NCHAIN + n_mla + n_swa + x * NQC + k; k -= NQC;
    { const int qlo = NQC * half / 2, nq = NQC * (half + 1) / 2 - qlo; const int h = gk * SWA_G + k / (nq > 0 ? nq : 1); return NCHAIN + n_mla + n_swa + n_mlac + (gb * SWA_H + h) * NQC + qlo + k % (nq > 0 ? nq : 1); }
}
static_assert(NCHAIN % 8 == 0 && B * MH == 8 && B * SWA_KVH == 4, "queue layout");
HD void attn_desc(const Params& p, int layer, int item, AttnDesc& a) {
    const float LOG2E = 1.4426950408889634f;
    const int n_mla = B * MH * (S / 128) * NSPLIT, n_swa = B * SWA_H * (S / 128), n_mlac = B * MH * (L / 128);
    bool mla, ctxq; int b, h, qb, part = -1;
    if (item < n_mla) { mla = true; ctxq = false; part = item % NSPLIT; item /= NSPLIT; qb = item % (S / 128); h = (item / (S / 128)) % MH; b = item / (S / 128) / MH; }
    else if (item < n_mla + n_swa) { item -= n_mla; mla = false; ctxq = false; qb = item % (S / 128); h = (item / (S / 128)) % SWA_H; b = item / (S / 128) / SWA_H; }
    else if (item < n_mla + n_swa + n_mlac) { item -= n_mla + n_swa; mla = true; ctxq = true; qb = item % (L / 128); h = (item / (L / 128)) % MH; b = item / (L / 128) / MH; }
    else { item -= n_mla + n_swa + n_mlac; mla = false; ctxq = true; qb = item % (L / 128); h = (item / (L / 128)) % SWA_H; b = item / (L / 128) / SWA_H; }
    a.q_row0 = ctxq ? T + b * L + qb * 128 : b * S + qb * 128; a.lat_row0 = b * S; a.ctx_row0 = T + b * L; a.nctx = L / 64; a.qpos0 = qb * 128; a.O = p.O(); a.ctx_t0 = 0; a.part = -1; a.opart = nullptr; a.mlpart = nullptr;
    if (mla) {
        a.dqk = 96; a.Q = p.MQ() + h * MQD; a.ldq = MH * MQD; a.K1 = p.MKV() + h * MKVD; a.ldk1 = MH * MKVD; a.K2 = p.P() + PO_KR; a.ldk2 = DPROJP;
        a.Vt = p.VtM() + (size_t)(b * MH + h) * 64 * NK; a.kt_lo = 0; a.kt_hi = ctxq ? 0 : S / 64; a.mask = 0; a.m_init = -1e30f; a.l_init = 0.f; a.c = LOG2E / sqrtf((float)MQD); a.o_col = 768 + h * 64;
        if (part >= 0 && NSPLIT > 1) {
            const int CT = (NK / 64) / NSPLIT, t0 = part * CT, t1 = t0 + CT, nl = S / 64;
            a.kt_lo = t0 < nl ? t0 : nl; a.kt_hi = t1 < nl ? t1 : nl; a.nctx = t1 > nl ? t1 - (t0 > nl ? t0 : nl) : 0; a.ctx_t0 = t0 > nl ? t0 - nl : 0;
            a.part = part; a.opart = p.OPART() + (size_t)part * T * MH * MV + h * MV; a.mlpart = p.MLPART() + ((size_t)part * T * MH + h) * 2; }
    } else {
        const int kvh = h / SWA_G;
        a.dqk = 64; a.Q = p.P() + PO_QA + h * 64; a.ldq = DPROJP; a.K1 = p.P() + PO_KA + kvh * 64; a.ldk1 = DPROJP; a.K2 = nullptr; a.ldk2 = 0;
        a.Vt = p.VtA() + (size_t)(b * SWA_KVH + kvh) * 64 * NK; a.mask = ctxq ? 0 : 1;
        if (ctxq) { a.kt_lo = 0; a.kt_hi = 0; } else { a.kt_lo = (a.qpos0 - SWA_W) / 64; if (a.kt_lo < 0) a.kt_lo = 0; a.kt_hi = (a.qpos0 + 128 + SWA_W) / 64; if (a.kt_hi > S / 64) a.kt_hi = S / 64; }
        a.m_init = p.swa_sink[layer * SWA_H + h] * LOG2E; a.l_init = 1.f; a.c = LOG2E * 0.125f; a.o_col = h * 64;
    }
}
#ifdef HOST_EMU
inline void attn_tile_host(const AttnDesc& a) {
    const int nl = a.kt_hi - a.kt_lo, ntile = nl + a.nctx;
    for (int q = 0; q < 128; ++q) {
        const st_t* qr = a.Q + (size_t)(a.q_row0 + q) * a.ldq; float m = a.m_init, l = a.l_init, acc[64]; for (int d = 0; d < 64; ++d) acc[d] = 0.f;
        for (int t = 0; t < ntile; ++t) for (int kk = 0; kk < 64; ++kk) {
            const int kidx = t < nl ? (a.kt_lo + t) * 64 + kk : S + (a.ctx_t0 + t - nl) * 64 + kk; const int row = kidx < S ? a.lat_row0 + kidx : a.ctx_row0 + kidx - S;
            if (a.mask && t < nl) { const int dq = a.qpos0 + q - kidx; if (dq > SWA_W || dq < -SWA_W) continue; }
            float sc = 0.f; for (int d = 0; d < 64; ++d) sc += qr[d] * a.K1[(size_t)row * a.ldk1 + d];
            if (a.dqk > 64) for (int d = 64; d < a.dqk; ++d) sc += qr[d] * a.K2[(size_t)row * a.ldk2 + d - 64];
            sc *= a.c; if (sc > m) { const float f = exp2f(m - sc); l *= f; for (int d = 0; d < 64; ++d) acc[d] *= f; m = sc; }
            const float pe = exp2f(sc - m); l += pe; for (int d = 0; d < 64; ++d) acc[d] += pe * a.Vt[(size_t)d * NK + kidx];
        }
        if (a.part >= 0) { for (int d = 0; d < 64; ++d) a.opart[(size_t)(a.q_row0 + q) * MH * MV + d] = acc[d] / l; a.mlpart[(size_t)(a.q_row0 + q) * MH * 2] = m; a.mlpart[(size_t)(a.q_row0 + q) * MH * 2 + 1] = l; }
        else for (int d = 0; d < 64; ++d) a.O[(size_t)(a.q_row0 + q) * DMIX + a.o_col + d] = acc[d] / l;
    }
}
#else
typedef float f32x16 __attribute__((ext_vector_type(16)));
typedef unsigned u32x4 __attribute__((ext_vector_type(4)));
typedef unsigned u32x2 __attribute__((ext_vector_type(2)));
__device__ __forceinline__ int crow16(int reg, int h) { return (reg & 3) + 8 * (reg >> 2) + 4 * h; }
template <int DQK>
__device__ __forceinline__ void attn_tile_dev(const AttnDesc& a, LAS unsigned char* lds, const int tid) {
    constexpr int KSTR = DQK * 2 + 16, VSTR = 136, KBYTES = 64 * KSTR, BUF = KBYTES + 64 * VSTR, CPR = DQK / 8, KCH = 64 * CPR / 256, NKS = DQK / 16;
    const int lane = tid & 63, wave = __builtin_amdgcn_readfirstlane(tid >> 6), l31 = lane & 31, hh = lane >> 5;
    bf16x8 qf[NKS];
    { const st_t* qrow = a.Q + (size_t)(a.q_row0 + wave * 32 + l31) * a.ldq;
#pragma unroll
      for (int ks = 0; ks < NKS; ++ks) qf[ks] = *(const bf16x8*)(qrow + 16 * ks + 8 * hh); }
    f32x16 ot[2];
#pragma unroll
    for (int r = 0; r < 16; ++r) { ot[0][r] = 0.f; ot[1][r] = 0.f; }
    float m = a.m_init, lsum = hh == 0 ? a.l_init : 0.f;
    const int nl = a.kt_hi - a.kt_lo, ntile = nl + a.nctx; const float c = a.c;
    u32x4 kreg[KCH], vreg[2];
    auto gload = [&](int t) {
        const int kidx0 = t < nl ? (a.kt_lo + t) * 64 : S + (a.ctx_t0 + t - nl) * 64; const int rowbase = t < nl ? a.lat_row0 + kidx0 : a.ctx_row0 + kidx0 - S;
#pragma unroll
        for (int u = 0; u < KCH; ++u) { const int ci = tid + 256 * u, row = ci / CPR, cc = ci % CPR;
            const st_t* src = (DQK == 64 || cc < 8) ? a.K1 + (size_t)(rowbase + row) * a.ldk1 + cc * 8 : a.K2 + (size_t)(rowbase + row) * a.ldk2 + (cc - 8) * 8;
            kreg[u] = *(const u32x4*)src; }
#pragma unroll
        for (int u = 0; u < 2; ++u) { const int ci = tid + 256 * u, dv = ci >> 3, cc = ci & 7; vreg[u] = *(const u32x4*)(a.Vt + (size_t)dv * NK + kidx0 + cc * 8); }
    };
    auto lstore = [&](int buf) {
#pragma unroll
        for (int u = 0; u < KCH; ++u) { const int ci = tid + 256 * u, row = ci / CPR, cc = ci % CPR; *(LAS u32x4*)(lds + buf * BUF + row * KSTR + cc * 16) = kreg[u]; }
#pragma unroll
        for (int u = 0; u < 2; ++u) { const int ci = tid + 256 * u, dv = ci >> 3, cc = ci & 7; LAS u32x2* d = (LAS u32x2*)(lds + buf * BUF + KBYTES + dv * VSTR + cc * 16);
            d[0] = (u32x2){vreg[u].x, vreg[u].y}; d[1] = (u32x2){vreg[u].z, vreg[u].w}; }
    };
    __syncthreads();
    gload(0); lstore(0);
    __syncthreads();
    for (int t = 0; t < ntile; ++t) {
        const int cur = t & 1;
        if (t + 1 < ntile) gload(t + 1);
        const LAS unsigned char* Ks = lds + cur * BUF; const LAS unsigned char* Vs = Ks + KBYTES;
        f32x16 st[2];
#pragma unroll
        for (int kb = 0; kb < 2; ++kb) {
#pragma unroll
            for (int r = 0; r < 16; ++r) st[kb][r] = 0.f;
#pragma unroll
            for (int ks = 0; ks < NKS; ++ks) { const bf16x8 af = *(const LAS bf16x8*)(Ks + (kb * 32 + l31) * KSTR + (16 * ks + 8 * hh) * 2);
                st[kb] = __builtin_amdgcn_mfma_f32_32x32x16_bf16(af, qf[ks], st[kb], 0, 0, 0); }
        }
        if (a.mask && t < nl) {
            const int d0 = a.qpos0 + wave * 32 + l31 - (a.kt_lo + t) * 64;
#pragma unroll
            for (int kb = 0; kb < 2; ++kb)
#pragma unroll
                for (int r = 0; r < 16; ++r) { const int dq = d0 - (kb * 32 + crow16(r, hh)); if (dq > SWA_W || dq < -SWA_W) st[kb][r] = -1e30f; }
        }
        float mx = st[0][0];
#pragma unroll
        for (int r = 1; r < 16; ++r) mx = fmaxf(mx, st[0][r]);
#pragma unroll
        for (int r = 0; r < 16; ++r) mx = fmaxf(mx, st[1][r]);
        mx = fmaxf(mx, __shfl_xor(mx, 32));
        const float m_new = fmaxf(m, mx * c), alpha = __builtin_amdgcn_exp2f(m - m_new);
        float rs = 0.f;
#pragma unroll
        for (int kb = 0; kb < 2; ++kb)
#pragma unroll
            for (int r = 0; r < 16; ++r) { const float pe = __builtin_amdgcn_exp2f(__builtin_fmaf(st[kb][r], c, -m_new)); st[kb][r] = pe; rs += pe; }
        lsum = lsum * alpha + rs; m = m_new;
#pragma unroll
        for (int r = 0; r < 16; ++r) { ot[0][r] *= alpha; ot[1][r] *= alpha; }
#pragma unroll
        for (int kb = 0; kb < 2; ++kb)
#pragma unroll
            for (int s2 = 0; s2 < 2; ++s2) {
                u32x4 pw; pw.x = pk_bf16(st[kb][8 * s2 + 0], st[kb][8 * s2 + 1]); pw.y = pk_bf16(st[kb][8 * s2 + 2], st[kb][8 * s2 + 3]);
                pw.z = pk_bf16(st[kb][8 * s2 + 4], st[kb][8 * s2 + 5]); pw.w = pk_bf16(st[kb][8 * s2 + 6], st[kb][8 * s2 + 7]);
                const bf16x8 pb = __builtin_bit_cast(bf16x8, pw);
#pragma unroll
                for (int db = 0; db < 2; ++db) { const LAS unsigned char* vp = Vs + (db * 32 + l31) * VSTR + (kb * 32 + 16 * s2 + 4 * hh) * 2;
                    const u32x2 lo = *(const LAS u32x2*)vp, hi = *(const LAS u32x2*)(vp + 16); u32x4 vw; vw.x = lo.x; vw.y = lo.y; vw.z = hi.x; vw.w = hi.y;
                    ot[db] = __builtin_amdgcn_mfma_f32_32x32x16_bf16(__builtin_bit_cast(bf16x8, vw), pb, ot[db], 0, 0, 0); }
            }
        if (t + 1 < ntile) lstore(cur ^ 1);
        __syncthreads();
    }
    const float ltot = lsum + __shfl_xor(lsum, 32), inv = 1.0f / ltot;
    st_t* orow = a.O + (size_t)(a.q_row0 + wave * 32 + l31) * DMIX + a.o_col;
    if (a.part >= 0) { orow = a.opart + (size_t)(a.q_row0 + wave * 32 + l31) * MH * MV;
        if (hh == 0) { float* ml = a.mlpart + (size_t)(a.q_row0 + wave * 32 + l31) * MH * 2; ml[0] = m; ml[1] = ltot; } }
#pragma unroll
    for (int db = 0; db < 2; ++db)
#pragma unroll
        for (int g = 0; g < 4; ++g) st4(orow + db * 32 + 8 * g + 4 * hh, ot[db][4 * g] * inv, ot[db][4 * g + 1] * inv, ot[db][4 * g + 2] * inv, ot[db][4 * g + 3] * inv);
}
#endif


HD int gdn_row(int b, int dir, int n, int i) {
    if (n < L / 64) { const int pos = n * 64 + i; return T + b * L + (dir == 0 ? pos : L - 1 - pos); }
    const int pos = (n - L / 64) * 64 + i; return b * S + (dir == 0 ? pos : S - 1 - pos);
}
#ifdef HOST_EMU
inline void gdn_pre_host(const Params& p, int item) {
    const int c = item / NCH, n = item % NCH, dir = c & 1, h = (c >> 1) % GH, b = (c >> 1) / GH;
    float gc[64], beta[64]; const st_t* kk[64]; const st_t* qq[64]; const st_t* vv[64]; float acc = 0.f;
    for (int i = 0; i < 64; ++i) { const int r = gdn_row(b, dir, n, i); acc += p.BG()[(size_t)r * 24 + 12 + dir * 6 + h]; gc[i] = acc; beta[i] = p.BG()[(size_t)r * 24 + dir * 6 + h];
        qq[i] = p.G() + (size_t)r * GQKV + h * 64; kk[i] = qq[i] + 384; vv[i] = qq[i] + 768; }
    static thread_local float A[64][64], XU[64][64], XW[64][64];
    for (int i = 0; i < 64; ++i) for (int j = 0; j < 64; ++j) { float d = 0.f; for (int e = 0; e < 64; ++e) d += kk[i][e] * kk[j][e]; A[i][j] = j < i ? beta[i] * d * expf(gc[i] - gc[j]) : 0.f; }
    for (int i = 0; i < 64; ++i) for (int e = 0; e < 64; ++e) { float u = beta[i] * vv[i][e], w = beta[i] * expf(gc[i]) * kk[i][e];
        for (int j = 0; j < i; ++j) { u -= A[i][j] * XU[j][e]; w -= A[i][j] * XW[j][e]; } XU[i][e] = u; XW[i][e] = w; }
    st_t* ch = p.CH() + (size_t)item * 5 * 4096;
    for (int i = 0; i < 64; ++i) for (int e = 0; e < 64; ++e) {
        ch[0 * 4096 + e * 64 + i] = XU[i][e]; ch[1 * 4096 + i * 64 + e] = XW[i][e]; ch[2 * 4096 + i * 64 + e] = qq[i][e] * 0.125f * expf(gc[i]);
        float d = 0.f; for (int x = 0; x < 64; ++x) d += qq[i][x] * kk[e][x]; ch[3 * 4096 + i * 64 + e] = e <= i ? d * 0.125f * expf(gc[i] - gc[e]) : 0.f;
        ch[4 * 4096 + e * 64 + i] = kk[i][e] * expf(gc[63] - gc[i]); }
    p.GAM()[item] = expf(gc[63]);
}
inline void gdn_scan_host(const Params& p, int c) {
    const int dir = c & 1, h = (c >> 1) % GH, b = (c >> 1) / GH; st_t* dst = dir == 0 ? p.OF() : p.OB();
    static thread_local float Sm[64][64], Vn[64][64]; for (int d = 0; d < 64; ++d) for (int e = 0; e < 64; ++e) Sm[d][e] = 0.f;
    for (int n = 0; n < NCH; ++n) { const st_t* ch = p.CH() + (size_t)(c * NCH + n) * 5 * 4096; const float gam = p.GAM()[c * NCH + n];
        for (int i = 0; i < 64; ++i) for (int e = 0; e < 64; ++e) { float v = ch[0 * 4096 + e * 64 + i]; for (int d = 0; d < 64; ++d) v -= ch[1 * 4096 + i * 64 + d] * Sm[d][e]; Vn[i][e] = v; }
        for (int i = 0; i < 64; ++i) for (int e = 0; e < 64; ++e) { float o = 0.f; for (int d = 0; d < 64; ++d) o += ch[2 * 4096 + i * 64 + d] * Sm[d][e]; for (int j = 0; j < 64; ++j) o += ch[3 * 4096 + i * 64 + j] * Vn[j][e];
            dst[(size_t)gdn_row(b, dir, n, i) * (GH * GDV) + h * 64 + e] = o; }
        for (int d = 0; d < 64; ++d) for (int e = 0; e < 64; ++e) { float sn = gam * Sm[d][e]; for (int i = 0; i < 64; ++i) sn += ch[4 * 4096 + d * 64 + i] * Vn[i][e]; Sm[d][e] = sn; }
    }
}
#else
template <int... Is, class F> __device__ __forceinline__ void static_for_impl(std::integer_sequence<int, Is...>, F&& f) { (f(std::integral_constant<int, Is>{}), ...); }
template <int N, class F> __device__ __forceinline__ void static_for(F&& f) { static_for_impl(std::make_integer_sequence<int, N>{}, f); }
__device__ __forceinline__ float bf_lo(unsigned u) { return __builtin_bit_cast(float, u << 16); }
__device__ __forceinline__ float bf_hi(unsigned u) { return __builtin_bit_cast(float, u & 0xffff0000u); }
template <int ROLE>
__device__ __forceinline__ void gdn_pre_role(const Params& p, int pair, LAS unsigned char* lds, const int lane, const int wave) {
    constexpr int AST = 68;
    const int l31 = lane & 31, hh = lane >> 5;
    const int item = pair * 2 + (wave >> 1);
    const int c = item / NCH, n = item % NCH, dir = c & 1, h = (c >> 1) % GH, b = (c >> 1) / GH;
    LAS float* At = (LAS float*)(lds + (wave >> 1) * 18432); LAS float* gcs = At + 64 * AST; LAS float* bts = gcs + 64; LAS float* ebt = bts + 64;
    st_t* ch = p.CH() + (size_t)item * 5 * 4096;
    const int row0 = gdn_row(b, dir, n, 0); const int sgn = dir == 0 ? 1 : -1;
    const int myrow = row0 + sgn * lane;
    float gc = p.BG()[(size_t)myrow * 24 + 12 + dir * 6 + h]; const float beta = p.BG()[(size_t)myrow * 24 + dir * 6 + h];
#pragma unroll
    for (int o = 1; o < 64; o <<= 1) { const float t = __shfl_up(gc, o); if (lane >= o) gc += t; }
    const float gc63 = __shfl(gc, 63);
    __syncthreads();
    if (ROLE == 0) { gcs[lane] = gc; bts[lane] = beta; ebt[lane] = beta * __expf(gc); }
    const st_t* gbase = p.G() + h * 64;
    f32x16 d00, d10, d11;
#pragma unroll
    for (int r = 0; r < 16; ++r) { d00[r] = 0.f; d10[r] = 0.f; d11[r] = 0.f; }
    { const size_t r0 = (size_t)(row0 + sgn * l31) * GQKV, r1 = (size_t)(row0 + sgn * (32 + l31)) * GQKV; constexpr int xo = ROLE == 0 ? 384 : 0;
#pragma unroll
      for (int ks = 0; ks < 4; ++ks) {
          const bf16x8 a0 = *(const bf16x8*)(gbase + r0 + xo + 16 * ks + 8 * hh), a1 = *(const bf16x8*)(gbase + r1 + xo + 16 * ks + 8 * hh);
          const bf16x8 b0 = *(const bf16x8*)(gbase + r0 + 384 + 16 * ks + 8 * hh), b1 = *(const bf16x8*)(gbase + r1 + 384 + 16 * ks + 8 * hh);
          d00 = __builtin_amdgcn_mfma_f32_32x32x16_bf16(a0, b0, d00, 0, 0, 0); d10 = __builtin_amdgcn_mfma_f32_32x32x16_bf16(a1, b0, d10, 0, 0, 0); d11 = __builtin_amdgcn_mfma_f32_32x32x16_bf16(a1, b1, d11, 0, 0, 0); } }
    __syncthreads();
    auto post = [&](const f32x16& d, int ib, int jb) __attribute__((always_inline)) {
        const int j = 32 * jb + l31; const float gcj = gcs[j];
#pragma unroll
        for (int g = 0; g < 4; ++g) { const int i0 = 32 * ib + 8 * g + 4 * hh; const f32x4 gci = *(const LAS f32x4*)(gcs + i0);
            if (ROLE == 0) { const f32x4 bi = *(const LAS f32x4*)(bts + i0); f32x4 o;
#pragma unroll
                for (int u = 0; u < 4; ++u) o[u] = (j < i0 + u) ? bi[u] * d[4 * g + u] * __expf(gci[u] - gcj) : 0.f;
                *(LAS f32x4*)(At + j * AST + i0) = o; }
            else {
#pragma unroll
                for (int u = 0; u < 4; ++u) { const float v = (j <= i0 + u) ? 0.125f * d[4 * g + u] * __expf(gci[u] - gcj) : 0.f; stf(ch + 3 * 4096 + (i0 + u) * 64 + j, v); } } }
    };
    post(d00, 0, 0); post(d10, 1, 0); post(d11, 1, 1);
    if (ROLE == 1) {
#pragma unroll
        for (int r = 0; r < 16; ++r) stf(ch + 3 * 4096 + crow16(r, hh) * 64 + 32 + l31, 0.f); }
    __syncthreads();
    float acc[64];
#pragma unroll
    for (int i = 0; i < 64; ++i) acc[i] = 0.f;
    { const long long stp = (long long)sgn * GQKV;
      const st_t* sp = gbase + (ROLE == 0 ? 768 : 384) + lane + (size_t)row0 * GQKV;
      const LAS float* sc = ROLE == 0 ? bts : ebt;
      float cur[8], pre[8];
#pragma unroll
      for (int u = 0; u < 8; ++u) { cur[u] = ldf(sp + u * stp); pre[u] = ldf(sp + (8 + u) * stp); }
      unsigned pk[4]; f32x4 s4 = (f32x4){0.f, 0.f, 0.f, 0.f}; float xprev = 0.f;
      static_for<64>([&](auto jc) __attribute__((always_inline)) {
          constexpr int j = decltype(jc)::value;
          if constexpr ((j & 7) == 0 && j > 0) {
#pragma unroll
              for (int u = 0; u < 8; ++u) cur[u] = pre[u];
              if constexpr (j + 8 < 64) { const st_t* gp = sp + (j + 8) * stp; asm volatile("" : "+v"(gp));
#pragma unroll
                  for (int u = 0; u < 8; ++u) pre[u] = ldf(gp + u * stp); }
          }
          if constexpr ((j & 3) == 0) s4 = *(const LAS f32x4*)(sc + j);
          const float x = s4[j & 3] * cur[j & 7] - acc[j];
          if constexpr (ROLE == 0) {
              if constexpr ((j & 1) == 1) pk[(j >> 1) & 3] = pk_bf16(xprev, x);
              if constexpr ((j & 7) == 7) { u32x4 w; w.x = pk[0]; w.y = pk[1]; w.z = pk[2]; w.w = pk[3]; *(u32x4*)(ch + 0 * 4096 + lane * 64 + (j - 7)) = w; }
          } else stf(ch + 1 * 4096 + j * 64 + lane, x);
          xprev = x;
          constexpr int I0 = ((j + 1) >> 2) << 2;
#pragma unroll
          for (int i4 = I0; i4 < 64; i4 += 4) { const f32x4 av = *(const LAS f32x4*)(At + j * AST + i4);
#pragma unroll
              for (int u = 0; u < 4; ++u) if (i4 + u > j) acc[i4 + u] += av[u] * x;
              asm volatile("" : "+v"(acc[i4]), "+v"(acc[i4 + 1]), "+v"(acc[i4 + 2]), "+v"(acc[i4 + 3])); }
          __builtin_amdgcn_sched_barrier(0);
      }); }
    { const st_t* src = gbase + (size_t)myrow * GQKV + (ROLE == 0 ? 384 : 0); const float sc = ROLE == 0 ? __expf(gc63 - gc) : 0.125f * __expf(gc);
#pragma unroll
      for (int c8 = 0; c8 < 8; ++c8) { const u32x4 w = *(const u32x4*)(src + 8 * c8);
          const float f0 = bf_lo(w.x) * sc, f1 = bf_hi(w.x) * sc, f2 = bf_lo(w.y) * sc, f3 = bf_hi(w.y) * sc, f4 = bf_lo(w.z) * sc, f5 = bf_hi(w.z) * sc, f6 = bf_lo(w.w) * sc, f7 = bf_hi(w.w) * sc;
          if (ROLE == 0) { st_t* kt = ch + 4 * 4096 + (8 * c8) * 64 + lane; stf(kt, f0); stf(kt + 64, f1); stf(kt + 128, f2); stf(kt + 192, f3); stf(kt + 256, f4); stf(kt + 320, f5); stf(kt + 384, f6); stf(kt + 448, f7); }
          else { u32x4 o; o.x = pk_bf16(f0, f1); o.y = pk_bf16(f2, f3); o.z = pk_bf16(f4, f5); o.w = pk_bf16(f6, f7); *(u32x4*)(ch + 2 * 4096 + lane * 64 + 8 * c8) = o; } } }
    if (ROLE == 0 && lane == 0) p.GAM()[item] = __expf(gc63);
}
static_assert((NCHAIN * NCH) % 2 == 0, "chunk items come in pairs");
__device__ __forceinline__ void gdn_pre_dev(const Params& p, int pair, LAS unsigned char* lds, const int tid) {
    const int lane = tid & 63, wave = __builtin_amdgcn_readfirstlane(tid >> 6);
    if ((wave & 1) == 0) gdn_pre_role<0>(p, pair, lds, lane, wave); else gdn_pre_role<1>(p, pair, lds, lane, wave);
}
__device__ __forceinline__ void gdn_scan_dev(const Params& p, int c, LAS unsigned char* lds, const int tid) {
    constexpr int RS = 136, MB = 64 * RS;
    const int lane = tid & 63, wave = __builtin_amdgcn_readfirstlane(tid >> 6), r16 = lane & 15, q = lane >> 4;
    const int dir = c & 1, h = (c >> 1) % GH, b = (c >> 1) / GH; st_t* dst = (dir == 0 ? p.OF() : p.OB()) + h * 64 + 16 * wave + r16;
    f32x4 Sb[4];
#pragma unroll
    for (int i = 0; i < 4; ++i) Sb[i] = (f32x4){0.f, 0.f, 0.f, 0.f};
    u32x4 stg[10]; float gam_next = 0.f;
    auto gload = [&](int n) { const u32x4* src = (const u32x4*)(p.CH() + (size_t)(c * NCH + n) * 5 * 4096);
#pragma unroll
        for (int u = 0; u < 10; ++u) stg[u] = src[tid + 256 * u];
        gam_next = p.GAM()[c * NCH + n]; };
    auto lstore = [&]() {
#pragma unroll
        for (int u = 0; u < 10; ++u) { const int ci = tid + 256 * u, mat = ci >> 9, row = (ci >> 3) & 63, cc = ci & 7; LAS u32x2* d = (LAS u32x2*)(lds + mat * MB + row * RS + cc * 16);
            d[0] = (u32x2){stg[u].x, stg[u].y}; d[1] = (u32x2){stg[u].z, stg[u].w}; } };
    auto afrag = [&](int mat, int row, int a2) -> bf16x8 { const LAS unsigned char* bp = lds + mat * MB + row * RS + (32 * a2 + 4 * q) * 2;
        const u32x2 lo = *(const LAS u32x2*)bp, hi = *(const LAS u32x2*)(bp + 32); u32x4 w; w.x = lo.x; w.y = lo.y; w.z = hi.x; w.w = hi.y; return __builtin_bit_cast(bf16x8, w); };
    auto pack2 = [&](const f32x4& x, const f32x4& y) -> bf16x8 { u32x4 w; w.x = pk_bf16(x[0], x[1]); w.y = pk_bf16(x[2], x[3]); w.z = pk_bf16(y[0], y[1]); w.w = pk_bf16(y[2], y[3]); return __builtin_bit_cast(bf16x8, w); };
    __syncthreads();
    gload(0); lstore(); float gam = gam_next;
    __syncthreads();
    for (int n = 0; n < NCH; ++n) {
        if (n + 1 < NCH) gload(n + 1);
        const bf16x8 sb0 = pack2(Sb[0], Sb[1]), sb1 = pack2(Sb[2], Sb[3]);
        f32x4 vn[4], oc[4];
#pragma unroll
        for (int tb = 0; tb < 4; ++tb) {
            f32x4 acc = (f32x4){0.f, 0.f, 0.f, 0.f};
            acc = __builtin_amdgcn_mfma_f32_16x16x32_bf16(afrag(1, 16 * tb + r16, 0), sb0, acc, 0, 0, 0);
            acc = __builtin_amdgcn_mfma_f32_16x16x32_bf16(afrag(1, 16 * tb + r16, 1), sb1, acc, 0, 0, 0);
            const u32x2 uu = *(const LAS u32x2*)(lds + 0 * MB + (16 * wave + r16) * RS + (16 * tb + 4 * q) * 2);
            vn[tb][0] = bf_lo(uu.x) - acc[0]; vn[tb][1] = bf_hi(uu.x) - acc[1]; vn[tb][2] = bf_lo(uu.y) - acc[2]; vn[tb][3] = bf_hi(uu.y) - acc[3];
            f32x4 o = (f32x4){0.f, 0.f, 0.f, 0.f};
            o = __builtin_amdgcn_mfma_f32_16x16x32_bf16(afrag(2, 16 * tb + r16, 0), sb0, o, 0, 0, 0);
            o = __builtin_amdgcn_mfma_f32_16x16x32_bf16(afrag(2, 16 * tb + r16, 1), sb1, o, 0, 0, 0);
            oc[tb] = o;
        }
        const bf16x8 vb0 = pack2(vn[0], vn[1]), vb1 = pack2(vn[2], vn[3]);
#pragma unroll
        for (int tb = 0; tb < 4; ++tb) {
            f32x4 o = oc[tb];
            o = __builtin_amdgcn_mfma_f32_16x16x32_bf16(afrag(3, 16 * tb + r16, 0), vb0, o, 0, 0, 0);
            o = __builtin_amdgcn_mfma_f32_16x16x32_bf16(afrag(3, 16 * tb + r16, 1), vb1, o, 0, 0, 0);
#pragma unroll
            for (int u = 0; u < 4; ++u) stf(dst + (size_t)gdn_row(b, dir, n, 16 * tb + 4 * q + u) * (GH * GDV), o[u]);
        }
#pragma unroll
        for (int db = 0; db < 4; ++db) {
            f32x4 sn = Sb[db] * gam;
            sn = __builtin_amdgcn_mfma_f32_16x16x32_bf16(afrag(4, 16 * db + r16, 0), vb0, sn, 0, 0, 0);
            sn = __builtin_amdgcn_mfma_f32_16x16x32_bf16(afrag(4, 16 * db + r16, 1), vb1, sn, 0, 0, 0);
            Sb[db] = sn;
        }
        __syncthreads();
        if (n + 1 < NCH) { lstore(); gam = gam_next; }
        __syncthreads();
    }
}
#endif


#ifndef HOST_EMU
enum { R_NORM1 = 0, R_POST1 = 1, R_POST2 = 2, R_XFORM = 3, R_GOUT = 4, R_ROUTE2 = 5 };
__device__ __forceinline__ float wave_sum(float v) {
#pragma unroll
    for (int o = 32; o > 0; o >>= 1) v += __shfl_xor(v, o);
    return v;
}
__device__ __forceinline__ void ld_row_f32(const float* p, int lane, f32x4 (&v)[D / 256]) {
#pragma unroll
    for (int j = 0; j < D / 256; ++j) v[j] = *(const f32x4*)(p + 4 * lane + 256 * j); }
__device__ __forceinline__ void ld_row_bf16(const st_t* p, int lane, f32x4 (&v)[D / 256]) {
#pragma unroll
    for (int j = 0; j < D / 256; ++j) { const u32x2 w = *(const u32x2*)(p + 4 * lane + 256 * j); v[j] = (f32x4){bf_lo(w.x), bf_hi(w.x), bf_lo(w.y), bf_hi(w.y)}; } }
__device__ __forceinline__ void st_row_bf16(st_t* p, int lane, const f32x4 (&v)[D / 256]) {
#pragma unroll
    for (int j = 0; j < D / 256; ++j) st4(p + 4 * lane + 256 * j, v[j][0], v[j][1], v[j][2], v[j][3]); }
__device__ __forceinline__ float sumsq(const f32x4 (&v)[D / 256]) { float s = 0.f;
#pragma unroll
    for (int j = 0; j < D / 256; ++j) s += (v[j][0] * v[j][0] + v[j][1] * v[j][1]) + (v[j][2] * v[j][2] + v[j][3] * v[j][3]);
    return wave_sum(s); }
template <bool TO_LDS>
__device__ __forceinline__ void modulate_store(const f32x4 (&x)[D / 256], float rstd, const float* gain, const float* sc, const float* sh, st_t* hrow, int lane, LAS float* hl) {
    f32x4 g[D / 256], a[D / 256], b[D / 256], h[D / 256]; ld_row_f32(gain, lane, g); ld_row_f32(sc, lane, a); ld_row_f32(sh, lane, b);
#pragma unroll
    for (int j = 0; j < D / 256; ++j) h[j] = x[j] * rstd * g[j] * (a[j] + 1.0f) + b[j];
    st_row_bf16(hrow, lane, h);
    if constexpr (TO_LDS) {
#pragma unroll
        for (int j = 0; j < D / 256; ++j) *(LAS f32x4*)(hl + 4 * lane + 256 * j) = h[j]; }
}
__device__ __forceinline__ void row_norm1(const Params& p, int layer, int r, int lane) {
    f32x4 x[D / 256]; ld_row_f32(xin_row(p, layer, r), lane, x);
    const float rstd = rsqrt_f(sumsq(x) / D + EPS);
    modulate_store<false>(x, rstd, p.mix_norm_pre + (size_t)layer * D, mod_vec(p, layer, r, 1), mod_vec(p, layer, r, 0), p.H() + (size_t)r * D, lane, (LAS float*)0);
}
__device__ __forceinline__ void route_pick(const Params& p, int layer, int r, int lane, float logit, LAS int* lcnt);
__device__ __forceinline__ void row_post1_pair(const Params& p, int layer, int pair, int lane, LAS float* hl, LAS int* lcnt) {
#pragma unroll
    for (int rr = 0; rr < 2; ++rr) { const int r = 2 * pair + rr;
        f32x4 y[D / 256], x[D / 256], g1[D / 256], gp[D / 256]; ld_row_bf16(p.Y() + (size_t)r * D, lane, y); ld_row_f32(xin_row(p, layer, r), lane, x);
        ld_row_f32(mod_vec(p, layer, r, 2), lane, g1); ld_row_f32(p.mix_norm_post + (size_t)layer * D, lane, gp);
        const float rstd = rsqrt_f(sumsq(y) / D + EPS);
#pragma unroll
        for (int j = 0; j < D / 256; ++j) x[j] = x[j] + g1[j] * y[j] * rstd * gp[j];
        float* xr = xrow(p, r);
#pragma unroll
        for (int j = 0; j < D / 256; ++j) *(f32x4*)(xr + 4 * lane + 256 * j) = x[j];
        const float r2 = rsqrt_f(sumsq(x) / D + EPS);
        modulate_store<true>(x, r2, p.ffn_norm_pre + (size_t)layer * D, mod_vec(p, layer, r, 4), mod_vec(p, layer, r, 3), p.H() + (size_t)r * D, lane, hl + rr * D);
    }
    asm volatile("s_waitcnt lgkmcnt(0)" ::: "memory");
    const float* wr = p.router_w + (size_t)layer * D * NE + lane; float a0 = 0.f, a1 = 0.f;
#pragma unroll 4
    for (int d4 = 0; d4 < D / 4; ++d4) { const f32x4 h0 = *(const LAS f32x4*)(hl + 4 * d4), h1 = *(const LAS f32x4*)(hl + D + 4 * d4);
#pragma unroll
        for (int u = 0; u < 4; ++u) { const float w = wr[(size_t)(4 * d4 + u) * NE]; a0 += h0[u] * w; a1 += h1[u] * w; } }
    route_pick(p, layer, 2 * pair, lane, a0, lcnt); route_pick(p, layer, 2 * pair + 1, lane, a1, lcnt);
    asm volatile("s_waitcnt lgkmcnt(0)" ::: "memory");
}
__device__ __forceinline__ void route_row(const Params& p, int layer, int r, int lane, float logit) {
    const float sg = sigmoid_f(logit), v = sg + p.router_bias[(size_t)layer * NE + lane];
    float m1 = v; int i1 = lane;
#pragma unroll
    for (int o = 1; o < 8; o <<= 1) { const float ov = __shfl_xor(m1, o); const int oi = __shfl_xor(i1, o); if (ov > m1 || (ov == m1 && oi < i1)) { m1 = ov; i1 = oi; } }
    float m2 = lane == i1 ? -3.0e38f : v;
#pragma unroll
    for (int o = 1; o < 8; o <<= 1) m2 = fmaxf(m2, __shfl_xor(m2, o));
    const float gs = m1 + m2; const int grp = lane >> 3;
    int grank = 0;
#pragma unroll
    for (int j = 0; j < NGRP; ++j) { const float og = __shfl(gs, j * 8); grank += (og > gs || (og == gs && j < grp)) ? 1 : 0; }
    const float mv = grank < TOPG ? v : -3.0e38f;
    int rank = 0;
#pragma unroll
    for (int j = 0; j < NE; ++j) { const float ov = __shfl(mv, j); rank += (ov > mv || (ov == mv && j < lane)) ? 1 : 0; }
    const bool sel = rank < TOPK;
    const float wsum = wave_sum(sel ? sg : 0.f);
    if (sel) { const float w = sg / wsum * ROUTED_SCALE; const int pos = atomicAdd(p.CNT() + layer * NE + lane, 1); atomicAdd(p.CNTP() + (layer * NE + lane) * 32, 1);
        p.EIDX()[(size_t)r * TOPK + rank] = lane; p.EPOS()[(size_t)r * TOPK + rank] = pos; p.TOKLIST()[(size_t)lane * TA + pos] = r; p.WLIST()[(size_t)lane * TA + pos] = w; }
}
__device__ __forceinline__ void row_post1_quad(const Params& p, int layer, int quad, int lane, LAS float* hl) {
#pragma unroll
    for (int rr = 0; rr < 4; ++rr) { const int r = 4 * quad + rr;
        f32x4 y[D / 256], x[D / 256], g1[D / 256], gp[D / 256]; ld_row_bf16(p.Y() + (size_t)r * D, lane, y); ld_row_f32(xin_row(p, layer, r), lane, x);
        ld_row_f32(mod_vec(p, layer, r, 2), lane, g1); ld_row_f32(p.mix_norm_post + (size_t)layer * D, lane, gp);
        const float rstd = rsqrt_f(sumsq(y) / D + EPS);
#pragma unroll
        for (int j = 0; j < D / 256; ++j) x[j] = x[j] + g1[j] * y[j] * rstd * gp[j];
        float* xr = xrow(p, r);
#pragma unroll
        for (int j = 0; j < D / 256; ++j) *(f32x4*)(xr + 4 * lane + 256 * j) = x[j];
        const float r2 = rsqrt_f(sumsq(x) / D + EPS);
        modulate_store<true>(x, r2, p.ffn_norm_pre + (size_t)layer * D, mod_vec(p, layer, r, 4), mod_vec(p, layer, r, 3), p.H() + (size_t)r * D, lane, hl + rr * D);
    }
    asm volatile("s_waitcnt lgkmcnt(0)" ::: "memory");
    const float* wr = p.router_w + (size_t)layer * D * NE + lane; float a0 = 0.f, a1 = 0.f, a2 = 0.f, a3 = 0.f;
#pragma unroll 4
    for (int d4 = 0; d4 < D / 4; ++d4) { const f32x4 h0 = *(const LAS f32x4*)(hl + 4 * d4), h1 = *(const LAS f32x4*)(hl + D + 4 * d4), h2 = *(const LAS f32x4*)(hl + 2 * D + 4 * d4), h3 = *(const LAS f32x4*)(hl + 3 * D + 4 * d4);
#pragma unroll
        for (int u = 0; u < 4; ++u) { const float w = wr[(size_t)(4 * d4 + u) * NE]; a0 += h0[u] * w; a1 += h1[u] * w; a2 += h2[u] * w; a3 += h3[u] * w; } }
    route_row(p, layer, 4 * quad, lane, a0); route_row(p, layer, 4 * quad + 1, lane, a1); route_row(p, layer, 4 * quad + 2, lane, a2); route_row(p, layer, 4 * quad + 3, lane, a3);
    asm volatile("s_waitcnt lgkmcnt(0)" ::: "memory");
}
__device__ __forceinline__ void route_pick(const Params& p, int layer, int r, int lane, float logit, LAS int* lcnt) {
    const float sg = sigmoid_f(logit), v = sg + p.router_bias[(size_t)layer * NE + lane];
    float m1 = v; int i1 = lane;
#pragma unroll
    for (int o = 1; o < 8; o <<= 1) { const float ov = __shfl_xor(m1, o); const int oi = __shfl_xor(i1, o); if (ov > m1 || (ov == m1 && oi < i1)) { m1 = ov; i1 = oi; } }
    float m2 = lane == i1 ? -3.0e38f : v;
#pragma unroll
    for (int o = 1; o < 8; o <<= 1) m2 = fmaxf(m2, __shfl_xor(m2, o));
    const float gs = m1 + m2; const int grp = lane >> 3;
    int grank = 0;
#pragma unroll
    for (int j = 0; j < NGRP; ++j) { const float og = __builtin_bit_cast(float, __builtin_amdgcn_readlane(__builtin_bit_cast(int, gs), j * 8)); grank += (og > gs || (og == gs && j < grp)) ? 1 : 0; }
    const float mv = grank < TOPG ? v : -3.0e38f;
    int rank = 0;
#pragma unroll
    for (int j = 0; j < NE; ++j) { const float ov = __builtin_bit_cast(float, __builtin_amdgcn_readlane(__builtin_bit_cast(int, mv), j)); rank += (ov > mv || (ov == mv && j < lane)) ? 1 : 0; }
    const bool sel = rank < TOPK;
    const float wsum = wave_sum(sel ? sg : 0.f);
    if (sel) { p.EIDX()[(size_t)r * TOPK + rank] = lane; p.EW()[(size_t)r * TOPK + rank] = sg / wsum * ROUTED_SCALE; __hip_atomic_fetch_add(lcnt + lane, 1, __ATOMIC_RELAXED, __HIP_MEMORY_SCOPE_WORKGROUP); }
}
__device__ __forceinline__ void route_place(const Params& p, int layer, LAS unsigned char* lds, int tid, int lane, int wave) {
    LAS int* pb = (LAS int*)lds; LAS int* lpos = pb + NE;
    __syncthreads();
    if (tid < NE) { int below = 0, tot = 0; const int* bc = p.BCNT() + tid;
        for (int b2 = 0; b2 < (int)gridDim.x; ++b2) { const int c = bc[(size_t)b2 * NE]; tot += c; below += b2 < (int)blockIdx.x ? c : 0; }
        pb[tid] = below; lpos[tid] = 0; if (blockIdx.x == 0) p.CNT()[layer * NE + tid] = tot; }
    __syncthreads();
    const int gw = blockIdx.x * 4 + wave, nw = gridDim.x * 4;
    for (int i = gw; i < rows_out(layer) / 2; i += nw) {
        if (lane < 2 * TOPK) { const int r = 2 * i + (lane >> 3), k = lane & 7; const int e = p.EIDX()[(size_t)r * TOPK + k]; const float w = p.EW()[(size_t)r * TOPK + k];
            const int pos = pb[e] + __hip_atomic_fetch_add(lpos + e, 1, __ATOMIC_RELAXED, __HIP_MEMORY_SCOPE_WORKGROUP);
            p.EPOS()[(size_t)r * TOPK + k] = pos; p.TOKLIST()[(size_t)e * TA + pos] = r; p.WLIST()[(size_t)e * TA + pos] = w; }
    }
}
__device__ __forceinline__ void row_post2(const Params& p, int layer, int r, int lane, const int* eb) {
    int slot = 0;
    if (lane < TOPK) { const int e = p.EIDX()[(size_t)r * TOPK + lane]; slot = eb[e] + p.EPOS()[(size_t)r * TOPK + lane]; }
    f32x4 f[D / 256]; ld_row_bf16(p.SH() + (size_t)r * D, lane, f);
#pragma unroll
    for (int k = 0; k < TOPK; ++k) { const int sk = __shfl(slot, k); f32x4 t[D / 256]; ld_row_bf16(p.YB() + (size_t)sk * D, lane, t);
#pragma unroll
        for (int j = 0; j < D / 256; ++j) f[j] += t[j]; }
    const float rstd = rsqrt_f(sumsq(f) / D + EPS);
    float* xr = xrow(p, r); f32x4 x[D / 256], g2[D / 256], gp[D / 256]; ld_row_f32(xr, lane, x); ld_row_f32(mod_vec(p, layer, r, 5), lane, g2); ld_row_f32(p.ffn_norm_post + (size_t)layer * D, lane, gp);
#pragma unroll
    for (int j = 0; j < D / 256; ++j) { x[j] = x[j] + g2[j] * f[j] * rstd * gp[j]; *(f32x4*)(xr + 4 * lane + 256 * j) = x[j]; }
    if (layer + 1 < DEPTH) { const float r2 = rsqrt_f(sumsq(x) / D + EPS);
        modulate_store<false>(x, r2, p.mix_norm_pre + (size_t)(layer + 1) * D, mod_vec(p, layer + 1, r, 1), mod_vec(p, layer + 1, r, 0), p.H() + (size_t)r * D, lane, (LAS float*)0); }
}
__device__ __forceinline__ void unpack8(const u32x4 w, float (&x)[8]) { x[0] = bf_lo(w.x); x[1] = bf_hi(w.x); x[2] = bf_lo(w.y); x[3] = bf_hi(w.y); x[4] = bf_lo(w.z); x[5] = bf_hi(w.z); x[6] = bf_lo(w.w); x[7] = bf_hi(w.w); }
__device__ __forceinline__ u32x4 pack8(const float (&x)[8]) { u32x4 o; o.x = pk_bf16(x[0], x[1]); o.y = pk_bf16(x[2], x[3]); o.z = pk_bf16(x[4], x[5]); o.w = pk_bf16(x[6], x[7]); return o; }
__device__ __forceinline__ void row_xform(const Params& p, int layer, int r, int lane, const LAS float* cw) {
    int lo, hi; seq_bounds(r, lo, hi);
    const st_t* prow = p.P() + (size_t)r * DPROJP;
#pragma unroll
    for (int gi = 0; gi < 3; ++gi) {
        if (gi < 2 || lane < 16) {
            const int c0 = 8 * (lane + 64 * gi); float acc[8];
#pragma unroll
            for (int e = 0; e < 8; ++e) acc[e] = 0.f;
#pragma unroll
            for (int j = 0; j < GCONV; ++j) { const int rr = r + j - 2;
                if (rr >= lo && rr < hi) { float x[8]; unpack8(*(const u32x4*)(p.P() + (size_t)rr * DPROJP + PO_GQKV + c0), x);
                    const f32x4 w0 = *(const LAS f32x4*)(cw + j * GQKV + c0), w1 = *(const LAS f32x4*)(cw + j * GQKV + c0 + 4);
#pragma unroll
                    for (int e = 0; e < 4; ++e) { acc[e] += w0[e] * x[e]; acc[4 + e] += w1[e] * x[4 + e]; } } }
            float ss = 0.f;
#pragma unroll
            for (int e = 0; e < 8; ++e) { acc[e] = silu_f(acc[e]); ss += acc[e] * acc[e]; }
            if (gi < 2) {
                ss += __shfl_xor(ss, 1); ss += __shfl_xor(ss, 2); ss += __shfl_xor(ss, 4);
                const float rn = c0 < 2 * GH * GDK ? rsqrt_f(ss + EPS) : 1.0f;
#pragma unroll
                for (int e = 0; e < 8; ++e) acc[e] *= rn; }
            *(u32x4*)(p.G() + (size_t)r * GQKV + c0) = pack8(acc);
        }
    }
    if (lane < 12) { const float beta = sigmoid_f(ldf(prow + PO_BA + lane)), a = ldf(prow + PO_BA + 12 + lane);
        p.BG()[(size_t)r * 24 + lane] = beta; p.BG()[(size_t)r * 24 + 12 + lane] = -expf(p.gdn_a_log[layer * 12 + lane]) * softplus_f(a + p.gdn_dt_bias[layer * 12 + lane]); }
    { float x[8]; float ss = 0.f;
      if (lane < MQR / 8) { unpack8(*(const u32x4*)(prow + PO_CQ + 8 * lane), x);
#pragma unroll
          for (int e = 0; e < 8; ++e) ss += x[e] * x[e]; }
      const float rstd = rsqrt_f(wave_sum(ss) / MQR + EPS);
      if (lane < MQR / 8) { const float* gn = p.mla_q_norm + (size_t)layer * MQR + 8 * lane;
#pragma unroll
          for (int e = 0; e < 8; ++e) x[e] = x[e] * rstd * gn[e];
          *(u32x4*)(p.CQN() + (size_t)r * MQR + 8 * lane) = pack8(x); } }
    { float x[8]; float ss = 0.f;
      if (lane < MKVR / 8) { unpack8(*(const u32x4*)(prow + PO_CKV + 8 * lane), x);
#pragma unroll
          for (int e = 0; e < 8; ++e) ss += x[e] * x[e]; }
      const float rstd = rsqrt_f(wave_sum(ss) / MKVR + EPS);
      if (lane < MKVR / 8) { const float* gn = p.mla_kv_norm + (size_t)layer * MKVR + 8 * lane;
#pragma unroll
          for (int e = 0; e < 8; ++e) x[e] = x[e] * rstd * gn[e];
          *(u32x4*)(p.CKVN() + (size_t)r * MKVR + 8 * lane) = pack8(x); } }
}
__device__ __forceinline__ void row_mla_merge(const Params& p, int r, int lane) {
    if (NSPLIT == 1 || r >= T || lane >= MH * MV / 8) return;
    const int h = lane / (MV / 8); float mc[NSPLIT], lc[NSPLIT], mx = -3.0e38f;
#pragma unroll
    for (int c = 0; c < NSPLIT; ++c) { const float* ml = p.MLPART() + (((size_t)c * T + r) * MH + h) * 2; mc[c] = ml[0]; lc[c] = ml[1]; mx = fmaxf(mx, mc[c]); }
    float o[8], wsum = 0.f;
#pragma unroll
    for (int e = 0; e < 8; ++e) o[e] = 0.f;
#pragma unroll
    for (int c = 0; c < NSPLIT; ++c) { const float w = lc[c] * __builtin_amdgcn_exp2f(mc[c] - mx); wsum += w; float x[8]; unpack8(*(const u32x4*)(p.OPART() + ((size_t)c * T + r) * MH * MV + 8 * lane), x);
#pragma unroll
        for (int e = 0; e < 8; ++e) o[e] += w * x[e]; }
    const float inv = __builtin_amdgcn_rcpf(wsum);
#pragma unroll
    for (int e = 0; e < 8; ++e) o[e] *= inv;
    *(u32x4*)(p.O() + (size_t)r * DMIX + (SWA_H + GH) * 64 + 8 * lane) = pack8(o);
}
__device__ __forceinline__ void row_gout(const Params& p, int layer, int r, int lane) {
    row_mla_merge(p, r, lane);
    float o[8]; float ss = 0.f; const bool act = lane < GH * GDV / 8;
    if (act) { float a[8], b[8]; unpack8(*(const u32x4*)(p.OF() + (size_t)r * (GH * GDV) + 8 * lane), a); unpack8(*(const u32x4*)(p.OB() + (size_t)r * (GH * GDV) + 8 * lane), b);
#pragma unroll
        for (int e = 0; e < 8; ++e) { o[e] = a[e] + b[e]; ss += o[e] * o[e]; } }
    ss += __shfl_xor(ss, 1); ss += __shfl_xor(ss, 2); ss += __shfl_xor(ss, 4);
    if (act) { const float rstd = rsqrt_f(ss / GDV + EPS); float z[8]; unpack8(*(const u32x4*)(p.P() + (size_t)r * DPROJP + PO_Z + 8 * lane), z);
        const float* nw = p.gdn_norm_w + layer * GDV + (8 * lane) % GDV;
#pragma unroll
        for (int e = 0; e < 8; ++e) o[e] = o[e] * rstd * nw[e] * silu_f(z[e]);
        *(u32x4*)(p.O() + (size_t)r * DMIX + GH * GDV + 8 * lane) = pack8(o); }
}
__device__ __forceinline__ void mod_block(const Params& p, int item, LAS unsigned char* lds, int tid) {
    const int lane = tid & 63, wave = __builtin_amdgcn_readfirstlane(tid >> 6); const int ly = item / (6 * D / 64), jb = item % (6 * D / 64);
    LAS float* sl = (LAS float*)lds; LAS float* red = sl + 3 * D;
    __syncthreads();
    for (int i = tid; i < 3 * D; i += 256) { const int w = i / D, k = i % D; sl[i] = silu_f(w < 2 ? p.c[(size_t)w * D + k] : p.c_ctx[k]); }
    __syncthreads();
    const float* W = p.ada_w + (size_t)ly * D * 6 * D + jb * 64 + lane; float a0 = 0.f, a1 = 0.f, a2 = 0.f;
#pragma unroll 8
    for (int k = wave * (D / 4); k < (wave + 1) * (D / 4); ++k) { const float w = W[(size_t)k * 6 * D]; a0 += sl[k] * w; a1 += sl[D + k] * w; a2 += sl[2 * D + k] * w; }
    red[(wave * 3 + 0) * 64 + lane] = a0; red[(wave * 3 + 1) * 64 + lane] = a1; red[(wave * 3 + 2) * 64 + lane] = a2;
    __syncthreads();
    if (wave < 3) { const float v = red[(0 * 3 + wave) * 64 + lane] + red[(1 * 3 + wave) * 64 + lane] + red[(2 * 3 + wave) * 64 + lane] + red[(3 * 3 + wave) * 64 + lane];
        p.MOD()[((size_t)(ly * 3 + wave) * 6 * D) + jb * 64 + lane] = v + p.ada_b[(size_t)ly * 6 * D + jb * 64 + lane]; }
}
#endif


#ifndef HOST_EMU
#define XB_TMO      128
#define XB_XCNT(j)  (256  + 64 * (j))
#define XB_XSUB(j)  (1280 + 64 * (j))
#define XB_XGEN(j)  (2304 + 64 * (j))
#define XB_TOP      3328
#define XB_TOPGEN   3392
#define XCD_BAR_WORDS 3456
#define XB_SPIN_CAP (1u << 18)

__device__ __forceinline__ unsigned xb_ld(unsigned* p)              { return __hip_atomic_load(p, __ATOMIC_RELAXED, __HIP_MEMORY_SCOPE_AGENT); }
__device__ __forceinline__ unsigned xb_add(unsigned* p, unsigned v) { return __hip_atomic_fetch_add(p, v, __ATOMIC_RELAXED, __HIP_MEMORY_SCOPE_AGENT); }
__device__ __forceinline__ unsigned xb_xcc_id() { return (unsigned)__builtin_amdgcn_s_getreg((3 << 11) | 20) & 0xFu; }
#define XB_SPIN(cond, bar) do { unsigned _sp = 0; while (cond) { __builtin_amdgcn_s_sleep(1); \
    if ((++_sp & 255u) == 0u) { if (xb_ld(&(bar)[XB_TMO])) break; if (_sp > XB_SPIN_CAP) { atomicAdd(&(bar)[XB_TMO], 1u); break; } } } } while (0)

struct XcdBarrier {
    unsigned* bar; unsigned x;
    volatile LAS unsigned* st;
};

__device__ __forceinline__ XcdBarrier xcd_barrier_post(unsigned* bar, volatile LAS unsigned* st) {
    XcdBarrier b; b.bar = bar; b.x = xb_xcc_id(); b.st = st;
    if (threadIdx.x == 0) (void)xb_add(&bar[XB_XCNT(b.x)], 1u);
    return b;
}
__device__ __forceinline__ void xcd_barrier_complete(unsigned* bar, unsigned x, unsigned& nloc, unsigned& nx) {
    const unsigned G = gridDim.x * gridDim.y * gridDim.z;
    unsigned sum, cnt, mine, sp = 0u;
    for (;;) {
        sum = 0u; cnt = 0u; mine = 0u;
#pragma unroll
        for (unsigned j = 0; j < 16; ++j) { const unsigned c = xb_ld(&bar[XB_XCNT(j)]); sum += c; cnt += (c > 0u) ? 1u : 0u; mine = (j == x) ? c : mine; }
        if (sum == G) break;
        __builtin_amdgcn_s_sleep(1);
        if ((++sp & 255u) == 0u) { if (xb_ld(&bar[XB_TMO])) break; if (sp > XB_SPIN_CAP) { atomicAdd(&bar[XB_TMO], 1u); break; } }
    }
    nloc = mine > 0u ? mine : 1u; nx = cnt > 0u ? cnt : 1u;
}

__device__ __forceinline__ void xcd_barrier(const XcdBarrier& b) {
    asm volatile("s_waitcnt vmcnt(0)" ::: "memory");
    __syncthreads();
    if (threadIdx.x == 0) {
        unsigned* bar = b.bar;
        __builtin_amdgcn_s_waitcnt(0);
        unsigned nloc = b.st[0], nx = b.st[1];
        if (nloc == 0u) { xcd_barrier_complete(bar, b.x, nloc, nx); b.st[0] = nloc; b.st[1] = nx; }
        const unsigned old = xb_add(&bar[XB_XSUB(b.x)], 1u);
        const unsigned gen = old / nloc;
        if (old + 1u == (gen + 1u) * nloc) {
            __builtin_amdgcn_fence(__ATOMIC_RELEASE, "agent");
            asm volatile("s_waitcnt vmcnt(0)" ::: "memory");
            const unsigned og = xb_add(&bar[XB_TOP], 1u);
            const unsigned tg = og / nx;
            if (og + 1u == (tg + 1u) * nx) xb_add(&bar[XB_TOPGEN], 1u);
            else XB_SPIN(xb_ld(&bar[XB_TOPGEN]) == tg, bar);
            __builtin_amdgcn_fence(__ATOMIC_ACQUIRE, "agent");
            xb_add(&bar[XB_XGEN(b.x)], 1u);
            asm volatile("s_waitcnt vmcnt(0)" ::: "memory");
        } else {
            XB_SPIN(xb_ld(&bar[XB_XGEN(b.x)]) == gen, bar);
            __builtin_amdgcn_fence(__ATOMIC_ACQUIRE, "agent");
            asm volatile("s_waitcnt vmcnt(0)" ::: "memory");
        }
    }
    __syncthreads();
}

#endif

enum { K_ITEM = 0, K_WT = 1, K_GEMM = 2, K_ATTN = 3, K_GPRE = 4, K_ROW = 5, K_MOD = 6 };
struct Step { int kind, st, layer, sync_before; };
inline int build_program(Step* prog) {
    int n = 0;
    prog[n++] = {K_ITEM, ST_ZERO, 0, 0}; prog[n++] = {K_ITEM, ST_TAB, 0, 0}; prog[n++] = {USE_KMOD ? K_MOD : K_ITEM, USE_KMOD ? 0 : ST_MOD, 0, 0}; prog[n++] = {K_WT, WT_STATIC, 0, 0};
    for (int l = 0; l < DEPTH; ++l) {
        if (l == 0 || !USE_RPOST2) { if (USE_RNORM1) prog[n++] = {K_ROW, 0  , l, 1}; else prog[n++] = {K_ITEM, ST_NORM1, l, 1}; }
        prog[n++] = {K_GEMM, G_PROJ, l, 1};
        prog[n++] = {K_ROW, 3  , l, 1};
        prog[n++] = {K_GEMM, G_UQ, l, 1}; prog[n++] = {K_GEMM, G_UKV, l, 0}; prog[n++] = {K_GPRE, 0, l, 0};
        prog[n++] = {K_ATTN, 0, l, 1};
        prog[n++] = {K_ROW, 4  , l, 1}; prog[n++] = {K_WT, WT_EXPERT, l, 0};
        prog[n++] = {K_GEMM, G_WOUT, l, 1};
        if (USE_RPOST1) { prog[n++] = {K_ROW, 1  , l, 1}; prog[n++] = {K_ROW, 5  , l, 1}; } else { prog[n++] = {K_ITEM, ST_POST1, l, 1}; prog[n++] = {K_ITEM, ST_ROUTER, l, 1}; prog[n++] = {K_ITEM, ST_ROUTE, l, 1}; }
        prog[n++] = {K_GEMM, G_SGU, l, 1}; prog[n++] = {K_GEMM, G_EGU, l, 0};
        prog[n++] = {K_GEMM, G_SDOWN, l, 1}; prog[n++] = {K_GEMM, G_EDOWN, l, 0};
        if (USE_RPOST2) prog[n++] = {K_ROW, 2  , l, 1}; else prog[n++] = {K_ITEM, ST_POST2, l, 1};
    }
    return n;
}
constexpr int MAX_STEPS = 64;

#ifndef HOST_EMU
namespace cg = cooperative_groups;
struct Prog { Step s[MAX_STEPS]; int n; int pad[3]; };

__global__ void __launch_bounds__(256, 2) k_mega(Params p, Prog pr) {
    extern __shared__ __attribute__((aligned(16))) unsigned char smem[];
    LAS unsigned char* lds = (LAS unsigned char*)smem;
    cg::grid_group grid = cg::this_grid();
    { volatile LAS unsigned* bst = (volatile LAS unsigned*)(lds + 65536); if (threadIdx.x < 2) bst[threadIdx.x] = 0u; }
    __syncthreads();
    (void)xcd_barrier_post(p.BAR(), (volatile LAS unsigned*)(lds + 65536));
#define XBAR_NOW() do { XcdBarrier xb_; xb_.bar = p.BAR(); xb_.x = xb_xcc_id(); xb_.st = (volatile LAS unsigned*)(lds + 65536); xcd_barrier(xb_); } while (0)
    bool first_sync = true;
    const long long gthreads = (long long)gridDim.x * 256;
#if PROBE_SEL
    unsigned long long pb_acc = 0, pb_t0 = __builtin_amdgcn_s_memrealtime(); bool pb_on = false;
#endif
    for (int s = 0; s < pr.n; ++s) {
        const int kind = pr.s[s].kind, st = pr.s[s].st, layer = pr.s[s].layer;
#if PROBE_SEL
        const bool pb_match = (PROBE_SEL == 1 && kind == K_ROW && st == 1) || (PROBE_SEL == 2 && ((kind == K_ITEM && st == ST_ROUTE) || (kind == K_ROW && st == 5))) || (PROBE_SEL == 3 && kind == K_ROW && st == 2) || (PROBE_SEL == 4 && kind == K_ROW && st == 3) ||
            (PROBE_SEL == 5 && kind == K_ROW && st == 4) || (PROBE_SEL == 6 && kind == K_ATTN) || (PROBE_SEL == 7 && kind == K_GEMM && st == G_PROJ) || (PROBE_SEL == 8 && kind == K_GEMM && st == G_WOUT) ||
            (PROBE_SEL == 9 && kind == K_GEMM && st == G_EGU) || (PROBE_SEL == 10 && kind == K_GEMM && st == G_EDOWN) || (PROBE_SEL == 11 && kind == K_GPRE) || (PROBE_SEL == 12 && kind == K_WT && st == WT_STATIC) || (PROBE_SEL == 13 && kind == K_WT && st == WT_EXPERT) || (PROBE_SEL == 14 && kind == K_ROW && st == 0);
#endif
        if (pr.s[s].sync_before) { if (first_sync) { grid.sync(); first_sync = false; } else XBAR_NOW();
#if PROBE_SEL
            { const unsigned long long now = __builtin_amdgcn_s_memrealtime(); if (pb_on) pb_acc += now - pb_t0; pb_t0 = now; pb_on = false; }
#endif
        }
#if PROBE_SEL
        if (pb_match) pb_on = true;
#endif
        int reps = 1;
        if (PROBE_MASK) { const int grp = kind == K_GEMM ? 0 : kind == K_ATTN ? 1 : kind == K_GPRE ? 2 : kind == K_WT ? 3 : (kind == K_ROW && (st == R_XFORM || st == R_GOUT || st == R_NORM1)) ? 4 : 7;
            if (grp < 5 && ((PROBE_MASK >> grp) & 1)) reps = 2; if (((PROBE_MASK >> 5) & 1) && pr.s[s].sync_before) XBAR_NOW(); }
        for (int rep = 0; rep < reps; ++rep) {
        if (rep > 0 && ((PROBE_MASK >> 6) & 1)) XBAR_NOW();
        int tid = threadIdx.x; asm volatile("" : "+v"(tid));
        const int lane = tid & 63, wave = __builtin_amdgcn_readfirstlane(tid >> 6);
        const long long gtid = (long long)blockIdx.x * 256 + tid;
        ETab et{nullptr, nullptr};
        if ((kind == K_GEMM && (st == G_EGU || st == G_EDOWN)) || (kind == K_ROW && st == R_POST2)) {
            LAS int* eb = (LAS int*)(lds + 65536 + 64); LAS int* tb = eb + 72;
            __syncthreads();
            if (wave == 0) { const int c = FUSE_ROUTE ? p.CNTP()[(layer * NE + lane) * 32] : p.CNT()[layer * NE + lane]; int a = c, t = (c + 127) >> 7;
#pragma unroll
                for (int o = 1; o < 64; o <<= 1) { const int ua = __shfl_up(a, o), ut = __shfl_up(t, o); if (lane >= o) { a += ua; t += ut; } }
                eb[lane + 1] = a; tb[lane + 1] = t; if (lane == 0) { eb[0] = 0; tb[0] = 0; } }
            __syncthreads();
            et.eb = (const int*)eb; et.tb = (const int*)tb;
        }
        if (kind == K_ITEM) {
            const long long n = n_items(st, layer);
#define RUN_ST(ST) case ST: for (long long i = gtid; i < n; i += gthreads) run_item(p, ST, layer, i); break;
            switch (st) {
#if !USE_KMOD
                RUN_ST(ST_MOD)
#endif
#if !USE_RNORM1
                RUN_ST(ST_NORM1)
#endif
#if !USE_RPOST1
                RUN_ST(ST_POST1) RUN_ST(ST_ROUTER)
#endif
#if !USE_RPOST2
                RUN_ST(ST_POST2)
#endif
                RUN_ST(ST_ZERO) RUN_ST(ST_TAB)
#if !USE_RPOST1 || !FUSE_ROUTE
                RUN_ST(ST_ROUTE)
#endif
                default: break; }
#undef RUN_ST
        } else if (kind == K_WT) {
            const long long n = wt_items(p, st); LAS float* scr = (LAS float*)(lds + wave * (64 * 33 * 4));
            for (long long i = (long long)blockIdx.x * 4 + wave; i < n; i += (long long)gridDim.x * 4) wt_item_dev(p, st, layer, i, scr, lane);
        } else if (kind == K_GEMM) {
            const int n = gemm_ntiles(p, st, layer, et);
            const int q8 = n >> 3, r8 = n & 7;
            for (int i = blockIdx.x; i < n; i += gridDim.x) {
                const int x = i & 7, tau = (x < r8 ? x * (q8 + 1) : r8 * (q8 + 1) + (x - r8) * q8) + (i >> 3);
                GemmDesc g; gemm_desc(p, st, layer, tau, g, et); gemm_tile_dev(g, lds, tid); }
        } else if (kind == K_ROW) {
            const int gw = blockIdx.x * 4 + wave, nw = gridDim.x * 4;
            if (st == R_NORM1) { for (int r = gw; r < TA; r += nw) row_norm1(p, layer, r, lane); }
            else if (st == R_POST1) { __syncthreads();
#if FUSE_ROUTE
                LAS float* hl = (LAS float*)(lds + wave * (4 * D * 4)); for (int i = gw; i < rows_out(layer) / 4; i += nw) row_post1_quad(p, layer, i, lane, hl);
#else
                LAS float* hl = (LAS float*)(lds + wave * (2 * D * 4)); LAS int* lcnt = (LAS int*)(lds + 65536 + 640);
                if (tid < NE) lcnt[tid] = 0;
                __syncthreads();
                for (int i = gw; i < rows_out(layer) / 2; i += nw) row_post1_pair(p, layer, i, lane, hl, lcnt);
                __syncthreads();
                if (tid < NE) p.BCNT()[(size_t)blockIdx.x * NE + tid] = lcnt[tid];
#endif
            }
            else if (st == R_ROUTE2) route_place(p, layer, lds, tid, lane, wave);
            else if (st == R_POST2) { for (int r = gw; r < rows_out(layer); r += nw) row_post2(p, layer, r, lane, et.eb); }
            else if (st == R_XFORM) { __syncthreads(); LAS float* cw = (LAS float*)lds; for (int i = tid; i < GCONV * GQKV; i += 256) cw[i] = p.gdn_conv_w[(size_t)layer * GCONV * GQKV + i]; __syncthreads();
                for (int r = gw; r < TA; r += nw) row_xform(p, layer, r, lane, cw); }
            else { for (int r = gw; r < rows_out(layer); r += nw) row_gout(p, layer, r, lane); }
        } else if (kind == K_MOD) {
            for (int i = blockIdx.x; i < DEPTH * (6 * D / 64); i += gridDim.x) mod_block(p, i, lds, tid);
        } else if (kind == K_GPRE) {
            const int n = NCHAIN * NCH / 2;
            for (int i = blockIdx.x; i < n; i += gridDim.x) gdn_pre_dev(p, i, lds, tid);
        } else {
            LAS int* slot = (LAS int*)(lds + 65536 + 16); const int x0 = (int)(xb_xcc_id() & 7u);
            for (int qs = 0; qs < 8; ++qs) {
                const int x = (x0 + qs) & 7, nq = attn_queue_size(layer, x);
                for (;;) {
                    __syncthreads(); if (tid == 0) *slot = atomicAdd(p.CTR() + layer * 16 + rep * 8 + x, 1); __syncthreads();
                    const int k = *slot; if (k >= nq) break;
                    const int item = attn_queue_item(layer, x, k);
                    int t2 = tid; asm volatile("" : "+v"(t2));
                    if (item < NCHAIN) { gdn_scan_dev(p, item, lds, t2); continue; }
                    AttnDesc a; attn_desc(p, layer, item - NCHAIN, a);
                    if (a.dqk == 96) attn_tile_dev<96>(a, lds, t2); else attn_tile_dev<64>(a, lds, t2);
                }
            }
        }
        }
    }
#if PROBE_SEL
    { const unsigned long long now = __builtin_amdgcn_s_memrealtime(); if (pb_on) pb_acc += now - pb_t0;
      if (blockIdx.x == 0) { const unsigned long long until = now + 4ull * pb_acc; while (__builtin_amdgcn_s_memrealtime() < until) __builtin_amdgcn_s_sleep(32); } }
#endif
}

extern "C" void kernel_launch(void* const* d_in, const int* in_sizes, int n_in, void* d_out, int out_size, void* d_ws, size_t ws_size, hipStream_t stream) {
    Params p{};
    const float** pin = (const float**)&p;
    for (int i = 0; i < 29 && i < n_in; ++i) pin[i] = (const float*)d_in[i];
    p.out = (float*)d_out;
    const size_t need = carve(p, (char*)d_ws);
    if (need > ws_size) { fprintf(stderr, "kernel_launch: workspace too small: need %zu have %zu\n", need, ws_size); return; }
    Prog pr{}; pr.n = build_program(pr.s);
    constexpr int LDS_BYTES = 65536 + 1024;
    static int grid_blocks = 0;
    if (!grid_blocks) {
        int dev = 0, cus = 0, per_cu = 0;
        (void)hipGetDevice(&dev);
        (void)hipDeviceGetAttribute(&cus, hipDeviceAttributeMultiprocessorCount, dev);
        (void)hipFuncSetAttribute((const void*)k_mega, hipFuncAttributeMaxDynamicSharedMemorySize, LDS_BYTES);
        (void)hipOccupancyMaxActiveBlocksPerMultiprocessor(&per_cu, k_mega, 256, LDS_BYTES);
        if (per_cu > 2) per_cu = 2;
        if (per_cu < 1) per_cu = 1;
        grid_blocks = cus * per_cu;
    }
    (void)hipMemsetAsync(p.BAR(), 0, 4096 * 4, stream);
    void* args[] = {&p, &pr};
    hipError_t e = hipLaunchCooperativeKernel((void*)k_mega, dim3(grid_blocks), dim3(256), args, LDS_BYTES, stream);
    if (e != hipSuccess) fprintf(stderr, "cooperative launch failed: %s (grid %d)\n", hipGetErrorString(e), grid_blocks);
}
#endif
```

```cpp
#ifndef HOST_EMU
#include <hip/hip_runtime.h>
#include <hip/hip_cooperative_groups.h>
#include <cstdio>
#define HD __host__ __device__ __forceinline__
#else
#include <cmath>
#include <cstdio>
#include <cstring>
#define HD inline
#endif
#include <cstdint>
#include <utility>

#ifndef CFG_D
#define CFG_D 1024
#endif
#ifndef CFG_S
#define CFG_S 8192
#endif
#ifndef CFG_L
#define CFG_L 256
#endif
#ifndef CFG_DE
#define CFG_DE 256
#endif
#ifndef CFG_DS
#define CFG_DS 256
#endif
#ifndef PROBE_SEL
#define PROBE_SEL 0
#endif
#ifndef PROBE_MASK
#define PROBE_MASK 0
#endif
#ifndef POST1_NR
#define POST1_NR 4
#endif
#ifndef FUSE_ROUTE
#define FUSE_ROUTE 0
#endif
#ifndef USE_KMOD
#define USE_KMOD 1
#endif
#ifndef USE_RNORM1
#define USE_RNORM1 1
#endif
#ifndef USE_RPOST1
#define USE_RPOST1 1
#endif
#ifndef USE_RPOST2
#define USE_RPOST2 1
#endif

namespace cfg {
constexpr int D = CFG_D, B = 2, S = CFG_S, L = CFG_L, DEPTH = 2, GRID_W = 64;
constexpr int T = B * S, TC = B * L, TA = T + TC;
constexpr int SWA_H = 6, SWA_KVH = 2, SWA_G = 3, SWA_W = 128;
constexpr int GH = 6, GDK = 64, GDV = 64, GCONV = 5;
constexpr int MH = 4, MQR = 192, MKVR = 128, MNOPE = 64, MROPE = 32, MV = 64, MQD = MNOPE + MROPE, MKVD = MNOPE + MV;
constexpr int DMIX = 1024, GQKV = 1152;
constexpr int PO_QA = 0, PO_KA = 384, PO_VA = 512, PO_GQKV = 640, PO_Z = 1792, PO_BA = 2176, PO_CQ = 2200, PO_CKV = 2392, PO_KR = 2528  , PO_KR_SRC = 2520, DPROJ = 2552, DPROJP = 2560;
constexpr int NE = 64, TOPK = 8, NGRP = 8, TOPG = 4, DE = CFG_DE, DS = CFG_DS;
constexpr float EPS = 1e-6f, ROUTED_SCALE = 2.5f;
constexpr int NSLOT = TA * TOPK, NK = S + L, NCHAIN = B * GH * 2, NCH = (S + L) / 64;
constexpr int NSPLIT = (NK / 64) % 4 == 0 ? 4 : ((NK / 64) % 2 == 0 ? 2 : 1);
static_assert(D % 128 == 0 && DE % 64 == 0 && DS % 64 == 0 && TA % 128 == 0 && T % 128 == 0, "tile divisibility");
}
using namespace cfg;

#ifdef HOST_EMU
typedef float st_t;
HD float ldf(const st_t* p) { return *p; }
HD void stf(st_t* p, float v) { *p = v; }
HD void st4(st_t* p, float a, float b, float c, float d) { p[0] = a; p[1] = b; p[2] = c; p[3] = d; }
#else
typedef unsigned short st_t;
typedef short bf16x8 __attribute__((ext_vector_type(8)));
typedef float f32x4 __attribute__((ext_vector_type(4)));
typedef float f32x2 __attribute__((ext_vector_type(2)));
typedef __bf16 bf16x2_t __attribute__((ext_vector_type(2)));
#define LAS __attribute__((address_space(3)))
HD float ldf(const st_t* p) { unsigned u = ((unsigned)*p) << 16; float f; __builtin_memcpy(&f, &u, 4); return f; }
HD unsigned short f2bf(float v) { unsigned u; __builtin_memcpy(&u, &v, 4); u = (u + 0x7fffu + ((u >> 16) & 1u)) >> 16; return (unsigned short)u; }
HD void stf(st_t* p, float v) { *p = f2bf(v); }
HD float ldf(const float* p) { return *p; }
HD void stf(float* p, float v) { *p = v; }
__device__ __forceinline__ unsigned pk_bf16(float lo, float hi) { f32x2 v = {lo, hi}; return __builtin_bit_cast(unsigned, __builtin_convertvector(v, bf16x2_t)); }
HD void st4(st_t* p, float a, float b, float c, float d) {
#if defined(__HIP_DEVICE_COMPILE__)
    uint2 w; w.x = pk_bf16(a, b); w.y = pk_bf16(c, d); *(uint2*)p = w;
#else
    p[0] = f2bf(a); p[1] = f2bf(b); p[2] = f2bf(c); p[3] = f2bf(d);
#endif
}
#endif

HD void st8(st_t* p, const float (&a)[4], const float (&b)[4]) {
#if defined(__HIP_DEVICE_COMPILE__)
    uint4 w; w.x = pk_bf16(a[0], a[1]); w.y = pk_bf16(a[2], a[3]); w.z = pk_bf16(b[0], b[1]); w.w = pk_bf16(b[2], b[3]); *(uint4*)p = w;
#else
    for (int i = 0; i < 4; ++i) { stf(p + i, a[i]); stf(p + 4 + i, b[i]); }
#endif
}
#if defined(__HIP_DEVICE_COMPILE__)
__device__ __forceinline__ float fast_exp(float x) { return __builtin_amdgcn_exp2f(x * 1.4426950408889634f); }
__device__ __forceinline__ float silu_f(float x) { return x * __builtin_amdgcn_rcpf(1.0f + fast_exp(-x)); }
__device__ __forceinline__ float sigmoid_f(float x) { return __builtin_amdgcn_rcpf(1.0f + fast_exp(-x)); }
__device__ __forceinline__ float softplus_f(float x) { return x > 20.f ? x : 0.6931471805599453f * __builtin_amdgcn_logf(1.0f + fast_exp(x)); }
__device__ __forceinline__ float rsqrt_f(float x) { return __builtin_amdgcn_rsqf(x); }
#else
HD float silu_f(float x) { return x / (1.0f + expf(-x)); }
HD float sigmoid_f(float x) { return 1.0f / (1.0f + expf(-x)); }
HD float softplus_f(float x) { return x > 20.f ? x : log1pf(expf(x)); }
HD float rsqrt_f(float x) { return 1.0f / sqrtf(x); }
#endif

struct TJob { const float* src; st_t* dst; int K, N, npad, grp, off, ldt, ldsrc, gran; };
constexpr int NJOBS = 16;

struct WsOff { size_t BAR, MOD, TABA, TABM, XC, BG, LOGITS, EW, EIDX, EPOS, CNT, CNTP, CTR, GAM, TOKLIST, WLIST, H, Wt_in, Wt_out, Wt_uq, Wt_ukv, Wt_sgu, Wt_sd, SACT, ACT, Wt_egu, Wt_ed, CH,
               P, G, CQN, CKVN, MQ, MKV, O, VtM, VtA, OF, OB, YB, OPART, MLPART, BCNT, total; };
constexpr size_t align256(size_t v) { return (v + 255) & ~(size_t)255; }
constexpr WsOff make_ws() {
    WsOff w{}; size_t off = 0; const size_t E = sizeof(st_t);
#define TAKE(name, bytes) w.name = off; off = align256(off + (size_t)(bytes));
    TAKE(BAR, 4096 * 4)
    TAKE(MOD, (size_t)DEPTH * 3 * 6 * D * 4) TAKE(TABA, 128 * 16 * 2 * 4) TAKE(TABM, 128 * 8 * 2 * 4) TAKE(XC, (size_t)TC * D * 4) TAKE(BG, (size_t)TA * 24 * 4)
    TAKE(LOGITS, (size_t)TA * NE * 4) TAKE(EW, (size_t)TA * TOPK * 4) TAKE(EIDX, (size_t)TA * TOPK * 4) TAKE(EPOS, (size_t)TA * TOPK * 4)
    TAKE(BCNT, 1024 * NE * 4)
    TAKE(CNT, DEPTH * NE * 4) TAKE(CNTP, DEPTH * NE * 32 * 4) TAKE(CTR, DEPTH * 16 * 4) TAKE(GAM, (size_t)NCHAIN * NCH * 4) TAKE(TOKLIST, (size_t)NE * TA * 4) TAKE(WLIST, (size_t)NE * TA * 4)
    TAKE(H, (size_t)TA * D * E)
    TAKE(Wt_in, (size_t)DEPTH * DPROJP * D * E) TAKE(Wt_out, (size_t)DEPTH * D * DMIX * E) TAKE(Wt_uq, (size_t)DEPTH * MH * MQD * MQR * E) TAKE(Wt_ukv, (size_t)DEPTH * MH * MKVD * MKVR * E)
    TAKE(Wt_sgu, (size_t)DEPTH * 2 * DS * D * E) TAKE(Wt_sd, (size_t)DEPTH * D * DS * E)
    const size_t q0 = off;
    TAKE(SACT, (size_t)TA * DS * E) TAKE(ACT, ((size_t)NSLOT * DE * E > (size_t)TA * D * E ? (size_t)NSLOT * DE * E : (size_t)TA * D * E))
    TAKE(Wt_egu, (size_t)NE * 2 * DE * D * E) TAKE(Wt_ed, (size_t)NE * D * DE * E)
    w.CH = q0; { const size_t chb = align256((size_t)NCHAIN * NCH * 5 * 4096 * E); if (q0 + chb > off) off = q0 + chb; }
    const size_t r0 = off;
    TAKE(P, (size_t)TA * DPROJP * E) TAKE(G, (size_t)TA * GQKV * E) TAKE(CQN, (size_t)TA * MQR * E) TAKE(CKVN, (size_t)TA * MKVR * E) TAKE(MQ, (size_t)TA * MH * MQD * E) TAKE(MKV, (size_t)TA * MH * MKVD * E)
    TAKE(O, (size_t)TA * DMIX * E) TAKE(VtM, (size_t)B * MH * MV * NK * E) TAKE(VtA, (size_t)B * SWA_KVH * 64 * NK * E) TAKE(OF, (size_t)TA * GH * GDV * E) TAKE(OB, (size_t)TA * GH * GDV * E)
#undef TAKE
    w.YB = r0; { const size_t yb = align256((size_t)NSLOT * D * E); if (r0 + yb > off) off = r0 + yb; }
    if ((size_t)NSPLIT * T * MH * MV * E <= (size_t)TA * D * E) w.OPART = w.H; else { w.OPART = off; off = align256(off + (size_t)NSPLIT * T * MH * MV * E); }
    if ((size_t)NSPLIT * T * MH * 2 * 4 <= (size_t)TA * NE * 4) w.MLPART = w.LOGITS; else { w.MLPART = off; off = align256(off + (size_t)NSPLIT * T * MH * 2 * 4); }
    w.total = off; return w;
}
constexpr WsOff WS = make_ws();

struct Params {
    const float *x, *c, *ctx, *c_ctx, *ada_w, *ada_b, *mix_norm_pre, *mix_norm_post, *ffn_norm_pre, *ffn_norm_post,
        *w_in, *w_out, *swa_sink, *gdn_conv_w, *gdn_a_log, *gdn_dt_bias, *gdn_norm_w, *mla_q_norm, *mla_w_uq, *mla_kv_norm, *mla_w_ukv,
        *router_w, *router_bias, *e_gate, *e_up, *e_down, *s_gate, *s_up, *s_down;
    float* out;
    char* ws;
#define WSF(T, name, field) HD T* name() const { return (T*)(ws + WS.field); }
    WSF(unsigned, BAR, BAR) WSF(float, MOD, MOD) WSF(float, TABA, TABA) WSF(float, TABM, TABM) WSF(float, XC, XC) WSF(float, BG, BG) WSF(float, LOGITS, LOGITS) WSF(float, EW, EW)
    WSF(int, EIDX, EIDX) WSF(int, EPOS, EPOS) WSF(int, CNT, CNT) WSF(int, CNTP, CNTP) WSF(int, CTR, CTR) WSF(float, GAM, GAM) WSF(int, TOKLIST, TOKLIST) WSF(float, WLIST, WLIST)
    WSF(st_t, H, H) WSF(st_t, SH, H) WSF(st_t, Wt_in, Wt_in) WSF(st_t, Wt_out, Wt_out) WSF(st_t, Wt_uq, Wt_uq) WSF(st_t, Wt_ukv, Wt_ukv) WSF(st_t, Wt_sgu, Wt_sgu) WSF(st_t, Wt_sd, Wt_sd)
    WSF(st_t, SACT, SACT) WSF(st_t, ACT, ACT) WSF(st_t, Y, ACT) WSF(st_t, Wt_egu, Wt_egu) WSF(st_t, Wt_ed, Wt_ed) WSF(st_t, CH, CH)
    WSF(st_t, P, P) WSF(st_t, G, G) WSF(st_t, CQN, CQN) WSF(st_t, CKVN, CKVN) WSF(st_t, MQ, MQ) WSF(st_t, MKV, MKV) WSF(st_t, O, O) WSF(st_t, VtM, VtM) WSF(st_t, VtA, VtA)
    WSF(st_t, OF, OF) WSF(st_t, OB, OB) WSF(st_t, YB, YB)
    WSF(st_t, OPART, OPART) WSF(float, MLPART, MLPART) WSF(int, BCNT, BCNT)
#undef WSF
};
inline size_t carve(Params& p, char* ws) { p.ws = ws; return WS.total; }

HD TJob static_job(const Params& p, int j) {
    const int l = j / (NJOBS / DEPTH), k = j % (NJOBS / DEPTH);
    switch (k) {
    case 0: return TJob{p.w_in + (size_t)l * D * DPROJ, p.Wt_in() + (size_t)l * DPROJP * D, D, PO_KR_SRC, PO_KR, 16, 0, D, DPROJ, 16};
    case 1: return TJob{p.w_in + (size_t)l * D * DPROJ + PO_KR_SRC, p.Wt_in() + (size_t)l * DPROJP * D + (size_t)PO_KR * D, D, MROPE, MROPE, 16, 0, D, DPROJ, 16};
    case 2: return TJob{p.w_out + (size_t)l * DMIX * D, p.Wt_out() + (size_t)l * D * DMIX, DMIX, D, D, 16, 0, DMIX, D, 16};
    case 3: return TJob{p.mla_w_uq + (size_t)l * MQR * MH * MQD, p.Wt_uq() + (size_t)l * MH * MQD * MQR, MQR, MH * MQD, MH * MQD, 16, 0, MQR, MH * MQD, 16};
    case 4: return TJob{p.mla_w_ukv + (size_t)l * MKVR * MH * MKVD, p.Wt_ukv() + (size_t)l * MH * MKVD * MKVR, MKVR, MH * MKVD, MH * MKVD, 16, 0, MKVR, MH * MKVD, 16};
    case 5: return TJob{p.s_gate + (size_t)l * D * DS, p.Wt_sgu() + (size_t)l * 2 * DS * D, D, DS, DS, 8, 0, D, DS, 4};
    case 6: return TJob{p.s_up + (size_t)l * D * DS, p.Wt_sgu() + (size_t)l * 2 * DS * D, D, DS, DS, 8, 4, D, DS, 4};
    default: return TJob{p.s_down + (size_t)l * DS * D, p.Wt_sd() + (size_t)l * D * DS, DS, D, D, 16, 0, DS, D, 16};
    }
}
HD long long static_job_items(int j) {
    const int k = j % (NJOBS / DEPTH);
    const int K = k == 2 ? DMIX : k == 3 ? MQR : k == 4 ? MKVR : k == 7 ? DS : D;
    const int npad = k == 0 ? PO_KR : k == 1 ? MROPE : k == 2 ? D : k == 3 ? MH * MQD : k == 4 ? MH * MKVD : k == 7 ? D : DS;
    return (long long)(K / 64) * ((npad + 31) / 32);
}

HD int mod_which(int r) { return r < T ? r / S : 2; }
HD const float* mod_vec(const Params& p, int layer, int r, int chunk) { return p.MOD() + ((size_t)(layer * 3 + mod_which(r)) * 6 + chunk) * D; }
HD void seq_bounds(int r, int& lo, int& hi) { if (r < T) { lo = (r / S) * S; hi = lo + S; } else { lo = T + ((r - T) / L) * L; hi = lo + L; } }
HD float* xrow(const Params& p, int r) { return r < T ? p.out + (size_t)r * D : p.XC() + (size_t)(r - T) * D; }
HD const float* xin_row(const Params& p, int layer, int r) { if (layer > 0) return xrow(p, r); return r < T ? p.x + (size_t)r * D : p.ctx + (size_t)(r - T) * D; }
HD int rows_out(int layer) { return layer == DEPTH - 1 ? T : TA; }
HD int expert_base(const int* cnt, int e) { int b = 0; for (int i = 0; i < e; ++i) b += cnt[i]; return b; }

#ifdef HOST_EMU
inline int atomic_inc(int* p) { int v;
#pragma omp atomic capture
    { v = *p; *p += 1; }
    return v; }
#else
__device__ __forceinline__ int atomic_inc(int* p) { return atomicAdd(p, 1); }
#endif

enum Stage { ST_MOD = 0, ST_ZERO, ST_NORM1, ST_ROPE_SWA, ST_GDN_CONV, ST_GDN_L2, ST_GDN_GATE, ST_MLA_NORM, ST_ROPE_MLA,
             ST_SWA, ST_GDN_SCAN, ST_GDN_OUT, ST_MLA, ST_POST1, ST_ROUTER, ST_ROUTE, ST_POST2, ST_VT, ST_TAB, ST_COUNT };

HD long long n_items(int st, int layer) {
    switch (st) {
    case ST_MOD: return (long long)DEPTH * 3 * 6 * D;
    case ST_ZERO: return DEPTH * NE + DEPTH * 16 + DEPTH * NE * 32;
    case ST_VT: return (long long)(B * MH + B * SWA_KVH) * (NK / 8) * 64;
    case ST_TAB: return 128 * 16 + 128 * 8;
    case ST_NORM1: return TA;
    case ST_ROPE_SWA: return (long long)T * 8 * 32;
    case ST_GDN_CONV: return (long long)TA * GQKV;
    case ST_GDN_L2: return (long long)TA * 12;
    case ST_GDN_GATE: return (long long)TA * 12;
    case ST_MLA_NORM: return (long long)TA * 2;
    case ST_ROPE_MLA: return (long long)T * 5 * 16;
    case ST_SWA: return (long long)rows_out(layer) * SWA_H;
    case ST_GDN_SCAN: return (long long)B * GH * 2 * GDV;
    case ST_GDN_OUT: return (long long)rows_out(layer) * GH;
    case ST_MLA: return (long long)rows_out(layer) * MH;
    case ST_POST1: return rows_out(layer);
    case ST_ROUTER: return (long long)rows_out(layer) * NE;
    case ST_ROUTE: return rows_out(layer);
    case ST_POST2: return rows_out(layer);
    }
    return 0;
}

HD float rope_inv(int i, int n) { return exp2f(-(float)i / (float)n * 13.287712379549449f); }

HD void run_item(const Params& p, int st, int layer, long long i) {
    switch (st) {
    case ST_MOD: {
        const int j = (int)(i % (6 * D)); const int w = (int)((i / (6 * D)) % 3); const int ly = (int)(i / (6 * D * 3));
        const float* cv = w < 2 ? p.c + (size_t)w * D : p.c_ctx;
        const float* W = p.ada_w + (size_t)ly * D * 6 * D;
        float acc = p.ada_b[(size_t)ly * 6 * D + j];
        for (int k = 0; k < D; ++k) acc += silu_f(cv[k]) * W[(size_t)k * 6 * D + j];
        p.MOD()[i] = acc;
    } break;
    case ST_ZERO: if (i < DEPTH * NE) p.CNT()[i] = 0; else if (i < DEPTH * NE + DEPTH * 16) p.CTR()[i - DEPTH * NE] = 0; else p.CNTP()[i - DEPTH * NE - DEPTH * 16] = 0; break;
    case ST_TAB: {
        if (i < 128 * 16) { const int pos = (int)(i / 16), ii = (int)(i % 16); const float ang = (float)pos * rope_inv(ii, 16); p.TABA()[2 * i] = cosf(ang); p.TABA()[2 * i + 1] = sinf(ang); }
        else { const long long k = i - 128 * 16; const int pos = (int)(k / 8), ii = (int)(k % 8); const float ang = (float)pos * rope_inv(ii, 8); p.TABM()[2 * k] = cosf(ang); p.TABM()[2 * k + 1] = sinf(ang); }
    } break;
    case ST_VT: {
        const int dv = (int)(i % 64); long long r = i / 64; const int kc = (int)(r % (NK / 8)); const int bh = (int)(r / (NK / 8));
        const bool mla = bh < B * MH; const int b = mla ? bh / MH : (bh - B * MH) / SWA_KVH, hd = mla ? bh % MH : (bh - B * MH) % SWA_KVH;
        st_t* dst = (mla ? p.VtM() + ((size_t)(b * MH + hd) * 64 + dv) * NK : p.VtA() + ((size_t)(b * SWA_KVH + hd) * 64 + dv) * NK) + kc * 8;
        for (int j = 0; j < 8; ++j) { const int kidx = kc * 8 + j; const int row = kidx < S ? b * S + kidx : T + b * L + (kidx - S);
            dst[j] = mla ? p.MKV()[(size_t)row * MH * MKVD + hd * MKVD + MNOPE + dv] : p.P()[(size_t)row * DPROJP + PO_VA + hd * 64 + dv]; }
    } break;
    case ST_NORM1: {
        const int r = (int)i; const float* xr = xin_row(p, layer, r); float ss = 0.f;
        for (int d = 0; d < D; ++d) ss += xr[d] * xr[d];
        const float rstd = 1.0f / sqrtf(ss / D + EPS);
        const float* gain = p.mix_norm_pre + (size_t)layer * D; const float* sh = mod_vec(p, layer, r, 0); const float* sc = mod_vec(p, layer, r, 1);
        st_t* hr = p.H() + (size_t)r * D;
        for (int d = 0; d < D; ++d) stf(hr + d, xr[d] * rstd * gain[d] * (1.0f + sc[d]) + sh[d]);
    } break;
    case ST_ROPE_SWA: {
        const int j = (int)(i % 32), hh = (int)((i / 32) % 8), r = (int)(i / 256);
        const int s = r % S, rp = s / GRID_W, cp = s % GRID_W;
        const int base = hh < 6 ? PO_QA + hh * 64 : PO_KA + (hh - 6) * 64;
        const int half = j / 16, ii = j % 16; const int i1 = base + half * 32 + ii, i2 = i1 + 16;
        const float ang = (float)(half == 0 ? rp : cp) * rope_inv(ii, 16); const float cs = cosf(ang), sn = sinf(ang);
        st_t* pr = p.P() + (size_t)r * DPROJP; const float x1 = ldf(pr + i1), x2 = ldf(pr + i2);
        stf(pr + i1, x1 * cs - x2 * sn); stf(pr + i2, x1 * sn + x2 * cs);
    } break;
    case ST_GDN_CONV: {
        const int cc = (int)(i % GQKV), r = (int)(i / GQKV); int lo, hi; seq_bounds(r, lo, hi);
        const float* w = p.gdn_conv_w + (size_t)layer * GCONV * GQKV; float acc = 0.f;
        for (int j = 0; j < GCONV; ++j) { const int rr = r + j - 2; if (rr >= lo && rr < hi) acc += w[j * GQKV + cc] * ldf(p.P() + (size_t)rr * DPROJP + PO_GQKV + cc); }
        stf(p.G() + (size_t)r * GQKV + cc, silu_f(acc));
    } break;
    case ST_GDN_L2: {
        const int hh = (int)(i % 12), r = (int)(i / 12); st_t* g = p.G() + (size_t)r * GQKV + hh * 64; float ss = 0.f;
        for (int d = 0; d < 64; ++d) { const float v = ldf(g + d); ss += v * v; }
        const float rn = 1.0f / sqrtf(ss + EPS);
        for (int d = 0; d < 64; ++d) stf(g + d, ldf(g + d) * rn);
    } break;
    case ST_GDN_GATE: {
        const int j = (int)(i % 12), r = (int)(i / 12); const st_t* pr = p.P() + (size_t)r * DPROJP + PO_BA;
        const float beta = sigmoid_f(ldf(pr + j)); const float a = ldf(pr + 12 + j);
        const float g = -expf(p.gdn_a_log[layer * 12 + j]) * softplus_f(a + p.gdn_dt_bias[layer * 12 + j]);
        p.BG()[(size_t)r * 24 + j] = beta; p.BG()[(size_t)r * 24 + 12 + j] = g;
    } break;
    case ST_MLA_NORM: {
        const int w = (int)(i % 2), r = (int)(i / 2);
        const int n = w == 0 ? MQR : MKVR; const st_t* src = p.P() + (size_t)r * DPROJP + (w == 0 ? PO_CQ : PO_CKV);
        const float* gain = w == 0 ? p.mla_q_norm + (size_t)layer * MQR : p.mla_kv_norm + (size_t)layer * MKVR;
        st_t* dst = w == 0 ? p.CQN() + (size_t)r * MQR : p.CKVN() + (size_t)r * MKVR; float ss = 0.f;
        for (int d = 0; d < n; ++d) { const float v = ldf(src + d); ss += v * v; }
        const float rstd = 1.0f / sqrtf(ss / n + EPS);
        for (int d = 0; d < n; ++d) stf(dst + d, ldf(src + d) * rstd * gain[d]);
    } break;
    case ST_ROPE_MLA: {
        const int j = (int)(i % 16), w = (int)((i / 16) % 5), r = (int)(i / 80);
        const int s = r % S, rp = s / GRID_W, cp = s % GRID_W;
        const int half = j / 8, ii = j % 8; const float ang = (float)(half == 0 ? rp : cp) * rope_inv(ii, 8); const float cs = cosf(ang), sn = sinf(ang);
        st_t* q = w < 4 ? p.MQ() + (size_t)r * MH * MQD + w * MQD + MNOPE + half * 16 + ii : p.P() + (size_t)r * DPROJP + PO_KR + half * 16 + ii;
        const float x1 = ldf(q), x2 = ldf(q + 8); stf(q, x1 * cs - x2 * sn); stf(q + 8, x1 * sn + x2 * cs);
    } break;
    case ST_SWA: {
        const int h = (int)(i % SWA_H), r = (int)(i / SWA_H); const int kvh = h / SWA_G;
        float q[64], acc[64]; const st_t* qp = p.P() + (size_t)r * DPROJP + PO_QA + h * 64;
        _Pragma("unroll") for (int d = 0; d < 64; ++d) { q[d] = ldf(qp + d) * 0.125f; acc[d] = 0.f; }
        float m = p.swa_sink[layer * SWA_H + h], den = 1.0f;
        int b, klo = 0, khi = 0;
        if (r < T) { b = r / S; const int s = r % S; klo = s - SWA_W < 0 ? 0 : s - SWA_W; khi = s + SWA_W > S - 1 ? S - 1 : s + SWA_W; } else { b = (r - T) / L; khi = -1; }
        const int nloc = khi - klo + 1;
        for (int t = 0; t < nloc + L; ++t) {
            const int kr = t < nloc ? b * S + klo + t : T + b * L + (t - nloc);
            const st_t* kp = p.P() + (size_t)kr * DPROJP + PO_KA + kvh * 64; const st_t* vp = p.P() + (size_t)kr * DPROJP + PO_VA + kvh * 64;
            float sc = 0.f; _Pragma("unroll") for (int d = 0; d < 64; ++d) sc += q[d] * ldf(kp + d);
            if (sc > m) { const float f = expf(m - sc); den *= f; _Pragma("unroll") for (int d = 0; d < 64; ++d) acc[d] *= f; m = sc; }
            const float pe = expf(sc - m); den += pe;
            _Pragma("unroll") for (int d = 0; d < 64; ++d) acc[d] += pe * ldf(vp + d);
        }
        const float inv = 1.0f / den; st_t* o = p.O() + (size_t)r * DMIX + h * 64;
        _Pragma("unroll") for (int d = 0; d < 64; ++d) stf(o + d, acc[d] * inv);
    } break;
    case ST_GDN_SCAN: {
        const int e = (int)(i % GDV), dir = (int)((i / GDV) % 2), h = (int)((i / (GDV * 2)) % GH), b = (int)(i / (GDV * 2 * GH));
        float s[64]; _Pragma("unroll") for (int d = 0; d < 64; ++d) s[d] = 0.f;
        st_t* dst = dir == 0 ? p.OF() : p.OB();
        for (int t = 0; t < L + S; ++t) {
            int r; if (t < L) r = T + b * L + (dir == 0 ? t : L - 1 - t); else { const int u = t - L; r = b * S + (dir == 0 ? u : S - 1 - u); }
            const st_t* g = p.G() + (size_t)r * GQKV; const st_t* qv = g + h * 64; const st_t* kv = g + 384 + h * 64; const float v = ldf(g + 768 + h * 64 + e);
            const float beta = p.BG()[(size_t)r * 24 + dir * 6 + h], alpha = expf(p.BG()[(size_t)r * 24 + 12 + dir * 6 + h]);
            float ks = 0.f; _Pragma("unroll") for (int d = 0; d < 64; ++d) { s[d] *= alpha; ks += ldf(kv + d) * s[d]; }
            const float vn = beta * (v - ks); float o = 0.f;
            _Pragma("unroll") for (int d = 0; d < 64; ++d) { s[d] += ldf(kv + d) * vn; o += ldf(qv + d) * s[d]; }
            stf(dst + (size_t)r * (GH * GDV) + h * 64 + e, o * 0.125f);
        }
    } break;
    case ST_GDN_OUT: {
        const int h = (int)(i % GH), r = (int)(i / GH); const st_t* of = p.OF() + (size_t)r * 384 + h * 64; const st_t* ob = p.OB() + (size_t)r * 384 + h * 64;
        float ss = 0.f; for (int d = 0; d < 64; ++d) { const float o = ldf(of + d) + ldf(ob + d); ss += o * o; }
        const float rstd = 1.0f / sqrtf(ss / 64 + EPS); const float* nw = p.gdn_norm_w + layer * 64; const st_t* z = p.P() + (size_t)r * DPROJP + PO_Z + h * 64;
        st_t* o = p.O() + (size_t)r * DMIX + 384 + h * 64;
        for (int d = 0; d < 64; ++d) stf(o + d, (ldf(of + d) + ldf(ob + d)) * rstd * nw[d] * silu_f(ldf(z + d)));
    } break;
    case ST_MLA: {
        const int h = (int)(i % MH), r = (int)(i / MH); const float scale = 1.0f / sqrtf((float)MQD);
        float acc[64]; const st_t* qp = p.MQ() + (size_t)r * MH * MQD + h * MQD;
        _Pragma("unroll") for (int d = 0; d < 64; ++d) acc[d] = 0.f;
        float m = -1e30f, den = 0.f; int b, nlat;
        if (r < T) { b = r / S; nlat = S; } else { b = (r - T) / L; nlat = 0; }
        for (int t = 0; t < nlat + L; ++t) {
            const int kr = t < nlat ? b * S + t : T + b * L + (t - nlat);
            const st_t* kn = p.MKV() + (size_t)kr * MH * MKVD + h * MKVD; const st_t* krp = p.P() + (size_t)kr * DPROJP + PO_KR;
            float sc = 0.f; for (int d = 0; d < 64; ++d) sc += ldf(qp + d) * ldf(kn + d);
            for (int d = 0; d < 32; ++d) sc += ldf(qp + 64 + d) * ldf(krp + d);
            sc *= scale;
            if (sc > m) { const float f = expf(m - sc); den *= f; _Pragma("unroll") for (int d = 0; d < 64; ++d) acc[d] *= f; m = sc; }
            const float pe = expf(sc - m); den += pe;
            _Pragma("unroll") for (int d = 0; d < 64; ++d) acc[d] += pe * ldf(kn + 64 + d);
        }
        const float inv = 1.0f / den; st_t* o = p.O() + (size_t)r * DMIX + 768 + h * 64;
        _Pragma("unroll") for (int d = 0; d < 64; ++d) stf(o + d, acc[d] * inv);
    } break;
    case ST_POST1: {
        const int r = (int)i; const st_t* y = p.Y() + (size_t)r * D; const float* xi = xin_row(p, layer, r); float* xr = xrow(p, r); float ss = 0.f;
        for (int d = 0; d < D; ++d) { const float v = ldf(y + d); ss += v * v; }
        const float rstd = 1.0f / sqrtf(ss / D + EPS); const float* gp = p.mix_norm_post + (size_t)layer * D; const float* g1 = mod_vec(p, layer, r, 2);
        float s2 = 0.f;
        for (int d = 0; d < D; ++d) { const float v = xi[d] + g1[d] * ldf(y + d) * rstd * gp[d]; xr[d] = v; s2 += v * v; }
        const float r2 = 1.0f / sqrtf(s2 / D + EPS); const float* gf = p.ffn_norm_pre + (size_t)layer * D; const float* sh = mod_vec(p, layer, r, 3); const float* sc = mod_vec(p, layer, r, 4);
        st_t* hr = p.H() + (size_t)r * D;
        for (int d = 0; d < D; ++d) stf(hr + d, xr[d] * r2 * gf[d] * (1.0f + sc[d]) + sh[d]);
    } break;
    case ST_ROUTER: {
        const int n = (int)(i % NE), r = (int)(i / NE); const st_t* a = p.H() + (size_t)r * D; const float* b = p.router_w + (size_t)layer * D * NE + n; float acc = 0.f;
        for (int k = 0; k < D; ++k) acc += ldf(a + k) * b[(size_t)k * NE];
        p.LOGITS()[(size_t)r * NE + n] = acc;
    } break;
    case ST_ROUTE: {
        const int r = (int)i; const float* lg = p.LOGITS() + (size_t)r * NE; const float* bias = p.router_bias + (size_t)layer * NE;
        float gs[NGRP];
        _Pragma("unroll") for (int g = 0; g < NGRP; ++g) { float m1 = -1e30f, m2 = -1e30f; for (int j = 0; j < 8; ++j) { const float v = sigmoid_f(lg[g * 8 + j]) + bias[g * 8 + j]; if (v > m1) { m2 = m1; m1 = v; } else if (v > m2) m2 = v; } gs[g] = m1 + m2; }
        unsigned gmask = 0;
        _Pragma("unroll") for (int k = 0; k < TOPG; ++k) { int best = 0; float bv = -1e30f; _Pragma("unroll") for (int g = 0; g < NGRP; ++g) if (!((gmask >> g) & 1u) && gs[g] > bv) { bv = gs[g]; best = g; } gmask |= 1u << best; }
        unsigned long long used = 0ull; float wsum = 0.f; float wv[TOPK]; int wi[TOPK];
        _Pragma("unroll") for (int k = 0; k < TOPK; ++k) { int best = 0; float bv = -1e30f;
            for (int e = 0; e < NE; ++e) if (((gmask >> (e / 8)) & 1u) && !((used >> e) & 1ull)) { const float v = sigmoid_f(lg[e]) + bias[e]; if (v > bv) { bv = v; best = e; } }
            used |= 1ull << best; wi[k] = best; wv[k] = sigmoid_f(lg[best]); wsum += wv[k]; }
        int* cnt = p.CNT() + layer * NE;
        _Pragma("unroll") for (int k = 0; k < TOPK; ++k) { const float w = wv[k] / wsum * ROUTED_SCALE; const int e = wi[k]; const int pos = atomic_inc(cnt + e);
            p.EIDX()[(size_t)r * TOPK + k] = e; p.EW()[(size_t)r * TOPK + k] = w; p.EPOS()[(size_t)r * TOPK + k] = pos; p.TOKLIST()[(size_t)e * TA + pos] = r; p.WLIST()[(size_t)e * TA + pos] = w; }
    } break;
    case ST_POST2: {
        const int r = (int)i; float* xr = xrow(p, r); const int* cnt = p.CNT() + layer * NE; const st_t* f[TOPK + 1]; f[0] = p.SH() + (size_t)r * D;
        _Pragma("unroll") for (int k = 0; k < TOPK; ++k) { const int e = p.EIDX()[(size_t)r * TOPK + k]; f[k + 1] = p.YB() + (size_t)(expert_base(cnt, e) + p.EPOS()[(size_t)r * TOPK + k]) * D; }
        float ss = 0.f;
        for (int d = 0; d < D; ++d) { float v = 0.f; _Pragma("unroll") for (int k = 0; k <= TOPK; ++k) v += ldf(f[k] + d); ss += v * v; }
        const float rstd = 1.0f / sqrtf(ss / D + EPS); const float* gp = p.ffn_norm_post + (size_t)layer * D; const float* g2 = mod_vec(p, layer, r, 5);
        for (int d = 0; d < D; ++d) { float v = 0.f; _Pragma("unroll") for (int k = 0; k <= TOPK; ++k) v += ldf(f[k] + d); xr[d] = xr[d] + g2[d] * v * rstd * gp[d]; }
    } break;
    }
}

enum { WT_STATIC = 0, WT_EXPERT = 1 };
HD long long wt_items(const Params& p, int kind) {
    if (kind == WT_STATIC) { long long n = 0; for (int j = 0; j < NJOBS; ++j) n += static_job_items(j); return n; }
    return (long long)NE * ((D / 64) * (DE / 32) * 2 + (DE / 64) * (D / 32));
}
HD bool wt_job(const Params& p, int kind, int layer, long long item, TJob& jb, int& kb, int& nb) {
    if (kind == WT_STATIC) {
        for (int j = 0; j < NJOBS; ++j) { const long long n = static_job_items(j); if (item < n) { jb = static_job(p, j); const int nblk = (jb.npad + 31) / 32; kb = (int)(item / nblk); nb = (int)(item % nblk); return true; } item -= n; }
        return false;
    }
    const int per_gu = (D / 64) * (DE / 32), per_d = (DE / 64) * (D / 32), per_e = 2 * per_gu + per_d;
    const int e = (int)(item / per_e); int r = (int)(item % per_e);
    if (r < 2 * per_gu) { const int w = r / per_gu; r %= per_gu; const float* src = (w == 0 ? p.e_gate : p.e_up) + ((size_t)layer * NE + e) * D * DE;
        jb = {src, p.Wt_egu() + (size_t)e * 2 * DE * D, D, DE, DE, 8, w * 4, D, DE, 4};   kb = r / (DE / 32); nb = r % (DE / 32); }
    else { r -= 2 * per_gu; jb = {p.e_down + ((size_t)layer * NE + e) * DE * D, p.Wt_ed() + (size_t)e * D * DE, DE, D, D, 16, 0, DE, D, 16}; kb = r / (D / 32); nb = r % (D / 32); }
    return true;
}
HD size_t wt_dst_row(const TJob& jb, int n) { return (size_t)(n / jb.gran) * jb.grp + (n % jb.gran) + jb.off; }
#ifdef HOST_EMU
inline void wt_item_host(const Params& p, int kind, int layer, long long item) {
    TJob jb; int kb, nb; if (!wt_job(p, kind, layer, item, jb, kb, nb)) return;
    for (int n = nb * 32; n < nb * 32 + 32 && n < jb.npad; ++n) for (int k = kb * 64; k < kb * 64 + 64; ++k)
        jb.dst[wt_dst_row(jb, n) * jb.ldt + k] = n < jb.N ? jb.src[(size_t)k * jb.ldsrc + n] : 0.f;
}
#else
__device__ __forceinline__ void wt_item_dev(const Params& p, int kind, int layer, long long item, LAS float* scr, int lane) {
    TJob jb; int kb, nb; if (!wt_job(p, kind, layer, item, jb, kb, nb)) return;
    const int k0 = kb * 64, n0 = nb * 32;
    { float tmp[32]; const int n = n0 + (lane & 31); const float* sp = jb.src + (size_t)(k0 + (lane >> 5)) * jb.ldsrc + n;
      if (n < jb.N) {
#pragma unroll
          for (int i = 0; i < 32; ++i) tmp[i] = sp[(size_t)(2 * i) * jb.ldsrc];
      } else {
#pragma unroll
          for (int i = 0; i < 32; ++i) tmp[i] = 0.f; }
#pragma unroll
      for (int i = 0; i < 32; ++i) scr[(2 * i + (lane >> 5)) * 33 + (lane & 31)] = tmp[i]; }
    asm volatile("s_waitcnt lgkmcnt(0)" ::: "memory");
    const int c = lane & 7;
#pragma unroll
    for (int j = 0; j < 4; ++j) { const int nl = (lane >> 3) + 8 * j, n = n0 + nl; const LAS float* s = scr + (8 * c) * 33 + nl;
        if (n < jb.npad) { uint4 o; o.x = pk_bf16(s[0 * 33], s[1 * 33]); o.y = pk_bf16(s[2 * 33], s[3 * 33]); o.z = pk_bf16(s[4 * 33], s[5 * 33]); o.w = pk_bf16(s[6 * 33], s[7 * 33]);
            *(uint4*)(jb.dst + wt_dst_row(jb, n) * jb.ldt + k0 + 8 * c) = o; } }
    asm volatile("s_waitcnt lgkmcnt(0)" ::: "memory");
}
#endif

enum { EPI_BF16 = 0, EPI_SWIGLU = 1, EPI_SCALE = 2, EPI_PROJ = 3, EPI_UQ = 4, EPI_UKV = 5 };
enum GStage { G_PROJ = 0, G_UQ, G_UKV, G_WOUT, G_SGU, G_SDOWN, G_EGU, G_EDOWN };
struct GemmDesc {
    const st_t* A; int lda; const int* rowidx; int a_row0, nrows;
    const st_t* Bt; int ldb, K, n0;
    int epi; st_t* out; int ldc; long long out_row0; const float* rowscale;
    const float* tab; st_t* vt;
    int perm;
};
HD int cdiv(int a, int b) { return (a + b - 1) / b; }
struct ETab { const int* eb; const int* tb; };
HD int gemm_ntiles(const Params& p, int gs, int layer, ETab et = ETab{nullptr, nullptr}) {
    const int mt = rows_out(layer) / 128;
    switch (gs) {
    case G_PROJ: return (TA / 128) * (DPROJP / 128);
    case G_UQ: return (TA / 128) * (MH * MQD / 128);
    case G_UKV: return (TA / 128) * (MH * MKVD / 128);
    case G_WOUT: return mt * (D / 128);
    case G_SGU: return mt * (2 * DS / 128);
    case G_SDOWN: return mt * (D / 128);
    case G_EGU: case G_EDOWN: { int t = 0; if (et.tb) t = et.tb[NE]; else for (int e = 0; e < NE; ++e) t += cdiv(p.CNT()[layer * NE + e], 128); return t * (gs == G_EGU ? 2 * DE / 128 : D / 128); }
    }
    return 0;
}
HD void gemm_desc(const Params& p, int gs, int layer, int item, GemmDesc& g, ETab et = ETab{nullptr, nullptr}) {
    g.rowidx = nullptr; g.rowscale = nullptr; g.nrows = 128; g.epi = EPI_BF16; g.tab = nullptr; g.vt = nullptr; g.perm = (gs == G_WOUT || gs == G_SGU || gs == G_SDOWN || gs == G_EGU || gs == G_EDOWN) ? 1 : 0;
    auto plain = [&](const st_t* A, int lda, const st_t* Bt, int K, int ntn, st_t* out, int ldc) {
        const int mtn = (gs == G_PROJ || gs == G_UQ || gs == G_UKV ? TA : rows_out(layer)) / 128, PW = ntn < 8 ? ntn : 8, nfull = ntn / PW;
        int mt, nt; { const int pidx = item / (mtn * PW); if (pidx < nfull) { const int w = item - pidx * mtn * PW; mt = w / PW; nt = pidx * PW + w % PW; } else { const int pw = ntn - nfull * PW, w = item - nfull * mtn * PW; mt = w / pw; nt = nfull * PW + w % pw; } }
        g.A = A; g.lda = lda; g.a_row0 = mt * 128; g.Bt = Bt; g.ldb = K; g.K = K; g.n0 = nt * 128; g.out = out; g.ldc = ldc; g.out_row0 = mt * 128; };
    switch (gs) {
    case G_PROJ: plain(p.H(), D, p.Wt_in() + (size_t)layer * DPROJP * D, D, DPROJP / 128, p.P(), DPROJP); g.epi = EPI_PROJ; g.tab = g.n0 + 128 > PO_KR ? p.TABM() : p.TABA(); g.vt = p.VtA(); break;
    case G_UQ: plain(p.CQN(), MQR, p.Wt_uq() + (size_t)layer * MH * MQD * MQR, MQR, MH * MQD / 128, p.MQ(), MH * MQD); g.epi = EPI_UQ; g.tab = p.TABM(); break;
    case G_UKV: plain(p.CKVN(), MKVR, p.Wt_ukv() + (size_t)layer * MH * MKVD * MKVR, MKVR, MH * MKVD / 128, p.MKV(), MH * MKVD); g.epi = EPI_UKV; g.vt = p.VtM(); break;
    case G_WOUT: plain(p.O(), DMIX, p.Wt_out() + (size_t)layer * D * DMIX, DMIX, D / 128, p.Y(), D); break;
    case G_SGU: plain(p.H(), D, p.Wt_sgu() + (size_t)layer * 2 * DS * D, D, 2 * DS / 128, p.SACT(), DS); g.epi = EPI_SWIGLU; break;
    case G_SDOWN: plain(p.SACT(), DS, p.Wt_sd() + (size_t)layer * D * DS, DS, D / 128, p.SH(), D); break;
    case G_EGU: case G_EDOWN: {
        const int ntn = gs == G_EGU ? 2 * DE / 128 : D / 128; int mt = item / ntn; const int nt = item % ntn; const int* cnt = p.CNT() + layer * NE;
        int e = 0, base = 0;
        if (et.tb) { int lo = 0, hi = NE - 1; while (lo < hi) { const int mid = (lo + hi + 1) >> 1; if (et.tb[mid] <= mt) lo = mid; else hi = mid - 1; } e = lo; mt -= et.tb[e]; base = et.eb[e]; }
        else for (; e < NE; ++e) { const int te = cdiv(cnt[e], 128); if (mt < te) break; mt -= te; base += cnt[e]; }
        g.a_row0 = mt * 128; g.nrows = cnt[e] - mt * 128 < 128 ? cnt[e] - mt * 128 : 128; g.n0 = nt * 128; g.out_row0 = base + mt * 128;
        if (gs == G_EGU) { g.A = p.H(); g.lda = D; g.rowidx = p.TOKLIST() + (size_t)e * TA; g.Bt = p.Wt_egu() + (size_t)e * 2 * DE * D; g.ldb = D; g.K = D; g.epi = EPI_SWIGLU; g.out = p.ACT(); g.ldc = DE; }
        else { g.A = p.ACT() + (size_t)base * DE; g.lda = DE; g.Bt = p.Wt_ed() + (size_t)e * D * DE; g.ldb = DE; g.K = DE; g.epi = EPI_SCALE; g.out = p.YB(); g.ldc = D; g.rowscale = p.WLIST() + (size_t)e * TA - base; }
    } break;
    }
}
HD bool epi_needs_partner(const GemmDesc& g, int cb) { return g.epi == EPI_UQ || (g.epi == EPI_PROJ && g.n0 + cb + 64 > PO_KR); }
HD void rope8(float (&v)[4], const float (&pv)[4], int q, const float* tab, int pos) {
    for (int r = 0; r < 4; ++r) { const int c16 = q * 4 + r, i = c16 & 7; const float cs = tab[(pos * 8 + i) * 2], sn = tab[(pos * 8 + i) * 2 + 1];
        v[r] = c16 < 8 ? v[r] * cs - pv[r] * sn : pv[r] * sn + v[r] * cs; }
}
HD void gemm_epi(const GemmDesc& g, int rl, int cb, int q, float (&v)[4][4], const float (&pv)[4][4]) {
    if (rl >= g.nrows) return;
    const long long orow = g.out_row0 + rl;
    if (g.perm) {
        if (g.epi == EPI_SWIGLU) { float a[2][4]; for (int jj = 0; jj < 2; ++jj) for (int r = 0; r < 4; ++r) a[jj][r] = silu_f(v[2 * jj][r]) * v[2 * jj + 1][r];
            st8(g.out + (size_t)orow * g.ldc + (g.n0 + cb + 16 * q) / 2, a[0], a[1]); return; }
        const float w = g.epi == EPI_SCALE ? g.rowscale[orow] : 1.0f;
        for (int j = 0; j < 4; ++j) for (int r = 0; r < 4; ++r) v[j][r] *= w;
        st_t* o = g.out + (size_t)orow * g.ldc + g.n0 + cb + 16 * q; st8(o, v[0], v[1]); st8(o + 8, v[2], v[3]); return;
    }
    if (g.epi == EPI_SWIGLU) {
        for (int jj = 0; jj < 2; ++jj) { float a[4]; for (int r = 0; r < 4; ++r) a[r] = silu_f(v[2 * jj][r]) * v[2 * jj + 1][r];
            st4(g.out + (size_t)orow * g.ldc + (g.n0 + cb) / 2 + jj * 16 + q * 4, a[0], a[1], a[2], a[3]); }
        return;
    }
    if (g.epi >= EPI_PROJ) {
        const int row = (int)orow; const bool lat = row < T; const int bb = lat ? row / S : (row - T) / L, kidx = lat ? row % S : S + (row - T) % L;
        const int rp = lat ? (row % S) / GRID_W : 0, cp = lat ? (row % S) % GRID_W : 0, span = (g.n0 + cb) / 64;
        if (g.epi == EPI_PROJ) {
            if (span < 8) { if (lat) for (int hp = 0; hp < 2; ++hp) for (int r = 0; r < 4; ++r) { const int i = q * 4 + r, pos = hp ? cp : rp; const float cs = g.tab[(pos * 16 + i) * 2], sn = g.tab[(pos * 16 + i) * 2 + 1];
                    const float x1 = v[2 * hp][r], x2 = v[2 * hp + 1][r]; v[2 * hp][r] = x1 * cs - x2 * sn; v[2 * hp + 1][r] = x1 * sn + x2 * cs; } }
            else if (span < 10) { for (int j = 0; j < 4; ++j) for (int r = 0; r < 4; ++r) stf(g.vt + ((size_t)(bb * SWA_KVH + span - 8) * 64 + j * 16 + q * 4 + r) * NK + kidx, v[j][r]); return; }
            else if (g.n0 + cb + 64 > PO_KR && lat) { rope8(v[2], pv[2], q, g.tab, rp); rope8(v[3], pv[3], q, g.tab, cp); }
        } else if (g.epi == EPI_UQ) {
            if (lat) for (int j = 0; j < 4; ++j) { const int k6 = ((g.n0 + cb) / 16 + j) % 6; if (k6 >= 4) rope8(v[j], pv[j], q, g.tab, k6 == 4 ? rp : cp); }
        } else {
            if (span & 1) { for (int j = 0; j < 4; ++j) for (int r = 0; r < 4; ++r) stf(g.vt + ((size_t)(bb * MH + span / 2) * 64 + j * 16 + q * 4 + r) * NK + kidx, v[j][r]); return; }
        }
    }
    const float w = g.epi == EPI_SCALE ? g.rowscale[orow] : 1.0f;
    for (int j = 0; j < 4; ++j) st4(g.out + (size_t)orow * g.ldc + g.n0 + cb + j * 16 + q * 4, v[j][0] * w, v[j][1] * w, v[j][2] * w, v[j][3] * w);
}
#ifdef HOST_EMU
inline void gemm_tile_host(const GemmDesc& g) {
    for (int rl = 0; rl < g.nrows; ++rl) {
        const long long ar = g.rowidx ? g.rowidx[g.a_row0 + rl] : g.a_row0 + rl; const st_t* a = g.A + (size_t)ar * g.lda;
        for (int cb = 0; cb < 128; cb += 64) for (int q = 0; q < 4; ++q) { float v[4][4], pv[4][4];
            for (int j = 0; j < 4; ++j) for (int r = 0; r < 4; ++r) { const st_t* b = g.Bt + (size_t)(g.n0 + cb + (g.perm ? q * 16 + j * 4 + r : j * 16 + q * 4 + r)) * g.ldb; float acc = 0.f; for (int k = 0; k < g.K; ++k) acc += a[k] * b[k]; v[j][r] = acc;
                const st_t* b2 = g.Bt + (size_t)(g.n0 + cb + j * 16 + (q ^ 2) * 4 + r) * g.ldb; float acc2 = 0.f; for (int k = 0; k < g.K; ++k) acc2 += a[k] * b2[k]; pv[j][r] = acc2; }
            gemm_epi(g, rl, cb, q, v, pv); }
    }
}
#else
__device__ __forceinline__ void gemm_tile_dev(const GemmDesc& g, LAS unsigned char* lds, const int tid) {
    const int lane = tid & 63, wave = __builtin_amdgcn_readfirstlane(tid >> 6), wr = wave >> 1, wc = wave & 1;
    const int lrow = lane >> 3, slot = lane & 7;
    const st_t* asrc[4]; const st_t* bsrc[4];
#pragma unroll
    for (int i = 0; i < 4; ++i) {
        const int row = i * 32 + wave * 8 + lrow, chunk = slot ^ ((row >> 1) & 7);
        int rl = row < g.nrows ? row : g.nrows - 1;
        const long long ar = g.rowidx ? (long long)g.rowidx[g.a_row0 + rl] : (long long)(g.a_row0 + rl);
        asrc[i] = g.A + (size_t)ar * g.lda + chunk * 8;
        const int brow = g.perm ? (row & 64) + ((row >> 2) & 3) * 16 + ((row >> 4) & 3) * 4 + (row & 3) : row;
        bsrc[i] = g.Bt + (size_t)(g.n0 + brow) * g.ldb + chunk * 8;
    }
    const int nt = g.K / 64;
    auto stage = [&](int buf, int t) {
#pragma unroll
        for (int i = 0; i < 4; ++i) {
            __builtin_amdgcn_global_load_lds((const unsigned*)(asrc[i] + t * 64), (LAS unsigned*)(lds + buf * 32768 + (i * 32 + wave * 8) * 128), 16, 0, 0);
            __builtin_amdgcn_global_load_lds((const unsigned*)(bsrc[i] + t * 64), (LAS unsigned*)(lds + buf * 32768 + 16384 + (i * 32 + wave * 8) * 128), 16, 0, 0);
        }
    };
    f32x4 acc[4][4];
#pragma unroll
    for (int i = 0; i < 4; ++i)
#pragma unroll
        for (int j = 0; j < 4; ++j) acc[i][j] = (f32x4){0.f, 0.f, 0.f, 0.f};
    const int fr = lane & 15, fq = lane >> 4;
    __syncthreads();
    stage(0, 0);
    __syncthreads();
    for (int t = 0; t < nt; ++t) {
        const int cur = t & 1;
        if (t + 1 < nt) stage(cur ^ 1, t + 1);
        const LAS unsigned char* As = lds + cur * 32768; const LAS unsigned char* Bs = As + 16384;
#pragma unroll
        for (int kk = 0; kk < 2; ++kk) {
            bf16x8 af[4], bfr[4];
#pragma unroll
            for (int i = 0; i < 4; ++i) { const int row = wr * 64 + i * 16 + fr; af[i] = *(const LAS bf16x8*)(As + row * 128 + (((kk * 4 + fq) ^ ((row >> 1) & 7)) << 4)); }
#pragma unroll
            for (int j = 0; j < 4; ++j) { const int row = wc * 64 + j * 16 + fr; bfr[j] = *(const LAS bf16x8*)(Bs + row * 128 + (((kk * 4 + fq) ^ ((row >> 1) & 7)) << 4)); }
#pragma unroll
            for (int i = 0; i < 4; ++i)
#pragma unroll
                for (int j = 0; j < 4; ++j) acc[i][j] = __builtin_amdgcn_mfma_f32_16x16x32_bf16(bfr[j], af[i], acc[i][j], 0, 0, 0);
        }
        __syncthreads();
    }
    const bool need_pv = epi_needs_partner(g, wc * 64);
#pragma unroll
    for (int i = 0; i < 4; ++i) { float v[4][4], pv[4][4];
#pragma unroll
        for (int j = 0; j < 4; ++j)
#pragma unroll
            for (int r = 0; r < 4; ++r) { v[j][r] = acc[i][j][r]; pv[j][r] = 0.f; }
        if (need_pv) {
#pragma unroll
            for (int j = 0; j < 4; ++j)
#pragma unroll
                for (int r = 0; r < 4; ++r) pv[j][r] = __shfl_xor(v[j][r], 32); }
        gemm_epi(g, wr * 64 + i * 16 + fr, wc * 64, fq, v, pv); }
}
#endif


struct AttnDesc {
    int dqk;
    const st_t* Q; int ldq, q_row0;
    const st_t* K1; int ldk1; const st_t* K2; int ldk2;
    int lat_row0, ctx_row0;
    const st_t* Vt;
    int kt_lo, kt_hi, nctx, ctx_t0;
    int mask, qpos0;
    float m_init, l_init, c;
    st_t* O; int o_col;
    int part; st_t* opart; float* mlpart;
};
HD int attn_nitems(int layer) { const int lat = B * MH * (S / 128) * NSPLIT + B * SWA_H * (S / 128); return layer == DEPTH - 1 ? lat : lat + B * MH * (L / 128) + B * SWA_H * (L / 128); }
HD int attn_queue_size(int layer, int x) {
    const int NQ = S / 128, NQC = L / 128, half = x / 4; int n = NCHAIN / 8 + NQ * NSPLIT + SWA_G * (NQ * (half + 1) / 2 - NQ * half / 2);
    if (layer < DEPTH - 1) n += NQC + SWA_G * (NQC * (half + 1) / 2 - NQC * half / 2);
    return n;
}
HD int attn_queue_item(int layer, int x, int k) {
    const int NQ = S / 128, NQC = L / 128, half = x / 4, n_mla = B * MH * NQ * NSPLIT, n_swa = B * SWA_H * NQ, n_mlac = B * MH * NQC;
    if (k < NCHAIN / 8) return x * (NCHAIN / 8) + k; k -= NCHAIN / 8;
    if (k < NQ * NSPLIT) return NCHAIN + x * NQ * NSPLIT + k; k -= NQ * NSPLIT;
    const int gb = (x % 4) / SWA_KVH, gk = (x % 4) % SWA_KVH;
    { const int qlo = NQ * half / 2, nq = NQ * (half + 1) / 2 - qlo; if (k < SWA_G * nq) { const int h = gk * SWA_G + k / nq; return NCHAIN + n_mla + (gb * SWA_H + h) * NQ + qlo + k % nq; } k -= SWA_G * nq; }
    if (k < NQC) return NCHAIN + n_mla + n_swa + x * NQC + k; k -= NQC;
    { const int qlo = NQC * half / 2, nq = NQC * (half + 1) / 2 - qlo; const int h = gk * SWA_G + k / (nq > 0 ? nq : 1); return NCHAIN + n_mla + n_swa + n_mlac + (gb * SWA_H + h) * NQC + qlo + k % (nq > 0 ? nq : 1); }
}
static_assert(NCHAIN % 8 == 0 && B * MH == 8 && B * SWA_KVH == 4, "queue layout");
HD void attn_desc(const Params& p, int layer, int item, AttnDesc& a) {
    const float LOG2E = 1.4426950408889634f;
    const int n_mla = B * MH * (S / 128) * NSPLIT, n_swa = B * SWA_H * (S / 128), n_mlac = B * MH * (L / 128);
    bool mla, ctxq; int b, h, qb, part = -1;
    if (item < n_mla) { mla = true; ctxq = false; part = item % NSPLIT; item /= NSPLIT; qb = item % (S / 128); h = (item / (S / 128)) % MH; b = item / (S / 128) / MH; }
    else if (item < n_mla + n_swa) { item -= n_mla; mla = false; ctxq = false; qb = item % (S / 128); h = (item / (S / 128)) % SWA_H; b = item / (S / 128) / SWA_H; }
    else if (item < n_mla + n_swa + n_mlac) { item -= n_mla + n_swa; mla = true; ctxq = true; qb = item % (L / 128); h = (item / (L / 128)) % MH; b = item / (L / 128) / MH; }
    else { item -= n_mla + n_swa + n_mlac; mla = false; ctxq = true; qb = item % (L / 128); h = (item / (L / 128)) % SWA_H; b = item / (L / 128) / SWA_H; }
    a.q_row0 = ctxq ? T + b * L + qb * 128 : b * S + qb * 128; a.lat_row0 = b * S; a.ctx_row0 = T + b * L; a.nctx = L / 64; a.qpos0 = qb * 128; a.O = p.O(); a.ctx_t0 = 0; a.part = -1; a.opart = nullptr; a.mlpart = nullptr;
    if (mla) {
        a.dqk = 96; a.Q = p.MQ() + h * MQD; a.ldq = MH * MQD; a.K1 = p.MKV() + h * MKVD; a.ldk1 = MH * MKVD; a.K2 = p.P() + PO_KR; a.ldk2 = DPROJP;
        a.Vt = p.VtM() + (size_t)(b * MH + h) * 64 * NK; a.kt_lo = 0; a.kt_hi = ctxq ? 0 : S / 64; a.mask = 0; a.m_init = -1e30f; a.l_init = 0.f; a.c = LOG2E / sqrtf((float)MQD); a.o_col = 768 + h * 64;
        if (part >= 0 && NSPLIT > 1) {
            const int CT = (NK / 64) / NSPLIT, t0 = part * CT, t1 = t0 + CT, nl = S / 64;
            a.kt_lo = t0 < nl ? t0 : nl; a.kt_hi = t1 < nl ? t1 : nl; a.nctx = t1 > nl ? t1 - (t0 > nl ? t0 : nl) : 0; a.ctx_t0 = t0 > nl ? t0 - nl : 0;
            a.part = part; a.opart = p.OPART() + (size_t)part * T * MH * MV + h * MV; a.mlpart = p.MLPART() + ((size_t)part * T * MH + h) * 2; }
    } else {
        const int kvh = h / SWA_G;
        a.dqk = 64; a.Q = p.P() + PO_QA + h * 64; a.ldq = DPROJP; a.K1 = p.P() + PO_KA + kvh * 64; a.ldk1 = DPROJP; a.K2 = nullptr; a.ldk2 = 0;
        a.Vt = p.VtA() + (size_t)(b * SWA_KVH + kvh) * 64 * NK; a.mask = ctxq ? 0 : 1;
        if (ctxq) { a.kt_lo = 0; a.kt_hi = 0; } else { a.kt_lo = (a.qpos0 - SWA_W) / 64; if (a.kt_lo < 0) a.kt_lo = 0; a.kt_hi = (a.qpos0 + 128 + SWA_W) / 64; if (a.kt_hi > S / 64) a.kt_hi = S / 64; }
        a.m_init = p.swa_sink[layer * SWA_H + h] * LOG2E; a.l_init = 1.f; a.c = LOG2E * 0.125f; a.o_col = h * 64;
    }
}
#ifdef HOST_EMU
inline void attn_tile_host(const AttnDesc& a) {
    const int nl = a.kt_hi - a.kt_lo, ntile = nl + a.nctx;
    for (int q = 0; q < 128; ++q) {
        const st_t* qr = a.Q + (size_t)(a.q_row0 + q) * a.ldq; float m = a.m_init, l = a.l_init, acc[64]; for (int d = 0; d < 64; ++d) acc[d] = 0.f;
        for (int t = 0; t < ntile; ++t) for (int kk = 0; kk < 64; ++kk) {
            const int kidx = t < nl ? (a.kt_lo + t) * 64 + kk : S + (a.ctx_t0 + t - nl) * 64 + kk; const int row = kidx < S ? a.lat_row0 + kidx : a.ctx_row0 + kidx - S;
            if (a.mask && t < nl) { const int dq = a.qpos0 + q - kidx; if (dq > SWA_W || dq < -SWA_W) continue; }
            float sc = 0.f; for (int d = 0; d < 64; ++d) sc += qr[d] * a.K1[(size_t)row * a.ldk1 + d];
            if (a.dqk > 64) for (int d = 64; d < a.dqk; ++d) sc += qr[d] * a.K2[(size_t)row * a.ldk2 + d - 64];
            sc *= a.c; if (sc > m) { const float f = exp2f(m - sc); l *= f; for (int d = 0; d < 64; ++d) acc[d] *= f; m = sc; }
            const float pe = exp2f(sc - m); l += pe; for (int d = 0; d < 64; ++d) acc[d] += pe * a.Vt[(size_t)d * NK + kidx];
        }
        if (a.part >= 0) { for (int d = 0; d < 64; ++d) a.opart[(size_t)(a.q_row0 + q) * MH * MV + d] = acc[d] / l; a.mlpart[(size_t)(a.q_row0 + q) * MH * 2] = m; a.mlpart[(size_t)(a.q_row0 + q) * MH * 2 + 1] = l; }
        else for (int d = 0; d < 64; ++d) a.O[(size_t)(a.q_row0 + q) * DMIX + a.o_col + d] = acc[d] / l;
    }
}
#else
typedef float f32x16 __attribute__((ext_vector_type(16)));
typedef unsigned u32x4 __attribute__((ext_vector_type(4)));
typedef unsigned u32x2 __attribute__((ext_vector_type(2)));
__device__ __forceinline__ int crow16(int reg, int h) { return (reg & 3) + 8 * (reg >> 2) + 4 * h; }
template <int DQK>
__device__ __forceinline__ void attn_tile_dev(const AttnDesc& a, LAS unsigned char* lds, const int tid) {
    constexpr int KSTR = DQK * 2 + 16, VSTR = 136, KBYTES = 64 * KSTR, BUF = KBYTES + 64 * VSTR, CPR = DQK / 8, KCH = 64 * CPR / 256, NKS = DQK / 16;
    const int lane = tid & 63, wave = __builtin_amdgcn_readfirstlane(tid >> 6), l31 = lane & 31, hh = lane >> 5;
    bf16x8 qf[NKS];
    { const st_t* qrow = a.Q + (size_t)(a.q_row0 + wave * 32 + l31) * a.ldq;
#pragma unroll
      for (int ks = 0; ks < NKS; ++ks) qf[ks] = *(const bf16x8*)(qrow + 16 * ks + 8 * hh); }
    f32x16 ot[2];
#pragma unroll
    for (int r = 0; r < 16; ++r) { ot[0][r] = 0.f; ot[1][r] = 0.f; }
    float m = a.m_init, lsum = hh == 0 ? a.l_init : 0.f;
    const int nl = a.kt_hi - a.kt_lo, ntile = nl + a.nctx; const float c = a.c;
    u32x4 kreg[KCH], vreg[2];
    auto gload = [&](int t) {
        const int kidx0 = t < nl ? (a.kt_lo + t) * 64 : S + (a.ctx_t0 + t - nl) * 64; const int rowbase = t < nl ? a.lat_row0 + kidx0 : a.ctx_row0 + kidx0 - S;
#pragma unroll
        for (int u = 0; u < KCH; ++u) { const int ci = tid + 256 * u, row = ci / CPR, cc = ci % CPR;
            const st_t* src = (DQK == 64 || cc < 8) ? a.K1 + (size_t)(rowbase + row) * a.ldk1 + cc * 8 : a.K2 + (size_t)(rowbase + row) * a.ldk2 + (cc - 8) * 8;
            kreg[u] = *(const u32x4*)src; }
#pragma unroll
        for (int u = 0; u < 2; ++u) { const int ci = tid + 256 * u, dv = ci >> 3, cc = ci & 7; vreg[u] = *(const u32x4*)(a.Vt + (size_t)dv * NK + kidx0 + cc * 8); }
    };
    auto lstore = [&](int buf) {
#pragma unroll
        for (int u = 0; u < KCH; ++u) { const int ci = tid + 256 * u, row = ci / CPR, cc = ci % CPR; *(LAS u32x4*)(lds + buf * BUF + row * KSTR + cc * 16) = kreg[u]; }
#pragma unroll
        for (int u = 0; u < 2; ++u) { const int ci = tid + 256 * u, dv = ci >> 3, cc = ci & 7; LAS u32x2* d = (LAS u32x2*)(lds + buf * BUF + KBYTES + dv * VSTR + cc * 16);
            d[0] = (u32x2){vreg[u].x, vreg[u].y}; d[1] = (u32x2){vreg[u].z, vreg[u].w}; }
    };
    __syncthreads();
    gload(0); lstore(0);
    __syncthreads();
    for (int t = 0; t < ntile; ++t) {
        const int cur = t & 1;
        if (t + 1 < ntile) gload(t + 1);
        const LAS unsigned char* Ks = lds + cur * BUF; const LAS unsigned char* Vs = Ks + KBYTES;
        f32x16 st[2];
#pragma unroll
        for (int kb = 0; kb < 2; ++kb) {
#pragma unroll
            for (int r = 0; r < 16; ++r) st[kb][r] = 0.f;
#pragma unroll
            for (int ks = 0; ks < NKS; ++ks) { const bf16x8 af = *(const LAS bf16x8*)(Ks + (kb * 32 + l31) * KSTR + (16 * ks + 8 * hh) * 2);
                st[kb] = __builtin_amdgcn_mfma_f32_32x32x16_bf16(af, qf[ks], st[kb], 0, 0, 0); }
        }
        if (a.mask && t < nl) {
            const int d0 = a.qpos0 + wave * 32 + l31 - (a.kt_lo + t) * 64;
#pragma unroll
            for (int kb = 0; kb < 2; ++kb)
#pragma unroll
                for (int r = 0; r < 16; ++r) { const int dq = d0 - (kb * 32 + crow16(r, hh)); if (dq > SWA_W || dq < -SWA_W) st[kb][r] = -1e30f; }
        }
        float mx = st[0][0];
#pragma unroll
        for (int r = 1; r < 16; ++r) mx = fmaxf(mx, st[0][r]);
#pragma unroll
        for (int r = 0; r < 16; ++r) mx = fmaxf(mx, st[1][r]);
        mx = fmaxf(mx, __shfl_xor(mx, 32));
        const float m_new = fmaxf(m, mx * c), alpha = __builtin_amdgcn_exp2f(m - m_new);
        float rs = 0.f;
#pragma unroll
        for (int kb = 0; kb < 2; ++kb)
#pragma unroll
            for (int r = 0; r < 16; ++r) { const float pe = __builtin_amdgcn_exp2f(__builtin_fmaf(st[kb][r], c, -m_new)); st[kb][r] = pe; rs += pe; }
        lsum = lsum * alpha + rs; m = m_new;
#pragma unroll
        for (int r = 0; r < 16; ++r) { ot[0][r] *= alpha; ot[1][r] *= alpha; }
#pragma unroll
        for (int kb = 0; kb < 2; ++kb)
#pragma unroll
            for (int s2 = 0; s2 < 2; ++s2) {
                u32x4 pw; pw.x = pk_bf16(st[kb][8 * s2 + 0], st[kb][8 * s2 + 1]); pw.y = pk_bf16(st[kb][8 * s2 + 2], st[kb][8 * s2 + 3]);
                pw.z = pk_bf16(st[kb][8 * s2 + 4], st[kb][8 * s2 + 5]); pw.w = pk_bf16(st[kb][8 * s2 + 6], st[kb][8 * s2 + 7]);
                const bf16x8 pb = __builtin_bit_cast(bf16x8, pw);
#pragma unroll
                for (int db = 0; db < 2; ++db) { const LAS unsigned char* vp = Vs + (db * 32 + l31) * VSTR + (kb * 32 + 16 * s2 + 4 * hh) * 2;
                    const u32x2 lo = *(const LAS u32x2*)vp, hi = *(const LAS u32x2*)(vp + 16); u32x4 vw; vw.x = lo.x; vw.y = lo.y; vw.z = hi.x; vw.w = hi.y;
                    ot[db] = __builtin_amdgcn_mfma_f32_32x32x16_bf16(__builtin_bit_cast(bf16x8, vw), pb, ot[db], 0, 0, 0); }
            }
        if (t + 1 < ntile) lstore(cur ^ 1);
        __syncthreads();
    }
    const float ltot = lsum + __shfl_xor(lsum, 32), inv = 1.0f / ltot;
    st_t* orow = a.O + (size_t)(a.q_row0 + wave * 32 + l31) * DMIX + a.o_col;
    if (a.part >= 0) { orow = a.opart + (size_t)(a.q_row0 + wave * 32 + l31) * MH * MV;
        if (hh == 0) { float* ml = a.mlpart + (size_t)(a.q_row0 + wave * 32 + l31) * MH * 2; ml[0] = m; ml[1] = ltot; } }
#pragma unroll
    for (int db = 0; db < 2; ++db)
#pragma unroll
        for (int g = 0; g < 4; ++g) st4(orow + db * 32 + 8 * g + 4 * hh, ot[db][4 * g] * inv, ot[db][4 * g + 1] * inv, ot[db][4 * g + 2] * inv, ot[db][4 * g + 3] * inv);
}
#endif


HD int gdn_row(int b, int dir, int n, int i) {
    if (n < L / 64) { const int pos = n * 64 + i; return T + b * L + (dir == 0 ? pos : L - 1 - pos); }
    const int pos = (n - L / 64) * 64 + i; return b * S + (dir == 0 ? pos : S - 1 - pos);
}
#ifdef HOST_EMU
inline void gdn_pre_host(const Params& p, int item) {
    const int c = item / NCH, n = item % NCH, dir = c & 1, h = (c >> 1) % GH, b = (c >> 1) / GH;
    float gc[64], beta[64]; const st_t* kk[64]; const st_t* qq[64]; const st_t* vv[64]; float acc = 0.f;
    for (int i = 0; i < 64; ++i) { const int r = gdn_row(b, dir, n, i); acc += p.BG()[(size_t)r * 24 + 12 + dir * 6 + h]; gc[i] = acc; beta[i] = p.BG()[(size_t)r * 24 + dir * 6 + h];
        qq[i] = p.G() + (size_t)r * GQKV + h * 64; kk[i] = qq[i] + 384; vv[i] = qq[i] + 768; }
    static thread_local float A[64][64], XU[64][64], XW[64][64];
    for (int i = 0; i < 64; ++i) for (int j = 0; j < 64; ++j) { float d = 0.f; for (int e = 0; e < 64; ++e) d += kk[i][e] * kk[j][e]; A[i][j] = j < i ? beta[i] * d * expf(gc[i] - gc[j]) : 0.f; }
    for (int i = 0; i < 64; ++i) for (int e = 0; e < 64; ++e) { float u = beta[i] * vv[i][e], w = beta[i] * expf(gc[i]) * kk[i][e];
        for (int j = 0; j < i; ++j) { u -= A[i][j] * XU[j][e]; w -= A[i][j] * XW[j][e]; } XU[i][e] = u; XW[i][e] = w; }
    st_t* ch = p.CH() + (size_t)item * 5 * 4096;
    for (int i = 0; i < 64; ++i) for (int e = 0; e < 64; ++e) {
        ch[0 * 4096 + e * 64 + i] = XU[i][e]; ch[1 * 4096 + i * 64 + e] = XW[i][e]; ch[2 * 4096 + i * 64 + e] = qq[i][e] * 0.125f * expf(gc[i]);
        float d = 0.f; for (int x = 0; x < 64; ++x) d += qq[i][x] * kk[e][x]; ch[3 * 4096 + i * 64 + e] = e <= i ? d * 0.125f * expf(gc[i] - gc[e]) : 0.f;
        ch[4 * 4096 + e * 64 + i] = kk[i][e] * expf(gc[63] - gc[i]); }
    p.GAM()[item] = expf(gc[63]);
}
inline void gdn_scan_host(const Params& p, int c) {
    const int dir = c & 1, h = (c >> 1) % GH, b = (c >> 1) / GH; st_t* dst = dir == 0 ? p.OF() : p.OB();
    static thread_local float Sm[64][64], Vn[64][64]; for (int d = 0; d < 64; ++d) for (int e = 0; e < 64; ++e) Sm[d][e] = 0.f;
    for (int n = 0; n < NCH; ++n) { const st_t* ch = p.CH() + (size_t)(c * NCH + n) * 5 * 4096; const float gam = p.GAM()[c * NCH + n];
        for (int i = 0; i < 64; ++i) for (int e = 0; e < 64; ++e) { float v = ch[0 * 4096 + e * 64 + i]; for (int d = 0; d < 64; ++d) v -= ch[1 * 4096 + i * 64 + d] * Sm[d][e]; Vn[i][e] = v; }
        for (int i = 0; i < 64; ++i) for (int e = 0; e < 64; ++e) { float o = 0.f; for (int d = 0; d < 64; ++d) o += ch[2 * 4096 + i * 64 + d] * Sm[d][e]; for (int j = 0; j < 64; ++j) o += ch[3 * 4096 + i * 64 + j] * Vn[j][e];
            dst[(size_t)gdn_row(b, dir, n, i) * (GH * GDV) + h * 64 + e] = o; }
        for (int d = 0; d < 64; ++d) for (int e = 0; e < 64; ++e) { float sn = gam * Sm[d][e]; for (int i = 0; i < 64; ++i) sn += ch[4 * 4096 + d * 64 + i] * Vn[i][e]; Sm[d][e] = sn; }
    }
}
#else
template <int... Is, class F> __device__ __forceinline__ void static_for_impl(std::integer_sequence<int, Is...>, F&& f) { (f(std::integral_constant<int, Is>{}), ...); }
template <int N, class F> __device__ __forceinline__ void static_for(F&& f) { static_for_impl(std::make_integer_sequence<int, N>{}, f); }
__device__ __forceinline__ float bf_lo(unsigned u) { return __builtin_bit_cast(float, u << 16); }
__device__ __forceinline__ float bf_hi(unsigned u) { return __builtin_bit_cast(float, u & 0xffff0000u); }
template <int ROLE>
__device__ __forceinline__ void gdn_pre_role(const Params& p, int pair, LAS unsigned char* lds, const int lane, const int wave) {
    constexpr int AST = 68;
    const int l31 = lane & 31, hh = lane >> 5;
    const int item = pair * 2 + (wave >> 1);
    const int c = item / NCH, n = item % NCH, dir = c & 1, h = (c >> 1) % GH, b = (c >> 1) / GH;
    LAS float* At = (LAS float*)(lds + (wave >> 1) * 18432); LAS float* gcs = At + 64 * AST; LAS float* bts = gcs + 64; LAS float* ebt = bts + 64;
    st_t* ch = p.CH() + (size_t)item * 5 * 4096;
    const int row0 = gdn_row(b, dir, n, 0); const int sgn = dir == 0 ? 1 : -1;
    const int myrow = row0 + sgn * lane;
    float gc = p.BG()[(size_t)myrow * 24 + 12 + dir * 6 + h]; const float beta = p.BG()[(size_t)myrow * 24 + dir * 6 + h];
#pragma unroll
    for (int o = 1; o < 64; o <<= 1) { const float t = __shfl_up(gc, o); if (lane >= o) gc += t; }
    const float gc63 = __shfl(gc, 63);
    __syncthreads();
    if (ROLE == 0) { gcs[lane] = gc; bts[lane] = beta; ebt[lane] = beta * __expf(gc); }
    const st_t* gbase = p.G() + h * 64;
    f32x16 d00, d10, d11;
#pragma unroll
    for (int r = 0; r < 16; ++r) { d00[r] = 0.f; d10[r] = 0.f; d11[r] = 0.f; }
    { const size_t r0 = (size_t)(row0 + sgn * l31) * GQKV, r1 = (size_t)(row0 + sgn * (32 + l31)) * GQKV; constexpr int xo = ROLE == 0 ? 384 : 0;
#pragma unroll
      for (int ks = 0; ks < 4; ++ks) {
          const bf16x8 a0 = *(const bf16x8*)(gbase + r0 + xo + 16 * ks + 8 * hh), a1 = *(const bf16x8*)(gbase + r1 + xo + 16 * ks + 8 * hh);
          const bf16x8 b0 = *(const bf16x8*)(gbase + r0 + 384 + 16 * ks + 8 * hh), b1 = *(const bf16x8*)(gbase + r1 + 384 + 16 * ks + 8 * hh);
          d00 = __builtin_amdgcn_mfma_f32_32x32x16_bf16(a0, b0, d00, 0, 0, 0); d10 = __builtin_amdgcn_mfma_f32_32x32x16_bf16(a1, b0, d10, 0, 0, 0); d11 = __builtin_amdgcn_mfma_f32_32x32x16_bf16(a1, b1, d11, 0, 0, 0); } }
    __syncthreads();
    auto post = [&](const f32x16& d, int ib, int jb) __attribute__((always_inline)) {
        const int j = 32 * jb + l31; const float gcj = gcs[j];
#pragma unroll
        for (int g = 0; g < 4; ++g) { const int i0 = 32 * ib + 8 * g + 4 * hh; const f32x4 gci = *(const LAS f32x4*)(gcs + i0);
            if (ROLE == 0) { const f32x4 bi = *(const LAS f32x4*)(bts + i0); f32x4 o;
#pragma unroll
                for (int u = 0; u < 4; ++u) o[u] = (j < i0 + u) ? bi[u] * d[4 * g + u] * __expf(gci[u] - gcj) : 0.f;
                *(LAS f32x4*)(At + j * AST + i0) = o; }
            else {
#pragma unroll
                for (int u = 0; u < 4; ++u) { const float v = (j <= i0 + u) ? 0.125f * d[4 * g + u] * __expf(gci[u] - gcj) : 0.f; stf(ch + 3 * 4096 + (i0 + u) * 64 + j, v); } } }
    };
    post(d00, 0, 0); post(d10, 1, 0); post(d11, 1, 1);
    if (ROLE == 1) {
#pragma unroll
        for (int r = 0; r < 16; ++r) stf(ch + 3 * 4096 + crow16(r, hh) * 64 + 32 + l31, 0.f); }
    __syncthreads();
    float acc[64];
#pragma unroll
    for (int i = 0; i < 64; ++i) acc[i] = 0.f;
    { const long long stp = (long long)sgn * GQKV;
      const st_t* sp = gbase + (ROLE == 0 ? 768 : 384) + lane + (size_t)row0 * GQKV;
      const LAS float* sc = ROLE == 0 ? bts : ebt;
      float cur[8], pre[8];
#pragma unroll
      for (int u = 0; u < 8; ++u) { cur[u] = ldf(sp + u * stp); pre[u] = ldf(sp + (8 + u) * stp); }
      unsigned pk[4]; f32x4 s4 = (f32x4){0.f, 0.f, 0.f, 0.f}; float xprev = 0.f;
      static_for<64>([&](auto jc) __attribute__((always_inline)) {
          constexpr int j = decltype(jc)::value;
          if constexpr ((j & 7) == 0 && j > 0) {
#pragma unroll
              for (int u = 0; u < 8; ++u) cur[u] = pre[u];
              if constexpr (j + 8 < 64) { const st_t* gp = sp + (j + 8) * stp; asm volatile("" : "+v"(gp));
#pragma unroll
                  for (int u = 0; u < 8; ++u) pre[u] = ldf(gp + u * stp); }
          }
          if constexpr ((j & 3) == 0) s4 = *(const LAS f32x4*)(sc + j);
          const float x = s4[j & 3] * cur[j & 7] - acc[j];
          if constexpr (ROLE == 0) {
              if constexpr ((j & 1) == 1) pk[(j >> 1) & 3] = pk_bf16(xprev, x);
              if constexpr ((j & 7) == 7) { u32x4 w; w.x = pk[0]; w.y = pk[1]; w.z = pk[2]; w.w = pk[3]; *(u32x4*)(ch + 0 * 4096 + lane * 64 + (j - 7)) = w; }
          } else stf(ch + 1 * 4096 + j * 64 + lane, x);
          xprev = x;
          constexpr int I0 = ((j + 1) >> 2) << 2;
#pragma unroll
          for (int i4 = I0; i4 < 64; i4 += 4) { const f32x4 av = *(const LAS f32x4*)(At + j * AST + i4);
#pragma unroll
              for (int u = 0; u < 4; ++u) if (i4 + u > j) acc[i4 + u] += av[u] * x;
              asm volatile("" : "+v"(acc[i4]), "+v"(acc[i4 + 1]), "+v"(acc[i4 + 2]), "+v"(acc[i4 + 3])); }
          __builtin_amdgcn_sched_barrier(0);
      }); }
    { const st_t* src = gbase + (size_t)myrow * GQKV + (ROLE == 0 ? 384 : 0); const float sc = ROLE == 0 ? __expf(gc63 - gc) : 0.125f * __expf(gc);
#pragma unroll
      for (int c8 = 0; c8 < 8; ++c8) { const u32x4 w = *(const u32x4*)(src + 8 * c8);
          const float f0 = bf_lo(w.x) * sc, f1 = bf_hi(w.x) * sc, f2 = bf_lo(w.y) * sc, f3 = bf_hi(w.y) * sc, f4 = bf_lo(w.z) * sc, f5 = bf_hi(w.z) * sc, f6 = bf_lo(w.w) * sc, f7 = bf_hi(w.w) * sc;
          if (ROLE == 0) { st_t* kt = ch + 4 * 4096 + (8 * c8) * 64 + lane; stf(kt, f0); stf(kt + 64, f1); stf(kt + 128, f2); stf(kt + 192, f3); stf(kt + 256, f4); stf(kt + 320, f5); stf(kt + 384, f6); stf(kt + 448, f7); }
          else { u32x4 o; o.x = pk_bf16(f0, f1); o.y = pk_bf16(f2, f3); o.z = pk_bf16(f4, f5); o.w = pk_bf16(f6, f7); *(u32x4*)(ch + 2 * 4096 + lane * 64 + 8 * c8) = o; } } }
    if (ROLE == 0 && lane == 0) p.GAM()[item] = __expf(gc63);
}
static_assert((NCHAIN * NCH) % 2 == 0, "chunk items come in pairs");
__device__ __forceinline__ void gdn_pre_dev(const Params& p, int pair, LAS unsigned char* lds, const int tid) {
    const int lane = tid & 63, wave = __builtin_amdgcn_readfirstlane(tid >> 6);
    if ((wave & 1) == 0) gdn_pre_role<0>(p, pair, lds, lane, wave); else gdn_pre_role<1>(p, pair, lds, lane, wave);
}
__device__ __forceinline__ void gdn_scan_dev(const Params& p, int c, LAS unsigned char* lds, const int tid) {
    constexpr int RS = 136, MB = 64 * RS;
    const int lane = tid & 63, wave = __builtin_amdgcn_readfirstlane(tid >> 6), r16 = lane & 15, q = lane >> 4;
    const int dir = c & 1, h = (c >> 1) % GH, b = (c >> 1) / GH; st_t* dst = (dir == 0 ? p.OF() : p.OB()) + h * 64 + 16 * wave + r16;
    f32x4 Sb[4];
#pragma unroll
    for (int i = 0; i < 4; ++i) Sb[i] = (f32x4){0.f, 0.f, 0.f, 0.f};
    u32x4 stg[10]; float gam_next = 0.f;
    auto gload = [&](int n) { const u32x4* src = (const u32x4*)(p.CH() + (size_t)(c * NCH + n) * 5 * 4096);
#pragma unroll
        for (int u = 0; u < 10; ++u) stg[u] = src[tid + 256 * u];
        gam_next = p.GAM()[c * NCH + n]; };
    auto lstore = [&]() {
#pragma unroll
        for (int u = 0; u < 10; ++u) { const int ci = tid + 256 * u, mat = ci >> 9, row = (ci >> 3) & 63, cc = ci & 7; LAS u32x2* d = (LAS u32x2*)(lds + mat * MB + row * RS + cc * 16);
            d[0] = (u32x2){stg[u].x, stg[u].y}; d[1] = (u32x2){stg[u].z, stg[u].w}; } };
    auto afrag = [&](int mat, int row, int a2) -> bf16x8 { const LAS unsigned char* bp = lds + mat * MB + row * RS + (32 * a2 + 4 * q) * 2;
        const u32x2 lo = *(const LAS u32x2*)bp, hi = *(const LAS u32x2*)(bp + 32); u32x4 w; w.x = lo.x; w.y = lo.y; w.z = hi.x; w.w = hi.y; return __builtin_bit_cast(bf16x8, w); };
    auto pack2 = [&](const f32x4& x, const f32x4& y) -> bf16x8 { u32x4 w; w.x = pk_bf16(x[0], x[1]); w.y = pk_bf16(x[2], x[3]); w.z = pk_bf16(y[0], y[1]); w.w = pk_bf16(y[2], y[3]); return __builtin_bit_cast(bf16x8, w); };
    __syncthreads();
    gload(0); lstore(); float gam = gam_next;
    __syncthreads();
    const int sgn = dir == 0 ? 1 : -1;
    for (int n = 0; n < NCH; ++n) {
        if (n + 1 < NCH) gload(n + 1);
        const bf16x8 sb0 = pack2(Sb[0], Sb[1]), sb1 = pack2(Sb[2], Sb[3]);
        bf16x8 fw[8], fq[8]; u32x2 uu[4];
#pragma unroll
        for (int i = 0; i < 8; ++i) fw[i] = afrag(1, 16 * (i >> 1) + r16, i & 1);
#pragma unroll
        for (int tb = 0; tb < 4; ++tb) uu[tb] = *(const LAS u32x2*)(lds + 0 * MB + (16 * wave + r16) * RS + (16 * tb + 4 * q) * 2);
#pragma unroll
        for (int i = 0; i < 8; ++i) fq[i] = afrag(2, 16 * (i >> 1) + r16, i & 1);
        __builtin_amdgcn_sched_barrier(0);
        f32x4 vn[4], oc[4];
#pragma unroll
        for (int tb = 0; tb < 4; ++tb) {
            f32x4 acc = (f32x4){0.f, 0.f, 0.f, 0.f};
            acc = __builtin_amdgcn_mfma_f32_16x16x32_bf16(fw[2 * tb], sb0, acc, 0, 0, 0);
            acc = __builtin_amdgcn_mfma_f32_16x16x32_bf16(fw[2 * tb + 1], sb1, acc, 0, 0, 0);
            vn[tb][0] = bf_lo(uu[tb].x) - acc[0]; vn[tb][1] = bf_hi(uu[tb].x) - acc[1]; vn[tb][2] = bf_lo(uu[tb].y) - acc[2]; vn[tb][3] = bf_hi(uu[tb].y) - acc[3];
        }
        __builtin_amdgcn_sched_barrier(0);
        bf16x8 fm[8];
#pragma unroll
        for (int i = 0; i < 8; ++i) fm[i] = afrag(3, 16 * (i >> 1) + r16, i & 1);
        __builtin_amdgcn_sched_barrier(0);
#pragma unroll
        for (int tb = 0; tb < 4; ++tb) {
            f32x4 o = (f32x4){0.f, 0.f, 0.f, 0.f};
            o = __builtin_amdgcn_mfma_f32_16x16x32_bf16(fq[2 * tb], sb0, o, 0, 0, 0);
            o = __builtin_amdgcn_mfma_f32_16x16x32_bf16(fq[2 * tb + 1], sb1, o, 0, 0, 0);
            oc[tb] = o;
        }
        const bf16x8 vb0 = pack2(vn[0], vn[1]), vb1 = pack2(vn[2], vn[3]);
        __builtin_amdgcn_sched_barrier(0);
        bf16x8 fk[8];
#pragma unroll
        for (int i = 0; i < 8; ++i) fk[i] = afrag(4, 16 * (i >> 1) + r16, i & 1);
        __builtin_amdgcn_sched_barrier(0);
        const int row0 = gdn_row(b, dir, n, 0);
#pragma unroll
        for (int tb = 0; tb < 4; ++tb) {
            f32x4 o = oc[tb];
            o = __builtin_amdgcn_mfma_f32_16x16x32_bf16(fm[2 * tb], vb0, o, 0, 0, 0);
            o = __builtin_amdgcn_mfma_f32_16x16x32_bf16(fm[2 * tb + 1], vb1, o, 0, 0, 0);
            oc[tb] = o;
        }
#pragma unroll
        for (int db = 0; db < 4; ++db) {
            f32x4 sn = Sb[db] * gam;
            sn = __builtin_amdgcn_mfma_f32_16x16x32_bf16(fk[2 * db], vb0, sn, 0, 0, 0);
            sn = __builtin_amdgcn_mfma_f32_16x16x32_bf16(fk[2 * db + 1], vb1, sn, 0, 0, 0);
            Sb[db] = sn;
        }
#pragma unroll
        for (int tb = 0; tb < 4; ++tb) {
#pragma unroll
            for (int u = 0; u < 4; ++u) stf(dst + (size_t)(row0 + sgn * (16 * tb + 4 * q + u)) * (GH * GDV), oc[tb][u]);
        }
        __syncthreads();
        if (n + 1 < NCH) { lstore(); gam = gam_next; }
        __syncthreads();
    }
}
#endif


#ifndef HOST_EMU
enum { R_NORM1 = 0, R_POST1 = 1, R_POST2 = 2, R_XFORM = 3, R_GOUT = 4, R_ROUTE2 = 5 };
__device__ __forceinline__ float wave_sum(float v) {
#pragma unroll
    for (int o = 32; o > 0; o >>= 1) v += __shfl_xor(v, o);
    return v;
}
__device__ __forceinline__ void ld_row_f32(const float* p, int lane, f32x4 (&v)[D / 256]) {
#pragma unroll
    for (int j = 0; j < D / 256; ++j) v[j] = *(const f32x4*)(p + 4 * lane + 256 * j); }
__device__ __forceinline__ void ld_row_bf16(const st_t* p, int lane, f32x4 (&v)[D / 256]) {
#pragma unroll
    for (int j = 0; j < D / 256; ++j) { const u32x2 w = *(const u32x2*)(p + 4 * lane + 256 * j); v[j] = (f32x4){bf_lo(w.x), bf_hi(w.x), bf_lo(w.y), bf_hi(w.y)}; } }
__device__ __forceinline__ void st_row_bf16(st_t* p, int lane, const f32x4 (&v)[D / 256]) {
#pragma unroll
    for (int j = 0; j < D / 256; ++j) st4(p + 4 * lane + 256 * j, v[j][0], v[j][1], v[j][2], v[j][3]); }
__device__ __forceinline__ float sumsq(const f32x4 (&v)[D / 256]) { float s = 0.f;
#pragma unroll
    for (int j = 0; j < D / 256; ++j) s += (v[j][0] * v[j][0] + v[j][1] * v[j][1]) + (v[j][2] * v[j][2] + v[j][3] * v[j][3]);
    return wave_sum(s); }
template <bool TO_LDS>
__device__ __forceinline__ void modulate_store(const f32x4 (&x)[D / 256], float rstd, const float* gain, const float* sc, const float* sh, st_t* hrow, int lane, LAS float* hl) {
    f32x4 g[D / 256], a[D / 256], b[D / 256], h[D / 256]; ld_row_f32(gain, lane, g); ld_row_f32(sc, lane, a); ld_row_f32(sh, lane, b);
#pragma unroll
    for (int j = 0; j < D / 256; ++j) h[j] = x[j] * rstd * g[j] * (a[j] + 1.0f) + b[j];
    st_row_bf16(hrow, lane, h);
    if constexpr (TO_LDS) {
#pragma unroll
        for (int j = 0; j < D / 256; ++j) *(LAS f32x4*)(hl + 4 * lane + 256 * j) = h[j]; }
}
__device__ __forceinline__ void row_norm1(const Params& p, int layer, int r, int lane) {
    f32x4 x[D / 256]; ld_row_f32(xin_row(p, layer, r), lane, x);
    const float rstd = rsqrt_f(sumsq(x) / D + EPS);
    modulate_store<false>(x, rstd, p.mix_norm_pre + (size_t)layer * D, mod_vec(p, layer, r, 1), mod_vec(p, layer, r, 0), p.H() + (size_t)r * D, lane, (LAS float*)0);
}
__device__ __forceinline__ void route_pick(const Params& p, int layer, int r, int lane, float logit, LAS int* lcnt);
template <int NR>
__device__ __forceinline__ void row_post1_multi(const Params& p, int layer, int item, int lane, LAS float* hl, LAS int* lcnt) {
#pragma unroll
    for (int rr = 0; rr < NR; ++rr) { const int r = NR * item + rr;
        f32x4 y[D / 256], x[D / 256], g1[D / 256], gp[D / 256]; ld_row_bf16(p.Y() + (size_t)r * D, lane, y); ld_row_f32(xin_row(p, layer, r), lane, x);
        ld_row_f32(mod_vec(p, layer, r, 2), lane, g1); ld_row_f32(p.mix_norm_post + (size_t)layer * D, lane, gp);
        const float rstd = rsqrt_f(sumsq(y) / D + EPS);
#pragma unroll
        for (int j = 0; j < D / 256; ++j) x[j] = x[j] + g1[j] * y[j] * rstd * gp[j];
        float* xr = xrow(p, r);
#pragma unroll
        for (int j = 0; j < D / 256; ++j) *(f32x4*)(xr + 4 * lane + 256 * j) = x[j];
        const float r2 = rsqrt_f(sumsq(x) / D + EPS);
        modulate_store<true>(x, r2, p.ffn_norm_pre + (size_t)layer * D, mod_vec(p, layer, r, 4), mod_vec(p, layer, r, 3), p.H() + (size_t)r * D, lane, hl + rr * D);
    }
    asm volatile("s_waitcnt lgkmcnt(0)" ::: "memory");
    const float* wr = p.router_w + (size_t)layer * D * NE + lane; float acc[NR];
#pragma unroll
    for (int rr = 0; rr < NR; ++rr) acc[rr] = 0.f;
#pragma unroll 4
    for (int d4 = 0; d4 < D / 4; ++d4) { f32x4 hv[NR];
#pragma unroll
        for (int rr = 0; rr < NR; ++rr) hv[rr] = *(const LAS f32x4*)(hl + rr * D + 4 * d4);
#pragma unroll
        for (int u = 0; u < 4; ++u) { const float w = wr[(size_t)(4 * d4 + u) * NE];
#pragma unroll
            for (int rr = 0; rr < NR; ++rr) acc[rr] += hv[rr][u] * w; } }
#pragma unroll
    for (int rr = 0; rr < NR; ++rr) route_pick(p, layer, NR * item + rr, lane, acc[rr], lcnt);
    asm volatile("s_waitcnt lgkmcnt(0)" ::: "memory");
}
__device__ __forceinline__ void route_row(const Params& p, int layer, int r, int lane, float logit) {
    const float sg = sigmoid_f(logit), v = sg + p.router_bias[(size_t)layer * NE + lane];
    float m1 = v; int i1 = lane;
#pragma unroll
    for (int o = 1; o < 8; o <<= 1) { const float ov = __shfl_xor(m1, o); const int oi = __shfl_xor(i1, o); if (ov > m1 || (ov == m1 && oi < i1)) { m1 = ov; i1 = oi; } }
    float m2 = lane == i1 ? -3.0e38f : v;
#pragma unroll
    for (int o = 1; o < 8; o <<= 1) m2 = fmaxf(m2, __shfl_xor(m2, o));
    const float gs = m1 + m2; const int grp = lane >> 3;
    int grank = 0;
#pragma unroll
    for (int j = 0; j < NGRP; ++j) { const float og = __shfl(gs, j * 8); grank += (og > gs || (og == gs && j < grp)) ? 1 : 0; }
    const float mv = grank < TOPG ? v : -3.0e38f;
    int rank = 0;
#pragma unroll
    for (int j = 0; j < NE; ++j) { const float ov = __shfl(mv, j); rank += (ov > mv || (ov == mv && j < lane)) ? 1 : 0; }
    const bool sel = rank < TOPK;
    const float wsum = wave_sum(sel ? sg : 0.f);
    if (sel) { const float w = sg / wsum * ROUTED_SCALE; const int pos = atomicAdd(p.CNT() + layer * NE + lane, 1); atomicAdd(p.CNTP() + (layer * NE + lane) * 32, 1);
        p.EIDX()[(size_t)r * TOPK + rank] = lane; p.EPOS()[(size_t)r * TOPK + rank] = pos; p.TOKLIST()[(size_t)lane * TA + pos] = r; p.WLIST()[(size_t)lane * TA + pos] = w; }
}
__device__ __forceinline__ void row_post1_quad(const Params& p, int layer, int quad, int lane, LAS float* hl) {
#pragma unroll
    for (int rr = 0; rr < 4; ++rr) { const int r = 4 * quad + rr;
        f32x4 y[D / 256], x[D / 256], g1[D / 256], gp[D / 256]; ld_row_bf16(p.Y() + (size_t)r * D, lane, y); ld_row_f32(xin_row(p, layer, r), lane, x);
        ld_row_f32(mod_vec(p, layer, r, 2), lane, g1); ld_row_f32(p.mix_norm_post + (size_t)layer * D, lane, gp);
        const float rstd = rsqrt_f(sumsq(y) / D + EPS);
#pragma unroll
        for (int j = 0; j < D / 256; ++j) x[j] = x[j] + g1[j] * y[j] * rstd * gp[j];
        float* xr = xrow(p, r);
#pragma unroll
        for (int j = 0; j < D / 256; ++j) *(f32x4*)(xr + 4 * lane + 256 * j) = x[j];
        const float r2 = rsqrt_f(sumsq(x) / D + EPS);
        modulate_store<true>(x, r2, p.ffn_norm_pre + (size_t)layer * D, mod_vec(p, layer, r, 4), mod_vec(p, layer, r, 3), p.H() + (size_t)r * D, lane, hl + rr * D);
    }
    asm volatile("s_waitcnt lgkmcnt(0)" ::: "memory");
    const float* wr = p.router_w + (size_t)layer * D * NE + lane; float a0 = 0.f, a1 = 0.f, a2 = 0.f, a3 = 0.f;
#pragma unroll 4
    for (int d4 = 0; d4 < D / 4; ++d4) { const f32x4 h0 = *(const LAS f32x4*)(hl + 4 * d4), h1 = *(const LAS f32x4*)(hl + D + 4 * d4), h2 = *(const LAS f32x4*)(hl + 2 * D + 4 * d4), h3 = *(const LAS f32x4*)(hl + 3 * D + 4 * d4);
#pragma unroll
        for (int u = 0; u < 4; ++u) { const float w = wr[(size_t)(4 * d4 + u) * NE]; a0 += h0[u] * w; a1 += h1[u] * w; a2 += h2[u] * w; a3 += h3[u] * w; } }
    route_row(p, layer, 4 * quad, lane, a0); route_row(p, layer, 4 * quad + 1, lane, a1); route_row(p, layer, 4 * quad + 2, lane, a2); route_row(p, layer, 4 * quad + 3, lane, a3);
    asm volatile("s_waitcnt lgkmcnt(0)" ::: "memory");
}
__device__ __forceinline__ void route_pick(const Params& p, int layer, int r, int lane, float logit, LAS int* lcnt) {
    const float sg = sigmoid_f(logit), v = sg + p.router_bias[(size_t)layer * NE + lane];
    float m1 = v; int i1 = lane;
#pragma unroll
    for (int o = 1; o < 8; o <<= 1) { const float ov = __shfl_xor(m1, o); const int oi = __shfl_xor(i1, o); if (ov > m1 || (ov == m1 && oi < i1)) { m1 = ov; i1 = oi; } }
    float m2 = lane == i1 ? -3.0e38f : v;
#pragma unroll
    for (int o = 1; o < 8; o <<= 1) m2 = fmaxf(m2, __shfl_xor(m2, o));
    const float gs = m1 + m2; const int grp = lane >> 3;
    int grank = 0;
#pragma unroll
    for (int j = 0; j < NGRP; ++j) { const float og = __builtin_bit_cast(float, __builtin_amdgcn_readlane(__builtin_bit_cast(int, gs), j * 8)); grank += (og > gs || (og == gs && j < grp)) ? 1 : 0; }
    const float mv = grank < TOPG ? v : -3.0e38f;
    int rank = 0;
#pragma unroll
    for (int j = 0; j < NE; ++j) { const float ov = __builtin_bit_cast(float, __builtin_amdgcn_readlane(__builtin_bit_cast(int, mv), j)); rank += (ov > mv || (ov == mv && j < lane)) ? 1 : 0; }
    const bool sel = rank < TOPK;
    const float wsum = wave_sum(sel ? sg : 0.f);
    if (sel) { p.EIDX()[(size_t)r * TOPK + rank] = lane; p.EW()[(size_t)r * TOPK + rank] = sg / wsum * ROUTED_SCALE; __hip_atomic_fetch_add(lcnt + lane, 1, __ATOMIC_RELAXED, __HIP_MEMORY_SCOPE_WORKGROUP); }
}
__device__ __forceinline__ void route_place(const Params& p, int layer, LAS unsigned char* lds, int tid, int lane, int wave) {
    LAS int* pb = (LAS int*)lds; LAS int* lpos = pb + NE;
    __syncthreads();
    { const int e = tid & (NE - 1), qd = tid >> 6, per = ((int)gridDim.x + 3) / 4; int below = 0, tot = 0; const int* bc = p.BCNT() + e;
      const int b_hi = (qd + 1) * per < (int)gridDim.x ? (qd + 1) * per : (int)gridDim.x;
#pragma unroll 8
      for (int b2 = qd * per; b2 < b_hi; ++b2) { const int c = bc[(size_t)b2 * NE]; tot += c; below += b2 < (int)blockIdx.x ? c : 0; }
      LAS int* red = lpos + NE; red[tid] = below; red[256 + tid] = tot; }
    __syncthreads();
    if (tid < NE) { LAS int* red = lpos + NE; pb[tid] = red[tid] + red[64 + tid] + red[128 + tid] + red[192 + tid]; lpos[tid] = 0;
        if (blockIdx.x == 0) p.CNT()[layer * NE + tid] = red[256 + tid] + red[320 + tid] + red[384 + tid] + red[448 + tid]; }
    __syncthreads();
    const int gw = blockIdx.x * 4 + wave, nw = gridDim.x * 4;
    for (int i = gw; i < rows_out(layer) / POST1_NR; i += nw) {
        if (lane < POST1_NR * TOPK) { const int r = POST1_NR * i + (lane >> 3), k = lane & 7; const int e = p.EIDX()[(size_t)r * TOPK + k]; const float w = p.EW()[(size_t)r * TOPK + k];
            const int pos = pb[e] + __hip_atomic_fetch_add(lpos + e, 1, __ATOMIC_RELAXED, __HIP_MEMORY_SCOPE_WORKGROUP);
            p.EPOS()[(size_t)r * TOPK + k] = pos; p.TOKLIST()[(size_t)e * TA + pos] = r; p.WLIST()[(size_t)e * TA + pos] = w; }
    }
}
__device__ __forceinline__ void row_post2(const Params& p, int layer, int r, int lane, const int* eb) {
    int slot = 0;
    if (lane < TOPK) { const int e = p.EIDX()[(size_t)r * TOPK + lane]; slot = eb[e] + p.EPOS()[(size_t)r * TOPK + lane]; }
    f32x4 f[D / 256]; ld_row_bf16(p.SH() + (size_t)r * D, lane, f);
#pragma unroll
    for (int k = 0; k < TOPK; ++k) { const int sk = __shfl(slot, k); f32x4 t[D / 256]; ld_row_bf16(p.YB() + (size_t)sk * D, lane, t);
#pragma unroll
        for (int j = 0; j < D / 256; ++j) f[j] += t[j]; }
    const float rstd = rsqrt_f(sumsq(f) / D + EPS);
    float* xr = xrow(p, r); f32x4 x[D / 256], g2[D / 256], gp[D / 256]; ld_row_f32(xr, lane, x); ld_row_f32(mod_vec(p, layer, r, 5), lane, g2); ld_row_f32(p.ffn_norm_post + (size_t)layer * D, lane, gp);
#pragma unroll
    for (int j = 0; j < D / 256; ++j) { x[j] = x[j] + g2[j] * f[j] * rstd * gp[j]; *(f32x4*)(xr + 4 * lane + 256 * j) = x[j]; }
    if (layer + 1 < DEPTH) { const float r2 = rsqrt_f(sumsq(x) / D + EPS);
        modulate_store<false>(x, r2, p.mix_norm_pre + (size_t)(layer + 1) * D, mod_vec(p, layer + 1, r, 1), mod_vec(p, layer + 1, r, 0), p.H() + (size_t)r * D, lane, (LAS float*)0); }
}
__device__ __forceinline__ void unpack8(const u32x4 w, float (&x)[8]) { x[0] = bf_lo(w.x); x[1] = bf_hi(w.x); x[2] = bf_lo(w.y); x[3] = bf_hi(w.y); x[4] = bf_lo(w.z); x[5] = bf_hi(w.z); x[6] = bf_lo(w.w); x[7] = bf_hi(w.w); }
__device__ __forceinline__ u32x4 pack8(const float (&x)[8]) { u32x4 o; o.x = pk_bf16(x[0], x[1]); o.y = pk_bf16(x[2], x[3]); o.z = pk_bf16(x[4], x[5]); o.w = pk_bf16(x[6], x[7]); return o; }
__device__ __forceinline__ void row_xform(const Params& p, int layer, int r, int lane, const LAS float* cw) {
    int lo, hi; seq_bounds(r, lo, hi);
    const st_t* prow = p.P() + (size_t)r * DPROJP;
#pragma unroll
    for (int gi = 0; gi < 3; ++gi) {
        if (gi < 2 || lane < 16) {
            const int c0 = 8 * (lane + 64 * gi); float acc[8];
#pragma unroll
            for (int e = 0; e < 8; ++e) acc[e] = 0.f;
#pragma unroll
            for (int j = 0; j < GCONV; ++j) { const int rr = r + j - 2;
                if (rr >= lo && rr < hi) { float x[8]; unpack8(*(const u32x4*)(p.P() + (size_t)rr * DPROJP + PO_GQKV + c0), x);
                    const f32x4 w0 = *(const LAS f32x4*)(cw + j * GQKV + c0), w1 = *(const LAS f32x4*)(cw + j * GQKV + c0 + 4);
#pragma unroll
                    for (int e = 0; e < 4; ++e) { acc[e] += w0[e] * x[e]; acc[4 + e] += w1[e] * x[4 + e]; } } }
            float ss = 0.f;
#pragma unroll
            for (int e = 0; e < 8; ++e) { acc[e] = silu_f(acc[e]); ss += acc[e] * acc[e]; }
            if (gi < 2) {
                ss += __shfl_xor(ss, 1); ss += __shfl_xor(ss, 2); ss += __shfl_xor(ss, 4);
                const float rn = c0 < 2 * GH * GDK ? rsqrt_f(ss + EPS) : 1.0f;
#pragma unroll
                for (int e = 0; e < 8; ++e) acc[e] *= rn; }
            *(u32x4*)(p.G() + (size_t)r * GQKV + c0) = pack8(acc);
        }
    }
    if (lane < 12) { const float beta = sigmoid_f(ldf(prow + PO_BA + lane)), a = ldf(prow + PO_BA + 12 + lane);
        p.BG()[(size_t)r * 24 + lane] = beta; p.BG()[(size_t)r * 24 + 12 + lane] = -expf(p.gdn_a_log[layer * 12 + lane]) * softplus_f(a + p.gdn_dt_bias[layer * 12 + lane]); }
    { float x[8]; float ss = 0.f;
      if (lane < MQR / 8) { unpack8(*(const u32x4*)(prow + PO_CQ + 8 * lane), x);
#pragma unroll
          for (int e = 0; e < 8; ++e) ss += x[e] * x[e]; }
      const float rstd = rsqrt_f(wave_sum(ss) / MQR + EPS);
      if (lane < MQR / 8) { const float* gn = p.mla_q_norm + (size_t)layer * MQR + 8 * lane;
#pragma unroll
          for (int e = 0; e < 8; ++e) x[e] = x[e] * rstd * gn[e];
          *(u32x4*)(p.CQN() + (size_t)r * MQR + 8 * lane) = pack8(x); } }
    { float x[8]; float ss = 0.f;
      if (lane < MKVR / 8) { unpack8(*(const u32x4*)(prow + PO_CKV + 8 * lane), x);
#pragma unroll
          for (int e = 0; e < 8; ++e) ss += x[e] * x[e]; }
      const float rstd = rsqrt_f(wave_sum(ss) / MKVR + EPS);
      if (lane < MKVR / 8) { const float* gn = p.mla_kv_norm + (size_t)layer * MKVR + 8 * lane;
#pragma unroll
          for (int e = 0; e < 8; ++e) x[e] = x[e] * rstd * gn[e];
          *(u32x4*)(p.CKVN() + (size_t)r * MKVR + 8 * lane) = pack8(x); } }
}
__device__ __forceinline__ void row_mla_merge(const Params& p, int r, int lane) {
    if (NSPLIT == 1 || r >= T || lane >= MH * MV / 8) return;
    const int h = lane / (MV / 8); float mc[NSPLIT], lc[NSPLIT], mx = -3.0e38f;
#pragma unroll
    for (int c = 0; c < NSPLIT; ++c) { const float* ml = p.MLPART() + (((size_t)c * T + r) * MH + h) * 2; mc[c] = ml[0]; lc[c] = ml[1]; mx = fmaxf(mx, mc[c]); }
    float o[8], wsum = 0.f;
#pragma unroll
    for (int e = 0; e < 8; ++e) o[e] = 0.f;
#pragma unroll
    for (int c = 0; c < NSPLIT; ++c) { const float w = lc[c] * __builtin_amdgcn_exp2f(mc[c] - mx); wsum += w; float x[8]; unpack8(*(const u32x4*)(p.OPART() + ((size_t)c * T + r) * MH * MV + 8 * lane), x);
#pragma unroll
        for (int e = 0; e < 8; ++e) o[e] += w * x[e]; }
    const float inv = __builtin_amdgcn_rcpf(wsum);
#pragma unroll
    for (int e = 0; e < 8; ++e) o[e] *= inv;
    *(u32x4*)(p.O() + (size_t)r * DMIX + (SWA_H + GH) * 64 + 8 * lane) = pack8(o);
}
__device__ __forceinline__ void row_gout(const Params& p, int layer, int r, int lane) {
    row_mla_merge(p, r, lane);
    float o[8]; float ss = 0.f; const bool act = lane < GH * GDV / 8;
    if (act) { float a[8], b[8]; unpack8(*(const u32x4*)(p.OF() + (size_t)r * (GH * GDV) + 8 * lane), a); unpack8(*(const u32x4*)(p.OB() + (size_t)r * (GH * GDV) + 8 * lane), b);
#pragma unroll
        for (int e = 0; e < 8; ++e) { o[e] = a[e] + b[e]; ss += o[e] * o[e]; } }
    ss += __shfl_xor(ss, 1); ss += __shfl_xor(ss, 2); ss += __shfl_xor(ss, 4);
    if (act) { const float rstd = rsqrt_f(ss / GDV + EPS); float z[8]; unpack8(*(const u32x4*)(p.P() + (size_t)r * DPROJP + PO_Z + 8 * lane), z);
        const float* nw = p.gdn_norm_w + layer * GDV + (8 * lane) % GDV;
#pragma unroll
        for (int e = 0; e < 8; ++e) o[e] = o[e] * rstd * nw[e] * silu_f(z[e]);
        *(u32x4*)(p.O() + (size_t)r * DMIX + GH * GDV + 8 * lane) = pack8(o); }
}
__device__ __forceinline__ void mod_block(const Params& p, int item, LAS unsigned char* lds, int tid) {
    const int lane = tid & 63, wave = __builtin_amdgcn_readfirstlane(tid >> 6); const int ly = item / (6 * D / 64), jb = item % (6 * D / 64);
    LAS float* sl = (LAS float*)lds; LAS float* red = sl + 3 * D;
    __syncthreads();
    for (int i = tid; i < 3 * D; i += 256) { const int w = i / D, k = i % D; sl[i] = silu_f(w < 2 ? p.c[(size_t)w * D + k] : p.c_ctx[k]); }
    __syncthreads();
    const float* W = p.ada_w + (size_t)ly * D * 6 * D + jb * 64 + lane; float a0 = 0.f, a1 = 0.f, a2 = 0.f;
#pragma unroll 8
    for (int k = wave * (D / 4); k < (wave + 1) * (D / 4); ++k) { const float w = W[(size_t)k * 6 * D]; a0 += sl[k] * w; a1 += sl[D + k] * w; a2 += sl[2 * D + k] * w; }
    red[(wave * 3 + 0) * 64 + lane] = a0; red[(wave * 3 + 1) * 64 + lane] = a1; red[(wave * 3 + 2) * 64 + lane] = a2;
    __syncthreads();
    if (wave < 3) { const float v = red[(0 * 3 + wave) * 64 + lane] + red[(1 * 3 + wave) * 64 + lane] + red[(2 * 3 + wave) * 64 + lane] + red[(3 * 3 + wave) * 64 + lane];
        p.MOD()[((size_t)(ly * 3 + wave) * 6 * D) + jb * 64 + lane] = v + p.ada_b[(size_t)ly * 6 * D + jb * 64 + lane]; }
}
#endif


#ifndef HOST_EMU
#define XB_TMO      128
#define XB_XCNT(j)  (256  + 64 * (j))
#define XB_XSUB(j)  (1280 + 64 * (j))
#define XB_XGEN(j)  (2304 + 64 * (j))
#define XB_TOP      3328
#define XB_TOPGEN   3392
#define XCD_BAR_WORDS 3456
#define XB_SPIN_CAP (1u << 18)

__device__ __forceinline__ unsigned xb_ld(unsigned* p)              { return __hip_atomic_load(p, __ATOMIC_RELAXED, __HIP_MEMORY_SCOPE_AGENT); }
__device__ __forceinline__ unsigned xb_add(unsigned* p, unsigned v) { return __hip_atomic_fetch_add(p, v, __ATOMIC_RELAXED, __HIP_MEMORY_SCOPE_AGENT); }
__device__ __forceinline__ unsigned xb_xcc_id() { return (unsigned)__builtin_amdgcn_s_getreg((3 << 11) | 20) & 0xFu; }
#define XB_SPIN(cond, bar) do { unsigned _sp = 0; while (cond) { __builtin_amdgcn_s_sleep(1); \
    if ((++_sp & 255u) == 0u) { if (xb_ld(&(bar)[XB_TMO])) break; if (_sp > XB_SPIN_CAP) { atomicAdd(&(bar)[XB_TMO], 1u); break; } } } } while (0)

struct XcdBarrier {
    unsigned* bar; unsigned x;
    volatile LAS unsigned* st;
};

__device__ __forceinline__ XcdBarrier xcd_barrier_post(unsigned* bar, volatile LAS unsigned* st) {
    XcdBarrier b; b.bar = bar; b.x = xb_xcc_id(); b.st = st;
    if (threadIdx.x == 0) (void)xb_add(&bar[XB_XCNT(b.x)], 1u);
    return b;
}
__device__ __forceinline__ void xcd_barrier_complete(unsigned* bar, unsigned x, unsigned& nloc, unsigned& nx) {
    const unsigned G = gridDim.x * gridDim.y * gridDim.z;
    unsigned sum, cnt, mine, sp = 0u;
    for (;;) {
        sum = 0u; cnt = 0u; mine = 0u;
#pragma unroll
        for (unsigned j = 0; j < 16; ++j) { const unsigned c = xb_ld(&bar[XB_XCNT(j)]); sum += c; cnt += (c > 0u) ? 1u : 0u; mine = (j == x) ? c : mine; }
        if (sum == G) break;
        __builtin_amdgcn_s_sleep(1);
        if ((++sp & 255u) == 0u) { if (xb_ld(&bar[XB_TMO])) break; if (sp > XB_SPIN_CAP) { atomicAdd(&bar[XB_TMO], 1u); break; } }
    }
    nloc = mine > 0u ? mine : 1u; nx = cnt > 0u ? cnt : 1u;
}

__device__ __forceinline__ void xcd_barrier(const XcdBarrier& b) {
    asm volatile("s_waitcnt vmcnt(0)" ::: "memory");
    __syncthreads();
    if (threadIdx.x == 0) {
        unsigned* bar = b.bar;
        __builtin_amdgcn_s_waitcnt(0);
        unsigned nloc = b.st[0], nx = b.st[1];
        if (nloc == 0u) { xcd_barrier_complete(bar, b.x, nloc, nx); b.st[0] = nloc; b.st[1] = nx; }
        const unsigned old = xb_add(&bar[XB_XSUB(b.x)], 1u);
        const unsigned gen = old / nloc;
        if (old + 1u == (gen + 1u) * nloc) {
            __builtin_amdgcn_fence(__ATOMIC_RELEASE, "agent");
            asm volatile("s_waitcnt vmcnt(0)" ::: "memory");
            const unsigned og = xb_add(&bar[XB_TOP], 1u);
            const unsigned tg = og / nx;
            if (og + 1u == (tg + 1u) * nx) xb_add(&bar[XB_TOPGEN], 1u);
            else XB_SPIN(xb_ld(&bar[XB_TOPGEN]) == tg, bar);
            __builtin_amdgcn_fence(__ATOMIC_ACQUIRE, "agent");
            xb_add(&bar[XB_XGEN(b.x)], 1u);
            asm volatile("s_waitcnt vmcnt(0)" ::: "memory");
        } else {
            XB_SPIN(xb_ld(&bar[XB_XGEN(b.x)]) == gen, bar);
            __builtin_amdgcn_fence(__ATOMIC_ACQUIRE, "agent");
            asm volatile("s_waitcnt vmcnt(0)" ::: "memory");
        }
    }
    __syncthreads();
}

#endif

enum { K_ITEM = 0, K_WT = 1, K_GEMM = 2, K_ATTN = 3, K_GPRE = 4, K_ROW = 5, K_MOD = 6 };
struct Step { int kind, st, layer, sync_before; };
inline int build_program(Step* prog) {
    int n = 0;
    prog[n++] = {K_ITEM, ST_ZERO, 0, 0}; prog[n++] = {K_ITEM, ST_TAB, 0, 0}; prog[n++] = {USE_KMOD ? K_MOD : K_ITEM, USE_KMOD ? 0 : ST_MOD, 0, 0}; prog[n++] = {K_WT, WT_STATIC, 0, 0};
    for (int l = 0; l < DEPTH; ++l) {
        if (l == 0 || !USE_RPOST2) { if (USE_RNORM1) prog[n++] = {K_ROW, 0  , l, 1}; else prog[n++] = {K_ITEM, ST_NORM1, l, 1}; }
        prog[n++] = {K_GEMM, G_PROJ, l, 1};
        prog[n++] = {K_ROW, 3  , l, 1};
        prog[n++] = {K_GEMM, G_UQ, l, 1}; prog[n++] = {K_GEMM, G_UKV, l, 0}; prog[n++] = {K_GPRE, 0, l, 0};
        prog[n++] = {K_ATTN, 0, l, 1};
        prog[n++] = {K_ROW, 4  , l, 1};
        prog[n++] = {K_GEMM, G_WOUT, l, 1}; prog[n++] = {K_WT, WT_EXPERT, l, 0};
        if (USE_RPOST1) { prog[n++] = {K_ROW, 1  , l, 1}; prog[n++] = {K_ROW, 5  , l, 1}; } else { prog[n++] = {K_ITEM, ST_POST1, l, 1}; prog[n++] = {K_ITEM, ST_ROUTER, l, 1}; prog[n++] = {K_ITEM, ST_ROUTE, l, 1}; }
        prog[n++] = {K_GEMM, G_SGU, l, 1}; prog[n++] = {K_GEMM, G_EGU, l, 0};
        prog[n++] = {K_GEMM, G_SDOWN, l, 1}; prog[n++] = {K_GEMM, G_EDOWN, l, 0};
        if (USE_RPOST2) prog[n++] = {K_ROW, 2  , l, 1}; else prog[n++] = {K_ITEM, ST_POST2, l, 1};
    }
    return n;
}
constexpr int MAX_STEPS = 64;

#ifndef HOST_EMU
namespace cg = cooperative_groups;
struct Prog { Step s[MAX_STEPS]; int n; int pad[3]; };

__global__ void __launch_bounds__(256, 2) k_mega(Params p, Prog pr) {
    extern __shared__ __attribute__((aligned(16))) unsigned char smem[];
    LAS unsigned char* lds = (LAS unsigned char*)smem;
    cg::grid_group grid = cg::this_grid();
    { volatile LAS unsigned* bst = (volatile LAS unsigned*)(lds + 65536); if (threadIdx.x < 2) bst[threadIdx.x] = 0u; }
    __syncthreads();
    (void)xcd_barrier_post(p.BAR(), (volatile LAS unsigned*)(lds + 65536));
#define XBAR_NOW() do { XcdBarrier xb_; xb_.bar = p.BAR(); xb_.x = xb_xcc_id(); xb_.st = (volatile LAS unsigned*)(lds + 65536); xcd_barrier(xb_); } while (0)
    bool first_sync = true;
    const long long gthreads = (long long)gridDim.x * 256;
#if PROBE_SEL
    unsigned long long pb_acc = 0, pb_t0 = __builtin_amdgcn_s_memrealtime(); bool pb_on = false;
#endif
    for (int s = 0; s < pr.n; ++s) {
        const int kind = pr.s[s].kind, st = pr.s[s].st, layer = pr.s[s].layer;
#if PROBE_SEL
        const bool pb_match = (PROBE_SEL == 1 && kind == K_ROW && st == 1) || (PROBE_SEL == 2 && ((kind == K_ITEM && st == ST_ROUTE) || (kind == K_ROW && st == 5))) || (PROBE_SEL == 3 && kind == K_ROW && st == 2) || (PROBE_SEL == 4 && kind == K_ROW && st == 3) ||
            (PROBE_SEL == 5 && kind == K_ROW && st == 4) || (PROBE_SEL == 6 && kind == K_ATTN) || (PROBE_SEL == 7 && kind == K_GEMM && st == G_PROJ) || (PROBE_SEL == 8 && kind == K_GEMM && st == G_WOUT) ||
            (PROBE_SEL == 9 && kind == K_GEMM && st == G_EGU) || (PROBE_SEL == 10 && kind == K_GEMM && st == G_EDOWN) || (PROBE_SEL == 11 && kind == K_GPRE) || (PROBE_SEL == 12 && kind == K_WT && st == WT_STATIC) || (PROBE_SEL == 13 && kind == K_WT && st == WT_EXPERT) || (PROBE_SEL == 14 && kind == K_ROW && st == 0);
#endif
        if (pr.s[s].sync_before) { if (first_sync) { grid.sync(); first_sync = false; } else XBAR_NOW();
#if PROBE_SEL
            { const unsigned long long now = __builtin_amdgcn_s_memrealtime(); if (pb_on) pb_acc += now - pb_t0; pb_t0 = now; pb_on = false; }
#endif
        }
#if PROBE_SEL
        if (pb_match) pb_on = true;
#endif
        int reps = 1;
        if (PROBE_MASK) { const int grp = kind == K_GEMM ? 0 : kind == K_ATTN ? 1 : kind == K_GPRE ? 2 : kind == K_WT ? 3 : (kind == K_ROW && (st == R_XFORM || st == R_GOUT || st == R_NORM1)) ? 4 : 7;
            if (grp < 5 && ((PROBE_MASK >> grp) & 1)) reps = 2; if (((PROBE_MASK >> 5) & 1) && pr.s[s].sync_before) XBAR_NOW(); }
        for (int rep = 0; rep < reps; ++rep) {
        if (rep > 0 && ((PROBE_MASK >> 6) & 1)) XBAR_NOW();
        int tid = threadIdx.x; asm volatile("" : "+v"(tid));
        const int lane = tid & 63, wave = __builtin_amdgcn_readfirstlane(tid >> 6);
        const long long gtid = (long long)blockIdx.x * 256 + tid;
        ETab et{nullptr, nullptr};
        if ((kind == K_GEMM && (st == G_EGU || st == G_EDOWN)) || (kind == K_ROW && st == R_POST2)) {
            LAS int* eb = (LAS int*)(lds + 65536 + 64); LAS int* tb = eb + 72;
            __syncthreads();
            if (wave == 0) { const int c = FUSE_ROUTE ? p.CNTP()[(layer * NE + lane) * 32] : p.CNT()[layer * NE + lane]; int a = c, t = (c + 127) >> 7;
#pragma unroll
                for (int o = 1; o < 64; o <<= 1) { const int ua = __shfl_up(a, o), ut = __shfl_up(t, o); if (lane >= o) { a += ua; t += ut; } }
                eb[lane + 1] = a; tb[lane + 1] = t; if (lane == 0) { eb[0] = 0; tb[0] = 0; } }
            __syncthreads();
            et.eb = (const int*)eb; et.tb = (const int*)tb;
        }
        if (kind == K_ITEM) {
            const long long n = n_items(st, layer);
#define RUN_ST(ST) case ST: for (long long i = gtid; i < n; i += gthreads) run_item(p, ST, layer, i); break;
            switch (st) {
#if !USE_KMOD
                RUN_ST(ST_MOD)
#endif
#if !USE_RNORM1
                RUN_ST(ST_NORM1)
#endif
#if !USE_RPOST1
                RUN_ST(ST_POST1) RUN_ST(ST_ROUTER)
#endif
#if !USE_RPOST2
                RUN_ST(ST_POST2)
#endif
                RUN_ST(ST_ZERO) RUN_ST(ST_TAB)
#if !USE_RPOST1 || !FUSE_ROUTE
                RUN_ST(ST_ROUTE)
#endif
                default: break; }
#undef RUN_ST
        } else if (kind == K_WT) {
            const long long n = wt_items(p, st); LAS float* scr = (LAS float*)(lds + wave * (64 * 33 * 4));
            for (long long i = (long long)blockIdx.x * 4 + wave; i < n; i += (long long)gridDim.x * 4) wt_item_dev(p, st, layer, i, scr, lane);
        } else if (kind == K_GEMM) {
            const int n = gemm_ntiles(p, st, layer, et);
            const int q8 = n >> 3, r8 = n & 7;
            for (int i = blockIdx.x; i < n; i += gridDim.x) {
                const int x = i & 7, tau = (x < r8 ? x * (q8 + 1) : r8 * (q8 + 1) + (x - r8) * q8) + (i >> 3);
                GemmDesc g; gemm_desc(p, st, layer, tau, g, et); gemm_tile_dev(g, lds, tid); }
        } else if (kind == K_ROW) {
            const int gw = blockIdx.x * 4 + wave, nw = gridDim.x * 4;
            if (st == R_NORM1) { for (int r = gw; r < TA; r += nw) row_norm1(p, layer, r, lane); }
            else if (st == R_POST1) { __syncthreads();
#if FUSE_ROUTE
                LAS float* hl = (LAS float*)(lds + wave * (4 * D * 4)); for (int i = gw; i < rows_out(layer) / 4; i += nw) row_post1_quad(p, layer, i, lane, hl);
#else
                LAS float* hl = (LAS float*)(lds + wave * (POST1_NR * D * 4)); LAS int* lcnt = (LAS int*)(lds + 65536 + 640);
                if (tid < NE) lcnt[tid] = 0;
                __syncthreads();
                for (int i = gw; i < rows_out(layer) / POST1_NR; i += nw) row_post1_multi<POST1_NR>(p, layer, i, lane, hl, lcnt);
                __syncthreads();
                if (tid < NE) p.BCNT()[(size_t)blockIdx.x * NE + tid] = lcnt[tid];
#endif
            }
            else if (st == R_ROUTE2) route_place(p, layer, lds, tid, lane, wave);
            else if (st == R_POST2) { for (int r = gw; r < rows_out(layer); r += nw) row_post2(p, layer, r, lane, et.eb); }
            else if (st == R_XFORM) { __syncthreads(); LAS float* cw = (LAS float*)lds; for (int i = tid; i < GCONV * GQKV; i += 256) cw[i] = p.gdn_conv_w[(size_t)layer * GCONV * GQKV + i]; __syncthreads();
                for (int r = gw; r < TA; r += nw) row_xform(p, layer, r, lane, cw); }
            else { for (int r = gw; r < rows_out(layer); r += nw) row_gout(p, layer, r, lane); }
        } else if (kind == K_MOD) {
            for (int i = blockIdx.x; i < DEPTH * (6 * D / 64); i += gridDim.x) mod_block(p, i, lds, tid);
        } else if (kind == K_GPRE) {
            const int n = NCHAIN * NCH / 2;
            for (int i = blockIdx.x; i < n; i += gridDim.x) gdn_pre_dev(p, i, lds, tid);
        } else {
            LAS int* slot = (LAS int*)(lds + 65536 + 16); const int x0 = (int)(xb_xcc_id() & 7u);
            for (int qs = 0; qs < 8; ++qs) {
                const int x = (x0 + qs) & 7, nq = attn_queue_size(layer, x);
                for (;;) {
                    __syncthreads(); if (tid == 0) *slot = atomicAdd(p.CTR() + layer * 16 + rep * 8 + x, 1); __syncthreads();
                    const int k = *slot; if (k >= nq) break;
                    const int item = attn_queue_item(layer, x, k);
                    int t2 = tid; asm volatile("" : "+v"(t2));
                    if (item < NCHAIN) { gdn_scan_dev(p, item, lds, t2); continue; }
                    AttnDesc a; attn_desc(p, layer, item - NCHAIN, a);
                    if (a.dqk == 96) attn_tile_dev<96>(a, lds, t2); else attn_tile_dev<64>(a, lds, t2);
                }
            }
        }
        }
    }
#if PROBE_SEL
    { const unsigned long long now = __builtin_amdgcn_s_memrealtime(); if (pb_on) pb_acc += now - pb_t0;
      if (blockIdx.x == 0) { const unsigned long long until = now + 4ull * pb_acc; while (__builtin_amdgcn_s_memrealtime() < until) __builtin_amdgcn_s_sleep(32); } }
#endif
}

extern "C" void kernel_launch(void* const* d_in, const int* in_sizes, int n_in, void* d_out, int out_size, void* d_ws, size_t ws_size, hipStream_t stream) {
    Params p{};
    const float** pin = (const float**)&p;
    for (int i = 0; i < 29 && i < n_in; ++i) pin[i] = (const float*)d_in[i];
    p.out = (float*)d_out;
    const size_t need = carve(p, (char*)d_ws);
    if (need > ws_size) { fprintf(stderr, "kernel_launch: workspace too small: need %zu have %zu\n", need, ws_size); return; }
    Prog pr{}; pr.n = build_program(pr.s);
    constexpr int LDS_BYTES = 65536 + 1024;
    static int grid_blocks = 0;
    if (!grid_blocks) {
        int dev = 0, cus = 0, per_cu = 0;
        (void)hipGetDevice(&dev);
        (void)hipDeviceGetAttribute(&cus, hipDeviceAttributeMultiprocessorCount, dev);
        (void)hipFuncSetAttribute((const void*)k_mega, hipFuncAttributeMaxDynamicSharedMemorySize, LDS_BYTES);
        (void)hipOccupancyMaxActiveBlocksPerMultiprocessor(&per_cu, k_mega, 256, LDS_BYTES);
        if (per_cu > 2) per_cu = 2;
        if (per_cu < 1) per_cu = 1;
        grid_blocks = cus * per_cu;
    }
    (void)hipMemsetAsync(p.BAR(), 0, 4096 * 4, stream);
    void* args[] = {&p, &pr};
    hipError_t e = hipLaunchCooperativeKernel((void*)k_mega, dim3(grid_blocks), dim3(256), args, LDS_BYTES, stream);
    if (e != hipSuccess) fprintf(stderr, "cooperative launch failed: %s (grid %d)\n", hipGetErrorString(e), grid_blocks);
}
#endif
```

```cpp
#ifndef HOST_EMU
#include <hip/hip_runtime.h>
#include <hip/hip_cooperative_groups.h>
#include <cstdio>
#define HD __host__ __device__ __forceinline__
#else
#include <cmath>
#include <cstdio>
#include <cstring>
#define HD inline
#endif
#include <cstdint>
#include <utility>

#ifndef CFG_D
#define CFG_D 1024
#endif
#ifndef CFG_S
#define CFG_S 8192
#endif
#ifndef CFG_L
#define CFG_L 256
#endif
#ifndef CFG_DE
#define CFG_DE 256
#endif
#ifndef CFG_DS
#define CFG_DS 256
#endif
#ifndef PROBE_SEL
#define PROBE_SEL 0
#endif
#ifndef PROBE_MASK
#define PROBE_MASK 0
#endif
#ifndef POST1_NR
#define POST1_NR 4
#endif
#ifndef FUSE_ROUTE
#define FUSE_ROUTE 0
#endif
#ifndef USE_KMOD
#define USE_KMOD 1
#endif
#ifndef USE_RNORM1
#define USE_RNORM1 1
#endif
#ifndef USE_RPOST1
#define USE_RPOST1 1
#endif
#ifndef USE_RPOST2
#define USE_RPOST2 1
#endif

namespace cfg {
constexpr int D = CFG_D, B = 2, S = CFG_S, L = CFG_L, DEPTH = 2, GRID_W = 64;
constexpr int T = B * S, TC = B * L, TA = T + TC;
constexpr int SWA_H = 6, SWA_KVH = 2, SWA_G = 3, SWA_W = 128;
constexpr int GH = 6, GDK = 64, GDV = 64, GCONV = 5;
constexpr int MH = 4, MQR = 192, MKVR = 128, MNOPE = 64, MROPE = 32, MV = 64, MQD = MNOPE + MROPE, MKVD = MNOPE + MV;
constexpr int DMIX = 1024, GQKV = 1152;
constexpr int PO_QA = 0, PO_KA = 384, PO_VA = 512, PO_GQKV = 640, PO_Z = 1792, PO_BA = 2176, PO_CQ = 2200, PO_CKV = 2392, PO_KR = 2528  , PO_KR_SRC = 2520, DPROJ = 2552, DPROJP = 2560;
constexpr int NE = 64, TOPK = 8, NGRP = 8, TOPG = 4, DE = CFG_DE, DS = CFG_DS;
constexpr float EPS = 1e-6f, ROUTED_SCALE = 2.5f;
constexpr int NSLOT = TA * TOPK, NK = S + L, NCHAIN = B * GH * 2, NCH = (S + L) / 64;
constexpr int NSPLIT = (NK / 64) % 4 == 0 ? 4 : ((NK / 64) % 2 == 0 ? 2 : 1);
static_assert(D % 128 == 0 && DE % 64 == 0 && DS % 64 == 0 && TA % 128 == 0 && T % 128 == 0, "tile divisibility");
}
using namespace cfg;

#ifdef HOST_EMU
typedef float st_t;
HD float ldf(const st_t* p) { return *p; }
HD void stf(st_t* p, float v) { *p = v; }
HD void st4(st_t* p, float a, float b, float c, float d) { p[0] = a; p[1] = b; p[2] = c; p[3] = d; }
#else
typedef unsigned short st_t;
typedef short bf16x8 __attribute__((ext_vector_type(8)));
typedef float f32x4 __attribute__((ext_vector_type(4)));
typedef float f32x2 __attribute__((ext_vector_type(2)));
typedef __bf16 bf16x2_t __attribute__((ext_vector_type(2)));
#define LAS __attribute__((address_space(3)))
HD float ldf(const st_t* p) { unsigned u = ((unsigned)*p) << 16; float f; __builtin_memcpy(&f, &u, 4); return f; }
HD unsigned short f2bf(float v) { unsigned u; __builtin_memcpy(&u, &v, 4); u = (u + 0x7fffu + ((u >> 16) & 1u)) >> 16; return (unsigned short)u; }
HD void stf(st_t* p, float v) { *p = f2bf(v); }
HD float ldf(const float* p) { return *p; }
HD void stf(float* p, float v) { *p = v; }
__device__ __forceinline__ unsigned pk_bf16(float lo, float hi) { f32x2 v = {lo, hi}; return __builtin_bit_cast(unsigned, __builtin_convertvector(v, bf16x2_t)); }
HD void st4(st_t* p, float a, float b, float c, float d) {
#if defined(__HIP_DEVICE_COMPILE__)
    uint2 w; w.x = pk_bf16(a, b); w.y = pk_bf16(c, d); *(uint2*)p = w;
#else
    p[0] = f2bf(a); p[1] = f2bf(b); p[2] = f2bf(c); p[3] = f2bf(d);
#endif
}
#endif

HD void st8(st_t* p, const float (&a)[4], const float (&b)[4]) {
#if defined(__HIP_DEVICE_COMPILE__)
    uint4 w; w.x = pk_bf16(a[0], a[1]); w.y = pk_bf16(a[2], a[3]); w.z = pk_bf16(b[0], b[1]); w.w = pk_bf16(b[2], b[3]); *(uint4*)p = w;
#else
    for (int i = 0; i < 4; ++i) { stf(p + i, a[i]); stf(p + 4 + i, b[i]); }
#endif
}
#if defined(__HIP_DEVICE_COMPILE__)
__device__ __forceinline__ float fast_exp(float x) { return __builtin_amdgcn_exp2f(x * 1.4426950408889634f); }
__device__ __forceinline__ float silu_f(float x) { return x * __builtin_amdgcn_rcpf(1.0f + fast_exp(-x)); }
__device__ __forceinline__ float sigmoid_f(float x) { return __builtin_amdgcn_rcpf(1.0f + fast_exp(-x)); }
__device__ __forceinline__ float softplus_f(float x) { return x > 20.f ? x : 0.6931471805599453f * __builtin_amdgcn_logf(1.0f + fast_exp(x)); }
__device__ __forceinline__ float rsqrt_f(float x) { return __builtin_amdgcn_rsqf(x); }
#else
HD float silu_f(float x) { return x / (1.0f + expf(-x)); }
HD float sigmoid_f(float x) { return 1.0f / (1.0f + expf(-x)); }
HD float softplus_f(float x) { return x > 20.f ? x : log1pf(expf(x)); }
HD float rsqrt_f(float x) { return 1.0f / sqrtf(x); }
#endif

struct TJob { const float* src; st_t* dst; int K, N, npad, grp, off, ldt, ldsrc, gran; };
constexpr int NJOBS = 16;

struct WsOff { size_t BAR, MOD, TABA, TABM, XC, BG, LOGITS, EW, EIDX, EPOS, CNT, CNTP, CTR, GAM, TOKLIST, WLIST, H, Wt_in, Wt_out, Wt_uq, Wt_ukv, Wt_sgu, Wt_sd, SACT, ACT, Wt_egu, Wt_ed, CH,
               P, G, CQN, CKVN, MQ, MKV, O, VtM, VtA, OF, OB, YB, OPART, MLPART, BCNT, total; };
constexpr size_t align256(size_t v) { return (v + 255) & ~(size_t)255; }
constexpr WsOff make_ws() {
    WsOff w{}; size_t off = 0; const size_t E = sizeof(st_t);
#define TAKE(name, bytes) w.name = off; off = align256(off + (size_t)(bytes));
    TAKE(BAR, 4096 * 4)
    TAKE(MOD, (size_t)DEPTH * 3 * 6 * D * 4) TAKE(TABA, 128 * 16 * 2 * 4) TAKE(TABM, 128 * 8 * 2 * 4) TAKE(XC, (size_t)TC * D * 4) TAKE(BG, (size_t)TA * 24 * 4)
    TAKE(LOGITS, (size_t)TA * NE * 4) TAKE(EW, (size_t)TA * TOPK * 4) TAKE(EIDX, (size_t)TA * TOPK * 4) TAKE(EPOS, (size_t)TA * TOPK * 4)
    TAKE(BCNT, 1024 * NE * 4)
    TAKE(CNT, DEPTH * NE * 4) TAKE(CNTP, DEPTH * NE * 32 * 4) TAKE(CTR, DEPTH * 16 * 4) TAKE(GAM, (size_t)NCHAIN * NCH * 4) TAKE(TOKLIST, (size_t)NE * TA * 4) TAKE(WLIST, (size_t)NE * TA * 4)
    TAKE(H, (size_t)TA * D * E)
    TAKE(Wt_in, (size_t)DEPTH * DPROJP * D * E) TAKE(Wt_out, (size_t)DEPTH * D * DMIX * E) TAKE(Wt_uq, (size_t)DEPTH * MH * MQD * MQR * E) TAKE(Wt_ukv, (size_t)DEPTH * MH * MKVD * MKVR * E)
    TAKE(Wt_sgu, (size_t)DEPTH * 2 * DS * D * E) TAKE(Wt_sd, (size_t)DEPTH * D * DS * E)
    const size_t q0 = off;
    TAKE(SACT, (size_t)TA * DS * E) TAKE(ACT, ((size_t)NSLOT * DE * E > (size_t)TA * D * E ? (size_t)NSLOT * DE * E : (size_t)TA * D * E))
    TAKE(Wt_egu, (size_t)NE * 2 * DE * D * E) TAKE(Wt_ed, (size_t)NE * D * DE * E)
    w.CH = q0; { const size_t chb = align256((size_t)NCHAIN * NCH * 5 * 4096 * E); if (q0 + chb > off) off = q0 + chb; }
    const size_t r0 = off;
    TAKE(P, (size_t)TA * DPROJP * E) TAKE(G, (size_t)TA * GQKV * E) TAKE(CQN, (size_t)TA * MQR * E) TAKE(CKVN, (size_t)TA * MKVR * E) TAKE(MQ, (size_t)TA * MH * MQD * E) TAKE(MKV, (size_t)TA * MH * MKVD * E)
    TAKE(O, (size_t)TA * DMIX * E) TAKE(VtM, (size_t)B * MH * MV * NK * E) TAKE(VtA, (size_t)B * SWA_KVH * 64 * NK * E) TAKE(OF, (size_t)TA * GH * GDV * E) TAKE(OB, (size_t)TA * GH * GDV * E)
#undef TAKE
    w.YB = r0; { const size_t yb = align256((size_t)NSLOT * D * E); if (r0 + yb > off) off = r0 + yb; }
    if ((size_t)NSPLIT * T * MH * MV * E <= (size_t)TA * D * E) w.OPART = w.H; else { w.OPART = off; off = align256(off + (size_t)NSPLIT * T * MH * MV * E); }
    if ((size_t)NSPLIT * T * MH * 2 * 4 <= (size_t)TA * NE * 4) w.MLPART = w.LOGITS; else { w.MLPART = off; off = align256(off + (size_t)NSPLIT * T * MH * 2 * 4); }
    w.total = off; return w;
}
constexpr WsOff WS = make_ws();

struct Params {
    const float *x, *c, *ctx, *c_ctx, *ada_w, *ada_b, *mix_norm_pre, *mix_norm_post, *ffn_norm_pre, *ffn_norm_post,
        *w_in, *w_out, *swa_sink, *gdn_conv_w, *gdn_a_log, *gdn_dt_bias, *gdn_norm_w, *mla_q_norm, *mla_w_uq, *mla_kv_norm, *mla_w_ukv,
        *router_w, *router_bias, *e_gate, *e_up, *e_down, *s_gate, *s_up, *s_down;
    float* out;
    char* ws;
#define WSF(T, name, field) HD T* name() const { return (T*)(ws + WS.field); }
    WSF(unsigned, BAR, BAR) WSF(float, MOD, MOD) WSF(float, TABA, TABA) WSF(float, TABM, TABM) WSF(float, XC, XC) WSF(float, BG, BG) WSF(float, LOGITS, LOGITS) WSF(float, EW, EW)
    WSF(int, EIDX, EIDX) WSF(int, EPOS, EPOS) WSF(int, CNT, CNT) WSF(int, CNTP, CNTP) WSF(int, CTR, CTR) WSF(float, GAM, GAM) WSF(int, TOKLIST, TOKLIST) WSF(float, WLIST, WLIST)
    WSF(st_t, H, H) WSF(st_t, SH, H) WSF(st_t, Wt_in, Wt_in) WSF(st_t, Wt_out, Wt_out) WSF(st_t, Wt_uq, Wt_uq) WSF(st_t, Wt_ukv, Wt_ukv) WSF(st_t, Wt_sgu, Wt_sgu) WSF(st_t, Wt_sd, Wt_sd)
    WSF(st_t, SACT, SACT) WSF(st_t, ACT, ACT) WSF(st_t, Y, ACT) WSF(st_t, Wt_egu, Wt_egu) WSF(st_t, Wt_ed, Wt_ed) WSF(st_t, CH, CH)
    WSF(st_t, P, P) WSF(st_t, G, G) WSF(st_t, CQN, CQN) WSF(st_t, CKVN, CKVN) WSF(st_t, MQ, MQ) WSF(st_t, MKV, MKV) WSF(st_t, O, O) WSF(st_t, VtM, VtM) WSF(st_t, VtA, VtA)
    WSF(st_t, OF, OF) WSF(st_t, OB, OB) WSF(st_t, YB, YB)
    WSF(st_t, OPART, OPART) WSF(float, MLPART, MLPART) WSF(int, BCNT, BCNT)
#undef WSF
};
inline size_t carve(Params& p, char* ws) { p.ws = ws; return WS.total; }

HD TJob static_job(const Params& p, int j) {
    const int l = j / (NJOBS / DEPTH), k = j % (NJOBS / DEPTH);
    switch (k) {
    case 0: return TJob{p.w_in + (size_t)l * D * DPROJ, p.Wt_in() + (size_t)l * DPROJP * D, D, PO_KR_SRC, PO_KR, 16, 0, D, DPROJ, 16};
    case 1: return TJob{p.w_in + (size_t)l * D * DPROJ + PO_KR_SRC, p.Wt_in() + (size_t)l * DPROJP * D + (size_t)PO_KR * D, D, MROPE, MROPE, 16, 0, D, DPROJ, 16};
    case 2: return TJob{p.w_out + (size_t)l * DMIX * D, p.Wt_out() + (size_t)l * D * DMIX, DMIX, D, D, 16, 0, DMIX, D, 16};
    case 3: return TJob{p.mla_w_uq + (size_t)l * MQR * MH * MQD, p.Wt_uq() + (size_t)l * MH * MQD * MQR, MQR, MH * MQD, MH * MQD, 16, 0, MQR, MH * MQD, 16};
    case 4: return TJob{p.mla_w_ukv + (size_t)l * MKVR * MH * MKVD, p.Wt_ukv() + (size_t)l * MH * MKVD * MKVR, MKVR, MH * MKVD, MH * MKVD, 16, 0, MKVR, MH * MKVD, 16};
    case 5: return TJob{p.s_gate + (size_t)l * D * DS, p.Wt_sgu() + (size_t)l * 2 * DS * D, D, DS, DS, 8, 0, D, DS, 4};
    case 6: return TJob{p.s_up + (size_t)l * D * DS, p.Wt_sgu() + (size_t)l * 2 * DS * D, D, DS, DS, 8, 4, D, DS, 4};
    default: return TJob{p.s_down + (size_t)l * DS * D, p.Wt_sd() + (size_t)l * D * DS, DS, D, D, 16, 0, DS, D, 16};
    }
}
HD long long static_job_items(int j) {
    const int k = j % (NJOBS / DEPTH);
    const int K = k == 2 ? DMIX : k == 3 ? MQR : k == 4 ? MKVR : k == 7 ? DS : D;
    const int npad = k == 0 ? PO_KR : k == 1 ? MROPE : k == 2 ? D : k == 3 ? MH * MQD : k == 4 ? MH * MKVD : k == 7 ? D : DS;
    return (long long)(K / 64) * ((npad + 31) / 32);
}

HD int mod_which(int r) { return r < T ? r / S : 2; }
HD const float* mod_vec(const Params& p, int layer, int r, int chunk) { return p.MOD() + ((size_t)(layer * 3 + mod_which(r)) * 6 + chunk) * D; }
HD void seq_bounds(int r, int& lo, int& hi) { if (r < T) { lo = (r / S) * S; hi = lo + S; } else { lo = T + ((r - T) / L) * L; hi = lo + L; } }
HD float* xrow(const Params& p, int r) { return r < T ? p.out + (size_t)r * D : p.XC() + (size_t)(r - T) * D; }
HD const float* xin_row(const Params& p, int layer, int r) { if (layer > 0) return xrow(p, r); return r < T ? p.x + (size_t)r * D : p.ctx + (size_t)(r - T) * D; }
HD int rows_out(int layer) { return layer == DEPTH - 1 ? T : TA; }
HD int expert_base(const int* cnt, int e) { int b = 0; for (int i = 0; i < e; ++i) b += cnt[i]; return b; }

#ifdef HOST_EMU
inline int atomic_inc(int* p) { int v;
#pragma omp atomic capture
    { v = *p; *p += 1; }
    return v; }
#else
__device__ __forceinline__ int atomic_inc(int* p) { return atomicAdd(p, 1); }
#endif

enum Stage { ST_MOD = 0, ST_ZERO, ST_NORM1, ST_ROPE_SWA, ST_GDN_CONV, ST_GDN_L2, ST_GDN_GATE, ST_MLA_NORM, ST_ROPE_MLA,
             ST_SWA, ST_GDN_SCAN, ST_GDN_OUT, ST_MLA, ST_POST1, ST_ROUTER, ST_ROUTE, ST_POST2, ST_VT, ST_TAB, ST_COUNT };

HD long long n_items(int st, int layer) {
    switch (st) {
    case ST_MOD: return (long long)DEPTH * 3 * 6 * D;
    case ST_ZERO: return DEPTH * NE + DEPTH * 16 + DEPTH * NE * 32;
    case ST_VT: return (long long)(B * MH + B * SWA_KVH) * (NK / 8) * 64;
    case ST_TAB: return 128 * 16 + 128 * 8;
    case ST_NORM1: return TA;
    case ST_ROPE_SWA: return (long long)T * 8 * 32;
    case ST_GDN_CONV: return (long long)TA * GQKV;
    case ST_GDN_L2: return (long long)TA * 12;
    case ST_GDN_GATE: return (long long)TA * 12;
    case ST_MLA_NORM: return (long long)TA * 2;
    case ST_ROPE_MLA: return (long long)T * 5 * 16;
    case ST_SWA: return (long long)rows_out(layer) * SWA_H;
    case ST_GDN_SCAN: return (long long)B * GH * 2 * GDV;
    case ST_GDN_OUT: return (long long)rows_out(layer) * GH;
    case ST_MLA: return (long long)rows_out(layer) * MH;
    case ST_POST1: return rows_out(layer);
    case ST_ROUTER: return (long long)rows_out(layer) * NE;
    case ST_ROUTE: return rows_out(layer);
    case ST_POST2: return rows_out(layer);
    }
    return 0;
}

HD float rope_inv(int i, int n) { return exp2f(-(float)i / (float)n * 13.287712379549449f); }

HD void run_item(const Params& p, int st, int layer, long long i) {
    switch (st) {
    case ST_MOD: {
        const int j = (int)(i % (6 * D)); const int w = (int)((i / (6 * D)) % 3); const int ly = (int)(i / (6 * D * 3));
        const float* cv = w < 2 ? p.c + (size_t)w * D : p.c_ctx;
        const float* W = p.ada_w + (size_t)ly * D * 6 * D;
        float acc = p.ada_b[(size_t)ly * 6 * D + j];
        for (int k = 0; k < D; ++k) acc += silu_f(cv[k]) * W[(size_t)k * 6 * D + j];
        p.MOD()[i] = acc;
    } break;
    case ST_ZERO: if (i < DEPTH * NE) p.CNT()[i] = 0; else if (i < DEPTH * NE + DEPTH * 16) p.CTR()[i - DEPTH * NE] = 0; else p.CNTP()[i - DEPTH * NE - DEPTH * 16] = 0; break;
    case ST_TAB: {
        if (i < 128 * 16) { const int pos = (int)(i / 16), ii = (int)(i % 16); const float ang = (float)pos * rope_inv(ii, 16); p.TABA()[2 * i] = cosf(ang); p.TABA()[2 * i + 1] = sinf(ang); }
        else { const long long k = i - 128 * 16; const int pos = (int)(k / 8), ii = (int)(k % 8); const float ang = (float)pos * rope_inv(ii, 8); p.TABM()[2 * k] = cosf(ang); p.TABM()[2 * k + 1] = sinf(ang); }
    } break;
    case ST_VT: {
        const int dv = (int)(i % 64); long long r = i / 64; const int kc = (int)(r % (NK / 8)); const int bh = (int)(r / (NK / 8));
        const bool mla = bh < B * MH; const int b = mla ? bh / MH : (bh - B * MH) / SWA_KVH, hd = mla ? bh % MH : (bh - B * MH) % SWA_KVH;
        st_t* dst = (mla ? p.VtM() + ((size_t)(b * MH + hd) * 64 + dv) * NK : p.VtA() + ((size_t)(b * SWA_KVH + hd) * 64 + dv) * NK) + kc * 8;
        for (int j = 0; j < 8; ++j) { const int kidx = kc * 8 + j; const int row = kidx < S ? b * S + kidx : T + b * L + (kidx - S);
            dst[j] = mla ? p.MKV()[(size_t)row * MH * MKVD + hd * MKVD + MNOPE + dv] : p.P()[(size_t)row * DPROJP + PO_VA + hd * 64 + dv]; }
    } break;
    case ST_NORM1: {
        const int r = (int)i; const float* xr = xin_row(p, layer, r); float ss = 0.f;
        for (int d = 0; d < D; ++d) ss += xr[d] * xr[d];
        const float rstd = 1.0f / sqrtf(ss / D + EPS);
        const float* gain = p.mix_norm_pre + (size_t)layer * D; const float* sh = mod_vec(p, layer, r, 0); const float* sc = mod_vec(p, layer, r, 1);
        st_t* hr = p.H() + (size_t)r * D;
        for (int d = 0; d < D; ++d) stf(hr + d, xr[d] * rstd * gain[d] * (1.0f + sc[d]) + sh[d]);
    } break;
    case ST_ROPE_SWA: {
        const int j = (int)(i % 32), hh = (int)((i / 32) % 8), r = (int)(i / 256);
        const int s = r % S, rp = s / GRID_W, cp = s % GRID_W;
        const int base = hh < 6 ? PO_QA + hh * 64 : PO_KA + (hh - 6) * 64;
        const int half = j / 16, ii = j % 16; const int i1 = base + half * 32 + ii, i2 = i1 + 16;
        const float ang = (float)(half == 0 ? rp : cp) * rope_inv(ii, 16); const float cs = cosf(ang), sn = sinf(ang);
        st_t* pr = p.P() + (size_t)r * DPROJP; const float x1 = ldf(pr + i1), x2 = ldf(pr + i2);
        stf(pr + i1, x1 * cs - x2 * sn); stf(pr + i2, x1 * sn + x2 * cs);
    } break;
    case ST_GDN_CONV: {
        const int cc = (int)(i % GQKV), r = (int)(i / GQKV); int lo, hi; seq_bounds(r, lo, hi);
        const float* w = p.gdn_conv_w + (size_t)layer * GCONV * GQKV; float acc = 0.f;
        for (int j = 0; j < GCONV; ++j) { const int rr = r + j - 2; if (rr >= lo && rr < hi) acc += w[j * GQKV + cc] * ldf(p.P() + (size_t)rr * DPROJP + PO_GQKV + cc); }
        stf(p.G() + (size_t)r * GQKV + cc, silu_f(acc));
    } break;
    case ST_GDN_L2: {
        const int hh = (int)(i % 12), r = (int)(i / 12); st_t* g = p.G() + (size_t)r * GQKV + hh * 64; float ss = 0.f;
        for (int d = 0; d < 64; ++d) { const float v = ldf(g + d); ss += v * v; }
        const float rn = 1.0f / sqrtf(ss + EPS);
        for (int d = 0; d < 64; ++d) stf(g + d, ldf(g + d) * rn);
    } break;
    case ST_GDN_GATE: {
        const int j = (int)(i % 12), r = (int)(i / 12); const st_t* pr = p.P() + (size_t)r * DPROJP + PO_BA;
        const float beta = sigmoid_f(ldf(pr + j)); const float a = ldf(pr + 12 + j);
        const float g = -expf(p.gdn_a_log[layer * 12 + j]) * softplus_f(a + p.gdn_dt_bias[layer * 12 + j]);
        p.BG()[(size_t)r * 24 + j] = beta; p.BG()[(size_t)r * 24 + 12 + j] = g;
    } break;
    case ST_MLA_NORM: {
        const int w = (int)(i % 2), r = (int)(i / 2);
        const int n = w == 0 ? MQR : MKVR; const st_t* src = p.P() + (size_t)r * DPROJP + (w == 0 ? PO_CQ : PO_CKV);
        const float* gain = w == 0 ? p.mla_q_norm + (size_t)layer * MQR : p.mla_kv_norm + (size_t)layer * MKVR;
        st_t* dst = w == 0 ? p.CQN() + (size_t)r * MQR : p.CKVN() + (size_t)r * MKVR; float ss = 0.f;
        for (int d = 0; d < n; ++d) { const float v = ldf(src + d); ss += v * v; }
        const float rstd = 1.0f / sqrtf(ss / n + EPS);
        for (int d = 0; d < n; ++d) stf(dst + d, ldf(src + d) * rstd * gain[d]);
    } break;
    case ST_ROPE_MLA: {
        const int j = (int)(i % 16), w = (int)((i / 16) % 5), r = (int)(i / 80);
        const int s = r % S, rp = s / GRID_W, cp = s % GRID_W;
        const int half = j / 8, ii = j % 8; const float ang = (float)(half == 0 ? rp : cp) * rope_inv(ii, 8); const float cs = cosf(ang), sn = sinf(ang);
        st_t* q = w < 4 ? p.MQ() + (size_t)r * MH * MQD + w * MQD + MNOPE + half * 16 + ii : p.P() + (size_t)r * DPROJP + PO_KR + half * 16 + ii;
        const float x1 = ldf(q), x2 = ldf(q + 8); stf(q, x1 * cs - x2 * sn); stf(q + 8, x1 * sn + x2 * cs);
    } break;
    case ST_SWA: {
        const int h = (int)(i % SWA_H), r = (int)(i / SWA_H); const int kvh = h / SWA_G;
        float q[64], acc[64]; const st_t* qp = p.P() + (size_t)r * DPROJP + PO_QA + h * 64;
        _Pragma("unroll") for (int d = 0; d < 64; ++d) { q[d] = ldf(qp + d) * 0.125f; acc[d] = 0.f; }
        float m = p.swa_sink[layer * SWA_H + h], den = 1.0f;
        int b, klo = 0, khi = 0;
        if (r < T) { b = r / S; const int s = r % S; klo = s - SWA_W < 0 ? 0 : s - SWA_W; khi = s + SWA_W > S - 1 ? S - 1 : s + SWA_W; } else { b = (r - T) / L; khi = -1; }
        const int nloc = khi - klo + 1;
        for (int t = 0; t < nloc + L; ++t) {
            const int kr = t < nloc ? b * S + klo + t : T + b * L + (t - nloc);
            const st_t* kp = p.P() + (size_t)kr * DPROJP + PO_KA + kvh * 64; const st_t* vp = p.P() + (size_t)kr * DPROJP + PO_VA + kvh * 64;
            float sc = 0.f; _Pragma("unroll") for (int d = 0; d < 64; ++d) sc += q[d] * ldf(kp + d);
            if (sc > m) { const float f = expf(m - sc); den *= f; _Pragma("unroll") for (int d = 0; d < 64; ++d) acc[d] *= f; m = sc; }
            const float pe = expf(sc - m); den += pe;
            _Pragma("unroll") for (int d = 0; d < 64; ++d) acc[d] += pe * ldf(vp + d);
        }
        const float inv = 1.0f / den; st_t* o = p.O() + (size_t)r * DMIX + h * 64;
        _Pragma("unroll") for (int d = 0; d < 64; ++d) stf(o + d, acc[d] * inv);
    } break;
    case ST_GDN_SCAN: {
        const int e = (int)(i % GDV), dir = (int)((i / GDV) % 2), h = (int)((i / (GDV * 2)) % GH), b = (int)(i / (GDV * 2 * GH));
        float s[64]; _Pragma("unroll") for (int d = 0; d < 64; ++d) s[d] = 0.f;
        st_t* dst = dir == 0 ? p.OF() : p.OB();
        for (int t = 0; t < L + S; ++t) {
            int r; if (t < L) r = T + b * L + (dir == 0 ? t : L - 1 - t); else { const int u = t - L; r = b * S + (dir == 0 ? u : S - 1 - u); }
            const st_t* g = p.G() + (size_t)r * GQKV; const st_t* qv = g + h * 64; const st_t* kv = g + 384 + h * 64; const float v = ldf(g + 768 + h * 64 + e);
            const float beta = p.BG()[(size_t)r * 24 + dir * 6 + h], alpha = expf(p.BG()[(size_t)r * 24 + 12 + dir * 6 + h]);
            float ks = 0.f; _Pragma("unroll") for (int d = 0; d < 64; ++d) { s[d] *= alpha; ks += ldf(kv + d) * s[d]; }
            const float vn = beta * (v - ks); float o = 0.f;
            _Pragma("unroll") for (int d = 0; d < 64; ++d) { s[d] += ldf(kv + d) * vn; o += ldf(qv + d) * s[d]; }
            stf(dst + (size_t)r * (GH * GDV) + h * 64 + e, o * 0.125f);
        }
    } break;
    case ST_GDN_OUT: {
        const int h = (int)(i % GH), r = (int)(i / GH); const st_t* of = p.OF() + (size_t)r * 384 + h * 64; const st_t* ob = p.OB() + (size_t)r * 384 + h * 64;
        float ss = 0.f; for (int d = 0; d < 64; ++d) { const float o = ldf(of + d) + ldf(ob + d); ss += o * o; }
        const float rstd = 1.0f / sqrtf(ss / 64 + EPS); const float* nw = p.gdn_norm_w + layer * 64; const st_t* z = p.P() + (size_t)r * DPROJP + PO_Z + h * 64;
        st_t* o = p.O() + (size_t)r * DMIX + 384 + h * 64;
        for (int d = 0; d < 64; ++d) stf(o + d, (ldf(of + d) + ldf(ob + d)) * rstd * nw[d] * silu_f(ldf(z + d)));
    } break;
    case ST_MLA: {
        const int h = (int)(i % MH), r = (int)(i / MH); const float scale = 1.0f / sqrtf((float)MQD);
        float acc[64]; const st_t* qp = p.MQ() + (size_t)r * MH * MQD + h * MQD;
        _Pragma("unroll") for (int d = 0; d < 64; ++d) acc[d] = 0.f;
        float m = -1e30f, den = 0.f; int b, nlat;
        if (r < T) { b = r / S; nlat = S; } else { b = (r - T) / L; nlat = 0; }
        for (int t = 0; t < nlat + L; ++t) {
            const int kr = t < nlat ? b * S + t : T + b * L + (t - nlat);
            const st_t* kn = p.MKV() + (size_t)kr * MH * MKVD + h * MKVD; const st_t* krp = p.P() + (size_t)kr * DPROJP + PO_KR;
            float sc = 0.f; for (int d = 0; d < 64; ++d) sc += ldf(qp + d) * ldf(kn + d);
            for (int d = 0; d < 32; ++d) sc += ldf(qp + 64 + d) * ldf(krp + d);
            sc *= scale;
            if (sc > m) { const float f = expf(m - sc); den *= f; _Pragma("unroll") for (int d = 0; d < 64; ++d) acc[d] *= f; m = sc; }
            const float pe = expf(sc - m); den += pe;
            _Pragma("unroll") for (int d = 0; d < 64; ++d) acc[d] += pe * ldf(kn + 64 + d);
        }
        const float inv = 1.0f / den; st_t* o = p.O() + (size_t)r * DMIX + 768 + h * 64;
        _Pragma("unroll") for (int d = 0; d < 64; ++d) stf(o + d, acc[d] * inv);
    } break;
    case ST_POST1: {
        const int r = (int)i; const st_t* y = p.Y() + (size_t)r * D; const float* xi = xin_row(p, layer, r); float* xr = xrow(p, r); float ss = 0.f;
        for (int d = 0; d < D; ++d) { const float v = ldf(y + d); ss += v * v; }
        const float rstd = 1.0f / sqrtf(ss / D + EPS); const float* gp = p.mix_norm_post + (size_t)layer * D; const float* g1 = mod_vec(p, layer, r, 2);
        float s2 = 0.f;
        for (int d = 0; d < D; ++d) { const float v = xi[d] + g1[d] * ldf(y + d) * rstd * gp[d]; xr[d] = v; s2 += v * v; }
        const float r2 = 1.0f / sqrtf(s2 / D + EPS); const float* gf = p.ffn_norm_pre + (size_t)layer * D; const float* sh = mod_vec(p, layer, r, 3); const float* sc = mod_vec(p, layer, r, 4);
        st_t* hr = p.H() + (size_t)r * D;
        for (int d = 0; d < D; ++d) stf(hr + d, xr[d] * r2 * gf[d] * (1.0f + sc[d]) + sh[d]);
    } break;
    case ST_ROUTER: {
        const int n = (int)(i % NE), r = (int)(i / NE); const st_t* a = p.H() + (size_t)r * D; const float* b = p.router_w + (size_t)layer * D * NE + n; float acc = 0.f;
        for (int k = 0; k < D; ++k) acc += ldf(a + k) * b[(size_t)k * NE];
        p.LOGITS()[(size_t)r * NE + n] = acc;
    } break;
    case ST_ROUTE: {
        const int r = (int)i; const float* lg = p.LOGITS() + (size_t)r * NE; const float* bias = p.router_bias + (size_t)layer * NE;
        float gs[NGRP];
        _Pragma("unroll") for (int g = 0; g < NGRP; ++g) { float m1 = -1e30f, m2 = -1e30f; for (int j = 0; j < 8; ++j) { const float v = sigmoid_f(lg[g * 8 + j]) + bias[g * 8 + j]; if (v > m1) { m2 = m1; m1 = v; } else if (v > m2) m2 = v; } gs[g] = m1 + m2; }
        unsigned gmask = 0;
        _Pragma("unroll") for (int k = 0; k < TOPG; ++k) { int best = 0; float bv = -1e30f; _Pragma("unroll") for (int g = 0; g < NGRP; ++g) if (!((gmask >> g) & 1u) && gs[g] > bv) { bv = gs[g]; best = g; } gmask |= 1u << best; }
        unsigned long long used = 0ull; float wsum = 0.f; float wv[TOPK]; int wi[TOPK];
        _Pragma("unroll") for (int k = 0; k < TOPK; ++k) { int best = 0; float bv = -1e30f;
            for (int e = 0; e < NE; ++e) if (((gmask >> (e / 8)) & 1u) && !((used >> e) & 1ull)) { const float v = sigmoid_f(lg[e]) + bias[e]; if (v > bv) { bv = v; best = e; } }
            used |= 1ull << best; wi[k] = best; wv[k] = sigmoid_f(lg[best]); wsum += wv[k]; }
        int* cnt = p.CNT() + layer * NE;
        _Pragma("unroll") for (int k = 0; k < TOPK; ++k) { const float w = wv[k] / wsum * ROUTED_SCALE; const int e = wi[k]; const int pos = atomic_inc(cnt + e);
            p.EIDX()[(size_t)r * TOPK + k] = e; p.EW()[(size_t)r * TOPK + k] = w; p.EPOS()[(size_t)r * TOPK + k] = pos; p.TOKLIST()[(size_t)e * TA + pos] = r; p.WLIST()[(size_t)e * TA + pos] = w; }
    } break;
    case ST_POST2: {
        const int r = (int)i; float* xr = xrow(p, r); const int* cnt = p.CNT() + layer * NE; const st_t* f[TOPK + 1]; f[0] = p.SH() + (size_t)r * D;
        _Pragma("unroll") for (int k = 0; k < TOPK; ++k) { const int e = p.EIDX()[(size_t)r * TOPK + k]; f[k + 1] = p.YB() + (size_t)(expert_base(cnt, e) + p.EPOS()[(size_t)r * TOPK + k]) * D; }
        float ss = 0.f;
        for (int d = 0; d < D; ++d) { float v = 0.f; _Pragma("unroll") for (int k = 0; k <= TOPK; ++k) v += ldf(f[k] + d); ss += v * v; }
        const float rstd = 1.0f / sqrtf(ss / D + EPS); const float* gp = p.ffn_norm_post + (size_t)layer * D; const float* g2 = mod_vec(p, layer, r, 5);
        for (int d = 0; d < D; ++d) { float v = 0.f; _Pragma("unroll") for (int k = 0; k <= TOPK; ++k) v += ldf(f[k] + d); xr[d] = xr[d] + g2[d] * v * rstd * gp[d]; }
    } break;
    }
}

enum { WT_STATIC = 0, WT_EXPERT = 1 };
HD long long wt_items(const Params& p, int kind) {
    if (kind == WT_STATIC) { long long n = 0; for (int j = 0; j < NJOBS; ++j) n += static_job_items(j); return n; }
    return (long long)NE * ((D / 64) * (DE / 32) * 2 + (DE / 64) * (D / 32));
}
HD bool wt_job(const Params& p, int kind, int layer, long long item, TJob& jb, int& kb, int& nb) {
    if (kind == WT_STATIC) {
        for (int j = 0; j < NJOBS; ++j) { const long long n = static_job_items(j); if (item < n) { jb = static_job(p, j); const int nblk = (jb.npad + 31) / 32; kb = (int)(item / nblk); nb = (int)(item % nblk); return true; } item -= n; }
        return false;
    }
    const int per_gu = (D / 64) * (DE / 32), per_d = (DE / 64) * (D / 32), per_e = 2 * per_gu + per_d;
    const int e = (int)(item / per_e); int r = (int)(item % per_e);
    if (r < 2 * per_gu) { const int w = r / per_gu; r %= per_gu; const float* src = (w == 0 ? p.e_gate : p.e_up) + ((size_t)layer * NE + e) * D * DE;
        jb = {src, p.Wt_egu() + (size_t)e * 2 * DE * D, D, DE, DE, 8, w * 4, D, DE, 4};   kb = r / (DE / 32); nb = r % (DE / 32); }
    else { r -= 2 * per_gu; jb = {p.e_down + ((size_t)layer * NE + e) * DE * D, p.Wt_ed() + (size_t)e * D * DE, DE, D, D, 16, 0, DE, D, 16}; kb = r / (D / 32); nb = r % (D / 32); }
    return true;
}
HD size_t wt_dst_row(const TJob& jb, int n) { return (size_t)(n / jb.gran) * jb.grp + (n % jb.gran) + jb.off; }
#ifdef HOST_EMU
inline void wt_item_host(const Params& p, int kind, int layer, long long item) {
    TJob jb; int kb, nb; if (!wt_job(p, kind, layer, item, jb, kb, nb)) return;
    for (int n = nb * 32; n < nb * 32 + 32 && n < jb.npad; ++n) for (int k = kb * 64; k < kb * 64 + 64; ++k)
        jb.dst[wt_dst_row(jb, n) * jb.ldt + k] = n < jb.N ? jb.src[(size_t)k * jb.ldsrc + n] : 0.f;
}
#else
__device__ __forceinline__ void wt_item_dev(const Params& p, int kind, int layer, long long item, LAS float* scr, int lane) {
    TJob jb; int kb, nb; if (!wt_job(p, kind, layer, item, jb, kb, nb)) return;
    const int k0 = kb * 64, n0 = nb * 32;
    { float tmp[32]; const int n = n0 + (lane & 31); const float* sp = jb.src + (size_t)(k0 + (lane >> 5)) * jb.ldsrc + n;
      if (n < jb.N) {
#pragma unroll
          for (int i = 0; i < 32; ++i) tmp[i] = sp[(size_t)(2 * i) * jb.ldsrc];
      } else {
#pragma unroll
          for (int i = 0; i < 32; ++i) tmp[i] = 0.f; }
#pragma unroll
      for (int i = 0; i < 32; ++i) scr[(2 * i + (lane >> 5)) * 33 + (lane & 31)] = tmp[i]; }
    asm volatile("s_waitcnt lgkmcnt(0)" ::: "memory");
    const int c = lane & 7;
#pragma unroll
    for (int j = 0; j < 4; ++j) { const int nl = (lane >> 3) + 8 * j, n = n0 + nl; const LAS float* s = scr + (8 * c) * 33 + nl;
        if (n < jb.npad) { uint4 o; o.x = pk_bf16(s[0 * 33], s[1 * 33]); o.y = pk_bf16(s[2 * 33], s[3 * 33]); o.z = pk_bf16(s[4 * 33], s[5 * 33]); o.w = pk_bf16(s[6 * 33], s[7 * 33]);
            *(uint4*)(jb.dst + wt_dst_row(jb, n) * jb.ldt + k0 + 8 * c) = o; } }
    asm volatile("s_waitcnt lgkmcnt(0)" ::: "memory");
}
#endif

enum { EPI_BF16 = 0, EPI_SWIGLU = 1, EPI_SCALE = 2, EPI_PROJ = 3, EPI_UQ = 4, EPI_UKV = 5 };
enum GStage { G_PROJ = 0, G_UQ, G_UKV, G_WOUT, G_SGU, G_SDOWN, G_EGU, G_EDOWN };
struct GemmDesc {
    const st_t* A; int lda; const int* rowidx; int a_row0, nrows;
    const st_t* Bt; int ldb, K, n0;
    int epi; st_t* out; int ldc; long long out_row0; const float* rowscale;
    const float* tab; st_t* vt;
    int perm;
};
HD int cdiv(int a, int b) { return (a + b - 1) / b; }
struct ETab { const int* eb; const int* tb; };
HD int gemm_ntiles(const Params& p, int gs, int layer, ETab et = ETab{nullptr, nullptr}) {
    const int mt = rows_out(layer) / 128;
    switch (gs) {
    case G_PROJ: return (TA / 128) * (DPROJP / 128);
    case G_UQ: return (TA / 128) * (MH * MQD / 128);
    case G_UKV: return (TA / 128) * (MH * MKVD / 128);
    case G_WOUT: return mt * (D / 128);
    case G_SGU: return mt * (2 * DS / 128);
    case G_SDOWN: return mt * (D / 128);
    case G_EGU: case G_EDOWN: { int t = 0; if (et.tb) t = et.tb[NE]; else for (int e = 0; e < NE; ++e) t += cdiv(p.CNT()[layer * NE + e], 128); return t * (gs == G_EGU ? 2 * DE / 128 : D / 128); }
    }
    return 0;
}
HD void gemm_desc(const Params& p, int gs, int layer, int item, GemmDesc& g, ETab et = ETab{nullptr, nullptr}) {
    g.rowidx = nullptr; g.rowscale = nullptr; g.nrows = 128; g.epi = EPI_BF16; g.tab = nullptr; g.vt = nullptr; g.perm = (gs == G_WOUT || gs == G_SGU || gs == G_SDOWN || gs == G_EGU || gs == G_EDOWN) ? 1 : 0;
    auto plain = [&](const st_t* A, int lda, const st_t* Bt, int K, int ntn, st_t* out, int ldc) {
        const int mtn = (gs == G_PROJ || gs == G_UQ || gs == G_UKV ? TA : rows_out(layer)) / 128, PW = ntn < 8 ? ntn : 8, nfull = ntn / PW;
        int mt, nt; { const int pidx = item / (mtn * PW); if (pidx < nfull) { const int w = item - pidx * mtn * PW; mt = w / PW; nt = pidx * PW + w % PW; } else { const int pw = ntn - nfull * PW, w = item - nfull * mtn * PW; mt = w / pw; nt = nfull * PW + w % pw; } }
        g.A = A; g.lda = lda; g.a_row0 = mt * 128; g.Bt = Bt; g.ldb = K; g.K = K; g.n0 = nt * 128; g.out = out; g.ldc = ldc; g.out_row0 = mt * 128; };
    switch (gs) {
    case G_PROJ: plain(p.H(), D, p.Wt_in() + (size_t)layer * DPROJP * D, D, DPROJP / 128, p.P(), DPROJP); g.epi = EPI_PROJ; g.tab = g.n0 + 128 > PO_KR ? p.TABM() : p.TABA(); g.vt = p.VtA(); break;
    case G_UQ: plain(p.CQN(), MQR, p.Wt_uq() + (size_t)layer * MH * MQD * MQR, MQR, MH * MQD / 128, p.MQ(), MH * MQD); g.epi = EPI_UQ; g.tab = p.TABM(); break;
    case G_UKV: plain(p.CKVN(), MKVR, p.Wt_ukv() + (size_t)layer * MH * MKVD * MKVR, MKVR, MH * MKVD / 128, p.MKV(), MH * MKVD); g.epi = EPI_UKV; g.vt = p.VtM(); break;
    case G_WOUT: plain(p.O(), DMIX, p.Wt_out() + (size_t)layer * D * DMIX, DMIX, D / 128, p.Y(), D); break;
    case G_SGU: plain(p.H(), D, p.Wt_sgu() + (size_t)layer * 2 * DS * D, D, 2 * DS / 128, p.SACT(), DS); g.epi = EPI_SWIGLU; break;
    case G_SDOWN: plain(p.SACT(), DS, p.Wt_sd() + (size_t)layer * D * DS, DS, D / 128, p.SH(), D); break;
    case G_EGU: case G_EDOWN: {
        const int ntn = gs == G_EGU ? 2 * DE / 128 : D / 128; int mt = item / ntn; const int nt = item % ntn; const int* cnt = p.CNT() + layer * NE;
        int e = 0, base = 0;
        if (et.tb) { int lo = 0, hi = NE - 1; while (lo < hi) { const int mid = (lo + hi + 1) >> 1; if (et.tb[mid] <= mt) lo = mid; else hi = mid - 1; } e = lo; mt -= et.tb[e]; base = et.eb[e]; }
        else for (; e < NE; ++e) { const int te = cdiv(cnt[e], 128); if (mt < te) break; mt -= te; base += cnt[e]; }
        g.a_row0 = mt * 128; g.nrows = cnt[e] - mt * 128 < 128 ? cnt[e] - mt * 128 : 128; g.n0 = nt * 128; g.out_row0 = base + mt * 128;
        if (gs == G_EGU) { g.A = p.H(); g.lda = D; g.rowidx = p.TOKLIST() + (size_t)e * TA; g.Bt = p.Wt_egu() + (size_t)e * 2 * DE * D; g.ldb = D; g.K = D; g.epi = EPI_SWIGLU; g.out = p.ACT(); g.ldc = DE; }
        else { g.A = p.ACT() + (size_t)base * DE; g.lda = DE; g.Bt = p.Wt_ed() + (size_t)e * D * DE; g.ldb = DE; g.K = DE; g.epi = EPI_SCALE; g.out = p.YB(); g.ldc = D; g.rowscale = p.WLIST() + (size_t)e * TA - base; }
    } break;
    }
}
HD bool epi_needs_partner(const GemmDesc& g, int cb) { return g.epi == EPI_UQ || (g.epi == EPI_PROJ && g.n0 + cb + 64 > PO_KR); }
HD void rope8(float (&v)[4], const float (&pv)[4], int q, const float* tab, int pos) {
    for (int r = 0; r < 4; ++r) { const int c16 = q * 4 + r, i = c16 & 7; const float cs = tab[(pos * 8 + i) * 2], sn = tab[(pos * 8 + i) * 2 + 1];
        v[r] = c16 < 8 ? v[r] * cs - pv[r] * sn : pv[r] * sn + v[r] * cs; }
}
HD void gemm_epi(const GemmDesc& g, int rl, int cb, int q, float (&v)[4][4], const float (&pv)[4][4]) {
    if (rl >= g.nrows) return;
    const long long orow = g.out_row0 + rl;
    if (g.perm) {
        if (g.epi == EPI_SWIGLU) { float a[2][4]; for (int jj = 0; jj < 2; ++jj) for (int r = 0; r < 4; ++r) a[jj][r] = silu_f(v[2 * jj][r]) * v[2 * jj + 1][r];
            st8(g.out + (size_t)orow * g.ldc + (g.n0 + cb + 16 * q) / 2, a[0], a[1]); return; }
        const float w = g.epi == EPI_SCALE ? g.rowscale[orow] : 1.0f;
        for (int j = 0; j < 4; ++j) for (int r = 0; r < 4; ++r) v[j][r] *= w;
        st_t* o = g.out + (size_t)orow * g.ldc + g.n0 + cb + 16 * q; st8(o, v[0], v[1]); st8(o + 8, v[2], v[3]); return;
    }
    if (g.epi == EPI_SWIGLU) {
        for (int jj = 0; jj < 2; ++jj) { float a[4]; for (int r = 0; r < 4; ++r) a[r] = silu_f(v[2 * jj][r]) * v[2 * jj + 1][r];
            st4(g.out + (size_t)orow * g.ldc + (g.n0 + cb) / 2 + jj * 16 + q * 4, a[0], a[1], a[2], a[3]); }
        return;
    }
    if (g.epi >= EPI_PROJ) {
        const int row = (int)orow; const bool lat = row < T; const int bb = lat ? row / S : (row - T) / L, kidx = lat ? row % S : S + (row - T) % L;
        const int rp = lat ? (row % S) / GRID_W : 0, cp = lat ? (row % S) % GRID_W : 0, span = (g.n0 + cb) / 64;
        if (g.epi == EPI_PROJ) {
            if (span < 8) { if (lat) for (int hp = 0; hp < 2; ++hp) for (int r = 0; r < 4; ++r) { const int i = q * 4 + r, pos = hp ? cp : rp; const float cs = g.tab[(pos * 16 + i) * 2], sn = g.tab[(pos * 16 + i) * 2 + 1];
                    const float x1 = v[2 * hp][r], x2 = v[2 * hp + 1][r]; v[2 * hp][r] = x1 * cs - x2 * sn; v[2 * hp + 1][r] = x1 * sn + x2 * cs; } }
            else if (span < 10) { for (int j = 0; j < 4; ++j) for (int r = 0; r < 4; ++r) stf(g.vt + ((size_t)(bb * SWA_KVH + span - 8) * 64 + j * 16 + q * 4 + r) * NK + kidx, v[j][r]); return; }
            else if (g.n0 + cb + 64 > PO_KR && lat) { rope8(v[2], pv[2], q, g.tab, rp); rope8(v[3], pv[3], q, g.tab, cp); }
        } else if (g.epi == EPI_UQ) {
            if (lat) for (int j = 0; j < 4; ++j) { const int k6 = ((g.n0 + cb) / 16 + j) % 6; if (k6 >= 4) rope8(v[j], pv[j], q, g.tab, k6 == 4 ? rp : cp); }
        } else {
            if (span & 1) { for (int j = 0; j < 4; ++j) for (int r = 0; r < 4; ++r) stf(g.vt + ((size_t)(bb * MH + span / 2) * 64 + j * 16 + q * 4 + r) * NK + kidx, v[j][r]); return; }
        }
    }
    const float w = g.epi == EPI_SCALE ? g.rowscale[orow] : 1.0f;
    for (int j = 0; j < 4; ++j) st4(g.out + (size_t)orow * g.ldc + g.n0 + cb + j * 16 + q * 4, v[j][0] * w, v[j][1] * w, v[j][2] * w, v[j][3] * w);
}
#ifdef HOST_EMU
inline void gemm_tile_host(const GemmDesc& g) {
    for (int rl = 0; rl < g.nrows; ++rl) {
        const long long ar = g.rowidx ? g.rowidx[g.a_row0 + rl] : g.a_row0 + rl; const st_t* a = g.A + (size_t)ar * g.lda;
        for (int cb = 0; cb < 128; cb += 64) for (int q = 0; q < 4; ++q) { float v[4][4], pv[4][4];
            for (int j = 0; j < 4; ++j) for (int r = 0; r < 4; ++r) { const st_t* b = g.Bt + (size_t)(g.n0 + cb + (g.perm ? q * 16 + j * 4 + r : j * 16 + q * 4 + r)) * g.ldb; float acc = 0.f; for (int k = 0; k < g.K; ++k) acc += a[k] * b[k]; v[j][r] = acc;
                const st_t* b2 = g.Bt + (size_t)(g.n0 + cb + j * 16 + (q ^ 2) * 4 + r) * g.ldb; float acc2 = 0.f; for (int k = 0; k < g.K; ++k) acc2 += a[k] * b2[k]; pv[j][r] = acc2; }
            gemm_epi(g, rl, cb, q, v, pv); }
    }
}
#else
__device__ __forceinline__ void gemm_tile_dev(const GemmDesc& g, LAS unsigned char* lds, const int tid) {
    const int lane = tid & 63, wave = __builtin_amdgcn_readfirstlane(tid >> 6), wr = wave >> 1, wc = wave & 1;
    const int lrow = lane >> 3, slot = lane & 7;
    const st_t* asrc[4]; const st_t* bsrc[4];
#pragma unroll
    for (int i = 0; i < 4; ++i) {
        const int row = i * 32 + wave * 8 + lrow, chunk = slot ^ ((row >> 1) & 7);
        int rl = row < g.nrows ? row : g.nrows - 1;
        const long long ar = g.rowidx ? (long long)g.rowidx[g.a_row0 + rl] : (long long)(g.a_row0 + rl);
        asrc[i] = g.A + (size_t)ar * g.lda + chunk * 8;
        const int brow = g.perm ? (row & 64) + ((row >> 2) & 3) * 16 + ((row >> 4) & 3) * 4 + (row & 3) : row;
        bsrc[i] = g.Bt + (size_t)(g.n0 + brow) * g.ldb + chunk * 8;
    }
    const int nt = g.K / 64;
    auto stage = [&](int buf, int t) {
#pragma unroll
        for (int i = 0; i < 4; ++i) {
            __builtin_amdgcn_global_load_lds((const unsigned*)(asrc[i] + t * 64), (LAS unsigned*)(lds + buf * 32768 + (i * 32 + wave * 8) * 128), 16, 0, 0);
            __builtin_amdgcn_global_load_lds((const unsigned*)(bsrc[i] + t * 64), (LAS unsigned*)(lds + buf * 32768 + 16384 + (i * 32 + wave * 8) * 128), 16, 0, 0);
        }
    };
    f32x4 acc[4][4];
#pragma unroll
    for (int i = 0; i < 4; ++i)
#pragma unroll
        for (int j = 0; j < 4; ++j) acc[i][j] = (f32x4){0.f, 0.f, 0.f, 0.f};
    const int fr = lane & 15, fq = lane >> 4;
    __syncthreads();
    stage(0, 0);
    __syncthreads();
    for (int t = 0; t < nt; ++t) {
        const int cur = t & 1;
        if (t + 1 < nt) stage(cur ^ 1, t + 1);
        const LAS unsigned char* As = lds + cur * 32768; const LAS unsigned char* Bs = As + 16384;
#pragma unroll
        for (int kk = 0; kk < 2; ++kk) {
            bf16x8 af[4], bfr[4];
#pragma unroll
            for (int i = 0; i < 4; ++i) { const int row = wr * 64 + i * 16 + fr; af[i] = *(const LAS bf16x8*)(As + row * 128 + (((kk * 4 + fq) ^ ((row >> 1) & 7)) << 4)); }
#pragma unroll
            for (int j = 0; j < 4; ++j) { const int row = wc * 64 + j * 16 + fr; bfr[j] = *(const LAS bf16x8*)(Bs + row * 128 + (((kk * 4 + fq) ^ ((row >> 1) & 7)) << 4)); }
#pragma unroll
            for (int i = 0; i < 4; ++i)
#pragma unroll
                for (int j = 0; j < 4; ++j) acc[i][j] = __builtin_amdgcn_mfma_f32_16x16x32_bf16(bfr[j], af[i], acc[i][j], 0, 0, 0);
        }
        __syncthreads();
    }
    const bool need_pv = epi_needs_partner(g, wc * 64);
#pragma unroll
    for (int i = 0; i < 4; ++i) { float v[4][4], pv[4][4];
#pragma unroll
        for (int j = 0; j < 4; ++j)
#pragma unroll
            for (int r = 0; r < 4; ++r) { v[j][r] = acc[i][j][r]; pv[j][r] = 0.f; }
        if (need_pv) {
#pragma unroll
            for (int j = 0; j < 4; ++j)
#pragma unroll
                for (int r = 0; r < 4; ++r) pv[j][r] = __shfl_xor(v[j][r], 32); }
        gemm_epi(g, wr * 64 + i * 16 + fr, wc * 64, fq, v, pv); }
}
#endif


struct AttnDesc {
    int dqk;
    const st_t* Q; int ldq, q_row0;
    const st_t* K1; int ldk1; const st_t* K2; int ldk2;
    int lat_row0, ctx_row0;
    const st_t* Vt;
    int kt_lo, kt_hi, nctx, ctx_t0;
    int mask, qpos0;
    float m_init, l_init, c;
    st_t* O; int o_col;
    int part; st_t* opart; float* mlpart;
};
HD int attn_nitems(int layer) { const int lat = B * MH * (S / 128) * NSPLIT + B * SWA_H * (S / 128); return layer == DEPTH - 1 ? lat : lat + B * MH * (L / 128) + B * SWA_H * (L / 128); }
HD int attn_queue_size(int layer, int x) {
    const int NQ = S / 128, NQC = L / 128, half = x / 4; int n = NCHAIN / 8 + NQ * NSPLIT + SWA_G * (NQ * (half + 1) / 2 - NQ * half / 2);
    if (layer < DEPTH - 1) n += NQC + SWA_G * (NQC * (half + 1) / 2 - NQC * half / 2);
    return n;
}
HD int attn_queue_item(int layer, int x, int k) {
    const int NQ = S / 128, NQC = L / 128, half = x / 4, n_mla = B * MH * NQ * NSPLIT, n_swa = B * SWA_H * NQ, n_mlac = B * MH * NQC;
    if (k < NCHAIN / 8) return x * (NCHAIN / 8) + k; k -= NCHAIN / 8;
    if (k < NQ * NSPLIT) return NCHAIN + x * NQ * NSPLIT + k; k -= NQ * NSPLIT;
    const int gb = (x % 4) / SWA_KVH, gk = (x % 4) % SWA_KVH;
    { const int qlo = NQ * half / 2, nq = NQ * (half + 1) / 2 - qlo; if (k < SWA_G * nq) { const int h = gk * SWA_G + k / nq; return NCHAIN + n_mla + (gb * SWA_H + h) * NQ + qlo + k % nq; } k -= SWA_G * nq; }
    if (k < NQC) return NCHAIN + n_mla + n_swa + x * NQC + k; k -= NQC;
    { const int qlo = NQC * half / 2, nq = NQC * (half + 1) / 2 - qlo; const int h = gk * SWA_G + k / (nq > 0 ? nq : 1); return NCHAIN + n_mla + n_swa + n_mlac + (gb * SWA_H + h) * NQC + qlo + k % (nq > 0 ? nq : 1); }
}
static_assert(NCHAIN % 8 == 0 && B * MH == 8 && B * SWA_KVH == 4, "queue layout");
HD void attn_desc(const Params& p, int layer, int item, AttnDesc& a) {
    const float LOG2E = 1.4426950408889634f;
    const int n_mla = B * MH * (S / 128) * NSPLIT, n_swa = B * SWA_H * (S / 128), n_mlac = B * MH * (L / 128);
    bool mla, ctxq; int b, h, qb, part = -1;
    if (item < n_mla) { mla = true; ctxq = false; qb = item % (S / 128); item /= S / 128; part = item % NSPLIT; item /= NSPLIT; h = item % MH; b = item / MH; }
    else if (item < n_mla + n_swa) { item -= n_mla; mla = false; ctxq = false; qb = item % (S / 128); h = (item / (S / 128)) % SWA_H; b = item / (S / 128) / SWA_H; }
    else if (item < n_mla + n_swa + n_mlac) { item -= n_mla + n_swa; mla = true; ctxq = true; qb = item % (L / 128); h = (item / (L / 128)) % MH; b = item / (L / 128) / MH; }
    else { item -= n_mla + n_swa + n_mlac; mla = false; ctxq = true; qb = item % (L / 128); h = (item / (L / 128)) % SWA_H; b = item / (L / 128) / SWA_H; }
    a.q_row0 = ctxq ? T + b * L + qb * 128 : b * S + qb * 128; a.lat_row0 = b * S; a.ctx_row0 = T + b * L; a.nctx = L / 64; a.qpos0 = qb * 128; a.O = p.O(); a.ctx_t0 = 0; a.part = -1; a.opart = nullptr; a.mlpart = nullptr;
    if (mla) {
        a.dqk = 96; a.Q = p.MQ() + h * MQD; a.ldq = MH * MQD; a.K1 = p.MKV() + h * MKVD; a.ldk1 = MH * MKVD; a.K2 = p.P() + PO_KR; a.ldk2 = DPROJP;
        a.Vt = p.VtM() + (size_t)(b * MH + h) * 64 * NK; a.kt_lo = 0; a.kt_hi = ctxq ? 0 : S / 64; a.mask = 0; a.m_init = -1e30f; a.l_init = 0.f; a.c = LOG2E / sqrtf((float)MQD); a.o_col = 768 + h * 64;
        if (part >= 0 && NSPLIT > 1) {
            const int CT = (NK / 64) / NSPLIT, t0 = part * CT, t1 = t0 + CT, nl = S / 64;
            a.kt_lo = t0 < nl ? t0 : nl; a.kt_hi = t1 < nl ? t1 : nl; a.nctx = t1 > nl ? t1 - (t0 > nl ? t0 : nl) : 0; a.ctx_t0 = t0 > nl ? t0 - nl : 0;
            a.part = part; a.opart = p.OPART() + (size_t)part * T * MH * MV + h * MV; a.mlpart = p.MLPART() + ((size_t)part * T * MH + h) * 2; }
    } else {
        const int kvh = h / SWA_G;
        a.dqk = 64; a.Q = p.P() + PO_QA + h * 64; a.ldq = DPROJP; a.K1 = p.P() + PO_KA + kvh * 64; a.ldk1 = DPROJP; a.K2 = nullptr; a.ldk2 = 0;
        a.Vt = p.VtA() + (size_t)(b * SWA_KVH + kvh) * 64 * NK; a.mask = ctxq ? 0 : 1;
        if (ctxq) { a.kt_lo = 0; a.kt_hi = 0; } else { a.kt_lo = (a.qpos0 - SWA_W) / 64; if (a.kt_lo < 0) a.kt_lo = 0; a.kt_hi = (a.qpos0 + 128 + SWA_W) / 64; if (a.kt_hi > S / 64) a.kt_hi = S / 64; }
        a.m_init = p.swa_sink[layer * SWA_H + h] * LOG2E; a.l_init = 1.f; a.c = LOG2E * 0.125f; a.o_col = h * 64;
    }
}
#ifdef HOST_EMU
inline void attn_tile_host(const AttnDesc& a) {
    const int nl = a.kt_hi - a.kt_lo, ntile = nl + a.nctx;
    for (int q = 0; q < 128; ++q) {
        const st_t* qr = a.Q + (size_t)(a.q_row0 + q) * a.ldq; float m = a.m_init, l = a.l_init, acc[64]; for (int d = 0; d < 64; ++d) acc[d] = 0.f;
        for (int t = 0; t < ntile; ++t) for (int kk = 0; kk < 64; ++kk) {
            const int kidx = t < nl ? (a.kt_lo + t) * 64 + kk : S + (a.ctx_t0 + t - nl) * 64 + kk; const int row = kidx < S ? a.lat_row0 + kidx : a.ctx_row0 + kidx - S;
            if (a.mask && t < nl) { const int dq = a.qpos0 + q - kidx; if (dq > SWA_W || dq < -SWA_W) continue; }
            float sc = 0.f; for (int d = 0; d < 64; ++d) sc += qr[d] * a.K1[(size_t)row * a.ldk1 + d];
            if (a.dqk > 64) for (int d = 64; d < a.dqk; ++d) sc += qr[d] * a.K2[(size_t)row * a.ldk2 + d - 64];
            sc *= a.c; if (sc > m) { const float f = exp2f(m - sc); l *= f; for (int d = 0; d < 64; ++d) acc[d] *= f; m = sc; }
            const float pe = exp2f(sc - m); l += pe; for (int d = 0; d < 64; ++d) acc[d] += pe * a.Vt[(size_t)d * NK + kidx];
        }
        if (a.part >= 0) { for (int d = 0; d < 64; ++d) a.opart[(size_t)(a.q_row0 + q) * MH * MV + d] = acc[d] / l; a.mlpart[(size_t)(a.q_row0 + q) * MH * 2] = m; a.mlpart[(size_t)(a.q_row0 + q) * MH * 2 + 1] = l; }
        else for (int d = 0; d < 64; ++d) a.O[(size_t)(a.q_row0 + q) * DMIX + a.o_col + d] = acc[d] / l;
    }
}
#else
typedef float f32x16 __attribute__((ext_vector_type(16)));
typedef unsigned u32x4 __attribute__((ext_vector_type(4)));
typedef unsigned u32x2 __attribute__((ext_vector_type(2)));
__device__ __forceinline__ int crow16(int reg, int h) { return (reg & 3) + 8 * (reg >> 2) + 4 * h; }
template <int DQK>
__device__ __forceinline__ void attn_tile_dev(const AttnDesc& a, LAS unsigned char* lds, const int tid) {
    constexpr int KSTR = DQK * 2 + 16, VSTR = 136, KBYTES = 64 * KSTR, BUF = KBYTES + 64 * VSTR, CPR = DQK / 8, KCH = 64 * CPR / 256, NKS = DQK / 16;
    const int lane = tid & 63, wave = __builtin_amdgcn_readfirstlane(tid >> 6), l31 = lane & 31, hh = lane >> 5;
    bf16x8 qf[NKS];
    { const st_t* qrow = a.Q + (size_t)(a.q_row0 + wave * 32 + l31) * a.ldq;
#pragma unroll
      for (int ks = 0; ks < NKS; ++ks) qf[ks] = *(const bf16x8*)(qrow + 16 * ks + 8 * hh); }
    f32x16 ot[2];
#pragma unroll
    for (int r = 0; r < 16; ++r) { ot[0][r] = 0.f; ot[1][r] = 0.f; }
    float m = a.m_init, lsum = hh == 0 ? a.l_init : 0.f;
    const int nl = a.kt_hi - a.kt_lo, ntile = nl + a.nctx; const float c = a.c;
    u32x4 kreg[2][KCH], vreg[2][2];
    auto gload = [&](auto PC, int t) { constexpr int P = decltype(PC)::value;
        const int kidx0 = t < nl ? (a.kt_lo + t) * 64 : S + (a.ctx_t0 + t - nl) * 64; const int rowbase = t < nl ? a.lat_row0 + kidx0 : a.ctx_row0 + kidx0 - S;
#pragma unroll
        for (int u = 0; u < KCH; ++u) { const int ci = tid + 256 * u, row = ci / CPR, cc = ci % CPR;
            const st_t* src = (DQK == 64 || cc < 8) ? a.K1 + (size_t)(rowbase + row) * a.ldk1 + cc * 8 : a.K2 + (size_t)(rowbase + row) * a.ldk2 + (cc - 8) * 8;
            kreg[P][u] = *(const u32x4*)src; }
#pragma unroll
        for (int u = 0; u < 2; ++u) { const int ci = tid + 256 * u, dv = ci >> 3, cc = ci & 7; vreg[P][u] = *(const u32x4*)(a.Vt + (size_t)dv * NK + kidx0 + cc * 8); }
    };
    auto lstore = [&](auto PC) { constexpr int P = decltype(PC)::value;
#pragma unroll
        for (int u = 0; u < KCH; ++u) { const int ci = tid + 256 * u, row = ci / CPR, cc = ci % CPR; *(LAS u32x4*)(lds + P * BUF + row * KSTR + cc * 16) = kreg[P][u]; }
#pragma unroll
        for (int u = 0; u < 2; ++u) { const int ci = tid + 256 * u, dv = ci >> 3, cc = ci & 7; LAS u32x2* d = (LAS u32x2*)(lds + P * BUF + KBYTES + dv * VSTR + cc * 16);
            d[0] = (u32x2){vreg[P][u].x, vreg[P][u].y}; d[1] = (u32x2){vreg[P][u].z, vreg[P][u].w}; }
    };
    using I0 = std::integral_constant<int, 0>; using I1 = std::integral_constant<int, 1>;
    __syncthreads();
    gload(I0{}, 0); lstore(I0{});
    if (ntile > 1) gload(I1{}, 1);
    __syncthreads();
    auto body = [&](auto PC, const int t) { constexpr int cur = decltype(PC)::value; using PN = std::integral_constant<int, 1 - cur>;
        if (t + 2 < ntile) gload(PC, t + 2);
        const LAS unsigned char* Ks = lds + cur * BUF; const LAS unsigned char* Vs = Ks + KBYTES;
        f32x16 st[2];
        {
            bf16x8 kf[2][NKS];
#pragma unroll
            for (int ks = 0; ks < NKS; ++ks)
#pragma unroll
                for (int kb = 0; kb < 2; ++kb) kf[kb][ks] = *(const LAS bf16x8*)(Ks + (kb * 32 + l31) * KSTR + (16 * ks + 8 * hh) * 2);
            __builtin_amdgcn_sched_barrier(0);
#pragma unroll
            for (int r = 0; r < 16; ++r) { st[0][r] = 0.f; st[1][r] = 0.f; }
#pragma unroll
            for (int ks = 0; ks < NKS; ++ks)
#pragma unroll
                for (int kb = 0; kb < 2; ++kb) st[kb] = __builtin_amdgcn_mfma_f32_32x32x16_bf16(kf[kb][ks], qf[ks], st[kb], 0, 0, 0);
        }
        u32x2 vlo[2][2][2], vhi[2][2][2];
#pragma unroll
        for (int kb = 0; kb < 2; ++kb)
#pragma unroll
            for (int s2 = 0; s2 < 2; ++s2)
#pragma unroll
                for (int db = 0; db < 2; ++db) { const LAS unsigned char* vp = Vs + (db * 32 + l31) * VSTR + (kb * 32 + 16 * s2 + 4 * hh) * 2;
                    vlo[kb][s2][db] = *(const LAS u32x2*)vp; vhi[kb][s2][db] = *(const LAS u32x2*)(vp + 16); }
        __builtin_amdgcn_sched_barrier(0);
        if (a.mask && t < nl) {
            const int d0 = a.qpos0 + wave * 32 + l31 - (a.kt_lo + t) * 64;
#pragma unroll
            for (int kb = 0; kb < 2; ++kb)
#pragma unroll
                for (int r = 0; r < 16; ++r) { const int dq = d0 - (kb * 32 + crow16(r, hh)); if (dq > SWA_W || dq < -SWA_W) st[kb][r] = -1e30f; }
        }
        float mx = st[0][0];
#pragma unroll
        for (int r = 1; r < 16; ++r) mx = fmaxf(mx, st[0][r]);
#pragma unroll
        for (int r = 0; r < 16; ++r) mx = fmaxf(mx, st[1][r]);
        mx = fmaxf(mx, __shfl_xor(mx, 32));
        const float m_new = fmaxf(m, mx * c), alpha = __builtin_amdgcn_exp2f(m - m_new);
        float rs = 0.f;
#pragma unroll
        for (int kb = 0; kb < 2; ++kb)
#pragma unroll
            for (int r = 0; r < 16; ++r) { const float pe = __builtin_amdgcn_exp2f(__builtin_fmaf(st[kb][r], c, -m_new)); st[kb][r] = pe; rs += pe; }
        lsum = lsum * alpha + rs; m = m_new;
#pragma unroll
        for (int r = 0; r < 16; ++r) { ot[0][r] *= alpha; ot[1][r] *= alpha; }
#pragma unroll
        for (int kb = 0; kb < 2; ++kb)
#pragma unroll
            for (int s2 = 0; s2 < 2; ++s2) {
                u32x4 pw; pw.x = pk_bf16(st[kb][8 * s2 + 0], st[kb][8 * s2 + 1]); pw.y = pk_bf16(st[kb][8 * s2 + 2], st[kb][8 * s2 + 3]);
                pw.z = pk_bf16(st[kb][8 * s2 + 4], st[kb][8 * s2 + 5]); pw.w = pk_bf16(st[kb][8 * s2 + 6], st[kb][8 * s2 + 7]);
                const bf16x8 pb = __builtin_bit_cast(bf16x8, pw);
#pragma unroll
                for (int db = 0; db < 2; ++db) { const u32x2 lo = vlo[kb][s2][db], hi = vhi[kb][s2][db]; u32x4 vw; vw.x = lo.x; vw.y = lo.y; vw.z = hi.x; vw.w = hi.y;
                    ot[db] = __builtin_amdgcn_mfma_f32_32x32x16_bf16(__builtin_bit_cast(bf16x8, vw), pb, ot[db], 0, 0, 0); }
            }
        if (t + 1 < ntile) lstore(PN{});
        __syncthreads();
    };
    for (int t = 0; t < ntile; t += 2) { body(I0{}, t); if (t + 1 < ntile) body(I1{}, t + 1); }
    const float ltot = lsum + __shfl_xor(lsum, 32), inv = 1.0f / ltot;
    st_t* orow = a.O + (size_t)(a.q_row0 + wave * 32 + l31) * DMIX + a.o_col;
    if (a.part >= 0) { orow = a.opart + (size_t)(a.q_row0 + wave * 32 + l31) * MH * MV;
        if (hh == 0) { float* ml = a.mlpart + (size_t)(a.q_row0 + wave * 32 + l31) * MH * 2; ml[0] = m; ml[1] = ltot; } }
#pragma unroll
    for (int db = 0; db < 2; ++db)
#pragma unroll
        for (int g = 0; g < 4; ++g) st4(orow + db * 32 + 8 * g + 4 * hh, ot[db][4 * g] * inv, ot[db][4 * g + 1] * inv, ot[db][4 * g + 2] * inv, ot[db][4 * g + 3] * inv);
}
#endif


HD int gdn_row(int b, int dir, int n, int i) {
    if (n < L / 64) { const int pos = n * 64 + i; return T + b * L + (dir == 0 ? pos : L - 1 - pos); }
    const int pos = (n - L / 64) * 64 + i; return b * S + (dir == 0 ? pos : S - 1 - pos);
}
#ifdef HOST_EMU
inline void gdn_pre_host(const Params& p, int item) {
    const int c = item / NCH, n = item % NCH, dir = c & 1, h = (c >> 1) % GH, b = (c >> 1) / GH;
    float gc[64], beta[64]; const st_t* kk[64]; const st_t* qq[64]; const st_t* vv[64]; float acc = 0.f;
    for (int i = 0; i < 64; ++i) { const int r = gdn_row(b, dir, n, i); acc += p.BG()[(size_t)r * 24 + 12 + dir * 6 + h]; gc[i] = acc; beta[i] = p.BG()[(size_t)r * 24 + dir * 6 + h];
        qq[i] = p.G() + (size_t)r * GQKV + h * 64; kk[i] = qq[i] + 384; vv[i] = qq[i] + 768; }
    static thread_local float A[64][64], XU[64][64], XW[64][64];
    for (int i = 0; i < 64; ++i) for (int j = 0; j < 64; ++j) { float d = 0.f; for (int e = 0; e < 64; ++e) d += kk[i][e] * kk[j][e]; A[i][j] = j < i ? beta[i] * d * expf(gc[i] - gc[j]) : 0.f; }
    for (int i = 0; i < 64; ++i) for (int e = 0; e < 64; ++e) { float u = beta[i] * vv[i][e], w = beta[i] * expf(gc[i]) * kk[i][e];
        for (int j = 0; j < i; ++j) { u -= A[i][j] * XU[j][e]; w -= A[i][j] * XW[j][e]; } XU[i][e] = u; XW[i][e] = w; }
    st_t* ch = p.CH() + (size_t)item * 5 * 4096;
    for (int i = 0; i < 64; ++i) for (int e = 0; e < 64; ++e) {
        ch[0 * 4096 + e * 64 + i] = XU[i][e]; ch[1 * 4096 + i * 64 + e] = XW[i][e]; ch[2 * 4096 + i * 64 + e] = qq[i][e] * 0.125f * expf(gc[i]);
        float d = 0.f; for (int x = 0; x < 64; ++x) d += qq[i][x] * kk[e][x]; ch[3 * 4096 + i * 64 + e] = e <= i ? d * 0.125f * expf(gc[i] - gc[e]) : 0.f;
        ch[4 * 4096 + e * 64 + i] = kk[i][e] * expf(gc[63] - gc[i]); }
    p.GAM()[item] = expf(gc[63]);
}
inline void gdn_scan_host(const Params& p, int c) {
    const int dir = c & 1, h = (c >> 1) % GH, b = (c >> 1) / GH; st_t* dst = dir == 0 ? p.OF() : p.OB();
    static thread_local float Sm[64][64], Vn[64][64]; for (int d = 0; d < 64; ++d) for (int e = 0; e < 64; ++e) Sm[d][e] = 0.f;
    for (int n = 0; n < NCH; ++n) { const st_t* ch = p.CH() + (size_t)(c * NCH + n) * 5 * 4096; const float gam = p.GAM()[c * NCH + n];
        for (int i = 0; i < 64; ++i) for (int e = 0; e < 64; ++e) { float v = ch[0 * 4096 + e * 64 + i]; for (int d = 0; d < 64; ++d) v -= ch[1 * 4096 + i * 64 + d] * Sm[d][e]; Vn[i][e] = v; }
        for (int i = 0; i < 64; ++i) for (int e = 0; e < 64; ++e) { float o = 0.f; for (int d = 0; d < 64; ++d) o += ch[2 * 4096 + i * 64 + d] * Sm[d][e]; for (int j = 0; j < 64; ++j) o += ch[3 * 4096 + i * 64 + j] * Vn[j][e];
            dst[(size_t)gdn_row(b, dir, n, i) * (GH * GDV) + h * 64 + e] = o; }
        for (int d = 0; d < 64; ++d) for (int e = 0; e < 64; ++e) { float sn = gam * Sm[d][e]; for (int i = 0; i < 64; ++i) sn += ch[4 * 4096 + d * 64 + i] * Vn[i][e]; Sm[d][e] = sn; }
    }
}
#else
template <int... Is, class F> __device__ __forceinline__ void static_for_impl(std::integer_sequence<int, Is...>, F&& f) { (f(std::integral_constant<int, Is>{}), ...); }
template <int N, class F> __device__ __forceinline__ void static_for(F&& f) { static_for_impl(std::make_integer_sequence<int, N>{}, f); }
__device__ __forceinline__ float bf_lo(unsigned u) { return __builtin_bit_cast(float, u << 16); }
__device__ __forceinline__ float bf_hi(unsigned u) { return __builtin_bit_cast(float, u & 0xffff0000u); }
template <int ROLE>
__device__ __forceinline__ void gdn_pre_role(const Params& p, int pair, LAS unsigned char* lds, const int lane, const int wave) {
    constexpr int AST = 68;
    const int l31 = lane & 31, hh = lane >> 5;
    const int item = pair * 2 + (wave >> 1);
    const int c = item / NCH, n = item % NCH, dir = c & 1, h = (c >> 1) % GH, b = (c >> 1) / GH;
    LAS float* At = (LAS float*)(lds + (wave >> 1) * 18432); LAS float* gcs = At + 64 * AST; LAS float* bts = gcs + 64; LAS float* ebt = bts + 64;
    st_t* ch = p.CH() + (size_t)item * 5 * 4096;
    const int row0 = gdn_row(b, dir, n, 0); const int sgn = dir == 0 ? 1 : -1;
    const int myrow = row0 + sgn * lane;
    float gc = p.BG()[(size_t)myrow * 24 + 12 + dir * 6 + h]; const float beta = p.BG()[(size_t)myrow * 24 + dir * 6 + h];
#pragma unroll
    for (int o = 1; o < 64; o <<= 1) { const float t = __shfl_up(gc, o); if (lane >= o) gc += t; }
    const float gc63 = __shfl(gc, 63);
    __syncthreads();
    if (ROLE == 0) { gcs[lane] = gc; bts[lane] = beta; ebt[lane] = beta * __expf(gc); }
    const st_t* gbase = p.G() + h * 64;
    f32x16 d00, d10, d11;
#pragma unroll
    for (int r = 0; r < 16; ++r) { d00[r] = 0.f; d10[r] = 0.f; d11[r] = 0.f; }
    { const size_t r0 = (size_t)(row0 + sgn * l31) * GQKV, r1 = (size_t)(row0 + sgn * (32 + l31)) * GQKV; constexpr int xo = ROLE == 0 ? 384 : 0;
#pragma unroll
      for (int ks = 0; ks < 4; ++ks) {
          const bf16x8 a0 = *(const bf16x8*)(gbase + r0 + xo + 16 * ks + 8 * hh), a1 = *(const bf16x8*)(gbase + r1 + xo + 16 * ks + 8 * hh);
          const bf16x8 b0 = *(const bf16x8*)(gbase + r0 + 384 + 16 * ks + 8 * hh), b1 = *(const bf16x8*)(gbase + r1 + 384 + 16 * ks + 8 * hh);
          d00 = __builtin_amdgcn_mfma_f32_32x32x16_bf16(a0, b0, d00, 0, 0, 0); d10 = __builtin_amdgcn_mfma_f32_32x32x16_bf16(a1, b0, d10, 0, 0, 0); d11 = __builtin_amdgcn_mfma_f32_32x32x16_bf16(a1, b1, d11, 0, 0, 0); } }
    __syncthreads();
    auto post = [&](const f32x16& d, int ib, int jb) __attribute__((always_inline)) {
        const int j = 32 * jb + l31; const float gcj = gcs[j];
#pragma unroll
        for (int g = 0; g < 4; ++g) { const int i0 = 32 * ib + 8 * g + 4 * hh; const f32x4 gci = *(const LAS f32x4*)(gcs + i0);
            if (ROLE == 0) { const f32x4 bi = *(const LAS f32x4*)(bts + i0); f32x4 o;
#pragma unroll
                for (int u = 0; u < 4; ++u) o[u] = (j < i0 + u) ? bi[u] * d[4 * g + u] * __expf(gci[u] - gcj) : 0.f;
                *(LAS f32x4*)(At + j * AST + i0) = o; }
            else {
#pragma unroll
                for (int u = 0; u < 4; ++u) { const float v = (j <= i0 + u) ? 0.125f * d[4 * g + u] * __expf(gci[u] - gcj) : 0.f; stf(ch + 3 * 4096 + (i0 + u) * 64 + j, v); } } }
    };
    post(d00, 0, 0); post(d10, 1, 0); post(d11, 1, 1);
    if (ROLE == 1) {
#pragma unroll
        for (int r = 0; r < 16; ++r) stf(ch + 3 * 4096 + crow16(r, hh) * 64 + 32 + l31, 0.f); }
    __syncthreads();
    float acc[64];
#pragma unroll
    for (int i = 0; i < 64; ++i) acc[i] = 0.f;
    { const long long stp = (long long)sgn * GQKV;
      const st_t* sp = gbase + (ROLE == 0 ? 768 : 384) + lane + (size_t)row0 * GQKV;
      const LAS float* sc = ROLE == 0 ? bts : ebt;
      float cur[8], pre[8];
#pragma unroll
      for (int u = 0; u < 8; ++u) { cur[u] = ldf(sp + u * stp); pre[u] = ldf(sp + (8 + u) * stp); }
      unsigned pk[4]; f32x4 s4 = (f32x4){0.f, 0.f, 0.f, 0.f}; float xprev = 0.f;
      static_for<64>([&](auto jc) __attribute__((always_inline)) {
          constexpr int j = decltype(jc)::value;
          if constexpr ((j & 7) == 0 && j > 0) {
#pragma unroll
              for (int u = 0; u < 8; ++u) cur[u] = pre[u];
              if constexpr (j + 8 < 64) { const st_t* gp = sp + (j + 8) * stp; asm volatile("" : "+v"(gp));
#pragma unroll
                  for (int u = 0; u < 8; ++u) pre[u] = ldf(gp + u * stp); }
          }
          if constexpr ((j & 3) == 0) s4 = *(const LAS f32x4*)(sc + j);
          const float x = s4[j & 3] * cur[j & 7] - acc[j];
          if constexpr (ROLE == 0) {
              if constexpr ((j & 1) == 1) pk[(j >> 1) & 3] = pk_bf16(xprev, x);
              if constexpr ((j & 7) == 7) { u32x4 w; w.x = pk[0]; w.y = pk[1]; w.z = pk[2]; w.w = pk[3]; *(u32x4*)(ch + 0 * 4096 + lane * 64 + (j - 7)) = w; }
          } else stf(ch + 1 * 4096 + j * 64 + lane, x);
          xprev = x;
          constexpr int I0 = ((j + 1) >> 2) << 2;
#pragma unroll
          for (int i4 = I0; i4 < 64; i4 += 4) { const f32x4 av = *(const LAS f32x4*)(At + j * AST + i4);
#pragma unroll
              for (int u = 0; u < 4; ++u) if (i4 + u > j) acc[i4 + u] += av[u] * x;
              asm volatile("" : "+v"(acc[i4]), "+v"(acc[i4 + 1]), "+v"(acc[i4 + 2]), "+v"(acc[i4 + 3])); }
          __builtin_amdgcn_sched_barrier(0);
      }); }
    { const st_t* src = gbase + (size_t)myrow * GQKV + (ROLE == 0 ? 384 : 0); const float sc = ROLE == 0 ? __expf(gc63 - gc) : 0.125f * __expf(gc);
#pragma unroll
      for (int c8 = 0; c8 < 8; ++c8) { const u32x4 w = *(const u32x4*)(src + 8 * c8);
          const float f0 = bf_lo(w.x) * sc, f1 = bf_hi(w.x) * sc, f2 = bf_lo(w.y) * sc, f3 = bf_hi(w.y) * sc, f4 = bf_lo(w.z) * sc, f5 = bf_hi(w.z) * sc, f6 = bf_lo(w.w) * sc, f7 = bf_hi(w.w) * sc;
          if (ROLE == 0) { st_t* kt = ch + 4 * 4096 + (8 * c8) * 64 + lane; stf(kt, f0); stf(kt + 64, f1); stf(kt + 128, f2); stf(kt + 192, f3); stf(kt + 256, f4); stf(kt + 320, f5); stf(kt + 384, f6); stf(kt + 448, f7); }
          else { u32x4 o; o.x = pk_bf16(f0, f1); o.y = pk_bf16(f2, f3); o.z = pk_bf16(f4, f5); o.w = pk_bf16(f6, f7); *(u32x4*)(ch + 2 * 4096 + lane * 64 + 8 * c8) = o; } } }
    if (ROLE == 0 && lane == 0) p.GAM()[item] = __expf(gc63);
}
static_assert((NCHAIN * NCH) % 2 == 0, "chunk items come in pairs");
__device__ __forceinline__ void gdn_pre_dev(const Params& p, int pair, LAS unsigned char* lds, const int tid) {
    const int lane = tid & 63, wave = __builtin_amdgcn_readfirstlane(tid >> 6);
    if ((wave & 1) == 0) gdn_pre_role<0>(p, pair, lds, lane, wave); else gdn_pre_role<1>(p, pair, lds, lane, wave);
}
__device__ __forceinline__ void gdn_scan_dev(const Params& p, int c, LAS unsigned char* lds, const int tid) {
    constexpr int RS = 136, MB = 64 * RS;
    const int lane = tid & 63, wave = __builtin_amdgcn_readfirstlane(tid >> 6), r16 = lane & 15, q = lane >> 4;
    const int dir = c & 1, h = (c >> 1) % GH, b = (c >> 1) / GH; st_t* dst = (dir == 0 ? p.OF() : p.OB()) + h * 64 + 16 * wave + r16;
    f32x4 Sb[4];
#pragma unroll
    for (int i = 0; i < 4; ++i) Sb[i] = (f32x4){0.f, 0.f, 0.f, 0.f};
    u32x4 stg[10]; float gam_next = 0.f;
    auto gload = [&](int n) { const u32x4* src = (const u32x4*)(p.CH() + (size_t)(c * NCH + n) * 5 * 4096);
#pragma unroll
        for (int u = 0; u < 10; ++u) stg[u] = src[tid + 256 * u];
        gam_next = p.GAM()[c * NCH + n]; };
    auto lstore = [&]() {
#pragma unroll
        for (int u = 0; u < 10; ++u) { const int ci = tid + 256 * u, mat = ci >> 9, row = (ci >> 3) & 63, cc = ci & 7; LAS u32x2* d = (LAS u32x2*)(lds + mat * MB + row * RS + cc * 16);
            d[0] = (u32x2){stg[u].x, stg[u].y}; d[1] = (u32x2){stg[u].z, stg[u].w}; } };
    auto afrag = [&](int mat, int row, int a2) -> bf16x8 { const LAS unsigned char* bp = lds + mat * MB + row * RS + (32 * a2 + 4 * q) * 2;
        const u32x2 lo = *(const LAS u32x2*)bp, hi = *(const LAS u32x2*)(bp + 32); u32x4 w; w.x = lo.x; w.y = lo.y; w.z = hi.x; w.w = hi.y; return __builtin_bit_cast(bf16x8, w); };
    auto pack2 = [&](const f32x4& x, const f32x4& y) -> bf16x8 { u32x4 w; w.x = pk_bf16(x[0], x[1]); w.y = pk_bf16(x[2], x[3]); w.z = pk_bf16(y[0], y[1]); w.w = pk_bf16(y[2], y[3]); return __builtin_bit_cast(bf16x8, w); };
    __syncthreads();
    gload(0); lstore(); float gam = gam_next;
    __syncthreads();
    const int sgn = dir == 0 ? 1 : -1;
    for (int n = 0; n < NCH; ++n) {
        if (n + 1 < NCH) gload(n + 1);
        const bf16x8 sb0 = pack2(Sb[0], Sb[1]), sb1 = pack2(Sb[2], Sb[3]);
        bf16x8 fw[8], fq[8]; u32x2 uu[4];
#pragma unroll
        for (int i = 0; i < 8; ++i) fw[i] = afrag(1, 16 * (i >> 1) + r16, i & 1);
#pragma unroll
        for (int tb = 0; tb < 4; ++tb) uu[tb] = *(const LAS u32x2*)(lds + 0 * MB + (16 * wave + r16) * RS + (16 * tb + 4 * q) * 2);
#pragma unroll
        for (int i = 0; i < 8; ++i) fq[i] = afrag(2, 16 * (i >> 1) + r16, i & 1);
        __builtin_amdgcn_sched_barrier(0);
        f32x4 vn[4], oc[4];
#pragma unroll
        for (int tb = 0; tb < 4; ++tb) {
            f32x4 acc = (f32x4){0.f, 0.f, 0.f, 0.f};
            acc = __builtin_amdgcn_mfma_f32_16x16x32_bf16(fw[2 * tb], sb0, acc, 0, 0, 0);
            acc = __builtin_amdgcn_mfma_f32_16x16x32_bf16(fw[2 * tb + 1], sb1, acc, 0, 0, 0);
            vn[tb][0] = bf_lo(uu[tb].x) - acc[0]; vn[tb][1] = bf_hi(uu[tb].x) - acc[1]; vn[tb][2] = bf_lo(uu[tb].y) - acc[2]; vn[tb][3] = bf_hi(uu[tb].y) - acc[3];
        }
        __builtin_amdgcn_sched_barrier(0);
        bf16x8 fm[8];
#pragma unroll
        for (int i = 0; i < 8; ++i) fm[i] = afrag(3, 16 * (i >> 1) + r16, i & 1);
        __builtin_amdgcn_sched_barrier(0);
#pragma unroll
        for (int tb = 0; tb < 4; ++tb) {
            f32x4 o = (f32x4){0.f, 0.f, 0.f, 0.f};
            o = __builtin_amdgcn_mfma_f32_16x16x32_bf16(fq[2 * tb], sb0, o, 0, 0, 0);
            o = __builtin_amdgcn_mfma_f32_16x16x32_bf16(fq[2 * tb + 1], sb1, o, 0, 0, 0);
            oc[tb] = o;
        }
        const bf16x8 vb0 = pack2(vn[0], vn[1]), vb1 = pack2(vn[2], vn[3]);
        __builtin_amdgcn_sched_barrier(0);
        bf16x8 fk[8];
#pragma unroll
        for (int i = 0; i < 8; ++i) fk[i] = afrag(4, 16 * (i >> 1) + r16, i & 1);
        __builtin_amdgcn_sched_barrier(0);
        const int row0 = gdn_row(b, dir, n, 0);
#pragma unroll
        for (int tb = 0; tb < 4; ++tb) {
            f32x4 o = oc[tb];
            o = __builtin_amdgcn_mfma_f32_16x16x32_bf16(fm[2 * tb], vb0, o, 0, 0, 0);
            o = __builtin_amdgcn_mfma_f32_16x16x32_bf16(fm[2 * tb + 1], vb1, o, 0, 0, 0);
            oc[tb] = o;
        }
#pragma unroll
        for (int db = 0; db < 4; ++db) {
            f32x4 sn = Sb[db] * gam;
            sn = __builtin_amdgcn_mfma_f32_16x16x32_bf16(fk[2 * db], vb0, sn, 0, 0, 0);
            sn = __builtin_amdgcn_mfma_f32_16x16x32_bf16(fk[2 * db + 1], vb1, sn, 0, 0, 0);
            Sb[db] = sn;
        }
#pragma unroll
        for (int tb = 0; tb < 4; ++tb) {
#pragma unroll
            for (int u = 0; u < 4; ++u) stf(dst + (size_t)(row0 + sgn * (16 * tb + 4 * q + u)) * (GH * GDV), oc[tb][u]);
        }
        __syncthreads();
        if (n + 1 < NCH) { lstore(); gam = gam_next; }
        __syncthreads();
    }
}
#endif


#ifndef HOST_EMU
enum { R_NORM1 = 0, R_POST1 = 1, R_POST2 = 2, R_XFORM = 3, R_GOUT = 4, R_ROUTE2 = 5 };
template <int CTRL> __device__ __forceinline__ float dpp_f(float v) { return __builtin_bit_cast(float, __builtin_amdgcn_update_dpp(0, __builtin_bit_cast(int, v), CTRL, 0xF, 0xF, true)); }
__device__ __forceinline__ float rdlane_f(float v, int l) { return __builtin_bit_cast(float, __builtin_amdgcn_readlane(__builtin_bit_cast(int, v), l)); }
__device__ __forceinline__ float wave_sum(float v) {
    v += dpp_f<0xB1>(v); v += dpp_f<0x4E>(v); v += dpp_f<0x141>(v); v += dpp_f<0x140>(v);
    return (rdlane_f(v, 0) + rdlane_f(v, 16)) + (rdlane_f(v, 32) + rdlane_f(v, 48));
}
__device__ __forceinline__ void ld_row_f32(const float* p, int lane, f32x4 (&v)[D / 256]) {
#pragma unroll
    for (int j = 0; j < D / 256; ++j) v[j] = *(const f32x4*)(p + 4 * lane + 256 * j); }
__device__ __forceinline__ void ld_row_bf16(const st_t* p, int lane, f32x4 (&v)[D / 256]) {
#pragma unroll
    for (int j = 0; j < D / 256; ++j) { const u32x2 w = *(const u32x2*)(p + 4 * lane + 256 * j); v[j] = (f32x4){bf_lo(w.x), bf_hi(w.x), bf_lo(w.y), bf_hi(w.y)}; } }
__device__ __forceinline__ void st_row_bf16(st_t* p, int lane, const f32x4 (&v)[D / 256]) {
#pragma unroll
    for (int j = 0; j < D / 256; ++j) st4(p + 4 * lane + 256 * j, v[j][0], v[j][1], v[j][2], v[j][3]); }
__device__ __forceinline__ float sumsq(const f32x4 (&v)[D / 256]) { float s = 0.f;
#pragma unroll
    for (int j = 0; j < D / 256; ++j) s += (v[j][0] * v[j][0] + v[j][1] * v[j][1]) + (v[j][2] * v[j][2] + v[j][3] * v[j][3]);
    return wave_sum(s); }
template <bool TO_LDS>
__device__ __forceinline__ void modulate_store(const f32x4 (&x)[D / 256], float rstd, const float* gain, const float* sc, const float* sh, st_t* hrow, int lane, LAS float* hl, int swz = 0) {
    f32x4 g[D / 256], a[D / 256], b[D / 256], h[D / 256]; ld_row_f32(gain, lane, g); ld_row_f32(sc, lane, a); ld_row_f32(sh, lane, b);
#pragma unroll
    for (int j = 0; j < D / 256; ++j) h[j] = x[j] * rstd * g[j] * (a[j] + 1.0f) + b[j];
    st_row_bf16(hrow, lane, h);
    if constexpr (TO_LDS) {
#pragma unroll
        for (int j = 0; j < D / 256; ++j) *(LAS f32x4*)(hl + (((lane + 64 * j) ^ swz) << 2)) = h[j]; }
}
__device__ __forceinline__ void row_norm1(const Params& p, int layer, int r, int lane) {
    f32x4 x[D / 256]; ld_row_f32(xin_row(p, layer, r), lane, x);
    const float rstd = rsqrt_f(sumsq(x) / D + EPS);
    modulate_store<false>(x, rstd, p.mix_norm_pre + (size_t)layer * D, mod_vec(p, layer, r, 1), mod_vec(p, layer, r, 0), p.H() + (size_t)r * D, lane, (LAS float*)0);
}
__device__ __forceinline__ void route_pick(const Params& p, int layer, int r, int lane, float logit, LAS int* lcnt);
template <int NR>
__device__ __forceinline__ void row_post1_multi(const Params& p, int layer, int item, int lane, LAS float* hl, LAS int* lcnt) {
#pragma unroll
    for (int rr = 0; rr < NR; ++rr) { const int r = NR * item + rr;
        f32x4 y[D / 256], x[D / 256], g1[D / 256], gp[D / 256]; ld_row_bf16(p.Y() + (size_t)r * D, lane, y); ld_row_f32(xin_row(p, layer, r), lane, x);
        ld_row_f32(mod_vec(p, layer, r, 2), lane, g1); ld_row_f32(p.mix_norm_post + (size_t)layer * D, lane, gp);
        const float rstd = rsqrt_f(sumsq(y) / D + EPS);
#pragma unroll
        for (int j = 0; j < D / 256; ++j) x[j] = x[j] + g1[j] * y[j] * rstd * gp[j];
        float* xr = xrow(p, r);
#pragma unroll
        for (int j = 0; j < D / 256; ++j) *(f32x4*)(xr + 4 * lane + 256 * j) = x[j];
        const float r2 = rsqrt_f(sumsq(x) / D + EPS);
        modulate_store<true>(x, r2, p.ffn_norm_pre + (size_t)layer * D, mod_vec(p, layer, r, 4), mod_vec(p, layer, r, 3), p.H() + (size_t)r * D, lane, hl + rr * D);
    }
    asm volatile("s_waitcnt lgkmcnt(0)" ::: "memory");
    const float* wr = p.router_w + (size_t)layer * D * NE + lane; float acc[NR];
#pragma unroll
    for (int rr = 0; rr < NR; ++rr) acc[rr] = 0.f;
#pragma unroll 4
    for (int d4 = 0; d4 < D / 4; ++d4) { f32x4 hv[NR];
#pragma unroll
        for (int rr = 0; rr < NR; ++rr) hv[rr] = *(const LAS f32x4*)(hl + rr * D + 4 * d4);
#pragma unroll
        for (int u = 0; u < 4; ++u) { const float w = wr[(size_t)(4 * d4 + u) * NE];
#pragma unroll
            for (int rr = 0; rr < NR; ++rr) acc[rr] += hv[rr][u] * w; } }
#pragma unroll
    for (int rr = 0; rr < NR; ++rr) route_pick(p, layer, NR * item + rr, lane, acc[rr], lcnt);
    asm volatile("s_waitcnt lgkmcnt(0)" ::: "memory");
}
__device__ __forceinline__ void block_post1(const Params& p, int layer, int j16, int lane, int wave, LAS unsigned char* lds, LAS int* lcnt) {
    LAS float* hl = (LAS float*)lds;
#pragma unroll
    for (int rr = 0; rr < 4; ++rr) { const int r16 = 4 * wave + rr, r = 16 * j16 + r16;
        f32x4 y[D / 256], x[D / 256], g1[D / 256], gp[D / 256]; ld_row_bf16(p.Y() + (size_t)r * D, lane, y); ld_row_f32(xin_row(p, layer, r), lane, x);
        ld_row_f32(mod_vec(p, layer, r, 2), lane, g1); ld_row_f32(p.mix_norm_post + (size_t)layer * D, lane, gp);
        const float rstd = rsqrt_f(sumsq(y) / D + EPS);
#pragma unroll
        for (int j = 0; j < D / 256; ++j) x[j] = x[j] + g1[j] * y[j] * rstd * gp[j];
        float* xr = xrow(p, r);
#pragma unroll
        for (int j = 0; j < D / 256; ++j) *(f32x4*)(xr + 4 * lane + 256 * j) = x[j];
        const float r2 = rsqrt_f(sumsq(x) / D + EPS);
        modulate_store<true>(x, r2, p.ffn_norm_pre + (size_t)layer * D, mod_vec(p, layer, r, 4), mod_vec(p, layer, r, 3), p.H() + (size_t)r * D, lane, hl + r16 * D, r16);
    }
    __syncthreads();
    const int row = lane & 15, kq = lane >> 4;
    const float* wr = p.router_w + (size_t)layer * D * NE + (size_t)(256 * wave + 4 * kq) * NE + 4 * row;
    f32x4 acc[4];
#pragma unroll
    for (int jj = 0; jj < 4; ++jj) acc[jj] = (f32x4){0.f, 0.f, 0.f, 0.f};
#pragma unroll 4
    for (int blk = 0; blk < 16; ++blk) {
        const int c = 64 * wave + 4 * blk + kq;
        const f32x4 a4 = *(const LAS f32x4*)(hl + row * D + ((c ^ row) << 2));
#pragma unroll
        for (int u = 0; u < 4; ++u) { const f32x4 b4 = *(const f32x4*)(wr + (size_t)(16 * blk + u) * NE);
#pragma unroll
            for (int jj = 0; jj < 4; ++jj) acc[jj] = __builtin_amdgcn_mfma_f32_16x16x4f32(a4[u], b4[jj], acc[jj], 0, 0, 0); }
    }
    __syncthreads();
#pragma unroll
    for (int r = 0; r < 4; ++r) *(LAS f32x4*)(hl + (wave * 16 + 4 * kq + r) * NE + 4 * row) = (f32x4){acc[0][r], acc[1][r], acc[2][r], acc[3][r]};
    __syncthreads();
#pragma unroll
    for (int rr = 0; rr < 4; ++rr) { const int r16 = 4 * wave + rr; float lg = 0.f;
#pragma unroll
        for (int w2 = 0; w2 < 4; ++w2) lg += hl[(w2 * 16 + r16) * NE + lane];
        route_pick(p, layer, 16 * j16 + r16, lane, lg, lcnt); }
    asm volatile("s_waitcnt lgkmcnt(0)" ::: "memory");
    __syncthreads();
}
__device__ __forceinline__ void route_row(const Params& p, int layer, int r, int lane, float logit) {
    const float sg = sigmoid_f(logit), v = sg + p.router_bias[(size_t)layer * NE + lane];
    float m1 = v; int i1 = lane;
#pragma unroll
    for (int o = 1; o < 8; o <<= 1) { const float ov = __shfl_xor(m1, o); const int oi = __shfl_xor(i1, o); if (ov > m1 || (ov == m1 && oi < i1)) { m1 = ov; i1 = oi; } }
    float m2 = lane == i1 ? -3.0e38f : v;
#pragma unroll
    for (int o = 1; o < 8; o <<= 1) m2 = fmaxf(m2, __shfl_xor(m2, o));
    const float gs = m1 + m2; const int grp = lane >> 3;
    int grank = 0;
#pragma unroll
    for (int j = 0; j < NGRP; ++j) { const float og = __shfl(gs, j * 8); grank += (og > gs || (og == gs && j < grp)) ? 1 : 0; }
    const float mv = grank < TOPG ? v : -3.0e38f;
    int rank = 0;
#pragma unroll
    for (int j = 0; j < NE; ++j) { const float ov = __shfl(mv, j); rank += (ov > mv || (ov == mv && j < lane)) ? 1 : 0; }
    const bool sel = rank < TOPK;
    const float wsum = wave_sum(sel ? sg : 0.f);
    if (sel) { const float w = sg / wsum * ROUTED_SCALE; const int pos = atomicAdd(p.CNT() + layer * NE + lane, 1); atomicAdd(p.CNTP() + (layer * NE + lane) * 32, 1);
        p.EIDX()[(size_t)r * TOPK + rank] = lane; p.EPOS()[(size_t)r * TOPK + rank] = pos; p.TOKLIST()[(size_t)lane * TA + pos] = r; p.WLIST()[(size_t)lane * TA + pos] = w; }
}
__device__ __forceinline__ void row_post1_quad(const Params& p, int layer, int quad, int lane, LAS float* hl) {
#pragma unroll
    for (int rr = 0; rr < 4; ++rr) { const int r = 4 * quad + rr;
        f32x4 y[D / 256], x[D / 256], g1[D / 256], gp[D / 256]; ld_row_bf16(p.Y() + (size_t)r * D, lane, y); ld_row_f32(xin_row(p, layer, r), lane, x);
        ld_row_f32(mod_vec(p, layer, r, 2), lane, g1); ld_row_f32(p.mix_norm_post + (size_t)layer * D, lane, gp);
        const float rstd = rsqrt_f(sumsq(y) / D + EPS);
#pragma unroll
        for (int j = 0; j < D / 256; ++j) x[j] = x[j] + g1[j] * y[j] * rstd * gp[j];
        float* xr = xrow(p, r);
#pragma unroll
        for (int j = 0; j < D / 256; ++j) *(f32x4*)(xr + 4 * lane + 256 * j) = x[j];
        const float r2 = rsqrt_f(sumsq(x) / D + EPS);
        modulate_store<true>(x, r2, p.ffn_norm_pre + (size_t)layer * D, mod_vec(p, layer, r, 4), mod_vec(p, layer, r, 3), p.H() + (size_t)r * D, lane, hl + rr * D);
    }
    asm volatile("s_waitcnt lgkmcnt(0)" ::: "memory");
    const float* wr = p.router_w + (size_t)layer * D * NE + lane; float a0 = 0.f, a1 = 0.f, a2 = 0.f, a3 = 0.f;
#pragma unroll 4
    for (int d4 = 0; d4 < D / 4; ++d4) { const f32x4 h0 = *(const LAS f32x4*)(hl + 4 * d4), h1 = *(const LAS f32x4*)(hl + D + 4 * d4), h2 = *(const LAS f32x4*)(hl + 2 * D + 4 * d4), h3 = *(const LAS f32x4*)(hl + 3 * D + 4 * d4);
#pragma unroll
        for (int u = 0; u < 4; ++u) { const float w = wr[(size_t)(4 * d4 + u) * NE]; a0 += h0[u] * w; a1 += h1[u] * w; a2 += h2[u] * w; a3 += h3[u] * w; } }
    route_row(p, layer, 4 * quad, lane, a0); route_row(p, layer, 4 * quad + 1, lane, a1); route_row(p, layer, 4 * quad + 2, lane, a2); route_row(p, layer, 4 * quad + 3, lane, a3);
    asm volatile("s_waitcnt lgkmcnt(0)" ::: "memory");
}
__device__ __forceinline__ void route_pick(const Params& p, int layer, int r, int lane, float logit, LAS int* lcnt) {
    const float sg = sigmoid_f(logit), v = sg + p.router_bias[(size_t)layer * NE + lane];
    float m1 = v; int i1 = lane;
#pragma unroll
    for (int o = 1; o < 8; o <<= 1) { const float ov = __shfl_xor(m1, o); const int oi = __shfl_xor(i1, o); if (ov > m1 || (ov == m1 && oi < i1)) { m1 = ov; i1 = oi; } }
    float m2 = lane == i1 ? -3.0e38f : v;
#pragma unroll
    for (int o = 1; o < 8; o <<= 1) m2 = fmaxf(m2, __shfl_xor(m2, o));
    const float gs = m1 + m2; const int grp = lane >> 3;
    int grank = 0;
#pragma unroll
    for (int j = 0; j < NGRP; ++j) { const float og = __builtin_bit_cast(float, __builtin_amdgcn_readlane(__builtin_bit_cast(int, gs), j * 8)); grank += (og > gs || (og == gs && j < grp)) ? 1 : 0; }
    const float mv = grank < TOPG ? v : -3.0e38f;
    int rank = 0;
#pragma unroll
    for (int j = 0; j < NE; ++j) { const float ov = __builtin_bit_cast(float, __builtin_amdgcn_readlane(__builtin_bit_cast(int, mv), j)); rank += (ov > mv || (ov == mv && j < lane)) ? 1 : 0; }
    const bool sel = rank < TOPK;
    const float wsum = wave_sum(sel ? sg : 0.f);
    if (sel) { p.EIDX()[(size_t)r * TOPK + rank] = lane; p.EW()[(size_t)r * TOPK + rank] = sg / wsum * ROUTED_SCALE; __hip_atomic_fetch_add(lcnt + lane, 1, __ATOMIC_RELAXED, __HIP_MEMORY_SCOPE_WORKGROUP); }
}
__device__ __forceinline__ void route_place(const Params& p, int layer, LAS unsigned char* lds, int tid, int lane, int wave) {
    LAS int* pb = (LAS int*)lds; LAS int* lpos = pb + NE;
    __syncthreads();
    { const int e = tid & (NE - 1), qd = tid >> 6, per = ((int)gridDim.x + 3) / 4; int below = 0, tot = 0; const int* bc = p.BCNT() + e;
      const int b_hi = (qd + 1) * per < (int)gridDim.x ? (qd + 1) * per : (int)gridDim.x;
#pragma unroll 8
      for (int b2 = qd * per; b2 < b_hi; ++b2) { const int c = bc[(size_t)b2 * NE]; tot += c; below += b2 < (int)blockIdx.x ? c : 0; }
      LAS int* red = lpos + NE; red[tid] = below; red[256 + tid] = tot; }
    __syncthreads();
    if (tid < NE) { LAS int* red = lpos + NE; pb[tid] = red[tid] + red[64 + tid] + red[128 + tid] + red[192 + tid]; lpos[tid] = 0;
        if (blockIdx.x == 0) p.CNT()[layer * NE + tid] = red[256 + tid] + red[320 + tid] + red[384 + tid] + red[448 + tid]; }
    __syncthreads();
    const int gw = blockIdx.x * 4 + wave, nw = gridDim.x * 4;
    for (int i = gw; i < rows_out(layer) / POST1_NR; i += nw) {
        if (lane < POST1_NR * TOPK) { const int r = POST1_NR * i + (lane >> 3), k = lane & 7; const int e = p.EIDX()[(size_t)r * TOPK + k]; const float w = p.EW()[(size_t)r * TOPK + k];
            const int pos = pb[e] + __hip_atomic_fetch_add(lpos + e, 1, __ATOMIC_RELAXED, __HIP_MEMORY_SCOPE_WORKGROUP);
            p.EPOS()[(size_t)r * TOPK + k] = pos; p.TOKLIST()[(size_t)e * TA + pos] = r; p.WLIST()[(size_t)e * TA + pos] = w; }
    }
}
__device__ __forceinline__ void row_post2(const Params& p, int layer, int r, int lane, const int* eb) {
    int slot = 0;
    if (lane < TOPK) { const int e = p.EIDX()[(size_t)r * TOPK + lane]; slot = eb[e] + p.EPOS()[(size_t)r * TOPK + lane]; }
    f32x4 f[D / 256]; ld_row_bf16(p.SH() + (size_t)r * D, lane, f);
#pragma unroll
    for (int k = 0; k < TOPK; ++k) { const int sk = __shfl(slot, k); f32x4 t[D / 256]; ld_row_bf16(p.YB() + (size_t)sk * D, lane, t);
#pragma unroll
        for (int j = 0; j < D / 256; ++j) f[j] += t[j]; }
    const float rstd = rsqrt_f(sumsq(f) / D + EPS);
    float* xr = xrow(p, r); f32x4 x[D / 256], g2[D / 256], gp[D / 256]; ld_row_f32(xr, lane, x); ld_row_f32(mod_vec(p, layer, r, 5), lane, g2); ld_row_f32(p.ffn_norm_post + (size_t)layer * D, lane, gp);
#pragma unroll
    for (int j = 0; j < D / 256; ++j) { x[j] = x[j] + g2[j] * f[j] * rstd * gp[j]; *(f32x4*)(xr + 4 * lane + 256 * j) = x[j]; }
    if (layer + 1 < DEPTH) { const float r2 = rsqrt_f(sumsq(x) / D + EPS);
        modulate_store<false>(x, r2, p.mix_norm_pre + (size_t)(layer + 1) * D, mod_vec(p, layer + 1, r, 1), mod_vec(p, layer + 1, r, 0), p.H() + (size_t)r * D, lane, (LAS float*)0); }
}
__device__ __forceinline__ void unpack8(const u32x4 w, float (&x)[8]) { x[0] = bf_lo(w.x); x[1] = bf_hi(w.x); x[2] = bf_lo(w.y); x[3] = bf_hi(w.y); x[4] = bf_lo(w.z); x[5] = bf_hi(w.z); x[6] = bf_lo(w.w); x[7] = bf_hi(w.w); }
__device__ __forceinline__ u32x4 pack8(const float (&x)[8]) { u32x4 o; o.x = pk_bf16(x[0], x[1]); o.y = pk_bf16(x[2], x[3]); o.z = pk_bf16(x[4], x[5]); o.w = pk_bf16(x[6], x[7]); return o; }
__device__ __forceinline__ void row_xform(const Params& p, int layer, int r, int lane, const LAS float* cw) {
    int lo, hi; seq_bounds(r, lo, hi);
    const st_t* prow = p.P() + (size_t)r * DPROJP;
#pragma unroll
    for (int gi = 0; gi < 3; ++gi) {
        if (gi < 2 || lane < 16) {
            const int c0 = 8 * (lane + 64 * gi); float acc[8];
#pragma unroll
            for (int e = 0; e < 8; ++e) acc[e] = 0.f;
#pragma unroll
            for (int j = 0; j < GCONV; ++j) { const int rr = r + j - 2;
                if (rr >= lo && rr < hi) { float x[8]; unpack8(*(const u32x4*)(p.P() + (size_t)rr * DPROJP + PO_GQKV + c0), x);
                    const f32x4 w0 = *(const LAS f32x4*)(cw + j * GQKV + c0), w1 = *(const LAS f32x4*)(cw + j * GQKV + c0 + 4);
#pragma unroll
                    for (int e = 0; e < 4; ++e) { acc[e] += w0[e] * x[e]; acc[4 + e] += w1[e] * x[4 + e]; } } }
            float ss = 0.f;
#pragma unroll
            for (int e = 0; e < 8; ++e) { acc[e] = silu_f(acc[e]); ss += acc[e] * acc[e]; }
            if (gi < 2) {
                ss += __shfl_xor(ss, 1); ss += __shfl_xor(ss, 2); ss += __shfl_xor(ss, 4);
                const float rn = c0 < 2 * GH * GDK ? rsqrt_f(ss + EPS) : 1.0f;
#pragma unroll
                for (int e = 0; e < 8; ++e) acc[e] *= rn; }
            *(u32x4*)(p.G() + (size_t)r * GQKV + c0) = pack8(acc);
        }
    }
    if (lane < 12) { const float beta = sigmoid_f(ldf(prow + PO_BA + lane)), a = ldf(prow + PO_BA + 12 + lane);
        p.BG()[(size_t)r * 24 + lane] = beta; p.BG()[(size_t)r * 24 + 12 + lane] = -expf(p.gdn_a_log[layer * 12 + lane]) * softplus_f(a + p.gdn_dt_bias[layer * 12 + lane]); }
    { float x[8]; float ss = 0.f;
      if (lane < MQR / 8) { unpack8(*(const u32x4*)(prow + PO_CQ + 8 * lane), x);
#pragma unroll
          for (int e = 0; e < 8; ++e) ss += x[e] * x[e]; }
      const float rstd = rsqrt_f(wave_sum(ss) / MQR + EPS);
      if (lane < MQR / 8) { const float* gn = p.mla_q_norm + (size_t)layer * MQR + 8 * lane;
#pragma unroll
          for (int e = 0; e < 8; ++e) x[e] = x[e] * rstd * gn[e];
          *(u32x4*)(p.CQN() + (size_t)r * MQR + 8 * lane) = pack8(x); } }
    { float x[8]; float ss = 0.f;
      if (lane < MKVR / 8) { unpack8(*(const u32x4*)(prow + PO_CKV + 8 * lane), x);
#pragma unroll
          for (int e = 0; e < 8; ++e) ss += x[e] * x[e]; }
      const float rstd = rsqrt_f(wave_sum(ss) / MKVR + EPS);
      if (lane < MKVR / 8) { const float* gn = p.mla_kv_norm + (size_t)layer * MKVR + 8 * lane;
#pragma unroll
          for (int e = 0; e < 8; ++e) x[e] = x[e] * rstd * gn[e];
          *(u32x4*)(p.CKVN() + (size_t)r * MKVR + 8 * lane) = pack8(x); } }
}
__device__ __forceinline__ void row_mla_merge(const Params& p, int r, int lane) {
    if (NSPLIT == 1 || r >= T || lane >= MH * MV / 8) return;
    const int h = lane / (MV / 8); float mc[NSPLIT], lc[NSPLIT], mx = -3.0e38f;
#pragma unroll
    for (int c = 0; c < NSPLIT; ++c) { const float* ml = p.MLPART() + (((size_t)c * T + r) * MH + h) * 2; mc[c] = ml[0]; lc[c] = ml[1]; mx = fmaxf(mx, mc[c]); }
    float o[8], wsum = 0.f;
#pragma unroll
    for (int e = 0; e < 8; ++e) o[e] = 0.f;
#pragma unroll
    for (int c = 0; c < NSPLIT; ++c) { const float w = lc[c] * __builtin_amdgcn_exp2f(mc[c] - mx); wsum += w; float x[8]; unpack8(*(const u32x4*)(p.OPART() + ((size_t)c * T + r) * MH * MV + 8 * lane), x);
#pragma unroll
        for (int e = 0; e < 8; ++e) o[e] += w * x[e]; }
    const float inv = __builtin_amdgcn_rcpf(wsum);
#pragma unroll
    for (int e = 0; e < 8; ++e) o[e] *= inv;
    *(u32x4*)(p.O() + (size_t)r * DMIX + (SWA_H + GH) * 64 + 8 * lane) = pack8(o);
}
__device__ __forceinline__ void row_gout(const Params& p, int layer, int r, int lane) {
    row_mla_merge(p, r, lane);
    float o[8]; float ss = 0.f; const bool act = lane < GH * GDV / 8;
    if (act) { float a[8], b[8]; unpack8(*(const u32x4*)(p.OF() + (size_t)r * (GH * GDV) + 8 * lane), a); unpack8(*(const u32x4*)(p.OB() + (size_t)r * (GH * GDV) + 8 * lane), b);
#pragma unroll
        for (int e = 0; e < 8; ++e) { o[e] = a[e] + b[e]; ss += o[e] * o[e]; } }
    ss += __shfl_xor(ss, 1); ss += __shfl_xor(ss, 2); ss += __shfl_xor(ss, 4);
    if (act) { const float rstd = rsqrt_f(ss / GDV + EPS); float z[8]; unpack8(*(const u32x4*)(p.P() + (size_t)r * DPROJP + PO_Z + 8 * lane), z);
        const float* nw = p.gdn_norm_w + layer * GDV + (8 * lane) % GDV;
#pragma unroll
        for (int e = 0; e < 8; ++e) o[e] = o[e] * rstd * nw[e] * silu_f(z[e]);
        *(u32x4*)(p.O() + (size_t)r * DMIX + GH * GDV + 8 * lane) = pack8(o); }
}
__device__ __forceinline__ void mod_block(const Params& p, int item, LAS unsigned char* lds, int tid) {
    const int lane = tid & 63, wave = __builtin_amdgcn_readfirstlane(tid >> 6); const int ly = item / (6 * D / 64), jb = item % (6 * D / 64);
    LAS float* sl = (LAS float*)lds; LAS float* red = sl + 3 * D;
    __syncthreads();
    for (int i = tid; i < 3 * D; i += 256) { const int w = i / D, k = i % D; sl[i] = silu_f(w < 2 ? p.c[(size_t)w * D + k] : p.c_ctx[k]); }
    __syncthreads();
    const float* W = p.ada_w + (size_t)ly * D * 6 * D + jb * 64 + lane; float a0 = 0.f, a1 = 0.f, a2 = 0.f;
#pragma unroll 8
    for (int k = wave * (D / 4); k < (wave + 1) * (D / 4); ++k) { const float w = W[(size_t)k * 6 * D]; a0 += sl[k] * w; a1 += sl[D + k] * w; a2 += sl[2 * D + k] * w; }
    red[(wave * 3 + 0) * 64 + lane] = a0; red[(wave * 3 + 1) * 64 + lane] = a1; red[(wave * 3 + 2) * 64 + lane] = a2;
    __syncthreads();
    if (wave < 3) { const float v = red[(0 * 3 + wave) * 64 + lane] + red[(1 * 3 + wave) * 64 + lane] + red[(2 * 3 + wave) * 64 + lane] + red[(3 * 3 + wave) * 64 + lane];
        p.MOD()[((size_t)(ly * 3 + wave) * 6 * D) + jb * 64 + lane] = v + p.ada_b[(size_t)ly * 6 * D + jb * 64 + lane]; }
}
#endif


#ifndef HOST_EMU
#define XB_TMO      128
#define XB_XCNT(j)  (256  + 64 * (j))
#define XB_XSUB(j)  (1280 + 64 * (j))
#define XB_XGEN(j)  (2304 + 64 * (j))
#define XB_TOP      3328
#define XB_TOPGEN   3392
#define XCD_BAR_WORDS 3456
#define XB_SPIN_CAP (1u << 18)

__device__ __forceinline__ unsigned xb_ld(unsigned* p)              { return __hip_atomic_load(p, __ATOMIC_RELAXED, __HIP_MEMORY_SCOPE_AGENT); }
__device__ __forceinline__ unsigned xb_add(unsigned* p, unsigned v) { return __hip_atomic_fetch_add(p, v, __ATOMIC_RELAXED, __HIP_MEMORY_SCOPE_AGENT); }
__device__ __forceinline__ unsigned xb_xcc_id() { return (unsigned)__builtin_amdgcn_s_getreg((3 << 11) | 20) & 0xFu; }
#define XB_SPIN(cond, bar) do { unsigned _sp = 0; while (cond) { __builtin_amdgcn_s_sleep(1); \
    if ((++_sp & 255u) == 0u) { if (xb_ld(&(bar)[XB_TMO])) break; if (_sp > XB_SPIN_CAP) { atomicAdd(&(bar)[XB_TMO], 1u); break; } } } } while (0)

struct XcdBarrier {
    unsigned* bar; unsigned x;
    volatile LAS unsigned* st;
};

__device__ __forceinline__ XcdBarrier xcd_barrier_post(unsigned* bar, volatile LAS unsigned* st) {
    XcdBarrier b; b.bar = bar; b.x = xb_xcc_id(); b.st = st;
    if (threadIdx.x == 0) (void)xb_add(&bar[XB_XCNT(b.x)], 1u);
    return b;
}
__device__ __forceinline__ void xcd_barrier_complete(unsigned* bar, unsigned x, unsigned& nloc, unsigned& nx) {
    const unsigned G = gridDim.x * gridDim.y * gridDim.z;
    unsigned sum, cnt, mine, sp = 0u;
    for (;;) {
        sum = 0u; cnt = 0u; mine = 0u;
#pragma unroll
        for (unsigned j = 0; j < 16; ++j) { const unsigned c = xb_ld(&bar[XB_XCNT(j)]); sum += c; cnt += (c > 0u) ? 1u : 0u; mine = (j == x) ? c : mine; }
        if (sum == G) break;
        __builtin_amdgcn_s_sleep(1);
        if ((++sp & 255u) == 0u) { if (xb_ld(&bar[XB_TMO])) break; if (sp > XB_SPIN_CAP) { atomicAdd(&bar[XB_TMO], 1u); break; } }
    }
    nloc = mine > 0u ? mine : 1u; nx = cnt > 0u ? cnt : 1u;
}

__device__ __forceinline__ void xcd_barrier(const XcdBarrier& b) {
    asm volatile("s_waitcnt vmcnt(0)" ::: "memory");
    __syncthreads();
    if (threadIdx.x == 0) {
        unsigned* bar = b.bar;
        __builtin_amdgcn_s_waitcnt(0);
        unsigned nloc = b.st[0], nx = b.st[1];
        if (nloc == 0u) { xcd_barrier_complete(bar, b.x, nloc, nx); b.st[0] = nloc; b.st[1] = nx; }
        const unsigned old = xb_add(&bar[XB_XSUB(b.x)], 1u);
        const unsigned gen = old / nloc;
        if (old + 1u == (gen + 1u) * nloc) {
            __builtin_amdgcn_fence(__ATOMIC_RELEASE, "agent");
            asm volatile("s_waitcnt vmcnt(0)" ::: "memory");
            const unsigned og = xb_add(&bar[XB_TOP], 1u);
            const unsigned tg = og / nx;
            if (og + 1u == (tg + 1u) * nx) xb_add(&bar[XB_TOPGEN], 1u);
            else XB_SPIN(xb_ld(&bar[XB_TOPGEN]) == tg, bar);
            __builtin_amdgcn_fence(__ATOMIC_ACQUIRE, "agent");
            xb_add(&bar[XB_XGEN(b.x)], 1u);
            asm volatile("s_waitcnt vmcnt(0)" ::: "memory");
        } else {
            XB_SPIN(xb_ld(&bar[XB_XGEN(b.x)]) == gen, bar);
            __builtin_amdgcn_fence(__ATOMIC_ACQUIRE, "agent");
            asm volatile("s_waitcnt vmcnt(0)" ::: "memory");
        }
    }
    __syncthreads();
}

#endif

enum { K_ITEM = 0, K_WT = 1, K_GEMM = 2, K_ATTN = 3, K_GPRE = 4, K_ROW = 5, K_MOD = 6 };
struct Step { int kind, st, layer, sync_before; };
inline int build_program(Step* prog) {
    int n = 0;
    prog[n++] = {K_ITEM, ST_ZERO, 0, 0}; prog[n++] = {K_ITEM, ST_TAB, 0, 0}; prog[n++] = {USE_KMOD ? K_MOD : K_ITEM, USE_KMOD ? 0 : ST_MOD, 0, 0}; prog[n++] = {K_WT, WT_STATIC, 0, 0};
    for (int l = 0; l < DEPTH; ++l) {
        if (l == 0 || !USE_RPOST2) { if (USE_RNORM1) prog[n++] = {K_ROW, 0  , l, 1}; else prog[n++] = {K_ITEM, ST_NORM1, l, 1}; }
        prog[n++] = {K_GEMM, G_PROJ, l, 1};
        prog[n++] = {K_ROW, 3  , l, 1};
        prog[n++] = {K_GEMM, G_UQ, l, 1}; prog[n++] = {K_GEMM, G_UKV, l, 0}; prog[n++] = {K_GPRE, 0, l, 0};
        prog[n++] = {K_ATTN, 0, l, 1};
        prog[n++] = {K_ROW, 4  , l, 1};
        prog[n++] = {K_GEMM, G_WOUT, l, 1}; prog[n++] = {K_WT, WT_EXPERT, l, 0};
        if (USE_RPOST1) { prog[n++] = {K_ROW, 1  , l, 1}; prog[n++] = {K_ROW, 5  , l, 1}; } else { prog[n++] = {K_ITEM, ST_POST1, l, 1}; prog[n++] = {K_ITEM, ST_ROUTER, l, 1}; prog[n++] = {K_ITEM, ST_ROUTE, l, 1}; }
        prog[n++] = {K_GEMM, G_SGU, l, 1}; prog[n++] = {K_GEMM, G_EGU, l, 0};
        prog[n++] = {K_GEMM, G_SDOWN, l, 1}; prog[n++] = {K_GEMM, G_EDOWN, l, 0};
        if (USE_RPOST2) prog[n++] = {K_ROW, 2  , l, 1}; else prog[n++] = {K_ITEM, ST_POST2, l, 1};
    }
    return n;
}
constexpr int MAX_STEPS = 64;

#ifndef HOST_EMU
namespace cg = cooperative_groups;
struct Prog { Step s[MAX_STEPS]; int n; int pad[3]; };

__global__ void __launch_bounds__(256, 2) k_mega(Params p, Prog pr) {
    extern __shared__ __attribute__((aligned(16))) unsigned char smem[];
    LAS unsigned char* lds = (LAS unsigned char*)smem;
    cg::grid_group grid = cg::this_grid();
    { volatile LAS unsigned* bst = (volatile LAS unsigned*)(lds + 65536); if (threadIdx.x < 2) bst[threadIdx.x] = 0u; }
    __syncthreads();
    (void)xcd_barrier_post(p.BAR(), (volatile LAS unsigned*)(lds + 65536));
#define XBAR_NOW() do { XcdBarrier xb_; xb_.bar = p.BAR(); xb_.x = xb_xcc_id(); xb_.st = (volatile LAS unsigned*)(lds + 65536); xcd_barrier(xb_); } while (0)
    bool first_sync = true;
    const long long gthreads = (long long)gridDim.x * 256;
#if PROBE_SEL
    unsigned long long pb_acc = 0, pb_t0 = __builtin_amdgcn_s_memrealtime(); bool pb_on = false; unsigned long long pb_chain = 0;
#endif
    for (int s = 0; s < pr.n; ++s) {
        const int kind = pr.s[s].kind, st = pr.s[s].st, layer = pr.s[s].layer;
#if PROBE_SEL
        const bool pb_match = (PROBE_SEL == 1 && kind == K_ROW && st == 1) || (PROBE_SEL == 2 && ((kind == K_ITEM && st == ST_ROUTE) || (kind == K_ROW && st == 5))) || (PROBE_SEL == 3 && kind == K_ROW && st == 2) || (PROBE_SEL == 4 && kind == K_ROW && st == 3) ||
            (PROBE_SEL == 5 && kind == K_ROW && st == 4) || (PROBE_SEL == 6 && kind == K_ATTN) || (PROBE_SEL == 7 && kind == K_GEMM && st == G_PROJ) || (PROBE_SEL == 8 && kind == K_GEMM && st == G_WOUT) ||
            (PROBE_SEL == 9 && kind == K_GEMM && st == G_EGU) || (PROBE_SEL == 10 && kind == K_GEMM && st == G_EDOWN) || (PROBE_SEL == 11 && kind == K_GPRE) || (PROBE_SEL == 12 && kind == K_WT && st == WT_STATIC) || (PROBE_SEL == 13 && kind == K_WT && st == WT_EXPERT) || (PROBE_SEL == 14 && kind == K_ROW && st == 0);
#endif
        if (pr.s[s].sync_before) { if (first_sync) { grid.sync(); first_sync = false; } else XBAR_NOW();
#if PROBE_SEL
            { const unsigned long long now = __builtin_amdgcn_s_memrealtime(); if (pb_on) pb_acc += now - pb_t0; pb_t0 = now; pb_on = false; }
#endif
        }
#if PROBE_SEL
        if (pb_match) pb_on = true;
#endif
        int reps = 1;
        if (PROBE_MASK) { const int grp = kind == K_GEMM ? 0 : kind == K_ATTN ? 1 : kind == K_GPRE ? 2 : kind == K_WT ? 3 : (kind == K_ROW && (st == R_XFORM || st == R_GOUT || st == R_NORM1)) ? 4 : 7;
            if (grp < 5 && ((PROBE_MASK >> grp) & 1)) reps = 2; if (((PROBE_MASK >> 5) & 1) && pr.s[s].sync_before) XBAR_NOW(); }
        for (int rep = 0; rep < reps; ++rep) {
        if (rep > 0 && ((PROBE_MASK >> 6) & 1)) XBAR_NOW();
        int tid = threadIdx.x; asm volatile("" : "+v"(tid));
        const int lane = tid & 63, wave = __builtin_amdgcn_readfirstlane(tid >> 6);
        const long long gtid = (long long)blockIdx.x * 256 + tid;
        ETab et{nullptr, nullptr};
        if ((kind == K_GEMM && (st == G_EGU || st == G_EDOWN)) || (kind == K_ROW && st == R_POST2)) {
            LAS int* eb = (LAS int*)(lds + 65536 + 64); LAS int* tb = eb + 72;
            __syncthreads();
            if (wave == 0) { const int c = FUSE_ROUTE ? p.CNTP()[(layer * NE + lane) * 32] : p.CNT()[layer * NE + lane]; int a = c, t = (c + 127) >> 7;
#pragma unroll
                for (int o = 1; o < 64; o <<= 1) { const int ua = __shfl_up(a, o), ut = __shfl_up(t, o); if (lane >= o) { a += ua; t += ut; } }
                eb[lane + 1] = a; tb[lane + 1] = t; if (lane == 0) { eb[0] = 0; tb[0] = 0; } }
            __syncthreads();
            et.eb = (const int*)eb; et.tb = (const int*)tb;
        }
        if (kind == K_ITEM) {
            const long long n = n_items(st, layer);
#define RUN_ST(ST) case ST: for (long long i = gtid; i < n; i += gthreads) run_item(p, ST, layer, i); break;
            switch (st) {
#if !USE_KMOD
                RUN_ST(ST_MOD)
#endif
#if !USE_RNORM1
                RUN_ST(ST_NORM1)
#endif
#if !USE_RPOST1
                RUN_ST(ST_POST1) RUN_ST(ST_ROUTER)
#endif
#if !USE_RPOST2
                RUN_ST(ST_POST2)
#endif
                RUN_ST(ST_ZERO) RUN_ST(ST_TAB)
#if !USE_RPOST1 || !FUSE_ROUTE
                RUN_ST(ST_ROUTE)
#endif
                default: break; }
#undef RUN_ST
        } else if (kind == K_WT) {
            const long long n = wt_items(p, st); LAS float* scr = (LAS float*)(lds + wave * (64 * 33 * 4));
            for (long long i = (long long)blockIdx.x * 4 + wave; i < n; i += (long long)gridDim.x * 4) wt_item_dev(p, st, layer, i, scr, lane);
        } else if (kind == K_GEMM) {
            const int n = gemm_ntiles(p, st, layer, et);
            const int q8 = n >> 3, r8 = n & 7;
            for (int i = blockIdx.x; i < n; i += gridDim.x) {
                const int x = i & 7, tau = (x < r8 ? x * (q8 + 1) : r8 * (q8 + 1) + (x - r8) * q8) + (i >> 3);
                GemmDesc g; gemm_desc(p, st, layer, tau, g, et); gemm_tile_dev(g, lds, tid); }
        } else if (kind == K_ROW) {
            const int gw = blockIdx.x * 4 + wave, nw = gridDim.x * 4;
            if (st == R_NORM1) { for (int r = gw; r < TA; r += nw) row_norm1(p, layer, r, lane); }
            else if (st == R_POST1) { __syncthreads();
#if FUSE_ROUTE
                LAS float* hl = (LAS float*)(lds + wave * (4 * D * 4)); for (int i = gw; i < rows_out(layer) / 4; i += nw) row_post1_quad(p, layer, i, lane, hl);
#else
                LAS float* hl = (LAS float*)(lds + wave * (POST1_NR * D * 4)); LAS int* lcnt = (LAS int*)(lds + 65536 + 640);
                if (tid < NE) lcnt[tid] = 0;
                __syncthreads();
                (void)hl; for (int j16 = blockIdx.x; j16 < rows_out(layer) / 16; j16 += gridDim.x) block_post1(p, layer, j16, lane, wave, lds, lcnt);
                __syncthreads();
                if (tid < NE) p.BCNT()[(size_t)blockIdx.x * NE + tid] = lcnt[tid];
#endif
            }
            else if (st == R_ROUTE2) route_place(p, layer, lds, tid, lane, wave);
            else if (st == R_POST2) { for (int r = gw; r < rows_out(layer); r += nw) row_post2(p, layer, r, lane, et.eb); }
            else if (st == R_XFORM) { __syncthreads(); LAS float* cw = (LAS float*)lds; for (int i = tid; i < GCONV * GQKV; i += 256) cw[i] = p.gdn_conv_w[(size_t)layer * GCONV * GQKV + i]; __syncthreads();
                for (int r = gw; r < TA; r += nw) row_xform(p, layer, r, lane, cw); }
            else { for (int r = gw; r < rows_out(layer); r += nw) row_gout(p, layer, r, lane); }
        } else if (kind == K_MOD) {
            for (int i = blockIdx.x; i < DEPTH * (6 * D / 64); i += gridDim.x) mod_block(p, i, lds, tid);
        } else if (kind == K_GPRE) {
            const int n = NCHAIN * NCH / 2;
            for (int i = blockIdx.x; i < n; i += gridDim.x) gdn_pre_dev(p, i, lds, tid);
        } else {
            LAS int* slot = (LAS int*)(lds + 65536 + 16); const int x0 = (int)(xb_xcc_id() & 7u);
            for (int qs = 0; qs < 8; ++qs) {
                const int x = (x0 + qs) & 7, nq = attn_queue_size(layer, x);
                for (;;) {
                    __syncthreads(); if (tid == 0) *slot = atomicAdd(p.CTR() + layer * 16 + rep * 8 + x, 1); __syncthreads();
                    const int k = *slot; if (k >= nq) break;
                    const int item = attn_queue_item(layer, x, k);
                    int t2 = tid; asm volatile("" : "+v"(t2));
#if PROBE_SEL == 24
                    if (item < NCHAIN) { const unsigned long long c0 = __builtin_amdgcn_s_memrealtime(); gdn_scan_dev(p, item, lds, t2); pb_chain += __builtin_amdgcn_s_memrealtime() - c0; continue; }
#else
                    if (item < NCHAIN) { gdn_scan_dev(p, item, lds, t2); continue; }
#endif
                    AttnDesc a; attn_desc(p, layer, item - NCHAIN, a);
                    if (a.dqk == 96) attn_tile_dev<96>(a, lds, t2); else attn_tile_dev<64>(a, lds, t2);
                }
            }
        }
        }
    }
#if PROBE_SEL
    { const unsigned long long now = __builtin_amdgcn_s_memrealtime(); if (pb_on) pb_acc += now - pb_t0;
      if (PROBE_SEL == 24) pb_acc = pb_chain;
      if (blockIdx.x == 0 || PROBE_SEL == 24) { const unsigned long long until = now + 4ull * pb_acc; while (__builtin_amdgcn_s_memrealtime() < until) __builtin_amdgcn_s_sleep(32); } }
#endif
}

extern "C" void kernel_launch(void* const* d_in, const int* in_sizes, int n_in, void* d_out, int out_size, void* d_ws, size_t ws_size, hipStream_t stream) {
    Params p{};
    const float** pin = (const float**)&p;
    for (int i = 0; i < 29 && i < n_in; ++i) pin[i] = (const float*)d_in[i];
    p.out = (float*)d_out;
    const size_t need = carve(p, (char*)d_ws);
    if (need > ws_size) { fprintf(stderr, "kernel_launch: workspace too small: need %zu have %zu\n", need, ws_size); return; }
    Prog pr{}; pr.n = build_program(pr.s);
    constexpr int LDS_BYTES = 65536 + 1024;
    static int grid_blocks = 0;
    if (!grid_blocks) {
        int dev = 0, cus = 0, per_cu = 0;
        (void)hipGetDevice(&dev);
        (void)hipDeviceGetAttribute(&cus, hipDeviceAttributeMultiprocessorCount, dev);
        (void)hipFuncSetAttribute((const void*)k_mega, hipFuncAttributeMaxDynamicSharedMemorySize, LDS_BYTES);
        (void)hipOccupancyMaxActiveBlocksPerMultiprocessor(&per_cu, k_mega, 256, LDS_BYTES);
        if (per_cu > 2) per_cu = 2;
        if (per_cu < 1) per_cu = 1;
        grid_blocks = cus * per_cu;
    }
    (void)hipMemsetAsync(p.BAR(), 0, 4096 * 4, stream);
    void* args[] = {&p, &pr};
    hipError_t e = hipLaunchCooperativeKernel((void*)k_mega, dim3(grid_blocks), dim3(256), args, LDS_BYTES, stream);
    if (e != hipSuccess) fprintf(stderr, "cooperative launch failed: %s (grid %d)\n", hipGetErrorString(e), grid_blocks);
}
#endif
```

```cpp
#ifndef HOST_EMU
#include <hip/hip_runtime.h>
#include <hip/hip_cooperative_groups.h>
#include <cstdio>
#define HD __host__ __device__ __forceinline__
#else
#include <cmath>
#include <cstdio>
#include <cstring>
#define HD inline
#endif
#include <cstdint>
#include <utility>

#ifndef CFG_D
#define CFG_D 1024
#endif
#ifndef CFG_S
#define CFG_S 8192
#endif
#ifndef CFG_L
#define CFG_L 256
#endif
#ifndef CFG_DE
#define CFG_DE 256
#endif
#ifndef CFG_DS
#define CFG_DS 256
#endif
#ifndef PROBE_SEL
#define PROBE_SEL 0
#endif
#ifndef PROBE_MASK
#define PROBE_MASK 0
#endif
#ifndef POST1_NR
#define POST1_NR 4
#endif
#ifndef FUSE_ROUTE
#define FUSE_ROUTE 0
#endif
#ifndef USE_KMOD
#define USE_KMOD 1
#endif
#ifndef USE_RNORM1
#define USE_RNORM1 1
#endif
#ifndef USE_RPOST1
#define USE_RPOST1 1
#endif
#ifndef USE_RPOST2
#define USE_RPOST2 1
#endif

namespace cfg {
constexpr int D = CFG_D, B = 2, S = CFG_S, L = CFG_L, DEPTH = 2, GRID_W = 64;
constexpr int T = B * S, TC = B * L, TA = T + TC;
constexpr int SWA_H = 6, SWA_KVH = 2, SWA_G = 3, SWA_W = 128;
constexpr int GH = 6, GDK = 64, GDV = 64, GCONV = 5;
constexpr int MH = 4, MQR = 192, MKVR = 128, MNOPE = 64, MROPE = 32, MV = 64, MQD = MNOPE + MROPE, MKVD = MNOPE + MV;
constexpr int DMIX = 1024, GQKV = 1152;
constexpr int PO_QA = 0, PO_KA = 384, PO_VA = 512, PO_GQKV = 640, PO_Z = 1792, PO_BA = 2176, PO_CQ = 2200, PO_CKV = 2392, PO_KR = 2528  , PO_KR_SRC = 2520, DPROJ = 2552, DPROJP = 2560;
constexpr int NE = 64, TOPK = 8, NGRP = 8, TOPG = 4, DE = CFG_DE, DS = CFG_DS;
constexpr float EPS = 1e-6f, ROUTED_SCALE = 2.5f;
constexpr int NSLOT = TA * TOPK, NK = S + L, NCHAIN = B * GH * 2, NCH = (S + L) / 64;
constexpr int NSPLIT = (NK / 64) % 4 == 0 ? 4 : ((NK / 64) % 2 == 0 ? 2 : 1);
static_assert(D % 128 == 0 && DE % 64 == 0 && DS % 64 == 0 && TA % 128 == 0 && T % 128 == 0, "tile divisibility");
}
using namespace cfg;

#ifdef HOST_EMU
typedef float st_t;
HD float ldf(const st_t* p) { return *p; }
HD void stf(st_t* p, float v) { *p = v; }
HD void st4(st_t* p, float a, float b, float c, float d) { p[0] = a; p[1] = b; p[2] = c; p[3] = d; }
#else
typedef unsigned short st_t;
typedef short bf16x8 __attribute__((ext_vector_type(8)));
typedef float f32x4 __attribute__((ext_vector_type(4)));
typedef float f32x2 __attribute__((ext_vector_type(2)));
typedef __bf16 bf16x2_t __attribute__((ext_vector_type(2)));
#define LAS __attribute__((address_space(3)))
HD float ldf(const st_t* p) { unsigned u = ((unsigned)*p) << 16; float f; __builtin_memcpy(&f, &u, 4); return f; }
HD unsigned short f2bf(float v) { unsigned u; __builtin_memcpy(&u, &v, 4); u = (u + 0x7fffu + ((u >> 16) & 1u)) >> 16; return (unsigned short)u; }
HD void stf(st_t* p, float v) { *p = f2bf(v); }
HD float ldf(const float* p) { return *p; }
HD void stf(float* p, float v) { *p = v; }
__device__ __forceinline__ unsigned pk_bf16(float lo, float hi) { f32x2 v = {lo, hi}; return __builtin_bit_cast(unsigned, __builtin_convertvector(v, bf16x2_t)); }
HD void st4(st_t* p, float a, float b, float c, float d) {
#if defined(__HIP_DEVICE_COMPILE__)
    uint2 w; w.x = pk_bf16(a, b); w.y = pk_bf16(c, d); *(uint2*)p = w;
#else
    p[0] = f2bf(a); p[1] = f2bf(b); p[2] = f2bf(c); p[3] = f2bf(d);
#endif
}
#endif

HD void st8(st_t* p, const float (&a)[4], const float (&b)[4]) {
#if defined(__HIP_DEVICE_COMPILE__)
    uint4 w; w.x = pk_bf16(a[0], a[1]); w.y = pk_bf16(a[2], a[3]); w.z = pk_bf16(b[0], b[1]); w.w = pk_bf16(b[2], b[3]); *(uint4*)p = w;
#else
    for (int i = 0; i < 4; ++i) { stf(p + i, a[i]); stf(p + 4 + i, b[i]); }
#endif
}
#if defined(__HIP_DEVICE_COMPILE__)
__device__ __forceinline__ float fast_exp(float x) { return __builtin_amdgcn_exp2f(x * 1.4426950408889634f); }
__device__ __forceinline__ float silu_f(float x) { return x * __builtin_amdgcn_rcpf(1.0f + fast_exp(-x)); }
__device__ __forceinline__ float sigmoid_f(float x) { return __builtin_amdgcn_rcpf(1.0f + fast_exp(-x)); }
__device__ __forceinline__ float softplus_f(float x) { return x > 20.f ? x : 0.6931471805599453f * __builtin_amdgcn_logf(1.0f + fast_exp(x)); }
__device__ __forceinline__ float rsqrt_f(float x) { return __builtin_amdgcn_rsqf(x); }
#else
HD float silu_f(float x) { return x / (1.0f + expf(-x)); }
HD float sigmoid_f(float x) { return 1.0f / (1.0f + expf(-x)); }
HD float softplus_f(float x) { return x > 20.f ? x : log1pf(expf(x)); }
HD float rsqrt_f(float x) { return 1.0f / sqrtf(x); }
#endif

struct TJob { const float* src; st_t* dst; int K, N, npad, grp, off, ldt, ldsrc, gran; };
constexpr int NJOBS = 16;

struct WsOff { size_t BAR, MOD, TABA, TABM, XC, BG, LOGITS, EW, EIDX, EPOS, CNT, CNTP, CTR, GAM, TOKLIST, WLIST, H, Wt_in, Wt_out, Wt_uq, Wt_ukv, Wt_sgu, Wt_sd, SACT, ACT, Wt_egu, Wt_ed, CH,
               P, G, CQN, CKVN, MQ, MKV, O, VtM, VtA, OF, OB, YB, OPART, MLPART, BCNT, total; };
constexpr size_t align256(size_t v) { return (v + 255) & ~(size_t)255; }
constexpr WsOff make_ws() {
    WsOff w{}; size_t off = 0; const size_t E = sizeof(st_t);
#define TAKE(name, bytes) w.name = off; off = align256(off + (size_t)(bytes));
    TAKE(BAR, 4096 * 4)
    TAKE(MOD, (size_t)DEPTH * 3 * 6 * D * 4) TAKE(TABA, 128 * 16 * 2 * 4) TAKE(TABM, 128 * 8 * 2 * 4) TAKE(XC, (size_t)TC * D * 4) TAKE(BG, (size_t)TA * 24 * 4)
    TAKE(LOGITS, (size_t)TA * NE * 4) TAKE(EW, (size_t)TA * TOPK * 4) TAKE(EIDX, (size_t)TA * TOPK * 4) TAKE(EPOS, (size_t)TA * TOPK * 4)
    TAKE(BCNT, 1024 * NE * 4)
    TAKE(CNT, DEPTH * NE * 4) TAKE(CNTP, DEPTH * NE * 32 * 4) TAKE(CTR, DEPTH * 16 * 4) TAKE(GAM, (size_t)NCHAIN * NCH * 4) TAKE(TOKLIST, (size_t)NE * TA * 4) TAKE(WLIST, (size_t)NE * TA * 4)
    TAKE(H, (size_t)TA * D * E)
    TAKE(Wt_in, (size_t)DEPTH * DPROJP * D * E) TAKE(Wt_out, (size_t)DEPTH * D * DMIX * E) TAKE(Wt_uq, (size_t)DEPTH * MH * MQD * MQR * E) TAKE(Wt_ukv, (size_t)DEPTH * MH * MKVD * MKVR * E)
    TAKE(Wt_sgu, (size_t)DEPTH * 2 * DS * D * E) TAKE(Wt_sd, (size_t)DEPTH * D * DS * E)
    const size_t q0 = off;
    TAKE(SACT, (size_t)TA * DS * E) TAKE(ACT, ((size_t)NSLOT * DE * E > (size_t)TA * D * E ? (size_t)NSLOT * DE * E : (size_t)TA * D * E))
    TAKE(Wt_egu, (size_t)NE * 2 * DE * D * E) TAKE(Wt_ed, (size_t)NE * D * DE * E)
    w.CH = q0; { const size_t chb = align256((size_t)NCHAIN * NCH * 5 * 4096 * E); if (q0 + chb > off) off = q0 + chb; }
    const size_t r0 = off;
    TAKE(P, (size_t)TA * DPROJP * E) TAKE(G, (size_t)TA * GQKV * E) TAKE(CQN, (size_t)TA * MQR * E) TAKE(CKVN, (size_t)TA * MKVR * E) TAKE(MQ, (size_t)TA * MH * MQD * E) TAKE(MKV, (size_t)TA * MH * MKVD * E)
    TAKE(O, (size_t)TA * DMIX * E) TAKE(VtM, (size_t)B * MH * MV * NK * E) TAKE(VtA, (size_t)B * SWA_KVH * 64 * NK * E) TAKE(OF, (size_t)TA * GH * GDV * E) TAKE(OB, (size_t)TA * GH * GDV * E)
#undef TAKE
    w.YB = r0; { const size_t yb = align256((size_t)NSLOT * D * E); if (r0 + yb > off) off = r0 + yb; }
    if ((size_t)NSPLIT * T * MH * MV * E <= (size_t)TA * D * E) w.OPART = w.H; else { w.OPART = off; off = align256(off + (size_t)NSPLIT * T * MH * MV * E); }
    if ((size_t)NSPLIT * T * MH * 2 * 4 <= (size_t)TA * NE * 4) w.MLPART = w.LOGITS; else { w.MLPART = off; off = align256(off + (size_t)NSPLIT * T * MH * 2 * 4); }
    w.total = off; return w;
}
constexpr WsOff WS = make_ws();

struct Params {
    const float *x, *c, *ctx, *c_ctx, *ada_w, *ada_b, *mix_norm_pre, *mix_norm_post, *ffn_norm_pre, *ffn_norm_post,
        *w_in, *w_out, *swa_sink, *gdn_conv_w, *gdn_a_log, *gdn_dt_bias, *gdn_norm_w, *mla_q_norm, *mla_w_uq, *mla_kv_norm, *mla_w_ukv,
        *router_w, *router_bias, *e_gate, *e_up, *e_down, *s_gate, *s_up, *s_down;
    float* out;
    char* ws;
#define WSF(T, name, field) HD T* name() const { return (T*)(ws + WS.field); }
    WSF(unsigned, BAR, BAR) WSF(float, MOD, MOD) WSF(float, TABA, TABA) WSF(float, TABM, TABM) WSF(float, XC, XC) WSF(float, BG, BG) WSF(float, LOGITS, LOGITS) WSF(float, EW, EW)
    WSF(int, EIDX, EIDX) WSF(int, EPOS, EPOS) WSF(int, CNT, CNT) WSF(int, CNTP, CNTP) WSF(int, CTR, CTR) WSF(float, GAM, GAM) WSF(int, TOKLIST, TOKLIST) WSF(float, WLIST, WLIST)
    WSF(st_t, H, H) WSF(st_t, SH, H) WSF(st_t, Wt_in, Wt_in) WSF(st_t, Wt_out, Wt_out) WSF(st_t, Wt_uq, Wt_uq) WSF(st_t, Wt_ukv, Wt_ukv) WSF(st_t, Wt_sgu, Wt_sgu) WSF(st_t, Wt_sd, Wt_sd)
    WSF(st_t, SACT, SACT) WSF(st_t, ACT, ACT) WSF(st_t, Y, ACT) WSF(st_t, Wt_egu, Wt_egu) WSF(st_t, Wt_ed, Wt_ed) WSF(st_t, CH, CH)
    WSF(st_t, P, P) WSF(st_t, G, G) WSF(st_t, CQN, CQN) WSF(st_t, CKVN, CKVN) WSF(st_t, MQ, MQ) WSF(st_t, MKV, MKV) WSF(st_t, O, O) WSF(st_t, VtM, VtM) WSF(st_t, VtA, VtA)
    WSF(st_t, OF, OF) WSF(st_t, OB, OB) WSF(st_t, YB, YB)
    WSF(st_t, OPART, OPART) WSF(float, MLPART, MLPART) WSF(int, BCNT, BCNT)
#undef WSF
};
inline size_t carve(Params& p, char* ws) { p.ws = ws; return WS.total; }

HD TJob static_job(const Params& p, int j) {
    const int l = j / (NJOBS / DEPTH), k = j % (NJOBS / DEPTH);
    switch (k) {
    case 0: return TJob{p.w_in + (size_t)l * D * DPROJ, p.Wt_in() + (size_t)l * DPROJP * D, D, PO_KR_SRC, PO_KR, 16, 0, D, DPROJ, 16};
    case 1: return TJob{p.w_in + (size_t)l * D * DPROJ + PO_KR_SRC, p.Wt_in() + (size_t)l * DPROJP * D + (size_t)PO_KR * D, D, MROPE, MROPE, 16, 0, D, DPROJ, 16};
    case 2: return TJob{p.w_out + (size_t)l * DMIX * D, p.Wt_out() + (size_t)l * D * DMIX, DMIX, D, D, 16, 0, DMIX, D, 16};
    case 3: return TJob{p.mla_w_uq + (size_t)l * MQR * MH * MQD, p.Wt_uq() + (size_t)l * MH * MQD * MQR, MQR, MH * MQD, MH * MQD, 16, 0, MQR, MH * MQD, 16};
    case 4: return TJob{p.mla_w_ukv + (size_t)l * MKVR * MH * MKVD, p.Wt_ukv() + (size_t)l * MH * MKVD * MKVR, MKVR, MH * MKVD, MH * MKVD, 16, 0, MKVR, MH * MKVD, 16};
    case 5: return TJob{p.s_gate + (size_t)l * D * DS, p.Wt_sgu() + (size_t)l * 2 * DS * D, D, DS, DS, 8, 0, D, DS, 4};
    case 6: return TJob{p.s_up + (size_t)l * D * DS, p.Wt_sgu() + (size_t)l * 2 * DS * D, D, DS, DS, 8, 4, D, DS, 4};
    default: return TJob{p.s_down + (size_t)l * DS * D, p.Wt_sd() + (size_t)l * D * DS, DS, D, D, 16, 0, DS, D, 16};
    }
}
HD long long static_job_items(int j) {
    const int k = j % (NJOBS / DEPTH);
    const int K = k == 2 ? DMIX : k == 3 ? MQR : k == 4 ? MKVR : k == 7 ? DS : D;
    const int npad = k == 0 ? PO_KR : k == 1 ? MROPE : k == 2 ? D : k == 3 ? MH * MQD : k == 4 ? MH * MKVD : k == 7 ? D : DS;
    return (long long)(K / 64) * ((npad + 31) / 32);
}

HD int mod_which(int r) { return r < T ? r / S : 2; }
HD const float* mod_vec(const Params& p, int layer, int r, int chunk) { return p.MOD() + ((size_t)(layer * 3 + mod_which(r)) * 6 + chunk) * D; }
HD void seq_bounds(int r, int& lo, int& hi) { if (r < T) { lo = (r / S) * S; hi = lo + S; } else { lo = T + ((r - T) / L) * L; hi = lo + L; } }
HD float* xrow(const Params& p, int r) { return r < T ? p.out + (size_t)r * D : p.XC() + (size_t)(r - T) * D; }
HD const float* xin_row(const Params& p, int layer, int r) { if (layer > 0) return xrow(p, r); return r < T ? p.x + (size_t)r * D : p.ctx + (size_t)(r - T) * D; }
HD int rows_out(int layer) { return layer == DEPTH - 1 ? T : TA; }
HD int expert_base(const int* cnt, int e) { int b = 0; for (int i = 0; i < e; ++i) b += cnt[i]; return b; }

#ifdef HOST_EMU
inline int atomic_inc(int* p) { int v;
#pragma omp atomic capture
    { v = *p; *p += 1; }
    return v; }
#else
__device__ __forceinline__ int atomic_inc(int* p) { return atomicAdd(p, 1); }
#endif

enum Stage { ST_MOD = 0, ST_ZERO, ST_NORM1, ST_ROPE_SWA, ST_GDN_CONV, ST_GDN_L2, ST_GDN_GATE, ST_MLA_NORM, ST_ROPE_MLA,
             ST_SWA, ST_GDN_SCAN, ST_GDN_OUT, ST_MLA, ST_POST1, ST_ROUTER, ST_ROUTE, ST_POST2, ST_VT, ST_TAB, ST_COUNT };

HD long long n_items(int st, int layer) {
    switch (st) {
    case ST_MOD: return (long long)DEPTH * 3 * 6 * D;
    case ST_ZERO: return DEPTH * NE + DEPTH * 16 + DEPTH * NE * 32;
    case ST_VT: return (long long)(B * MH + B * SWA_KVH) * (NK / 8) * 64;
    case ST_TAB: return 128 * 16 + 128 * 8;
    case ST_NORM1: return TA;
    case ST_ROPE_SWA: return (long long)T * 8 * 32;
    case ST_GDN_CONV: return (long long)TA * GQKV;
    case ST_GDN_L2: return (long long)TA * 12;
    case ST_GDN_GATE: return (long long)TA * 12;
    case ST_MLA_NORM: return (long long)TA * 2;
    case ST_ROPE_MLA: return (long long)T * 5 * 16;
    case ST_SWA: return (long long)rows_out(layer) * SWA_H;
    case ST_GDN_SCAN: return (long long)B * GH * 2 * GDV;
    case ST_GDN_OUT: return (long long)rows_out(layer) * GH;
    case ST_MLA: return (long long)rows_out(layer) * MH;
    case ST_POST1: return rows_out(layer);
    case ST_ROUTER: return (long long)rows_out(layer) * NE;
    case ST_ROUTE: return rows_out(layer);
    case ST_POST2: return rows_out(layer);
    }
    return 0;
}

HD float rope_inv(int i, int n) { return exp2f(-(float)i / (float)n * 13.287712379549449f); }

HD void run_item(const Params& p, int st, int layer, long long i) {
    switch (st) {
    case ST_MOD: {
        const int j = (int)(i % (6 * D)); const int w = (int)((i / (6 * D)) % 3); const int ly = (int)(i / (6 * D * 3));
        const float* cv = w < 2 ? p.c + (size_t)w * D : p.c_ctx;
        const float* W = p.ada_w + (size_t)ly * D * 6 * D;
        float acc = p.ada_b[(size_t)ly * 6 * D + j];
        for (int k = 0; k < D; ++k) acc += silu_f(cv[k]) * W[(size_t)k * 6 * D + j];
        p.MOD()[i] = acc;
    } break;
    case ST_ZERO: if (i < DEPTH * NE) p.CNT()[i] = 0; else if (i < DEPTH * NE + DEPTH * 16) p.CTR()[i - DEPTH * NE] = 0; else p.CNTP()[i - DEPTH * NE - DEPTH * 16] = 0; break;
    case ST_TAB: {
        if (i < 128 * 16) { const int pos = (int)(i / 16), ii = (int)(i % 16); const float ang = (float)pos * rope_inv(ii, 16); p.TABA()[2 * i] = cosf(ang); p.TABA()[2 * i + 1] = sinf(ang); }
        else { const long long k = i - 128 * 16; const int pos = (int)(k / 8), ii = (int)(k % 8); const float ang = (float)pos * rope_inv(ii, 8); p.TABM()[2 * k] = cosf(ang); p.TABM()[2 * k + 1] = sinf(ang); }
    } break;
    case ST_VT: {
        const int dv = (int)(i % 64); long long r = i / 64; const int kc = (int)(r % (NK / 8)); const int bh = (int)(r / (NK / 8));
        const bool mla = bh < B * MH; const int b = mla ? bh / MH : (bh - B * MH) / SWA_KVH, hd = mla ? bh % MH : (bh - B * MH) % SWA_KVH;
        st_t* dst = (mla ? p.VtM() + ((size_t)(b * MH + hd) * 64 + dv) * NK : p.VtA() + ((size_t)(b * SWA_KVH + hd) * 64 + dv) * NK) + kc * 8;
        for (int j = 0; j < 8; ++j) { const int kidx = kc * 8 + j; const int row = kidx < S ? b * S + kidx : T + b * L + (kidx - S);
            dst[j] = mla ? p.MKV()[(size_t)row * MH * MKVD + hd * MKVD + MNOPE + dv] : p.P()[(size_t)row * DPROJP + PO_VA + hd * 64 + dv]; }
    } break;
    case ST_NORM1: {
        const int r = (int)i; const float* xr = xin_row(p, layer, r); float ss = 0.f;
        for (int d = 0; d < D; ++d) ss += xr[d] * xr[d];
        const float rstd = 1.0f / sqrtf(ss / D + EPS);
        const float* gain = p.mix_norm_pre + (size_t)layer * D; const float* sh = mod_vec(p, layer, r, 0); const float* sc = mod_vec(p, layer, r, 1);
        st_t* hr = p.H() + (size_t)r * D;
        for (int d = 0; d < D; ++d) stf(hr + d, xr[d] * rstd * gain[d] * (1.0f + sc[d]) + sh[d]);
    } break;
    case ST_ROPE_SWA: {
        const int j = (int)(i % 32), hh = (int)((i / 32) % 8), r = (int)(i / 256);
        const int s = r % S, rp = s / GRID_W, cp = s % GRID_W;
        const int base = hh < 6 ? PO_QA + hh * 64 : PO_KA + (hh - 6) * 64;
        const int half = j / 16, ii = j % 16; const int i1 = base + half * 32 + ii, i2 = i1 + 16;
        const float ang = (float)(half == 0 ? rp : cp) * rope_inv(ii, 16); const float cs = cosf(ang), sn = sinf(ang);
        st_t* pr = p.P() + (size_t)r * DPROJP; const float x1 = ldf(pr + i1), x2 = ldf(pr + i2);
        stf(pr + i1, x1 * cs - x2 * sn); stf(pr + i2, x1 * sn + x2 * cs);
    } break;
    case ST_GDN_CONV: {
        const int cc = (int)(i % GQKV), r = (int)(i / GQKV); int lo, hi; seq_bounds(r, lo, hi);
        const float* w = p.gdn_conv_w + (size_t)layer * GCONV * GQKV; float acc = 0.f;
        for (int j = 0; j < GCONV; ++j) { const int rr = r + j - 2; if (rr >= lo && rr < hi) acc += w[j * GQKV + cc] * ldf(p.P() + (size_t)rr * DPROJP + PO_GQKV + cc); }
        stf(p.G() + (size_t)r * GQKV + cc, silu_f(acc));
    } break;
    case ST_GDN_L2: {
        const int hh = (int)(i % 12), r = (int)(i / 12); st_t* g = p.G() + (size_t)r * GQKV + hh * 64; float ss = 0.f;
        for (int d = 0; d < 64; ++d) { const float v = ldf(g + d); ss += v * v; }
        const float rn = 1.0f / sqrtf(ss + EPS);
        for (int d = 0; d < 64; ++d) stf(g + d, ldf(g + d) * rn);
    } break;
    case ST_GDN_GATE: {
        const int j = (int)(i % 12), r = (int)(i / 12); const st_t* pr = p.P() + (size_t)r * DPROJP + PO_BA;
        const float beta = sigmoid_f(ldf(pr + j)); const float a = ldf(pr + 12 + j);
        const float g = -expf(p.gdn_a_log[layer * 12 + j]) * softplus_f(a + p.gdn_dt_bias[layer * 12 + j]);
        p.BG()[(size_t)r * 24 + j] = beta; p.BG()[(size_t)r * 24 + 12 + j] = g;
    } break;
    case ST_MLA_NORM: {
        const int w = (int)(i % 2), r = (int)(i / 2);
        const int n = w == 0 ? MQR : MKVR; const st_t* src = p.P() + (size_t)r * DPROJP + (w == 0 ? PO_CQ : PO_CKV);
        const float* gain = w == 0 ? p.mla_q_norm + (size_t)layer * MQR : p.mla_kv_norm + (size_t)layer * MKVR;
        st_t* dst = w == 0 ? p.CQN() + (size_t)r * MQR : p.CKVN() + (size_t)r * MKVR; float ss = 0.f;
        for (int d = 0; d < n; ++d) { const float v = ldf(src + d); ss += v * v; }
        const float rstd = 1.0f / sqrtf(ss / n + EPS);
        for (int d = 0; d < n; ++d) stf(dst + d, ldf(src + d) * rstd * gain[d]);
    } break;
    case ST_ROPE_MLA: {
        const int j = (int)(i % 16), w = (int)((i / 16) % 5), r = (int)(i / 80);
        const int s = r % S, rp = s / GRID_W, cp = s % GRID_W;
        const int half = j / 8, ii = j % 8; const float ang = (float)(half == 0 ? rp : cp) * rope_inv(ii, 8); const float cs = cosf(ang), sn = sinf(ang);
        st_t* q = w < 4 ? p.MQ() + (size_t)r * MH * MQD + w * MQD + MNOPE + half * 16 + ii : p.P() + (size_t)r * DPROJP + PO_KR + half * 16 + ii;
        const float x1 = ldf(q), x2 = ldf(q + 8); stf(q, x1 * cs - x2 * sn); stf(q + 8, x1 * sn + x2 * cs);
    } break;
    case ST_SWA: {
        const int h = (int)(i % SWA_H), r = (int)(i / SWA_H); const int kvh = h / SWA_G;
        float q[64], acc[64]; const st_t* qp = p.P() + (size_t)r * DPROJP + PO_QA + h * 64;
        _Pragma("unroll") for (int d = 0; d < 64; ++d) { q[d] = ldf(qp + d) * 0.125f; acc[d] = 0.f; }
        float m = p.swa_sink[layer * SWA_H + h], den = 1.0f;
        int b, klo = 0, khi = 0;
        if (r < T) { b = r / S; const int s = r % S; klo = s - SWA_W < 0 ? 0 : s - SWA_W; khi = s + SWA_W > S - 1 ? S - 1 : s + SWA_W; } else { b = (r - T) / L; khi = -1; }
        const int nloc = khi - klo + 1;
        for (int t = 0; t < nloc + L; ++t) {
            const int kr = t < nloc ? b * S + klo + t : T + b * L + (t - nloc);
            const st_t* kp = p.P() + (size_t)kr * DPROJP + PO_KA + kvh * 64; const st_t* vp = p.P() + (size_t)kr * DPROJP + PO_VA + kvh * 64;
            float sc = 0.f; _Pragma("unroll") for (int d = 0; d < 64; ++d) sc += q[d] * ldf(kp + d);
            if (sc > m) { const float f = expf(m - sc); den *= f; _Pragma("unroll") for (int d = 0; d < 64; ++d) acc[d] *= f; m = sc; }
            const float pe = expf(sc - m); den += pe;
            _Pragma("unroll") for (int d = 0; d < 64; ++d) acc[d] += pe * ldf(vp + d);
        }
        const float inv = 1.0f / den; st_t* o = p.O() + (size_t)r * DMIX + h * 64;
        _Pragma("unroll") for (int d = 0; d < 64; ++d) stf(o + d, acc[d] * inv);
    } break;
    case ST_GDN_SCAN: {
        const int e = (int)(i % GDV), dir = (int)((i / GDV) % 2), h = (int)((i / (GDV * 2)) % GH), b = (int)(i / (GDV * 2 * GH));
        float s[64]; _Pragma("unroll") for (int d = 0; d < 64; ++d) s[d] = 0.f;
        st_t* dst = dir == 0 ? p.OF() : p.OB();
        for (int t = 0; t < L + S; ++t) {
            int r; if (t < L) r = T + b * L + (dir == 0 ? t : L - 1 - t); else { const int u = t - L; r = b * S + (dir == 0 ? u : S - 1 - u); }
            const st_t* g = p.G() + (size_t)r * GQKV; const st_t* qv = g + h * 64; const st_t* kv = g + 384 + h * 64; const float v = ldf(g + 768 + h * 64 + e);
            const float beta = p.BG()[(size_t)r * 24 + dir * 6 + h], alpha = expf(p.BG()[(size_t)r * 24 + 12 + dir * 6 + h]);
            float ks = 0.f; _Pragma("unroll") for (int d = 0; d < 64; ++d) { s[d] *= alpha; ks += ldf(kv + d) * s[d]; }
            const float vn = beta * (v - ks); float o = 0.f;
            _Pragma("unroll") for (int d = 0; d < 64; ++d) { s[d] += ldf(kv + d) * vn; o += ldf(qv + d) * s[d]; }
            stf(dst + (size_t)r * (GH * GDV) + h * 64 + e, o * 0.125f);
        }
    } break;
    case ST_GDN_OUT: {
        const int h = (int)(i % GH), r = (int)(i / GH); const st_t* of = p.OF() + (size_t)r * 384 + h * 64; const st_t* ob = p.OB() + (size_t)r * 384 + h * 64;
        float ss = 0.f; for (int d = 0; d < 64; ++d) { const float o = ldf(of + d) + ldf(ob + d); ss += o * o; }
        const float rstd = 1.0f / sqrtf(ss / 64 + EPS); const float* nw = p.gdn_norm_w + layer * 64; const st_t* z = p.P() + (size_t)r * DPROJP + PO_Z + h * 64;
        st_t* o = p.O() + (size_t)r * DMIX + 384 + h * 64;
        for (int d = 0; d < 64; ++d) stf(o + d, (ldf(of + d) + ldf(ob + d)) * rstd * nw[d] * silu_f(ldf(z + d)));
    } break;
    case ST_MLA: {
        const int h = (int)(i % MH), r = (int)(i / MH); const float scale = 1.0f / sqrtf((float)MQD);
        float acc[64]; const st_t* qp = p.MQ() + (size_t)r * MH * MQD + h * MQD;
        _Pragma("unroll") for (int d = 0; d < 64; ++d) acc[d] = 0.f;
        float m = -1e30f, den = 0.f; int b, nlat;
        if (r < T) { b = r / S; nlat = S; } else { b = (r - T) / L; nlat = 0; }
        for (int t = 0; t < nlat + L; ++t) {
            const int kr = t < nlat ? b * S + t : T + b * L + (t - nlat);
            const st_t* kn = p.MKV() + (size_t)kr * MH * MKVD + h * MKVD; const st_t* krp = p.P() + (size_t)kr * DPROJP + PO_KR;
            float sc = 0.f; for (int d = 0; d < 64; ++d) sc += ldf(qp + d) * ldf(kn + d);
            for (int d = 0; d < 32; ++d) sc += ldf(qp + 64 + d) * ldf(krp + d);
            sc *= scale;
            if (sc > m) { const float f = expf(m - sc); den *= f; _Pragma("unroll") for (int d = 0; d < 64; ++d) acc[d] *= f; m = sc; }
            const float pe = expf(sc - m); den += pe;
            _Pragma("unroll") for (int d = 0; d < 64; ++d) acc[d] += pe * ldf(kn + 64 + d);
        }
        const float inv = 1.0f / den; st_t* o = p.O() + (size_t)r * DMIX + 768 + h * 64;
        _Pragma("unroll") for (int d = 0; d < 64; ++d) stf(o + d, acc[d] * inv);
    } break;
    case ST_POST1: {
        const int r = (int)i; const st_t* y = p.Y() + (size_t)r * D; const float* xi = xin_row(p, layer, r); float* xr = xrow(p, r); float ss = 0.f;
        for (int d = 0; d < D; ++d) { const float v = ldf(y + d); ss += v * v; }
        const float rstd = 1.0f / sqrtf(ss / D + EPS); const float* gp = p.mix_norm_post + (size_t)layer * D; const float* g1 = mod_vec(p, layer, r, 2);
        float s2 = 0.f;
        for (int d = 0; d < D; ++d) { const float v = xi[d] + g1[d] * ldf(y + d) * rstd * gp[d]; xr[d] = v; s2 += v * v; }
        const float r2 = 1.0f / sqrtf(s2 / D + EPS); const float* gf = p.ffn_norm_pre + (size_t)layer * D; const float* sh = mod_vec(p, layer, r, 3); const float* sc = mod_vec(p, layer, r, 4);
        st_t* hr = p.H() + (size_t)r * D;
        for (int d = 0; d < D; ++d) stf(hr + d, xr[d] * r2 * gf[d] * (1.0f + sc[d]) + sh[d]);
    } break;
    case ST_ROUTER: {
        const int n = (int)(i % NE), r = (int)(i / NE); const st_t* a = p.H() + (size_t)r * D; const float* b = p.router_w + (size_t)layer * D * NE + n; float acc = 0.f;
        for (int k = 0; k < D; ++k) acc += ldf(a + k) * b[(size_t)k * NE];
        p.LOGITS()[(size_t)r * NE + n] = acc;
    } break;
    case ST_ROUTE: {
        const int r = (int)i; const float* lg = p.LOGITS() + (size_t)r * NE; const float* bias = p.router_bias + (size_t)layer * NE;
        float gs[NGRP];
        _Pragma("unroll") for (int g = 0; g < NGRP; ++g) { float m1 = -1e30f, m2 = -1e30f; for (int j = 0; j < 8; ++j) { const float v = sigmoid_f(lg[g * 8 + j]) + bias[g * 8 + j]; if (v > m1) { m2 = m1; m1 = v; } else if (v > m2) m2 = v; } gs[g] = m1 + m2; }
        unsigned gmask = 0;
        _Pragma("unroll") for (int k = 0; k < TOPG; ++k) { int best = 0; float bv = -1e30f; _Pragma("unroll") for (int g = 0; g < NGRP; ++g) if (!((gmask >> g) & 1u) && gs[g] > bv) { bv = gs[g]; best = g; } gmask |= 1u << best; }
        unsigned long long used = 0ull; float wsum = 0.f; float wv[TOPK]; int wi[TOPK];
        _Pragma("unroll") for (int k = 0; k < TOPK; ++k) { int best = 0; float bv = -1e30f;
            for (int e = 0; e < NE; ++e) if (((gmask >> (e / 8)) & 1u) && !((used >> e) & 1ull)) { const float v = sigmoid_f(lg[e]) + bias[e]; if (v > bv) { bv = v; best = e; } }
            used |= 1ull << best; wi[k] = best; wv[k] = sigmoid_f(lg[best]); wsum += wv[k]; }
        int* cnt = p.CNT() + layer * NE;
        _Pragma("unroll") for (int k = 0; k < TOPK; ++k) { const float w = wv[k] / wsum * ROUTED_SCALE; const int e = wi[k]; const int pos = atomic_inc(cnt + e);
            p.EIDX()[(size_t)r * TOPK + k] = e; p.EW()[(size_t)r * TOPK + k] = w; p.EPOS()[(size_t)r * TOPK + k] = pos; p.TOKLIST()[(size_t)e * TA + pos] = r; p.WLIST()[(size_t)e * TA + pos] = w; }
    } break;
    case ST_POST2: {
        const int r = (int)i; float* xr = xrow(p, r); const int* cnt = p.CNT() + layer * NE; const st_t* f[TOPK + 1]; f[0] = p.SH() + (size_t)r * D;
        _Pragma("unroll") for (int k = 0; k < TOPK; ++k) { const int e = p.EIDX()[(size_t)r * TOPK + k]; f[k + 1] = p.YB() + (size_t)(expert_base(cnt, e) + p.EPOS()[(size_t)r * TOPK + k]) * D; }
        float ss = 0.f;
        for (int d = 0; d < D; ++d) { float v = 0.f; _Pragma("unroll") for (int k = 0; k <= TOPK; ++k) v += ldf(f[k] + d); ss += v * v; }
        const float rstd = 1.0f / sqrtf(ss / D + EPS); const float* gp = p.ffn_norm_post + (size_t)layer * D; const float* g2 = mod_vec(p, layer, r, 5);
        for (int d = 0; d < D; ++d) { float v = 0.f; _Pragma("unroll") for (int k = 0; k <= TOPK; ++k) v += ldf(f[k] + d); xr[d] = xr[d] + g2[d] * v * rstd * gp[d]; }
    } break;
    }
}

enum { WT_STATIC = 0, WT_EXPERT = 1 };
HD long long wt_items(const Params& p, int kind) {
    if (kind == WT_STATIC) { long long n = 0; for (int j = 0; j < NJOBS; ++j) n += static_job_items(j); return n; }
    return (long long)NE * ((D / 64) * (DE / 32) * 2 + (DE / 64) * (D / 32));
}
HD bool wt_job(const Params& p, int kind, int layer, long long item, TJob& jb, int& kb, int& nb) {
    if (kind == WT_STATIC) {
        for (int j = 0; j < NJOBS; ++j) { const long long n = static_job_items(j); if (item < n) { jb = static_job(p, j); const int nblk = (jb.npad + 31) / 32; kb = (int)(item / nblk); nb = (int)(item % nblk); return true; } item -= n; }
        return false;
    }
    const int per_gu = (D / 64) * (DE / 32), per_d = (DE / 64) * (D / 32), per_e = 2 * per_gu + per_d;
    const int e = (int)(item / per_e); int r = (int)(item % per_e);
    if (r < 2 * per_gu) { const int w = r / per_gu; r %= per_gu; const float* src = (w == 0 ? p.e_gate : p.e_up) + ((size_t)layer * NE + e) * D * DE;
        jb = {src, p.Wt_egu() + (size_t)e * 2 * DE * D, D, DE, DE, 8, w * 4, D, DE, 4};   kb = r / (DE / 32); nb = r % (DE / 32); }
    else { r -= 2 * per_gu; jb = {p.e_down + ((size_t)layer * NE + e) * DE * D, p.Wt_ed() + (size_t)e * D * DE, DE, D, D, 16, 0, DE, D, 16}; kb = r / (D / 32); nb = r % (D / 32); }
    return true;
}
HD size_t wt_dst_row(const TJob& jb, int n) { return (size_t)(n / jb.gran) * jb.grp + (n % jb.gran) + jb.off; }
#ifdef HOST_EMU
inline void wt_item_host(const Params& p, int kind, int layer, long long item) {
    TJob jb; int kb, nb; if (!wt_job(p, kind, layer, item, jb, kb, nb)) return;
    for (int n = nb * 32; n < nb * 32 + 32 && n < jb.npad; ++n) for (int k = kb * 64; k < kb * 64 + 64; ++k)
        jb.dst[wt_dst_row(jb, n) * jb.ldt + k] = n < jb.N ? jb.src[(size_t)k * jb.ldsrc + n] : 0.f;
}
#else
__device__ __forceinline__ void wt_item_dev(const Params& p, int kind, int layer, long long item, LAS float* scr, int lane) {
    TJob jb; int kb, nb; if (!wt_job(p, kind, layer, item, jb, kb, nb)) return;
    const int k0 = kb * 64, n0 = nb * 32;
    { float tmp[32]; const int n = n0 + (lane & 31); const float* sp = jb.src + (size_t)(k0 + (lane >> 5)) * jb.ldsrc + n;
      if (n < jb.N) {
#pragma unroll
          for (int i = 0; i < 32; ++i) tmp[i] = sp[(size_t)(2 * i) * jb.ldsrc];
      } else {
#pragma unroll
          for (int i = 0; i < 32; ++i) tmp[i] = 0.f; }
#pragma unroll
      for (int i = 0; i < 32; ++i) scr[(2 * i + (lane >> 5)) * 33 + (lane & 31)] = tmp[i]; }
    asm volatile("s_waitcnt lgkmcnt(0)" ::: "memory");
    const int c = lane & 7;
#pragma unroll
    for (int j = 0; j < 4; ++j) { const int nl = (lane >> 3) + 8 * j, n = n0 + nl; const LAS float* s = scr + (8 * c) * 33 + nl;
        if (n < jb.npad) { uint4 o; o.x = pk_bf16(s[0 * 33], s[1 * 33]); o.y = pk_bf16(s[2 * 33], s[3 * 33]); o.z = pk_bf16(s[4 * 33], s[5 * 33]); o.w = pk_bf16(s[6 * 33], s[7 * 33]);
            *(uint4*)(jb.dst + wt_dst_row(jb, n) * jb.ldt + k0 + 8 * c) = o; } }
    asm volatile("s_waitcnt lgkmcnt(0)" ::: "memory");
}
#endif

enum { EPI_BF16 = 0, EPI_SWIGLU = 1, EPI_SCALE = 2, EPI_PROJ = 3, EPI_UQ = 4, EPI_UKV = 5 };
enum GStage { G_PROJ = 0, G_UQ, G_UKV, G_WOUT, G_SGU, G_SDOWN, G_EGU, G_EDOWN };
struct GemmDesc {
    const st_t* A; int lda; const int* rowidx; int a_row0, nrows;
    const st_t* Bt; int ldb, K, n0;
    int epi; st_t* out; int ldc; long long out_row0; const float* rowscale;
    const float* tab; st_t* vt;
    int perm;
};
HD int cdiv(int a, int b) { return (a + b - 1) / b; }
struct ETab { const int* eb; const int* tb; };
HD int gemm_ntiles(const Params& p, int gs, int layer, ETab et = ETab{nullptr, nullptr}) {
    const int mt = rows_out(layer) / 128;
    switch (gs) {
    case G_PROJ: return (TA / 128) * (DPROJP / 128);
    case G_UQ: return (TA / 128) * (MH * MQD / 128);
    case G_UKV: return (TA / 128) * (MH * MKVD / 128);
    case G_WOUT: return mt * (D / 128);
    case G_SGU: return mt * (2 * DS / 128);
    case G_SDOWN: return mt * (D / 128);
    case G_EGU: case G_EDOWN: { int t = 0; if (et.tb) t = et.tb[NE]; else for (int e = 0; e < NE; ++e) t += cdiv(p.CNT()[layer * NE + e], 128); return t * (gs == G_EGU ? 2 * DE / 128 : D / 128); }
    }
    return 0;
}
HD void gemm_desc(const Params& p, int gs, int layer, int item, GemmDesc& g, ETab et = ETab{nullptr, nullptr}) {
    g.rowidx = nullptr; g.rowscale = nullptr; g.nrows = 128; g.epi = EPI_BF16; g.tab = nullptr; g.vt = nullptr; g.perm = (gs == G_WOUT || gs == G_SGU || gs == G_SDOWN || gs == G_EGU || gs == G_EDOWN) ? 1 : 0;
    auto plain = [&](const st_t* A, int lda, const st_t* Bt, int K, int ntn, st_t* out, int ldc) {
        const int mtn = (gs == G_PROJ || gs == G_UQ || gs == G_UKV ? TA : rows_out(layer)) / 128, PW = ntn < 8 ? ntn : 8, nfull = ntn / PW;
        int mt, nt; { const int pidx = item / (mtn * PW); if (pidx < nfull) { const int w = item - pidx * mtn * PW; mt = w / PW; nt = pidx * PW + w % PW; } else { const int pw = ntn - nfull * PW, w = item - nfull * mtn * PW; mt = w / pw; nt = nfull * PW + w % pw; } }
        g.A = A; g.lda = lda; g.a_row0 = mt * 128; g.Bt = Bt; g.ldb = K; g.K = K; g.n0 = nt * 128; g.out = out; g.ldc = ldc; g.out_row0 = mt * 128; };
    switch (gs) {
    case G_PROJ: plain(p.H(), D, p.Wt_in() + (size_t)layer * DPROJP * D, D, DPROJP / 128, p.P(), DPROJP); g.epi = EPI_PROJ; g.tab = g.n0 + 128 > PO_KR ? p.TABM() : p.TABA(); g.vt = p.VtA(); break;
    case G_UQ: plain(p.CQN(), MQR, p.Wt_uq() + (size_t)layer * MH * MQD * MQR, MQR, MH * MQD / 128, p.MQ(), MH * MQD); g.epi = EPI_UQ; g.tab = p.TABM(); break;
    case G_UKV: plain(p.CKVN(), MKVR, p.Wt_ukv() + (size_t)layer * MH * MKVD * MKVR, MKVR, MH * MKVD / 128, p.MKV(), MH * MKVD); g.epi = EPI_UKV; g.vt = p.VtM(); break;
    case G_WOUT: plain(p.O(), DMIX, p.Wt_out() + (size_t)layer * D * DMIX, DMIX, D / 128, p.Y(), D); break;
    case G_SGU: plain(p.H(), D, p.Wt_sgu() + (size_t)layer * 2 * DS * D, D, 2 * DS / 128, p.SACT(), DS); g.epi = EPI_SWIGLU; break;
    case G_SDOWN: plain(p.SACT(), DS, p.Wt_sd() + (size_t)layer * D * DS, DS, D / 128, p.SH(), D); break;
    case G_EGU: case G_EDOWN: {
        const int ntn = gs == G_EGU ? 2 * DE / 128 : D / 128; int mt = item / ntn; const int nt = item % ntn; const int* cnt = p.CNT() + layer * NE;
        int e = 0, base = 0;
        if (et.tb) { int lo = 0, hi = NE - 1; while (lo < hi) { const int mid = (lo + hi + 1) >> 1; if (et.tb[mid] <= mt) lo = mid; else hi = mid - 1; } e = lo; mt -= et.tb[e]; base = et.eb[e]; }
        else for (; e < NE; ++e) { const int te = cdiv(cnt[e], 128); if (mt < te) break; mt -= te; base += cnt[e]; }
        g.a_row0 = mt * 128; g.nrows = cnt[e] - mt * 128 < 128 ? cnt[e] - mt * 128 : 128; g.n0 = nt * 128; g.out_row0 = base + mt * 128;
        if (gs == G_EGU) { g.A = p.H(); g.lda = D; g.rowidx = p.TOKLIST() + (size_t)e * TA; g.Bt = p.Wt_egu() + (size_t)e * 2 * DE * D; g.ldb = D; g.K = D; g.epi = EPI_SWIGLU; g.out = p.ACT(); g.ldc = DE; }
        else { g.A = p.ACT() + (size_t)base * DE; g.lda = DE; g.Bt = p.Wt_ed() + (size_t)e * D * DE; g.ldb = DE; g.K = DE; g.epi = EPI_SCALE; g.out = p.YB(); g.ldc = D; g.rowscale = p.WLIST() + (size_t)e * TA - base; }
    } break;
    }
}
HD bool epi_needs_partner(const GemmDesc& g, int cb) { return g.epi == EPI_UQ || (g.epi == EPI_PROJ && g.n0 + cb + 64 > PO_KR); }
HD void rope8(float (&v)[4], const float (&pv)[4], int q, const float* tab, int pos) {
    for (int r = 0; r < 4; ++r) { const int c16 = q * 4 + r, i = c16 & 7; const float cs = tab[(pos * 8 + i) * 2], sn = tab[(pos * 8 + i) * 2 + 1];
        v[r] = c16 < 8 ? v[r] * cs - pv[r] * sn : pv[r] * sn + v[r] * cs; }
}
HD void gemm_epi(const GemmDesc& g, int rl, int cb, int q, float (&v)[4][4], const float (&pv)[4][4]) {
    if (rl >= g.nrows) return;
    const long long orow = g.out_row0 + rl;
    if (g.perm) {
        if (g.epi == EPI_SWIGLU) { float a[2][4]; for (int jj = 0; jj < 2; ++jj) for (int r = 0; r < 4; ++r) a[jj][r] = silu_f(v[2 * jj][r]) * v[2 * jj + 1][r];
            st8(g.out + (size_t)orow * g.ldc + (g.n0 + cb + 16 * q) / 2, a[0], a[1]); return; }
        const float w = g.epi == EPI_SCALE ? g.rowscale[orow] : 1.0f;
        for (int j = 0; j < 4; ++j) for (int r = 0; r < 4; ++r) v[j][r] *= w;
        st_t* o = g.out + (size_t)orow * g.ldc + g.n0 + cb + 16 * q; st8(o, v[0], v[1]); st8(o + 8, v[2], v[3]); return;
    }
    if (g.epi == EPI_SWIGLU) {
        for (int jj = 0; jj < 2; ++jj) { float a[4]; for (int r = 0; r < 4; ++r) a[r] = silu_f(v[2 * jj][r]) * v[2 * jj + 1][r];
            st4(g.out + (size_t)orow * g.ldc + (g.n0 + cb) / 2 + jj * 16 + q * 4, a[0], a[1], a[2], a[3]); }
        return;
    }
    if (g.epi >= EPI_PROJ) {
        const int row = (int)orow; const bool lat = row < T; const int bb = lat ? row / S : (row - T) / L, kidx = lat ? row % S : S + (row - T) % L;
        const int rp = lat ? (row % S) / GRID_W : 0, cp = lat ? (row % S) % GRID_W : 0, span = (g.n0 + cb) / 64;
        if (g.epi == EPI_PROJ) {
            if (span < 8) { if (lat) for (int hp = 0; hp < 2; ++hp) for (int r = 0; r < 4; ++r) { const int i = q * 4 + r, pos = hp ? cp : rp; const float cs = g.tab[(pos * 16 + i) * 2], sn = g.tab[(pos * 16 + i) * 2 + 1];
                    const float x1 = v[2 * hp][r], x2 = v[2 * hp + 1][r]; v[2 * hp][r] = x1 * cs - x2 * sn; v[2 * hp + 1][r] = x1 * sn + x2 * cs; } }
            else if (span < 10) { for (int j = 0; j < 4; ++j) for (int r = 0; r < 4; ++r) stf(g.vt + ((size_t)(bb * SWA_KVH + span - 8) * 64 + j * 16 + q * 4 + r) * NK + kidx, v[j][r]); return; }
            else if (g.n0 + cb + 64 > PO_KR && lat) { rope8(v[2], pv[2], q, g.tab, rp); rope8(v[3], pv[3], q, g.tab, cp); }
        } else if (g.epi == EPI_UQ) {
            if (lat) for (int j = 0; j < 4; ++j) { const int k6 = ((g.n0 + cb) / 16 + j) % 6; if (k6 >= 4) rope8(v[j], pv[j], q, g.tab, k6 == 4 ? rp : cp); }
        } else {
            if (span & 1) { for (int j = 0; j < 4; ++j) for (int r = 0; r < 4; ++r) stf(g.vt + ((size_t)(bb * MH + span / 2) * 64 + j * 16 + q * 4 + r) * NK + kidx, v[j][r]); return; }
        }
    }
    const float w = g.epi == EPI_SCALE ? g.rowscale[orow] : 1.0f;
    for (int j = 0; j < 4; ++j) st4(g.out + (size_t)orow * g.ldc + g.n0 + cb + j * 16 + q * 4, v[j][0] * w, v[j][1] * w, v[j][2] * w, v[j][3] * w);
}
#ifdef HOST_EMU
inline void gemm_tile_host(const GemmDesc& g) {
    for (int rl = 0; rl < g.nrows; ++rl) {
        const long long ar = g.rowidx ? g.rowidx[g.a_row0 + rl] : g.a_row0 + rl; const st_t* a = g.A + (size_t)ar * g.lda;
        for (int cb = 0; cb < 128; cb += 64) for (int q = 0; q < 4; ++q) { float v[4][4], pv[4][4];
            for (int j = 0; j < 4; ++j) for (int r = 0; r < 4; ++r) { const st_t* b = g.Bt + (size_t)(g.n0 + cb + (g.perm ? q * 16 + j * 4 + r : j * 16 + q * 4 + r)) * g.ldb; float acc = 0.f; for (int k = 0; k < g.K; ++k) acc += a[k] * b[k]; v[j][r] = acc;
                const st_t* b2 = g.Bt + (size_t)(g.n0 + cb + j * 16 + (q ^ 2) * 4 + r) * g.ldb; float acc2 = 0.f; for (int k = 0; k < g.K; ++k) acc2 += a[k] * b2[k]; pv[j][r] = acc2; }
            gemm_epi(g, rl, cb, q, v, pv); }
    }
}
#else
__device__ __forceinline__ void gemm_tile_dev(const GemmDesc& g, LAS unsigned char* lds, const int tid) {
    const int lane = tid & 63, wave = __builtin_amdgcn_readfirstlane(tid >> 6), wr = wave >> 1, wc = wave & 1;
    const int lrow = lane >> 3, slot = lane & 7;
    const st_t* asrc[4]; const st_t* bsrc[4];
#pragma unroll
    for (int i = 0; i < 4; ++i) {
        const int row = i * 32 + wave * 8 + lrow, chunk = slot ^ ((row >> 1) & 7);
        int rl = row < g.nrows ? row : g.nrows - 1;
        const long long ar = g.rowidx ? (long long)g.rowidx[g.a_row0 + rl] : (long long)(g.a_row0 + rl);
        asrc[i] = g.A + (size_t)ar * g.lda + chunk * 8;
        const int brow = g.perm ? (row & 64) + ((row >> 2) & 3) * 16 + ((row >> 4) & 3) * 4 + (row & 3) : row;
        bsrc[i] = g.Bt + (size_t)(g.n0 + brow) * g.ldb + chunk * 8;
    }
    const int nt = g.K / 64;
    auto stage = [&](int buf, int t) {
#pragma unroll
        for (int i = 0; i < 4; ++i) {
            __builtin_amdgcn_global_load_lds((const unsigned*)(asrc[i] + t * 64), (LAS unsigned*)(lds + buf * 32768 + (i * 32 + wave * 8) * 128), 16, 0, 0);
            __builtin_amdgcn_global_load_lds((const unsigned*)(bsrc[i] + t * 64), (LAS unsigned*)(lds + buf * 32768 + 16384 + (i * 32 + wave * 8) * 128), 16, 0, 0);
        }
    };
    f32x4 acc[4][4];
#pragma unroll
    for (int i = 0; i < 4; ++i)
#pragma unroll
        for (int j = 0; j < 4; ++j) acc[i][j] = (f32x4){0.f, 0.f, 0.f, 0.f};
    const int fr = lane & 15, fq = lane >> 4;
    __syncthreads();
    stage(0, 0);
    __syncthreads();
    for (int t = 0; t < nt; ++t) {
        const int cur = t & 1;
        if (t + 1 < nt) stage(cur ^ 1, t + 1);
        const LAS unsigned char* As = lds + cur * 32768; const LAS unsigned char* Bs = As + 16384;
#pragma unroll
        for (int kk = 0; kk < 2; ++kk) {
            bf16x8 af[4], bfr[4];
#pragma unroll
            for (int i = 0; i < 4; ++i) { const int row = wr * 64 + i * 16 + fr; af[i] = *(const LAS bf16x8*)(As + row * 128 + (((kk * 4 + fq) ^ ((row >> 1) & 7)) << 4)); }
#pragma unroll
            for (int j = 0; j < 4; ++j) { const int row = wc * 64 + j * 16 + fr; bfr[j] = *(const LAS bf16x8*)(Bs + row * 128 + (((kk * 4 + fq) ^ ((row >> 1) & 7)) << 4)); }
#pragma unroll
            for (int i = 0; i < 4; ++i)
#pragma unroll
                for (int j = 0; j < 4; ++j) acc[i][j] = __builtin_amdgcn_mfma_f32_16x16x32_bf16(bfr[j], af[i], acc[i][j], 0, 0, 0);
        }
        __syncthreads();
    }
    const bool need_pv = epi_needs_partner(g, wc * 64);
#pragma unroll
    for (int i = 0; i < 4; ++i) { float v[4][4], pv[4][4];
#pragma unroll
        for (int j = 0; j < 4; ++j)
#pragma unroll
            for (int r = 0; r < 4; ++r) { v[j][r] = acc[i][j][r]; pv[j][r] = 0.f; }
        if (need_pv) {
#pragma unroll
            for (int j = 0; j < 4; ++j)
#pragma unroll
                for (int r = 0; r < 4; ++r) pv[j][r] = __shfl_xor(v[j][r], 32); }
        gemm_epi(g, wr * 64 + i * 16 + fr, wc * 64, fq, v, pv); }
}
#endif


struct AttnDesc {
    int dqk;
    const st_t* Q; int ldq, q_row0;
    const st_t* K1; int ldk1; const st_t* K2; int ldk2;
    int lat_row0, ctx_row0;
    const st_t* Vt;
    int kt_lo, kt_hi, nctx, ctx_t0;
    int mask, qpos0;
    float m_init, l_init, c;
    st_t* O; int o_col;
    int part; st_t* opart; float* mlpart;
};
HD int attn_nitems(int layer) { const int lat = B * MH * (S / 128) * NSPLIT + B * SWA_H * (S / 128); return layer == DEPTH - 1 ? lat : lat + B * MH * (L / 128) + B * SWA_H * (L / 128); }
HD int attn_queue_size(int layer, int x) {
    const int NQ = S / 128, NQC = L / 128, half = x / 4; int n = NCHAIN / 8 + NQ * NSPLIT + SWA_G * (NQ * (half + 1) / 2 - NQ * half / 2);
    if (layer < DEPTH - 1) n += NQC + SWA_G * (NQC * (half + 1) / 2 - NQC * half / 2);
    return n;
}
HD int attn_queue_item(int layer, int x, int k) {
    const int NQ = S / 128, NQC = L / 128, half = x / 4, n_mla = B * MH * NQ * NSPLIT, n_swa = B * SWA_H * NQ, n_mlac = B * MH * NQC;
    if (k < NCHAIN / 8) return x * (NCHAIN / 8) + k; k -= NCHAIN / 8;
    if (k < NQ * NSPLIT) return NCHAIN + x * NQ * NSPLIT + k; k -= NQ * NSPLIT;
    const int gb = (x % 4) / SWA_KVH, gk = (x % 4) % SWA_KVH;
    { const int qlo = NQ * half / 2, nq = NQ * (half + 1) / 2 - qlo; if (k < SWA_G * nq) { const int h = gk * SWA_G + k / nq; return NCHAIN + n_mla + (gb * SWA_H + h) * NQ + qlo + k % nq; } k -= SWA_G * nq; }
    if (k < NQC) return NCHAIN + n_mla + n_swa + x * NQC + k; k -= NQC;
    { const int qlo = NQC * half / 2, nq = NQC * (half + 1) / 2 - qlo; const int h = gk * SWA_G + k / (nq > 0 ? nq : 1); return NCHAIN + n_mla + n_swa + n_mlac + (gb * SWA_H + h) * NQC + qlo + k % (nq > 0 ? nq : 1); }
}
static_assert(NCHAIN % 8 == 0 && B * MH == 8 && B * SWA_KVH == 4, "queue layout");
HD void attn_desc(const Params& p, int layer, int item, AttnDesc& a) {
    const float LOG2E = 1.4426950408889634f;
    const int n_mla = B * MH * (S / 128) * NSPLIT, n_swa = B * SWA_H * (S / 128), n_mlac = B * MH * (L / 128);
    bool mla, ctxq; int b, h, qb, part = -1;
    if (item < n_mla) { mla = true; ctxq = false; qb = item % (S / 128); item /= S / 128; part = item % NSPLIT; item /= NSPLIT; h = item % MH; b = item / MH; }
    else if (item < n_mla + n_swa) { item -= n_mla; mla = false; ctxq = false; qb = item % (S / 128); h = (item / (S / 128)) % SWA_H; b = item / (S / 128) / SWA_H; }
    else if (item < n_mla + n_swa + n_mlac) { item -= n_mla + n_swa; mla = true; ctxq = true; qb = item % (L / 128); h = (item / (L / 128)) % MH; b = item / (L / 128) / MH; }
    else { item -= n_mla + n_swa + n_mlac; mla = false; ctxq = true; qb = item % (L / 128); h = (item / (L / 128)) % SWA_H; b = item / (L / 128) / SWA_H; }
    a.q_row0 = ctxq ? T + b * L + qb * 128 : b * S + qb * 128; a.lat_row0 = b * S; a.ctx_row0 = T + b * L; a.nctx = L / 64; a.qpos0 = qb * 128; a.O = p.O(); a.ctx_t0 = 0; a.part = -1; a.opart = nullptr; a.mlpart = nullptr;
    if (mla) {
        a.dqk = 96; a.Q = p.MQ() + h * MQD; a.ldq = MH * MQD; a.K1 = p.MKV() + h * MKVD; a.ldk1 = MH * MKVD; a.K2 = p.P() + PO_KR; a.ldk2 = DPROJP;
        a.Vt = p.VtM() + (size_t)(b * MH + h) * 64 * NK; a.kt_lo = 0; a.kt_hi = ctxq ? 0 : S / 64; a.mask = 0; a.m_init = -1e30f; a.l_init = 0.f; a.c = LOG2E / sqrtf((float)MQD); a.o_col = 768 + h * 64;
        if (part >= 0 && NSPLIT > 1) {
            const int CT = (NK / 64) / NSPLIT, t0 = part * CT, t1 = t0 + CT, nl = S / 64;
            a.kt_lo = t0 < nl ? t0 : nl; a.kt_hi = t1 < nl ? t1 : nl; a.nctx = t1 > nl ? t1 - (t0 > nl ? t0 : nl) : 0; a.ctx_t0 = t0 > nl ? t0 - nl : 0;
            a.part = part; a.opart = p.OPART() + (size_t)part * T * MH * MV + h * MV; a.mlpart = p.MLPART() + ((size_t)part * T * MH + h) * 2; }
    } else {
        const int kvh = h / SWA_G;
        a.dqk = 64; a.Q = p.P() + PO_QA + h * 64; a.ldq = DPROJP; a.K1 = p.P() + PO_KA + kvh * 64; a.ldk1 = DPROJP; a.K2 = nullptr; a.ldk2 = 0;
        a.Vt = p.VtA() + (size_t)(b * SWA_KVH + kvh) * 64 * NK; a.mask = ctxq ? 0 : 1;
        if (ctxq) { a.kt_lo = 0; a.kt_hi = 0; } else { a.kt_lo = (a.qpos0 - SWA_W) / 64; if (a.kt_lo < 0) a.kt_lo = 0; a.kt_hi = (a.qpos0 + 128 + SWA_W) / 64; if (a.kt_hi > S / 64) a.kt_hi = S / 64; }
        a.m_init = p.swa_sink[layer * SWA_H + h] * LOG2E; a.l_init = 1.f; a.c = LOG2E * 0.125f; a.o_col = h * 64;
    }
}
#ifdef HOST_EMU
inline void attn_tile_host(const AttnDesc& a) {
    const int nl = a.kt_hi - a.kt_lo, ntile = nl + a.nctx;
    for (int q = 0; q < 128; ++q) {
        const st_t* qr = a.Q + (size_t)(a.q_row0 + q) * a.ldq; float m = a.m_init, l = a.l_init, acc[64]; for (int d = 0; d < 64; ++d) acc[d] = 0.f;
        for (int t = 0; t < ntile; ++t) for (int kk = 0; kk < 64; ++kk) {
            const int kidx = t < nl ? (a.kt_lo + t) * 64 + kk : S + (a.ctx_t0 + t - nl) * 64 + kk; const int row = kidx < S ? a.lat_row0 + kidx : a.ctx_row0 + kidx - S;
            if (a.mask && t < nl) { const int dq = a.qpos0 + q - kidx; if (dq > SWA_W || dq < -SWA_W) continue; }
            float sc = 0.f; for (int d = 0; d < 64; ++d) sc += qr[d] * a.K1[(size_t)row * a.ldk1 + d];
            if (a.dqk > 64) for (int d = 64; d < a.dqk; ++d) sc += qr[d] * a.K2[(size_t)row * a.ldk2 + d - 64];
            sc *= a.c; if (sc > m) { const float f = exp2f(m - sc); l *= f; for (int d = 0; d < 64; ++d) acc[d] *= f; m = sc; }
            const float pe = exp2f(sc - m); l += pe; for (int d = 0; d < 64; ++d) acc[d] += pe * a.Vt[(size_t)d * NK + kidx];
        }
        if (a.part >= 0) { for (int d = 0; d < 64; ++d) a.opart[(size_t)(a.q_row0 + q) * MH * MV + d] = acc[d] / l; a.mlpart[(size_t)(a.q_row0 + q) * MH * 2] = m; a.mlpart[(size_t)(a.q_row0 + q) * MH * 2 + 1] = l; }
        else for (int d = 0; d < 64; ++d) a.O[(size_t)(a.q_row0 + q) * DMIX + a.o_col + d] = acc[d] / l;
    }
}
#else
typedef float f32x16 __attribute__((ext_vector_type(16)));
typedef unsigned u32x4 __attribute__((ext_vector_type(4)));
typedef unsigned u32x2 __attribute__((ext_vector_type(2)));
__device__ __forceinline__ int crow16(int reg, int h) { return (reg & 3) + 8 * (reg >> 2) + 4 * h; }
template <int DQK>
__device__ __forceinline__ void attn_tile_dev(const AttnDesc& a, LAS unsigned char* lds, const int tid) {
    constexpr int KSTR = DQK * 2 + 16, VSTR = 136, KBYTES = 64 * KSTR, BUF = KBYTES + 64 * VSTR, CPR = DQK / 8, KCH = 64 * CPR / 256, NKS = DQK / 16;
    const int lane = tid & 63, wave = __builtin_amdgcn_readfirstlane(tid >> 6), l31 = lane & 31, hh = lane >> 5;
    bf16x8 qf[NKS];
    { const st_t* qrow = a.Q + (size_t)(a.q_row0 + wave * 32 + l31) * a.ldq;
#pragma unroll
      for (int ks = 0; ks < NKS; ++ks) qf[ks] = *(const bf16x8*)(qrow + 16 * ks + 8 * hh); }
    f32x16 ot[2];
#pragma unroll
    for (int r = 0; r < 16; ++r) { ot[0][r] = 0.f; ot[1][r] = 0.f; }
    float m = a.m_init, lsum = hh == 0 ? a.l_init : 0.f;
    const int nl = a.kt_hi - a.kt_lo, ntile = nl + a.nctx; const float c = a.c;
    u32x4 kreg[2][KCH], vreg[2][2];
    auto gload = [&](auto PC, int t) { constexpr int P = decltype(PC)::value;
        const int kidx0 = t < nl ? (a.kt_lo + t) * 64 : S + (a.ctx_t0 + t - nl) * 64; const int rowbase = t < nl ? a.lat_row0 + kidx0 : a.ctx_row0 + kidx0 - S;
#pragma unroll
        for (int u = 0; u < KCH; ++u) { const int ci = tid + 256 * u, row = ci / CPR, cc = ci % CPR;
            const st_t* src = (DQK == 64 || cc < 8) ? a.K1 + (size_t)(rowbase + row) * a.ldk1 + cc * 8 : a.K2 + (size_t)(rowbase + row) * a.ldk2 + (cc - 8) * 8;
            kreg[P][u] = *(const u32x4*)src; }
#pragma unroll
        for (int u = 0; u < 2; ++u) { const int ci = tid + 256 * u, dv = ci >> 3, cc = ci & 7; vreg[P][u] = *(const u32x4*)(a.Vt + (size_t)dv * NK + kidx0 + cc * 8); }
    };
    auto lstore = [&](auto PC) { constexpr int P = decltype(PC)::value;
#pragma unroll
        for (int u = 0; u < KCH; ++u) { const int ci = tid + 256 * u, row = ci / CPR, cc = ci % CPR; *(LAS u32x4*)(lds + P * BUF + row * KSTR + cc * 16) = kreg[P][u]; }
#pragma unroll
        for (int u = 0; u < 2; ++u) { const int ci = tid + 256 * u, dv = ci >> 3, cc = ci & 7; LAS u32x2* d = (LAS u32x2*)(lds + P * BUF + KBYTES + dv * VSTR + cc * 16);
            d[0] = (u32x2){vreg[P][u].x, vreg[P][u].y}; d[1] = (u32x2){vreg[P][u].z, vreg[P][u].w}; }
    };
    using I0 = std::integral_constant<int, 0>; using I1 = std::integral_constant<int, 1>;
    __syncthreads();
    gload(I0{}, 0); lstore(I0{});
    if (ntile > 1) gload(I1{}, 1);
    __syncthreads();
    auto body = [&](auto PC, const int t) { constexpr int cur = decltype(PC)::value; using PN = std::integral_constant<int, 1 - cur>;
        if (t + 2 < ntile) gload(PC, t + 2);
        const LAS unsigned char* Ks = lds + cur * BUF; const LAS unsigned char* Vs = Ks + KBYTES;
        f32x16 st[2];
        {
            bf16x8 kf[2][NKS];
#pragma unroll
            for (int ks = 0; ks < NKS; ++ks)
#pragma unroll
                for (int kb = 0; kb < 2; ++kb) kf[kb][ks] = *(const LAS bf16x8*)(Ks + (kb * 32 + l31) * KSTR + (16 * ks + 8 * hh) * 2);
            __builtin_amdgcn_sched_barrier(0);
#pragma unroll
            for (int r = 0; r < 16; ++r) { st[0][r] = 0.f; st[1][r] = 0.f; }
#pragma unroll
            for (int ks = 0; ks < NKS; ++ks)
#pragma unroll
                for (int kb = 0; kb < 2; ++kb) st[kb] = __builtin_amdgcn_mfma_f32_32x32x16_bf16(kf[kb][ks], qf[ks], st[kb], 0, 0, 0);
        }
        u32x2 vlo[2][2][2], vhi[2][2][2];
#pragma unroll
        for (int kb = 0; kb < 2; ++kb)
#pragma unroll
            for (int s2 = 0; s2 < 2; ++s2)
#pragma unroll
                for (int db = 0; db < 2; ++db) { const LAS unsigned char* vp = Vs + (db * 32 + l31) * VSTR + (kb * 32 + 16 * s2 + 4 * hh) * 2;
                    vlo[kb][s2][db] = *(const LAS u32x2*)vp; vhi[kb][s2][db] = *(const LAS u32x2*)(vp + 16); }
        __builtin_amdgcn_sched_barrier(0);
        if (a.mask && t < nl) {
            const int d0 = a.qpos0 + wave * 32 + l31 - (a.kt_lo + t) * 64;
#pragma unroll
            for (int kb = 0; kb < 2; ++kb)
#pragma unroll
                for (int r = 0; r < 16; ++r) { const int dq = d0 - (kb * 32 + crow16(r, hh)); if (dq > SWA_W || dq < -SWA_W) st[kb][r] = -1e30f; }
        }
        float mx = st[0][0];
#pragma unroll
        for (int r = 1; r < 16; ++r) mx = fmaxf(mx, st[0][r]);
#pragma unroll
        for (int r = 0; r < 16; ++r) mx = fmaxf(mx, st[1][r]);
        mx = fmaxf(mx, __shfl_xor(mx, 32));
        const float m_new = fmaxf(m, mx * c), alpha = __builtin_amdgcn_exp2f(m - m_new);
        float rs = 0.f;
#pragma unroll
        for (int kb = 0; kb < 2; ++kb)
#pragma unroll
            for (int r = 0; r < 16; ++r) { const float pe = __builtin_amdgcn_exp2f(__builtin_fmaf(st[kb][r], c, -m_new)); st[kb][r] = pe; rs += pe; }
        lsum = lsum * alpha + rs; m = m_new;
#pragma unroll
        for (int r = 0; r < 16; ++r) { ot[0][r] *= alpha; ot[1][r] *= alpha; }
#pragma unroll
        for (int kb = 0; kb < 2; ++kb)
#pragma unroll
            for (int s2 = 0; s2 < 2; ++s2) {
                u32x4 pw; pw.x = pk_bf16(st[kb][8 * s2 + 0], st[kb][8 * s2 + 1]); pw.y = pk_bf16(st[kb][8 * s2 + 2], st[kb][8 * s2 + 3]);
                pw.z = pk_bf16(st[kb][8 * s2 + 4], st[kb][8 * s2 + 5]); pw.w = pk_bf16(st[kb][8 * s2 + 6], st[kb][8 * s2 + 7]);
                const bf16x8 pb = __builtin_bit_cast(bf16x8, pw);
#pragma unroll
                for (int db = 0; db < 2; ++db) { const u32x2 lo = vlo[kb][s2][db], hi = vhi[kb][s2][db]; u32x4 vw; vw.x = lo.x; vw.y = lo.y; vw.z = hi.x; vw.w = hi.y;
                    ot[db] = __builtin_amdgcn_mfma_f32_32x32x16_bf16(__builtin_bit_cast(bf16x8, vw), pb, ot[db], 0, 0, 0); }
            }
        if (t + 1 < ntile) lstore(PN{});
        __syncthreads();
    };
    for (int t = 0; t < ntile; t += 2) { body(I0{}, t); if (t + 1 < ntile) body(I1{}, t + 1); }
    const float ltot = lsum + __shfl_xor(lsum, 32), inv = 1.0f / ltot;
    st_t* orow = a.O + (size_t)(a.q_row0 + wave * 32 + l31) * DMIX + a.o_col;
    if (a.part >= 0) { orow = a.opart + (size_t)(a.q_row0 + wave * 32 + l31) * MH * MV;
        if (hh == 0) { float* ml = a.mlpart + (size_t)(a.q_row0 + wave * 32 + l31) * MH * 2; ml[0] = m; ml[1] = ltot; } }
#pragma unroll
    for (int db = 0; db < 2; ++db)
#pragma unroll
        for (int g = 0; g < 4; ++g) st4(orow + db * 32 + 8 * g + 4 * hh, ot[db][4 * g] * inv, ot[db][4 * g + 1] * inv, ot[db][4 * g + 2] * inv, ot[db][4 * g + 3] * inv);
}
#endif


HD int gdn_row(int b, int dir, int n, int i) {
    if (n < L / 64) { const int pos = n * 64 + i; return T + b * L + (dir == 0 ? pos : L - 1 - pos); }
    const int pos = (n - L / 64) * 64 + i; return b * S + (dir == 0 ? pos : S - 1 - pos);
}
#ifdef HOST_EMU
inline void gdn_pre_host(const Params& p, int item) {
    const int c = item / NCH, n = item % NCH, dir = c & 1, h = (c >> 1) % GH, b = (c >> 1) / GH;
    float gc[64], beta[64]; const st_t* kk[64]; const st_t* qq[64]; const st_t* vv[64]; float acc = 0.f;
    for (int i = 0; i < 64; ++i) { const int r = gdn_row(b, dir, n, i); acc += p.BG()[(size_t)r * 24 + 12 + dir * 6 + h]; gc[i] = acc; beta[i] = p.BG()[(size_t)r * 24 + dir * 6 + h];
        qq[i] = p.G() + (size_t)r * GQKV + h * 64; kk[i] = qq[i] + 384; vv[i] = qq[i] + 768; }
    static thread_local float A[64][64], XU[64][64], XW[64][64];
    for (int i = 0; i < 64; ++i) for (int j = 0; j < 64; ++j) { float d = 0.f; for (int e = 0; e < 64; ++e) d += kk[i][e] * kk[j][e]; A[i][j] = j < i ? beta[i] * d * expf(gc[i] - gc[j]) : 0.f; }
    for (int i = 0; i < 64; ++i) for (int e = 0; e < 64; ++e) { float u = beta[i] * vv[i][e], w = beta[i] * expf(gc[i]) * kk[i][e];
        for (int j = 0; j < i; ++j) { u -= A[i][j] * XU[j][e]; w -= A[i][j] * XW[j][e]; } XU[i][e] = u; XW[i][e] = w; }
    st_t* ch = p.CH() + (size_t)item * 5 * 4096;
    for (int i = 0; i < 64; ++i) for (int e = 0; e < 64; ++e) {
        ch[0 * 4096 + e * 64 + i] = XU[i][e]; ch[1 * 4096 + i * 64 + e] = XW[i][e]; ch[2 * 4096 + i * 64 + e] = qq[i][e] * 0.125f * expf(gc[i]);
        float d = 0.f; for (int x = 0; x < 64; ++x) d += qq[i][x] * kk[e][x]; ch[3 * 4096 + i * 64 + e] = e <= i ? d * 0.125f * expf(gc[i] - gc[e]) : 0.f;
        ch[4 * 4096 + e * 64 + i] = kk[i][e] * expf(gc[63] - gc[i]); }
    p.GAM()[item] = expf(gc[63]);
}
inline void gdn_scan_host(const Params& p, int c) {
    const int dir = c & 1, h = (c >> 1) % GH, b = (c >> 1) / GH; st_t* dst = dir == 0 ? p.OF() : p.OB();
    static thread_local float Sm[64][64], Vn[64][64]; for (int d = 0; d < 64; ++d) for (int e = 0; e < 64; ++e) Sm[d][e] = 0.f;
    for (int n = 0; n < NCH; ++n) { const st_t* ch = p.CH() + (size_t)(c * NCH + n) * 5 * 4096; const float gam = p.GAM()[c * NCH + n];
        for (int i = 0; i < 64; ++i) for (int e = 0; e < 64; ++e) { float v = ch[0 * 4096 + e * 64 + i]; for (int d = 0; d < 64; ++d) v -= ch[1 * 4096 + i * 64 + d] * Sm[d][e]; Vn[i][e] = v; }
        for (int i = 0; i < 64; ++i) for (int e = 0; e < 64; ++e) { float o = 0.f; for (int d = 0; d < 64; ++d) o += ch[2 * 4096 + i * 64 + d] * Sm[d][e]; for (int j = 0; j < 64; ++j) o += ch[3 * 4096 + i * 64 + j] * Vn[j][e];
            dst[(size_t)gdn_row(b, dir, n, i) * (GH * GDV) + h * 64 + e] = o; }
        for (int d = 0; d < 64; ++d) for (int e = 0; e < 64; ++e) { float sn = gam * Sm[d][e]; for (int i = 0; i < 64; ++i) sn += ch[4 * 4096 + d * 64 + i] * Vn[i][e]; Sm[d][e] = sn; }
    }
}
#else
template <int... Is, class F> __device__ __forceinline__ void static_for_impl(std::integer_sequence<int, Is...>, F&& f) { (f(std::integral_constant<int, Is>{}), ...); }
template <int N, class F> __device__ __forceinline__ void static_for(F&& f) { static_for_impl(std::make_integer_sequence<int, N>{}, f); }
__device__ __forceinline__ float bf_lo(unsigned u) { return __builtin_bit_cast(float, u << 16); }
__device__ __forceinline__ float bf_hi(unsigned u) { return __builtin_bit_cast(float, u & 0xffff0000u); }
template <int ROLE>
__device__ __forceinline__ void gdn_pre_role(const Params& p, int pair, LAS unsigned char* lds, const int lane, const int wave) {
    constexpr int AST = 68;
    const int l31 = lane & 31, hh = lane >> 5;
    const int item = pair * 2 + (wave >> 1);
    const int c = item / NCH, n = item % NCH, dir = c & 1, h = (c >> 1) % GH, b = (c >> 1) / GH;
    LAS float* At = (LAS float*)(lds + (wave >> 1) * 18432); LAS float* gcs = At + 64 * AST; LAS float* bts = gcs + 64; LAS float* ebt = bts + 64;
    st_t* ch = p.CH() + (size_t)item * 5 * 4096;
    const int row0 = gdn_row(b, dir, n, 0); const int sgn = dir == 0 ? 1 : -1;
    const int myrow = row0 + sgn * lane;
    float gc = p.BG()[(size_t)myrow * 24 + 12 + dir * 6 + h]; const float beta = p.BG()[(size_t)myrow * 24 + dir * 6 + h];
#pragma unroll
    for (int o = 1; o < 64; o <<= 1) { const float t = __shfl_up(gc, o); if (lane >= o) gc += t; }
    const float gc63 = __shfl(gc, 63);
    __syncthreads();
    if (ROLE == 0) { gcs[lane] = gc; bts[lane] = beta; ebt[lane] = beta * __expf(gc); }
    const st_t* gbase = p.G() + h * 64;
    f32x16 d00, d10, d11;
#pragma unroll
    for (int r = 0; r < 16; ++r) { d00[r] = 0.f; d10[r] = 0.f; d11[r] = 0.f; }
    { const size_t r0 = (size_t)(row0 + sgn * l31) * GQKV, r1 = (size_t)(row0 + sgn * (32 + l31)) * GQKV; constexpr int xo = ROLE == 0 ? 384 : 0;
#pragma unroll
      for (int ks = 0; ks < 4; ++ks) {
          const bf16x8 a0 = *(const bf16x8*)(gbase + r0 + xo + 16 * ks + 8 * hh), a1 = *(const bf16x8*)(gbase + r1 + xo + 16 * ks + 8 * hh);
          const bf16x8 b0 = *(const bf16x8*)(gbase + r0 + 384 + 16 * ks + 8 * hh), b1 = *(const bf16x8*)(gbase + r1 + 384 + 16 * ks + 8 * hh);
          d00 = __builtin_amdgcn_mfma_f32_32x32x16_bf16(a0, b0, d00, 0, 0, 0); d10 = __builtin_amdgcn_mfma_f32_32x32x16_bf16(a1, b0, d10, 0, 0, 0); d11 = __builtin_amdgcn_mfma_f32_32x32x16_bf16(a1, b1, d11, 0, 0, 0); } }
    __syncthreads();
    auto post = [&](const f32x16& d, int ib, int jb) __attribute__((always_inline)) {
        const int j = 32 * jb + l31; const float gcj = gcs[j];
#pragma unroll
        for (int g = 0; g < 4; ++g) { const int i0 = 32 * ib + 8 * g + 4 * hh; const f32x4 gci = *(const LAS f32x4*)(gcs + i0);
            if (ROLE == 0) { const f32x4 bi = *(const LAS f32x4*)(bts + i0); f32x4 o;
#pragma unroll
                for (int u = 0; u < 4; ++u) o[u] = (j < i0 + u) ? bi[u] * d[4 * g + u] * __expf(gci[u] - gcj) : 0.f;
                *(LAS f32x4*)(At + j * AST + i0) = o; }
            else {
#pragma unroll
                for (int u = 0; u < 4; ++u) { const float v = (j <= i0 + u) ? 0.125f * d[4 * g + u] * __expf(gci[u] - gcj) : 0.f; stf(ch + 3 * 4096 + (i0 + u) * 64 + j, v); } } }
    };
    post(d00, 0, 0); post(d10, 1, 0); post(d11, 1, 1);
    if (ROLE == 1) {
#pragma unroll
        for (int r = 0; r < 16; ++r) stf(ch + 3 * 4096 + crow16(r, hh) * 64 + 32 + l31, 0.f); }
    __syncthreads();
    float acc[64];
#pragma unroll
    for (int i = 0; i < 64; ++i) acc[i] = 0.f;
    { const long long stp = (long long)sgn * GQKV;
      const st_t* sp = gbase + (ROLE == 0 ? 768 : 384) + lane + (size_t)row0 * GQKV;
      const LAS float* sc = ROLE == 0 ? bts : ebt;
      float cur[8], pre[8];
#pragma unroll
      for (int u = 0; u < 8; ++u) { cur[u] = ldf(sp + u * stp); pre[u] = ldf(sp + (8 + u) * stp); }
      unsigned pk[4]; f32x4 s4 = (f32x4){0.f, 0.f, 0.f, 0.f}; float xprev = 0.f;
      static_for<64>([&](auto jc) __attribute__((always_inline)) {
          constexpr int j = decltype(jc)::value;
          if constexpr ((j & 7) == 0 && j > 0) {
#pragma unroll
              for (int u = 0; u < 8; ++u) cur[u] = pre[u];
              if constexpr (j + 8 < 64) { const st_t* gp = sp + (j + 8) * stp; asm volatile("" : "+v"(gp));
#pragma unroll
                  for (int u = 0; u < 8; ++u) pre[u] = ldf(gp + u * stp); }
          }
          if constexpr ((j & 3) == 0) s4 = *(const LAS f32x4*)(sc + j);
          const float x = s4[j & 3] * cur[j & 7] - acc[j];
          if constexpr (ROLE == 0) {
              if constexpr ((j & 1) == 1) pk[(j >> 1) & 3] = pk_bf16(xprev, x);
              if constexpr ((j & 7) == 7) { u32x4 w; w.x = pk[0]; w.y = pk[1]; w.z = pk[2]; w.w = pk[3]; *(u32x4*)(ch + 0 * 4096 + lane * 64 + (j - 7)) = w; }
          } else stf(ch + 1 * 4096 + j * 64 + lane, x);
          xprev = x;
          constexpr int I0 = ((j + 1) >> 2) << 2;
#pragma unroll
          for (int i4 = I0; i4 < 64; i4 += 4) { const f32x4 av = *(const LAS f32x4*)(At + j * AST + i4);
#pragma unroll
              for (int u = 0; u < 4; ++u) if (i4 + u > j) acc[i4 + u] += av[u] * x;
              asm volatile("" : "+v"(acc[i4]), "+v"(acc[i4 + 1]), "+v"(acc[i4 + 2]), "+v"(acc[i4 + 3])); }
          __builtin_amdgcn_sched_barrier(0);
      }); }
    { const st_t* src = gbase + (size_t)myrow * GQKV + (ROLE == 0 ? 384 : 0); const float sc = ROLE == 0 ? __expf(gc63 - gc) : 0.125f * __expf(gc);
#pragma unroll
      for (int c8 = 0; c8 < 8; ++c8) { const u32x4 w = *(const u32x4*)(src + 8 * c8);
          const float f0 = bf_lo(w.x) * sc, f1 = bf_hi(w.x) * sc, f2 = bf_lo(w.y) * sc, f3 = bf_hi(w.y) * sc, f4 = bf_lo(w.z) * sc, f5 = bf_hi(w.z) * sc, f6 = bf_lo(w.w) * sc, f7 = bf_hi(w.w) * sc;
          if (ROLE == 0) { st_t* kt = ch + 4 * 4096 + (8 * c8) * 64 + lane; stf(kt, f0); stf(kt + 64, f1); stf(kt + 128, f2); stf(kt + 192, f3); stf(kt + 256, f4); stf(kt + 320, f5); stf(kt + 384, f6); stf(kt + 448, f7); }
          else { u32x4 o; o.x = pk_bf16(f0, f1); o.y = pk_bf16(f2, f3); o.z = pk_bf16(f4, f5); o.w = pk_bf16(f6, f7); *(u32x4*)(ch + 2 * 4096 + lane * 64 + 8 * c8) = o; } } }
    if (ROLE == 0 && lane == 0) p.GAM()[item] = __expf(gc63);
}
static_assert((NCHAIN * NCH) % 2 == 0, "chunk items come in pairs");
__device__ __forceinline__ void gdn_pre_dev(const Params& p, int pair, LAS unsigned char* lds, const int tid) {
    const int lane = tid & 63, wave = __builtin_amdgcn_readfirstlane(tid >> 6);
    if ((wave & 1) == 0) gdn_pre_role<0>(p, pair, lds, lane, wave); else gdn_pre_role<1>(p, pair, lds, lane, wave);
}
__device__ __forceinline__ void gdn_scan_dev(const Params& p, int c, LAS unsigned char* lds, const int tid) {
    constexpr int RS = 136, MB = 64 * RS;
    const int lane = tid & 63, wave = __builtin_amdgcn_readfirstlane(tid >> 6), r16 = lane & 15, q = lane >> 4;
    const int dir = c & 1, h = (c >> 1) % GH, b = (c >> 1) / GH; st_t* dst = (dir == 0 ? p.OF() : p.OB()) + h * 64 + 16 * wave + r16;
    f32x4 Sb[4];
#pragma unroll
    for (int i = 0; i < 4; ++i) Sb[i] = (f32x4){0.f, 0.f, 0.f, 0.f};
    u32x4 stg[10]; float gam_next = 0.f;
    auto gload = [&](int n) { const u32x4* src = (const u32x4*)(p.CH() + (size_t)(c * NCH + n) * 5 * 4096);
#pragma unroll
        for (int u = 0; u < 10; ++u) stg[u] = src[tid + 256 * u];
        gam_next = p.GAM()[c * NCH + n]; };
    auto lstore = [&]() {
#pragma unroll
        for (int u = 0; u < 10; ++u) { const int ci = tid + 256 * u, mat = ci >> 9, row = (ci >> 3) & 63, cc = ci & 7; LAS u32x2* d = (LAS u32x2*)(lds + mat * MB + row * RS + cc * 16);
            d[0] = (u32x2){stg[u].x, stg[u].y}; d[1] = (u32x2){stg[u].z, stg[u].w}; } };
    auto afrag = [&](int mat, int row, int a2) -> bf16x8 { const LAS unsigned char* bp = lds + mat * MB + row * RS + (32 * a2 + 4 * q) * 2;
        const u32x2 lo = *(const LAS u32x2*)bp, hi = *(const LAS u32x2*)(bp + 32); u32x4 w; w.x = lo.x; w.y = lo.y; w.z = hi.x; w.w = hi.y; return __builtin_bit_cast(bf16x8, w); };
    auto pack2 = [&](const f32x4& x, const f32x4& y) -> bf16x8 { u32x4 w; w.x = pk_bf16(x[0], x[1]); w.y = pk_bf16(x[2], x[3]); w.z = pk_bf16(y[0], y[1]); w.w = pk_bf16(y[2], y[3]); return __builtin_bit_cast(bf16x8, w); };
    __syncthreads();
    gload(0); lstore(); float gam = gam_next;
    __syncthreads();
    const int sgn = dir == 0 ? 1 : -1;
    for (int n = 0; n < NCH; ++n) {
        if (n + 1 < NCH) gload(n + 1);
        const bf16x8 sb0 = pack2(Sb[0], Sb[1]), sb1 = pack2(Sb[2], Sb[3]);
        bf16x8 fw[8], fq[8]; u32x2 uu[4];
#pragma unroll
        for (int i = 0; i < 8; ++i) fw[i] = afrag(1, 16 * (i >> 1) + r16, i & 1);
#pragma unroll
        for (int tb = 0; tb < 4; ++tb) uu[tb] = *(const LAS u32x2*)(lds + 0 * MB + (16 * wave + r16) * RS + (16 * tb + 4 * q) * 2);
#pragma unroll
        for (int i = 0; i < 8; ++i) fq[i] = afrag(2, 16 * (i >> 1) + r16, i & 1);
        __builtin_amdgcn_sched_barrier(0);
        f32x4 vn[4], oc[4];
#pragma unroll
        for (int tb = 0; tb < 4; ++tb) {
            f32x4 acc = (f32x4){0.f, 0.f, 0.f, 0.f};
            acc = __builtin_amdgcn_mfma_f32_16x16x32_bf16(fw[2 * tb], sb0, acc, 0, 0, 0);
            acc = __builtin_amdgcn_mfma_f32_16x16x32_bf16(fw[2 * tb + 1], sb1, acc, 0, 0, 0);
            vn[tb][0] = bf_lo(uu[tb].x) - acc[0]; vn[tb][1] = bf_hi(uu[tb].x) - acc[1]; vn[tb][2] = bf_lo(uu[tb].y) - acc[2]; vn[tb][3] = bf_hi(uu[tb].y) - acc[3];
        }
        __builtin_amdgcn_sched_barrier(0);
        bf16x8 fm[8];
#pragma unroll
        for (int i = 0; i < 8; ++i) fm[i] = afrag(3, 16 * (i >> 1) + r16, i & 1);
        __builtin_amdgcn_sched_barrier(0);
#pragma unroll
        for (int tb = 0; tb < 4; ++tb) {
            f32x4 o = (f32x4){0.f, 0.f, 0.f, 0.f};
            o = __builtin_amdgcn_mfma_f32_16x16x32_bf16(fq[2 * tb], sb0, o, 0, 0, 0);
            o = __builtin_amdgcn_mfma_f32_16x16x32_bf16(fq[2 * tb + 1], sb1, o, 0, 0, 0);
            oc[tb] = o;
        }
        const bf16x8 vb0 = pack2(vn[0], vn[1]), vb1 = pack2(vn[2], vn[3]);
        __builtin_amdgcn_sched_barrier(0);
        bf16x8 fk[8];
#pragma unroll
        for (int i = 0; i < 8; ++i) fk[i] = afrag(4, 16 * (i >> 1) + r16, i & 1);
        __builtin_amdgcn_sched_barrier(0);
        const int row0 = gdn_row(b, dir, n, 0);
#pragma unroll
        for (int tb = 0; tb < 4; ++tb) {
            f32x4 o = oc[tb];
            o = __builtin_amdgcn_mfma_f32_16x16x32_bf16(fm[2 * tb], vb0, o, 0, 0, 0);
            o = __builtin_amdgcn_mfma_f32_16x16x32_bf16(fm[2 * tb + 1], vb1, o, 0, 0, 0);
            oc[tb] = o;
        }
#pragma unroll
        for (int db = 0; db < 4; ++db) {
            f32x4 sn = Sb[db] * gam;
            sn = __builtin_amdgcn_mfma_f32_16x16x32_bf16(fk[2 * db], vb0, sn, 0, 0, 0);
            sn = __builtin_amdgcn_mfma_f32_16x16x32_bf16(fk[2 * db + 1], vb1, sn, 0, 0, 0);
            Sb[db] = sn;
        }
#pragma unroll
        for (int tb = 0; tb < 4; ++tb) {
#pragma unroll
            for (int u = 0; u < 4; ++u) stf(dst + (size_t)(row0 + sgn * (16 * tb + 4 * q + u)) * (GH * GDV), oc[tb][u]);
        }
        __syncthreads();
        if (n + 1 < NCH) { lstore(); gam = gam_next; }
        __syncthreads();
    }
}
#endif


#ifndef HOST_EMU
enum { R_NORM1 = 0, R_POST1 = 1, R_POST2 = 2, R_XFORM = 3, R_GOUT = 4, R_ROUTE2 = 5 };
template <int CTRL> __device__ __forceinline__ float dpp_f(float v) { return __builtin_bit_cast(float, __builtin_amdgcn_update_dpp(0, __builtin_bit_cast(int, v), CTRL, 0xF, 0xF, true)); }
__device__ __forceinline__ float rdlane_f(float v, int l) { return __builtin_bit_cast(float, __builtin_amdgcn_readlane(__builtin_bit_cast(int, v), l)); }
__device__ __forceinline__ float wave_sum(float v) {
    v += dpp_f<0xB1>(v); v += dpp_f<0x4E>(v); v += dpp_f<0x141>(v); v += dpp_f<0x140>(v);
    return (rdlane_f(v, 0) + rdlane_f(v, 16)) + (rdlane_f(v, 32) + rdlane_f(v, 48));
}
__device__ __forceinline__ void ld_row_f32(const float* p, int lane, f32x4 (&v)[D / 256]) {
#pragma unroll
    for (int j = 0; j < D / 256; ++j) v[j] = *(const f32x4*)(p + 4 * lane + 256 * j); }
__device__ __forceinline__ void ld_row_bf16(const st_t* p, int lane, f32x4 (&v)[D / 256]) {
#pragma unroll
    for (int j = 0; j < D / 256; ++j) { const u32x2 w = *(const u32x2*)(p + 4 * lane + 256 * j); v[j] = (f32x4){bf_lo(w.x), bf_hi(w.x), bf_lo(w.y), bf_hi(w.y)}; } }
__device__ __forceinline__ void st_row_bf16(st_t* p, int lane, const f32x4 (&v)[D / 256]) {
#pragma unroll
    for (int j = 0; j < D / 256; ++j) st4(p + 4 * lane + 256 * j, v[j][0], v[j][1], v[j][2], v[j][3]); }
__device__ __forceinline__ float sumsq(const f32x4 (&v)[D / 256]) { float s = 0.f;
#pragma unroll
    for (int j = 0; j < D / 256; ++j) s += (v[j][0] * v[j][0] + v[j][1] * v[j][1]) + (v[j][2] * v[j][2] + v[j][3] * v[j][3]);
    return wave_sum(s); }
template <bool TO_LDS>
__device__ __forceinline__ void modulate_store(const f32x4 (&x)[D / 256], float rstd, const float* gain, const float* sc, const float* sh, st_t* hrow, int lane, LAS float* hl, int swz = 0) {
    f32x4 g[D / 256], a[D / 256], b[D / 256], h[D / 256]; ld_row_f32(gain, lane, g); ld_row_f32(sc, lane, a); ld_row_f32(sh, lane, b);
#pragma unroll
    for (int j = 0; j < D / 256; ++j) h[j] = x[j] * rstd * g[j] * (a[j] + 1.0f) + b[j];
    st_row_bf16(hrow, lane, h);
    if constexpr (TO_LDS) {
#pragma unroll
        for (int j = 0; j < D / 256; ++j) *(LAS f32x4*)(hl + (((lane + 64 * j) ^ swz) << 2)) = h[j]; }
}
__device__ __forceinline__ void row_norm1(const Params& p, int layer, int r, int lane) {
    f32x4 x[D / 256]; ld_row_f32(xin_row(p, layer, r), lane, x);
    const float rstd = rsqrt_f(sumsq(x) / D + EPS);
    modulate_store<false>(x, rstd, p.mix_norm_pre + (size_t)layer * D, mod_vec(p, layer, r, 1), mod_vec(p, layer, r, 0), p.H() + (size_t)r * D, lane, (LAS float*)0);
}
__device__ __forceinline__ void route_pick(const Params& p, int layer, int r, int lane, float logit, LAS int* lcnt);
template <int NR>
__device__ __forceinline__ void row_post1_multi(const Params& p, int layer, int item, int lane, LAS float* hl, LAS int* lcnt) {
#pragma unroll
    for (int rr = 0; rr < NR; ++rr) { const int r = NR * item + rr;
        f32x4 y[D / 256], x[D / 256], g1[D / 256], gp[D / 256]; ld_row_bf16(p.Y() + (size_t)r * D, lane, y); ld_row_f32(xin_row(p, layer, r), lane, x);
        ld_row_f32(mod_vec(p, layer, r, 2), lane, g1); ld_row_f32(p.mix_norm_post + (size_t)layer * D, lane, gp);
        const float rstd = rsqrt_f(sumsq(y) / D + EPS);
#pragma unroll
        for (int j = 0; j < D / 256; ++j) x[j] = x[j] + g1[j] * y[j] * rstd * gp[j];
        float* xr = xrow(p, r);
#pragma unroll
        for (int j = 0; j < D / 256; ++j) *(f32x4*)(xr + 4 * lane + 256 * j) = x[j];
        const float r2 = rsqrt_f(sumsq(x) / D + EPS);
        modulate_store<true>(x, r2, p.ffn_norm_pre + (size_t)layer * D, mod_vec(p, layer, r, 4), mod_vec(p, layer, r, 3), p.H() + (size_t)r * D, lane, hl + rr * D);
    }
    asm volatile("s_waitcnt lgkmcnt(0)" ::: "memory");
    const float* wr = p.router_w + (size_t)layer * D * NE + lane; float acc[NR];
#pragma unroll
    for (int rr = 0; rr < NR; ++rr) acc[rr] = 0.f;
#pragma unroll 4
    for (int d4 = 0; d4 < D / 4; ++d4) { f32x4 hv[NR];
#pragma unroll
        for (int rr = 0; rr < NR; ++rr) hv[rr] = *(const LAS f32x4*)(hl + rr * D + 4 * d4);
#pragma unroll
        for (int u = 0; u < 4; ++u) { const float w = wr[(size_t)(4 * d4 + u) * NE];
#pragma unroll
            for (int rr = 0; rr < NR; ++rr) acc[rr] += hv[rr][u] * w; } }
#pragma unroll
    for (int rr = 0; rr < NR; ++rr) route_pick(p, layer, NR * item + rr, lane, acc[rr], lcnt);
    asm volatile("s_waitcnt lgkmcnt(0)" ::: "memory");
}
#if PROBE_SEL >= 40 && PROBE_SEL <= 43
#define P1SEC(n) do { const unsigned long long now_ = __builtin_amdgcn_s_memrealtime(); if (PROBE_SEL == 40 + (n)) pbv += now_ - last_; last_ = now_; } while (0)
#else
#define P1SEC(n) do { } while (0)
#endif
__device__ __forceinline__ void block_post1(const Params& p, int layer, int j16, int lane, int wave, LAS unsigned char* lds, LAS int* lcnt, unsigned long long& pbv) {
    LAS float* hl = (LAS float*)lds;
    asm volatile("s_nop 0\n\ts_nop 0\n\ts_nop 0\n\ts_nop 0\n\ts_nop 0\n\ts_nop 0\n\ts_nop 0\n\ts_nop 0\n\ts_nop 0");
#if PROBE_SEL >= 40 && PROBE_SEL <= 43
    unsigned long long last_ = __builtin_amdgcn_s_memrealtime();
#endif
#pragma unroll
    for (int rr = 0; rr < 4; ++rr) { const int r16 = 4 * wave + rr, r = 16 * j16 + r16;
        f32x4 y[D / 256], x[D / 256], g1[D / 256], gp[D / 256]; ld_row_bf16(p.Y() + (size_t)r * D, lane, y); ld_row_f32(xin_row(p, layer, r), lane, x);
        ld_row_f32(mod_vec(p, layer, r, 2), lane, g1); ld_row_f32(p.mix_norm_post + (size_t)layer * D, lane, gp);
        const float rstd = rsqrt_f(sumsq(y) / D + EPS);
#pragma unroll
        for (int j = 0; j < D / 256; ++j) x[j] = x[j] + g1[j] * y[j] * rstd * gp[j];
        float* xr = xrow(p, r);
#pragma unroll
        for (int j = 0; j < D / 256; ++j) *(f32x4*)(xr + 4 * lane + 256 * j) = x[j];
        const float r2 = rsqrt_f(sumsq(x) / D + EPS);
        modulate_store<true>(x, r2, p.ffn_norm_pre + (size_t)layer * D, mod_vec(p, layer, r, 4), mod_vec(p, layer, r, 3), p.H() + (size_t)r * D, lane, hl + r16 * D, r16);
    }
    P1SEC(0);
    __syncthreads();
    P1SEC(1);
    const int row = lane & 15, kq = lane >> 4;
    const float* wr = p.router_w + (size_t)layer * D * NE + (size_t)(256 * wave + 4 * kq) * NE + 4 * row;
    f32x4 acc[4];
#pragma unroll
    for (int jj = 0; jj < 4; ++jj) acc[jj] = (f32x4){0.f, 0.f, 0.f, 0.f};
#pragma unroll 4
    for (int blk = 0; blk < 16; ++blk) {
        const int c = 64 * wave + 4 * blk + kq;
        const f32x4 a4 = *(const LAS f32x4*)(hl + row * D + ((c ^ row) << 2));
#pragma unroll
        for (int u = 0; u < 4; ++u) { const f32x4 b4 = *(const f32x4*)(wr + (size_t)(16 * blk + u) * NE);
#pragma unroll
            for (int jj = 0; jj < 4; ++jj) acc[jj] = __builtin_amdgcn_mfma_f32_16x16x4f32(a4[u], b4[jj], acc[jj], 0, 0, 0); }
    }
    P1SEC(2);
    __syncthreads();
#pragma unroll
    for (int r = 0; r < 4; ++r) *(LAS f32x4*)(hl + (wave * 16 + 4 * kq + r) * NE + 4 * row) = (f32x4){acc[0][r], acc[1][r], acc[2][r], acc[3][r]};
    __syncthreads();
#pragma unroll
    for (int rr = 0; rr < 4; ++rr) { const int r16 = 4 * wave + rr; float lg = 0.f;
#pragma unroll
        for (int w2 = 0; w2 < 4; ++w2) lg += hl[(w2 * 16 + r16) * NE + lane];
        route_pick(p, layer, 16 * j16 + r16, lane, lg, lcnt); }
    asm volatile("s_waitcnt lgkmcnt(0)" ::: "memory");
    __syncthreads();
    P1SEC(3);
}
__device__ __forceinline__ void route_row(const Params& p, int layer, int r, int lane, float logit) {
    const float sg = sigmoid_f(logit), v = sg + p.router_bias[(size_t)layer * NE + lane];
    float m1 = v; int i1 = lane;
#pragma unroll
    for (int o = 1; o < 8; o <<= 1) { const float ov = __shfl_xor(m1, o); const int oi = __shfl_xor(i1, o); if (ov > m1 || (ov == m1 && oi < i1)) { m1 = ov; i1 = oi; } }
    float m2 = lane == i1 ? -3.0e38f : v;
#pragma unroll
    for (int o = 1; o < 8; o <<= 1) m2 = fmaxf(m2, __shfl_xor(m2, o));
    const float gs = m1 + m2; const int grp = lane >> 3;
    int grank = 0;
#pragma unroll
    for (int j = 0; j < NGRP; ++j) { const float og = __shfl(gs, j * 8); grank += (og > gs || (og == gs && j < grp)) ? 1 : 0; }
    const float mv = grank < TOPG ? v : -3.0e38f;
    int rank = 0;
#pragma unroll
    for (int j = 0; j < NE; ++j) { const float ov = __shfl(mv, j); rank += (ov > mv || (ov == mv && j < lane)) ? 1 : 0; }
    const bool sel = rank < TOPK;
    const float wsum = wave_sum(sel ? sg : 0.f);
    if (sel) { const float w = sg / wsum * ROUTED_SCALE; const int pos = atomicAdd(p.CNT() + layer * NE + lane, 1); atomicAdd(p.CNTP() + (layer * NE + lane) * 32, 1);
        p.EIDX()[(size_t)r * TOPK + rank] = lane; p.EPOS()[(size_t)r * TOPK + rank] = pos; p.TOKLIST()[(size_t)lane * TA + pos] = r; p.WLIST()[(size_t)lane * TA + pos] = w; }
}
__device__ __forceinline__ void row_post1_quad(const Params& p, int layer, int quad, int lane, LAS float* hl) {
#pragma unroll
    for (int rr = 0; rr < 4; ++rr) { const int r = 4 * quad + rr;
        f32x4 y[D / 256], x[D / 256], g1[D / 256], gp[D / 256]; ld_row_bf16(p.Y() + (size_t)r * D, lane, y); ld_row_f32(xin_row(p, layer, r), lane, x);
        ld_row_f32(mod_vec(p, layer, r, 2), lane, g1); ld_row_f32(p.mix_norm_post + (size_t)layer * D, lane, gp);
        const float rstd = rsqrt_f(sumsq(y) / D + EPS);
#pragma unroll
        for (int j = 0; j < D / 256; ++j) x[j] = x[j] + g1[j] * y[j] * rstd * gp[j];
        float* xr = xrow(p, r);
#pragma unroll
        for (int j = 0; j < D / 256; ++j) *(f32x4*)(xr + 4 * lane + 256 * j) = x[j];
        const float r2 = rsqrt_f(sumsq(x) / D + EPS);
        modulate_store<true>(x, r2, p.ffn_norm_pre + (size_t)layer * D, mod_vec(p, layer, r, 4), mod_vec(p, layer, r, 3), p.H() + (size_t)r * D, lane, hl + rr * D);
    }
    asm volatile("s_waitcnt lgkmcnt(0)" ::: "memory");
    const float* wr = p.router_w + (size_t)layer * D * NE + lane; float a0 = 0.f, a1 = 0.f, a2 = 0.f, a3 = 0.f;
#pragma unroll 4
    for (int d4 = 0; d4 < D / 4; ++d4) { const f32x4 h0 = *(const LAS f32x4*)(hl + 4 * d4), h1 = *(const LAS f32x4*)(hl + D + 4 * d4), h2 = *(const LAS f32x4*)(hl + 2 * D + 4 * d4), h3 = *(const LAS f32x4*)(hl + 3 * D + 4 * d4);
#pragma unroll
        for (int u = 0; u < 4; ++u) { const float w = wr[(size_t)(4 * d4 + u) * NE]; a0 += h0[u] * w; a1 += h1[u] * w; a2 += h2[u] * w; a3 += h3[u] * w; } }
    route_row(p, layer, 4 * quad, lane, a0); route_row(p, layer, 4 * quad + 1, lane, a1); route_row(p, layer, 4 * quad + 2, lane, a2); route_row(p, layer, 4 * quad + 3, lane, a3);
    asm volatile("s_waitcnt lgkmcnt(0)" ::: "memory");
}
__device__ __forceinline__ void route_pick(const Params& p, int layer, int r, int lane, float logit, LAS int* lcnt) {
    const float sg = sigmoid_f(logit), v = sg + p.router_bias[(size_t)layer * NE + lane];
    float m1 = v; int i1 = lane;
#pragma unroll
    for (int o = 1; o < 8; o <<= 1) { const float ov = __shfl_xor(m1, o); const int oi = __shfl_xor(i1, o); if (ov > m1 || (ov == m1 && oi < i1)) { m1 = ov; i1 = oi; } }
    float m2 = lane == i1 ? -3.0e38f : v;
#pragma unroll
    for (int o = 1; o < 8; o <<= 1) m2 = fmaxf(m2, __shfl_xor(m2, o));
    const float gs = m1 + m2; const int grp = lane >> 3;
    int grank = 0;
#pragma unroll
    for (int j = 0; j < NGRP; ++j) { const float og = __builtin_bit_cast(float, __builtin_amdgcn_readlane(__builtin_bit_cast(int, gs), j * 8)); grank += (og > gs || (og == gs && j < grp)) ? 1 : 0; }
    const float mv = grank < TOPG ? v : -3.0e38f;
    int rank = 0;
#pragma unroll
    for (int j = 0; j < NE; ++j) { const float ov = __builtin_bit_cast(float, __builtin_amdgcn_readlane(__builtin_bit_cast(int, mv), j)); rank += (ov > mv || (ov == mv && j < lane)) ? 1 : 0; }
    const bool sel = rank < TOPK;
    const float wsum = wave_sum(sel ? sg : 0.f);
    if (sel) { p.EIDX()[(size_t)r * TOPK + rank] = lane; p.EW()[(size_t)r * TOPK + rank] = sg / wsum * ROUTED_SCALE; __hip_atomic_fetch_add(lcnt + lane, 1, __ATOMIC_RELAXED, __HIP_MEMORY_SCOPE_WORKGROUP); }
}
__device__ __forceinline__ void route_place(const Params& p, int layer, LAS unsigned char* lds, int tid, int lane, int wave) {
    LAS int* pb = (LAS int*)lds; LAS int* lpos = pb + NE;
    __syncthreads();
    { const int e = tid & (NE - 1), qd = tid >> 6, per = ((int)gridDim.x + 3) / 4; int below = 0, tot = 0; const int* bc = p.BCNT() + e;
      const int b_hi = (qd + 1) * per < (int)gridDim.x ? (qd + 1) * per : (int)gridDim.x;
#pragma unroll 8
      for (int b2 = qd * per; b2 < b_hi; ++b2) { const int c = bc[(size_t)b2 * NE]; tot += c; below += b2 < (int)blockIdx.x ? c : 0; }
      LAS int* red = lpos + NE; red[tid] = below; red[256 + tid] = tot; }
    __syncthreads();
    if (tid < NE) { LAS int* red = lpos + NE; pb[tid] = red[tid] + red[64 + tid] + red[128 + tid] + red[192 + tid]; lpos[tid] = 0;
        if (blockIdx.x == 0) p.CNT()[layer * NE + tid] = red[256 + tid] + red[320 + tid] + red[384 + tid] + red[448 + tid]; }
    __syncthreads();
    const int gw = blockIdx.x * 4 + wave, nw = gridDim.x * 4;
    for (int i = gw; i < rows_out(layer) / POST1_NR; i += nw) {
        if (lane < POST1_NR * TOPK) { const int r = POST1_NR * i + (lane >> 3), k = lane & 7; const int e = p.EIDX()[(size_t)r * TOPK + k]; const float w = p.EW()[(size_t)r * TOPK + k];
            const int pos = pb[e] + __hip_atomic_fetch_add(lpos + e, 1, __ATOMIC_RELAXED, __HIP_MEMORY_SCOPE_WORKGROUP);
            p.EPOS()[(size_t)r * TOPK + k] = pos; p.TOKLIST()[(size_t)e * TA + pos] = r; p.WLIST()[(size_t)e * TA + pos] = w; }
    }
}
__device__ __forceinline__ void row_post2(const Params& p, int layer, int r, int lane, const int* eb) {
    int slot = 0;
    if (lane < TOPK) { const int e = p.EIDX()[(size_t)r * TOPK + lane]; slot = eb[e] + p.EPOS()[(size_t)r * TOPK + lane]; }
    f32x4 f[D / 256]; ld_row_bf16(p.SH() + (size_t)r * D, lane, f);
#pragma unroll
    for (int k = 0; k < TOPK; ++k) { const int sk = __shfl(slot, k); f32x4 t[D / 256]; ld_row_bf16(p.YB() + (size_t)sk * D, lane, t);
#pragma unroll
        for (int j = 0; j < D / 256; ++j) f[j] += t[j]; }
    const float rstd = rsqrt_f(sumsq(f) / D + EPS);
    float* xr = xrow(p, r); f32x4 x[D / 256], g2[D / 256], gp[D / 256]; ld_row_f32(xr, lane, x); ld_row_f32(mod_vec(p, layer, r, 5), lane, g2); ld_row_f32(p.ffn_norm_post + (size_t)layer * D, lane, gp);
#pragma unroll
    for (int j = 0; j < D / 256; ++j) { x[j] = x[j] + g2[j] * f[j] * rstd * gp[j]; *(f32x4*)(xr + 4 * lane + 256 * j) = x[j]; }
    if (layer + 1 < DEPTH) { const float r2 = rsqrt_f(sumsq(x) / D + EPS);
        modulate_store<false>(x, r2, p.mix_norm_pre + (size_t)(layer + 1) * D, mod_vec(p, layer + 1, r, 1), mod_vec(p, layer + 1, r, 0), p.H() + (size_t)r * D, lane, (LAS float*)0); }
}
__device__ __forceinline__ void unpack8(const u32x4 w, float (&x)[8]) { x[0] = bf_lo(w.x); x[1] = bf_hi(w.x); x[2] = bf_lo(w.y); x[3] = bf_hi(w.y); x[4] = bf_lo(w.z); x[5] = bf_hi(w.z); x[6] = bf_lo(w.w); x[7] = bf_hi(w.w); }
__device__ __forceinline__ u32x4 pack8(const float (&x)[8]) { u32x4 o; o.x = pk_bf16(x[0], x[1]); o.y = pk_bf16(x[2], x[3]); o.z = pk_bf16(x[4], x[5]); o.w = pk_bf16(x[6], x[7]); return o; }
__device__ __forceinline__ void row_xform(const Params& p, int layer, int r, int lane, const LAS float* cw) {
    int lo, hi; seq_bounds(r, lo, hi);
    const st_t* prow = p.P() + (size_t)r * DPROJP;
#pragma unroll
    for (int gi = 0; gi < 3; ++gi) {
        if (gi < 2 || lane < 16) {
            const int c0 = 8 * (lane + 64 * gi); float acc[8];
#pragma unroll
            for (int e = 0; e < 8; ++e) acc[e] = 0.f;
#pragma unroll
            for (int j = 0; j < GCONV; ++j) { const int rr = r + j - 2;
                if (rr >= lo && rr < hi) { float x[8]; unpack8(*(const u32x4*)(p.P() + (size_t)rr * DPROJP + PO_GQKV + c0), x);
                    const f32x4 w0 = *(const LAS f32x4*)(cw + j * GQKV + c0), w1 = *(const LAS f32x4*)(cw + j * GQKV + c0 + 4);
#pragma unroll
                    for (int e = 0; e < 4; ++e) { acc[e] += w0[e] * x[e]; acc[4 + e] += w1[e] * x[4 + e]; } } }
            float ss = 0.f;
#pragma unroll
            for (int e = 0; e < 8; ++e) { acc[e] = silu_f(acc[e]); ss += acc[e] * acc[e]; }
            if (gi < 2) {
                ss += __shfl_xor(ss, 1); ss += __shfl_xor(ss, 2); ss += __shfl_xor(ss, 4);
                const float rn = c0 < 2 * GH * GDK ? rsqrt_f(ss + EPS) : 1.0f;
#pragma unroll
                for (int e = 0; e < 8; ++e) acc[e] *= rn; }
            *(u32x4*)(p.G() + (size_t)r * GQKV + c0) = pack8(acc);
        }
    }
    if (lane < 12) { const float beta = sigmoid_f(ldf(prow + PO_BA + lane)), a = ldf(prow + PO_BA + 12 + lane);
        p.BG()[(size_t)r * 24 + lane] = beta; p.BG()[(size_t)r * 24 + 12 + lane] = -expf(p.gdn_a_log[layer * 12 + lane]) * softplus_f(a + p.gdn_dt_bias[layer * 12 + lane]); }
    { float x[8]; float ss = 0.f;
      if (lane < MQR / 8) { unpack8(*(const u32x4*)(prow + PO_CQ + 8 * lane), x);
#pragma unroll
          for (int e = 0; e < 8; ++e) ss += x[e] * x[e]; }
      const float rstd = rsqrt_f(wave_sum(ss) / MQR + EPS);
      if (lane < MQR / 8) { const float* gn = p.mla_q_norm + (size_t)layer * MQR + 8 * lane;
#pragma unroll
          for (int e = 0; e < 8; ++e) x[e] = x[e] * rstd * gn[e];
          *(u32x4*)(p.CQN() + (size_t)r * MQR + 8 * lane) = pack8(x); } }
    { float x[8]; float ss = 0.f;
      if (lane < MKVR / 8) { unpack8(*(const u32x4*)(prow + PO_CKV + 8 * lane), x);
#pragma unroll
          for (int e = 0; e < 8; ++e) ss += x[e] * x[e]; }
      const float rstd = rsqrt_f(wave_sum(ss) / MKVR + EPS);
      if (lane < MKVR / 8) { const float* gn = p.mla_kv_norm + (size_t)layer * MKVR + 8 * lane;
#pragma unroll
          for (int e = 0; e < 8; ++e) x[e] = x[e] * rstd * gn[e];
          *(u32x4*)(p.CKVN() + (size_t)r * MKVR + 8 * lane) = pack8(x); } }
}
__device__ __forceinline__ void row_mla_merge(const Params& p, int r, int lane) {
    if (NSPLIT == 1 || r >= T || lane >= MH * MV / 8) return;
    const int h = lane / (MV / 8); float mc[NSPLIT], lc[NSPLIT], mx = -3.0e38f;
#pragma unroll
    for (int c = 0; c < NSPLIT; ++c) { const float* ml = p.MLPART() + (((size_t)c * T + r) * MH + h) * 2; mc[c] = ml[0]; lc[c] = ml[1]; mx = fmaxf(mx, mc[c]); }
    float o[8], wsum = 0.f;
#pragma unroll
    for (int e = 0; e < 8; ++e) o[e] = 0.f;
#pragma unroll
    for (int c = 0; c < NSPLIT; ++c) { const float w = lc[c] * __builtin_amdgcn_exp2f(mc[c] - mx); wsum += w; float x[8]; unpack8(*(const u32x4*)(p.OPART() + ((size_t)c * T + r) * MH * MV + 8 * lane), x);
#pragma unroll
        for (int e = 0; e < 8; ++e) o[e] += w * x[e]; }
    const float inv = __builtin_amdgcn_rcpf(wsum);
#pragma unroll
    for (int e = 0; e < 8; ++e) o[e] *= inv;
    *(u32x4*)(p.O() + (size_t)r * DMIX + (SWA_H + GH) * 64 + 8 * lane) = pack8(o);
}
__device__ __forceinline__ void row_gout(const Params& p, int layer, int r, int lane) {
    row_mla_merge(p, r, lane);
    float o[8]; float ss = 0.f; const bool act = lane < GH * GDV / 8;
    if (act) { float a[8], b[8]; unpack8(*(const u32x4*)(p.OF() + (size_t)r * (GH * GDV) + 8 * lane), a); unpack8(*(const u32x4*)(p.OB() + (size_t)r * (GH * GDV) + 8 * lane), b);
#pragma unroll
        for (int e = 0; e < 8; ++e) { o[e] = a[e] + b[e]; ss += o[e] * o[e]; } }
    ss += __shfl_xor(ss, 1); ss += __shfl_xor(ss, 2); ss += __shfl_xor(ss, 4);
    if (act) { const float rstd = rsqrt_f(ss / GDV + EPS); float z[8]; unpack8(*(const u32x4*)(p.P() + (size_t)r * DPROJP + PO_Z + 8 * lane), z);
        const float* nw = p.gdn_norm_w + layer * GDV + (8 * lane) % GDV;
#pragma unroll
        for (int e = 0; e < 8; ++e) o[e] = o[e] * rstd * nw[e] * silu_f(z[e]);
        *(u32x4*)(p.O() + (size_t)r * DMIX + GH * GDV + 8 * lane) = pack8(o); }
}
__device__ __forceinline__ void mod_block(const Params& p, int item, LAS unsigned char* lds, int tid) {
    const int lane = tid & 63, wave = __builtin_amdgcn_readfirstlane(tid >> 6); const int ly = item / (6 * D / 64), jb = item % (6 * D / 64);
    LAS float* sl = (LAS float*)lds; LAS float* red = sl + 3 * D;
    __syncthreads();
    for (int i = tid; i < 3 * D; i += 256) { const int w = i / D, k = i % D; sl[i] = silu_f(w < 2 ? p.c[(size_t)w * D + k] : p.c_ctx[k]); }
    __syncthreads();
    const float* W = p.ada_w + (size_t)ly * D * 6 * D + jb * 64 + lane; float a0 = 0.f, a1 = 0.f, a2 = 0.f;
#pragma unroll 8
    for (int k = wave * (D / 4); k < (wave + 1) * (D / 4); ++k) { const float w = W[(size_t)k * 6 * D]; a0 += sl[k] * w; a1 += sl[D + k] * w; a2 += sl[2 * D + k] * w; }
    red[(wave * 3 + 0) * 64 + lane] = a0; red[(wave * 3 + 1) * 64 + lane] = a1; red[(wave * 3 + 2) * 64 + lane] = a2;
    __syncthreads();
    if (wave < 3) { const float v = red[(0 * 3 + wave) * 64 + lane] + red[(1 * 3 + wave) * 64 + lane] + red[(2 * 3 + wave) * 64 + lane] + red[(3 * 3 + wave) * 64 + lane];
        p.MOD()[((size_t)(ly * 3 + wave) * 6 * D) + jb * 64 + lane] = v + p.ada_b[(size_t)ly * 6 * D + jb * 64 + lane]; }
}
#endif


#ifndef HOST_EMU
#define XB_TMO      128
#define XB_XCNT(j)  (256  + 64 * (j))
#define XB_XSUB(j)  (1280 + 64 * (j))
#define XB_XGEN(j)  (2304 + 64 * (j))
#define XB_TOP      3328
#define XB_TOPGEN   3392
#define XCD_BAR_WORDS 3456
#define XB_SPIN_CAP (1u << 18)

__device__ __forceinline__ unsigned xb_ld(unsigned* p)              { return __hip_atomic_load(p, __ATOMIC_RELAXED, __HIP_MEMORY_SCOPE_AGENT); }
__device__ __forceinline__ unsigned xb_add(unsigned* p, unsigned v) { return __hip_atomic_fetch_add(p, v, __ATOMIC_RELAXED, __HIP_MEMORY_SCOPE_AGENT); }
__device__ __forceinline__ unsigned xb_xcc_id() { return (unsigned)__builtin_amdgcn_s_getreg((3 << 11) | 20) & 0xFu; }
#define XB_SPIN(cond, bar) do { unsigned _sp = 0; while (cond) { __builtin_amdgcn_s_sleep(1); \
    if ((++_sp & 255u) == 0u) { if (xb_ld(&(bar)[XB_TMO])) break; if (_sp > XB_SPIN_CAP) { atomicAdd(&(bar)[XB_TMO], 1u); break; } } } } while (0)

struct XcdBarrier {
    unsigned* bar; unsigned x;
    volatile LAS unsigned* st;
};

__device__ __forceinline__ XcdBarrier xcd_barrier_post(unsigned* bar, volatile LAS unsigned* st) {
    XcdBarrier b; b.bar = bar; b.x = xb_xcc_id(); b.st = st;
    if (threadIdx.x == 0) (void)xb_add(&bar[XB_XCNT(b.x)], 1u);
    return b;
}
__device__ __forceinline__ void xcd_barrier_complete(unsigned* bar, unsigned x, unsigned& nloc, unsigned& nx) {
    const unsigned G = gridDim.x * gridDim.y * gridDim.z;
    unsigned sum, cnt, mine, sp = 0u;
    for (;;) {
        sum = 0u; cnt = 0u; mine = 0u;
#pragma unroll
        for (unsigned j = 0; j < 16; ++j) { const unsigned c = xb_ld(&bar[XB_XCNT(j)]); sum += c; cnt += (c > 0u) ? 1u : 0u; mine = (j == x) ? c : mine; }
        if (sum == G) break;
        __builtin_amdgcn_s_sleep(1);
        if ((++sp & 255u) == 0u) { if (xb_ld(&bar[XB_TMO])) break; if (sp > XB_SPIN_CAP) { atomicAdd(&bar[XB_TMO], 1u); break; } }
    }
    nloc = mine > 0u ? mine : 1u; nx = cnt > 0u ? cnt : 1u;
}

__device__ __forceinline__ void xcd_barrier(const XcdBarrier& b) {
    asm volatile("s_waitcnt vmcnt(0)" ::: "memory");
    __syncthreads();
    if (threadIdx.x == 0) {
        unsigned* bar = b.bar;
        __builtin_amdgcn_s_waitcnt(0);
        unsigned nloc = b.st[0], nx = b.st[1];
        if (nloc == 0u) { xcd_barrier_complete(bar, b.x, nloc, nx); b.st[0] = nloc; b.st[1] = nx; }
        const unsigned old = xb_add(&bar[XB_XSUB(b.x)], 1u);
        const unsigned gen = old / nloc;
        if (old + 1u == (gen + 1u) * nloc) {
            __builtin_amdgcn_fence(__ATOMIC_RELEASE, "agent");
            asm volatile("s_waitcnt vmcnt(0)" ::: "memory");
            const unsigned og = xb_add(&bar[XB_TOP], 1u);
            const unsigned tg = og / nx;
            if (og + 1u == (tg + 1u) * nx) xb_add(&bar[XB_TOPGEN], 1u);
            else XB_SPIN(xb_ld(&bar[XB_TOPGEN]) == tg, bar);
            __builtin_amdgcn_fence(__ATOMIC_ACQUIRE, "agent");
            xb_add(&bar[XB_XGEN(b.x)], 1u);
            asm volatile("s_waitcnt vmcnt(0)" ::: "memory");
        } else {
            XB_SPIN(xb_ld(&bar[XB_XGEN(b.x)]) == gen, bar);
            __builtin_amdgcn_fence(__ATOMIC_ACQUIRE, "agent");
            asm volatile("s_waitcnt vmcnt(0)" ::: "memory");
        }
    }
    __syncthreads();
}

#endif

enum { K_ITEM = 0, K_WT = 1, K_GEMM = 2, K_ATTN = 3, K_GPRE = 4, K_ROW = 5, K_MOD = 6 };
struct Step { int kind, st, layer, sync_before; };
inline int build_program(Step* prog) {
    int n = 0;
    prog[n++] = {K_ITEM, ST_ZERO, 0, 0}; prog[n++] = {K_ITEM, ST_TAB, 0, 0}; prog[n++] = {USE_KMOD ? K_MOD : K_ITEM, USE_KMOD ? 0 : ST_MOD, 0, 0}; prog[n++] = {K_WT, WT_STATIC, 0, 0};
    for (int l = 0; l < DEPTH; ++l) {
        if (l == 0 || !USE_RPOST2) { if (USE_RNORM1) prog[n++] = {K_ROW, 0  , l, 1}; else prog[n++] = {K_ITEM, ST_NORM1, l, 1}; }
        prog[n++] = {K_GEMM, G_PROJ, l, 1};
        prog[n++] = {K_ROW, 3  , l, 1};
        prog[n++] = {K_GEMM, G_UQ, l, 1}; prog[n++] = {K_GEMM, G_UKV, l, 0}; prog[n++] = {K_GPRE, 0, l, 0};
        prog[n++] = {K_ATTN, 0, l, 1};
        prog[n++] = {K_ROW, 4  , l, 1};
        prog[n++] = {K_GEMM, G_WOUT, l, 1}; prog[n++] = {K_WT, WT_EXPERT, l, 0};
        if (USE_RPOST1) { prog[n++] = {K_ROW, 1  , l, 1}; prog[n++] = {K_ROW, 5  , l, 1}; } else { prog[n++] = {K_ITEM, ST_POST1, l, 1}; prog[n++] = {K_ITEM, ST_ROUTER, l, 1}; prog[n++] = {K_ITEM, ST_ROUTE, l, 1}; }
        prog[n++] = {K_GEMM, G_SGU, l, 1}; prog[n++] = {K_GEMM, G_EGU, l, 0};
        prog[n++] = {K_GEMM, G_SDOWN, l, 1}; prog[n++] = {K_GEMM, G_EDOWN, l, 0};
        if (USE_RPOST2) prog[n++] = {K_ROW, 2  , l, 1}; else prog[n++] = {K_ITEM, ST_POST2, l, 1};
    }
    return n;
}
constexpr int MAX_STEPS = 64;

#ifndef HOST_EMU
namespace cg = cooperative_groups;
struct Prog { Step s[MAX_STEPS]; int n; int pad[3]; };

__global__ void __launch_bounds__(256, 2) k_mega(Params p, Prog pr) {
    extern __shared__ __attribute__((aligned(16))) unsigned char smem[];
    LAS unsigned char* lds = (LAS unsigned char*)smem;
    cg::grid_group grid = cg::this_grid();
    { volatile LAS unsigned* bst = (volatile LAS unsigned*)(lds + 65536); if (threadIdx.x < 2) bst[threadIdx.x] = 0u; }
    __syncthreads();
    (void)xcd_barrier_post(p.BAR(), (volatile LAS unsigned*)(lds + 65536));
#define XBAR_NOW() do { XcdBarrier xb_; xb_.bar = p.BAR(); xb_.x = xb_xcc_id(); xb_.st = (volatile LAS unsigned*)(lds + 65536); xcd_barrier(xb_); } while (0)
    bool first_sync = true;
    const long long gthreads = (long long)gridDim.x * 256;
    unsigned long long pb_chain = 0; (void)pb_chain;
#if PROBE_SEL
    unsigned long long pb_acc = 0, pb_t0 = __builtin_amdgcn_s_memrealtime(); bool pb_on = false;
#endif
    for (int s = 0; s < pr.n; ++s) {
        const int kind = pr.s[s].kind, st = pr.s[s].st, layer = pr.s[s].layer;
#if PROBE_SEL
        const bool pb_match = (PROBE_SEL == 1 && kind == K_ROW && st == 1) || (PROBE_SEL == 2 && ((kind == K_ITEM && st == ST_ROUTE) || (kind == K_ROW && st == 5))) || (PROBE_SEL == 3 && kind == K_ROW && st == 2) || (PROBE_SEL == 4 && kind == K_ROW && st == 3) ||
            (PROBE_SEL == 5 && kind == K_ROW && st == 4) || (PROBE_SEL == 6 && kind == K_ATTN) || (PROBE_SEL == 7 && kind == K_GEMM && st == G_PROJ) || (PROBE_SEL == 8 && kind == K_GEMM && st == G_WOUT) ||
            (PROBE_SEL == 9 && kind == K_GEMM && st == G_EGU) || (PROBE_SEL == 10 && kind == K_GEMM && st == G_EDOWN) || (PROBE_SEL == 11 && kind == K_GPRE) || (PROBE_SEL == 12 && kind == K_WT && st == WT_STATIC) || (PROBE_SEL == 13 && kind == K_WT && st == WT_EXPERT) || (PROBE_SEL == 14 && kind == K_ROW && st == 0) || (PROBE_SEL == 30 && kind == K_GEMM) || (PROBE_SEL == 31 && kind == K_ROW && st != 1) || (PROBE_SEL == 32 && (kind == K_GPRE || kind == K_WT || kind == K_ITEM || kind == K_MOD));
#endif
        if (pr.s[s].sync_before) { if (first_sync) { grid.sync(); first_sync = false; } else XBAR_NOW();
#if PROBE_SEL
            { const unsigned long long now = __builtin_amdgcn_s_memrealtime(); if (pb_on) pb_acc += now - pb_t0; pb_t0 = now; pb_on = false; }
#endif
        }
#if PROBE_SEL
        if (pb_match) pb_on = true;
#endif
        int reps = 1;
        if (PROBE_MASK) { const int grp = kind == K_GEMM ? 0 : kind == K_ATTN ? 1 : kind == K_GPRE ? 2 : kind == K_WT ? 3 : (kind == K_ROW && (st == R_XFORM || st == R_GOUT || st == R_NORM1)) ? 4 : 7;
            if (grp < 5 && ((PROBE_MASK >> grp) & 1)) reps = 2; if (((PROBE_MASK >> 5) & 1) && pr.s[s].sync_before) XBAR_NOW(); }
        for (int rep = 0; rep < reps; ++rep) {
        if (rep > 0 && ((PROBE_MASK >> 6) & 1)) XBAR_NOW();
        int tid = threadIdx.x; asm volatile("" : "+v"(tid));
        const int lane = tid & 63, wave = __builtin_amdgcn_readfirstlane(tid >> 6);
        const long long gtid = (long long)blockIdx.x * 256 + tid;
        ETab et{nullptr, nullptr};
        if ((kind == K_GEMM && (st == G_EGU || st == G_EDOWN)) || (kind == K_ROW && st == R_POST2)) {
            LAS int* eb = (LAS int*)(lds + 65536 + 64); LAS int* tb = eb + 72;
            __syncthreads();
            if (wave == 0) { const int c = FUSE_ROUTE ? p.CNTP()[(layer * NE + lane) * 32] : p.CNT()[layer * NE + lane]; int a = c, t = (c + 127) >> 7;
#pragma unroll
                for (int o = 1; o < 64; o <<= 1) { const int ua = __shfl_up(a, o), ut = __shfl_up(t, o); if (lane >= o) { a += ua; t += ut; } }
                eb[lane + 1] = a; tb[lane + 1] = t; if (lane == 0) { eb[0] = 0; tb[0] = 0; } }
            __syncthreads();
            et.eb = (const int*)eb; et.tb = (const int*)tb;
        }
        if (kind == K_ITEM) {
            const long long n = n_items(st, layer);
#define RUN_ST(ST) case ST: for (long long i = gtid; i < n; i += gthreads) run_item(p, ST, layer, i); break;
            switch (st) {
#if !USE_KMOD
                RUN_ST(ST_MOD)
#endif
#if !USE_RNORM1
                RUN_ST(ST_NORM1)
#endif
#if !USE_RPOST1
                RUN_ST(ST_POST1) RUN_ST(ST_ROUTER)
#endif
#if !USE_RPOST2
                RUN_ST(ST_POST2)
#endif
                RUN_ST(ST_ZERO) RUN_ST(ST_TAB)
#if !USE_RPOST1 || !FUSE_ROUTE
                RUN_ST(ST_ROUTE)
#endif
                default: break; }
#undef RUN_ST
        } else if (kind == K_WT) {
            const long long n = wt_items(p, st); LAS float* scr = (LAS float*)(lds + wave * (64 * 33 * 4));
            for (long long i = (long long)blockIdx.x * 4 + wave; i < n; i += (long long)gridDim.x * 4) wt_item_dev(p, st, layer, i, scr, lane);
        } else if (kind == K_GEMM) {
            const int n = gemm_ntiles(p, st, layer, et);
            const int q8 = n >> 3, r8 = n & 7;
            for (int i = blockIdx.x; i < n; i += gridDim.x) {
                const int x = i & 7, tau = (x < r8 ? x * (q8 + 1) : r8 * (q8 + 1) + (x - r8) * q8) + (i >> 3);
                GemmDesc g; gemm_desc(p, st, layer, tau, g, et); gemm_tile_dev(g, lds, tid); }
        } else if (kind == K_ROW) {
            const int gw = blockIdx.x * 4 + wave, nw = gridDim.x * 4;
            if (st == R_NORM1) { for (int r = gw; r < TA; r += nw) row_norm1(p, layer, r, lane); }
            else if (st == R_POST1) { __syncthreads();
#if FUSE_ROUTE
                LAS float* hl = (LAS float*)(lds + wave * (4 * D * 4)); for (int i = gw; i < rows_out(layer) / 4; i += nw) row_post1_quad(p, layer, i, lane, hl);
#else
                LAS float* hl = (LAS float*)(lds + wave * (POST1_NR * D * 4)); LAS int* lcnt = (LAS int*)(lds + 65536 + 640);
                if (tid < NE) lcnt[tid] = 0;
                __syncthreads();
                (void)hl; for (int j16 = blockIdx.x; j16 < rows_out(layer) / 16; j16 += gridDim.x) block_post1(p, layer, j16, lane, wave, lds, lcnt, pb_chain);
                __syncthreads();
                if (tid < NE) p.BCNT()[(size_t)blockIdx.x * NE + tid] = lcnt[tid];
#endif
            }
            else if (st == R_ROUTE2) route_place(p, layer, lds, tid, lane, wave);
            else if (st == R_POST2) { for (int r = gw; r < rows_out(layer); r += nw) row_post2(p, layer, r, lane, et.eb); }
            else if (st == R_XFORM) { __syncthreads(); LAS float* cw = (LAS float*)lds; for (int i = tid; i < GCONV * GQKV; i += 256) cw[i] = p.gdn_conv_w[(size_t)layer * GCONV * GQKV + i]; __syncthreads();
                for (int r = gw; r < TA; r += nw) row_xform(p, layer, r, lane, cw); }
            else { for (int r = gw; r < rows_out(layer); r += nw) row_gout(p, layer, r, lane); }
        } else if (kind == K_MOD) {
            for (int i = blockIdx.x; i < DEPTH * (6 * D / 64); i += gridDim.x) mod_block(p, i, lds, tid);
        } else if (kind == K_GPRE) {
            const int n = NCHAIN * NCH / 2;
            for (int i = blockIdx.x; i < n; i += gridDim.x) gdn_pre_dev(p, i, lds, tid);
        } else {
            LAS int* slot = (LAS int*)(lds + 65536 + 16); const int x0 = (int)(xb_xcc_id() & 7u);
            for (int qs = 0; qs < 8; ++qs) {
                const int x = (x0 + qs) & 7, nq = attn_queue_size(layer, x);
                for (;;) {
                    __syncthreads(); if (tid == 0) *slot = atomicAdd(p.CTR() + layer * 16 + rep * 8 + x, 1); __syncthreads();
                    const int k = *slot; if (k >= nq) break;
                    const int item = attn_queue_item(layer, x, k);
                    int t2 = tid; asm volatile("" : "+v"(t2));
#if PROBE_SEL == 24
                    if (item < NCHAIN) { const unsigned long long c0 = __builtin_amdgcn_s_memrealtime(); gdn_scan_dev(p, item, lds, t2); pb_chain += __builtin_amdgcn_s_memrealtime() - c0; continue; }
#else
                    if (item < NCHAIN) { gdn_scan_dev(p, item, lds, t2); continue; }
#endif
                    AttnDesc a; attn_desc(p, layer, item - NCHAIN, a);
                    if (a.dqk == 96) attn_tile_dev<96>(a, lds, t2); else attn_tile_dev<64>(a, lds, t2);
                }
            }
        }
        }
    }
#if PROBE_SEL
    { const unsigned long long now = __builtin_amdgcn_s_memrealtime(); if (pb_on) pb_acc += now - pb_t0;
      if (PROBE_SEL == 24 || PROBE_SEL >= 40) pb_acc = pb_chain;
      if (blockIdx.x == 0 || PROBE_SEL == 24 || PROBE_SEL >= 40) { const unsigned long long until = now + 4ull * pb_acc; while (__builtin_amdgcn_s_memrealtime() < until) __builtin_amdgcn_s_sleep(32); } }
#endif
}

extern "C" void kernel_launch(void* const* d_in, const int* in_sizes, int n_in, void* d_out, int out_size, void* d_ws, size_t ws_size, hipStream_t stream) {
    Params p{};
    const float** pin = (const float**)&p;
    for (int i = 0; i < 29 && i < n_in; ++i) pin[i] = (const float*)d_in[i];
    p.out = (float*)d_out;
    const size_t need = carve(p, (char*)d_ws);
    if (need > ws_size) { fprintf(stderr, "kernel_launch: workspace too small: need %zu have %zu\n", need, ws_size); return; }
    Prog pr{}; pr.n = build_program(pr.s);
    constexpr int LDS_BYTES = 65536 + 1024;
    static int grid_blocks = 0;
    if (!grid_blocks) {
        int dev = 0, cus = 0, per_cu = 0;
        (void)hipGetDevice(&dev);
        (void)hipDeviceGetAttribute(&cus, hipDeviceAttributeMultiprocessorCount, dev);
        (void)hipFuncSetAttribute((const void*)k_mega, hipFuncAttributeMaxDynamicSharedMemorySize, LDS_BYTES);
        (void)hipOccupancyMaxActiveBlocksPerMultiprocessor(&per_cu, k_mega, 256, LDS_BYTES);
        if (per_cu > 2) per_cu = 2;
        if (per_cu < 1) per_cu = 1;
        grid_blocks = cus * per_cu;
    }
    (void)hipMemsetAsync(p.BAR(), 0, 4096 * 4, stream);
    void* args[] = {&p, &pr};
    hipError_t e = hipLaunchCooperativeKernel((void*)k_mega, dim3(grid_blocks), dim3(256), args, LDS_BYTES, stream);
    if (e != hipSuccess) fprintf(stderr, "cooperative launch failed: %s (grid %d)\n", hipGetErrorString(e), grid_blocks);
}
#endif
```

```cpp
#ifndef HOST_EMU
#include <hip/hip_runtime.h>
#include <hip/hip_cooperative_groups.h>
#include <cstdio>
#define HD __host__ __device__ __forceinline__
#else
#include <cmath>
#include <cstdio>
#include <cstring>
#define HD inline
#endif
#include <cstdint>
#include <utility>

#ifndef CFG_D
#define CFG_D 1024
#endif
#ifndef CFG_S
#define CFG_S 8192
#endif
#ifndef CFG_L
#define CFG_L 256
#endif
#ifndef CFG_DE
#define CFG_DE 256
#endif
#ifndef CFG_DS
#define CFG_DS 256
#endif
#ifndef PROBE_SEL
#define PROBE_SEL 0
#endif
#ifndef PROBE_MASK
#define PROBE_MASK 0
#endif
#ifndef POST1_NR
#define POST1_NR 4
#endif
#ifndef FUSE_ROUTE
#define FUSE_ROUTE 0
#endif
#ifndef USE_KMOD
#define USE_KMOD 1
#endif
#ifndef USE_RNORM1
#define USE_RNORM1 1
#endif
#ifndef USE_RPOST1
#define USE_RPOST1 1
#endif
#ifndef USE_RPOST2
#define USE_RPOST2 1
#endif

namespace cfg {
constexpr int D = CFG_D, B = 2, S = CFG_S, L = CFG_L, DEPTH = 2, GRID_W = 64;
constexpr int T = B * S, TC = B * L, TA = T + TC;
constexpr int SWA_H = 6, SWA_KVH = 2, SWA_G = 3, SWA_W = 128;
constexpr int GH = 6, GDK = 64, GDV = 64, GCONV = 5;
constexpr int MH = 4, MQR = 192, MKVR = 128, MNOPE = 64, MROPE = 32, MV = 64, MQD = MNOPE + MROPE, MKVD = MNOPE + MV;
constexpr int DMIX = 1024, GQKV = 1152;
constexpr int PO_QA = 0, PO_KA = 384, PO_VA = 512, PO_GQKV = 640, PO_Z = 1792, PO_BA = 2176, PO_CQ = 2200, PO_CKV = 2392, PO_KR = 2528  , PO_KR_SRC = 2520, DPROJ = 2552, DPROJP = 2560;
constexpr int NE = 64, TOPK = 8, NGRP = 8, TOPG = 4, DE = CFG_DE, DS = CFG_DS;
constexpr float EPS = 1e-6f, ROUTED_SCALE = 2.5f;
constexpr int NSLOT = TA * TOPK, NK = S + L, NCHAIN = B * GH * 2, NCH = (S + L) / 64;
constexpr int NSPLIT = (NK / 64) % 4 == 0 ? 4 : ((NK / 64) % 2 == 0 ? 2 : 1);
static_assert(D % 128 == 0 && DE % 64 == 0 && DS % 64 == 0 && TA % 128 == 0 && T % 128 == 0, "tile divisibility");
}
using namespace cfg;

#ifdef HOST_EMU
typedef float st_t;
HD float ldf(const st_t* p) { return *p; }
HD void stf(st_t* p, float v) { *p = v; }
HD void st4(st_t* p, float a, float b, float c, float d) { p[0] = a; p[1] = b; p[2] = c; p[3] = d; }
#else
typedef unsigned short st_t;
typedef short bf16x8 __attribute__((ext_vector_type(8)));
typedef float f32x4 __attribute__((ext_vector_type(4)));
typedef float f32x2 __attribute__((ext_vector_type(2)));
typedef __bf16 bf16x2_t __attribute__((ext_vector_type(2)));
#define LAS __attribute__((address_space(3)))
HD float ldf(const st_t* p) { unsigned u = ((unsigned)*p) << 16; float f; __builtin_memcpy(&f, &u, 4); return f; }
HD unsigned short f2bf(float v) { unsigned u; __builtin_memcpy(&u, &v, 4); u = (u + 0x7fffu + ((u >> 16) & 1u)) >> 16; return (unsigned short)u; }
HD void stf(st_t* p, float v) { *p = f2bf(v); }
HD float ldf(const float* p) { return *p; }
HD void stf(float* p, float v) { *p = v; }
__device__ __forceinline__ unsigned pk_bf16(float lo, float hi) { f32x2 v = {lo, hi}; return __builtin_bit_cast(unsigned, __builtin_convertvector(v, bf16x2_t)); }
HD void st4(st_t* p, float a, float b, float c, float d) {
#if defined(__HIP_DEVICE_COMPILE__)
    uint2 w; w.x = pk_bf16(a, b); w.y = pk_bf16(c, d); *(uint2*)p = w;
#else
    p[0] = f2bf(a); p[1] = f2bf(b); p[2] = f2bf(c); p[3] = f2bf(d);
#endif
}
#endif

HD void st8(st_t* p, const float (&a)[4], const float (&b)[4]) {
#if defined(__HIP_DEVICE_COMPILE__)
    uint4 w; w.x = pk_bf16(a[0], a[1]); w.y = pk_bf16(a[2], a[3]); w.z = pk_bf16(b[0], b[1]); w.w = pk_bf16(b[2], b[3]); *(uint4*)p = w;
#else
    for (int i = 0; i < 4; ++i) { stf(p + i, a[i]); stf(p + 4 + i, b[i]); }
#endif
}
#if defined(__HIP_DEVICE_COMPILE__)
__device__ __forceinline__ float fast_exp(float x) { return __builtin_amdgcn_exp2f(x * 1.4426950408889634f); }
__device__ __forceinline__ float silu_f(float x) { return x * __builtin_amdgcn_rcpf(1.0f + fast_exp(-x)); }
__device__ __forceinline__ float sigmoid_f(float x) { return __builtin_amdgcn_rcpf(1.0f + fast_exp(-x)); }
__device__ __forceinline__ float softplus_f(float x) { return x > 20.f ? x : 0.6931471805599453f * __builtin_amdgcn_logf(1.0f + fast_exp(x)); }
__device__ __forceinline__ float rsqrt_f(float x) { return __builtin_amdgcn_rsqf(x); }
#else
HD float silu_f(float x) { return x / (1.0f + expf(-x)); }
HD float sigmoid_f(float x) { return 1.0f / (1.0f + expf(-x)); }
HD float softplus_f(float x) { return x > 20.f ? x : log1pf(expf(x)); }
HD float rsqrt_f(float x) { return 1.0f / sqrtf(x); }
#endif

struct TJob { const float* src; st_t* dst; int K, N, npad, grp, off, ldt, ldsrc, gran; };
constexpr int NJOBS = 16;

struct WsOff { size_t BAR, MOD, TABA, TABM, XC, BG, LOGITS, EW, EIDX, EPOS, CNT, CNTP, CTR, GAM, TOKLIST, WLIST, H, Wt_in, Wt_out, Wt_uq, Wt_ukv, Wt_sgu, Wt_sd, SACT, ACT, Wt_egu, Wt_ed, CH,
               P, G, CQN, CKVN, MQ, MKV, O, VtM, VtA, OF, OB, YB, OPART, MLPART, BCNT, total; };
constexpr size_t align256(size_t v) { return (v + 255) & ~(size_t)255; }
constexpr WsOff make_ws() {
    WsOff w{}; size_t off = 0; const size_t E = sizeof(st_t);
#define TAKE(name, bytes) w.name = off; off = align256(off + (size_t)(bytes));
    TAKE(BAR, 4096 * 4)
    TAKE(MOD, (size_t)DEPTH * 3 * 6 * D * 4) TAKE(TABA, 128 * 16 * 2 * 4) TAKE(TABM, 128 * 8 * 2 * 4) TAKE(XC, (size_t)TC * D * 4) TAKE(BG, (size_t)TA * 24 * 4)
    TAKE(LOGITS, (size_t)TA * NE * 4) TAKE(EW, (size_t)TA * TOPK * 4) TAKE(EIDX, (size_t)TA * TOPK * 4) TAKE(EPOS, (size_t)TA * TOPK * 4)
    TAKE(BCNT, 1024 * NE * 4)
    TAKE(CNT, DEPTH * NE * 4) TAKE(CNTP, DEPTH * NE * 32 * 4) TAKE(CTR, DEPTH * 16 * 4) TAKE(GAM, (size_t)NCHAIN * NCH * 4) TAKE(TOKLIST, (size_t)NE * TA * 4) TAKE(WLIST, (size_t)NE * TA * 4)
    TAKE(H, (size_t)TA * D * E)
    TAKE(Wt_in, (size_t)DEPTH * DPROJP * D * E) TAKE(Wt_out, (size_t)DEPTH * D * DMIX * E) TAKE(Wt_uq, (size_t)DEPTH * MH * MQD * MQR * E) TAKE(Wt_ukv, (size_t)DEPTH * MH * MKVD * MKVR * E)
    TAKE(Wt_sgu, (size_t)DEPTH * 2 * DS * D * E) TAKE(Wt_sd, (size_t)DEPTH * D * DS * E)
    const size_t q0 = off;
    TAKE(SACT, (size_t)TA * DS * E) TAKE(ACT, ((size_t)NSLOT * DE * E > (size_t)TA * D * E ? (size_t)NSLOT * DE * E : (size_t)TA * D * E))
    TAKE(Wt_egu, (size_t)NE * 2 * DE * D * E) TAKE(Wt_ed, (size_t)NE * D * DE * E)
    w.CH = q0; { const size_t chb = align256((size_t)NCHAIN * NCH * 5 * 4096 * E); if (q0 + chb > off) off = q0 + chb; }
    const size_t r0 = off;
    TAKE(P, (size_t)TA * DPROJP * E) TAKE(G, (size_t)TA * GQKV * E) TAKE(CQN, (size_t)TA * MQR * E) TAKE(CKVN, (size_t)TA * MKVR * E) TAKE(MQ, (size_t)TA * MH * MQD * E) TAKE(MKV, (size_t)TA * MH * MKVD * E)
    TAKE(O, (size_t)TA * DMIX * E) TAKE(VtM, (size_t)B * MH * MV * NK * E) TAKE(VtA, (size_t)B * SWA_KVH * 64 * NK * E) TAKE(OF, (size_t)TA * GH * GDV * E) TAKE(OB, (size_t)TA * GH * GDV * E)
#undef TAKE
    w.YB = r0; { const size_t yb = align256((size_t)NSLOT * D * E); if (r0 + yb > off) off = r0 + yb; }
    if ((size_t)NSPLIT * T * MH * MV * E <= (size_t)TA * D * E) w.OPART = w.H; else { w.OPART = off; off = align256(off + (size_t)NSPLIT * T * MH * MV * E); }
    if ((size_t)NSPLIT * T * MH * 2 * 4 <= (size_t)TA * NE * 4) w.MLPART = w.LOGITS; else { w.MLPART = off; off = align256(off + (size_t)NSPLIT * T * MH * 2 * 4); }
    w.total = off; return w;
}
constexpr WsOff WS = make_ws();

struct Params {
    const float *x, *c, *ctx, *c_ctx, *ada_w, *ada_b, *mix_norm_pre, *mix_norm_post, *ffn_norm_pre, *ffn_norm_post,
        *w_in, *w_out, *swa_sink, *gdn_conv_w, *gdn_a_log, *gdn_dt_bias, *gdn_norm_w, *mla_q_norm, *mla_w_uq, *mla_kv_norm, *mla_w_ukv,
        *router_w, *router_bias, *e_gate, *e_up, *e_down, *s_gate, *s_up, *s_down;
    float* out;
    char* ws;
#define WSF(T, name, field) HD T* name() const { return (T*)(ws + WS.field); }
    WSF(unsigned, BAR, BAR) WSF(float, MOD, MOD) WSF(float, TABA, TABA) WSF(float, TABM, TABM) WSF(float, XC, XC) WSF(float, BG, BG) WSF(float, LOGITS, LOGITS) WSF(float, EW, EW)
    WSF(int, EIDX, EIDX) WSF(int, EPOS, EPOS) WSF(int, CNT, CNT) WSF(int, CNTP, CNTP) WSF(int, CTR, CTR) WSF(float, GAM, GAM) WSF(int, TOKLIST, TOKLIST) WSF(float, WLIST, WLIST)
    WSF(st_t, H, H) WSF(st_t, SH, H) WSF(st_t, Wt_in, Wt_in) WSF(st_t, Wt_out, Wt_out) WSF(st_t, Wt_uq, Wt_uq) WSF(st_t, Wt_ukv, Wt_ukv) WSF(st_t, Wt_sgu, Wt_sgu) WSF(st_t, Wt_sd, Wt_sd)
    WSF(st_t, SACT, SACT) WSF(st_t, ACT, ACT) WSF(st_t, Y, ACT) WSF(st_t, Wt_egu, Wt_egu) WSF(st_t, Wt_ed, Wt_ed) WSF(st_t, CH, CH)
    WSF(st_t, P, P) WSF(st_t, G, G) WSF(st_t, CQN, CQN) WSF(st_t, CKVN, CKVN) WSF(st_t, MQ, MQ) WSF(st_t, MKV, MKV) WSF(st_t, O, O) WSF(st_t, VtM, VtM) WSF(st_t, VtA, VtA)
    WSF(st_t, OF, OF) WSF(st_t, OB, OB) WSF(st_t, YB, YB)
    WSF(st_t, OPART, OPART) WSF(float, MLPART, MLPART) WSF(int, BCNT, BCNT)
#undef WSF
};
inline size_t carve(Params& p, char* ws) { p.ws = ws; return WS.total; }

HD TJob static_job(const Params& p, int j) {
    const int l = j / (NJOBS / DEPTH), k = j % (NJOBS / DEPTH);
    switch (k) {
    case 0: return TJob{p.w_in + (size_t)l * D * DPROJ, p.Wt_in() + (size_t)l * DPROJP * D, D, PO_KR_SRC, PO_KR, 16, 0, D, DPROJ, 16};
    case 1: return TJob{p.w_in + (size_t)l * D * DPROJ + PO_KR_SRC, p.Wt_in() + (size_t)l * DPROJP * D + (size_t)PO_KR * D, D, MROPE, MROPE, 16, 0, D, DPROJ, 16};
    case 2: return TJob{p.w_out + (size_t)l * DMIX * D, p.Wt_out() + (size_t)l * D * DMIX, DMIX, D, D, 16, 0, DMIX, D, 16};
    case 3: return TJob{p.mla_w_uq + (size_t)l * MQR * MH * MQD, p.Wt_uq() + (size_t)l * MH * MQD * MQR, MQR, MH * MQD, MH * MQD, 16, 0, MQR, MH * MQD, 16};
    case 4: return TJob{p.mla_w_ukv + (size_t)l * MKVR * MH * MKVD, p.Wt_ukv() + (size_t)l * MH * MKVD * MKVR, MKVR, MH * MKVD, MH * MKVD, 16, 0, MKVR, MH * MKVD, 16};
    case 5: return TJob{p.s_gate + (size_t)l * D * DS, p.Wt_sgu() + (size_t)l * 2 * DS * D, D, DS, DS, 8, 0, D, DS, 4};
    case 6: return TJob{p.s_up + (size_t)l * D * DS, p.Wt_sgu() + (size_t)l * 2 * DS * D, D, DS, DS, 8, 4, D, DS, 4};
    default: return TJob{p.s_down + (size_t)l * DS * D, p.Wt_sd() + (size_t)l * D * DS, DS, D, D, 16, 0, DS, D, 16};
    }
}
HD long long static_job_items(int j) {
    const int k = j % (NJOBS / DEPTH);
    const int K = k == 2 ? DMIX : k == 3 ? MQR : k == 4 ? MKVR : k == 7 ? DS : D;
    const int npad = k == 0 ? PO_KR : k == 1 ? MROPE : k == 2 ? D : k == 3 ? MH * MQD : k == 4 ? MH * MKVD : k == 7 ? D : DS;
    return (long long)(K / 64) * ((npad + 31) / 32);
}

HD int mod_which(int r) { return r < T ? r / S : 2; }
HD const float* mod_vec(const Params& p, int layer, int r, int chunk) { return p.MOD() + ((size_t)(layer * 3 + mod_which(r)) * 6 + chunk) * D; }
HD void seq_bounds(int r, int& lo, int& hi) { if (r < T) { lo = (r / S) * S; hi = lo + S; } else { lo = T + ((r - T) / L) * L; hi = lo + L; } }
HD float* xrow(const Params& p, int r) { return r < T ? p.out + (size_t)r * D : p.XC() + (size_t)(r - T) * D; }
HD const float* xin_row(const Params& p, int layer, int r) { if (layer > 0) return xrow(p, r); return r < T ? p.x + (size_t)r * D : p.ctx + (size_t)(r - T) * D; }
HD int rows_out(int layer) { return layer == DEPTH - 1 ? T : TA; }
HD int expert_base(const int* cnt, int e) { int b = 0; for (int i = 0; i < e; ++i) b += cnt[i]; return b; }

#ifdef HOST_EMU
inline int atomic_inc(int* p) { int v;
#pragma omp atomic capture
    { v = *p; *p += 1; }
    return v; }
#else
__device__ __forceinline__ int atomic_inc(int* p) { return atomicAdd(p, 1); }
#endif

enum Stage { ST_MOD = 0, ST_ZERO, ST_NORM1, ST_ROPE_SWA, ST_GDN_CONV, ST_GDN_L2, ST_GDN_GATE, ST_MLA_NORM, ST_ROPE_MLA,
             ST_SWA, ST_GDN_SCAN, ST_GDN_OUT, ST_MLA, ST_POST1, ST_ROUTER, ST_ROUTE, ST_POST2, ST_VT, ST_TAB, ST_COUNT };

HD long long n_items(int st, int layer) {
    switch (st) {
    case ST_MOD: return (long long)DEPTH * 3 * 6 * D;
    case ST_ZERO: return DEPTH * NE + DEPTH * 16 + DEPTH * NE * 32;
    case ST_VT: return (long long)(B * MH + B * SWA_KVH) * (NK / 8) * 64;
    case ST_TAB: return 128 * 16 + 128 * 8;
    case ST_NORM1: return TA;
    case ST_ROPE_SWA: return (long long)T * 8 * 32;
    case ST_GDN_CONV: return (long long)TA * GQKV;
    case ST_GDN_L2: return (long long)TA * 12;
    case ST_GDN_GATE: return (long long)TA * 12;
    case ST_MLA_NORM: return (long long)TA * 2;
    case ST_ROPE_MLA: return (long long)T * 5 * 16;
    case ST_SWA: return (long long)rows_out(layer) * SWA_H;
    case ST_GDN_SCAN: return (long long)B * GH * 2 * GDV;
    case ST_GDN_OUT: return (long long)rows_out(layer) * GH;
    case ST_MLA: return (long long)rows_out(layer) * MH;
    case ST_POST1: return rows_out(layer);
    case ST_ROUTER: return (long long)rows_out(layer) * NE;
    case ST_ROUTE: return rows_out(layer);
    case ST_POST2: return rows_out(layer);
    }
    return 0;
}

HD float rope_inv(int i, int n) { return exp2f(-(float)i / (float)n * 13.287712379549449f); }

HD void run_item(const Params& p, int st, int layer, long long i) {
    switch (st) {
    case ST_MOD: {
        const int j = (int)(i % (6 * D)); const int w = (int)((i / (6 * D)) % 3); const int ly = (int)(i / (6 * D * 3));
        const float* cv = w < 2 ? p.c + (size_t)w * D : p.c_ctx;
        const float* W = p.ada_w + (size_t)ly * D * 6 * D;
        float acc = p.ada_b[(size_t)ly * 6 * D + j];
        for (int k = 0; k < D; ++k) acc += silu_f(cv[k]) * W[(size_t)k * 6 * D + j];
        p.MOD()[i] = acc;
    } break;
    case ST_ZERO: if (i < DEPTH * NE) p.CNT()[i] = 0; else if (i < DEPTH * NE + DEPTH * 16) p.CTR()[i - DEPTH * NE] = 0; else p.CNTP()[i - DEPTH * NE - DEPTH * 16] = 0; break;
    case ST_TAB: {
        if (i < 128 * 16) { const int pos = (int)(i / 16), ii = (int)(i % 16); const float ang = (float)pos * rope_inv(ii, 16); p.TABA()[2 * i] = cosf(ang); p.TABA()[2 * i + 1] = sinf(ang); }
        else { const long long k = i - 128 * 16; const int pos = (int)(k / 8), ii = (int)(k % 8); const float ang = (float)pos * rope_inv(ii, 8); p.TABM()[2 * k] = cosf(ang); p.TABM()[2 * k + 1] = sinf(ang); }
    } break;
    case ST_VT: {
        const int dv = (int)(i % 64); long long r = i / 64; const int kc = (int)(r % (NK / 8)); const int bh = (int)(r / (NK / 8));
        const bool mla = bh < B * MH; const int b = mla ? bh / MH : (bh - B * MH) / SWA_KVH, hd = mla ? bh % MH : (bh - B * MH) % SWA_KVH;
        st_t* dst = (mla ? p.VtM() + ((size_t)(b * MH + hd) * 64 + dv) * NK : p.VtA() + ((size_t)(b * SWA_KVH + hd) * 64 + dv) * NK) + kc * 8;
        for (int j = 0; j < 8; ++j) { const int kidx = kc * 8 + j; const int row = kidx < S ? b * S + kidx : T + b * L + (kidx - S);
            dst[j] = mla ? p.MKV()[(size_t)row * MH * MKVD + hd * MKVD + MNOPE + dv] : p.P()[(size_t)row * DPROJP + PO_VA + hd * 64 + dv]; }
    } break;
    case ST_NORM1: {
        const int r = (int)i; const float* xr = xin_row(p, layer, r); float ss = 0.f;
        for (int d = 0; d < D; ++d) ss += xr[d] * xr[d];
        const float rstd = 1.0f / sqrtf(ss / D + EPS);
        const float* gain = p.mix_norm_pre + (size_t)layer * D; const float* sh = mod_vec(p, layer, r, 0); const float* sc = mod_vec(p, layer, r, 1);
        st_t* hr = p.H() + (size_t)r * D;
        for (int d = 0; d < D; ++d) stf(hr + d, xr[d] * rstd * gain[d] * (1.0f + sc[d]) + sh[d]);
    } break;
    case ST_ROPE_SWA: {
        const int j = (int)(i % 32), hh = (int)((i / 32) % 8), r = (int)(i / 256);
        const int s = r % S, rp = s / GRID_W, cp = s % GRID_W;
        const int base = hh < 6 ? PO_QA + hh * 64 : PO_KA + (hh - 6) * 64;
        const int half = j / 16, ii = j % 16; const int i1 = base + half * 32 + ii, i2 = i1 + 16;
        const float ang = (float)(half == 0 ? rp : cp) * rope_inv(ii, 16); const float cs = cosf(ang), sn = sinf(ang);
        st_t* pr = p.P() + (size_t)r * DPROJP; const float x1 = ldf(pr + i1), x2 = ldf(pr + i2);
        stf(pr + i1, x1 * cs - x2 * sn); stf(pr + i2, x1 * sn + x2 * cs);
    } break;
    case ST_GDN_CONV: {
        const int cc = (int)(i % GQKV), r = (int)(i / GQKV); int lo, hi; seq_bounds(r, lo, hi);
        const float* w = p.gdn_conv_w + (size_t)layer * GCONV * GQKV; float acc = 0.f;
        for (int j = 0; j < GCONV; ++j) { const int rr = r + j - 2; if (rr >= lo && rr < hi) acc += w[j * GQKV + cc] * ldf(p.P() + (size_t)rr * DPROJP + PO_GQKV + cc); }
        stf(p.G() + (size_t)r * GQKV + cc, silu_f(acc));
    } break;
    case ST_GDN_L2: {
        const int hh = (int)(i % 12), r = (int)(i / 12); st_t* g = p.G() + (size_t)r * GQKV + hh * 64; float ss = 0.f;
        for (int d = 0; d < 64; ++d) { const float v = ldf(g + d); ss += v * v; }
        const float rn = 1.0f / sqrtf(ss + EPS);
        for (int d = 0; d < 64; ++d) stf(g + d, ldf(g + d) * rn);
    } break;
    case ST_GDN_GATE: {
        const int j = (int)(i % 12), r = (int)(i / 12); const st_t* pr = p.P() + (size_t)r * DPROJP + PO_BA;
        const float beta = sigmoid_f(ldf(pr + j)); const float a = ldf(pr + 12 + j);
        const float g = -expf(p.gdn_a_log[layer * 12 + j]) * softplus_f(a + p.gdn_dt_bias[layer * 12 + j]);
        p.BG()[(size_t)r * 24 + j] = beta; p.BG()[(size_t)r * 24 + 12 + j] = g;
    } break;
    case ST_MLA_NORM: {
        const int w = (int)(i % 2), r = (int)(i / 2);
        const int n = w == 0 ? MQR : MKVR; const st_t* src = p.P() + (size_t)r * DPROJP + (w == 0 ? PO_CQ : PO_CKV);
        const float* gain = w == 0 ? p.mla_q_norm + (size_t)layer * MQR : p.mla_kv_norm + (size_t)layer * MKVR;
        st_t* dst = w == 0 ? p.CQN() + (size_t)r * MQR : p.CKVN() + (size_t)r * MKVR; float ss = 0.f;
        for (int d = 0; d < n; ++d) { const float v = ldf(src + d); ss += v * v; }
        const float rstd = 1.0f / sqrtf(ss / n + EPS);
        for (int d = 0; d < n; ++d) stf(dst + d, ldf(src + d) * rstd * gain[d]);
    } break;
    case ST_ROPE_MLA: {
        const int j = (int)(i % 16), w = (int)((i / 16) % 5), r = (int)(i / 80);
        const int s = r % S, rp = s / GRID_W, cp = s % GRID_W;
        const int half = j / 8, ii = j % 8; const float ang = (float)(half == 0 ? rp : cp) * rope_inv(ii, 8); const float cs = cosf(ang), sn = sinf(ang);
        st_t* q = w < 4 ? p.MQ() + (size_t)r * MH * MQD + w * MQD + MNOPE + half * 16 + ii : p.P() + (size_t)r * DPROJP + PO_KR + half * 16 + ii;
        const float x1 = ldf(q), x2 = ldf(q + 8); stf(q, x1 * cs - x2 * sn); stf(q + 8, x1 * sn + x2 * cs);
    } break;
    case ST_SWA: {
        const int h = (int)(i % SWA_H), r = (int)(i / SWA_H); const int kvh = h / SWA_G;
        float q[64], acc[64]; const st_t* qp = p.P() + (size_t)r * DPROJP + PO_QA + h * 64;
        _Pragma("unroll") for (int d = 0; d < 64; ++d) { q[d] = ldf(qp + d) * 0.125f; acc[d] = 0.f; }
        float m = p.swa_sink[layer * SWA_H + h], den = 1.0f;
        int b, klo = 0, khi = 0;
        if (r < T) { b = r / S; const int s = r % S; klo = s - SWA_W < 0 ? 0 : s - SWA_W; khi = s + SWA_W > S - 1 ? S - 1 : s + SWA_W; } else { b = (r - T) / L; khi = -1; }
        const int nloc = khi - klo + 1;
        for (int t = 0; t < nloc + L; ++t) {
            const int kr = t < nloc ? b * S + klo + t : T + b * L + (t - nloc);
            const st_t* kp = p.P() + (size_t)kr * DPROJP + PO_KA + kvh * 64; const st_t* vp = p.P() + (size_t)kr * DPROJP + PO_VA + kvh * 64;
            float sc = 0.f; _Pragma("unroll") for (int d = 0; d < 64; ++d) sc += q[d] * ldf(kp + d);
            if (sc > m) { const float f = expf(m - sc); den *= f; _Pragma("unroll") for (int d = 0; d < 64; ++d) acc[d] *= f; m = sc; }
            const float pe = expf(sc - m); den += pe;
            _Pragma("unroll") for (int d = 0; d < 64; ++d) acc[d] += pe * ldf(vp + d);
        }
        const float inv = 1.0f / den; st_t* o = p.O() + (size_t)r * DMIX + h * 64;
        _Pragma("unroll") for (int d = 0; d < 64; ++d) stf(o + d, acc[d] * inv);
    } break;
    case ST_GDN_SCAN: {
        const int e = (int)(i % GDV), dir = (int)((i / GDV) % 2), h = (int)((i / (GDV * 2)) % GH), b = (int)(i / (GDV * 2 * GH));
        float s[64]; _Pragma("unroll") for (int d = 0; d < 64; ++d) s[d] = 0.f;
        st_t* dst = dir == 0 ? p.OF() : p.OB();
        for (int t = 0; t < L + S; ++t) {
            int r; if (t < L) r = T + b * L + (dir == 0 ? t : L - 1 - t); else { const int u = t - L; r = b * S + (dir == 0 ? u : S - 1 - u); }
            const st_t* g = p.G() + (size_t)r * GQKV; const st_t* qv = g + h * 64; const st_t* kv = g + 384 + h * 64; const float v = ldf(g + 768 + h * 64 + e);
            const float beta = p.BG()[(size_t)r * 24 + dir * 6 + h], alpha = expf(p.BG()[(size_t)r * 24 + 12 + dir * 6 + h]);
            float ks = 0.f; _Pragma("unroll") for (int d = 0; d < 64; ++d) { s[d] *= alpha; ks += ldf(kv + d) * s[d]; }
            const float vn = beta * (v - ks); float o = 0.f;
            _Pragma("unroll") for (int d = 0; d < 64; ++d) { s[d] += ldf(kv + d) * vn; o += ldf(qv + d) * s[d]; }
            stf(dst + (size_t)r * (GH * GDV) + h * 64 + e, o * 0.125f);
        }
    } break;
    case ST_GDN_OUT: {
        const int h = (int)(i % GH), r = (int)(i / GH); const st_t* of = p.OF() + (size_t)r * 384 + h * 64; const st_t* ob = p.OB() + (size_t)r * 384 + h * 64;
        float ss = 0.f; for (int d = 0; d < 64; ++d) { const float o = ldf(of + d) + ldf(ob + d); ss += o * o; }
        const float rstd = 1.0f / sqrtf(ss / 64 + EPS); const float* nw = p.gdn_norm_w + layer * 64; const st_t* z = p.P() + (size_t)r * DPROJP + PO_Z + h * 64;
        st_t* o = p.O() + (size_t)r * DMIX + 384 + h * 64;
        for (int d = 0; d < 64; ++d) stf(o + d, (ldf(of + d) + ldf(ob + d)) * rstd * nw[d] * silu_f(ldf(z + d)));
    } break;
    case ST_MLA: {
        const int h = (int)(i % MH), r = (int)(i / MH); const float scale = 1.0f / sqrtf((float)MQD);
        float acc[64]; const st_t* qp = p.MQ() + (size_t)r * MH * MQD + h * MQD;
        _Pragma("unroll") for (int d = 0; d < 64; ++d) acc[d] = 0.f;
        float m = -1e30f, den = 0.f; int b, nlat;
        if (r < T) { b = r / S; nlat = S; } else { b = (r - T) / L; nlat = 0; }
        for (int t = 0; t < nlat + L; ++t) {
            const int kr = t < nlat ? b * S + t : T + b * L + (t - nlat);
            const st_t* kn = p.MKV() + (size_t)kr * MH * MKVD + h * MKVD; const st_t* krp = p.P() + (size_t)kr * DPROJP + PO_KR;
            float sc = 0.f; for (int d = 0; d < 64; ++d) sc += ldf(qp + d) * ldf(kn + d);
            for (int d = 0; d < 32; ++d) sc += ldf(qp + 64 + d) * ldf(krp + d);
            sc *= scale;
            if (sc > m) { const float f = expf(m - sc); den *= f; _Pragma("unroll") for (int d = 0; d < 64; ++d) acc[d] *= f; m = sc; }
            const float pe = expf(sc - m); den += pe;
            _Pragma("unroll") for (int d = 0; d < 64; ++d) acc[d] += pe * ldf(kn + 64 + d);
        }
        const float inv = 1.0f / den; st_t* o = p.O() + (size_t)r * DMIX + 768 + h * 64;
        _Pragma("unroll") for (int d = 0; d < 64; ++d) stf(o + d, acc[d] * inv);
    } break;
    case ST_POST1: {
        const int r = (int)i; const st_t* y = p.Y() + (size_t)r * D; const float* xi = xin_row(p, layer, r); float* xr = xrow(p, r); float ss = 0.f;
        for (int d = 0; d < D; ++d) { const float v = ldf(y + d); ss += v * v; }
        const float rstd = 1.0f / sqrtf(ss / D + EPS); const float* gp = p.mix_norm_post + (size_t)layer * D; const float* g1 = mod_vec(p, layer, r, 2);
        float s2 = 0.f;
        for (int d = 0; d < D; ++d) { const float v = xi[d] + g1[d] * ldf(y + d) * rstd * gp[d]; xr[d] = v; s2 += v * v; }
        const float r2 = 1.0f / sqrtf(s2 / D + EPS); const float* gf = p.ffn_norm_pre + (size_t)layer * D; const float* sh = mod_vec(p, layer, r, 3); const float* sc = mod_vec(p, layer, r, 4);
        st_t* hr = p.H() + (size_t)r * D;
        for (int d = 0; d < D; ++d) stf(hr + d, xr[d] * r2 * gf[d] * (1.0f + sc[d]) + sh[d]);
    } break;
    case ST_ROUTER: {
        const int n = (int)(i % NE), r = (int)(i / NE); const st_t* a = p.H() + (size_t)r * D; const float* b = p.router_w + (size_t)layer * D * NE + n; float acc = 0.f;
        for (int k = 0; k < D; ++k) acc += ldf(a + k) * b[(size_t)k * NE];
        p.LOGITS()[(size_t)r * NE + n] = acc;
    } break;
    case ST_ROUTE: {
        const int r = (int)i; const float* lg = p.LOGITS() + (size_t)r * NE; const float* bias = p.router_bias + (size_t)layer * NE;
        float gs[NGRP];
        _Pragma("unroll") for (int g = 0; g < NGRP; ++g) { float m1 = -1e30f, m2 = -1e30f; for (int j = 0; j < 8; ++j) { const float v = sigmoid_f(lg[g * 8 + j]) + bias[g * 8 + j]; if (v > m1) { m2 = m1; m1 = v; } else if (v > m2) m2 = v; } gs[g] = m1 + m2; }
        unsigned gmask = 0;
        _Pragma("unroll") for (int k = 0; k < TOPG; ++k) { int best = 0; float bv = -1e30f; _Pragma("unroll") for (int g = 0; g < NGRP; ++g) if (!((gmask >> g) & 1u) && gs[g] > bv) { bv = gs[g]; best = g; } gmask |= 1u << best; }
        unsigned long long used = 0ull; float wsum = 0.f; float wv[TOPK]; int wi[TOPK];
        _Pragma("unroll") for (int k = 0; k < TOPK; ++k) { int best = 0; float bv = -1e30f;
            for (int e = 0; e < NE; ++e) if (((gmask >> (e / 8)) & 1u) && !((used >> e) & 1ull)) { const float v = sigmoid_f(lg[e]) + bias[e]; if (v > bv) { bv = v; best = e; } }
            used |= 1ull << best; wi[k] = best; wv[k] = sigmoid_f(lg[best]); wsum += wv[k]; }
        int* cnt = p.CNT() + layer * NE;
        _Pragma("unroll") for (int k = 0; k < TOPK; ++k) { const float w = wv[k] / wsum * ROUTED_SCALE; const int e = wi[k]; const int pos = atomic_inc(cnt + e);
            p.EIDX()[(size_t)r * TOPK + k] = e; p.EW()[(size_t)r * TOPK + k] = w; p.EPOS()[(size_t)r * TOPK + k] = pos; p.TOKLIST()[(size_t)e * TA + pos] = r; p.WLIST()[(size_t)e * TA + pos] = w; }
    } break;
    case ST_POST2: {
        const int r = (int)i; float* xr = xrow(p, r); const int* cnt = p.CNT() + layer * NE; const st_t* f[TOPK + 1]; f[0] = p.SH() + (size_t)r * D;
        _Pragma("unroll") for (int k = 0; k < TOPK; ++k) { const int e = p.EIDX()[(size_t)r * TOPK + k]; f[k + 1] = p.YB() + (size_t)(expert_base(cnt, e) + p.EPOS()[(size_t)r * TOPK + k]) * D; }
        float ss = 0.f;
        for (int d = 0; d < D; ++d) { float v = 0.f; _Pragma("unroll") for (int k = 0; k <= TOPK; ++k) v += ldf(f[k] + d); ss += v * v; }
        const float rstd = 1.0f / sqrtf(ss / D + EPS); const float* gp = p.ffn_norm_post + (size_t)layer * D; const float* g2 = mod_vec(p, layer, r, 5);
        for (int d = 0; d < D; ++d) { float v = 0.f; _Pragma("unroll") for (int k = 0; k <= TOPK; ++k) v += ldf(f[k] + d); xr[d] = xr[d] + g2[d] * v * rstd * gp[d]; }
    } break;
    }
}

enum { WT_STATIC = 0, WT_EXPERT = 1 };
HD long long wt_items(const Params& p, int kind) {
    if (kind == WT_STATIC) { long long n = 0; for (int j = 0; j < NJOBS; ++j) n += static_job_items(j); return n; }
    return (long long)NE * ((D / 64) * (DE / 32) * 2 + (DE / 64) * (D / 32));
}
HD bool wt_job(const Params& p, int kind, int layer, long long item, TJob& jb, int& kb, int& nb) {
    if (kind == WT_STATIC) {
        for (int j = 0; j < NJOBS; ++j) { const long long n = static_job_items(j); if (item < n) { jb = static_job(p, j); const int nblk = (jb.npad + 31) / 32; kb = (int)(item / nblk); nb = (int)(item % nblk); return true; } item -= n; }
        return false;
    }
    const int per_gu = (D / 64) * (DE / 32), per_d = (DE / 64) * (D / 32), per_e = 2 * per_gu + per_d;
    const int e = (int)(item / per_e); int r = (int)(item % per_e);
    if (r < 2 * per_gu) { const int w = r / per_gu; r %= per_gu; const float* src = (w == 0 ? p.e_gate : p.e_up) + ((size_t)layer * NE + e) * D * DE;
        jb = {src, p.Wt_egu() + (size_t)e * 2 * DE * D, D, DE, DE, 8, w * 4, D, DE, 4};   kb = r / (DE / 32); nb = r % (DE / 32); }
    else { r -= 2 * per_gu; jb = {p.e_down + ((size_t)layer * NE + e) * DE * D, p.Wt_ed() + (size_t)e * D * DE, DE, D, D, 16, 0, DE, D, 16}; kb = r / (D / 32); nb = r % (D / 32); }
    return true;
}
HD size_t wt_dst_row(const TJob& jb, int n) { return (size_t)(n / jb.gran) * jb.grp + (n % jb.gran) + jb.off; }
#ifdef HOST_EMU
inline void wt_item_host(const Params& p, int kind, int layer, long long item) {
    TJob jb; int kb, nb; if (!wt_job(p, kind, layer, item, jb, kb, nb)) return;
    for (int n = nb * 32; n < nb * 32 + 32 && n < jb.npad; ++n) for (int k = kb * 64; k < kb * 64 + 64; ++k)
        jb.dst[wt_dst_row(jb, n) * jb.ldt + k] = n < jb.N ? jb.src[(size_t)k * jb.ldsrc + n] : 0.f;
}
#else
__device__ __forceinline__ void wt_item_dev(const Params& p, int kind, int layer, long long item, LAS float* scr, int lane) {
    TJob jb; int kb, nb; if (!wt_job(p, kind, layer, item, jb, kb, nb)) return;
    const int k0 = kb * 64, n0 = nb * 32;
    { float tmp[32]; const int n = n0 + (lane & 31); const float* sp = jb.src + (size_t)(k0 + (lane >> 5)) * jb.ldsrc + n;
      if (n < jb.N) {
#pragma unroll
          for (int i = 0; i < 32; ++i) tmp[i] = sp[(size_t)(2 * i) * jb.ldsrc];
      } else {
#pragma unroll
          for (int i = 0; i < 32; ++i) tmp[i] = 0.f; }
#pragma unroll
      for (int i = 0; i < 32; ++i) scr[(2 * i + (lane >> 5)) * 33 + (lane & 31)] = tmp[i]; }
    asm volatile("s_waitcnt lgkmcnt(0)" ::: "memory");
    const int c = lane & 7;
#pragma unroll
    for (int j = 0; j < 4; ++j) { const int nl = (lane >> 3) + 8 * j, n = n0 + nl; const LAS float* s = scr + (8 * c) * 33 + nl;
        if (n < jb.npad) { uint4 o; o.x = pk_bf16(s[0 * 33], s[1 * 33]); o.y = pk_bf16(s[2 * 33], s[3 * 33]); o.z = pk_bf16(s[4 * 33], s[5 * 33]); o.w = pk_bf16(s[6 * 33], s[7 * 33]);
            *(uint4*)(jb.dst + wt_dst_row(jb, n) * jb.ldt + k0 + 8 * c) = o; } }
    asm volatile("s_waitcnt lgkmcnt(0)" ::: "memory");
}
#endif

enum { EPI_BF16 = 0, EPI_SWIGLU = 1, EPI_SCALE = 2, EPI_PROJ = 3, EPI_UQ = 4, EPI_UKV = 5 };
enum GStage { G_PROJ = 0, G_UQ, G_UKV, G_WOUT, G_SGU, G_SDOWN, G_EGU, G_EDOWN };
struct GemmDesc {
    const st_t* A; int lda; const int* rowidx; int a_row0, nrows;
    const st_t* Bt; int ldb, K, n0;
    int epi; st_t* out; int ldc; long long out_row0; const float* rowscale;
    const float* tab; st_t* vt;
    int perm;
};
HD int cdiv(int a, int b) { return (a + b - 1) / b; }
struct ETab { const int* eb; const int* tb; };
HD int gemm_ntiles(const Params& p, int gs, int layer, ETab et = ETab{nullptr, nullptr}) {
    const int mt = rows_out(layer) / 128;
    switch (gs) {
    case G_PROJ: return (TA / 128) * (DPROJP / 128);
    case G_UQ: return (TA / 128) * (MH * MQD / 128);
    case G_UKV: return (TA / 128) * (MH * MKVD / 128);
    case G_WOUT: return mt * (D / 128);
    case G_SGU: return mt * (2 * DS / 128);
    case G_SDOWN: return mt * (D / 128);
    case G_EGU: case G_EDOWN: { int t = 0; if (et.tb) t = et.tb[NE]; else for (int e = 0; e < NE; ++e) t += cdiv(p.CNT()[layer * NE + e], 128); return t * (gs == G_EGU ? 2 * DE / 128 : D / 128); }
    }
    return 0;
}
HD void gemm_desc(const Params& p, int gs, int layer, int item, GemmDesc& g, ETab et = ETab{nullptr, nullptr}) {
    g.rowidx = nullptr; g.rowscale = nullptr; g.nrows = 128; g.epi = EPI_BF16; g.tab = nullptr; g.vt = nullptr; g.perm = (gs == G_WOUT || gs == G_SGU || gs == G_SDOWN || gs == G_EGU || gs == G_EDOWN) ? 1 : 0;
    auto plain = [&](const st_t* A, int lda, const st_t* Bt, int K, int ntn, st_t* out, int ldc) {
        const int mtn = (gs == G_PROJ || gs == G_UQ || gs == G_UKV ? TA : rows_out(layer)) / 128, PW = ntn < 8 ? ntn : 8, nfull = ntn / PW;
        int mt, nt; { const int pidx = item / (mtn * PW); if (pidx < nfull) { const int w = item - pidx * mtn * PW; mt = w / PW; nt = pidx * PW + w % PW; } else { const int pw = ntn - nfull * PW, w = item - nfull * mtn * PW; mt = w / pw; nt = nfull * PW + w % pw; } }
        g.A = A; g.lda = lda; g.a_row0 = mt * 128; g.Bt = Bt; g.ldb = K; g.K = K; g.n0 = nt * 128; g.out = out; g.ldc = ldc; g.out_row0 = mt * 128; };
    switch (gs) {
    case G_PROJ: plain(p.H(), D, p.Wt_in() + (size_t)layer * DPROJP * D, D, DPROJP / 128, p.P(), DPROJP); g.epi = EPI_PROJ; g.tab = g.n0 + 128 > PO_KR ? p.TABM() : p.TABA(); g.vt = p.VtA(); break;
    case G_UQ: plain(p.CQN(), MQR, p.Wt_uq() + (size_t)layer * MH * MQD * MQR, MQR, MH * MQD / 128, p.MQ(), MH * MQD); g.epi = EPI_UQ; g.tab = p.TABM(); break;
    case G_UKV: plain(p.CKVN(), MKVR, p.Wt_ukv() + (size_t)layer * MH * MKVD * MKVR, MKVR, MH * MKVD / 128, p.MKV(), MH * MKVD); g.epi = EPI_UKV; g.vt = p.VtM(); break;
    case G_WOUT: plain(p.O(), DMIX, p.Wt_out() + (size_t)layer * D * DMIX, DMIX, D / 128, p.Y(), D); break;
    case G_SGU: plain(p.H(), D, p.Wt_sgu() + (size_t)layer * 2 * DS * D, D, 2 * DS / 128, p.SACT(), DS); g.epi = EPI_SWIGLU; break;
    case G_SDOWN: plain(p.SACT(), DS, p.Wt_sd() + (size_t)layer * D * DS, DS, D / 128, p.SH(), D); break;
    case G_EGU: case G_EDOWN: {
        const int ntn = gs == G_EGU ? 2 * DE / 128 : D / 128; int mt = item / ntn; const int nt = item % ntn; const int* cnt = p.CNT() + layer * NE;
        int e = 0, base = 0;
        if (et.tb) { int lo = 0, hi = NE - 1; while (lo < hi) { const int mid = (lo + hi + 1) >> 1; if (et.tb[mid] <= mt) lo = mid; else hi = mid - 1; } e = lo; mt -= et.tb[e]; base = et.eb[e]; }
        else for (; e < NE; ++e) { const int te = cdiv(cnt[e], 128); if (mt < te) break; mt -= te; base += cnt[e]; }
        g.a_row0 = mt * 128; g.nrows = cnt[e] - mt * 128 < 128 ? cnt[e] - mt * 128 : 128; g.n0 = nt * 128; g.out_row0 = base + mt * 128;
        if (gs == G_EGU) { g.A = p.H(); g.lda = D; g.rowidx = p.TOKLIST() + (size_t)e * TA; g.Bt = p.Wt_egu() + (size_t)e * 2 * DE * D; g.ldb = D; g.K = D; g.epi = EPI_SWIGLU; g.out = p.ACT(); g.ldc = DE; }
        else { g.A = p.ACT() + (size_t)base * DE; g.lda = DE; g.Bt = p.Wt_ed() + (size_t)e * D * DE; g.ldb = DE; g.K = DE; g.epi = EPI_SCALE; g.out = p.YB(); g.ldc = D; g.rowscale = p.WLIST() + (size_t)e * TA - base; }
    } break;
    }
}
HD bool epi_needs_partner(const GemmDesc& g, int cb) { return g.epi == EPI_UQ || (g.epi == EPI_PROJ && g.n0 + cb + 64 > PO_KR); }
HD void rope8(float (&v)[4], const float (&pv)[4], int q, const float* tab, int pos) {
    for (int r = 0; r < 4; ++r) { const int c16 = q * 4 + r, i = c16 & 7; const float cs = tab[(pos * 8 + i) * 2], sn = tab[(pos * 8 + i) * 2 + 1];
        v[r] = c16 < 8 ? v[r] * cs - pv[r] * sn : pv[r] * sn + v[r] * cs; }
}
HD void gemm_epi(const GemmDesc& g, int rl, int cb, int q, float (&v)[4][4], const float (&pv)[4][4]) {
    if (rl >= g.nrows) return;
    const long long orow = g.out_row0 + rl;
    if (g.perm) {
        if (g.epi == EPI_SWIGLU) { float a[2][4]; for (int jj = 0; jj < 2; ++jj) for (int r = 0; r < 4; ++r) a[jj][r] = silu_f(v[2 * jj][r]) * v[2 * jj + 1][r];
            st8(g.out + (size_t)orow * g.ldc + (g.n0 + cb + 16 * q) / 2, a[0], a[1]); return; }
        const float w = g.epi == EPI_SCALE ? g.rowscale[orow] : 1.0f;
        for (int j = 0; j < 4; ++j) for (int r = 0; r < 4; ++r) v[j][r] *= w;
        st_t* o = g.out + (size_t)orow * g.ldc + g.n0 + cb + 16 * q; st8(o, v[0], v[1]); st8(o + 8, v[2], v[3]); return;
    }
    if (g.epi == EPI_SWIGLU) {
        for (int jj = 0; jj < 2; ++jj) { float a[4]; for (int r = 0; r < 4; ++r) a[r] = silu_f(v[2 * jj][r]) * v[2 * jj + 1][r];
            st4(g.out + (size_t)orow * g.ldc + (g.n0 + cb) / 2 + jj * 16 + q * 4, a[0], a[1], a[2], a[3]); }
        return;
    }
    if (g.epi >= EPI_PROJ) {
        const int row = (int)orow; const bool lat = row < T; const int bb = lat ? row / S : (row - T) / L, kidx = lat ? row % S : S + (row - T) % L;
        const int rp = lat ? (row % S) / GRID_W : 0, cp = lat ? (row % S) % GRID_W : 0, span = (g.n0 + cb) / 64;
        if (g.epi == EPI_PROJ) {
            if (span < 8) { if (lat) for (int hp = 0; hp < 2; ++hp) for (int r = 0; r < 4; ++r) { const int i = q * 4 + r, pos = hp ? cp : rp; const float cs = g.tab[(pos * 16 + i) * 2], sn = g.tab[(pos * 16 + i) * 2 + 1];
                    const float x1 = v[2 * hp][r], x2 = v[2 * hp + 1][r]; v[2 * hp][r] = x1 * cs - x2 * sn; v[2 * hp + 1][r] = x1 * sn + x2 * cs; } }
            else if (span < 10) { for (int j = 0; j < 4; ++j) for (int r = 0; r < 4; ++r) stf(g.vt + ((size_t)(bb * SWA_KVH + span - 8) * 64 + j * 16 + q * 4 + r) * NK + kidx, v[j][r]); return; }
            else if (g.n0 + cb + 64 > PO_KR && lat) { rope8(v[2], pv[2], q, g.tab, rp); rope8(v[3], pv[3], q, g.tab, cp); }
        } else if (g.epi == EPI_UQ) {
            if (lat) for (int j = 0; j < 4; ++j) { const int k6 = ((g.n0 + cb) / 16 + j) % 6; if (k6 >= 4) rope8(v[j], pv[j], q, g.tab, k6 == 4 ? rp : cp); }
        } else {
            if (span & 1) { for (int j = 0; j < 4; ++j) for (int r = 0; r < 4; ++r) stf(g.vt + ((size_t)(bb * MH + span / 2) * 64 + j * 16 + q * 4 + r) * NK + kidx, v[j][r]); return; }
        }
    }
    const float w = g.epi == EPI_SCALE ? g.rowscale[orow] : 1.0f;
    for (int j = 0; j < 4; ++j) st4(g.out + (size_t)orow * g.ldc + g.n0 + cb + j * 16 + q * 4, v[j][0] * w, v[j][1] * w, v[j][2] * w, v[j][3] * w);
}
#ifdef HOST_EMU
inline void gemm_tile_host(const GemmDesc& g) {
    for (int rl = 0; rl < g.nrows; ++rl) {
        const long long ar = g.rowidx ? g.rowidx[g.a_row0 + rl] : g.a_row0 + rl; const st_t* a = g.A + (size_t)ar * g.lda;
        for (int cb = 0; cb < 128; cb += 64) for (int q = 0; q < 4; ++q) { float v[4][4], pv[4][4];
            for (int j = 0; j < 4; ++j) for (int r = 0; r < 4; ++r) { const st_t* b = g.Bt + (size_t)(g.n0 + cb + (g.perm ? q * 16 + j * 4 + r : j * 16 + q * 4 + r)) * g.ldb; float acc = 0.f; for (int k = 0; k < g.K; ++k) acc += a[k] * b[k]; v[j][r] = acc;
                const st_t* b2 = g.Bt + (size_t)(g.n0 + cb + j * 16 + (q ^ 2) * 4 + r) * g.ldb; float acc2 = 0.f; for (int k = 0; k < g.K; ++k) acc2 += a[k] * b2[k]; pv[j][r] = acc2; }
            gemm_epi(g, rl, cb, q, v, pv); }
    }
}
#else
__device__ __forceinline__ void gemm_tile_dev(const GemmDesc& g, LAS unsigned char* lds, const int tid) {
    const int lane = tid & 63, wave = __builtin_amdgcn_readfirstlane(tid >> 6), wr = wave >> 1, wc = wave & 1;
    const int lrow = lane >> 3, slot = lane & 7;
    const st_t* asrc[4]; const st_t* bsrc[4];
#pragma unroll
    for (int i = 0; i < 4; ++i) {
        const int row = i * 32 + wave * 8 + lrow, chunk = slot ^ ((row >> 1) & 7);
        int rl = row < g.nrows ? row : g.nrows - 1;
        const long long ar = g.rowidx ? (long long)g.rowidx[g.a_row0 + rl] : (long long)(g.a_row0 + rl);
        asrc[i] = g.A + (size_t)ar * g.lda + chunk * 8;
        const int brow = g.perm ? (row & 64) + ((row >> 2) & 3) * 16 + ((row >> 4) & 3) * 4 + (row & 3) : row;
        bsrc[i] = g.Bt + (size_t)(g.n0 + brow) * g.ldb + chunk * 8;
    }
    const int nt = g.K / 64;
    auto stage = [&](int buf, int t) {
#pragma unroll
        for (int i = 0; i < 4; ++i) {
            __builtin_amdgcn_global_load_lds((const unsigned*)(asrc[i] + t * 64), (LAS unsigned*)(lds + buf * 32768 + (i * 32 + wave * 8) * 128), 16, 0, 0);
            __builtin_amdgcn_global_load_lds((const unsigned*)(bsrc[i] + t * 64), (LAS unsigned*)(lds + buf * 32768 + 16384 + (i * 32 + wave * 8) * 128), 16, 0, 0);
        }
    };
    f32x4 acc[4][4];
#pragma unroll
    for (int i = 0; i < 4; ++i)
#pragma unroll
        for (int j = 0; j < 4; ++j) acc[i][j] = (f32x4){0.f, 0.f, 0.f, 0.f};
    const int fr = lane & 15, fq = lane >> 4;
    __syncthreads();
    stage(0, 0);
    __syncthreads();
    for (int t = 0; t < nt; ++t) {
        const int cur = t & 1;
        if (t + 1 < nt) stage(cur ^ 1, t + 1);
        const LAS unsigned char* As = lds + cur * 32768; const LAS unsigned char* Bs = As + 16384;
#pragma unroll
        for (int kk = 0; kk < 2; ++kk) {
            bf16x8 af[4], bfr[4];
#pragma unroll
            for (int i = 0; i < 4; ++i) { const int row = wr * 64 + i * 16 + fr; af[i] = *(const LAS bf16x8*)(As + row * 128 + (((kk * 4 + fq) ^ ((row >> 1) & 7)) << 4)); }
#pragma unroll
            for (int j = 0; j < 4; ++j) { const int row = wc * 64 + j * 16 + fr; bfr[j] = *(const LAS bf16x8*)(Bs + row * 128 + (((kk * 4 + fq) ^ ((row >> 1) & 7)) << 4)); }
#pragma unroll
            for (int i = 0; i < 4; ++i)
#pragma unroll
                for (int j = 0; j < 4; ++j) acc[i][j] = __builtin_amdgcn_mfma_f32_16x16x32_bf16(bfr[j], af[i], acc[i][j], 0, 0, 0);
        }
        __syncthreads();
    }
    const bool need_pv = epi_needs_partner(g, wc * 64);
#pragma unroll
    for (int i = 0; i < 4; ++i) { float v[4][4], pv[4][4];
#pragma unroll
        for (int j = 0; j < 4; ++j)
#pragma unroll
            for (int r = 0; r < 4; ++r) { v[j][r] = acc[i][j][r]; pv[j][r] = 0.f; }
        if (need_pv) {
#pragma unroll
            for (int j = 0; j < 4; ++j)
#pragma unroll
                for (int r = 0; r < 4; ++r) pv[j][r] = __shfl_xor(v[j][r], 32); }
        gemm_epi(g, wr * 64 + i * 16 + fr, wc * 64, fq, v, pv); }
}
#endif


struct AttnDesc {
    int dqk;
    const st_t* Q; int ldq, q_row0;
    const st_t* K1; int ldk1; const st_t* K2; int ldk2;
    int lat_row0, ctx_row0;
    const st_t* Vt;
    int kt_lo, kt_hi, nctx, ctx_t0;
    int mask, qpos0;
    float m_init, l_init, c;
    st_t* O; int o_col;
    int part; st_t* opart; float* mlpart;
};
HD int attn_nitems(int layer) { const int lat = B * MH * (S / 128) * NSPLIT + B * SWA_H * (S / 128); return layer == DEPTH - 1 ? lat : lat + B * MH * (L / 128) + B * SWA_H * (L / 128); }
HD int attn_queue_size(int layer, int x) {
    const int NQ = S / 128, NQC = L / 128, half = x / 4; int n = NCHAIN / 8 + NQ * NSPLIT + SWA_G * (NQ * (half + 1) / 2 - NQ * half / 2);
    if (layer < DEPTH - 1) n += NQC + SWA_G * (NQC * (half + 1) / 2 - NQC * half / 2);
    return n;
}
HD int attn_queue_item(int layer, int x, int k) {
    const int NQ = S / 128, NQC = L / 128, half = x / 4, n_mla = B * MH * NQ * NSPLIT, n_swa = B * SWA_H * NQ, n_mlac = B * MH * NQC;
    if (k < NCHAIN / 8) return x * (NCHAIN / 8) + k; k -= NCHAIN / 8;
    if (k < NQ * NSPLIT) return NCHAIN + x * NQ * NSPLIT + k; k -= NQ * NSPLIT;
    const int gb = (x % 4) / SWA_KVH, gk = (x % 4) % SWA_KVH;
    { const int qlo = NQ * half / 2, nq = NQ * (half + 1) / 2 - qlo; if (k < SWA_G * nq) { const int h = gk * SWA_G + k / nq; return NCHAIN + n_mla + (gb * SWA_H + h) * NQ + qlo + k % nq; } k -= SWA_G * nq; }
    if (k < NQC) return NCHAIN + n_mla + n_swa + x * NQC + k; k -= NQC;
    { const int qlo = NQC * half / 2, nq = NQC * (half + 1) / 2 - qlo; const int h = gk * SWA_G + k / (nq > 0 ? nq : 1); return NCHAIN + n_mla + n_swa + n_mlac + (gb * SWA_H + h) * NQC + qlo + k % (nq > 0 ? nq : 1); }
}
static_assert(NCHAIN % 8 == 0 && B * MH == 8 && B * SWA_KVH == 4, "queue layout");
HD void attn_desc(const Params& p, int layer, int item, AttnDesc& a) {
    const float LOG2E = 1.4426950408889634f;
    const int n_mla = B * MH * (S / 128) * NSPLIT, n_swa = B * SWA_H * (S / 128), n_mlac = B * MH * (L / 128);
    bool mla, ctxq; int b, h, qb, part = -1;
    if (item < n_mla) { mla = true; ctxq = false; qb = item % (S / 128); item /= S / 128; part = item % NSPLIT; item /= NSPLIT; h = item % MH; b = item / MH; }
    else if (item < n_mla + n_swa) { item -= n_mla; mla = false; ctxq = false; qb = item % (S / 128); h = (item / (S / 128)) % SWA_H; b = item / (S / 128) / SWA_H; }
    else if (item < n_mla + n_swa + n_mlac) { item -= n_mla + n_swa; mla = true; ctxq = true; qb = item % (L / 128); h = (item / (L / 128)) % MH; b = item / (L / 128) / MH; }
    else { item -= n_mla + n_swa + n_mlac; mla = false; ctxq = true; qb = item % (L / 128); h = (item / (L / 128)) % SWA_H; b = item / (L / 128) / SWA_H; }
    a.q_row0 = ctxq ? T + b * L + qb * 128 : b * S + qb * 128; a.lat_row0 = b * S; a.ctx_row0 = T + b * L; a.nctx = L / 64; a.qpos0 = qb * 128; a.O = p.O(); a.ctx_t0 = 0; a.part = -1; a.opart = nullptr; a.mlpart = nullptr;
    if (mla) {
        a.dqk = 96; a.Q = p.MQ() + h * MQD; a.ldq = MH * MQD; a.K1 = p.MKV() + h * MKVD; a.ldk1 = MH * MKVD; a.K2 = p.P() + PO_KR; a.ldk2 = DPROJP;
        a.Vt = p.VtM() + (size_t)(b * MH + h) * 64 * NK; a.kt_lo = 0; a.kt_hi = ctxq ? 0 : S / 64; a.mask = 0; a.m_init = -1e30f; a.l_init = 0.f; a.c = LOG2E / sqrtf((float)MQD); a.o_col = 768 + h * 64;
        if (part >= 0 && NSPLIT > 1) {
            const int CT = (NK / 64) / NSPLIT, t0 = part * CT, t1 = t0 + CT, nl = S / 64;
            a.kt_lo = t0 < nl ? t0 : nl; a.kt_hi = t1 < nl ? t1 : nl; a.nctx = t1 > nl ? t1 - (t0 > nl ? t0 : nl) : 0; a.ctx_t0 = t0 > nl ? t0 - nl : 0;
            a.part = part; a.opart = p.OPART() + (size_t)part * T * MH * MV + h * MV; a.mlpart = p.MLPART() + ((size_t)part * T * MH + h) * 2; }
    } else {
        const int kvh = h / SWA_G;
        a.dqk = 64; a.Q = p.P() + PO_QA + h * 64; a.ldq = DPROJP; a.K1 = p.P() + PO_KA + kvh * 64; a.ldk1 = DPROJP; a.K2 = nullptr; a.ldk2 = 0;
        a.Vt = p.VtA() + (size_t)(b * SWA_KVH + kvh) * 64 * NK; a.mask = ctxq ? 0 : 1;
        if (ctxq) { a.kt_lo = 0; a.kt_hi = 0; } else { a.kt_lo = (a.qpos0 - SWA_W) / 64; if (a.kt_lo < 0) a.kt_lo = 0; a.kt_hi = (a.qpos0 + 128 + SWA_W) / 64; if (a.kt_hi > S / 64) a.kt_hi = S / 64; }
        a.m_init = p.swa_sink[layer * SWA_H + h] * LOG2E; a.l_init = 1.f; a.c = LOG2E * 0.125f; a.o_col = h * 64;
    }
}
#ifdef HOST_EMU
inline void attn_tile_host(const AttnDesc& a) {
    const int nl = a.kt_hi - a.kt_lo, ntile = nl + a.nctx;
    for (int q = 0; q < 128; ++q) {
        const st_t* qr = a.Q + (size_t)(a.q_row0 + q) * a.ldq; float m = a.m_init, l = a.l_init, acc[64]; for (int d = 0; d < 64; ++d) acc[d] = 0.f;
        for (int t = 0; t < ntile; ++t) for (int kk = 0; kk < 64; ++kk) {
            const int kidx = t < nl ? (a.kt_lo + t) * 64 + kk : S + (a.ctx_t0 + t - nl) * 64 + kk; const int row = kidx < S ? a.lat_row0 + kidx : a.ctx_row0 + kidx - S;
            if (a.mask && t < nl) { const int dq = a.qpos0 + q - kidx; if (dq > SWA_W || dq < -SWA_W) continue; }
            float sc = 0.f; for (int d = 0; d < 64; ++d) sc += qr[d] * a.K1[(size_t)row * a.ldk1 + d];
            if (a.dqk > 64) for (int d = 64; d < a.dqk; ++d) sc += qr[d] * a.K2[(size_t)row * a.ldk2 + d - 64];
            sc *= a.c; if (sc > m) { const float f = exp2f(m - sc); l *= f; for (int d = 0; d < 64; ++d) acc[d] *= f; m = sc; }
            const float pe = exp2f(sc - m); l += pe; for (int d = 0; d < 64; ++d) acc[d] += pe * a.Vt[(size_t)d * NK + kidx];
        }
        if (a.part >= 0) { for (int d = 0; d < 64; ++d) a.opart[(size_t)(a.q_row0 + q) * MH * MV + d] = acc[d] / l; a.mlpart[(size_t)(a.q_row0 + q) * MH * 2] = m; a.mlpart[(size_t)(a.q_row0 + q) * MH * 2 + 1] = l; }
        else for (int d = 0; d < 64; ++d) a.O[(size_t)(a.q_row0 + q) * DMIX + a.o_col + d] = acc[d] / l;
    }
}
#else
typedef float f32x16 __attribute__((ext_vector_type(16)));
typedef unsigned u32x4 __attribute__((ext_vector_type(4)));
typedef unsigned u32x2 __attribute__((ext_vector_type(2)));
__device__ __forceinline__ int crow16(int reg, int h) { return (reg & 3) + 8 * (reg >> 2) + 4 * h; }
template <int DQK>
__device__ __forceinline__ void attn_tile_dev(const AttnDesc& a, LAS unsigned char* lds, const int tid) {
    constexpr int KSTR = DQK * 2 + 16, VSTR = 136, KBYTES = 64 * KSTR, BUF = KBYTES + 64 * VSTR, CPR = DQK / 8, KCH = 64 * CPR / 256, NKS = DQK / 16;
    const int lane = tid & 63, wave = __builtin_amdgcn_readfirstlane(tid >> 6), l31 = lane & 31, hh = lane >> 5;
    bf16x8 qf[NKS];
    { const st_t* qrow = a.Q + (size_t)(a.q_row0 + wave * 32 + l31) * a.ldq;
#pragma unroll
      for (int ks = 0; ks < NKS; ++ks) qf[ks] = *(const bf16x8*)(qrow + 16 * ks + 8 * hh); }
    f32x16 ot[2];
#pragma unroll
    for (int r = 0; r < 16; ++r) { ot[0][r] = 0.f; ot[1][r] = 0.f; }
    float m = a.m_init, lsum = hh == 0 ? a.l_init : 0.f;
    const int nl = a.kt_hi - a.kt_lo, ntile = nl + a.nctx; const float c = a.c;
    u32x4 kreg[2][KCH], vreg[2][2];
    auto gload = [&](auto PC, int t) { constexpr int P = decltype(PC)::value;
        const int kidx0 = t < nl ? (a.kt_lo + t) * 64 : S + (a.ctx_t0 + t - nl) * 64; const int rowbase = t < nl ? a.lat_row0 + kidx0 : a.ctx_row0 + kidx0 - S;
#pragma unroll
        for (int u = 0; u < KCH; ++u) { const int ci = tid + 256 * u, row = ci / CPR, cc = ci % CPR;
            const st_t* src = (DQK == 64 || cc < 8) ? a.K1 + (size_t)(rowbase + row) * a.ldk1 + cc * 8 : a.K2 + (size_t)(rowbase + row) * a.ldk2 + (cc - 8) * 8;
            kreg[P][u] = *(const u32x4*)src; }
#pragma unroll
        for (int u = 0; u < 2; ++u) { const int ci = tid + 256 * u, dv = ci >> 3, cc = ci & 7; vreg[P][u] = *(const u32x4*)(a.Vt + (size_t)dv * NK + kidx0 + cc * 8); }
    };
    auto lstore = [&](auto PC) { constexpr int P = decltype(PC)::value;
#pragma unroll
        for (int u = 0; u < KCH; ++u) { const int ci = tid + 256 * u, row = ci / CPR, cc = ci % CPR; *(LAS u32x4*)(lds + P * BUF + row * KSTR + cc * 16) = kreg[P][u]; }
#pragma unroll
        for (int u = 0; u < 2; ++u) { const int ci = tid + 256 * u, dv = ci >> 3, cc = ci & 7; LAS u32x2* d = (LAS u32x2*)(lds + P * BUF + KBYTES + dv * VSTR + cc * 16);
            d[0] = (u32x2){vreg[P][u].x, vreg[P][u].y}; d[1] = (u32x2){vreg[P][u].z, vreg[P][u].w}; }
    };
    using I0 = std::integral_constant<int, 0>; using I1 = std::integral_constant<int, 1>;
    __syncthreads();
    gload(I0{}, 0); lstore(I0{});
    if (ntile > 1) gload(I1{}, 1);
    __syncthreads();
    auto body = [&](auto PC, const int t) { constexpr int cur = decltype(PC)::value; using PN = std::integral_constant<int, 1 - cur>;
        if (t + 2 < ntile) gload(PC, t + 2);
        const LAS unsigned char* Ks = lds + cur * BUF; const LAS unsigned char* Vs = Ks + KBYTES;
        f32x16 st[2];
        {
            bf16x8 kf[2][NKS];
#pragma unroll
            for (int ks = 0; ks < NKS; ++ks)
#pragma unroll
                for (int kb = 0; kb < 2; ++kb) kf[kb][ks] = *(const LAS bf16x8*)(Ks + (kb * 32 + l31) * KSTR + (16 * ks + 8 * hh) * 2);
            __builtin_amdgcn_sched_barrier(0);
#pragma unroll
            for (int r = 0; r < 16; ++r) { st[0][r] = 0.f; st[1][r] = 0.f; }
#pragma unroll
            for (int ks = 0; ks < NKS; ++ks)
#pragma unroll
                for (int kb = 0; kb < 2; ++kb) st[kb] = __builtin_amdgcn_mfma_f32_32x32x16_bf16(kf[kb][ks], qf[ks], st[kb], 0, 0, 0);
        }
        u32x2 vlo[2][2][2], vhi[2][2][2];
#pragma unroll
        for (int kb = 0; kb < 2; ++kb)
#pragma unroll
            for (int s2 = 0; s2 < 2; ++s2)
#pragma unroll
                for (int db = 0; db < 2; ++db) { const LAS unsigned char* vp = Vs + (db * 32 + l31) * VSTR + (kb * 32 + 16 * s2 + 4 * hh) * 2;
                    vlo[kb][s2][db] = *(const LAS u32x2*)vp; vhi[kb][s2][db] = *(const LAS u32x2*)(vp + 16); }
        __builtin_amdgcn_sched_barrier(0);
        if (a.mask && t < nl) {
            const int d0 = a.qpos0 + wave * 32 + l31 - (a.kt_lo + t) * 64;
#pragma unroll
            for (int kb = 0; kb < 2; ++kb)
#pragma unroll
                for (int r = 0; r < 16; ++r) { const int dq = d0 - (kb * 32 + crow16(r, hh)); if (dq > SWA_W || dq < -SWA_W) st[kb][r] = -1e30f; }
        }
        float mx = st[0][0];
#pragma unroll
        for (int r = 1; r < 16; ++r) mx = fmaxf(mx, st[0][r]);
#pragma unroll
        for (int r = 0; r < 16; ++r) mx = fmaxf(mx, st[1][r]);
        mx = fmaxf(mx, __shfl_xor(mx, 32));
        const float m_new = fmaxf(m, mx * c), alpha = __builtin_amdgcn_exp2f(m - m_new);
        float rs = 0.f;
#pragma unroll
        for (int kb = 0; kb < 2; ++kb)
#pragma unroll
            for (int r = 0; r < 16; ++r) { const float pe = __builtin_amdgcn_exp2f(__builtin_fmaf(st[kb][r], c, -m_new)); st[kb][r] = pe; rs += pe; }
        lsum = lsum * alpha + rs; m = m_new;
#pragma unroll
        for (int r = 0; r < 16; ++r) { ot[0][r] *= alpha; ot[1][r] *= alpha; }
#pragma unroll
        for (int kb = 0; kb < 2; ++kb)
#pragma unroll
            for (int s2 = 0; s2 < 2; ++s2) {
                u32x4 pw; pw.x = pk_bf16(st[kb][8 * s2 + 0], st[kb][8 * s2 + 1]); pw.y = pk_bf16(st[kb][8 * s2 + 2], st[kb][8 * s2 + 3]);
                pw.z = pk_bf16(st[kb][8 * s2 + 4], st[kb][8 * s2 + 5]); pw.w = pk_bf16(st[kb][8 * s2 + 6], st[kb][8 * s2 + 7]);
                const bf16x8 pb = __builtin_bit_cast(bf16x8, pw);
#pragma unroll
                for (int db = 0; db < 2; ++db) { const u32x2 lo = vlo[kb][s2][db], hi = vhi[kb][s2][db]; u32x4 vw; vw.x = lo.x; vw.y = lo.y; vw.z = hi.x; vw.w = hi.y;
                    ot[db] = __builtin_amdgcn_mfma_f32_32x32x16_bf16(__builtin_bit_cast(bf16x8, vw), pb, ot[db], 0, 0, 0); }
            }
        if (t + 1 < ntile) lstore(PN{});
        __syncthreads();
    };
    for (int t = 0; t < ntile; t += 2) { body(I0{}, t); if (t + 1 < ntile) body(I1{}, t + 1); }
    const float ltot = lsum + __shfl_xor(lsum, 32), inv = 1.0f / ltot;
    st_t* orow = a.O + (size_t)(a.q_row0 + wave * 32 + l31) * DMIX + a.o_col;
    if (a.part >= 0) { orow = a.opart + (size_t)(a.q_row0 + wave * 32 + l31) * MH * MV;
        if (hh == 0) { float* ml = a.mlpart + (size_t)(a.q_row0 + wave * 32 + l31) * MH * 2; ml[0] = m; ml[1] = ltot; } }
#pragma unroll
    for (int db = 0; db < 2; ++db)
#pragma unroll
        for (int g = 0; g < 4; ++g) st4(orow + db * 32 + 8 * g + 4 * hh, ot[db][4 * g] * inv, ot[db][4 * g + 1] * inv, ot[db][4 * g + 2] * inv, ot[db][4 * g + 3] * inv);
}
#endif


HD int gdn_row(int b, int dir, int n, int i) {
    if (n < L / 64) { const int pos = n * 64 + i; return T + b * L + (dir == 0 ? pos : L - 1 - pos); }
    const int pos = (n - L / 64) * 64 + i; return b * S + (dir == 0 ? pos : S - 1 - pos);
}
#ifdef HOST_EMU
inline void gdn_pre_host(const Params& p, int item) {
    const int c = item / NCH, n = item % NCH, dir = c & 1, h = (c >> 1) % GH, b = (c >> 1) / GH;
    float gc[64], beta[64]; const st_t* kk[64]; const st_t* qq[64]; const st_t* vv[64]; float acc = 0.f;
    for (int i = 0; i < 64; ++i) { const int r = gdn_row(b, dir, n, i); acc += p.BG()[(size_t)r * 24 + 12 + dir * 6 + h]; gc[i] = acc; beta[i] = p.BG()[(size_t)r * 24 + dir * 6 + h];
        qq[i] = p.G() + (size_t)r * GQKV + h * 64; kk[i] = qq[i] + 384; vv[i] = qq[i] + 768; }
    static thread_local float A[64][64], XU[64][64], XW[64][64];
    for (int i = 0; i < 64; ++i) for (int j = 0; j < 64; ++j) { float d = 0.f; for (int e = 0; e < 64; ++e) d += kk[i][e] * kk[j][e]; A[i][j] = j < i ? beta[i] * d * expf(gc[i] - gc[j]) : 0.f; }
    for (int i = 0; i < 64; ++i) for (int e = 0; e < 64; ++e) { float u = beta[i] * vv[i][e], w = beta[i] * expf(gc[i]) * kk[i][e];
        for (int j = 0; j < i; ++j) { u -= A[i][j] * XU[j][e]; w -= A[i][j] * XW[j][e]; } XU[i][e] = u; XW[i][e] = w; }
    st_t* ch = p.CH() + (size_t)item * 5 * 4096;
    for (int i = 0; i < 64; ++i) for (int e = 0; e < 64; ++e) {
        ch[0 * 4096 + e * 64 + i] = XU[i][e]; ch[1 * 4096 + i * 64 + e] = XW[i][e]; ch[2 * 4096 + i * 64 + e] = qq[i][e] * 0.125f * expf(gc[i]);
        float d = 0.f; for (int x = 0; x < 64; ++x) d += qq[i][x] * kk[e][x]; ch[3 * 4096 + i * 64 + e] = e <= i ? d * 0.125f * expf(gc[i] - gc[e]) : 0.f;
        ch[4 * 4096 + e * 64 + i] = kk[i][e] * expf(gc[63] - gc[i]); }
    p.GAM()[item] = expf(gc[63]);
}
inline void gdn_scan_host(const Params& p, int c) {
    const int dir = c & 1, h = (c >> 1) % GH, b = (c >> 1) / GH; st_t* dst = dir == 0 ? p.OF() : p.OB();
    static thread_local float Sm[64][64], Vn[64][64]; for (int d = 0; d < 64; ++d) for (int e = 0; e < 64; ++e) Sm[d][e] = 0.f;
    for (int n = 0; n < NCH; ++n) { const st_t* ch = p.CH() + (size_t)(c * NCH + n) * 5 * 4096; const float gam = p.GAM()[c * NCH + n];
        for (int i = 0; i < 64; ++i) for (int e = 0; e < 64; ++e) { float v = ch[0 * 4096 + e * 64 + i]; for (int d = 0; d < 64; ++d) v -= ch[1 * 4096 + i * 64 + d] * Sm[d][e]; Vn[i][e] = v; }
        for (int i = 0; i < 64; ++i) for (int e = 0; e < 64; ++e) { float o = 0.f; for (int d = 0; d < 64; ++d) o += ch[2 * 4096 + i * 64 + d] * Sm[d][e]; for (int j = 0; j < 64; ++j) o += ch[3 * 4096 + i * 64 + j] * Vn[j][e];
            dst[(size_t)gdn_row(b, dir, n, i) * (GH * GDV) + h * 64 + e] = o; }
        for (int d = 0; d < 64; ++d) for (int e = 0; e < 64; ++e) { float sn = gam * Sm[d][e]; for (int i = 0; i < 64; ++i) sn += ch[4 * 4096 + d * 64 + i] * Vn[i][e]; Sm[d][e] = sn; }
    }
}
#else
template <int... Is, class F> __device__ __forceinline__ void static_for_impl(std::integer_sequence<int, Is...>, F&& f) { (f(std::integral_constant<int, Is>{}), ...); }
template <int N, class F> __device__ __forceinline__ void static_for(F&& f) { static_for_impl(std::make_integer_sequence<int, N>{}, f); }
__device__ __forceinline__ float bf_lo(unsigned u) { return __builtin_bit_cast(float, u << 16); }
__device__ __forceinline__ float bf_hi(unsigned u) { return __builtin_bit_cast(float, u & 0xffff0000u); }
template <int ROLE>
__device__ __forceinline__ void gdn_pre_role(const Params& p, int pair, LAS unsigned char* lds, const int lane, const int wave) {
    constexpr int AST = 68;
    const int l31 = lane & 31, hh = lane >> 5;
    const int item = pair * 2 + (wave >> 1);
    const int c = item / NCH, n = item % NCH, dir = c & 1, h = (c >> 1) % GH, b = (c >> 1) / GH;
    LAS float* At = (LAS float*)(lds + (wave >> 1) * 18432); LAS float* gcs = At + 64 * AST; LAS float* bts = gcs + 64; LAS float* ebt = bts + 64;
    st_t* ch = p.CH() + (size_t)item * 5 * 4096;
    const int row0 = gdn_row(b, dir, n, 0); const int sgn = dir == 0 ? 1 : -1;
    const int myrow = row0 + sgn * lane;
    float gc = p.BG()[(size_t)myrow * 24 + 12 + dir * 6 + h]; const float beta = p.BG()[(size_t)myrow * 24 + dir * 6 + h];
#pragma unroll
    for (int o = 1; o < 64; o <<= 1) { const float t = __shfl_up(gc, o); if (lane >= o) gc += t; }
    const float gc63 = __shfl(gc, 63);
    __syncthreads();
    if (ROLE == 0) { gcs[lane] = gc; bts[lane] = beta; ebt[lane] = beta * __expf(gc); }
    const st_t* gbase = p.G() + h * 64;
    f32x16 d00, d10, d11;
#pragma unroll
    for (int r = 0; r < 16; ++r) { d00[r] = 0.f; d10[r] = 0.f; d11[r] = 0.f; }
    { const size_t r0 = (size_t)(row0 + sgn * l31) * GQKV, r1 = (size_t)(row0 + sgn * (32 + l31)) * GQKV; constexpr int xo = ROLE == 0 ? 384 : 0;
#pragma unroll
      for (int ks = 0; ks < 4; ++ks) {
          const bf16x8 a0 = *(const bf16x8*)(gbase + r0 + xo + 16 * ks + 8 * hh), a1 = *(const bf16x8*)(gbase + r1 + xo + 16 * ks + 8 * hh);
          const bf16x8 b0 = *(const bf16x8*)(gbase + r0 + 384 + 16 * ks + 8 * hh), b1 = *(const bf16x8*)(gbase + r1 + 384 + 16 * ks + 8 * hh);
          d00 = __builtin_amdgcn_mfma_f32_32x32x16_bf16(a0, b0, d00, 0, 0, 0); d10 = __builtin_amdgcn_mfma_f32_32x32x16_bf16(a1, b0, d10, 0, 0, 0); d11 = __builtin_amdgcn_mfma_f32_32x32x16_bf16(a1, b1, d11, 0, 0, 0); } }
    __syncthreads();
    auto post = [&](const f32x16& d, int ib, int jb) __attribute__((always_inline)) {
        const int j = 32 * jb + l31; const float gcj = gcs[j];
#pragma unroll
        for (int g = 0; g < 4; ++g) { const int i0 = 32 * ib + 8 * g + 4 * hh; const f32x4 gci = *(const LAS f32x4*)(gcs + i0);
            if (ROLE == 0) { const f32x4 bi = *(const LAS f32x4*)(bts + i0); f32x4 o;
#pragma unroll
                for (int u = 0; u < 4; ++u) o[u] = (j < i0 + u) ? bi[u] * d[4 * g + u] * __expf(gci[u] - gcj) : 0.f;
                *(LAS f32x4*)(At + j * AST + i0) = o; }
            else {
#pragma unroll
                for (int u = 0; u < 4; ++u) { const float v = (j <= i0 + u) ? 0.125f * d[4 * g + u] * __expf(gci[u] - gcj) : 0.f; stf(ch + 3 * 4096 + (i0 + u) * 64 + j, v); } } }
    };
    post(d00, 0, 0); post(d10, 1, 0); post(d11, 1, 1);
    if (ROLE == 1) {
#pragma unroll
        for (int r = 0; r < 16; ++r) stf(ch + 3 * 4096 + crow16(r, hh) * 64 + 32 + l31, 0.f); }
    __syncthreads();
    float acc[64];
#pragma unroll
    for (int i = 0; i < 64; ++i) acc[i] = 0.f;
    { const long long stp = (long long)sgn * GQKV;
      const st_t* sp = gbase + (ROLE == 0 ? 768 : 384) + lane + (size_t)row0 * GQKV;
      const LAS float* sc = ROLE == 0 ? bts : ebt;
      float cur[8], pre[8];
#pragma unroll
      for (int u = 0; u < 8; ++u) { cur[u] = ldf(sp + u * stp); pre[u] = ldf(sp + (8 + u) * stp); }
      unsigned pk[4]; f32x4 s4 = (f32x4){0.f, 0.f, 0.f, 0.f}; float xprev = 0.f;
      static_for<64>([&](auto jc) __attribute__((always_inline)) {
          constexpr int j = decltype(jc)::value;
          if constexpr ((j & 7) == 0 && j > 0) {
#pragma unroll
              for (int u = 0; u < 8; ++u) cur[u] = pre[u];
              if constexpr (j + 8 < 64) { const st_t* gp = sp + (j + 8) * stp; asm volatile("" : "+v"(gp));
#pragma unroll
                  for (int u = 0; u < 8; ++u) pre[u] = ldf(gp + u * stp); }
          }
          if constexpr ((j & 3) == 0) s4 = *(const LAS f32x4*)(sc + j);
          const float x = s4[j & 3] * cur[j & 7] - acc[j];
          if constexpr (ROLE == 0) {
              if constexpr ((j & 1) == 1) pk[(j >> 1) & 3] = pk_bf16(xprev, x);
              if constexpr ((j & 7) == 7) { u32x4 w; w.x = pk[0]; w.y = pk[1]; w.z = pk[2]; w.w = pk[3]; *(u32x4*)(ch + 0 * 4096 + lane * 64 + (j - 7)) = w; }
          } else stf(ch + 1 * 4096 + j * 64 + lane, x);
          xprev = x;
          constexpr int I0 = ((j + 1) >> 2) << 2;
#pragma unroll
          for (int i4 = I0; i4 < 64; i4 += 4) { const f32x4 av = *(const LAS f32x4*)(At + j * AST + i4);
#pragma unroll
              for (int u = 0; u < 4; ++u) if (i4 + u > j) acc[i4 + u] += av[u] * x;
              asm volatile("" : "+v"(acc[i4]), "+v"(acc[i4 + 1]), "+v"(acc[i4 + 2]), "+v"(acc[i4 + 3])); }
          __builtin_amdgcn_sched_barrier(0);
      }); }
    { const st_t* src = gbase + (size_t)myrow * GQKV + (ROLE == 0 ? 384 : 0); const float sc = ROLE == 0 ? __expf(gc63 - gc) : 0.125f * __expf(gc);
#pragma unroll
      for (int c8 = 0; c8 < 8; ++c8) { const u32x4 w = *(const u32x4*)(src + 8 * c8);
          const float f0 = bf_lo(w.x) * sc, f1 = bf_hi(w.x) * sc, f2 = bf_lo(w.y) * sc, f3 = bf_hi(w.y) * sc, f4 = bf_lo(w.z) * sc, f5 = bf_hi(w.z) * sc, f6 = bf_lo(w.w) * sc, f7 = bf_hi(w.w) * sc;
          if (ROLE == 0) { st_t* kt = ch + 4 * 4096 + (8 * c8) * 64 + lane; stf(kt, f0); stf(kt + 64, f1); stf(kt + 128, f2); stf(kt + 192, f3); stf(kt + 256, f4); stf(kt + 320, f5); stf(kt + 384, f6); stf(kt + 448, f7); }
          else { u32x4 o; o.x = pk_bf16(f0, f1); o.y = pk_bf16(f2, f3); o.z = pk_bf16(f4, f5); o.w = pk_bf16(f6, f7); *(u32x4*)(ch + 2 * 4096 + lane * 64 + 8 * c8) = o; } } }
    if (ROLE == 0 && lane == 0) p.GAM()[item] = __expf(gc63);
}
static_assert((NCHAIN * NCH) % 2 == 0, "chunk items come in pairs");
__device__ __forceinline__ void gdn_pre_dev(const Params& p, int pair, LAS unsigned char* lds, const int tid) {
    const int lane = tid & 63, wave = __builtin_amdgcn_readfirstlane(tid >> 6);
    if ((wave & 1) == 0) gdn_pre_role<0>(p, pair, lds, lane, wave); else gdn_pre_role<1>(p, pair, lds, lane, wave);
}
__device__ __forceinline__ void gdn_scan_dev(const Params& p, int c, LAS unsigned char* lds, const int tid) {
    constexpr int RS = 136, MB = 64 * RS;
    const int lane = tid & 63, wave = __builtin_amdgcn_readfirstlane(tid >> 6), r16 = lane & 15, q = lane >> 4;
    const int dir = c & 1, h = (c >> 1) % GH, b = (c >> 1) / GH; st_t* dst = (dir == 0 ? p.OF() : p.OB()) + h * 64 + 16 * wave + r16;
    f32x4 Sb[4];
#pragma unroll
    for (int i = 0; i < 4; ++i) Sb[i] = (f32x4){0.f, 0.f, 0.f, 0.f};
    u32x4 stg[10]; float gam_next = 0.f;
    auto gload = [&](int n) { const u32x4* src = (const u32x4*)(p.CH() + (size_t)(c * NCH + n) * 5 * 4096);
#pragma unroll
        for (int u = 0; u < 10; ++u) stg[u] = src[tid + 256 * u];
        gam_next = p.GAM()[c * NCH + n]; };
    auto lstore = [&]() {
#pragma unroll
        for (int u = 0; u < 10; ++u) { const int ci = tid + 256 * u, mat = ci >> 9, row = (ci >> 3) & 63, cc = ci & 7; LAS u32x2* d = (LAS u32x2*)(lds + mat * MB + row * RS + cc * 16);
            d[0] = (u32x2){stg[u].x, stg[u].y}; d[1] = (u32x2){stg[u].z, stg[u].w}; } };
    auto afrag = [&](int mat, int row, int a2) -> bf16x8 { const LAS unsigned char* bp = lds + mat * MB + row * RS + (32 * a2 + 4 * q) * 2;
        const u32x2 lo = *(const LAS u32x2*)bp, hi = *(const LAS u32x2*)(bp + 32); u32x4 w; w.x = lo.x; w.y = lo.y; w.z = hi.x; w.w = hi.y; return __builtin_bit_cast(bf16x8, w); };
    auto pack2 = [&](const f32x4& x, const f32x4& y) -> bf16x8 { u32x4 w; w.x = pk_bf16(x[0], x[1]); w.y = pk_bf16(x[2], x[3]); w.z = pk_bf16(y[0], y[1]); w.w = pk_bf16(y[2], y[3]); return __builtin_bit_cast(bf16x8, w); };
    __syncthreads();
    gload(0); lstore(); float gam = gam_next;
    __syncthreads();
    const int sgn = dir == 0 ? 1 : -1;
    for (int n = 0; n < NCH; ++n) {
        if (n + 1 < NCH) gload(n + 1);
        const bf16x8 sb0 = pack2(Sb[0], Sb[1]), sb1 = pack2(Sb[2], Sb[3]);
        bf16x8 fw[8], fq[8]; u32x2 uu[4];
#pragma unroll
        for (int i = 0; i < 8; ++i) fw[i] = afrag(1, 16 * (i >> 1) + r16, i & 1);
#pragma unroll
        for (int tb = 0; tb < 4; ++tb) uu[tb] = *(const LAS u32x2*)(lds + 0 * MB + (16 * wave + r16) * RS + (16 * tb + 4 * q) * 2);
#pragma unroll
        for (int i = 0; i < 8; ++i) fq[i] = afrag(2, 16 * (i >> 1) + r16, i & 1);
        __builtin_amdgcn_sched_barrier(0);
        f32x4 vn[4], oc[4];
#pragma unroll
        for (int tb = 0; tb < 4; ++tb) {
            f32x4 acc = (f32x4){0.f, 0.f, 0.f, 0.f};
            acc = __builtin_amdgcn_mfma_f32_16x16x32_bf16(fw[2 * tb], sb0, acc, 0, 0, 0);
            acc = __builtin_amdgcn_mfma_f32_16x16x32_bf16(fw[2 * tb + 1], sb1, acc, 0, 0, 0);
            vn[tb][0] = bf_lo(uu[tb].x) - acc[0]; vn[tb][1] = bf_hi(uu[tb].x) - acc[1]; vn[tb][2] = bf_lo(uu[tb].y) - acc[2]; vn[tb][3] = bf_hi(uu[tb].y) - acc[3];
        }
        __builtin_amdgcn_sched_barrier(0);
        bf16x8 fm[8];
#pragma unroll
        for (int i = 0; i < 8; ++i) fm[i] = afrag(3, 16 * (i >> 1) + r16, i & 1);
        __builtin_amdgcn_sched_barrier(0);
#pragma unroll
        for (int tb = 0; tb < 4; ++tb) {
            f32x4 o = (f32x4){0.f, 0.f, 0.f, 0.f};
            o = __builtin_amdgcn_mfma_f32_16x16x32_bf16(fq[2 * tb], sb0, o, 0, 0, 0);
            o = __builtin_amdgcn_mfma_f32_16x16x32_bf16(fq[2 * tb + 1], sb1, o, 0, 0, 0);
            oc[tb] = o;
        }
        const bf16x8 vb0 = pack2(vn[0], vn[1]), vb1 = pack2(vn[2], vn[3]);
        __builtin_amdgcn_sched_barrier(0);
        bf16x8 fk[8];
#pragma unroll
        for (int i = 0; i < 8; ++i) fk[i] = afrag(4, 16 * (i >> 1) + r16, i & 1);
        __builtin_amdgcn_sched_barrier(0);
        const int row0 = gdn_row(b, dir, n, 0);
#pragma unroll
        for (int tb = 0; tb < 4; ++tb) {
            f32x4 o = oc[tb];
            o = __builtin_amdgcn_mfma_f32_16x16x32_bf16(fm[2 * tb], vb0, o, 0, 0, 0);
            o = __builtin_amdgcn_mfma_f32_16x16x32_bf16(fm[2 * tb + 1], vb1, o, 0, 0, 0);
            oc[tb] = o;
        }
#pragma unroll
        for (int db = 0; db < 4; ++db) {
            f32x4 sn = Sb[db] * gam;
            sn = __builtin_amdgcn_mfma_f32_16x16x32_bf16(fk[2 * db], vb0, sn, 0, 0, 0);
            sn = __builtin_amdgcn_mfma_f32_16x16x32_bf16(fk[2 * db + 1], vb1, sn, 0, 0, 0);
            Sb[db] = sn;
        }
#pragma unroll
        for (int tb = 0; tb < 4; ++tb) {
#pragma unroll
            for (int u = 0; u < 4; ++u) stf(dst + (size_t)(row0 + sgn * (16 * tb + 4 * q + u)) * (GH * GDV), oc[tb][u]);
        }
        __syncthreads();
        if (n + 1 < NCH) { lstore(); gam = gam_next; }
        __syncthreads();
    }
}
#endif


#ifndef HOST_EMU
enum { R_NORM1 = 0, R_POST1 = 1, R_POST2 = 2, R_XFORM = 3, R_GOUT = 4, R_ROUTE2 = 5 };
template <int CTRL> __device__ __forceinline__ float dpp_f(float v) { return __builtin_bit_cast(float, __builtin_amdgcn_update_dpp(0, __builtin_bit_cast(int, v), CTRL, 0xF, 0xF, true)); }
__device__ __forceinline__ float rdlane_f(float v, int l) { return __builtin_bit_cast(float, __builtin_amdgcn_readlane(__builtin_bit_cast(int, v), l)); }
__device__ __forceinline__ float wave_sum(float v) {
    v += dpp_f<0xB1>(v); v += dpp_f<0x4E>(v); v += dpp_f<0x141>(v); v += dpp_f<0x140>(v);
    return (rdlane_f(v, 0) + rdlane_f(v, 16)) + (rdlane_f(v, 32) + rdlane_f(v, 48));
}
__device__ __forceinline__ void ld_row_f32(const float* p, int lane, f32x4 (&v)[D / 256]) {
#pragma unroll
    for (int j = 0; j < D / 256; ++j) v[j] = *(const f32x4*)(p + 4 * lane + 256 * j); }
__device__ __forceinline__ void ld_row_bf16(const st_t* p, int lane, f32x4 (&v)[D / 256]) {
#pragma unroll
    for (int j = 0; j < D / 256; ++j) { const u32x2 w = *(const u32x2*)(p + 4 * lane + 256 * j); v[j] = (f32x4){bf_lo(w.x), bf_hi(w.x), bf_lo(w.y), bf_hi(w.y)}; } }
__device__ __forceinline__ void st_row_bf16(st_t* p, int lane, const f32x4 (&v)[D / 256]) {
#pragma unroll
    for (int j = 0; j < D / 256; ++j) st4(p + 4 * lane + 256 * j, v[j][0], v[j][1], v[j][2], v[j][3]); }
__device__ __forceinline__ float sumsq(const f32x4 (&v)[D / 256]) { float s = 0.f;
#pragma unroll
    for (int j = 0; j < D / 256; ++j) s += (v[j][0] * v[j][0] + v[j][1] * v[j][1]) + (v[j][2] * v[j][2] + v[j][3] * v[j][3]);
    return wave_sum(s); }
template <bool TO_LDS>
__device__ __forceinline__ void modulate_store(const f32x4 (&x)[D / 256], float rstd, const float* gain, const float* sc, const float* sh, st_t* hrow, int lane, LAS float* hl, int swz = 0) {
    f32x4 g[D / 256], a[D / 256], b[D / 256], h[D / 256]; ld_row_f32(gain, lane, g); ld_row_f32(sc, lane, a); ld_row_f32(sh, lane, b);
#pragma unroll
    for (int j = 0; j < D / 256; ++j) h[j] = x[j] * rstd * g[j] * (a[j] + 1.0f) + b[j];
    st_row_bf16(hrow, lane, h);
    if constexpr (TO_LDS) {
#pragma unroll
        for (int j = 0; j < D / 256; ++j) *(LAS f32x4*)(hl + (((lane + 64 * j) ^ swz) << 2)) = h[j]; }
}
__device__ __forceinline__ void row_norm1(const Params& p, int layer, int r, int lane) {
    f32x4 x[D / 256]; ld_row_f32(xin_row(p, layer, r), lane, x);
    const float rstd = rsqrt_f(sumsq(x) / D + EPS);
    modulate_store<false>(x, rstd, p.mix_norm_pre + (size_t)layer * D, mod_vec(p, layer, r, 1), mod_vec(p, layer, r, 0), p.H() + (size_t)r * D, lane, (LAS float*)0);
}
__device__ __forceinline__ void route_pick(const Params& p, int layer, int r, int lane, float logit, LAS int* lcnt);
template <int NR>
__device__ __forceinline__ void row_post1_multi(const Params& p, int layer, int item, int lane, LAS float* hl, LAS int* lcnt) {
#pragma unroll
    for (int rr = 0; rr < NR; ++rr) { const int r = NR * item + rr;
        f32x4 y[D / 256], x[D / 256], g1[D / 256], gp[D / 256]; ld_row_bf16(p.Y() + (size_t)r * D, lane, y); ld_row_f32(xin_row(p, layer, r), lane, x);
        ld_row_f32(mod_vec(p, layer, r, 2), lane, g1); ld_row_f32(p.mix_norm_post + (size_t)layer * D, lane, gp);
        const float rstd = rsqrt_f(sumsq(y) / D + EPS);
#pragma unroll
        for (int j = 0; j < D / 256; ++j) x[j] = x[j] + g1[j] * y[j] * rstd * gp[j];
        float* xr = xrow(p, r);
#pragma unroll
        for (int j = 0; j < D / 256; ++j) *(f32x4*)(xr + 4 * lane + 256 * j) = x[j];
        const float r2 = rsqrt_f(sumsq(x) / D + EPS);
        modulate_store<true>(x, r2, p.ffn_norm_pre + (size_t)layer * D, mod_vec(p, layer, r, 4), mod_vec(p, layer, r, 3), p.H() + (size_t)r * D, lane, hl + rr * D);
    }
    asm volatile("s_waitcnt lgkmcnt(0)" ::: "memory");
    const float* wr = p.router_w + (size_t)layer * D * NE + lane; float acc[NR];
#pragma unroll
    for (int rr = 0; rr < NR; ++rr) acc[rr] = 0.f;
#pragma unroll 4
    for (int d4 = 0; d4 < D / 4; ++d4) { f32x4 hv[NR];
#pragma unroll
        for (int rr = 0; rr < NR; ++rr) hv[rr] = *(const LAS f32x4*)(hl + rr * D + 4 * d4);
#pragma unroll
        for (int u = 0; u < 4; ++u) { const float w = wr[(size_t)(4 * d4 + u) * NE];
#pragma unroll
            for (int rr = 0; rr < NR; ++rr) acc[rr] += hv[rr][u] * w; } }
#pragma unroll
    for (int rr = 0; rr < NR; ++rr) route_pick(p, layer, NR * item + rr, lane, acc[rr], lcnt);
    asm volatile("s_waitcnt lgkmcnt(0)" ::: "memory");
}
#if PROBE_SEL >= 40 && PROBE_SEL <= 43
#define P1SEC(n) do { const unsigned long long now_ = __builtin_amdgcn_s_memrealtime(); if (PROBE_SEL == 40 + (n)) pbv += now_ - last_; last_ = now_; } while (0)
#else
#define P1SEC(n) do { } while (0)
#endif
__device__ __forceinline__ void block_post1(const Params& p, int layer, int j16, int lane, int wave, LAS unsigned char* lds, LAS int* lcnt, unsigned long long& pbv) {
    LAS float* hl = (LAS float*)lds;
    asm volatile("s_nop 0\n\ts_nop 0\n\ts_nop 0\n\ts_nop 0\n\ts_nop 0\n\ts_nop 0\n\ts_nop 0\n\ts_nop 0\n\ts_nop 0");
#if PROBE_SEL >= 40 && PROBE_SEL <= 43
    unsigned long long last_ = __builtin_amdgcn_s_memrealtime();
#endif
#pragma unroll
    for (int rr = 0; rr < 4; ++rr) { const int r16 = 4 * wave + rr, r = 16 * j16 + r16;
        f32x4 y[D / 256], x[D / 256], g1[D / 256], gp[D / 256]; ld_row_bf16(p.Y() + (size_t)r * D, lane, y); ld_row_f32(xin_row(p, layer, r), lane, x);
        ld_row_f32(mod_vec(p, layer, r, 2), lane, g1); ld_row_f32(p.mix_norm_post + (size_t)layer * D, lane, gp);
        const float rstd = rsqrt_f(sumsq(y) / D + EPS);
#pragma unroll
        for (int j = 0; j < D / 256; ++j) x[j] = x[j] + g1[j] * y[j] * rstd * gp[j];
        float* xr = xrow(p, r);
#pragma unroll
        for (int j = 0; j < D / 256; ++j) *(f32x4*)(xr + 4 * lane + 256 * j) = x[j];
        const float r2 = rsqrt_f(sumsq(x) / D + EPS);
        modulate_store<true>(x, r2, p.ffn_norm_pre + (size_t)layer * D, mod_vec(p, layer, r, 4), mod_vec(p, layer, r, 3), p.H() + (size_t)r * D, lane, hl + r16 * D, r16);
    }
    P1SEC(0);
    __syncthreads();
    P1SEC(1);
    const int row = lane & 15, kq = lane >> 4;
    const float* wr = p.router_w + (size_t)layer * D * NE + (size_t)(256 * wave + 4 * kq) * NE + 4 * row;
    f32x4 acc[4];
#pragma unroll
    for (int jj = 0; jj < 4; ++jj) acc[jj] = (f32x4){0.f, 0.f, 0.f, 0.f};
#pragma unroll 1
    for (int bt = 0; bt < 8; ++bt) {
        f32x4 bq[8], aq[2];
        const float* wb = wr + (size_t)(32 * bt) * NE; asm volatile("" : "+v"(wb));
#pragma unroll
        for (int b2 = 0; b2 < 2; ++b2) { const int c = 64 * wave + 8 * bt + 4 * b2 + kq;
            aq[b2] = *(const LAS f32x4*)(hl + row * D + ((c ^ row) << 2));
#pragma unroll
            for (int u = 0; u < 4; ++u) bq[4 * b2 + u] = *(const f32x4*)(wb + (size_t)(16 * b2 + u) * NE); }
        __builtin_amdgcn_sched_barrier(0);
#pragma unroll
        for (int b2 = 0; b2 < 2; ++b2)
#pragma unroll
            for (int u = 0; u < 4; ++u)
#pragma unroll
                for (int jj = 0; jj < 4; ++jj) acc[jj] = __builtin_amdgcn_mfma_f32_16x16x4f32(aq[b2][u], bq[4 * b2 + u][jj], acc[jj], 0, 0, 0);
        __builtin_amdgcn_sched_barrier(0);
    }
    P1SEC(2);
    __syncthreads();
#pragma unroll
    for (int r = 0; r < 4; ++r) *(LAS f32x4*)(hl + (wave * 16 + 4 * kq + r) * NE + 4 * row) = (f32x4){acc[0][r], acc[1][r], acc[2][r], acc[3][r]};
    __syncthreads();
#pragma unroll
    for (int rr = 0; rr < 4; ++rr) { const int r16 = 4 * wave + rr; float lg = 0.f;
#pragma unroll
        for (int w2 = 0; w2 < 4; ++w2) lg += hl[(w2 * 16 + r16) * NE + lane];
        route_pick(p, layer, 16 * j16 + r16, lane, lg, lcnt); }
    asm volatile("s_waitcnt lgkmcnt(0)" ::: "memory");
    __syncthreads();
    P1SEC(3);
}
__device__ __forceinline__ void route_row(const Params& p, int layer, int r, int lane, float logit) {
    const float sg = sigmoid_f(logit), v = sg + p.router_bias[(size_t)layer * NE + lane];
    float m1 = v; int i1 = lane;
#pragma unroll
    for (int o = 1; o < 8; o <<= 1) { const float ov = __shfl_xor(m1, o); const int oi = __shfl_xor(i1, o); if (ov > m1 || (ov == m1 && oi < i1)) { m1 = ov; i1 = oi; } }
    float m2 = lane == i1 ? -3.0e38f : v;
#pragma unroll
    for (int o = 1; o < 8; o <<= 1) m2 = fmaxf(m2, __shfl_xor(m2, o));
    const float gs = m1 + m2; const int grp = lane >> 3;
    int grank = 0;
#pragma unroll
    for (int j = 0; j < NGRP; ++j) { const float og = __shfl(gs, j * 8); grank += (og > gs || (og == gs && j < grp)) ? 1 : 0; }
    const float mv = grank < TOPG ? v : -3.0e38f;
    int rank = 0;
#pragma unroll
    for (int j = 0; j < NE; ++j) { const float ov = __shfl(mv, j); rank += (ov > mv || (ov == mv && j < lane)) ? 1 : 0; }
    const bool sel = rank < TOPK;
    const float wsum = wave_sum(sel ? sg : 0.f);
    if (sel) { const float w = sg / wsum * ROUTED_SCALE; const int pos = atomicAdd(p.CNT() + layer * NE + lane, 1); atomicAdd(p.CNTP() + (layer * NE + lane) * 32, 1);
        p.EIDX()[(size_t)r * TOPK + rank] = lane; p.EPOS()[(size_t)r * TOPK + rank] = pos; p.TOKLIST()[(size_t)lane * TA + pos] = r; p.WLIST()[(size_t)lane * TA + pos] = w; }
}
__device__ __forceinline__ void row_post1_quad(const Params& p, int layer, int quad, int lane, LAS float* hl) {
#pragma unroll
    for (int rr = 0; rr < 4; ++rr) { const int r = 4 * quad + rr;
        f32x4 y[D / 256], x[D / 256], g1[D / 256], gp[D / 256]; ld_row_bf16(p.Y() + (size_t)r * D, lane, y); ld_row_f32(xin_row(p, layer, r), lane, x);
        ld_row_f32(mod_vec(p, layer, r, 2), lane, g1); ld_row_f32(p.mix_norm_post + (size_t)layer * D, lane, gp);
        const float rstd = rsqrt_f(sumsq(y) / D + EPS);
#pragma unroll
        for (int j = 0; j < D / 256; ++j) x[j] = x[j] + g1[j] * y[j] * rstd * gp[j];
        float* xr = xrow(p, r);
#pragma unroll
        for (int j = 0; j < D / 256; ++j) *(f32x4*)(xr + 4 * lane + 256 * j) = x[j];
        const float r2 = rsqrt_f(sumsq(x) / D + EPS);
        modulate_store<true>(x, r2, p.ffn_norm_pre + (size_t)layer * D, mod_vec(p, layer, r, 4), mod_vec(p, layer, r, 3), p.H() + (size_t)r * D, lane, hl + rr * D);
    }
    asm volatile("s_waitcnt lgkmcnt(0)" ::: "memory");
    const float* wr = p.router_w + (size_t)layer * D * NE + lane; float a0 = 0.f, a1 = 0.f, a2 = 0.f, a3 = 0.f;
#pragma unroll 4
    for (int d4 = 0; d4 < D / 4; ++d4) { const f32x4 h0 = *(const LAS f32x4*)(hl + 4 * d4), h1 = *(const LAS f32x4*)(hl + D + 4 * d4), h2 = *(const LAS f32x4*)(hl + 2 * D + 4 * d4), h3 = *(const LAS f32x4*)(hl + 3 * D + 4 * d4);
#pragma unroll
        for (int u = 0; u < 4; ++u) { const float w = wr[(size_t)(4 * d4 + u) * NE]; a0 += h0[u] * w; a1 += h1[u] * w; a2 += h2[u] * w; a3 += h3[u] * w; } }
    route_row(p, layer, 4 * quad, lane, a0); route_row(p, layer, 4 * quad + 1, lane, a1); route_row(p, layer, 4 * quad + 2, lane, a2); route_row(p, layer, 4 * quad + 3, lane, a3);
    asm volatile("s_waitcnt lgkmcnt(0)" ::: "memory");
}
__device__ __forceinline__ void route_pick(const Params& p, int layer, int r, int lane, float logit, LAS int* lcnt) {
    const float sg = sigmoid_f(logit), v = sg + p.router_bias[(size_t)layer * NE + lane];
    float m1 = v; int i1 = lane;
#pragma unroll
    for (int o = 1; o < 8; o <<= 1) { const float ov = __shfl_xor(m1, o); const int oi = __shfl_xor(i1, o); if (ov > m1 || (ov == m1 && oi < i1)) { m1 = ov; i1 = oi; } }
    float m2 = lane == i1 ? -3.0e38f : v;
#pragma unroll
    for (int o = 1; o < 8; o <<= 1) m2 = fmaxf(m2, __shfl_xor(m2, o));
    const float gs = m1 + m2; const int grp = lane >> 3;
    int grank = 0;
#pragma unroll
    for (int j = 0; j < NGRP; ++j) { const float og = __builtin_bit_cast(float, __builtin_amdgcn_readlane(__builtin_bit_cast(int, gs), j * 8)); grank += (og > gs || (og == gs && j < grp)) ? 1 : 0; }
    const float mv = grank < TOPG ? v : -3.0e38f;
    int rank = 0;
#pragma unroll
    for (int j = 0; j < NE; ++j) { const float ov = __builtin_bit_cast(float, __builtin_amdgcn_readlane(__builtin_bit_cast(int, mv), j)); rank += (ov > mv || (ov == mv && j < lane)) ? 1 : 0; }
    const bool sel = rank < TOPK;
    const float wsum = wave_sum(sel ? sg : 0.f);
    if (sel) { p.EIDX()[(size_t)r * TOPK + rank] = lane; p.EW()[(size_t)r * TOPK + rank] = sg / wsum * ROUTED_SCALE; __hip_atomic_fetch_add(lcnt + lane, 1, __ATOMIC_RELAXED, __HIP_MEMORY_SCOPE_WORKGROUP); }
}
__device__ __forceinline__ void route_place(const Params& p, int layer, LAS unsigned char* lds, int tid, int lane, int wave) {
    LAS int* pb = (LAS int*)lds; LAS int* lpos = pb + NE;
    __syncthreads();
    { const int e = tid & (NE - 1), qd = tid >> 6, per = ((int)gridDim.x + 3) / 4; int below = 0, tot = 0; const int* bc = p.BCNT() + e;
      const int b_hi = (qd + 1) * per < (int)gridDim.x ? (qd + 1) * per : (int)gridDim.x;
#pragma unroll 8
      for (int b2 = qd * per; b2 < b_hi; ++b2) { const int c = bc[(size_t)b2 * NE]; tot += c; below += b2 < (int)blockIdx.x ? c : 0; }
      LAS int* red = lpos + NE; red[tid] = below; red[256 + tid] = tot; }
    __syncthreads();
    if (tid < NE) { LAS int* red = lpos + NE; pb[tid] = red[tid] + red[64 + tid] + red[128 + tid] + red[192 + tid]; lpos[tid] = 0;
        if (blockIdx.x == 0) p.CNT()[layer * NE + tid] = red[256 + tid] + red[320 + tid] + red[384 + tid] + red[448 + tid]; }
    __syncthreads();
    const int gw = blockIdx.x * 4 + wave, nw = gridDim.x * 4;
    for (int i = gw; i < rows_out(layer) / POST1_NR; i += nw) {
        if (lane < POST1_NR * TOPK) { const int r = POST1_NR * i + (lane >> 3), k = lane & 7; const int e = p.EIDX()[(size_t)r * TOPK + k]; const float w = p.EW()[(size_t)r * TOPK + k];
            const int pos = pb[e] + __hip_atomic_fetch_add(lpos + e, 1, __ATOMIC_RELAXED, __HIP_MEMORY_SCOPE_WORKGROUP);
            p.EPOS()[(size_t)r * TOPK + k] = pos; p.TOKLIST()[(size_t)e * TA + pos] = r; p.WLIST()[(size_t)e * TA + pos] = w; }
    }
}
__device__ __forceinline__ void row_post2(const Params& p, int layer, int r, int lane, const int* eb) {
    int slot = 0;
    if (lane < TOPK) { const int e = p.EIDX()[(size_t)r * TOPK + lane]; slot = eb[e] + p.EPOS()[(size_t)r * TOPK + lane]; }
    f32x4 f[D / 256]; ld_row_bf16(p.SH() + (size_t)r * D, lane, f);
#pragma unroll
    for (int k = 0; k < TOPK; ++k) { const int sk = __shfl(slot, k); f32x4 t[D / 256]; ld_row_bf16(p.YB() + (size_t)sk * D, lane, t);
#pragma unroll
        for (int j = 0; j < D / 256; ++j) f[j] += t[j]; }
    const float rstd = rsqrt_f(sumsq(f) / D + EPS);
    float* xr = xrow(p, r); f32x4 x[D / 256], g2[D / 256], gp[D / 256]; ld_row_f32(xr, lane, x); ld_row_f32(mod_vec(p, layer, r, 5), lane, g2); ld_row_f32(p.ffn_norm_post + (size_t)layer * D, lane, gp);
#pragma unroll
    for (int j = 0; j < D / 256; ++j) { x[j] = x[j] + g2[j] * f[j] * rstd * gp[j]; *(f32x4*)(xr + 4 * lane + 256 * j) = x[j]; }
    if (layer + 1 < DEPTH) { const float r2 = rsqrt_f(sumsq(x) / D + EPS);
        modulate_store<false>(x, r2, p.mix_norm_pre + (size_t)(layer + 1) * D, mod_vec(p, layer + 1, r, 1), mod_vec(p, layer + 1, r, 0), p.H() + (size_t)r * D, lane, (LAS float*)0); }
}
__device__ __forceinline__ void unpack8(const u32x4 w, float (&x)[8]) { x[0] = bf_lo(w.x); x[1] = bf_hi(w.x); x[2] = bf_lo(w.y); x[3] = bf_hi(w.y); x[4] = bf_lo(w.z); x[5] = bf_hi(w.z); x[6] = bf_lo(w.w); x[7] = bf_hi(w.w); }
__device__ __forceinline__ u32x4 pack8(const float (&x)[8]) { u32x4 o; o.x = pk_bf16(x[0], x[1]); o.y = pk_bf16(x[2], x[3]); o.z = pk_bf16(x[4], x[5]); o.w = pk_bf16(x[6], x[7]); return o; }
__device__ __forceinline__ void row_xform(const Params& p, int layer, int r, int lane, const LAS float* cw) {
    int lo, hi; seq_bounds(r, lo, hi);
    const st_t* prow = p.P() + (size_t)r * DPROJP;
#pragma unroll
    for (int gi = 0; gi < 3; ++gi) {
        if (gi < 2 || lane < 16) {
            const int c0 = 8 * (lane + 64 * gi); float acc[8];
#pragma unroll
            for (int e = 0; e < 8; ++e) acc[e] = 0.f;
#pragma unroll
            for (int j = 0; j < GCONV; ++j) { const int rr = r + j - 2;
                if (rr >= lo && rr < hi) { float x[8]; unpack8(*(const u32x4*)(p.P() + (size_t)rr * DPROJP + PO_GQKV + c0), x);
                    const f32x4 w0 = *(const LAS f32x4*)(cw + j * GQKV + c0), w1 = *(const LAS f32x4*)(cw + j * GQKV + c0 + 4);
#pragma unroll
                    for (int e = 0; e < 4; ++e) { acc[e] += w0[e] * x[e]; acc[4 + e] += w1[e] * x[4 + e]; } } }
            float ss = 0.f;
#pragma unroll
            for (int e = 0; e < 8; ++e) { acc[e] = silu_f(acc[e]); ss += acc[e] * acc[e]; }
            if (gi < 2) {
                ss += __shfl_xor(ss, 1); ss += __shfl_xor(ss, 2); ss += __shfl_xor(ss, 4);
                const float rn = c0 < 2 * GH * GDK ? rsqrt_f(ss + EPS) : 1.0f;
#pragma unroll
                for (int e = 0; e < 8; ++e) acc[e] *= rn; }
            *(u32x4*)(p.G() + (size_t)r * GQKV + c0) = pack8(acc);
        }
    }
    if (lane < 12) { const float beta = sigmoid_f(ldf(prow + PO_BA + lane)), a = ldf(prow + PO_BA + 12 + lane);
        p.BG()[(size_t)r * 24 + lane] = beta; p.BG()[(size_t)r * 24 + 12 + lane] = -expf(p.gdn_a_log[layer * 12 + lane]) * softplus_f(a + p.gdn_dt_bias[layer * 12 + lane]); }
    { float x[8]; float ss = 0.f;
      if (lane < MQR / 8) { unpack8(*(const u32x4*)(prow + PO_CQ + 8 * lane), x);
#pragma unroll
          for (int e = 0; e < 8; ++e) ss += x[e] * x[e]; }
      const float rstd = rsqrt_f(wave_sum(ss) / MQR + EPS);
      if (lane < MQR / 8) { const float* gn = p.mla_q_norm + (size_t)layer * MQR + 8 * lane;
#pragma unroll
          for (int e = 0; e < 8; ++e) x[e] = x[e] * rstd * gn[e];
          *(u32x4*)(p.CQN() + (size_t)r * MQR + 8 * lane) = pack8(x); } }
    { float x[8]; float ss = 0.f;
      if (lane < MKVR / 8) { unpack8(*(const u32x4*)(prow + PO_CKV + 8 * lane), x);
#pragma unroll
          for (int e = 0; e < 8; ++e) ss += x[e] * x[e]; }
      const float rstd = rsqrt_f(wave_sum(ss) / MKVR + EPS);
      if (lane < MKVR / 8) { const float* gn = p.mla_kv_norm + (size_t)layer * MKVR + 8 * lane;
#pragma unroll
          for (int e = 0; e < 8; ++e) x[e] = x[e] * rstd * gn[e];
          *(u32x4*)(p.CKVN() + (size_t)r * MKVR + 8 * lane) = pack8(x); } }
}
__device__ __forceinline__ void row_mla_merge(const Params& p, int r, int lane) {
    if (NSPLIT == 1 || r >= T || lane >= MH * MV / 8) return;
    const int h = lane / (MV / 8); float mc[NSPLIT], lc[NSPLIT], mx = -3.0e38f;
#pragma unroll
    for (int c = 0; c < NSPLIT; ++c) { const float* ml = p.MLPART() + (((size_t)c * T + r) * MH + h) * 2; mc[c] = ml[0]; lc[c] = ml[1]; mx = fmaxf(mx, mc[c]); }
    float o[8], wsum = 0.f;
#pragma unroll
    for (int e = 0; e < 8; ++e) o[e] = 0.f;
#pragma unroll
    for (int c = 0; c < NSPLIT; ++c) { const float w = lc[c] * __builtin_amdgcn_exp2f(mc[c] - mx); wsum += w; float x[8]; unpack8(*(const u32x4*)(p.OPART() + ((size_t)c * T + r) * MH * MV + 8 * lane), x);
#pragma unroll
        for (int e = 0; e < 8; ++e) o[e] += w * x[e]; }
    const float inv = __builtin_amdgcn_rcpf(wsum);
#pragma unroll
    for (int e = 0; e < 8; ++e) o[e] *= inv;
    *(u32x4*)(p.O() + (size_t)r * DMIX + (SWA_H + GH) * 64 + 8 * lane) = pack8(o);
}
__device__ __forceinline__ void row_gout(const Params& p, int layer, int r, int lane) {
    row_mla_merge(p, r, lane);
    float o[8]; float ss = 0.f; const bool act = lane < GH * GDV / 8;
    if (act) { float a[8], b[8]; unpack8(*(const u32x4*)(p.OF() + (size_t)r * (GH * GDV) + 8 * lane), a); unpack8(*(const u32x4*)(p.OB() + (size_t)r * (GH * GDV) + 8 * lane), b);
#pragma unroll
        for (int e = 0; e < 8; ++e) { o[e] = a[e] + b[e]; ss += o[e] * o[e]; } }
    ss += __shfl_xor(ss, 1); ss += __shfl_xor(ss, 2); ss += __shfl_xor(ss, 4);
    if (act) { const float rstd = rsqrt_f(ss / GDV + EPS); float z[8]; unpack8(*(const u32x4*)(p.P() + (size_t)r * DPROJP + PO_Z + 8 * lane), z);
        const float* nw = p.gdn_norm_w + layer * GDV + (8 * lane) % GDV;
#pragma unroll
        for (int e = 0; e < 8; ++e) o[e] = o[e] * rstd * nw[e] * silu_f(z[e]);
        *(u32x4*)(p.O() + (size_t)r * DMIX + GH * GDV + 8 * lane) = pack8(o); }
}
__device__ __forceinline__ void mod_block(const Params& p, int item, LAS unsigned char* lds, int tid) {
    const int lane = tid & 63, wave = __builtin_amdgcn_readfirstlane(tid >> 6); const int ly = item / (6 * D / 64), jb = item % (6 * D / 64);
    LAS float* sl = (LAS float*)lds; LAS float* red = sl + 3 * D;
    __syncthreads();
    for (int i = tid; i < 3 * D; i += 256) { const int w = i / D, k = i % D; sl[i] = silu_f(w < 2 ? p.c[(size_t)w * D + k] : p.c_ctx[k]); }
    __syncthreads();
    const float* W = p.ada_w + (size_t)ly * D * 6 * D + jb * 64 + lane; float a0 = 0.f, a1 = 0.f, a2 = 0.f;
#pragma unroll 8
    for (int k = wave * (D / 4); k < (wave + 1) * (D / 4); ++k) { const float w = W[(size_t)k * 6 * D]; a0 += sl[k] * w; a1 += sl[D + k] * w; a2 += sl[2 * D + k] * w; }
    red[(wave * 3 + 0) * 64 + lane] = a0; red[(wave * 3 + 1) * 64 + lane] = a1; red[(wave * 3 + 2) * 64 + lane] = a2;
    __syncthreads();
    if (wave < 3) { const float v = red[(0 * 3 + wave) * 64 + lane] + red[(1 * 3 + wave) * 64 + lane] + red[(2 * 3 + wave) * 64 + lane] + red[(3 * 3 + wave) * 64 + lane];
        p.MOD()[((size_t)(ly * 3 + wave) * 6 * D) + jb * 64 + lane] = v + p.ada_b[(size_t)ly * 6 * D + jb * 64 + lane]; }
}
#endif


#ifndef HOST_EMU
#define XB_TMO      128
#define XB_XCNT(j)  (256  + 64 * (j))
#define XB_XSUB(j)  (1280 + 64 * (j))
#define XB_XGEN(j)  (2304 + 64 * (j))
#define XB_TOP      3328
#define XB_TOPGEN   3392
#define XCD_BAR_WORDS 3456
#define XB_SPIN_CAP (1u << 18)

__device__ __forceinline__ unsigned xb_ld(unsigned* p)              { return __hip_atomic_load(p, __ATOMIC_RELAXED, __HIP_MEMORY_SCOPE_AGENT); }
__device__ __forceinline__ unsigned xb_add(unsigned* p, unsigned v) { return __hip_atomic_fetch_add(p, v, __ATOMIC_RELAXED, __HIP_MEMORY_SCOPE_AGENT); }
__device__ __forceinline__ unsigned xb_xcc_id() { return (unsigned)__builtin_amdgcn_s_getreg((3 << 11) | 20) & 0xFu; }
#define XB_SPIN(cond, bar) do { unsigned _sp = 0; while (cond) { __builtin_amdgcn_s_sleep(1); \
    if ((++_sp & 255u) == 0u) { if (xb_ld(&(bar)[XB_TMO])) break; if (_sp > XB_SPIN_CAP) { atomicAdd(&(bar)[XB_TMO], 1u); break; } } } } while (0)

struct XcdBarrier {
    unsigned* bar; unsigned x;
    volatile LAS unsigned* st;
};

__device__ __forceinline__ XcdBarrier xcd_barrier_post(unsigned* bar, volatile LAS unsigned* st) {
    XcdBarrier b; b.bar = bar; b.x = xb_xcc_id(); b.st = st;
    if (threadIdx.x == 0) (void)xb_add(&bar[XB_XCNT(b.x)], 1u);
    return b;
}
__device__ __forceinline__ void xcd_barrier_complete(unsigned* bar, unsigned x, unsigned& nloc, unsigned& nx) {
    const unsigned G = gridDim.x * gridDim.y * gridDim.z;
    unsigned sum, cnt, mine, sp = 0u;
    for (;;) {
        sum = 0u; cnt = 0u; mine = 0u;
#pragma unroll
        for (unsigned j = 0; j < 16; ++j) { const unsigned c = xb_ld(&bar[XB_XCNT(j)]); sum += c; cnt += (c > 0u) ? 1u : 0u; mine = (j == x) ? c : mine; }
        if (sum == G) break;
        __builtin_amdgcn_s_sleep(1);
        if ((++sp & 255u) == 0u) { if (xb_ld(&bar[XB_TMO])) break; if (sp > XB_SPIN_CAP) { atomicAdd(&bar[XB_TMO], 1u); break; } }
    }
    nloc = mine > 0u ? mine : 1u; nx = cnt > 0u ? cnt : 1u;
}

__device__ __forceinline__ void xcd_barrier(const XcdBarrier& b) {
    asm volatile("s_waitcnt vmcnt(0)" ::: "memory");
    __syncthreads();
    if (threadIdx.x == 0) {
        unsigned* bar = b.bar;
        __builtin_amdgcn_s_waitcnt(0);
        unsigned nloc = b.st[0], nx = b.st[1];
        if (nloc == 0u) { xcd_barrier_complete(bar, b.x, nloc, nx); b.st[0] = nloc; b.st[1] = nx; }
        const unsigned old = xb_add(&bar[XB_XSUB(b.x)], 1u);
        const unsigned gen = old / nloc;
        if (old + 1u == (gen + 1u) * nloc) {
            __builtin_amdgcn_fence(__ATOMIC_RELEASE, "agent");
            asm volatile("s_waitcnt vmcnt(0)" ::: "memory");
            const unsigned og = xb_add(&bar[XB_TOP], 1u);
            const unsigned tg = og / nx;
            if (og + 1u == (tg + 1u) * nx) xb_add(&bar[XB_TOPGEN], 1u);
            else XB_SPIN(xb_ld(&bar[XB_TOPGEN]) == tg, bar);
            __builtin_amdgcn_fence(__ATOMIC_ACQUIRE, "agent");
            xb_add(&bar[XB_XGEN(b.x)], 1u);
            asm volatile("s_waitcnt vmcnt(0)" ::: "memory");
        } else {
            XB_SPIN(xb_ld(&bar[XB_XGEN(b.x)]) == gen, bar);
            __builtin_amdgcn_fence(__ATOMIC_ACQUIRE, "agent");
            asm volatile("s_waitcnt vmcnt(0)" ::: "memory");
        }
    }
    __syncthreads();
}

#endif

enum { K_ITEM = 0, K_WT = 1, K_GEMM = 2, K_ATTN = 3, K_GPRE = 4, K_ROW = 5, K_MOD = 6 };
struct Step { int kind, st, layer, sync_before; };
inline int build_program(Step* prog) {
    int n = 0;
    prog[n++] = {K_ITEM, ST_ZERO, 0, 0}; prog[n++] = {K_ITEM, ST_TAB, 0, 0}; prog[n++] = {USE_KMOD ? K_MOD : K_ITEM, USE_KMOD ? 0 : ST_MOD, 0, 0}; prog[n++] = {K_WT, WT_STATIC, 0, 0};
    for (int l = 0; l < DEPTH; ++l) {
        if (l == 0 || !USE_RPOST2) { if (USE_RNORM1) prog[n++] = {K_ROW, 0  , l, 1}; else prog[n++] = {K_ITEM, ST_NORM1, l, 1}; }
        prog[n++] = {K_GEMM, G_PROJ, l, 1};
        prog[n++] = {K_ROW, 3  , l, 1};
        prog[n++] = {K_GEMM, G_UQ, l, 1}; prog[n++] = {K_GEMM, G_UKV, l, 0}; prog[n++] = {K_GPRE, 0, l, 0};
        prog[n++] = {K_ATTN, 0, l, 1};
        prog[n++] = {K_ROW, 4  , l, 1};
        prog[n++] = {K_GEMM, G_WOUT, l, 1}; prog[n++] = {K_WT, WT_EXPERT, l, 0};
        if (USE_RPOST1) { prog[n++] = {K_ROW, 1  , l, 1}; prog[n++] = {K_ROW, 5  , l, 1}; } else { prog[n++] = {K_ITEM, ST_POST1, l, 1}; prog[n++] = {K_ITEM, ST_ROUTER, l, 1}; prog[n++] = {K_ITEM, ST_ROUTE, l, 1}; }
        prog[n++] = {K_GEMM, G_SGU, l, 1}; prog[n++] = {K_GEMM, G_EGU, l, 0};
        prog[n++] = {K_GEMM, G_SDOWN, l, 1}; prog[n++] = {K_GEMM, G_EDOWN, l, 0};
        if (USE_RPOST2) prog[n++] = {K_ROW, 2  , l, 1}; else prog[n++] = {K_ITEM, ST_POST2, l, 1};
    }
    return n;
}
constexpr int MAX_STEPS = 64;

#ifndef HOST_EMU
namespace cg = cooperative_groups;
struct Prog { Step s[MAX_STEPS]; int n; int pad[3]; };

__global__ void __launch_bounds__(256, 2) k_mega(Params p, Prog pr) {
    extern __shared__ __attribute__((aligned(16))) unsigned char smem[];
    LAS unsigned char* lds = (LAS unsigned char*)smem;
    cg::grid_group grid = cg::this_grid();
    { volatile LAS unsigned* bst = (volatile LAS unsigned*)(lds + 65536); if (threadIdx.x < 2) bst[threadIdx.x] = 0u; }
    __syncthreads();
    (void)xcd_barrier_post(p.BAR(), (volatile LAS unsigned*)(lds + 65536));
#define XBAR_NOW() do { XcdBarrier xb_; xb_.bar = p.BAR(); xb_.x = xb_xcc_id(); xb_.st = (volatile LAS unsigned*)(lds + 65536); xcd_barrier(xb_); } while (0)
    bool first_sync = true;
    const long long gthreads = (long long)gridDim.x * 256;
    unsigned long long pb_chain = 0; (void)pb_chain;
#if PROBE_SEL
    unsigned long long pb_acc = 0, pb_t0 = __builtin_amdgcn_s_memrealtime(); bool pb_on = false;
#endif
    for (int s = 0; s < pr.n; ++s) {
        const int kind = pr.s[s].kind, st = pr.s[s].st, layer = pr.s[s].layer;
#if PROBE_SEL
        const bool pb_match = (PROBE_SEL == 1 && kind == K_ROW && st == 1) || (PROBE_SEL == 2 && ((kind == K_ITEM && st == ST_ROUTE) || (kind == K_ROW && st == 5))) || (PROBE_SEL == 3 && kind == K_ROW && st == 2) || (PROBE_SEL == 4 && kind == K_ROW && st == 3) ||
            (PROBE_SEL == 5 && kind == K_ROW && st == 4) || (PROBE_SEL == 6 && kind == K_ATTN) || (PROBE_SEL == 7 && kind == K_GEMM && st == G_PROJ) || (PROBE_SEL == 8 && kind == K_GEMM && st == G_WOUT) ||
            (PROBE_SEL == 9 && kind == K_GEMM && st == G_EGU) || (PROBE_SEL == 10 && kind == K_GEMM && st == G_EDOWN) || (PROBE_SEL == 11 && kind == K_GPRE) || (PROBE_SEL == 12 && kind == K_WT && st == WT_STATIC) || (PROBE_SEL == 13 && kind == K_WT && st == WT_EXPERT) || (PROBE_SEL == 14 && kind == K_ROW && st == 0) || (PROBE_SEL == 30 && kind == K_GEMM) || (PROBE_SEL == 31 && kind == K_ROW && st != 1) || (PROBE_SEL == 32 && (kind == K_GPRE || kind == K_WT || kind == K_ITEM || kind == K_MOD));
#endif
        if (pr.s[s].sync_before) { if (first_sync) { grid.sync(); first_sync = false; } else XBAR_NOW();
#if PROBE_SEL
            { const unsigned long long now = __builtin_amdgcn_s_memrealtime(); if (pb_on) pb_acc += now - pb_t0; pb_t0 = now; pb_on = false; }
#endif
        }
#if PROBE_SEL
        if (pb_match) pb_on = true;
#endif
        int reps = 1;
        if (PROBE_MASK) { const int grp = kind == K_GEMM ? 0 : kind == K_ATTN ? 1 : kind == K_GPRE ? 2 : kind == K_WT ? 3 : (kind == K_ROW && (st == R_XFORM || st == R_GOUT || st == R_NORM1)) ? 4 : 7;
            if (grp < 5 && ((PROBE_MASK >> grp) & 1)) reps = 2; if (((PROBE_MASK >> 5) & 1) && pr.s[s].sync_before) XBAR_NOW(); }
        for (int rep = 0; rep < reps; ++rep) {
        if (rep > 0 && ((PROBE_MASK >> 6) & 1)) XBAR_NOW();
        int tid = threadIdx.x; asm volatile("" : "+v"(tid));
        const int lane = tid & 63, wave = __builtin_amdgcn_readfirstlane(tid >> 6);
        const long long gtid = (long long)blockIdx.x * 256 + tid;
        ETab et{nullptr, nullptr};
        if ((kind == K_GEMM && (st == G_EGU || st == G_EDOWN)) || (kind == K_ROW && st == R_POST2)) {
            LAS int* eb = (LAS int*)(lds + 65536 + 64); LAS int* tb = eb + 72;
            __syncthreads();
            if (wave == 0) { const int c = FUSE_ROUTE ? p.CNTP()[(layer * NE + lane) * 32] : p.CNT()[layer * NE + lane]; int a = c, t = (c + 127) >> 7;
#pragma unroll
                for (int o = 1; o < 64; o <<= 1) { const int ua = __shfl_up(a, o), ut = __shfl_up(t, o); if (lane >= o) { a += ua; t += ut; } }
                eb[lane + 1] = a; tb[lane + 1] = t; if (lane == 0) { eb[0] = 0; tb[0] = 0; } }
            __syncthreads();
            et.eb = (const int*)eb; et.tb = (const int*)tb;
        }
        if (kind == K_ITEM) {
            const long long n = n_items(st, layer);
#define RUN_ST(ST) case ST: for (long long i = gtid; i < n; i += gthreads) run_item(p, ST, layer, i); break;
            switch (st) {
#if !USE_KMOD
                RUN_ST(ST_MOD)
#endif
#if !USE_RNORM1
                RUN_ST(ST_NORM1)
#endif
#if !USE_RPOST1
                RUN_ST(ST_POST1) RUN_ST(ST_ROUTER)
#endif
#if !USE_RPOST2
                RUN_ST(ST_POST2)
#endif
                RUN_ST(ST_ZERO) RUN_ST(ST_TAB)
#if !USE_RPOST1 || !FUSE_ROUTE
                RUN_ST(ST_ROUTE)
#endif
                default: break; }
#undef RUN_ST
        } else if (kind == K_WT) {
            const long long n = wt_items(p, st); LAS float* scr = (LAS float*)(lds + wave * (64 * 33 * 4));
            for (long long i = (long long)blockIdx.x * 4 + wave; i < n; i += (long long)gridDim.x * 4) wt_item_dev(p, st, layer, i, scr, lane);
        } else if (kind == K_GEMM) {
            const int n = gemm_ntiles(p, st, layer, et);
            const int q8 = n >> 3, r8 = n & 7;
            for (int i = blockIdx.x; i < n; i += gridDim.x) {
                const int x = i & 7, tau = (x < r8 ? x * (q8 + 1) : r8 * (q8 + 1) + (x - r8) * q8) + (i >> 3);
                GemmDesc g; gemm_desc(p, st, layer, tau, g, et); gemm_tile_dev(g, lds, tid); }
        } else if (kind == K_ROW) {
            const int gw = blockIdx.x * 4 + wave, nw = gridDim.x * 4;
            if (st == R_NORM1) { for (int r = gw; r < TA; r += nw) row_norm1(p, layer, r, lane); }
            else if (st == R_POST1) { __syncthreads();
#if FUSE_ROUTE
                LAS float* hl = (LAS float*)(lds + wave * (4 * D * 4)); for (int i = gw; i < rows_out(layer) / 4; i += nw) row_post1_quad(p, layer, i, lane, hl);
#else
                LAS float* hl = (LAS float*)(lds + wave * (POST1_NR * D * 4)); LAS int* lcnt = (LAS int*)(lds + 65536 + 640);
                if (tid < NE) lcnt[tid] = 0;
                __syncthreads();
                (void)hl; for (int j16 = blockIdx.x; j16 < rows_out(layer) / 16; j16 += gridDim.x) block_post1(p, layer, j16, lane, wave, lds, lcnt, pb_chain);
                __syncthreads();
                if (tid < NE) p.BCNT()[(size_t)blockIdx.x * NE + tid] = lcnt[tid];
#endif
            }
            else if (st == R_ROUTE2) route_place(p, layer, lds, tid, lane, wave);
            else if (st == R_POST2) { for (int r = gw; r < rows_out(layer); r += nw) row_post2(p, layer, r, lane, et.eb); }
            else if (st == R_XFORM) { __syncthreads(); LAS float* cw = (LAS float*)lds; for (int i = tid; i < GCONV * GQKV; i += 256) cw[i] = p.gdn_conv_w[(size_t)layer * GCONV * GQKV + i]; __syncthreads();
                for (int r = gw; r < TA; r += nw) row_xform(p, layer, r, lane, cw); }
            else { for (int r = gw; r < rows_out(layer); r += nw) row_gout(p, layer, r, lane); }
        } else if (kind == K_MOD) {
            for (int i = blockIdx.x; i < DEPTH * (6 * D / 64); i += gridDim.x) mod_block(p, i, lds, tid);
        } else if (kind == K_GPRE) {
            const int n = NCHAIN * NCH / 2;
            for (int i = blockIdx.x; i < n; i += gridDim.x) gdn_pre_dev(p, i, lds, tid);
        } else {
            LAS int* slot = (LAS int*)(lds + 65536 + 16); const int x0 = (int)(xb_xcc_id() & 7u);
            for (int qs = 0; qs < 8; ++qs) {
                const int x = (x0 + qs) & 7, nq = attn_queue_size(layer, x);
                for (;;) {
                    __syncthreads(); if (tid == 0) *slot = atomicAdd(p.CTR() + layer * 16 + rep * 8 + x, 1); __syncthreads();
                    const int k = *slot; if (k >= nq) break;
                    const int item = attn_queue_item(layer, x, k);
                    int t2 = tid; asm volatile("" : "+v"(t2));
#if PROBE_SEL == 24
                    if (item < NCHAIN) { const unsigned long long c0 = __builtin_amdgcn_s_memrealtime(); gdn_scan_dev(p, item, lds, t2); pb_chain += __builtin_amdgcn_s_memrealtime() - c0; continue; }
#else
                    if (item < NCHAIN) { gdn_scan_dev(p, item, lds, t2); continue; }
#endif
                    AttnDesc a; attn_desc(p, layer, item - NCHAIN, a);
                    if (a.dqk == 96) attn_tile_dev<96>(a, lds, t2); else attn_tile_dev<64>(a, lds, t2);
                }
            }
        }
        }
    }
#if PROBE_SEL
    { const unsigned long long now = __builtin_amdgcn_s_memrealtime(); if (pb_on) pb_acc += now - pb_t0;
      if (PROBE_SEL == 24 || PROBE_SEL >= 40) pb_acc = pb_chain;
      if (blockIdx.x == 0 || PROBE_SEL == 24 || PROBE_SEL >= 40) { const unsigned long long until = now + 4ull * pb_acc; while (__builtin_amdgcn_s_memrealtime() < until) __builtin_amdgcn_s_sleep(32); } }
#endif
}

extern "C" void kernel_launch(void* const* d_in, const int* in_sizes, int n_in, void* d_out, int out_size, void* d_ws, size_t ws_size, hipStream_t stream) {
    Params p{};
    const float** pin = (const float**)&p;
    for (int i = 0; i < 29 && i < n_in; ++i) pin[i] = (const float*)d_in[i];
    p.out = (float*)d_out;
    const size_t need = carve(p, (char*)d_ws);
    if (need > ws_size) { fprintf(stderr, "kernel_launch: workspace too small: need %zu have %zu\n", need, ws_size); return; }
    Prog pr{}; pr.n = build_program(pr.s);
    constexpr int LDS_BYTES = 65536 + 1024;
    static int grid_blocks = 0;
    if (!grid_blocks) {
        int dev = 0, cus = 0, per_cu = 0;
        (void)hipGetDevice(&dev);
        (void)hipDeviceGetAttribute(&cus, hipDeviceAttributeMultiprocessorCount, dev);
        (void)hipFuncSetAttribute((const void*)k_mega, hipFuncAttributeMaxDynamicSharedMemorySize, LDS_BYTES);
        (void)hipOccupancyMaxActiveBlocksPerMultiprocessor(&per_cu, k_mega, 256, LDS_BYTES);
        if (per_cu > 2) per_cu = 2;
        if (per_cu < 1) per_cu = 1;
        grid_blocks = cus * per_cu;
    }
    (void)hipMemsetAsync(p.BAR(), 0, 4096 * 4, stream);
    void* args[] = {&p, &pr};
    hipError_t e = hipLaunchCooperativeKernel((void*)k_mega, dim3(grid_blocks), dim3(256), args, LDS_BYTES, stream);
    if (e != hipSuccess) fprintf(stderr, "cooperative launch failed: %s (grid %d)\n", hipGetErrorString(e), grid_blocks);
}
#endif
```

```cpp
#ifndef HOST_EMU
#include <hip/hip_runtime.h>
#include <hip/hip_cooperative_groups.h>
#include <cstdio>
#define HD __host__ __device__ __forceinline__
#else
#include <cmath>
#include <cstdio>
#include <cstring>
#define HD inline
#endif
#include <cstdint>
#include <utility>

#ifndef CFG_D
#define CFG_D 1024
#endif
#ifndef CFG_S
#define CFG_S 8192
#endif
#ifndef CFG_L
#define CFG_L 256
#endif
#ifndef CFG_DE
#define CFG_DE 256
#endif
#ifndef CFG_DS
#define CFG_DS 256
#endif
#ifndef PROBE_SEL
#define PROBE_SEL 0
#endif
#ifndef PROBE_MASK
#define PROBE_MASK 0
#endif
#ifndef POST1_NR
#define POST1_NR 4
#endif
#ifndef FUSE_ROUTE
#define FUSE_ROUTE 0
#endif
#ifndef USE_KMOD
#define USE_KMOD 1
#endif
#ifndef USE_RNORM1
#define USE_RNORM1 1
#endif
#ifndef USE_RPOST1
#define USE_RPOST1 1
#endif
#ifndef USE_RPOST2
#define USE_RPOST2 1
#endif

namespace cfg {
constexpr int D = CFG_D, B = 2, S = CFG_S, L = CFG_L, DEPTH = 2, GRID_W = 64;
constexpr int T = B * S, TC = B * L, TA = T + TC;
constexpr int SWA_H = 6, SWA_KVH = 2, SWA_G = 3, SWA_W = 128;
constexpr int GH = 6, GDK = 64, GDV = 64, GCONV = 5;
constexpr int MH = 4, MQR = 192, MKVR = 128, MNOPE = 64, MROPE = 32, MV = 64, MQD = MNOPE + MROPE, MKVD = MNOPE + MV;
constexpr int DMIX = 1024, GQKV = 1152;
constexpr int PO_QA = 0, PO_KA = 384, PO_VA = 512, PO_GQKV = 640, PO_Z = 1792, PO_BA = 2176, PO_CQ = 2200, PO_CKV = 2392, PO_KR = 2528  , PO_KR_SRC = 2520, DPROJ = 2552, DPROJP = 2560;
constexpr int NE = 64, TOPK = 8, NGRP = 8, TOPG = 4, DE = CFG_DE, DS = CFG_DS;
constexpr float EPS = 1e-6f, ROUTED_SCALE = 2.5f;
constexpr int NSLOT = TA * TOPK, NK = S + L, NCHAIN = B * GH * 2, NCH = (S + L) / 64;
constexpr int NSPLIT = (NK / 64) % 4 == 0 ? 4 : ((NK / 64) % 2 == 0 ? 2 : 1);
static_assert(D % 128 == 0 && DE % 64 == 0 && DS % 64 == 0 && TA % 128 == 0 && T % 128 == 0, "tile divisibility");
}
using namespace cfg;

#ifdef HOST_EMU
typedef float st_t;
HD float ldf(const st_t* p) { return *p; }
HD void stf(st_t* p, float v) { *p = v; }
HD void st4(st_t* p, float a, float b, float c, float d) { p[0] = a; p[1] = b; p[2] = c; p[3] = d; }
#else
typedef unsigned short st_t;
typedef short bf16x8 __attribute__((ext_vector_type(8)));
typedef float f32x4 __attribute__((ext_vector_type(4)));
typedef float f32x2 __attribute__((ext_vector_type(2)));
typedef __bf16 bf16x2_t __attribute__((ext_vector_type(2)));
#define LAS __attribute__((address_space(3)))
HD float ldf(const st_t* p) { unsigned u = ((unsigned)*p) << 16; float f; __builtin_memcpy(&f, &u, 4); return f; }
HD unsigned short f2bf(float v) { unsigned u; __builtin_memcpy(&u, &v, 4); u = (u + 0x7fffu + ((u >> 16) & 1u)) >> 16; return (unsigned short)u; }
HD void stf(st_t* p, float v) { *p = f2bf(v); }
HD float ldf(const float* p) { return *p; }
HD void stf(float* p, float v) { *p = v; }
__device__ __forceinline__ unsigned pk_bf16(float lo, float hi) { f32x2 v = {lo, hi}; return __builtin_bit_cast(unsigned, __builtin_convertvector(v, bf16x2_t)); }
HD void st4(st_t* p, float a, float b, float c, float d) {
#if defined(__HIP_DEVICE_COMPILE__)
    uint2 w; w.x = pk_bf16(a, b); w.y = pk_bf16(c, d); *(uint2*)p = w;
#else
    p[0] = f2bf(a); p[1] = f2bf(b); p[2] = f2bf(c); p[3] = f2bf(d);
#endif
}
#endif

HD void st8_nt(st_t* p, const float (&a)[4], const float (&b)[4]) {
#if defined(__HIP_DEVICE_COMPILE__)
    typedef unsigned u32x4_nt __attribute__((ext_vector_type(4)));
    u32x4_nt w; w.x = pk_bf16(a[0], a[1]); w.y = pk_bf16(a[2], a[3]); w.z = pk_bf16(b[0], b[1]); w.w = pk_bf16(b[2], b[3]); __builtin_nontemporal_store(w, (u32x4_nt*)p);
#else
    for (int i = 0; i < 4; ++i) { stf(p + i, a[i]); stf(p + 4 + i, b[i]); }
#endif
}
HD void st8(st_t* p, const float (&a)[4], const float (&b)[4]) {
#if defined(__HIP_DEVICE_COMPILE__)
    uint4 w; w.x = pk_bf16(a[0], a[1]); w.y = pk_bf16(a[2], a[3]); w.z = pk_bf16(b[0], b[1]); w.w = pk_bf16(b[2], b[3]); *(uint4*)p = w;
#else
    for (int i = 0; i < 4; ++i) { stf(p + i, a[i]); stf(p + 4 + i, b[i]); }
#endif
}
#if defined(__HIP_DEVICE_COMPILE__)
__device__ __forceinline__ float fast_exp(float x) { return __builtin_amdgcn_exp2f(x * 1.4426950408889634f); }
__device__ __forceinline__ float silu_f(float x) { return x * __builtin_amdgcn_rcpf(1.0f + fast_exp(-x)); }
__device__ __forceinline__ float sigmoid_f(float x) { return __builtin_amdgcn_rcpf(1.0f + fast_exp(-x)); }
__device__ __forceinline__ float softplus_f(float x) { return x > 20.f ? x : 0.6931471805599453f * __builtin_amdgcn_logf(1.0f + fast_exp(x)); }
__device__ __forceinline__ float rsqrt_f(float x) { return __builtin_amdgcn_rsqf(x); }
#else
HD float silu_f(float x) { return x / (1.0f + expf(-x)); }
HD float sigmoid_f(float x) { return 1.0f / (1.0f + expf(-x)); }
HD float softplus_f(float x) { return x > 20.f ? x : log1pf(expf(x)); }
HD float rsqrt_f(float x) { return 1.0f / sqrtf(x); }
#endif

struct TJob { const float* src; st_t* dst; int K, N, npad, grp, off, ldt, ldsrc, gran; };
constexpr int NJOBS = 16;

struct WsOff { size_t BAR, MOD, TABA, TABM, XC, BG, LOGITS, EW, EIDX, EPOS, CNT, CNTP, CTR, GAM, TOKLIST, WLIST, H, Wt_in, Wt_out, Wt_uq, Wt_ukv, Wt_sgu, Wt_sd, SACT, ACT, Wt_egu, Wt_ed, CH,
               P, G, CQN, CKVN, MQ, MKV, O, VtM, VtA, OF, OB, YB, OPART, MLPART, BCNT, total; };
constexpr size_t align256(size_t v) { return (v + 255) & ~(size_t)255; }
constexpr WsOff make_ws() {
    WsOff w{}; size_t off = 0; const size_t E = sizeof(st_t);
#define TAKE(name, bytes) w.name = off; off = align256(off + (size_t)(bytes));
    TAKE(BAR, 4096 * 4)
    TAKE(MOD, (size_t)DEPTH * 3 * 6 * D * 4) TAKE(TABA, 128 * 16 * 2 * 4) TAKE(TABM, 128 * 8 * 2 * 4) TAKE(XC, (size_t)TC * D * 4) TAKE(BG, (size_t)TA * 24 * 4)
    TAKE(LOGITS, (size_t)TA * NE * 4) TAKE(EW, (size_t)TA * TOPK * 4) TAKE(EIDX, (size_t)TA * TOPK * 4) TAKE(EPOS, (size_t)TA * TOPK * 4)
    TAKE(BCNT, 1024 * NE * 4)
    TAKE(CNT, DEPTH * NE * 4) TAKE(CNTP, DEPTH * NE * 32 * 4) TAKE(CTR, DEPTH * 16 * 4) TAKE(GAM, (size_t)NCHAIN * NCH * 4) TAKE(TOKLIST, (size_t)NE * TA * 4) TAKE(WLIST, (size_t)NE * TA * 4)
    TAKE(H, (size_t)TA * D * E)
    TAKE(Wt_in, (size_t)DEPTH * DPROJP * D * E) TAKE(Wt_out, (size_t)DEPTH * D * DMIX * E) TAKE(Wt_uq, (size_t)DEPTH * MH * MQD * MQR * E) TAKE(Wt_ukv, (size_t)DEPTH * MH * MKVD * MKVR * E)
    TAKE(Wt_sgu, (size_t)DEPTH * 2 * DS * D * E) TAKE(Wt_sd, (size_t)DEPTH * D * DS * E)
    const size_t q0 = off;
    TAKE(SACT, (size_t)TA * DS * E) TAKE(ACT, ((size_t)NSLOT * DE * E > (size_t)TA * D * E ? (size_t)NSLOT * DE * E : (size_t)TA * D * E))
    TAKE(Wt_egu, (size_t)NE * 2 * DE * D * E) TAKE(Wt_ed, (size_t)NE * D * DE * E)
    w.CH = q0; { const size_t chb = align256((size_t)NCHAIN * NCH * 5 * 4096 * E); if (q0 + chb > off) off = q0 + chb; }
    const size_t r0 = off;
    TAKE(P, (size_t)TA * DPROJP * E) TAKE(G, (size_t)TA * GQKV * E) TAKE(CQN, (size_t)TA * MQR * E) TAKE(CKVN, (size_t)TA * MKVR * E) TAKE(MQ, (size_t)TA * MH * MQD * E) TAKE(MKV, (size_t)TA * MH * MKVD * E)
    TAKE(O, (size_t)TA * DMIX * E) TAKE(VtM, (size_t)B * MH * MV * NK * E) TAKE(VtA, (size_t)B * SWA_KVH * 64 * NK * E) TAKE(OF, (size_t)TA * GH * GDV * E) TAKE(OB, (size_t)TA * GH * GDV * E)
#undef TAKE
    w.YB = r0; { const size_t yb = align256((size_t)NSLOT * D * E); if (r0 + yb > off) off = r0 + yb; }
    if ((size_t)NSPLIT * T * MH * MV * E <= (size_t)TA * D * E) w.OPART = w.H; else { w.OPART = off; off = align256(off + (size_t)NSPLIT * T * MH * MV * E); }
    if ((size_t)NSPLIT * T * MH * 2 * 4 <= (size_t)TA * NE * 4) w.MLPART = w.LOGITS; else { w.MLPART = off; off = align256(off + (size_t)NSPLIT * T * MH * 2 * 4); }
    w.total = off; return w;
}
constexpr WsOff WS = make_ws();

struct Params {
    const float *x, *c, *ctx, *c_ctx, *ada_w, *ada_b, *mix_norm_pre, *mix_norm_post, *ffn_norm_pre, *ffn_norm_post,
        *w_in, *w_out, *swa_sink, *gdn_conv_w, *gdn_a_log, *gdn_dt_bias, *gdn_norm_w, *mla_q_norm, *mla_w_uq, *mla_kv_norm, *mla_w_ukv,
        *router_w, *router_bias, *e_gate, *e_up, *e_down, *s_gate, *s_up, *s_down;
    float* out;
    char* ws;
#define WSF(T, name, field) HD T* name() const { return (T*)(ws + WS.field); }
    WSF(unsigned, BAR, BAR) WSF(float, MOD, MOD) WSF(float, TABA, TABA) WSF(float, TABM, TABM) WSF(float, XC, XC) WSF(float, BG, BG) WSF(float, LOGITS, LOGITS) WSF(float, EW, EW)
    WSF(int, EIDX, EIDX) WSF(int, EPOS, EPOS) WSF(int, CNT, CNT) WSF(int, CNTP, CNTP) WSF(int, CTR, CTR) WSF(float, GAM, GAM) WSF(int, TOKLIST, TOKLIST) WSF(float, WLIST, WLIST)
    WSF(st_t, H, H) WSF(st_t, SH, H) WSF(st_t, Wt_in, Wt_in) WSF(st_t, Wt_out, Wt_out) WSF(st_t, Wt_uq, Wt_uq) WSF(st_t, Wt_ukv, Wt_ukv) WSF(st_t, Wt_sgu, Wt_sgu) WSF(st_t, Wt_sd, Wt_sd)
    WSF(st_t, SACT, SACT) WSF(st_t, ACT, ACT) WSF(st_t, Y, ACT) WSF(st_t, Wt_egu, Wt_egu) WSF(st_t, Wt_ed, Wt_ed) WSF(st_t, CH, CH)
    WSF(st_t, P, P) WSF(st_t, G, G) WSF(st_t, CQN, CQN) WSF(st_t, CKVN, CKVN) WSF(st_t, MQ, MQ) WSF(st_t, MKV, MKV) WSF(st_t, O, O) WSF(st_t, VtM, VtM) WSF(st_t, VtA, VtA)
    WSF(st_t, OF, OF) WSF(st_t, OB, OB) WSF(st_t, YB, YB)
    WSF(st_t, OPART, OPART) WSF(float, MLPART, MLPART) WSF(int, BCNT, BCNT)
#undef WSF
};
inline size_t carve(Params& p, char* ws) { p.ws = ws; return WS.total; }

HD TJob static_job(const Params& p, int j) {
    const int l = j / (NJOBS / DEPTH), k = j % (NJOBS / DEPTH);
    switch (k) {
    case 0: return TJob{p.w_in + (size_t)l * D * DPROJ, p.Wt_in() + (size_t)l * DPROJP * D, D, PO_KR_SRC, PO_KR, 16, 0, D, DPROJ, 16};
    case 1: return TJob{p.w_in + (size_t)l * D * DPROJ + PO_KR_SRC, p.Wt_in() + (size_t)l * DPROJP * D + (size_t)PO_KR * D, D, MROPE, MROPE, 16, 0, D, DPROJ, 16};
    case 2: return TJob{p.w_out + (size_t)l * DMIX * D, p.Wt_out() + (size_t)l * D * DMIX, DMIX, D, D, 16, 0, DMIX, D, 16};
    case 3: return TJob{p.mla_w_uq + (size_t)l * MQR * MH * MQD, p.Wt_uq() + (size_t)l * MH * MQD * MQR, MQR, MH * MQD, MH * MQD, 16, 0, MQR, MH * MQD, 16};
    case 4: return TJob{p.mla_w_ukv + (size_t)l * MKVR * MH * MKVD, p.Wt_ukv() + (size_t)l * MH * MKVD * MKVR, MKVR, MH * MKVD, MH * MKVD, 16, 0, MKVR, MH * MKVD, 16};
    case 5: return TJob{p.s_gate + (size_t)l * D * DS, p.Wt_sgu() + (size_t)l * 2 * DS * D, D, DS, DS, 8, 0, D, DS, 4};
    case 6: return TJob{p.s_up + (size_t)l * D * DS, p.Wt_sgu() + (size_t)l * 2 * DS * D, D, DS, DS, 8, 4, D, DS, 4};
    default: return TJob{p.s_down + (size_t)l * DS * D, p.Wt_sd() + (size_t)l * D * DS, DS, D, D, 16, 0, DS, D, 16};
    }
}
HD long long static_job_items(int j) {
    const int k = j % (NJOBS / DEPTH);
    const int K = k == 2 ? DMIX : k == 3 ? MQR : k == 4 ? MKVR : k == 7 ? DS : D;
    const int npad = k == 0 ? PO_KR : k == 1 ? MROPE : k == 2 ? D : k == 3 ? MH * MQD : k == 4 ? MH * MKVD : k == 7 ? D : DS;
    return (long long)(K / 64) * ((npad + 31) / 32);
}

HD int mod_which(int r) { return r < T ? r / S : 2; }
HD const float* mod_vec(const Params& p, int layer, int r, int chunk) { return p.MOD() + ((size_t)(layer * 3 + mod_which(r)) * 6 + chunk) * D; }
HD void seq_bounds(int r, int& lo, int& hi) { if (r < T) { lo = (r / S) * S; hi = lo + S; } else { lo = T + ((r - T) / L) * L; hi = lo + L; } }
HD float* xrow(const Params& p, int r) { return r < T ? p.out + (size_t)r * D : p.XC() + (size_t)(r - T) * D; }
HD const float* xin_row(const Params& p, int layer, int r) { if (layer > 0) return xrow(p, r); return r < T ? p.x + (size_t)r * D : p.ctx + (size_t)(r - T) * D; }
HD int rows_out(int layer) { return layer == DEPTH - 1 ? T : TA; }
HD int expert_base(const int* cnt, int e) { int b = 0; for (int i = 0; i < e; ++i) b += cnt[i]; return b; }

#ifdef HOST_EMU
inline int atomic_inc(int* p) { int v;
#pragma omp atomic capture
    { v = *p; *p += 1; }
    return v; }
#else
__device__ __forceinline__ int atomic_inc(int* p) { return atomicAdd(p, 1); }
#endif

enum Stage { ST_MOD = 0, ST_ZERO, ST_NORM1, ST_ROPE_SWA, ST_GDN_CONV, ST_GDN_L2, ST_GDN_GATE, ST_MLA_NORM, ST_ROPE_MLA,
             ST_SWA, ST_GDN_SCAN, ST_GDN_OUT, ST_MLA, ST_POST1, ST_ROUTER, ST_ROUTE, ST_POST2, ST_VT, ST_TAB, ST_COUNT };

HD long long n_items(int st, int layer) {
    switch (st) {
    case ST_MOD: return (long long)DEPTH * 3 * 6 * D;
    case ST_ZERO: return DEPTH * NE + DEPTH * 16 + DEPTH * NE * 32;
    case ST_VT: return (long long)(B * MH + B * SWA_KVH) * (NK / 8) * 64;
    case ST_TAB: return 128 * 16 + 128 * 8;
    case ST_NORM1: return TA;
    case ST_ROPE_SWA: return (long long)T * 8 * 32;
    case ST_GDN_CONV: return (long long)TA * GQKV;
    case ST_GDN_L2: return (long long)TA * 12;
    case ST_GDN_GATE: return (long long)TA * 12;
    case ST_MLA_NORM: return (long long)TA * 2;
    case ST_ROPE_MLA: return (long long)T * 5 * 16;
    case ST_SWA: return (long long)rows_out(layer) * SWA_H;
    case ST_GDN_SCAN: return (long long)B * GH * 2 * GDV;
    case ST_GDN_OUT: return (long long)rows_out(layer) * GH;
    case ST_MLA: return (long long)rows_out(layer) * MH;
    case ST_POST1: return rows_out(layer);
    case ST_ROUTER: return (long long)rows_out(layer) * NE;
    case ST_ROUTE: return rows_out(layer);
    case ST_POST2: return rows_out(layer);
    }
    return 0;
}

HD float rope_inv(int i, int n) { return exp2f(-(float)i / (float)n * 13.287712379549449f); }

HD void run_item(const Params& p, int st, int layer, long long i) {
    switch (st) {
    case ST_MOD: {
        const int j = (int)(i % (6 * D)); const int w = (int)((i / (6 * D)) % 3); const int ly = (int)(i / (6 * D * 3));
        const float* cv = w < 2 ? p.c + (size_t)w * D : p.c_ctx;
        const float* W = p.ada_w + (size_t)ly * D * 6 * D;
        float acc = p.ada_b[(size_t)ly * 6 * D + j];
        for (int k = 0; k < D; ++k) acc += silu_f(cv[k]) * W[(size_t)k * 6 * D + j];
        p.MOD()[i] = acc;
    } break;
    case ST_ZERO: if (i < DEPTH * NE) p.CNT()[i] = 0; else if (i < DEPTH * NE + DEPTH * 16) p.CTR()[i - DEPTH * NE] = 0; else p.CNTP()[i - DEPTH * NE - DEPTH * 16] = 0; break;
    case ST_TAB: {
        if (i < 128 * 16) { const int pos = (int)(i / 16), ii = (int)(i % 16); const float ang = (float)pos * rope_inv(ii, 16); p.TABA()[2 * i] = cosf(ang); p.TABA()[2 * i + 1] = sinf(ang); }
        else { const long long k = i - 128 * 16; const int pos = (int)(k / 8), ii = (int)(k % 8); const float ang = (float)pos * rope_inv(ii, 8); p.TABM()[2 * k] = cosf(ang); p.TABM()[2 * k + 1] = sinf(ang); }
    } break;
    case ST_VT: {
        const int dv = (int)(i % 64); long long r = i / 64; const int kc = (int)(r % (NK / 8)); const int bh = (int)(r / (NK / 8));
        const bool mla = bh < B * MH; const int b = mla ? bh / MH : (bh - B * MH) / SWA_KVH, hd = mla ? bh % MH : (bh - B * MH) % SWA_KVH;
        st_t* dst = (mla ? p.VtM() + ((size_t)(b * MH + hd) * 64 + dv) * NK : p.VtA() + ((size_t)(b * SWA_KVH + hd) * 64 + dv) * NK) + kc * 8;
        for (int j = 0; j < 8; ++j) { const int kidx = kc * 8 + j; const int row = kidx < S ? b * S + kidx : T + b * L + (kidx - S);
            dst[j] = mla ? p.MKV()[(size_t)row * MH * MKVD + hd * MKVD + MNOPE + dv] : p.P()[(size_t)row * DPROJP + PO_VA + hd * 64 + dv]; }
    } break;
    case ST_NORM1: {
        const int r = (int)i; const float* xr = xin_row(p, layer, r); float ss = 0.f;
        for (int d = 0; d < D; ++d) ss += xr[d] * xr[d];
        const float rstd = 1.0f / sqrtf(ss / D + EPS);
        const float* gain = p.mix_norm_pre + (size_t)layer * D; const float* sh = mod_vec(p, layer, r, 0); const float* sc = mod_vec(p, layer, r, 1);
        st_t* hr = p.H() + (size_t)r * D;
        for (int d = 0; d < D; ++d) stf(hr + d, xr[d] * rstd * gain[d] * (1.0f + sc[d]) + sh[d]);
    } break;
    case ST_ROPE_SWA: {
        const int j = (int)(i % 32), hh = (int)((i / 32) % 8), r = (int)(i / 256);
        const int s = r % S, rp = s / GRID_W, cp = s % GRID_W;
        const int base = hh < 6 ? PO_QA + hh * 64 : PO_KA + (hh - 6) * 64;
        const int half = j / 16, ii = j % 16; const int i1 = base + half * 32 + ii, i2 = i1 + 16;
        const float ang = (float)(half == 0 ? rp : cp) * rope_inv(ii, 16); const float cs = cosf(ang), sn = sinf(ang);
        st_t* pr = p.P() + (size_t)r * DPROJP; const float x1 = ldf(pr + i1), x2 = ldf(pr + i2);
        stf(pr + i1, x1 * cs - x2 * sn); stf(pr + i2, x1 * sn + x2 * cs);
    } break;
    case ST_GDN_CONV: {
        const int cc = (int)(i % GQKV), r = (int)(i / GQKV); int lo, hi; seq_bounds(r, lo, hi);
        const float* w = p.gdn_conv_w + (size_t)layer * GCONV * GQKV; float acc = 0.f;
        for (int j = 0; j < GCONV; ++j) { const int rr = r + j - 2; if (rr >= lo && rr < hi) acc += w[j * GQKV + cc] * ldf(p.P() + (size_t)rr * DPROJP + PO_GQKV + cc); }
        stf(p.G() + (size_t)r * GQKV + cc, silu_f(acc));
    } break;
    case ST_GDN_L2: {
        const int hh = (int)(i % 12), r = (int)(i / 12); st_t* g = p.G() + (size_t)r * GQKV + hh * 64; float ss = 0.f;
        for (int d = 0; d < 64; ++d) { const float v = ldf(g + d); ss += v * v; }
        const float rn = 1.0f / sqrtf(ss + EPS);
        for (int d = 0; d < 64; ++d) stf(g + d, ldf(g + d) * rn);
    } break;
    case ST_GDN_GATE: {
        const int j = (int)(i % 12), r = (int)(i / 12); const st_t* pr = p.P() + (size_t)r * DPROJP + PO_BA;
        const float beta = sigmoid_f(ldf(pr + j)); const float a = ldf(pr + 12 + j);
        const float g = -expf(p.gdn_a_log[layer * 12 + j]) * softplus_f(a + p.gdn_dt_bias[layer * 12 + j]);
        p.BG()[(size_t)r * 24 + j] = beta; p.BG()[(size_t)r * 24 + 12 + j] = g;
    } break;
    case ST_MLA_NORM: {
        const int w = (int)(i % 2), r = (int)(i / 2);
        const int n = w == 0 ? MQR : MKVR; const st_t* src = p.P() + (size_t)r * DPROJP + (w == 0 ? PO_CQ : PO_CKV);
        const float* gain = w == 0 ? p.mla_q_norm + (size_t)layer * MQR : p.mla_kv_norm + (size_t)layer * MKVR;
        st_t* dst = w == 0 ? p.CQN() + (size_t)r * MQR : p.CKVN() + (size_t)r * MKVR; float ss = 0.f;
        for (int d = 0; d < n; ++d) { const float v = ldf(src + d); ss += v * v; }
        const float rstd = 1.0f / sqrtf(ss / n + EPS);
        for (int d = 0; d < n; ++d) stf(dst + d, ldf(src + d) * rstd * gain[d]);
    } break;
    case ST_ROPE_MLA: {
        const int j = (int)(i % 16), w = (int)((i / 16) % 5), r = (int)(i / 80);
        const int s = r % S, rp = s / GRID_W, cp = s % GRID_W;
        const int half = j / 8, ii = j % 8; const float ang = (float)(half == 0 ? rp : cp) * rope_inv(ii, 8); const float cs = cosf(ang), sn = sinf(ang);
        st_t* q = w < 4 ? p.MQ() + (size_t)r * MH * MQD + w * MQD + MNOPE + half * 16 + ii : p.P() + (size_t)r * DPROJP + PO_KR + half * 16 + ii;
        const float x1 = ldf(q), x2 = ldf(q + 8); stf(q, x1 * cs - x2 * sn); stf(q + 8, x1 * sn + x2 * cs);
    } break;
    case ST_SWA: {
        const int h = (int)(i % SWA_H), r = (int)(i / SWA_H); const int kvh = h / SWA_G;
        float q[64], acc[64]; const st_t* qp = p.P() + (size_t)r * DPROJP + PO_QA + h * 64;
        _Pragma("unroll") for (int d = 0; d < 64; ++d) { q[d] = ldf(qp + d) * 0.125f; acc[d] = 0.f; }
        float m = p.swa_sink[layer * SWA_H + h], den = 1.0f;
        int b, klo = 0, khi = 0;
        if (r < T) { b = r / S; const int s = r % S; klo = s - SWA_W < 0 ? 0 : s - SWA_W; khi = s + SWA_W > S - 1 ? S - 1 : s + SWA_W; } else { b = (r - T) / L; khi = -1; }
        const int nloc = khi - klo + 1;
        for (int t = 0; t < nloc + L; ++t) {
            const int kr = t < nloc ? b * S + klo + t : T + b * L + (t - nloc);
            const st_t* kp = p.P() + (size_t)kr * DPROJP + PO_KA + kvh * 64; const st_t* vp = p.P() + (size_t)kr * DPROJP + PO_VA + kvh * 64;
            float sc = 0.f; _Pragma("unroll") for (int d = 0; d < 64; ++d) sc += q[d] * ldf(kp + d);
            if (sc > m) { const float f = expf(m - sc); den *= f; _Pragma("unroll") for (int d = 0; d < 64; ++d) acc[d] *= f; m = sc; }
            const float pe = expf(sc - m); den += pe;
            _Pragma("unroll") for (int d = 0; d < 64; ++d) acc[d] += pe * ldf(vp + d);
        }
        const float inv = 1.0f / den; st_t* o = p.O() + (size_t)r * DMIX + h * 64;
        _Pragma("unroll") for (int d = 0; d < 64; ++d) stf(o + d, acc[d] * inv);
    } break;
    case ST_GDN_SCAN: {
        const int e = (int)(i % GDV), dir = (int)((i / GDV) % 2), h = (int)((i / (GDV * 2)) % GH), b = (int)(i / (GDV * 2 * GH));
        float s[64]; _Pragma("unroll") for (int d = 0; d < 64; ++d) s[d] = 0.f;
        st_t* dst = dir == 0 ? p.OF() : p.OB();
        for (int t = 0; t < L + S; ++t) {
            int r; if (t < L) r = T + b * L + (dir == 0 ? t : L - 1 - t); else { const int u = t - L; r = b * S + (dir == 0 ? u : S - 1 - u); }
            const st_t* g = p.G() + (size_t)r * GQKV; const st_t* qv = g + h * 64; const st_t* kv = g + 384 + h * 64; const float v = ldf(g + 768 + h * 64 + e);
            const float beta = p.BG()[(size_t)r * 24 + dir * 6 + h], alpha = expf(p.BG()[(size_t)r * 24 + 12 + dir * 6 + h]);
            float ks = 0.f; _Pragma("unroll") for (int d = 0; d < 64; ++d) { s[d] *= alpha; ks += ldf(kv + d) * s[d]; }
            const float vn = beta * (v - ks); float o = 0.f;
            _Pragma("unroll") for (int d = 0; d < 64; ++d) { s[d] += ldf(kv + d) * vn; o += ldf(qv + d) * s[d]; }
            stf(dst + (size_t)r * (GH * GDV) + h * 64 + e, o * 0.125f);
        }
    } break;
    case ST_GDN_OUT: {
        const int h = (int)(i % GH), r = (int)(i / GH); const st_t* of = p.OF() + (size_t)r * 384 + h * 64; const st_t* ob = p.OB() + (size_t)r * 384 + h * 64;
        float ss = 0.f; for (int d = 0; d < 64; ++d) { const float o = ldf(of + d) + ldf(ob + d); ss += o * o; }
        const float rstd = 1.0f / sqrtf(ss / 64 + EPS); const float* nw = p.gdn_norm_w + layer * 64; const st_t* z = p.P() + (size_t)r * DPROJP + PO_Z + h * 64;
        st_t* o = p.O() + (size_t)r * DMIX + 384 + h * 64;
        for (int d = 0; d < 64; ++d) stf(o + d, (ldf(of + d) + ldf(ob + d)) * rstd * nw[d] * silu_f(ldf(z + d)));
    } break;
    case ST_MLA: {
        const int h = (int)(i % MH), r = (int)(i / MH); const float scale = 1.0f / sqrtf((float)MQD);
        float acc[64]; const st_t* qp = p.MQ() + (size_t)r * MH * MQD + h * MQD;
        _Pragma("unroll") for (int d = 0; d < 64; ++d) acc[d] = 0.f;
        float m = -1e30f, den = 0.f; int b, nlat;
        if (r < T) { b = r / S; nlat = S; } else { b = (r - T) / L; nlat = 0; }
        for (int t = 0; t < nlat + L; ++t) {
            const int kr = t < nlat ? b * S + t : T + b * L + (t - nlat);
            const st_t* kn = p.MKV() + (size_t)kr * MH * MKVD + h * MKVD; const st_t* krp = p.P() + (size_t)kr * DPROJP + PO_KR;
            float sc = 0.f; for (int d = 0; d < 64; ++d) sc += ldf(qp + d) * ldf(kn + d);
            for (int d = 0; d < 32; ++d) sc += ldf(qp + 64 + d) * ldf(krp + d);
            sc *= scale;
            if (sc > m) { const float f = expf(m - sc); den *= f; _Pragma("unroll") for (int d = 0; d < 64; ++d) acc[d] *= f; m = sc; }
            const float pe = expf(sc - m); den += pe;
            _Pragma("unroll") for (int d = 0; d < 64; ++d) acc[d] += pe * ldf(kn + 64 + d);
        }
        const float inv = 1.0f / den; st_t* o = p.O() + (size_t)r * DMIX + 768 + h * 64;
        _Pragma("unroll") for (int d = 0; d < 64; ++d) stf(o + d, acc[d] * inv);
    } break;
    case ST_POST1: {
        const int r = (int)i; const st_t* y = p.Y() + (size_t)r * D; const float* xi = xin_row(p, layer, r); float* xr = xrow(p, r); float ss = 0.f;
        for (int d = 0; d < D; ++d) { const float v = ldf(y + d); ss += v * v; }
        const float rstd = 1.0f / sqrtf(ss / D + EPS); const float* gp = p.mix_norm_post + (size_t)layer * D; const float* g1 = mod_vec(p, layer, r, 2);
        float s2 = 0.f;
        for (int d = 0; d < D; ++d) { const float v = xi[d] + g1[d] * ldf(y + d) * rstd * gp[d]; xr[d] = v; s2 += v * v; }
        const float r2 = 1.0f / sqrtf(s2 / D + EPS); const float* gf = p.ffn_norm_pre + (size_t)layer * D; const float* sh = mod_vec(p, layer, r, 3); const float* sc = mod_vec(p, layer, r, 4);
        st_t* hr = p.H() + (size_t)r * D;
        for (int d = 0; d < D; ++d) stf(hr + d, xr[d] * r2 * gf[d] * (1.0f + sc[d]) + sh[d]);
    } break;
    case ST_ROUTER: {
        const int n = (int)(i % NE), r = (int)(i / NE); const st_t* a = p.H() + (size_t)r * D; const float* b = p.router_w + (size_t)layer * D * NE + n; float acc = 0.f;
        for (int k = 0; k < D; ++k) acc += ldf(a + k) * b[(size_t)k * NE];
        p.LOGITS()[(size_t)r * NE + n] = acc;
    } break;
    case ST_ROUTE: {
        const int r = (int)i; const float* lg = p.LOGITS() + (size_t)r * NE; const float* bias = p.router_bias + (size_t)layer * NE;
        float gs[NGRP];
        _Pragma("unroll") for (int g = 0; g < NGRP; ++g) { float m1 = -1e30f, m2 = -1e30f; for (int j = 0; j < 8; ++j) { const float v = sigmoid_f(lg[g * 8 + j]) + bias[g * 8 + j]; if (v > m1) { m2 = m1; m1 = v; } else if (v > m2) m2 = v; } gs[g] = m1 + m2; }
        unsigned gmask = 0;
        _Pragma("unroll") for (int k = 0; k < TOPG; ++k) { int best = 0; float bv = -1e30f; _Pragma("unroll") for (int g = 0; g < NGRP; ++g) if (!((gmask >> g) & 1u) && gs[g] > bv) { bv = gs[g]; best = g; } gmask |= 1u << best; }
        unsigned long long used = 0ull; float wsum = 0.f; float wv[TOPK]; int wi[TOPK];
        _Pragma("unroll") for (int k = 0; k < TOPK; ++k) { int best = 0; float bv = -1e30f;
            for (int e = 0; e < NE; ++e) if (((gmask >> (e / 8)) & 1u) && !((used >> e) & 1ull)) { const float v = sigmoid_f(lg[e]) + bias[e]; if (v > bv) { bv = v; best = e; } }
            used |= 1ull << best; wi[k] = best; wv[k] = sigmoid_f(lg[best]); wsum += wv[k]; }
        int* cnt = p.CNT() + layer * NE;
        _Pragma("unroll") for (int k = 0; k < TOPK; ++k) { const float w = wv[k] / wsum * ROUTED_SCALE; const int e = wi[k]; const int pos = atomic_inc(cnt + e);
            p.EIDX()[(size_t)r * TOPK + k] = e; p.EW()[(size_t)r * TOPK + k] = w; p.EPOS()[(size_t)r * TOPK + k] = pos; p.TOKLIST()[(size_t)e * TA + pos] = r; p.WLIST()[(size_t)e * TA + pos] = w; }
    } break;
    case ST_POST2: {
        const int r = (int)i; float* xr = xrow(p, r); const int* cnt = p.CNT() + layer * NE; const st_t* f[TOPK + 1]; f[0] = p.SH() + (size_t)r * D;
        _Pragma("unroll") for (int k = 0; k < TOPK; ++k) { const int e = p.EIDX()[(size_t)r * TOPK + k]; f[k + 1] = p.YB() + (size_t)(expert_base(cnt, e) + p.EPOS()[(size_t)r * TOPK + k]) * D; }
        float ss = 0.f;
        for (int d = 0; d < D; ++d) { float v = 0.f; _Pragma("unroll") for (int k = 0; k <= TOPK; ++k) v += ldf(f[k] + d); ss += v * v; }
        const float rstd = 1.0f / sqrtf(ss / D + EPS); const float* gp = p.ffn_norm_post + (size_t)layer * D; const float* g2 = mod_vec(p, layer, r, 5);
        for (int d = 0; d < D; ++d) { float v = 0.f; _Pragma("unroll") for (int k = 0; k <= TOPK; ++k) v += ldf(f[k] + d); xr[d] = xr[d] + g2[d] * v * rstd * gp[d]; }
    } break;
    }
}

enum { WT_STATIC = 0, WT_EXPERT = 1 };
HD long long wt_items(const Params& p, int kind) {
    if (kind == WT_STATIC) { long long n = 0; for (int j = 0; j < NJOBS; ++j) n += static_job_items(j); return n; }
    return (long long)NE * ((D / 64) * (DE / 32) * 2 + (DE / 64) * (D / 32));
}
HD bool wt_job(const Params& p, int kind, int layer, long long item, TJob& jb, int& kb, int& nb) {
    if (kind == WT_STATIC) {
        for (int j = 0; j < NJOBS; ++j) { const long long n = static_job_items(j); if (item < n) { jb = static_job(p, j); const int nblk = (jb.npad + 31) / 32; kb = (int)(item / nblk); nb = (int)(item % nblk); return true; } item -= n; }
        return false;
    }
    const int per_gu = (D / 64) * (DE / 32), per_d = (DE / 64) * (D / 32), per_e = 2 * per_gu + per_d;
    const int e = (int)(item / per_e); int r = (int)(item % per_e);
    if (r < 2 * per_gu) { const int w = r / per_gu; r %= per_gu; const float* src = (w == 0 ? p.e_gate : p.e_up) + ((size_t)layer * NE + e) * D * DE;
        jb = {src, p.Wt_egu() + (size_t)e * 2 * DE * D, D, DE, DE, 8, w * 4, D, DE, 4};   kb = r / (DE / 32); nb = r % (DE / 32); }
    else { r -= 2 * per_gu; jb = {p.e_down + ((size_t)layer * NE + e) * DE * D, p.Wt_ed() + (size_t)e * D * DE, DE, D, D, 16, 0, DE, D, 16}; kb = r / (D / 32); nb = r % (D / 32); }
    return true;
}
HD size_t wt_dst_row(const TJob& jb, int n) { return (size_t)(n / jb.gran) * jb.grp + (n % jb.gran) + jb.off; }
#ifdef HOST_EMU
inline void wt_item_host(const Params& p, int kind, int layer, long long item) {
    TJob jb; int kb, nb; if (!wt_job(p, kind, layer, item, jb, kb, nb)) return;
    for (int n = nb * 32; n < nb * 32 + 32 && n < jb.npad; ++n) for (int k = kb * 64; k < kb * 64 + 64; ++k)
        jb.dst[wt_dst_row(jb, n) * jb.ldt + k] = n < jb.N ? jb.src[(size_t)k * jb.ldsrc + n] : 0.f;
}
#else
__device__ __forceinline__ void wt_item_dev(const Params& p, int kind, int layer, long long item, LAS float* scr, int lane) {
    TJob jb; int kb, nb; if (!wt_job(p, kind, layer, item, jb, kb, nb)) return;
    const int k0 = kb * 64, n0 = nb * 32;
    { float tmp[32]; const int n = n0 + (lane & 31); const float* sp = jb.src + (size_t)(k0 + (lane >> 5)) * jb.ldsrc + n;
      if (n < jb.N) {
#pragma unroll
          for (int i = 0; i < 32; ++i) tmp[i] = __builtin_nontemporal_load(sp + (size_t)(2 * i) * jb.ldsrc);
      } else {
#pragma unroll
          for (int i = 0; i < 32; ++i) tmp[i] = 0.f; }
#pragma unroll
      for (int i = 0; i < 32; ++i) scr[(2 * i + (lane >> 5)) * 33 + (lane & 31)] = tmp[i]; }
    asm volatile("s_waitcnt lgkmcnt(0)" ::: "memory");
    const int c = lane & 7;
#pragma unroll
    for (int j = 0; j < 4; ++j) { const int nl = (lane >> 3) + 8 * j, n = n0 + nl; const LAS float* s = scr + (8 * c) * 33 + nl;
        if (n < jb.npad) { uint4 o; o.x = pk_bf16(s[0 * 33], s[1 * 33]); o.y = pk_bf16(s[2 * 33], s[3 * 33]); o.z = pk_bf16(s[4 * 33], s[5 * 33]); o.w = pk_bf16(s[6 * 33], s[7 * 33]);
            *(uint4*)(jb.dst + wt_dst_row(jb, n) * jb.ldt + k0 + 8 * c) = o; } }
    asm volatile("s_waitcnt lgkmcnt(0)" ::: "memory");
}
#endif

enum { EPI_BF16 = 0, EPI_SWIGLU = 1, EPI_SCALE = 2, EPI_PROJ = 3, EPI_UQ = 4, EPI_UKV = 5 };
enum GStage { G_PROJ = 0, G_UQ, G_UKV, G_WOUT, G_SGU, G_SDOWN, G_EGU, G_EDOWN };
struct GemmDesc {
    const st_t* A; int lda; const int* rowidx; int a_row0, nrows;
    const st_t* Bt; int ldb, K, n0;
    int epi; st_t* out; int ldc; long long out_row0; const float* rowscale;
    const float* tab; st_t* vt;
    int perm;
};
HD int cdiv(int a, int b) { return (a + b - 1) / b; }
struct ETab { const int* eb; const int* tb; };
HD int gemm_ntiles(const Params& p, int gs, int layer, ETab et = ETab{nullptr, nullptr}) {
    const int mt = rows_out(layer) / 128;
    switch (gs) {
    case G_PROJ: return (TA / 128) * (DPROJP / 128);
    case G_UQ: return (TA / 128) * (MH * MQD / 128);
    case G_UKV: return (TA / 128) * (MH * MKVD / 128);
    case G_WOUT: return mt * (D / 128);
    case G_SGU: return mt * (2 * DS / 128);
    case G_SDOWN: return mt * (D / 128);
    case G_EGU: case G_EDOWN: { int t = 0; if (et.tb) t = et.tb[NE]; else for (int e = 0; e < NE; ++e) t += cdiv(p.CNT()[layer * NE + e], 128); return t * (gs == G_EGU ? 2 * DE / 128 : D / 128); }
    }
    return 0;
}
HD void gemm_desc(const Params& p, int gs, int layer, int item, GemmDesc& g, ETab et = ETab{nullptr, nullptr}) {
    g.rowidx = nullptr; g.rowscale = nullptr; g.nrows = 128; g.epi = EPI_BF16; g.tab = nullptr; g.vt = nullptr; g.perm = (gs == G_WOUT || gs == G_SGU || gs == G_SDOWN || gs == G_EGU || gs == G_EDOWN) ? 1 : 0;
    auto plain = [&](const st_t* A, int lda, const st_t* Bt, int K, int ntn, st_t* out, int ldc) {
        const int mtn = (gs == G_PROJ || gs == G_UQ || gs == G_UKV ? TA : rows_out(layer)) / 128, PW = ntn < 8 ? ntn : 8, nfull = ntn / PW;
        int mt, nt; { const int pidx = item / (mtn * PW); if (pidx < nfull) { const int w = item - pidx * mtn * PW; mt = w / PW; nt = pidx * PW + w % PW; } else { const int pw = ntn - nfull * PW, w = item - nfull * mtn * PW; mt = w / pw; nt = nfull * PW + w % pw; } }
        g.A = A; g.lda = lda; g.a_row0 = mt * 128; g.Bt = Bt; g.ldb = K; g.K = K; g.n0 = nt * 128; g.out = out; g.ldc = ldc; g.out_row0 = mt * 128; };
    switch (gs) {
    case G_PROJ: plain(p.H(), D, p.Wt_in() + (size_t)layer * DPROJP * D, D, DPROJP / 128, p.P(), DPROJP); g.epi = EPI_PROJ; g.tab = g.n0 + 128 > PO_KR ? p.TABM() : p.TABA(); g.vt = p.VtA(); break;
    case G_UQ: plain(p.CQN(), MQR, p.Wt_uq() + (size_t)layer * MH * MQD * MQR, MQR, MH * MQD / 128, p.MQ(), MH * MQD); g.epi = EPI_UQ; g.tab = p.TABM(); break;
    case G_UKV: plain(p.CKVN(), MKVR, p.Wt_ukv() + (size_t)layer * MH * MKVD * MKVR, MKVR, MH * MKVD / 128, p.MKV(), MH * MKVD); g.epi = EPI_UKV; g.vt = p.VtM(); break;
    case G_WOUT: plain(p.O(), DMIX, p.Wt_out() + (size_t)layer * D * DMIX, DMIX, D / 128, p.Y(), D); break;
    case G_SGU: plain(p.H(), D, p.Wt_sgu() + (size_t)layer * 2 * DS * D, D, 2 * DS / 128, p.SACT(), DS); g.epi = EPI_SWIGLU; break;
    case G_SDOWN: plain(p.SACT(), DS, p.Wt_sd() + (size_t)layer * D * DS, DS, D / 128, p.SH(), D); break;
    case G_EGU: case G_EDOWN: {
        const int ntn = gs == G_EGU ? 2 * DE / 128 : D / 128; int mt = item / ntn; const int nt = item % ntn; const int* cnt = p.CNT() + layer * NE;
        int e = 0, base = 0;
        if (et.tb) { int lo = 0, hi = NE - 1; while (lo < hi) { const int mid = (lo + hi + 1) >> 1; if (et.tb[mid] <= mt) lo = mid; else hi = mid - 1; } e = lo; mt -= et.tb[e]; base = et.eb[e]; }
        else for (; e < NE; ++e) { const int te = cdiv(cnt[e], 128); if (mt < te) break; mt -= te; base += cnt[e]; }
        g.a_row0 = mt * 128; g.nrows = cnt[e] - mt * 128 < 128 ? cnt[e] - mt * 128 : 128; g.n0 = nt * 128; g.out_row0 = base + mt * 128;
        if (gs == G_EGU) { g.A = p.H(); g.lda = D; g.rowidx = p.TOKLIST() + (size_t)e * TA; g.Bt = p.Wt_egu() + (size_t)e * 2 * DE * D; g.ldb = D; g.K = D; g.epi = EPI_SWIGLU; g.out = p.ACT(); g.ldc = DE; }
        else { g.A = p.ACT() + (size_t)base * DE; g.lda = DE; g.Bt = p.Wt_ed() + (size_t)e * D * DE; g.ldb = DE; g.K = DE; g.epi = EPI_SCALE; g.out = p.YB(); g.ldc = D; g.rowscale = p.WLIST() + (size_t)e * TA - base; }
    } break;
    }
}
HD bool epi_needs_partner(const GemmDesc& g, int cb) { return g.epi == EPI_UQ || (g.epi == EPI_PROJ && g.n0 + cb + 64 > PO_KR); }
HD void rope8(float (&v)[4], const float (&pv)[4], int q, const float* tab, int pos) {
    for (int r = 0; r < 4; ++r) { const int c16 = q * 4 + r, i = c16 & 7; const float cs = tab[(pos * 8 + i) * 2], sn = tab[(pos * 8 + i) * 2 + 1];
        v[r] = c16 < 8 ? v[r] * cs - pv[r] * sn : pv[r] * sn + v[r] * cs; }
}
HD void gemm_epi(const GemmDesc& g, int rl, int cb, int q, float (&v)[4][4], const float (&pv)[4][4], const float wscale) {
    if (rl >= g.nrows) return;
    const long long orow = g.out_row0 + rl;
    if (g.perm) {
        if (g.epi == EPI_SWIGLU) { float a[2][4]; for (int jj = 0; jj < 2; ++jj) for (int r = 0; r < 4; ++r) a[jj][r] = silu_f(v[2 * jj][r]) * v[2 * jj + 1][r];
            st8(g.out + (size_t)orow * g.ldc + (g.n0 + cb + 16 * q) / 2, a[0], a[1]); return; }
        const float w = wscale;
        for (int j = 0; j < 4; ++j) for (int r = 0; r < 4; ++r) v[j][r] *= w;
        st_t* o = g.out + (size_t)orow * g.ldc + g.n0 + cb + 16 * q; if (g.epi == EPI_SCALE) { st8_nt(o, v[0], v[1]); st8_nt(o + 8, v[2], v[3]); } else { st8(o, v[0], v[1]); st8(o + 8, v[2], v[3]); } return;
    }
    if (g.epi == EPI_SWIGLU) {
        for (int jj = 0; jj < 2; ++jj) { float a[4]; for (int r = 0; r < 4; ++r) a[r] = silu_f(v[2 * jj][r]) * v[2 * jj + 1][r];
            st4(g.out + (size_t)orow * g.ldc + (g.n0 + cb) / 2 + jj * 16 + q * 4, a[0], a[1], a[2], a[3]); }
        return;
    }
    if (g.epi >= EPI_PROJ) {
        const int row = (int)orow; const bool lat = row < T; const int bb = lat ? row / S : (row - T) / L, kidx = lat ? row % S : S + (row - T) % L;
        const int rp = lat ? (row % S) / GRID_W : 0, cp = lat ? (row % S) % GRID_W : 0, span = (g.n0 + cb) / 64;
        if (g.epi == EPI_PROJ) {
            if (span < 8) { if (lat) for (int hp = 0; hp < 2; ++hp) for (int r = 0; r < 4; ++r) { const int i = q * 4 + r, pos = hp ? cp : rp; const float cs = g.tab[(pos * 16 + i) * 2], sn = g.tab[(pos * 16 + i) * 2 + 1];
                    const float x1 = v[2 * hp][r], x2 = v[2 * hp + 1][r]; v[2 * hp][r] = x1 * cs - x2 * sn; v[2 * hp + 1][r] = x1 * sn + x2 * cs; } }
            else if (span < 10) { for (int j = 0; j < 4; ++j) for (int r = 0; r < 4; ++r) stf(g.vt + ((size_t)(bb * SWA_KVH + span - 8) * 64 + j * 16 + q * 4 + r) * NK + kidx, v[j][r]); return; }
            else if (g.n0 + cb + 64 > PO_KR && lat) { rope8(v[2], pv[2], q, g.tab, rp); rope8(v[3], pv[3], q, g.tab, cp); }
        } else if (g.epi == EPI_UQ) {
            if (lat) for (int j = 0; j < 4; ++j) { const int k6 = ((g.n0 + cb) / 16 + j) % 6; if (k6 >= 4) rope8(v[j], pv[j], q, g.tab, k6 == 4 ? rp : cp); }
        } else {
            if (span & 1) { for (int j = 0; j < 4; ++j) for (int r = 0; r < 4; ++r) stf(g.vt + ((size_t)(bb * MH + span / 2) * 64 + j * 16 + q * 4 + r) * NK + kidx, v[j][r]); return; }
        }
    }
    const float w = wscale;
    for (int j = 0; j < 4; ++j) st4(g.out + (size_t)orow * g.ldc + g.n0 + cb + j * 16 + q * 4, v[j][0] * w, v[j][1] * w, v[j][2] * w, v[j][3] * w);
}
#ifdef HOST_EMU
inline void gemm_tile_host(const GemmDesc& g) {
    for (int rl = 0; rl < g.nrows; ++rl) {
        const long long ar = g.rowidx ? g.rowidx[g.a_row0 + rl] : g.a_row0 + rl; const st_t* a = g.A + (size_t)ar * g.lda;
        for (int cb = 0; cb < 128; cb += 64) for (int q = 0; q < 4; ++q) { float v[4][4], pv[4][4];
            for (int j = 0; j < 4; ++j) for (int r = 0; r < 4; ++r) { const st_t* b = g.Bt + (size_t)(g.n0 + cb + (g.perm ? q * 16 + j * 4 + r : j * 16 + q * 4 + r)) * g.ldb; float acc = 0.f; for (int k = 0; k < g.K; ++k) acc += a[k] * b[k]; v[j][r] = acc;
                const st_t* b2 = g.Bt + (size_t)(g.n0 + cb + j * 16 + (q ^ 2) * 4 + r) * g.ldb; float acc2 = 0.f; for (int k = 0; k < g.K; ++k) acc2 += a[k] * b2[k]; pv[j][r] = acc2; }
            gemm_epi(g, rl, cb, q, v, pv, g.epi == EPI_SCALE ? g.rowscale[g.out_row0 + rl] : 1.0f); }
    }
}
#else
__device__ __forceinline__ void gemm_tile_dev(const GemmDesc& g, LAS unsigned char* lds, const int tid) {
    const int lane = tid & 63, wave = __builtin_amdgcn_readfirstlane(tid >> 6), wr = wave >> 1, wc = wave & 1;
    const int lrow = lane >> 3, slot = lane & 7;
    const st_t* asrc[4]; const st_t* bsrc[4];
#pragma unroll
    for (int i = 0; i < 4; ++i) {
        const int row = i * 32 + wave * 8 + lrow, chunk = slot ^ ((row >> 1) & 7);
        int rl = row < g.nrows ? row : g.nrows - 1;
        const long long ar = g.rowidx ? (long long)g.rowidx[g.a_row0 + rl] : (long long)(g.a_row0 + rl);
        asrc[i] = g.A + (size_t)ar * g.lda + chunk * 8;
        const int brow = g.perm ? (row & 64) + ((row >> 2) & 3) * 16 + ((row >> 4) & 3) * 4 + (row & 3) : row;
        bsrc[i] = g.Bt + (size_t)(g.n0 + brow) * g.ldb + chunk * 8;
    }
    const int nt = g.K / 64;
    auto stage = [&](int buf, int t) {
#pragma unroll
        for (int i = 0; i < 4; ++i) {
            __builtin_amdgcn_global_load_lds((const unsigned*)(asrc[i] + t * 64), (LAS unsigned*)(lds + buf * 32768 + (i * 32 + wave * 8) * 128), 16, 0, 0);
            __builtin_amdgcn_global_load_lds((const unsigned*)(bsrc[i] + t * 64), (LAS unsigned*)(lds + buf * 32768 + 16384 + (i * 32 + wave * 8) * 128), 16, 0, 0);
        }
    };
    f32x4 acc[4][4];
#pragma unroll
    for (int i = 0; i < 4; ++i)
#pragma unroll
        for (int j = 0; j < 4; ++j) acc[i][j] = (f32x4){0.f, 0.f, 0.f, 0.f};
    const int fr = lane & 15, fq = lane >> 4;
    float wrow[4];
#pragma unroll
    for (int i = 0; i < 4; ++i) { const int rl = wr * 64 + i * 16 + fr; wrow[i] = (g.epi == EPI_SCALE && rl < g.nrows) ? g.rowscale[g.out_row0 + rl] : 1.0f; }
    __syncthreads();
    stage(0, 0);
    __syncthreads();
    for (int t = 0; t < nt; ++t) {
        const int cur = t & 1;
        if (t + 1 < nt) stage(cur ^ 1, t + 1);
        const LAS unsigned char* As = lds + cur * 32768; const LAS unsigned char* Bs = As + 16384;
#pragma unroll
        for (int kk = 0; kk < 2; ++kk) {
            bf16x8 af[4], bfr[4];
#pragma unroll
            for (int i = 0; i < 4; ++i) { const int row = wr * 64 + i * 16 + fr; af[i] = *(const LAS bf16x8*)(As + row * 128 + (((kk * 4 + fq) ^ ((row >> 1) & 7)) << 4)); }
#pragma unroll
            for (int j = 0; j < 4; ++j) { const int row = wc * 64 + j * 16 + fr; bfr[j] = *(const LAS bf16x8*)(Bs + row * 128 + (((kk * 4 + fq) ^ ((row >> 1) & 7)) << 4)); }
#pragma unroll
            for (int i = 0; i < 4; ++i)
#pragma unroll
                for (int j = 0; j < 4; ++j) acc[i][j] = __builtin_amdgcn_mfma_f32_16x16x32_bf16(bfr[j], af[i], acc[i][j], 0, 0, 0);
        }
        __syncthreads();
    }
    const bool need_pv = epi_needs_partner(g, wc * 64);
#pragma unroll
    for (int i = 0; i < 4; ++i) { float v[4][4], pv[4][4];
#pragma unroll
        for (int j = 0; j < 4; ++j)
#pragma unroll
            for (int r = 0; r < 4; ++r) { v[j][r] = acc[i][j][r]; pv[j][r] = 0.f; }
        if (need_pv) {
#pragma unroll
            for (int j = 0; j < 4; ++j)
#pragma unroll
                for (int r = 0; r < 4; ++r) pv[j][r] = __shfl_xor(v[j][r], 32); }
        gemm_epi(g, wr * 64 + i * 16 + fr, wc * 64, fq, v, pv, wrow[i]); }
}
#endif


struct AttnDesc {
    int dqk;
    const st_t* Q; int ldq, q_row0;
    const st_t* K1; int ldk1; const st_t* K2; int ldk2;
    int lat_row0, ctx_row0;
    const st_t* Vt;
    int kt_lo, kt_hi, nctx, ctx_t0;
    int mask, qpos0;
    float m_init, l_init, c;
    st_t* O; int o_col;
    int part; st_t* opart; float* mlpart;
};
HD int attn_nitems(int layer) { const int lat = B * MH * (S / 128) * NSPLIT + B * SWA_H * (S / 128); return layer == DEPTH - 1 ? lat : lat + B * MH * (L / 128) + B * SWA_H * (L / 128); }
HD int attn_queue_size(int layer, int x) {
    const int NQ = S / 128, NQC = L / 128, half = x / 4; int n = NCHAIN / 8 + NQ * NSPLIT + SWA_G * (NQ * (half + 1) / 2 - NQ * half / 2);
    if (layer < DEPTH - 1) n += NQC + SWA_G * (NQC * (half + 1) / 2 - NQC * half / 2);
    return n;
}
HD int attn_queue_item(int layer, int x, int k) {
    const int NQ = S / 128, NQC = L / 128, half = x / 4, n_mla = B * MH * NQ * NSPLIT, n_swa = B * SWA_H * NQ, n_mlac = B * MH * NQC;
    if (k < NCHAIN / 8) return x * (NCHAIN / 8) + k; k -= NCHAIN / 8;
    if (k < NQ * NSPLIT) return NCHAIN + x * NQ * NSPLIT + k; k -= NQ * NSPLIT;
    const int gb = (x % 4) / SWA_KVH, gk = (x % 4) % SWA_KVH;
    { const int qlo = NQ * half / 2, nq = NQ * (half + 1) / 2 - qlo; if (k < SWA_G * nq) { const int h = gk * SWA_G + k / nq; return NCHAIN + n_mla + (gb * SWA_H + h) * NQ + qlo + k % nq; } k -= SWA_G * nq; }
    if (k < NQC) return NCHAIN + n_mla + n_swa + x * NQC + k; k -= NQC;
    { const int qlo = NQC * half / 2, nq = NQC * (half + 1) / 2 - qlo; const int h = gk * SWA_G + k / (nq > 0 ? nq : 1); return NCHAIN + n_mla + n_swa + n_mlac + (gb * SWA_H + h) * NQC + qlo + k % (nq > 0 ? nq : 1); }
}
static_assert(NCHAIN % 8 == 0 && B * MH == 8 && B * SWA_KVH == 4, "queue layout");
HD void attn_desc(const Params& p, int layer, int item, AttnDesc& a) {
    const float LOG2E = 1.4426950408889634f;
    const int n_mla = B * MH * (S / 128) * NSPLIT, n_swa = B * SWA_H * (S / 128), n_mlac = B * MH * (L / 128);
    bool mla, ctxq; int b, h, qb, part = -1;
    if (item < n_mla) { mla = true; ctxq = false; qb = item % (S / 128); item /= S / 128; part = item % NSPLIT; item /= NSPLIT; h = item % MH; b = item / MH; }
    else if (item < n_mla + n_swa) { item -= n_mla; mla = false; ctxq = false; qb = item % (S / 128); h = (item / (S / 128)) % SWA_H; b = item / (S / 128) / SWA_H; }
    else if (item < n_mla + n_swa + n_mlac) { item -= n_mla + n_swa; mla = true; ctxq = true; qb = item % (L / 128); h = (item / (L / 128)) % MH; b = item / (L / 128) / MH; }
    else { item -= n_mla + n_swa + n_mlac; mla = false; ctxq = true; qb = item % (L / 128); h = (item / (L / 128)) % SWA_H; b = item / (L / 128) / SWA_H; }
    a.q_row0 = ctxq ? T + b * L + qb * 128 : b * S + qb * 128; a.lat_row0 = b * S; a.ctx_row0 = T + b * L; a.nctx = L / 64; a.qpos0 = qb * 128; a.O = p.O(); a.ctx_t0 = 0; a.part = -1; a.opart = nullptr; a.mlpart = nullptr;
    if (mla) {
        a.dqk = 96; a.Q = p.MQ() + h * MQD; a.ldq = MH * MQD; a.K1 = p.MKV() + h * MKVD; a.ldk1 = MH * MKVD; a.K2 = p.P() + PO_KR; a.ldk2 = DPROJP;
        a.Vt = p.VtM() + (size_t)(b * MH + h) * 64 * NK; a.kt_lo = 0; a.kt_hi = ctxq ? 0 : S / 64; a.mask = 0; a.m_init = -1e30f; a.l_init = 0.f; a.c = LOG2E / sqrtf((float)MQD); a.o_col = 768 + h * 64;
        if (part >= 0 && NSPLIT > 1) {
            const int CT = (NK / 64) / NSPLIT, t0 = part * CT, t1 = t0 + CT, nl = S / 64;
            a.kt_lo = t0 < nl ? t0 : nl; a.kt_hi = t1 < nl ? t1 : nl; a.nctx = t1 > nl ? t1 - (t0 > nl ? t0 : nl) : 0; a.ctx_t0 = t0 > nl ? t0 - nl : 0;
            a.part = part; a.opart = p.OPART() + (size_t)part * T * MH * MV + h * MV; a.mlpart = p.MLPART() + ((size_t)part * T * MH + h) * 2; }
    } else {
        const int kvh = h / SWA_G;
        a.dqk = 64; a.Q = p.P() + PO_QA + h * 64; a.ldq = DPROJP; a.K1 = p.P() + PO_KA + kvh * 64; a.ldk1 = DPROJP; a.K2 = nullptr; a.ldk2 = 0;
        a.Vt = p.VtA() + (size_t)(b * SWA_KVH + kvh) * 64 * NK; a.mask = ctxq ? 0 : 1;
        if (ctxq) { a.kt_lo = 0; a.kt_hi = 0; } else { a.kt_lo = (a.qpos0 - SWA_W) / 64; if (a.kt_lo < 0) a.kt_lo = 0; a.kt_hi = (a.qpos0 + 128 + SWA_W) / 64; if (a.kt_hi > S / 64) a.kt_hi = S / 64; }
        a.m_init = p.swa_sink[layer * SWA_H + h] * LOG2E; a.l_init = 1.f; a.c = LOG2E * 0.125f; a.o_col = h * 64;
    }
}
#ifdef HOST_EMU
inline void attn_tile_host(const AttnDesc& a) {
    const int nl = a.kt_hi - a.kt_lo, ntile = nl + a.nctx;
    for (int q = 0; q < 128; ++q) {
        const st_t* qr = a.Q + (size_t)(a.q_row0 + q) * a.ldq; float m = a.m_init, l = a.l_init, acc[64]; for (int d = 0; d < 64; ++d) acc[d] = 0.f;
        for (int t = 0; t < ntile; ++t) for (int kk = 0; kk < 64; ++kk) {
            const int kidx = t < nl ? (a.kt_lo + t) * 64 + kk : S + (a.ctx_t0 + t - nl) * 64 + kk; const int row = kidx < S ? a.lat_row0 + kidx : a.ctx_row0 + kidx - S;
            if (a.mask && t < nl) { const int dq = a.qpos0 + q - kidx; if (dq > SWA_W || dq < -SWA_W) continue; }
            float sc = 0.f; for (int d = 0; d < 64; ++d) sc += qr[d] * a.K1[(size_t)row * a.ldk1 + d];
            if (a.dqk > 64) for (int d = 64; d < a.dqk; ++d) sc += qr[d] * a.K2[(size_t)row * a.ldk2 + d - 64];
            sc *= a.c; if (sc > m) { const float f = exp2f(m - sc); l *= f; for (int d = 0; d < 64; ++d) acc[d] *= f; m = sc; }
            const float pe = exp2f(sc - m); l += pe; for (int d = 0; d < 64; ++d) acc[d] += pe * a.Vt[(size_t)d * NK + kidx];
        }
        if (a.part >= 0) { for (int d = 0; d < 64; ++d) a.opart[(size_t)(a.q_row0 + q) * MH * MV + d] = acc[d] / l; a.mlpart[(size_t)(a.q_row0 + q) * MH * 2] = m; a.mlpart[(size_t)(a.q_row0 + q) * MH * 2 + 1] = l; }
        else for (int d = 0; d < 64; ++d) a.O[(size_t)(a.q_row0 + q) * DMIX + a.o_col + d] = acc[d] / l;
    }
}
#else
typedef float f32x16 __attribute__((ext_vector_type(16)));
typedef unsigned u32x4 __attribute__((ext_vector_type(4)));
typedef unsigned u32x2 __attribute__((ext_vector_type(2)));
__device__ __forceinline__ int crow16(int reg, int h) { return (reg & 3) + 8 * (reg >> 2) + 4 * h; }
template <int DQK>
__device__ __forceinline__ void attn_tile_dev(const AttnDesc& a, LAS unsigned char* lds, const int tid) {
    constexpr int KSTR = DQK * 2 + 16, VSTR = 136, KBYTES = 64 * KSTR, BUF = KBYTES + 64 * VSTR, CPR = DQK / 8, KCH = 64 * CPR / 256, NKS = DQK / 16;
    const int lane = tid & 63, wave = __builtin_amdgcn_readfirstlane(tid >> 6), l31 = lane & 31, hh = lane >> 5;
    bf16x8 qf[NKS];
    { const st_t* qrow = a.Q + (size_t)(a.q_row0 + wave * 32 + l31) * a.ldq;
#pragma unroll
      for (int ks = 0; ks < NKS; ++ks) qf[ks] = *(const bf16x8*)(qrow + 16 * ks + 8 * hh); }
    f32x16 ot[2];
#pragma unroll
    for (int r = 0; r < 16; ++r) { ot[0][r] = 0.f; ot[1][r] = 0.f; }
    float m = a.m_init, lsum = hh == 0 ? a.l_init : 0.f;
    const int nl = a.kt_hi - a.kt_lo, ntile = nl + a.nctx; const float c = a.c;
    u32x4 kreg[2][KCH], vreg[2][2];
    auto gload = [&](auto PC, int t) { constexpr int P = decltype(PC)::value;
        const int kidx0 = t < nl ? (a.kt_lo + t) * 64 : S + (a.ctx_t0 + t - nl) * 64; const int rowbase = t < nl ? a.lat_row0 + kidx0 : a.ctx_row0 + kidx0 - S;
#pragma unroll
        for (int u = 0; u < KCH; ++u) { const int ci = tid + 256 * u, row = ci / CPR, cc = ci % CPR;
            const st_t* src = (DQK == 64 || cc < 8) ? a.K1 + (size_t)(rowbase + row) * a.ldk1 + cc * 8 : a.K2 + (size_t)(rowbase + row) * a.ldk2 + (cc - 8) * 8;
            kreg[P][u] = *(const u32x4*)src; }
#pragma unroll
        for (int u = 0; u < 2; ++u) { const int ci = tid + 256 * u, dv = ci >> 3, cc = ci & 7; vreg[P][u] = *(const u32x4*)(a.Vt + (size_t)dv * NK + kidx0 + cc * 8); }
    };
    auto lstore = [&](auto PC) { constexpr int P = decltype(PC)::value;
#pragma unroll
        for (int u = 0; u < KCH; ++u) { const int ci = tid + 256 * u, row = ci / CPR, cc = ci % CPR; *(LAS u32x4*)(lds + P * BUF + row * KSTR + cc * 16) = kreg[P][u]; }
#pragma unroll
        for (int u = 0; u < 2; ++u) { const int ci = tid + 256 * u, dv = ci >> 3, cc = ci & 7; LAS u32x2* d = (LAS u32x2*)(lds + P * BUF + KBYTES + dv * VSTR + cc * 16);
            d[0] = (u32x2){vreg[P][u].x, vreg[P][u].y}; d[1] = (u32x2){vreg[P][u].z, vreg[P][u].w}; }
    };
    using I0 = std::integral_constant<int, 0>; using I1 = std::integral_constant<int, 1>;
    __syncthreads();
    gload(I0{}, 0); lstore(I0{});
    if (ntile > 1) gload(I1{}, 1);
    __syncthreads();
    auto body = [&](auto PC, const int t) { constexpr int cur = decltype(PC)::value; using PN = std::integral_constant<int, 1 - cur>;
        if (t + 2 < ntile) gload(PC, t + 2);
        const LAS unsigned char* Ks = lds + cur * BUF; const LAS unsigned char* Vs = Ks + KBYTES;
        f32x16 st[2];
        {
            bf16x8 kf[2][NKS];
#pragma unroll
            for (int ks = 0; ks < NKS; ++ks)
#pragma unroll
                for (int kb = 0; kb < 2; ++kb) kf[kb][ks] = *(const LAS bf16x8*)(Ks + (kb * 32 + l31) * KSTR + (16 * ks + 8 * hh) * 2);
            __builtin_amdgcn_sched_barrier(0);
#pragma unroll
            for (int r = 0; r < 16; ++r) { st[0][r] = 0.f; st[1][r] = 0.f; }
#pragma unroll
            for (int ks = 0; ks < NKS; ++ks)
#pragma unroll
                for (int kb = 0; kb < 2; ++kb) st[kb] = __builtin_amdgcn_mfma_f32_32x32x16_bf16(kf[kb][ks], qf[ks], st[kb], 0, 0, 0);
        }
        u32x2 vlo[2][2][2], vhi[2][2][2];
#pragma unroll
        for (int kb = 0; kb < 2; ++kb)
#pragma unroll
            for (int s2 = 0; s2 < 2; ++s2)
#pragma unroll
                for (int db = 0; db < 2; ++db) { const LAS unsigned char* vp = Vs + (db * 32 + l31) * VSTR + (kb * 32 + 16 * s2 + 4 * hh) * 2;
                    vlo[kb][s2][db] = *(const LAS u32x2*)vp; vhi[kb][s2][db] = *(const LAS u32x2*)(vp + 16); }
        __builtin_amdgcn_sched_barrier(0);
        if (a.mask && t < nl) {
            const int d0 = a.qpos0 + wave * 32 + l31 - (a.kt_lo + t) * 64;
#pragma unroll
            for (int kb = 0; kb < 2; ++kb)
#pragma unroll
                for (int r = 0; r < 16; ++r) { const int dq = d0 - (kb * 32 + crow16(r, hh)); if (dq > SWA_W || dq < -SWA_W) st[kb][r] = -1e30f; }
        }
        float mx = st[0][0];
#pragma unroll
        for (int r = 1; r < 16; ++r) mx = fmaxf(mx, st[0][r]);
#pragma unroll
        for (int r = 0; r < 16; ++r) mx = fmaxf(mx, st[1][r]);
        mx = fmaxf(mx, __shfl_xor(mx, 32));
        const float m_new = fmaxf(m, mx * c), alpha = __builtin_amdgcn_exp2f(m - m_new);
        f32x2 rs2 = (f32x2){0.f, 0.f}; const f32x2 c2 = (f32x2){c, c}, nm2 = (f32x2){-m_new, -m_new};
#pragma unroll
        for (int kb = 0; kb < 2; ++kb)
#pragma unroll
            for (int r = 0; r < 16; r += 2) { const f32x2 t = (f32x2){st[kb][r], st[kb][r + 1]} * c2 + nm2; const f32x2 pe = (f32x2){__builtin_amdgcn_exp2f(t.x), __builtin_amdgcn_exp2f(t.y)};
                st[kb][r] = pe.x; st[kb][r + 1] = pe.y; rs2 += pe; }
        const float rs = rs2.x + rs2.y;
        lsum = lsum * alpha + rs; m = m_new;
#pragma unroll
        for (int r = 0; r < 16; ++r) { ot[0][r] *= alpha; ot[1][r] *= alpha; }
#pragma unroll
        for (int kb = 0; kb < 2; ++kb)
#pragma unroll
            for (int s2 = 0; s2 < 2; ++s2) {
                u32x4 pw; pw.x = pk_bf16(st[kb][8 * s2 + 0], st[kb][8 * s2 + 1]); pw.y = pk_bf16(st[kb][8 * s2 + 2], st[kb][8 * s2 + 3]);
                pw.z = pk_bf16(st[kb][8 * s2 + 4], st[kb][8 * s2 + 5]); pw.w = pk_bf16(st[kb][8 * s2 + 6], st[kb][8 * s2 + 7]);
                const bf16x8 pb = __builtin_bit_cast(bf16x8, pw);
#pragma unroll
                for (int db = 0; db < 2; ++db) { const u32x2 lo = vlo[kb][s2][db], hi = vhi[kb][s2][db]; u32x4 vw; vw.x = lo.x; vw.y = lo.y; vw.z = hi.x; vw.w = hi.y;
                    ot[db] = __builtin_amdgcn_mfma_f32_32x32x16_bf16(__builtin_bit_cast(bf16x8, vw), pb, ot[db], 0, 0, 0); }
            }
        if (t + 1 < ntile) lstore(PN{});
        __syncthreads();
    };
    for (int t = 0; t < ntile; t += 2) { body(I0{}, t); if (t + 1 < ntile) body(I1{}, t + 1); }
    const float ltot = lsum + __shfl_xor(lsum, 32), inv = 1.0f / ltot;
    st_t* orow = a.O + (size_t)(a.q_row0 + wave * 32 + l31) * DMIX + a.o_col;
    if (a.part >= 0) { orow = a.opart + (size_t)(a.q_row0 + wave * 32 + l31) * MH * MV;
        if (hh == 0) { float* ml = a.mlpart + (size_t)(a.q_row0 + wave * 32 + l31) * MH * 2; ml[0] = m; ml[1] = ltot; } }
#pragma unroll
    for (int db = 0; db < 2; ++db)
#pragma unroll
        for (int g = 0; g < 4; ++g) st4(orow + db * 32 + 8 * g + 4 * hh, ot[db][4 * g] * inv, ot[db][4 * g + 1] * inv, ot[db][4 * g + 2] * inv, ot[db][4 * g + 3] * inv);
}
#endif


HD int gdn_row(int b, int dir, int n, int i) {
    if (n < L / 64) { const int pos = n * 64 + i; return T + b * L + (dir == 0 ? pos : L - 1 - pos); }
    const int pos = (n - L / 64) * 64 + i; return b * S + (dir == 0 ? pos : S - 1 - pos);
}
#ifdef HOST_EMU
inline void gdn_pre_host(const Params& p, int item) {
    const int c = item / NCH, n = item % NCH, dir = c & 1, h = (c >> 1) % GH, b = (c >> 1) / GH;
    float gc[64], beta[64]; const st_t* kk[64]; const st_t* qq[64]; const st_t* vv[64]; float acc = 0.f;
    for (int i = 0; i < 64; ++i) { const int r = gdn_row(b, dir, n, i); acc += p.BG()[(size_t)r * 24 + 12 + dir * 6 + h]; gc[i] = acc; beta[i] = p.BG()[(size_t)r * 24 + dir * 6 + h];
        qq[i] = p.G() + (size_t)r * GQKV + h * 64; kk[i] = qq[i] + 384; vv[i] = qq[i] + 768; }
    static thread_local float A[64][64], XU[64][64], XW[64][64];
    for (int i = 0; i < 64; ++i) for (int j = 0; j < 64; ++j) { float d = 0.f; for (int e = 0; e < 64; ++e) d += kk[i][e] * kk[j][e]; A[i][j] = j < i ? beta[i] * d * expf(gc[i] - gc[j]) : 0.f; }
    for (int i = 0; i < 64; ++i) for (int e = 0; e < 64; ++e) { float u = beta[i] * vv[i][e], w = beta[i] * expf(gc[i]) * kk[i][e];
        for (int j = 0; j < i; ++j) { u -= A[i][j] * XU[j][e]; w -= A[i][j] * XW[j][e]; } XU[i][e] = u; XW[i][e] = w; }
    st_t* ch = p.CH() + (size_t)item * 5 * 4096;
    for (int i = 0; i < 64; ++i) for (int e = 0; e < 64; ++e) {
        ch[0 * 4096 + e * 64 + i] = XU[i][e]; ch[1 * 4096 + i * 64 + e] = XW[i][e]; ch[2 * 4096 + i * 64 + e] = qq[i][e] * 0.125f * expf(gc[i]);
        float d = 0.f; for (int x = 0; x < 64; ++x) d += qq[i][x] * kk[e][x]; ch[3 * 4096 + i * 64 + e] = e <= i ? d * 0.125f * expf(gc[i] - gc[e]) : 0.f;
        ch[4 * 4096 + e * 64 + i] = kk[i][e] * expf(gc[63] - gc[i]); }
    p.GAM()[item] = expf(gc[63]);
}
inline void gdn_scan_host(const Params& p, int c) {
    const int dir = c & 1, h = (c >> 1) % GH, b = (c >> 1) / GH; st_t* dst = dir == 0 ? p.OF() : p.OB();
    static thread_local float Sm[64][64], Vn[64][64]; for (int d = 0; d < 64; ++d) for (int e = 0; e < 64; ++e) Sm[d][e] = 0.f;
    for (int n = 0; n < NCH; ++n) { const st_t* ch = p.CH() + (size_t)(c * NCH + n) * 5 * 4096; const float gam = p.GAM()[c * NCH + n];
        for (int i = 0; i < 64; ++i) for (int e = 0; e < 64; ++e) { float v = ch[0 * 4096 + e * 64 + i]; for (int d = 0; d < 64; ++d) v -= ch[1 * 4096 + i * 64 + d] * Sm[d][e]; Vn[i][e] = v; }
        for (int i = 0; i < 64; ++i) for (int e = 0; e < 64; ++e) { float o = 0.f; for (int d = 0; d < 64; ++d) o += ch[2 * 4096 + i * 64 + d] * Sm[d][e]; for (int j = 0; j < 64; ++j) o += ch[3 * 4096 + i * 64 + j] * Vn[j][e];
            dst[(size_t)gdn_row(b, dir, n, i) * (GH * GDV) + h * 64 + e] = o; }
        for (int d = 0; d < 64; ++d) for (int e = 0; e < 64; ++e) { float sn = gam * Sm[d][e]; for (int i = 0; i < 64; ++i) sn += ch[4 * 4096 + d * 64 + i] * Vn[i][e]; Sm[d][e] = sn; }
    }
}
#else
template <int... Is, class F> __device__ __forceinline__ void static_for_impl(std::integer_sequence<int, Is...>, F&& f) { (f(std::integral_constant<int, Is>{}), ...); }
template <int N, class F> __device__ __forceinline__ void static_for(F&& f) { static_for_impl(std::make_integer_sequence<int, N>{}, f); }
__device__ __forceinline__ float bf_lo(unsigned u) { return __builtin_bit_cast(float, u << 16); }
__device__ __forceinline__ float bf_hi(unsigned u) { return __builtin_bit_cast(float, u & 0xffff0000u); }
#if PROBE_SEL >= 50 && PROBE_SEL <= 56
#define GSEC(n) do { const unsigned long long now_ = __builtin_amdgcn_s_memrealtime(); if (PROBE_SEL == 50 + (n)) pbv += now_ - last_; last_ = now_; } while (0)
#else
#define GSEC(n) do { } while (0)
#endif
template <int ROLE>
__device__ __forceinline__ void gdn_pre_role(const Params& p, int pair, LAS unsigned char* lds, const int lane, const int wave, unsigned long long& pbv) {
#if PROBE_SEL >= 50 && PROBE_SEL <= 56
    unsigned long long last_ = __builtin_amdgcn_s_memrealtime();
#endif
    constexpr int AST = 68;
    const int l31 = lane & 31, hh = lane >> 5;
    const int item = pair * 2 + (wave >> 1);
    const int c = item / NCH, n = item % NCH, dir = c & 1, h = (c >> 1) % GH, b = (c >> 1) / GH;
    LAS float* At = (LAS float*)(lds + (wave >> 1) * 18432); LAS float* gcs = At + 64 * AST; LAS float* bts = gcs + 64; LAS float* ebt = bts + 64;
    st_t* ch = p.CH() + (size_t)item * 5 * 4096;
    const int row0 = gdn_row(b, dir, n, 0); const int sgn = dir == 0 ? 1 : -1;
    const int myrow = row0 + sgn * lane;
    float gc = p.BG()[(size_t)myrow * 24 + 12 + dir * 6 + h]; const float beta = p.BG()[(size_t)myrow * 24 + dir * 6 + h];
#pragma unroll
    for (int o = 1; o < 64; o <<= 1) { const float t = __shfl_up(gc, o); if (lane >= o) gc += t; }
    const float gc63 = __shfl(gc, 63);
    __syncthreads();
    if (ROLE == 0) { gcs[lane] = gc; bts[lane] = beta; ebt[lane] = beta * __expf(gc); }
    unsigned rhs[64];
    { const long long stp = (long long)sgn * GQKV; const st_t* sp = p.G() + h * 64 + (ROLE == 0 ? 768 : 384) + lane + (size_t)row0 * GQKV;
#pragma unroll
      for (int u = 0; u < 64; ++u) rhs[u] = sp[u * stp]; }
    __builtin_amdgcn_sched_barrier(0);

    GSEC(0);
    const st_t* gbase = p.G() + h * 64;
    f32x16 d00, d10, d11;
#pragma unroll
    for (int r = 0; r < 16; ++r) { d00[r] = 0.f; d10[r] = 0.f; d11[r] = 0.f; }
    { const size_t r0 = (size_t)(row0 + sgn * l31) * GQKV, r1 = (size_t)(row0 + sgn * (32 + l31)) * GQKV; constexpr int xo = ROLE == 0 ? 384 : 0;
#pragma unroll
      for (int k2 = 0; k2 < 2; ++k2) { bf16x8 fa0[2], fa1[2], fb0[2], fb1[2];
#pragma unroll
          for (int q = 0; q < 2; ++q) { const int ks = 2 * k2 + q;
              fa0[q] = *(const bf16x8*)(gbase + r0 + xo + 16 * ks + 8 * hh); fa1[q] = *(const bf16x8*)(gbase + r1 + xo + 16 * ks + 8 * hh);
              fb0[q] = *(const bf16x8*)(gbase + r0 + 384 + 16 * ks + 8 * hh); fb1[q] = *(const bf16x8*)(gbase + r1 + 384 + 16 * ks + 8 * hh); }
          __builtin_amdgcn_sched_barrier(0);
#pragma unroll
          for (int q = 0; q < 2; ++q) {
              d00 = __builtin_amdgcn_mfma_f32_32x32x16_bf16(fa0[q], fb0[q], d00, 0, 0, 0); d10 = __builtin_amdgcn_mfma_f32_32x32x16_bf16(fa1[q], fb0[q], d10, 0, 0, 0); d11 = __builtin_amdgcn_mfma_f32_32x32x16_bf16(fa1[q], fb1[q], d11, 0, 0, 0); }
          __builtin_amdgcn_sched_barrier(0); } }
    GSEC(1);
    __syncthreads();
    auto post = [&](const f32x16& d, int ib, int jb) __attribute__((always_inline)) {
        const int j = 32 * jb + l31; const float gcj = gcs[j];
#pragma unroll
        for (int g = 0; g < 4; ++g) { const int i0 = 32 * ib + 8 * g + 4 * hh; const f32x4 gci = *(const LAS f32x4*)(gcs + i0);
            if (ROLE == 0) { const f32x4 bi = *(const LAS f32x4*)(bts + i0); f32x4 o;
#pragma unroll
                for (int u = 0; u < 4; ++u) o[u] = (j < i0 + u) ? bi[u] * d[4 * g + u] * __expf(gci[u] - gcj) : 0.f;
                *(LAS f32x4*)(At + j * AST + i0) = o; }
            else {
#pragma unroll
                for (int u = 0; u < 4; ++u) { const float v = (j <= i0 + u) ? 0.125f * d[4 * g + u] * __expf(gci[u] - gcj) : 0.f; stf(ch + 3 * 4096 + (i0 + u) * 64 + j, v); } } }
    };
    post(d00, 0, 0); post(d10, 1, 0); post(d11, 1, 1);
    if (ROLE == 1) {
#pragma unroll
        for (int r = 0; r < 16; ++r) stf(ch + 3 * 4096 + crow16(r, hh) * 64 + 32 + l31, 0.f); }
    GSEC(2);
    __syncthreads();
    GSEC(3);
    unsigned rhp[32];
#pragma unroll
    for (int u = 0; u < 32; ++u) rhp[u] = rhs[2 * u] | (rhs[2 * u + 1] << 16);
    __builtin_amdgcn_sched_barrier(0);
    f32x2 accp[32];
#pragma unroll
    for (int i = 0; i < 32; ++i) accp[i] = (f32x2){0.f, 0.f};
    { const LAS float* sc = ROLE == 0 ? bts : ebt;
      unsigned pk[4]; f32x4 s4 = (f32x4){0.f, 0.f, 0.f, 0.f}; float xprev = 0.f;
      static_for<64>([&](auto jc) __attribute__((always_inline)) {
          constexpr int j = decltype(jc)::value;
          if constexpr ((j & 3) == 0) s4 = *(const LAS f32x4*)(sc + j);
          constexpr int I0 = ((j + 1) >> 2) << 2, NV = (64 - I0) / 4, NB = 4;
          const float x = s4[j & 3] * ((j & 1) ? bf_hi(rhp[j >> 1]) : bf_lo(rhp[j >> 1])) - accp[j >> 1][j & 1];
          if constexpr (ROLE == 0) {
              if constexpr ((j & 1) == 1) pk[(j >> 1) & 3] = pk_bf16(xprev, x);
              if constexpr ((j & 7) == 7) { u32x4 w; w.x = pk[0]; w.y = pk[1]; w.z = pk[2]; w.w = pk[3]; *(u32x4*)(ch + 0 * 4096 + lane * 64 + (j - 7)) = w; }
          } else stf(ch + 1 * 4096 + j * 64 + lane, x);
          xprev = x;
#pragma unroll
          for (int k0 = 0; k0 < NV; k0 += NB) { f32x4 av[NB];
#pragma unroll
              for (int k = 0; k < NB; ++k) if (k0 + k < NV) av[k] = *(const LAS f32x4*)(At + j * AST + I0 + 4 * (k0 + k));
              __builtin_amdgcn_sched_barrier(0);
#pragma unroll
              for (int k = 0; k < NB; ++k) if (k0 + k < NV) { const int q = (I0 + 4 * (k0 + k)) >> 1;
                  const f32x2 xx = (f32x2){x, x}; accp[q] = accp[q] + (f32x2){av[k][0], av[k][1]} * xx; accp[q + 1] = accp[q + 1] + (f32x2){av[k][2], av[k][3]} * xx;
                  asm volatile("" : "+v"(accp[q]), "+v"(accp[q + 1])); }
              __builtin_amdgcn_sched_barrier(0); }
      }); }
    GSEC(4);
    { const st_t* src = gbase + (size_t)myrow * GQKV + (ROLE == 0 ? 384 : 0); const float sc = ROLE == 0 ? __expf(gc63 - gc) : 0.125f * __expf(gc);
      u32x4 wv[8];
#pragma unroll
      for (int c8 = 0; c8 < 8; ++c8) wv[c8] = *(const u32x4*)(src + 8 * c8);
      __builtin_amdgcn_sched_barrier(0);
#pragma unroll
      for (int c8 = 0; c8 < 8; ++c8) { const u32x4 w = wv[c8];
          const float f0 = bf_lo(w.x) * sc, f1 = bf_hi(w.x) * sc, f2 = bf_lo(w.y) * sc, f3 = bf_hi(w.y) * sc, f4 = bf_lo(w.z) * sc, f5 = bf_hi(w.z) * sc, f6 = bf_lo(w.w) * sc, f7 = bf_hi(w.w) * sc;
          if (ROLE == 0) { st_t* kt = ch + 4 * 4096 + (8 * c8) * 64 + lane; stf(kt, f0); stf(kt + 64, f1); stf(kt + 128, f2); stf(kt + 192, f3); stf(kt + 256, f4); stf(kt + 320, f5); stf(kt + 384, f6); stf(kt + 448, f7); }
          else { u32x4 o; o.x = pk_bf16(f0, f1); o.y = pk_bf16(f2, f3); o.z = pk_bf16(f4, f5); o.w = pk_bf16(f6, f7); *(u32x4*)(ch + 2 * 4096 + lane * 64 + 8 * c8) = o; } } }
    if (ROLE == 0 && lane == 0) p.GAM()[item] = __expf(gc63);
    GSEC(5);
}
static_assert((NCHAIN * NCH) % 2 == 0, "chunk items come in pairs");
__device__ __forceinline__ void gdn_pre_dev(const Params& p, int pair, LAS unsigned char* lds, const int tid, unsigned long long& pbv) {
    const int lane = tid & 63, wave = __builtin_amdgcn_readfirstlane(tid >> 6);
    if ((wave & 1) == 0) gdn_pre_role<0>(p, pair, lds, lane, wave, pbv); else gdn_pre_role<1>(p, pair, lds, lane, wave, pbv);
}
__device__ __forceinline__ void gdn_scan_dev(const Params& p, int c, LAS unsigned char* lds, const int tid) {
    constexpr int RS = 136, MB = 64 * RS;
    const int lane = tid & 63, wave = __builtin_amdgcn_readfirstlane(tid >> 6), r16 = lane & 15, q = lane >> 4;
    const int dir = c & 1, h = (c >> 1) % GH, b = (c >> 1) / GH; st_t* dst = (dir == 0 ? p.OF() : p.OB()) + h * 64 + 16 * wave + r16;
    f32x4 Sb[4];
#pragma unroll
    for (int i = 0; i < 4; ++i) Sb[i] = (f32x4){0.f, 0.f, 0.f, 0.f};
    u32x4 stg[10]; float gam_next = 0.f;
    auto gload = [&](int n) { const u32x4* src = (const u32x4*)(p.CH() + (size_t)(c * NCH + n) * 5 * 4096);
#pragma unroll
        for (int u = 0; u < 10; ++u) stg[u] = __builtin_nontemporal_load(src + tid + 256 * u);
        gam_next = p.GAM()[c * NCH + n]; };
    auto lstore = [&]() {
#pragma unroll
        for (int u = 0; u < 10; ++u) { const int ci = tid + 256 * u, mat = ci >> 9, row = (ci >> 3) & 63, cc = ci & 7; LAS u32x2* d = (LAS u32x2*)(lds + mat * MB + row * RS + cc * 16);
            d[0] = (u32x2){stg[u].x, stg[u].y}; d[1] = (u32x2){stg[u].z, stg[u].w}; } };
    auto afrag = [&](int mat, int row, int a2) -> bf16x8 { const LAS unsigned char* bp = lds + mat * MB + row * RS + (32 * a2 + 4 * q) * 2;
        const u32x2 lo = *(const LAS u32x2*)bp, hi = *(const LAS u32x2*)(bp + 32); u32x4 w; w.x = lo.x; w.y = lo.y; w.z = hi.x; w.w = hi.y; return __builtin_bit_cast(bf16x8, w); };
    auto pack2 = [&](const f32x4& x, const f32x4& y) -> bf16x8 { u32x4 w; w.x = pk_bf16(x[0], x[1]); w.y = pk_bf16(x[2], x[3]); w.z = pk_bf16(y[0], y[1]); w.w = pk_bf16(y[2], y[3]); return __builtin_bit_cast(bf16x8, w); };
    __syncthreads();
    gload(0); lstore(); float gam = gam_next;
    __syncthreads();
    const int sgn = dir == 0 ? 1 : -1;
    for (int n = 0; n < NCH; ++n) {
        if (n + 1 < NCH) gload(n + 1);
        const bf16x8 sb0 = pack2(Sb[0], Sb[1]), sb1 = pack2(Sb[2], Sb[3]);
        bf16x8 fw[8], fq[8]; u32x2 uu[4];
#pragma unroll
        for (int i = 0; i < 8; ++i) fw[i] = afrag(1, 16 * (i >> 1) + r16, i & 1);
#pragma unroll
        for (int tb = 0; tb < 4; ++tb) uu[tb] = *(const LAS u32x2*)(lds + 0 * MB + (16 * wave + r16) * RS + (16 * tb + 4 * q) * 2);
#pragma unroll
        for (int i = 0; i < 8; ++i) fq[i] = afrag(2, 16 * (i >> 1) + r16, i & 1);
        __builtin_amdgcn_sched_barrier(0);
        f32x4 vn[4], oc[4];
#pragma unroll
        for (int tb = 0; tb < 4; ++tb) {
            f32x4 acc = (f32x4){0.f, 0.f, 0.f, 0.f};
            acc = __builtin_amdgcn_mfma_f32_16x16x32_bf16(fw[2 * tb], sb0, acc, 0, 0, 0);
            acc = __builtin_amdgcn_mfma_f32_16x16x32_bf16(fw[2 * tb + 1], sb1, acc, 0, 0, 0);
            vn[tb][0] = bf_lo(uu[tb].x) - acc[0]; vn[tb][1] = bf_hi(uu[tb].x) - acc[1]; vn[tb][2] = bf_lo(uu[tb].y) - acc[2]; vn[tb][3] = bf_hi(uu[tb].y) - acc[3];
        }
        __builtin_amdgcn_sched_barrier(0);
        bf16x8 fm[8];
#pragma unroll
        for (int i = 0; i < 8; ++i) fm[i] = afrag(3, 16 * (i >> 1) + r16, i & 1);
        __builtin_amdgcn_sched_barrier(0);
#pragma unroll
        for (int tb = 0; tb < 4; ++tb) {
            f32x4 o = (f32x4){0.f, 0.f, 0.f, 0.f};
            o = __builtin_amdgcn_mfma_f32_16x16x32_bf16(fq[2 * tb], sb0, o, 0, 0, 0);
            o = __builtin_amdgcn_mfma_f32_16x16x32_bf16(fq[2 * tb + 1], sb1, o, 0, 0, 0);
            oc[tb] = o;
        }
        const bf16x8 vb0 = pack2(vn[0], vn[1]), vb1 = pack2(vn[2], vn[3]);
        __builtin_amdgcn_sched_barrier(0);
        bf16x8 fk[8];
#pragma unroll
        for (int i = 0; i < 8; ++i) fk[i] = afrag(4, 16 * (i >> 1) + r16, i & 1);
        __builtin_amdgcn_sched_barrier(0);
        const int row0 = gdn_row(b, dir, n, 0);
#pragma unroll
        for (int tb = 0; tb < 4; ++tb) {
            f32x4 o = oc[tb];
            o = __builtin_amdgcn_mfma_f32_16x16x32_bf16(fm[2 * tb], vb0, o, 0, 0, 0);
            o = __builtin_amdgcn_mfma_f32_16x16x32_bf16(fm[2 * tb + 1], vb1, o, 0, 0, 0);
            oc[tb] = o;
        }
#pragma unroll
        for (int db = 0; db < 4; ++db) {
            f32x4 sn = Sb[db] * gam;
            sn = __builtin_amdgcn_mfma_f32_16x16x32_bf16(fk[2 * db], vb0, sn, 0, 0, 0);
            sn = __builtin_amdgcn_mfma_f32_16x16x32_bf16(fk[2 * db + 1], vb1, sn, 0, 0, 0);
            Sb[db] = sn;
        }
#pragma unroll
        for (int tb = 0; tb < 4; ++tb) {
#pragma unroll
            for (int u = 0; u < 4; ++u) stf(dst + (size_t)(row0 + sgn * (16 * tb + 4 * q + u)) * (GH * GDV), oc[tb][u]);
        }
        __syncthreads();
        if (n + 1 < NCH) { lstore(); gam = gam_next; }
        __syncthreads();
    }
}
#endif


#ifndef HOST_EMU
enum { R_NORM1 = 0, R_POST1 = 1, R_POST2 = 2, R_XFORM = 3, R_GOUT = 4, R_ROUTE2 = 5 };
template <int CTRL> __device__ __forceinline__ float dpp_f(float v) { return __builtin_bit_cast(float, __builtin_amdgcn_update_dpp(0, __builtin_bit_cast(int, v), CTRL, 0xF, 0xF, true)); }
__device__ __forceinline__ float rdlane_f(float v, int l) { return __builtin_bit_cast(float, __builtin_amdgcn_readlane(__builtin_bit_cast(int, v), l)); }
__device__ __forceinline__ float wave_sum(float v) {
    v += dpp_f<0xB1>(v); v += dpp_f<0x4E>(v); v += dpp_f<0x141>(v); v += dpp_f<0x140>(v);
    return (rdlane_f(v, 0) + rdlane_f(v, 16)) + (rdlane_f(v, 32) + rdlane_f(v, 48));
}
__device__ __forceinline__ void ld_row_f32(const float* p, int lane, f32x4 (&v)[D / 256]) {
#pragma unroll
    for (int j = 0; j < D / 256; ++j) v[j] = *(const f32x4*)(p + 4 * lane + 256 * j); }
__device__ __forceinline__ void ld_row_bf16(const st_t* p, int lane, f32x4 (&v)[D / 256]) {
#pragma unroll
    for (int j = 0; j < D / 256; ++j) { const u32x2 w = *(const u32x2*)(p + 4 * lane + 256 * j); v[j] = (f32x4){bf_lo(w.x), bf_hi(w.x), bf_lo(w.y), bf_hi(w.y)}; } }
__device__ __forceinline__ void st_row_bf16(st_t* p, int lane, const f32x4 (&v)[D / 256]) {
#pragma unroll
    for (int j = 0; j < D / 256; ++j) st4(p + 4 * lane + 256 * j, v[j][0], v[j][1], v[j][2], v[j][3]); }
__device__ __forceinline__ float sumsq(const f32x4 (&v)[D / 256]) { float s = 0.f;
#pragma unroll
    for (int j = 0; j < D / 256; ++j) s += (v[j][0] * v[j][0] + v[j][1] * v[j][1]) + (v[j][2] * v[j][2] + v[j][3] * v[j][3]);
    return wave_sum(s); }
template <bool TO_LDS>
__device__ __forceinline__ void modulate_store(const f32x4 (&x)[D / 256], float rstd, const float* gain, const float* sc, const float* sh, st_t* hrow, int lane, LAS float* hl, int swz = 0) {
    f32x4 g[D / 256], a[D / 256], b[D / 256], h[D / 256]; ld_row_f32(gain, lane, g); ld_row_f32(sc, lane, a); ld_row_f32(sh, lane, b);
#pragma unroll
    for (int j = 0; j < D / 256; ++j) h[j] = x[j] * rstd * g[j] * (a[j] + 1.0f) + b[j];
    st_row_bf16(hrow, lane, h);
    if constexpr (TO_LDS) {
#pragma unroll
        for (int j = 0; j < D / 256; ++j) *(LAS f32x4*)(hl + (((lane + 64 * j) ^ swz) << 2)) = h[j]; }
}
__device__ __forceinline__ void row_norm1(const Params& p, int layer, int r, int lane) {
    f32x4 x[D / 256]; ld_row_f32(xin_row(p, layer, r), lane, x);
    const float rstd = rsqrt_f(sumsq(x) / D + EPS);
    modulate_store<false>(x, rstd, p.mix_norm_pre + (size_t)layer * D, mod_vec(p, layer, r, 1), mod_vec(p, layer, r, 0), p.H() + (size_t)r * D, lane, (LAS float*)0);
}
__device__ __forceinline__ void route_pick(const Params& p, int layer, int r, int lane, float logit, LAS int* lcnt);
template <int NR>
__device__ __forceinline__ void row_post1_multi(const Params& p, int layer, int item, int lane, LAS float* hl, LAS int* lcnt) {
#pragma unroll
    for (int rr = 0; rr < NR; ++rr) { const int r = NR * item + rr;
        f32x4 y[D / 256], x[D / 256], g1[D / 256], gp[D / 256]; ld_row_bf16(p.Y() + (size_t)r * D, lane, y); ld_row_f32(xin_row(p, layer, r), lane, x);
        ld_row_f32(mod_vec(p, layer, r, 2), lane, g1); ld_row_f32(p.mix_norm_post + (size_t)layer * D, lane, gp);
        const float rstd = rsqrt_f(sumsq(y) / D + EPS);
#pragma unroll
        for (int j = 0; j < D / 256; ++j) x[j] = x[j] + g1[j] * y[j] * rstd * gp[j];
        float* xr = xrow(p, r);
#pragma unroll
        for (int j = 0; j < D / 256; ++j) *(f32x4*)(xr + 4 * lane + 256 * j) = x[j];
        const float r2 = rsqrt_f(sumsq(x) / D + EPS);
        modulate_store<true>(x, r2, p.ffn_norm_pre + (size_t)layer * D, mod_vec(p, layer, r, 4), mod_vec(p, layer, r, 3), p.H() + (size_t)r * D, lane, hl + rr * D);
    }
    asm volatile("s_waitcnt lgkmcnt(0)" ::: "memory");
    const float* wr = p.router_w + (size_t)layer * D * NE + lane; float acc[NR];
#pragma unroll
    for (int rr = 0; rr < NR; ++rr) acc[rr] = 0.f;
#pragma unroll 4
    for (int d4 = 0; d4 < D / 4; ++d4) { f32x4 hv[NR];
#pragma unroll
        for (int rr = 0; rr < NR; ++rr) hv[rr] = *(const LAS f32x4*)(hl + rr * D + 4 * d4);
#pragma unroll
        for (int u = 0; u < 4; ++u) { const float w = wr[(size_t)(4 * d4 + u) * NE];
#pragma unroll
            for (int rr = 0; rr < NR; ++rr) acc[rr] += hv[rr][u] * w; } }
#pragma unroll
    for (int rr = 0; rr < NR; ++rr) route_pick(p, layer, NR * item + rr, lane, acc[rr], lcnt);
    asm volatile("s_waitcnt lgkmcnt(0)" ::: "memory");
}
#if PROBE_SEL >= 40 && PROBE_SEL <= 43
#define P1SEC(n) do { const unsigned long long now_ = __builtin_amdgcn_s_memrealtime(); if (PROBE_SEL == 40 + (n)) pbv += now_ - last_; last_ = now_; } while (0)
#else
#define P1SEC(n) do { } while (0)
#endif
__device__ __forceinline__ void block_post1(const Params& p, int layer, int j16, int lane, int wave, LAS unsigned char* lds, LAS int* lcnt, unsigned long long& pbv) {
    LAS float* hl = (LAS float*)lds;
    asm volatile("s_nop 0\n\ts_nop 0\n\ts_nop 0\n\ts_nop 0\n\ts_nop 0\n\ts_nop 0\n\ts_nop 0\n\ts_nop 0\n\ts_nop 0");
#if PROBE_SEL >= 40 && PROBE_SEL <= 43
    unsigned long long last_ = __builtin_amdgcn_s_memrealtime();
#endif
#pragma unroll
    for (int rr = 0; rr < 4; ++rr) { const int r16 = 4 * wave + rr, r = 16 * j16 + r16;
        f32x4 y[D / 256], x[D / 256], g1[D / 256], gp[D / 256]; ld_row_bf16(p.Y() + (size_t)r * D, lane, y); ld_row_f32(xin_row(p, layer, r), lane, x);
        ld_row_f32(mod_vec(p, layer, r, 2), lane, g1); ld_row_f32(p.mix_norm_post + (size_t)layer * D, lane, gp);
        const float rstd = rsqrt_f(sumsq(y) / D + EPS);
#pragma unroll
        for (int j = 0; j < D / 256; ++j) x[j] = x[j] + g1[j] * y[j] * rstd * gp[j];
        float* xr = xrow(p, r);
#pragma unroll
        for (int j = 0; j < D / 256; ++j) *(f32x4*)(xr + 4 * lane + 256 * j) = x[j];
        const float r2 = rsqrt_f(sumsq(x) / D + EPS);
        modulate_store<true>(x, r2, p.ffn_norm_pre + (size_t)layer * D, mod_vec(p, layer, r, 4), mod_vec(p, layer, r, 3), p.H() + (size_t)r * D, lane, hl + r16 * D, r16);
    }
    P1SEC(0);
    __syncthreads();
    P1SEC(1);
    const int row = lane & 15, kq = lane >> 4;
    const float* wr = p.router_w + (size_t)layer * D * NE + (size_t)(256 * wave + 4 * kq) * NE + 4 * row;
    f32x4 acc[4];
#pragma unroll
    for (int jj = 0; jj < 4; ++jj) acc[jj] = (f32x4){0.f, 0.f, 0.f, 0.f};
#pragma unroll 1
    for (int bt = 0; bt < 8; ++bt) {
        f32x4 bq[8], aq[2];
        const float* wb = wr + (size_t)(32 * bt) * NE; asm volatile("" : "+v"(wb));
#pragma unroll
        for (int b2 = 0; b2 < 2; ++b2) { const int c = 64 * wave + 8 * bt + 4 * b2 + kq;
            aq[b2] = *(const LAS f32x4*)(hl + row * D + ((c ^ row) << 2));
#pragma unroll
            for (int u = 0; u < 4; ++u) bq[4 * b2 + u] = *(const f32x4*)(wb + (size_t)(16 * b2 + u) * NE); }
        __builtin_amdgcn_sched_barrier(0);
#pragma unroll
        for (int b2 = 0; b2 < 2; ++b2)
#pragma unroll
            for (int u = 0; u < 4; ++u)
#pragma unroll
                for (int jj = 0; jj < 4; ++jj) acc[jj] = __builtin_amdgcn_mfma_f32_16x16x4f32(aq[b2][u], bq[4 * b2 + u][jj], acc[jj], 0, 0, 0);
        __builtin_amdgcn_sched_barrier(0);
    }
    P1SEC(2);
    __syncthreads();
#pragma unroll
    for (int r = 0; r < 4; ++r) *(LAS f32x4*)(hl + (wave * 16 + 4 * kq + r) * NE + 4 * row) = (f32x4){acc[0][r], acc[1][r], acc[2][r], acc[3][r]};
    __syncthreads();
#pragma unroll
    for (int rr = 0; rr < 4; ++rr) { const int r16 = 4 * wave + rr; float lg = 0.f;
#pragma unroll
        for (int w2 = 0; w2 < 4; ++w2) lg += hl[(w2 * 16 + r16) * NE + lane];
        route_pick(p, layer, 16 * j16 + r16, lane, lg, lcnt); }
    asm volatile("s_waitcnt lgkmcnt(0)" ::: "memory");
    __syncthreads();
    P1SEC(3);
}
__device__ __forceinline__ void route_row(const Params& p, int layer, int r, int lane, float logit) {
    const float sg = sigmoid_f(logit), v = sg + p.router_bias[(size_t)layer * NE + lane];
    float m1 = v; int i1 = lane;
#pragma unroll
    for (int o = 1; o < 8; o <<= 1) { const float ov = __shfl_xor(m1, o); const int oi = __shfl_xor(i1, o); if (ov > m1 || (ov == m1 && oi < i1)) { m1 = ov; i1 = oi; } }
    float m2 = lane == i1 ? -3.0e38f : v;
#pragma unroll
    for (int o = 1; o < 8; o <<= 1) m2 = fmaxf(m2, __shfl_xor(m2, o));
    const float gs = m1 + m2; const int grp = lane >> 3;
    int grank = 0;
#pragma unroll
    for (int j = 0; j < NGRP; ++j) { const float og = __shfl(gs, j * 8); grank += (og > gs || (og == gs && j < grp)) ? 1 : 0; }
    const float mv = grank < TOPG ? v : -3.0e38f;
    int rank = 0;
#pragma unroll
    for (int j = 0; j < NE; ++j) { const float ov = __shfl(mv, j); rank += (ov > mv || (ov == mv && j < lane)) ? 1 : 0; }
    const bool sel = rank < TOPK;
    const float wsum = wave_sum(sel ? sg : 0.f);
    if (sel) { const float w = sg / wsum * ROUTED_SCALE; const int pos = atomicAdd(p.CNT() + layer * NE + lane, 1); atomicAdd(p.CNTP() + (layer * NE + lane) * 32, 1);
        p.EIDX()[(size_t)r * TOPK + rank] = lane; p.EPOS()[(size_t)r * TOPK + rank] = pos; p.TOKLIST()[(size_t)lane * TA + pos] = r; p.WLIST()[(size_t)lane * TA + pos] = w; }
}
__device__ __forceinline__ void row_post1_quad(const Params& p, int layer, int quad, int lane, LAS float* hl) {
#pragma unroll
    for (int rr = 0; rr < 4; ++rr) { const int r = 4 * quad + rr;
        f32x4 y[D / 256], x[D / 256], g1[D / 256], gp[D / 256]; ld_row_bf16(p.Y() + (size_t)r * D, lane, y); ld_row_f32(xin_row(p, layer, r), lane, x);
        ld_row_f32(mod_vec(p, layer, r, 2), lane, g1); ld_row_f32(p.mix_norm_post + (size_t)layer * D, lane, gp);
        const float rstd = rsqrt_f(sumsq(y) / D + EPS);
#pragma unroll
        for (int j = 0; j < D / 256; ++j) x[j] = x[j] + g1[j] * y[j] * rstd * gp[j];
        float* xr = xrow(p, r);
#pragma unroll
        for (int j = 0; j < D / 256; ++j) *(f32x4*)(xr + 4 * lane + 256 * j) = x[j];
        const float r2 = rsqrt_f(sumsq(x) / D + EPS);
        modulate_store<true>(x, r2, p.ffn_norm_pre + (size_t)layer * D, mod_vec(p, layer, r, 4), mod_vec(p, layer, r, 3), p.H() + (size_t)r * D, lane, hl + rr * D);
    }
    asm volatile("s_waitcnt lgkmcnt(0)" ::: "memory");
    const float* wr = p.router_w + (size_t)layer * D * NE + lane; float a0 = 0.f, a1 = 0.f, a2 = 0.f, a3 = 0.f;
#pragma unroll 4
    for (int d4 = 0; d4 < D / 4; ++d4) { const f32x4 h0 = *(const LAS f32x4*)(hl + 4 * d4), h1 = *(const LAS f32x4*)(hl + D + 4 * d4), h2 = *(const LAS f32x4*)(hl + 2 * D + 4 * d4), h3 = *(const LAS f32x4*)(hl + 3 * D + 4 * d4);
#pragma unroll
        for (int u = 0; u < 4; ++u) { const float w = wr[(size_t)(4 * d4 + u) * NE]; a0 += h0[u] * w; a1 += h1[u] * w; a2 += h2[u] * w; a3 += h3[u] * w; } }
    route_row(p, layer, 4 * quad, lane, a0); route_row(p, layer, 4 * quad + 1, lane, a1); route_row(p, layer, 4 * quad + 2, lane, a2); route_row(p, layer, 4 * quad + 3, lane, a3);
    asm volatile("s_waitcnt lgkmcnt(0)" ::: "memory");
}
__device__ __forceinline__ void route_pick(const Params& p, int layer, int r, int lane, float logit, LAS int* lcnt) {
    const float sg = sigmoid_f(logit), v = sg + p.router_bias[(size_t)layer * NE + lane];
    float m1 = v; int i1 = lane;
#pragma unroll
    for (int o = 1; o < 8; o <<= 1) { const float ov = __shfl_xor(m1, o); const int oi = __shfl_xor(i1, o); if (ov > m1 || (ov == m1 && oi < i1)) { m1 = ov; i1 = oi; } }
    float m2 = lane == i1 ? -3.0e38f : v;
#pragma unroll
    for (int o = 1; o < 8; o <<= 1) m2 = fmaxf(m2, __shfl_xor(m2, o));
    const float gs = m1 + m2; const int grp = lane >> 3;
    int grank = 0;
#pragma unroll
    for (int j = 0; j < NGRP; ++j) { const float og = __builtin_bit_cast(float, __builtin_amdgcn_readlane(__builtin_bit_cast(int, gs), j * 8)); grank += (og > gs || (og == gs && j < grp)) ? 1 : 0; }
    const float mv = grank < TOPG ? v : -3.0e38f;
    int rank = 0;
#pragma unroll
    for (int j = 0; j < NE; ++j) { const float ov = __builtin_bit_cast(float, __builtin_amdgcn_readlane(__builtin_bit_cast(int, mv), j)); rank += (ov > mv || (ov == mv && j < lane)) ? 1 : 0; }
    const bool sel = rank < TOPK;
    const float wsum = wave_sum(sel ? sg : 0.f);
    if (sel) { p.EIDX()[(size_t)r * TOPK + rank] = lane; p.EW()[(size_t)r * TOPK + rank] = sg / wsum * ROUTED_SCALE; __hip_atomic_fetch_add(lcnt + lane, 1, __ATOMIC_RELAXED, __HIP_MEMORY_SCOPE_WORKGROUP); }
}
__device__ __forceinline__ void route_place(const Params& p, int layer, LAS unsigned char* lds, int tid, int lane, int wave) {
    LAS int* pb = (LAS int*)lds; LAS int* lpos = pb + NE;
    __syncthreads();
    { const int e = tid & (NE - 1), qd = tid >> 6, per = ((int)gridDim.x + 3) / 4; int below = 0, tot = 0; const int* bc = p.BCNT() + e;
      const int b_hi = (qd + 1) * per < (int)gridDim.x ? (qd + 1) * per : (int)gridDim.x;
#pragma unroll 8
      for (int b2 = qd * per; b2 < b_hi; ++b2) { const int c = bc[(size_t)b2 * NE]; tot += c; below += b2 < (int)blockIdx.x ? c : 0; }
      LAS int* red = lpos + NE; red[tid] = below; red[256 + tid] = tot; }
    __syncthreads();
    if (tid < NE) { LAS int* red = lpos + NE; pb[tid] = red[tid] + red[64 + tid] + red[128 + tid] + red[192 + tid]; lpos[tid] = 0;
        if (blockIdx.x == 0) p.CNT()[layer * NE + tid] = red[256 + tid] + red[320 + tid] + red[384 + tid] + red[448 + tid]; }
    __syncthreads();
    const int gw = blockIdx.x * 4 + wave, nw = gridDim.x * 4;
    for (int i = gw; i < rows_out(layer) / POST1_NR; i += nw) {
        if (lane < POST1_NR * TOPK) { const int r = POST1_NR * i + (lane >> 3), k = lane & 7; const int e = p.EIDX()[(size_t)r * TOPK + k]; const float w = p.EW()[(size_t)r * TOPK + k];
            const int pos = pb[e] + __hip_atomic_fetch_add(lpos + e, 1, __ATOMIC_RELAXED, __HIP_MEMORY_SCOPE_WORKGROUP);
            p.EPOS()[(size_t)r * TOPK + k] = pos; p.TOKLIST()[(size_t)e * TA + pos] = r; p.WLIST()[(size_t)e * TA + pos] = w; }
    }
}
__device__ __forceinline__ void row_post2(const Params& p, int layer, int r, int lane, const int* eb) {
    int slot = 0;
    if (lane < TOPK) { const int e = p.EIDX()[(size_t)r * TOPK + lane]; slot = eb[e] + p.EPOS()[(size_t)r * TOPK + lane]; }
    f32x4 f[D / 256]; ld_row_bf16(p.SH() + (size_t)r * D, lane, f);
#pragma unroll
    for (int k = 0; k < TOPK; ++k) { const int sk = __shfl(slot, k); f32x4 t[D / 256];
#pragma unroll
        for (int j = 0; j < D / 256; ++j) { const u32x2 w = __builtin_nontemporal_load((const u32x2*)(p.YB() + (size_t)sk * D + 4 * lane + 256 * j)); t[j] = (f32x4){bf_lo(w.x), bf_hi(w.x), bf_lo(w.y), bf_hi(w.y)}; }
#pragma unroll
        for (int j = 0; j < D / 256; ++j) f[j] += t[j]; }
    const float rstd = rsqrt_f(sumsq(f) / D + EPS);
    float* xr = xrow(p, r); f32x4 x[D / 256], g2[D / 256], gp[D / 256]; ld_row_f32(xr, lane, x); ld_row_f32(mod_vec(p, layer, r, 5), lane, g2); ld_row_f32(p.ffn_norm_post + (size_t)layer * D, lane, gp);
#pragma unroll
    for (int j = 0; j < D / 256; ++j) { x[j] = x[j] + g2[j] * f[j] * rstd * gp[j]; *(f32x4*)(xr + 4 * lane + 256 * j) = x[j]; }
    if (layer + 1 < DEPTH) { const float r2 = rsqrt_f(sumsq(x) / D + EPS);
        modulate_store<false>(x, r2, p.mix_norm_pre + (size_t)(layer + 1) * D, mod_vec(p, layer + 1, r, 1), mod_vec(p, layer + 1, r, 0), p.H() + (size_t)r * D, lane, (LAS float*)0); }
}
__device__ __forceinline__ void unpack8(const u32x4 w, float (&x)[8]) { x[0] = bf_lo(w.x); x[1] = bf_hi(w.x); x[2] = bf_lo(w.y); x[3] = bf_hi(w.y); x[4] = bf_lo(w.z); x[5] = bf_hi(w.z); x[6] = bf_lo(w.w); x[7] = bf_hi(w.w); }
__device__ __forceinline__ u32x4 pack8(const float (&x)[8]) { u32x4 o; o.x = pk_bf16(x[0], x[1]); o.y = pk_bf16(x[2], x[3]); o.z = pk_bf16(x[4], x[5]); o.w = pk_bf16(x[6], x[7]); return o; }
__device__ __forceinline__ void row_xform(const Params& p, int layer, int r, int lane, const LAS float* cw) {
    int lo, hi; seq_bounds(r, lo, hi);
    const st_t* prow = p.P() + (size_t)r * DPROJP;
    float tapw[GCONV]; int tapr[GCONV];
#pragma unroll
    for (int j = 0; j < GCONV; ++j) { const int rr = r + j - 2; const bool in = rr >= lo && rr < hi; tapw[j] = in ? 1.0f : 0.0f; tapr[j] = in ? rr : r; }
    u32x4 cqv = (u32x4){0u, 0u, 0u, 0u}, ckvv = (u32x4){0u, 0u, 0u, 0u};
    if (lane < MQR / 8) cqv = *(const u32x4*)(prow + PO_CQ + 8 * lane);
    if (lane < MKVR / 8) ckvv = *(const u32x4*)(prow + PO_CKV + 8 * lane);
#pragma unroll
    for (int gi = 0; gi < 3; ++gi) {
        if (gi < 2 || lane < 16) {
            const int c0 = 8 * (lane + 64 * gi); float acc[8];
            u32x4 xv[GCONV];
#pragma unroll
            for (int j = 0; j < GCONV; ++j) xv[j] = *(const u32x4*)(p.P() + (size_t)tapr[j] * DPROJP + PO_GQKV + c0);
            __builtin_amdgcn_sched_barrier(0);
#pragma unroll
            for (int e = 0; e < 8; ++e) acc[e] = 0.f;
#pragma unroll
            for (int j = 0; j < GCONV; ++j) { float x[8]; unpack8(xv[j], x);
                const f32x4 w0 = *(const LAS f32x4*)(cw + j * GQKV + c0) * tapw[j], w1 = *(const LAS f32x4*)(cw + j * GQKV + c0 + 4) * tapw[j];
#pragma unroll
                for (int e = 0; e < 4; ++e) { acc[e] += w0[e] * x[e]; acc[4 + e] += w1[e] * x[4 + e]; } }
            float ss = 0.f;
#pragma unroll
            for (int e = 0; e < 8; ++e) { acc[e] = silu_f(acc[e]); ss += acc[e] * acc[e]; }
            if (gi < 2) {
                ss += dpp_f<0xB1>(ss); ss += dpp_f<0x4E>(ss); ss += dpp_f<0x141>(ss);
                const float rn = c0 < 2 * GH * GDK ? rsqrt_f(ss + EPS) : 1.0f;
#pragma unroll
                for (int e = 0; e < 8; ++e) acc[e] *= rn; }
            *(u32x4*)(p.G() + (size_t)r * GQKV + c0) = pack8(acc);
        }
    }
    if (lane < 12) { const float beta = sigmoid_f(ldf(prow + PO_BA + lane)), a = ldf(prow + PO_BA + 12 + lane);
        p.BG()[(size_t)r * 24 + lane] = beta; p.BG()[(size_t)r * 24 + 12 + lane] = -expf(p.gdn_a_log[layer * 12 + lane]) * softplus_f(a + p.gdn_dt_bias[layer * 12 + lane]); }
    { float x[8]; float ss = 0.f;
      if (lane < MQR / 8) { unpack8(cqv, x);
#pragma unroll
          for (int e = 0; e < 8; ++e) ss += x[e] * x[e]; }
      const float rstd = rsqrt_f(wave_sum(ss) / MQR + EPS);
      if (lane < MQR / 8) { const float* gn = p.mla_q_norm + (size_t)layer * MQR + 8 * lane;
#pragma unroll
          for (int e = 0; e < 8; ++e) x[e] = x[e] * rstd * gn[e];
          *(u32x4*)(p.CQN() + (size_t)r * MQR + 8 * lane) = pack8(x); } }
    { float x[8]; float ss = 0.f;
      if (lane < MKVR / 8) { unpack8(ckvv, x);
#pragma unroll
          for (int e = 0; e < 8; ++e) ss += x[e] * x[e]; }
      const float rstd = rsqrt_f(wave_sum(ss) / MKVR + EPS);
      if (lane < MKVR / 8) { const float* gn = p.mla_kv_norm + (size_t)layer * MKVR + 8 * lane;
#pragma unroll
          for (int e = 0; e < 8; ++e) x[e] = x[e] * rstd * gn[e];
          *(u32x4*)(p.CKVN() + (size_t)r * MKVR + 8 * lane) = pack8(x); } }
}
__device__ __forceinline__ void row_mla_merge(const Params& p, int r, int lane) {
    if (NSPLIT == 1 || r >= T || lane >= MH * MV / 8) return;
    const int h = lane / (MV / 8); float mc[NSPLIT], lc[NSPLIT], mx = -3.0e38f;
#pragma unroll
    for (int c = 0; c < NSPLIT; ++c) { const float* ml = p.MLPART() + (((size_t)c * T + r) * MH + h) * 2; mc[c] = ml[0]; lc[c] = ml[1]; mx = fmaxf(mx, mc[c]); }
    float o[8], wsum = 0.f;
#pragma unroll
    for (int e = 0; e < 8; ++e) o[e] = 0.f;
#pragma unroll
    for (int c = 0; c < NSPLIT; ++c) { const float w = lc[c] * __builtin_amdgcn_exp2f(mc[c] - mx); wsum += w; float x[8]; unpack8(*(const u32x4*)(p.OPART() + ((size_t)c * T + r) * MH * MV + 8 * lane), x);
#pragma unroll
        for (int e = 0; e < 8; ++e) o[e] += w * x[e]; }
    const float inv = __builtin_amdgcn_rcpf(wsum);
#pragma unroll
    for (int e = 0; e < 8; ++e) o[e] *= inv;
    *(u32x4*)(p.O() + (size_t)r * DMIX + (SWA_H + GH) * 64 + 8 * lane) = pack8(o);
}
__device__ __forceinline__ void row_gout(const Params& p, int layer, int r, int lane) {
    row_mla_merge(p, r, lane);
    float o[8]; float ss = 0.f; const bool act = lane < GH * GDV / 8;
    if (act) { float a[8], b[8]; unpack8(*(const u32x4*)(p.OF() + (size_t)r * (GH * GDV) + 8 * lane), a); unpack8(*(const u32x4*)(p.OB() + (size_t)r * (GH * GDV) + 8 * lane), b);
#pragma unroll
        for (int e = 0; e < 8; ++e) { o[e] = a[e] + b[e]; ss += o[e] * o[e]; } }
    ss += __shfl_xor(ss, 1); ss += __shfl_xor(ss, 2); ss += __shfl_xor(ss, 4);
    if (act) { const float rstd = rsqrt_f(ss / GDV + EPS); float z[8]; unpack8(*(const u32x4*)(p.P() + (size_t)r * DPROJP + PO_Z + 8 * lane), z);
        const float* nw = p.gdn_norm_w + layer * GDV + (8 * lane) % GDV;
#pragma unroll
        for (int e = 0; e < 8; ++e) o[e] = o[e] * rstd * nw[e] * silu_f(z[e]);
        *(u32x4*)(p.O() + (size_t)r * DMIX + GH * GDV + 8 * lane) = pack8(o); }
}
template <int NR>
__device__ __forceinline__ void row_gout_multi(const Params& p, int layer, const int (&rows)[NR], int nvalid, int lane) {
    const int lm = lane & 31, hm = lm / (MV / 8);
    const int lg = lane < GH * GDV / 8 ? lane : GH * GDV / 8 - 1;
    float ml[NR][NSPLIT][2]; u32x4 op[NR][NSPLIT], ofv[NR], obv[NR], zv[NR];
#pragma unroll
    for (int i = 0; i < NR; ++i) { const int r = rows[i], rl = r < T ? r : 0;
#pragma unroll
        for (int c = 0; c < NSPLIT; ++c) { const float* mp = p.MLPART() + (((size_t)c * T + rl) * MH + hm) * 2; ml[i][c][0] = mp[0]; ml[i][c][1] = mp[1];
            op[i][c] = *(const u32x4*)(p.OPART() + ((size_t)c * T + rl) * MH * MV + 8 * lm); }
        ofv[i] = *(const u32x4*)(p.OF() + (size_t)r * (GH * GDV) + 8 * lg); obv[i] = *(const u32x4*)(p.OB() + (size_t)r * (GH * GDV) + 8 * lg);
        zv[i] = *(const u32x4*)(p.P() + (size_t)r * DPROJP + PO_Z + 8 * lg); }
    const float* nwp = p.gdn_norm_w + layer * GDV + (8 * lg) % GDV; const f32x4 nw0 = *(const f32x4*)nwp, nw1 = *(const f32x4*)(nwp + 4);
    __builtin_amdgcn_sched_barrier(0);
#pragma unroll
    for (int i = 0; i < NR; ++i) { const int r = rows[i]; const bool ok = i < nvalid;
        if (NSPLIT > 1) { float mx = -3.0e38f;
#pragma unroll
            for (int c = 0; c < NSPLIT; ++c) mx = fmaxf(mx, ml[i][c][0]);
            float o[8], wsum = 0.f;
#pragma unroll
            for (int e = 0; e < 8; ++e) o[e] = 0.f;
#pragma unroll
            for (int c = 0; c < NSPLIT; ++c) { const float w = ml[i][c][1] * __builtin_amdgcn_exp2f(ml[i][c][0] - mx); wsum += w; float x[8]; unpack8(op[i][c], x);
#pragma unroll
                for (int e = 0; e < 8; ++e) o[e] += w * x[e]; }
            const float inv = __builtin_amdgcn_rcpf(wsum);
#pragma unroll
            for (int e = 0; e < 8; ++e) o[e] *= inv;
            if (ok && r < T && lane < MH * MV / 8) *(u32x4*)(p.O() + (size_t)r * DMIX + (SWA_H + GH) * 64 + 8 * lane) = pack8(o); }
        float a[8], b[8], z[8], o[8]; unpack8(ofv[i], a); unpack8(obv[i], b); unpack8(zv[i], z); float ss = 0.f;
#pragma unroll
        for (int e = 0; e < 8; ++e) { o[e] = a[e] + b[e]; ss += o[e] * o[e]; }
        ss += dpp_f<0xB1>(ss); ss += dpp_f<0x4E>(ss); ss += dpp_f<0x141>(ss);
        const float rstd = rsqrt_f(ss / GDV + EPS);
#pragma unroll
        for (int e = 0; e < 8; ++e) o[e] = o[e] * rstd * (e < 4 ? nw0[e & 3] : nw1[e & 3]) * silu_f(z[e]);
        if (ok && lane < GH * GDV / 8) *(u32x4*)(p.O() + (size_t)r * DMIX + GH * GDV + 8 * lane) = pack8(o); }
}
__device__ __forceinline__ void mod_block(const Params& p, int item, LAS unsigned char* lds, int tid) {
    const int lane = tid & 63, wave = __builtin_amdgcn_readfirstlane(tid >> 6); const int ly = item / (6 * D / 64), jb = item % (6 * D / 64);
    LAS float* sl = (LAS float*)lds; LAS float* red = sl + 3 * D;
    __syncthreads();
    for (int i = tid; i < 3 * D; i += 256) { const int w = i / D, k = i % D; sl[i] = silu_f(w < 2 ? p.c[(size_t)w * D + k] : p.c_ctx[k]); }
    __syncthreads();
    const float* W = p.ada_w + (size_t)ly * D * 6 * D + jb * 64 + lane; float a0 = 0.f, a1 = 0.f, a2 = 0.f;
#pragma unroll 8
    for (int k = wave * (D / 4); k < (wave + 1) * (D / 4); ++k) { const float w = W[(size_t)k * 6 * D]; a0 += sl[k] * w; a1 += sl[D + k] * w; a2 += sl[2 * D + k] * w; }
    red[(wave * 3 + 0) * 64 + lane] = a0; red[(wave * 3 + 1) * 64 + lane] = a1; red[(wave * 3 + 2) * 64 + lane] = a2;
    __syncthreads();
    if (wave < 3) { const float v = red[(0 * 3 + wave) * 64 + lane] + red[(1 * 3 + wave) * 64 + lane] + red[(2 * 3 + wave) * 64 + lane] + red[(3 * 3 + wave) * 64 + lane];
        p.MOD()[((size_t)(ly * 3 + wave) * 6 * D) + jb * 64 + lane] = v + p.ada_b[(size_t)ly * 6 * D + jb * 64 + lane]; }
}
#endif


#ifndef HOST_EMU
#define XB_TMO      128
#define XB_XCNT(j)  (256  + 64 * (j))
#define XB_XSUB(j)  (1280 + 64 * (j))
#define XB_XGEN(j)  (2304 + 64 * (j))
#define XB_TOP      3328
#define XB_TOPGEN   3392
#define XCD_BAR_WORDS 3456
#define XB_SPIN_CAP (1u << 18)

__device__ __forceinline__ unsigned xb_ld(unsigned* p)              { return __hip_atomic_load(p, __ATOMIC_RELAXED, __HIP_MEMORY_SCOPE_AGENT); }
__device__ __forceinline__ unsigned xb_add(unsigned* p, unsigned v) { return __hip_atomic_fetch_add(p, v, __ATOMIC_RELAXED, __HIP_MEMORY_SCOPE_AGENT); }
__device__ __forceinline__ unsigned xb_xcc_id() { return (unsigned)__builtin_amdgcn_s_getreg((3 << 11) | 20) & 0xFu; }
#define XB_SPIN(cond, bar) do { unsigned _sp = 0; while (cond) { __builtin_amdgcn_s_sleep(1); \
    if ((++_sp & 255u) == 0u) { if (xb_ld(&(bar)[XB_TMO])) break; if (_sp > XB_SPIN_CAP) { atomicAdd(&(bar)[XB_TMO], 1u); break; } } } } while (0)

struct XcdBarrier {
    unsigned* bar; unsigned x;
    volatile LAS unsigned* st;
};

__device__ __forceinline__ XcdBarrier xcd_barrier_post(unsigned* bar, volatile LAS unsigned* st) {
    XcdBarrier b; b.bar = bar; b.x = xb_xcc_id(); b.st = st;
    if (threadIdx.x == 0) (void)xb_add(&bar[XB_XCNT(b.x)], 1u);
    return b;
}
__device__ __forceinline__ void xcd_barrier_complete(unsigned* bar, unsigned x, unsigned& nloc, unsigned& nx) {
    const unsigned G = gridDim.x * gridDim.y * gridDim.z;
    unsigned sum, cnt, mine, sp = 0u;
    for (;;) {
        sum = 0u; cnt = 0u; mine = 0u;
#pragma unroll
        for (unsigned j = 0; j < 16; ++j) { const unsigned c = xb_ld(&bar[XB_XCNT(j)]); sum += c; cnt += (c > 0u) ? 1u : 0u; mine = (j == x) ? c : mine; }
        if (sum == G) break;
        __builtin_amdgcn_s_sleep(1);
        if ((++sp & 255u) == 0u) { if (xb_ld(&bar[XB_TMO])) break; if (sp > XB_SPIN_CAP) { atomicAdd(&bar[XB_TMO], 1u); break; } }
    }
    nloc = mine > 0u ? mine : 1u; nx = cnt > 0u ? cnt : 1u;
}

__device__ __forceinline__ void xcd_barrier(const XcdBarrier& b) {
    asm volatile("s_waitcnt vmcnt(0)" ::: "memory");
    __syncthreads();
    if (threadIdx.x == 0) {
        unsigned* bar = b.bar;
        __builtin_amdgcn_s_waitcnt(0);
        unsigned nloc = b.st[0], nx = b.st[1];
        if (nloc == 0u) { xcd_barrier_complete(bar, b.x, nloc, nx); b.st[0] = nloc; b.st[1] = nx; }
        const unsigned old = xb_add(&bar[XB_XSUB(b.x)], 1u);
        const unsigned gen = old / nloc;
        if (old + 1u == (gen + 1u) * nloc) {
            __builtin_amdgcn_fence(__ATOMIC_RELEASE, "agent");
            asm volatile("s_waitcnt vmcnt(0)" ::: "memory");
            const unsigned og = xb_add(&bar[XB_TOP], 1u);
            const unsigned tg = og / nx;
            if (og + 1u == (tg + 1u) * nx) xb_add(&bar[XB_TOPGEN], 1u);
            else XB_SPIN(xb_ld(&bar[XB_TOPGEN]) == tg, bar);
            __builtin_amdgcn_fence(__ATOMIC_ACQUIRE, "agent");
            xb_add(&bar[XB_XGEN(b.x)], 1u);
            asm volatile("s_waitcnt vmcnt(0)" ::: "memory");
        } else {
            XB_SPIN(xb_ld(&bar[XB_XGEN(b.x)]) == gen, bar);
            __builtin_amdgcn_fence(__ATOMIC_ACQUIRE, "agent");
            asm volatile("s_waitcnt vmcnt(0)" ::: "memory");
        }
    }
    __syncthreads();
}

#endif

enum { K_ITEM = 0, K_WT = 1, K_GEMM = 2, K_ATTN = 3, K_GPRE = 4, K_ROW = 5, K_MOD = 6 };
struct Step { int kind, st, layer, sync_before; };
inline int build_program(Step* prog) {
    int n = 0;
    prog[n++] = {K_ITEM, ST_ZERO, 0, 0}; prog[n++] = {K_ITEM, ST_TAB, 0, 0}; prog[n++] = {USE_KMOD ? K_MOD : K_ITEM, USE_KMOD ? 0 : ST_MOD, 0, 0}; prog[n++] = {K_WT, WT_STATIC, 0, 0};
    for (int l = 0; l < DEPTH; ++l) {
        if (l == 0 || !USE_RPOST2) { if (USE_RNORM1) prog[n++] = {K_ROW, 0  , l, 1}; else prog[n++] = {K_ITEM, ST_NORM1, l, 1}; }
        prog[n++] = {K_GEMM, G_PROJ, l, 1};
        prog[n++] = {K_ROW, 3  , l, 1};
        prog[n++] = {K_GEMM, G_UQ, l, 1}; prog[n++] = {K_GEMM, G_UKV, l, 0}; prog[n++] = {K_GPRE, 0, l, 0};
        prog[n++] = {K_ATTN, 0, l, 1};
        prog[n++] = {K_ROW, 4  , l, 1};
        prog[n++] = {K_GEMM, G_WOUT, l, 1};
        if (USE_RPOST1) { prog[n++] = {K_ROW, 1  , l, 1}; prog[n++] = {K_ROW, 5  , l, 1}; prog[n++] = {K_WT, WT_EXPERT, l, 0};   } else { prog[n++] = {K_ITEM, ST_POST1, l, 1}; prog[n++] = {K_ITEM, ST_ROUTER, l, 1}; prog[n++] = {K_ITEM, ST_ROUTE, l, 1}; }
        prog[n++] = {K_GEMM, G_SGU, l, 1}; prog[n++] = {K_GEMM, G_EGU, l, 0};
        prog[n++] = {K_GEMM, G_SDOWN, l, 1}; prog[n++] = {K_GEMM, G_EDOWN, l, 0};
        if (USE_RPOST2) prog[n++] = {K_ROW, 2  , l, 1}; else prog[n++] = {K_ITEM, ST_POST2, l, 1};
    }
    return n;
}
constexpr int MAX_STEPS = 64;

#ifndef HOST_EMU
namespace cg = cooperative_groups;
struct Prog { Step s[MAX_STEPS]; Step s2[MAX_STEPS]; int n; int pad[3]; };

__global__ void __launch_bounds__(256, 2) k_mega(Params p, Prog pr) {
    extern __shared__ __attribute__((aligned(16))) unsigned char smem[];
    LAS unsigned char* lds = (LAS unsigned char*)smem;
    { volatile LAS unsigned* bst = (volatile LAS unsigned*)(lds + 65536); if (threadIdx.x < 2) bst[threadIdx.x] = 0u; }
    __syncthreads();
    (void)xcd_barrier_post(p.BAR(), (volatile LAS unsigned*)(lds + 65536));
#define XBAR_NOW() do { XcdBarrier xb_; xb_.bar = p.BAR(); xb_.x = xb_xcc_id(); xb_.st = (volatile LAS unsigned*)(lds + 65536); xcd_barrier(xb_); } while (0)
    const long long gthreads = (long long)gridDim.x * 256;
    unsigned long long pb_chain = 0; (void)pb_chain;
#if PROBE_SEL
    unsigned long long pb_acc = 0, pb_t0 = __builtin_amdgcn_s_memrealtime(); bool pb_on = false;
#endif
    const Step* steps = (blockIdx.x & 1) ? pr.s2 : pr.s;
    for (int s = 0; s < pr.n; ++s) {
        const int kind = steps[s].kind, st = steps[s].st, layer = steps[s].layer;
#if PROBE_SEL
        const bool pb_match = (PROBE_SEL == 1 && kind == K_ROW && st == 1) || (PROBE_SEL == 2 && ((kind == K_ITEM && st == ST_ROUTE) || (kind == K_ROW && st == 5))) || (PROBE_SEL == 3 && kind == K_ROW && st == 2) || (PROBE_SEL == 4 && kind == K_ROW && st == 3) ||
            (PROBE_SEL == 5 && kind == K_ROW && st == 4) || (PROBE_SEL == 6 && kind == K_ATTN) || (PROBE_SEL == 7 && kind == K_GEMM && st == G_PROJ) || (PROBE_SEL == 8 && kind == K_GEMM && st == G_WOUT) ||
            (PROBE_SEL == 9 && kind == K_GEMM && st == G_EGU) || (PROBE_SEL == 10 && kind == K_GEMM && st == G_EDOWN) || (PROBE_SEL == 11 && kind == K_GPRE) || (PROBE_SEL == 12 && kind == K_WT && st == WT_STATIC) || (PROBE_SEL == 13 && kind == K_WT && st == WT_EXPERT) || (PROBE_SEL == 14 && kind == K_ROW && st == 0) || (PROBE_SEL == 30 && kind == K_GEMM) || (PROBE_SEL == 31 && kind == K_ROW && st != 1) || (PROBE_SEL == 32 && (kind == K_GPRE || kind == K_WT || kind == K_ITEM || kind == K_MOD));
#endif
        if (steps[s].sync_before) { XBAR_NOW();
#if PROBE_SEL
            { const unsigned long long now = __builtin_amdgcn_s_memrealtime(); if (pb_on) pb_acc += now - pb_t0; pb_t0 = now; pb_on = false; }
#endif
        }
#if PROBE_SEL
        if (pb_match) pb_on = true;
#endif
        int reps = 1;
        if (PROBE_MASK) { const int grp = kind == K_GEMM ? 0 : kind == K_ATTN ? 1 : kind == K_GPRE ? 2 : kind == K_WT ? 3 : (kind == K_ROW && (st == R_XFORM || st == R_GOUT || st == R_NORM1)) ? 4 : 7;
            if (grp < 5 && ((PROBE_MASK >> grp) & 1)) reps = 2; if (((PROBE_MASK >> 5) & 1) && steps[s].sync_before) XBAR_NOW(); }
        for (int rep = 0; rep < reps; ++rep) {
        if (rep > 0 && ((PROBE_MASK >> 6) & 1)) XBAR_NOW();
        int tid = threadIdx.x; asm volatile("" : "+v"(tid));
        const int lane = tid & 63, wave = __builtin_amdgcn_readfirstlane(tid >> 6);
        const long long gtid = (long long)blockIdx.x * 256 + tid;
        ETab et{nullptr, nullptr};
        if ((kind == K_GEMM && (st == G_EGU || st == G_EDOWN)) || (kind == K_ROW && st == R_POST2)) {
            LAS int* eb = (LAS int*)(lds + 65536 + 64); LAS int* tb = eb + 72;
            __syncthreads();
            if (wave == 0) { const int c = FUSE_ROUTE ? p.CNTP()[(layer * NE + lane) * 32] : p.CNT()[layer * NE + lane]; int a = c, t = (c + 127) >> 7;
#pragma unroll
                for (int o = 1; o < 64; o <<= 1) { const int ua = __shfl_up(a, o), ut = __shfl_up(t, o); if (lane >= o) { a += ua; t += ut; } }
                eb[lane + 1] = a; tb[lane + 1] = t; if (lane == 0) { eb[0] = 0; tb[0] = 0; } }
            __syncthreads();
            et.eb = (const int*)eb; et.tb = (const int*)tb;
        }
        if (kind == K_ITEM) {
            const long long n = n_items(st, layer);
#define RUN_ST(ST) case ST: for (long long i = gtid; i < n; i += gthreads) run_item(p, ST, layer, i); break;
            switch (st) {
#if !USE_KMOD
                RUN_ST(ST_MOD)
#endif
#if !USE_RNORM1
                RUN_ST(ST_NORM1)
#endif
#if !USE_RPOST1
                RUN_ST(ST_POST1) RUN_ST(ST_ROUTER)
#endif
#if !USE_RPOST2
                RUN_ST(ST_POST2)
#endif
                RUN_ST(ST_ZERO) RUN_ST(ST_TAB)
#if !USE_RPOST1 || !FUSE_ROUTE
                RUN_ST(ST_ROUTE)
#endif
                default: break; }
#undef RUN_ST
        } else if (kind == K_WT) {
            const long long n = wt_items(p, st); LAS float* scr = (LAS float*)(lds + wave * (64 * 33 * 4));
            for (long long i = (long long)blockIdx.x * 4 + wave; i < n; i += (long long)gridDim.x * 4) wt_item_dev(p, st, layer, i, scr, lane);
        } else if (kind == K_GEMM) {
            const int n = gemm_ntiles(p, st, layer, et);
            const int q8 = n >> 3, r8 = n & 7;
            for (int i = blockIdx.x; i < n; i += gridDim.x) {
                const int x = i & 7, tau = (x < r8 ? x * (q8 + 1) : r8 * (q8 + 1) + (x - r8) * q8) + (i >> 3);
                GemmDesc g; gemm_desc(p, st, layer, tau, g, et); gemm_tile_dev(g, lds, tid); }
        } else if (kind == K_ROW) {
            const int gw = blockIdx.x * 4 + wave, nw = gridDim.x * 4;
            if (st == R_NORM1) { for (int r = gw; r < TA; r += nw) row_norm1(p, layer, r, lane); }
            else if (st == R_POST1) { __syncthreads();
#if FUSE_ROUTE
                LAS float* hl = (LAS float*)(lds + wave * (4 * D * 4)); for (int i = gw; i < rows_out(layer) / 4; i += nw) row_post1_quad(p, layer, i, lane, hl);
#else
                LAS float* hl = (LAS float*)(lds + wave * (POST1_NR * D * 4)); LAS int* lcnt = (LAS int*)(lds + 65536 + 640);
                if (tid < NE) lcnt[tid] = 0;
                __syncthreads();
                (void)hl; for (int j16 = blockIdx.x; j16 < rows_out(layer) / 16; j16 += gridDim.x) block_post1(p, layer, j16, lane, wave, lds, lcnt, pb_chain);
                __syncthreads();
                if (tid < NE) p.BCNT()[(size_t)blockIdx.x * NE + tid] = lcnt[tid];
#endif
            }
            else if (st == R_ROUTE2) route_place(p, layer, lds, tid, lane, wave);
            else if (st == R_POST2) { for (int r = gw; r < rows_out(layer); r += nw) row_post2(p, layer, r, lane, et.eb); }
            else if (st == R_XFORM) { __syncthreads(); LAS float* cw = (LAS float*)lds; for (int i = tid; i < GCONV * GQKV; i += 256) cw[i] = p.gdn_conv_w[(size_t)layer * GCONV * GQKV + i]; __syncthreads();
                for (int r = gw; r < TA; r += nw) row_xform(p, layer, r, lane, cw); }
            else { const int nr = rows_out(layer);
                for (int r = gw; r < nr; r += 2 * nw) { const bool two = r + nw < nr; const int rows[2] = {r, two ? r + nw : r}; row_gout_multi<2>(p, layer, rows, two ? 2 : 1, lane); } }
        } else if (kind == K_MOD) {
            for (int i = blockIdx.x; i < DEPTH * (6 * D / 64); i += gridDim.x) mod_block(p, i, lds, tid);
        } else if (kind == K_GPRE) {
            const int n = NCHAIN * NCH / 2;
            for (int i = blockIdx.x; i < n; i += gridDim.x) gdn_pre_dev(p, i, lds, tid, pb_chain);
        } else {
            LAS int* slot = (LAS int*)(lds + 65536 + 16); const int x0 = (int)(xb_xcc_id() & 7u);
            for (int qs = 0; qs < 8; ++qs) {
                const int x = (x0 + qs) & 7, nq = attn_queue_size(layer, x);
                for (;;) {
                    __syncthreads(); if (tid == 0) *slot = atomicAdd(p.CTR() + layer * 16 + rep * 8 + x, 1); __syncthreads();
                    const int k = *slot; if (k >= nq) break;
                    const int item = attn_queue_item(layer, x, k);
                    int t2 = tid; asm volatile("" : "+v"(t2));
#if PROBE_SEL == 24
                    if (item < NCHAIN) { const unsigned long long c0 = __builtin_amdgcn_s_memrealtime(); gdn_scan_dev(p, item, lds, t2); pb_chain += __builtin_amdgcn_s_memrealtime() - c0; continue; }
#else
                    if (item < NCHAIN) { gdn_scan_dev(p, item, lds, t2); continue; }
#endif
                    AttnDesc a; attn_desc(p, layer, item - NCHAIN, a);
                    if (a.dqk == 96) attn_tile_dev<96>(a, lds, t2); else attn_tile_dev<64>(a, lds, t2);
                }
            }
        }
        }
    }
#if PROBE_SEL
    { const unsigned long long now = __builtin_amdgcn_s_memrealtime(); if (pb_on) pb_acc += now - pb_t0;
      if (PROBE_SEL == 24 || PROBE_SEL >= 40) pb_acc = pb_chain;
      if (blockIdx.x == 0 || PROBE_SEL == 24 || PROBE_SEL >= 40) { const unsigned long long until = now + 4ull * pb_acc; while (__builtin_amdgcn_s_memrealtime() < until) __builtin_amdgcn_s_sleep(32); } }
#endif
}

extern "C" void kernel_launch(void* const* d_in, const int* in_sizes, int n_in, void* d_out, int out_size, void* d_ws, size_t ws_size, hipStream_t stream) {
    Params p{};
    const float** pin = (const float**)&p;
    for (int i = 0; i < 29 && i < n_in; ++i) pin[i] = (const float*)d_in[i];
    p.out = (float*)d_out;
    const size_t need = carve(p, (char*)d_ws);
    if (need > ws_size) { fprintf(stderr, "kernel_launch: workspace too small: need %zu have %zu\n", need, ws_size); return; }
    Prog pr{}; pr.n = build_program(pr.s);
    for (int i = 0; i < pr.n; ++i) pr.s2[i] = pr.s[i];
    for (int i = 0; i + 1 < pr.n; ++i) if (pr.s[i].kind == K_ROW && pr.s[i].st == 5 && pr.s[i + 1].kind == K_WT && pr.s[i + 1].st == WT_EXPERT && !pr.s[i + 1].sync_before) {
        pr.s2[i] = pr.s[i + 1]; pr.s2[i + 1] = pr.s[i]; pr.s2[i].sync_before = pr.s[i].sync_before; pr.s2[i + 1].sync_before = pr.s[i + 1].sync_before; }
    constexpr int LDS_BYTES = 65536 + 1024;
    static int grid_blocks = 0;
    if (!grid_blocks) {
        int dev = 0, cus = 0, per_cu = 0;
        (void)hipGetDevice(&dev);
        (void)hipDeviceGetAttribute(&cus, hipDeviceAttributeMultiprocessorCount, dev);
        (void)hipFuncSetAttribute((const void*)k_mega, hipFuncAttributeMaxDynamicSharedMemorySize, LDS_BYTES);
        (void)hipOccupancyMaxActiveBlocksPerMultiprocessor(&per_cu, k_mega, 256, LDS_BYTES);
        if (per_cu > 2) per_cu = 2;
        if (per_cu < 1) per_cu = 1;
        grid_blocks = cus * per_cu;
    }
    (void)hipMemsetAsync(p.BAR(), 0, 4096 * 4, stream);
    void* args[] = {&p, &pr};
    hipError_t e = hipLaunchCooperativeKernel((void*)k_mega, dim3(grid_blocks), dim3(256), args, LDS_BYTES, stream);
    if (e != hipSuccess) fprintf(stderr, "cooperative launch failed: %s (grid %d)\n", hipGetErrorString(e), grid_blocks);
}
#endif
```
